# Optimizing an MI355X kernel written in HIP

```python
import math
import jax, jax.numpy as jnp
from jax import lax
import numpy as np

D_MODEL = 2048
BATCH = 16
SEQ = 2048
DEPTH = 2

CTX_LEN = 256
GRID_W = 64
N_MOD = 6
EPS = 1e-6
POS_THETA = 10000.0
D_A = D_MODEL // 2
G_A = 8
DG_A = D_A // G_A
GMLP_CHUNK = 128
D_B = D_MODEL // 2
H_B = 8
DK_B = D_B // H_B
GLA_CHUNK = 32
S5_IN = 16
S5_STATE = 64
D_C = 3 * D_MODEL // 8
G_C = D_C // S5_IN
IN_COLS = 2 * D_A + 5 * D_B + D_C + 3 * D_MODEL
PEER_HEADS = 8
PEER_NKEYS = 128
PEER_EXPERTS = PEER_NKEYS * PEER_NKEYS
PEER_TOPK = 16
PEER_DQ = 256
PEER_BLOCK = 128

kernel_name = "hybrid_gmlp_hgrn2_s5_peer_dit"


def rms_norm(x):
    xf = x.astype(jnp.float32)
    return (xf * lax.rsqrt(jnp.mean(xf * xf, axis=-1, keepdims=True) + EPS)).astype(x.dtype)


def layer_norm(x, g, b):
    xf = x.astype(jnp.float32)
    xc = xf - jnp.mean(xf, axis=-1, keepdims=True)
    var = jnp.mean(xc * xc, axis=-1, keepdims=True)
    return (xc * lax.rsqrt(var + EPS) * g.astype(jnp.float32) + b.astype(jnp.float32)).astype(x.dtype)


def pos_embed_2d(n, d):
    n_rows = n // GRID_W
    quarter = d // 4
    omega = 1.0 / (POS_THETA ** (jnp.arange(quarter, dtype=jnp.float32) / quarter))
    def axis_code(length):
        ang = jnp.arange(length, dtype=jnp.float32)[:, None] * omega[None]
        return jnp.concatenate([jnp.sin(ang), jnp.cos(ang)], axis=-1)
    er = jnp.broadcast_to(axis_code(n_rows)[:, None], (n_rows, GRID_W, d // 2))
    ec = jnp.broadcast_to(axis_code(GRID_W)[None], (n_rows, GRID_W, d // 2))
    return jnp.concatenate([er, ec], axis=-1).reshape(n, d)


def split_in_proj(p):
    sizes = (D_A, D_A, D_B, D_B, D_B, D_B, D_B, D_C, 3 * D_MODEL)
    idx = np.cumsum(sizes)[:-1].tolist()
    return jnp.split(p, idx, axis=-1)


def gmlp_branch(a_u, a_v, ln_g, ln_b, w_s, b_s):
    bsz, n, _ = a_v.shape
    u = jax.nn.gelu(a_u, approximate=False)
    v = layer_norm(jax.nn.gelu(a_v, approximate=False), ln_g, ln_b)
    v = v.reshape(bsz, n // GMLP_CHUNK, GMLP_CHUNK, G_A, DG_A)
    v = jnp.einsum('gts,bcsgd->bctgd', w_s.astype(v.dtype), v) + b_s.T[None, None, :, :, None].astype(v.dtype)
    return u * v.reshape(bsz, n, D_A)


def gla_chunk_scan(q, k, v, log_f, s0):
    bsz, n, h, _ = q.shape
    dv = v.shape[-1]
    nc = n // GLA_CHUNK
    def to_chunks(a):
        return a.reshape(bsz, nc, GLA_CHUNK, h, a.shape[-1]).transpose(1, 0, 3, 2, 4)
    mask = jnp.tril(jnp.ones((GLA_CHUNK, GLA_CHUNK), dtype=bool))[:, :, None]
    def step(s, inp):
        qc, kc, vc, lfc = inp
        b = jnp.cumsum(lfc, axis=2)
        b_last = b[:, :, -1:, :]
        o_inter = jnp.einsum('bhtk,bhkv->bhtv', qc * jnp.exp(b), s)
        diff = b[:, :, :, None, :] - b[:, :, None, :, :]
        decay = jnp.where(mask, jnp.exp(jnp.where(mask, diff, 0.0)), 0.0)
        att = jnp.einsum('bhtk,bhsk,bhtsk->bhts', qc, kc, decay)
        o = o_inter + jnp.einsum('bhts,bhsv->bhtv', att, vc)
        s_new = jnp.exp(b_last[:, :, 0, :])[..., None] * s + jnp.einsum('bhsk,bhsv->bhkv', kc * jnp.exp(b_last - b), vc)
        return s_new, o
    s_fin, o = lax.scan(step, s0, (to_chunks(q), to_chunks(k), to_chunks(v), to_chunks(log_f)))
    return o.transpose(1, 0, 3, 2, 4).reshape(bsz, n, h, dv), s_fin


def hgrn_bidir(q, f_fwd, f_bwd, i, lb, s0_f, s0_b):
    rev = lambda a: jnp.flip(a, axis=1)
    log_f_f = jnp.log(lb[0] + (1.0 - lb[0]) * jax.nn.sigmoid(f_fwd))
    log_f_b = rev(jnp.log(lb[1] + (1.0 - lb[1]) * jax.nn.sigmoid(f_bwd)))
    o_f, s_f = gla_chunk_scan(q, -jnp.expm1(log_f_f), i, log_f_f, s0_f)
    o_b, s_b = gla_chunk_scan(rev(q), -jnp.expm1(log_f_b), rev(i), log_f_b, s0_b)
    return o_f + rev(o_b), s_f, s_b


def head_rms_norm(o, g):
    bsz, n = o.shape[:2]
    o = o * lax.rsqrt(jnp.mean(o * o, axis=-1, keepdims=True) + EPS) * g.astype(jnp.float32).reshape(H_B, DK_B)
    return o.reshape(bsz, n, D_B)


def _linear_combine(left, right):
    a_l, b_l = left
    a_r, b_r = right
    return a_r * a_l, a_r * b_l + b_r


def s5_direction(u, lam_re, lam_im, log_step, b_re, b_im, c_re, c_im, x0):
    f32 = jnp.float32
    n = u.shape[1]
    lam = lax.complex(lam_re.astype(f32), lam_im.astype(f32))
    lam_dt = lam * jnp.exp(log_step.astype(f32))[:, None]
    lam_bar = jnp.exp(lam_dt)
    b_bar = ((lam_bar - 1.0) / lam)[:, :, None] * lax.complex(b_re.astype(f32), b_im.astype(f32))
    bu = jnp.einsum('bngd,gpd->bngp', u.astype(jnp.complex64), b_bar)
    a = jnp.broadcast_to(lam_bar, (1, n) + lam_bar.shape)
    _, xs = lax.associative_scan(_linear_combine, (a, bu), axis=1)
    steps = jnp.arange(1, n + 1, dtype=f32)[:, None, None]
    xs = xs + jnp.exp(lam_dt[None] * steps)[None] * x0[:, None]
    y = jnp.einsum('bngp,gdp->bngd', xs, lax.complex(c_re.astype(f32), c_im.astype(f32))).real
    return y, xs[:, -1]


def s5_bidir(u, lam_re, lam_im, log_step, b_re, b_im, c_re, c_im, x0_f, x0_b):
    y_f, x_f = s5_direction(u, lam_re[0], lam_im[0], log_step[0], b_re[0], b_im[0], c_re[0], c_im[0], x0_f)
    y_b, x_b = s5_direction(jnp.flip(u, axis=1), lam_re[1], lam_im[1], log_step[1], b_re[1], b_im[1], c_re[1], c_im[1], x0_b)
    return y_f + jnp.flip(y_b, axis=1), x_f, x_b


def s5_glu(y, u, d_skip, w_glu):
    bsz, n = y.shape[:2]
    y = y.reshape(bsz, n, D_C) + d_skip.astype(jnp.float32) * u.reshape(bsz, n, D_C)
    z = jax.nn.gelu(y, approximate=False) @ w_glu.astype(jnp.float32)
    za, zg = jnp.split(z, 2, axis=-1)
    return za * jax.nn.sigmoid(zg)


def token_mix(h, wi, ln_g, ln_b, w_s, b_s, lb, hn_g, lam_re, lam_im, log_step, b_re, b_im, c_re, c_im,
              d_skip, w_glu, wa, wb, wc, wo, hgrn_s0, s5_x0, need_out):
    f32 = jnp.float32
    bsz, n, _ = h.shape
    a_u, a_v, b_q, b_ff, b_fb, b_i, b_g, c_u, gates = split_in_proj(h @ wi)
    heads = lambda t: t.astype(f32).reshape(bsz, n, H_B, DK_B)
    o_b, hs_f, hs_b = hgrn_bidir(jax.nn.silu(heads(b_q)), heads(b_ff), heads(b_fb), heads(b_i), lb, hgrn_s0[0], hgrn_s0[1])
    cu = c_u.astype(f32).reshape(bsz, n, G_C, S5_IN)
    y_s5, xs_f, xs_b = s5_bidir(cu, lam_re, lam_im, log_step, b_re, b_im, c_re, c_im, s5_x0[0], s5_x0[1])
    if not need_out:
        return None, (hs_f, hs_b), (xs_f, xs_b)
    ya = gmlp_branch(a_u, a_v, ln_g, ln_b, w_s, b_s)
    yb = (head_rms_norm(o_b, hn_g) * jax.nn.silu(b_g.astype(f32))).astype(h.dtype)
    yc = s5_glu(y_s5, cu, d_skip, w_glu).astype(h.dtype)
    ga, gb, gc = jnp.split(gates, 3, axis=-1)
    merged = jax.nn.sigmoid(ga) * (ya @ wa) + jax.nn.sigmoid(gb) * (yb @ wb) + jax.nn.sigmoid(gc) * (yc @ wc)
    return merged @ wo, (hs_f, hs_b), (xs_f, xs_b)


def peer(h, w_q, sub_keys, u_tab, v_tab):
    f32 = jnp.float32
    bsz, n, d = h.shape
    t = h.reshape(bsz * n, d)
    q = (t @ w_q).astype(f32).reshape(-1, PEER_HEADS, 2, PEER_DQ // 2)
    s = jnp.einsum('thpe,hpke->thpk', q, sub_keys.astype(f32))
    sv, si = lax.top_k(s, PEER_TOPK)
    cand = (sv[:, :, 0, :, None] + sv[:, :, 1, None, :]).reshape(-1, PEER_HEADS, PEER_TOPK * PEER_TOPK)
    fv, fi = lax.top_k(cand, PEER_TOPK)
    i1 = jnp.take_along_axis(si[:, :, 0], fi // PEER_TOPK, axis=-1)
    i2 = jnp.take_along_axis(si[:, :, 1], fi % PEER_TOPK, axis=-1)
    idx = (i1 * PEER_NKEYS + i2).reshape(-1, PEER_HEADS * PEER_TOPK)
    g = jax.nn.softmax(fv, axis=-1).reshape(-1, PEER_HEADS * PEER_TOPK)
    nb = t.shape[0] // PEER_BLOCK
    def expert_block(args):
        tb, ib, gb = args
        act = jnp.einsum('td,tkd->tk', tb, u_tab[ib]).astype(f32)
        w = (jax.nn.gelu(act, approximate=False) * gb).astype(v_tab.dtype)
        return jnp.einsum('tk,tkd->td', w, v_tab[ib])
    out = lax.map(expert_block, (t.reshape(nb, PEER_BLOCK, d), idx.reshape(nb, PEER_BLOCK, -1), g.reshape(nb, PEER_BLOCK, -1)))
    return out.reshape(bsz, n, d).astype(h.dtype)


def setup_inputs(seed: int = 0) -> dict:
    key = jax.random.key(seed)
    ks = jax.random.split(key, 32)
    f32 = jnp.float32
    nrm = lambda k, shape, s: jax.random.normal(k, shape, f32) * s
    x = nrm(ks[0], (BATCH, SEQ, D_MODEL), 1.0)
    c = nrm(ks[1], (BATCH, D_MODEL), 1.0)
    ctx = nrm(ks[2], (BATCH, CTX_LEN, D_MODEL), 1.0)
    c_ctx = nrm(ks[3], (D_MODEL,), 1.0)
    w_mod = nrm(ks[4], (DEPTH, D_MODEL, N_MOD * D_MODEL), 0.5 * D_MODEL ** -0.5)
    b_mod = nrm(ks[5], (DEPTH, N_MOD * D_MODEL), 0.01)
    w_in = nrm(ks[6], (DEPTH, D_MODEL, IN_COLS), D_MODEL ** -0.5)
    gmlp_ln_g = 1.0 + nrm(ks[7], (DEPTH, D_A), 0.02)
    gmlp_ln_b = nrm(ks[8], (DEPTH, D_A), 0.02)
    gmlp_w_s = nrm(ks[9], (DEPTH, G_A, GMLP_CHUNK, GMLP_CHUNK), 0.5 * GMLP_CHUNK ** -0.5)
    gmlp_b_s = 1.0 + nrm(ks[10], (DEPTH, G_A, GMLP_CHUNK), 0.01)
    hgrn_lb_logits = nrm(ks[11], (DEPTH, 2, D_B), 0.1)
    hgrn_norm_g = 1.0 + nrm(ks[12], (DEPTH, D_B), 0.02)
    n_idx = jnp.arange(S5_STATE, dtype=f32)
    s5_lam_re = -0.5 + nrm(ks[13], (DEPTH, 2, G_C, S5_STATE), 0.01)
    s5_lam_im = math.pi * n_idx + nrm(ks[14], (DEPTH, 2, G_C, S5_STATE), 0.01)
    s5_log_step = jax.random.uniform(ks[15], (DEPTH, 2, G_C), f32, math.log(1e-3), math.log(1e-1))
    s5_b_re = nrm(ks[16], (DEPTH, 2, G_C, S5_STATE, S5_IN), (2 * S5_IN) ** -0.5)
    s5_b_im = nrm(ks[17], (DEPTH, 2, G_C, S5_STATE, S5_IN), (2 * S5_IN) ** -0.5)
    s5_c_re = nrm(ks[18], (DEPTH, 2, G_C, S5_IN, S5_STATE), (2 * S5_STATE) ** -0.5)
    s5_c_im = nrm(ks[19], (DEPTH, 2, G_C, S5_IN, S5_STATE), (2 * S5_STATE) ** -0.5)
    s5_d = nrm(ks[20], (DEPTH, D_C), 1.0)
    s5_w_glu = nrm(ks[21], (DEPTH, D_C, 2 * D_C), D_C ** -0.5)
    w_branch_a = nrm(ks[22], (DEPTH, D_A, D_MODEL), D_A ** -0.5)
    w_branch_b = nrm(ks[23], (DEPTH, D_B, D_MODEL), D_B ** -0.5)
    w_branch_c = nrm(ks[24], (DEPTH, D_C, D_MODEL), D_C ** -0.5)
    w_out = nrm(ks[25], (DEPTH, D_MODEL, D_MODEL), D_MODEL ** -0.5)
    peer_w_q = nrm(ks[26], (DEPTH, D_MODEL, PEER_HEADS * PEER_DQ), D_MODEL ** -0.5)
    peer_sub_keys = nrm(ks[27], (DEPTH, PEER_HEADS, 2, PEER_NKEYS, PEER_DQ // 2), (PEER_DQ // 2) ** -0.5)
    peer_u = nrm(ks[28], (DEPTH, PEER_EXPERTS, D_MODEL), D_MODEL ** -0.5)
    peer_v = nrm(ks[29], (DEPTH, PEER_EXPERTS, D_MODEL), 1.0)
    final_norm_g = 1.0 + nrm(ks[30], (D_MODEL,), 0.02)
    return {"x": x, "c": c, "ctx": ctx, "c_ctx": c_ctx, "w_mod": w_mod, "b_mod": b_mod, "w_in": w_in,
            "gmlp_ln_g": gmlp_ln_g, "gmlp_ln_b": gmlp_ln_b, "gmlp_w_s": gmlp_w_s, "gmlp_b_s": gmlp_b_s,
            "hgrn_lb_logits": hgrn_lb_logits, "hgrn_norm_g": hgrn_norm_g,
            "s5_lam_re": s5_lam_re, "s5_lam_im": s5_lam_im, "s5_log_step": s5_log_step,
            "s5_b_re": s5_b_re, "s5_b_im": s5_b_im, "s5_c_re": s5_c_re, "s5_c_im": s5_c_im,
            "s5_d": s5_d, "s5_w_glu": s5_w_glu,
            "w_branch_a": w_branch_a, "w_branch_b": w_branch_b, "w_branch_c": w_branch_c, "w_out": w_out,
            "peer_w_q": peer_w_q, "peer_sub_keys": peer_sub_keys, "peer_u": peer_u, "peer_v": peer_v,
            "final_norm_g": final_norm_g}


def reference(x, c, ctx, c_ctx, w_mod, b_mod, w_in, gmlp_ln_g, gmlp_ln_b, gmlp_w_s, gmlp_b_s,
              hgrn_lb_logits, hgrn_norm_g, s5_lam_re, s5_lam_im, s5_log_step, s5_b_re, s5_b_im, s5_c_re, s5_c_im,
              s5_d, s5_w_glu, w_branch_a, w_branch_b, w_branch_c, w_out, peer_w_q, peer_sub_keys, peer_u, peer_v,
              final_norm_g):
    bsz, n, d = x.shape
    x = x + pos_embed_2d(n, d).astype(x.dtype)[None]
    xc = ctx
    gamma = jax.nn.softmax(hgrn_lb_logits.astype(jnp.float32), axis=0)
    lower_bounds = jnp.cumsum(gamma, axis=0) - gamma[0:1]
    zero_h = jnp.zeros((bsz, H_B, DK_B, DK_B), jnp.float32)
    zero_s = jnp.zeros((bsz, G_C, S5_STATE), jnp.complex64)
    for l in range(DEPTH):
        ctx_out = l < DEPTH - 1
        mod_x = jax.nn.silu(c) @ w_mod[l] + b_mod[l]
        mod_c = jax.nn.silu(c_ctx) @ w_mod[l] + b_mod[l]
        sh1, sc1, g1, sh2, sc2, g2 = jnp.split(mod_x[:, None, :], N_MOD, axis=-1)
        csh1, csc1, cg1, csh2, csc2, cg2 = jnp.split(mod_c, N_MOD, axis=-1)
        lb = lower_bounds[l].reshape(2, H_B, DK_B)
        lp = (w_in[l], gmlp_ln_g[l], gmlp_ln_b[l], gmlp_w_s[l], gmlp_b_s[l], lb, hgrn_norm_g[l],
              s5_lam_re[l], s5_lam_im[l], s5_log_step[l], s5_b_re[l], s5_b_im[l], s5_c_re[l], s5_c_im[l],
              s5_d[l], s5_w_glu[l], w_branch_a[l], w_branch_b[l], w_branch_c[l], w_out[l])
        y_ctx, hgrn_state, s5_state = token_mix(rms_norm(xc) * (1.0 + csc1) + csh1, *lp,
                                                (zero_h, zero_h), (zero_s, zero_s), ctx_out)
        y_lat, _, _ = token_mix(rms_norm(x) * (1.0 + sc1) + sh1, *lp, hgrn_state, s5_state, True)
        x = x + g1 * y_lat
        x = x + g2 * peer(rms_norm(x) * (1.0 + sc2) + sh2, peer_w_q[l], peer_sub_keys[l], peer_u[l], peer_v[l])
        if ctx_out:
            xc = xc + cg1 * y_ctx
            xc = xc + cg2 * peer(rms_norm(xc) * (1.0 + csc2) + csh2, peer_w_q[l], peer_sub_keys[l], peer_u[l], peer_v[l])
    return rms_norm(x) * final_norm_g.astype(x.dtype)
```

```cpp
#include <hip/hip_runtime.h>
#include <stdint.h>

#define LAS __attribute__((address_space(3)))
typedef unsigned short bf16_t;
typedef short bf16x8 __attribute__((ext_vector_type(8)));
typedef float f32x4 __attribute__((ext_vector_type(4)));
typedef float f32x2 __attribute__((ext_vector_type(2)));
typedef unsigned u32x4 __attribute__((ext_vector_type(4)));
typedef unsigned u32x2 __attribute__((ext_vector_type(2)));
typedef __bf16 bf16x2_t __attribute__((ext_vector_type(2)));
typedef __bf16 bf16x32_t __attribute__((ext_vector_type(32)));
typedef float f32x32 __attribute__((ext_vector_type(32)));
typedef unsigned u32x6 __attribute__((ext_vector_type(6)));

constexpr int D = 2048, NB = 16, SEQ = 2048, CTXL = 256;
constexpr int TL = NB * SEQ;
constexpr int TC = NB * CTXL;
constexpr int TT = TL + TC;
constexpr int INC = 14080;
constexpr int NMOD = 12288;
constexpr int NTHREADS = 512;
constexpr int LDS_BYTES = 160 * 1024;

constexpr size_t OFF_BAR = 0;
constexpr size_t OFF_MODV = 16384;
constexpr size_t OFF_LB = OFF_MODV + (size_t)2 * 17 * NMOD * 4;
constexpr size_t OFF_S5LAM = OFF_LB + 2 * 2 * 1024 * 4;
constexpr size_t OFF_S5BB = OFF_S5LAM + (size_t)2 * 2 * 48 * 64 * 2 * 4;
constexpr size_t OFF_PE = OFF_S5BB + (size_t)2 * 2 * 48 * 64 * 32 * 4;
constexpr size_t OFF_CMAX = (OFF_PE + (size_t)96 * 1024 * 4 + 255) & ~(size_t)255;
constexpr size_t OFF_HS = OFF_CMAX + (size_t)2 * INC * 4;
constexpr size_t OFF_XC = (OFF_HS + (size_t)TT * 4 + 255) & ~(size_t)255;
constexpr size_t OFF_H = OFF_XC + (size_t)TC * D * 4;
constexpr size_t OFF_W = OFF_H + (size_t)TT * D * 2;
constexpr size_t W_IN = 0;
constexpr size_t W_GLU = W_IN + (size_t)INC * D;
constexpr size_t W_A = W_GLU + (size_t)1536 * 768 * 2;
constexpr size_t W_B = W_A + (size_t)2048 * 1024 * 2;
constexpr size_t W_C = W_B + (size_t)2048 * 1024 * 2;
constexpr size_t W_O = W_C + (size_t)2048 * 768 * 2;
constexpr size_t W_S = W_O + (size_t)2048 * 2048 * 2;
constexpr size_t W_TOTAL = W_S + (size_t)2048 * 2048 * 2;
constexpr size_t OFF_P = OFF_W + W_TOTAL;
constexpr size_t SEG = (size_t)TT * 1024 * 2;
constexpr size_t P_AU = 0, P_AV = SEG, P_BQ = 2 * SEG, P_BFF = 3 * SEG, P_BFB = 4 * SEG, P_BI = 5 * SEG, P_BG = 6 * SEG;
constexpr size_t P_CU = 7 * SEG;
constexpr size_t P_GATES = P_CU + (size_t)TT * 768 * 2;
constexpr size_t P_TOTAL = P_GATES + (size_t)TT * 6144 * 2;
constexpr size_t P_MERGED = SEG;
constexpr size_t Q_UT = 0;
constexpr size_t Q_VT = Q_UT + (size_t)16384 * 1536;
constexpr size_t Q_USC = Q_VT + (size_t)16384 * 1536;
constexpr size_t Q_VSC = Q_USC + (size_t)16384 * 4;
constexpr size_t Q_SC = Q_VSC + (size_t)16384 * 4;
constexpr size_t Q_IDX = Q_SC + (size_t)TT * 2048 * 4;
constexpr size_t Q_GATE = Q_IDX + (size_t)TT * 128 * 4;
constexpr size_t H_YSF = 0;
constexpr size_t H_YSB = (size_t)TT * 768 * 2;
constexpr size_t OFF_H8 = OFF_P + P_TOTAL;
constexpr size_t WS_NEEDED = OFF_H8 + (size_t)TT * D;

struct Params {
    const float *x, *c, *ctx, *c_ctx, *w_mod, *b_mod, *w_in, *ln_g, *ln_b, *w_s, *b_s, *lb_logits, *hn_g;
    const float *lam_re, *lam_im, *log_step, *b_re, *b_im, *c_re, *c_im, *s5_d, *w_glu, *wa, *wb, *wc, *wo, *w_q, *sub_keys, *peer_u, *peer_v, *final_g;
    float* out;
    unsigned char* ws;
};

__device__ __forceinline__ float bf_lo(unsigned u) { return __uint_as_float(u << 16); }
__device__ __forceinline__ float bf_hi(unsigned u) { return __uint_as_float(u & 0xffff0000u); }
__device__ __forceinline__ unsigned cvt_pk_bf16(float lo, float hi) { f32x2 v; v.x = lo; v.y = hi; const bf16x2_t b = __builtin_convertvector(v, bf16x2_t); return __builtin_bit_cast(unsigned, b); }
__device__ __forceinline__ float fexp(float x) { return __builtin_amdgcn_exp2f(x * 1.44269504f); }
__device__ __forceinline__ float flog(float x) { return __builtin_amdgcn_logf(x) * 0.693147181f; }
__device__ __forceinline__ float fast_sigmoid(float x) { return __builtin_amdgcn_rcpf(1.0f + fexp(-x)); }
__device__ __forceinline__ float fast_silu(float x) { return x * fast_sigmoid(x); }
__device__ __forceinline__ float gelu_f(float v) {
    const float av = fabsf(v), t = __builtin_amdgcn_rcpf(av * 0.2316418882f + 1.0f);
    float q = t * 0.5307027145f + (-0.7265760135f); q = q * t + 0.7107068705f; q = q * t + (-0.142248368f); q = q * t + 0.127414796f; q = q * t;
    const float e = __builtin_amdgcn_exp2f((v * v) * (-0.72134752044f));
    const float m = v * (q * e);
    return v < 0.f ? m : v - m;
}
__device__ __forceinline__ unsigned pack_fp8x4(float a, float b, float c, float d) {
    int pk = 0; pk = __builtin_amdgcn_cvt_pk_fp8_f32(a, b, pk, false); pk = __builtin_amdgcn_cvt_pk_fp8_f32(c, d, pk, true); return (unsigned)pk;
}
template <int CTRL> __device__ __forceinline__ float dpp_f(float v) { return __int_as_float(__builtin_amdgcn_update_dpp(0, __float_as_int(v), CTRL, 0xF, 0xF, false)); }
__device__ __forceinline__ float row16_max(float v) { v = fmaxf(v, dpp_f<0x128>(v)); v = fmaxf(v, dpp_f<0x124>(v)); v = fmaxf(v, dpp_f<0x122>(v)); v = fmaxf(v, dpp_f<0x121>(v)); return v; }
__device__ __forceinline__ float row16_sum(float v) { v += dpp_f<0x128>(v); v += dpp_f<0x124>(v); v += dpp_f<0x122>(v); v += dpp_f<0x121>(v); return v; }
__device__ __forceinline__ __amdgpu_buffer_rsrc_t wt_rsrc(const void* base, unsigned nbytes) { return __builtin_amdgcn_make_buffer_rsrc((void*)base, (short)0, (int)nbytes, 0x00020000); }
__device__ __forceinline__ void wt_store16(__amdgpu_buffer_rsrc_t r, unsigned byte_off, u32x4 v) { __builtin_amdgcn_raw_buffer_store_b128(v, r, (int)byte_off, 0, 16); }
__device__ __forceinline__ float wave_sum(float v) {
#pragma unroll
    for (int o = 32; o >= 1; o >>= 1) v += __shfl_xor(v, o);
    return v;
}
__device__ __forceinline__ int otid() { int t; asm volatile("v_mov_b32 %0, %1" : "=v"(t) : "v"((int)threadIdx.x)); return t; }


#define XB_TMO      128
#define XB_XCNT(j)  (256  + 64 * (j))
#define XB_XSUB(j)  (1280 + 64 * (j))
#define XB_XGEN(j)  (2304 + 64 * (j))
#define XB_TOP      3328
#define XB_TOPGEN   3392
#define XCD_BAR_WORDS 3456
#define XB_SPIN_CAP (1u << 22)
__device__ __forceinline__ unsigned xb_ld(unsigned* p)              { return __hip_atomic_load(p, __ATOMIC_RELAXED, __HIP_MEMORY_SCOPE_AGENT); }
__device__ __forceinline__ unsigned xb_add(unsigned* p, unsigned v) { return __hip_atomic_fetch_add(p, v, __ATOMIC_RELAXED, __HIP_MEMORY_SCOPE_AGENT); }
__device__ __forceinline__ unsigned xb_xcc_id() { return (unsigned)__builtin_amdgcn_s_getreg((3 << 11) | 20) & 0xFu; }
#define XB_SPIN(cond, bar) do { unsigned _sp = 0; while (cond) { __builtin_amdgcn_s_sleep(1); \
    if ((++_sp & 255u) == 0u) { if (xb_ld(&(bar)[XB_TMO])) break; if (_sp > XB_SPIN_CAP) { atomicAdd(&(bar)[XB_TMO], 1u); break; } } } } while (0)
struct XcdBarrier { unsigned* bar; unsigned x; volatile LAS unsigned* st; };
__device__ __forceinline__ XcdBarrier xcd_barrier_post(unsigned* bar, volatile LAS unsigned* st) {
    XcdBarrier b; b.bar = bar; b.x = xb_xcc_id(); b.st = st;
    if (threadIdx.x == 0) (void)xb_add(&bar[XB_XCNT(b.x)], 1u);
    return b;
}
__device__ __forceinline__ void xcd_barrier_complete(unsigned* bar, unsigned x, unsigned& nloc, unsigned& nx) {
    const unsigned G = gridDim.x * gridDim.y * gridDim.z;
    unsigned sum, cnt, mine, sp = 0u;
    for (;;) {
        sum = 0u; cnt = 0u; mine = 0u;
#pragma unroll
        for (unsigned j = 0; j < 16; ++j) { const unsigned c = xb_ld(&bar[XB_XCNT(j)]); sum += c; cnt += (c > 0u) ? 1u : 0u; mine = (j == x) ? c : mine; }
        if (sum == G) break;
        __builtin_amdgcn_s_sleep(1);
        if ((++sp & 255u) == 0u) { if (xb_ld(&bar[XB_TMO])) break; if (sp > XB_SPIN_CAP) { atomicAdd(&bar[XB_TMO], 1u); break; } }
    }
    nloc = mine > 0u ? mine : 1u; nx = cnt > 0u ? cnt : 1u;
}
__device__ __forceinline__ void xcd_barrier(const XcdBarrier& b) {
    asm volatile("s_waitcnt vmcnt(0)" ::: "memory");
    __syncthreads();
    if (threadIdx.x == 0) {
        unsigned* bar = b.bar;
        __builtin_amdgcn_s_waitcnt(0);
        unsigned nloc = b.st[0], nx = b.st[1];
        if (nloc == 0u) { xcd_barrier_complete(bar, b.x, nloc, nx); b.st[0] = nloc; b.st[1] = nx; }
        const unsigned old = xb_add(&bar[XB_XSUB(b.x)], 1u);
        const unsigned gen = old / nloc;
        if (old + 1u == (gen + 1u) * nloc) {
            __builtin_amdgcn_fence(__ATOMIC_RELEASE, "agent");
            asm volatile("s_waitcnt vmcnt(0)" ::: "memory");
            const unsigned og = xb_add(&bar[XB_TOP], 1u);
            const unsigned tg = og / nx;
            if (og + 1u == (tg + 1u) * nx) xb_add(&bar[XB_TOPGEN], 1u);
            else XB_SPIN(xb_ld(&bar[XB_TOPGEN]) == tg, bar);
            __builtin_amdgcn_fence(__ATOMIC_ACQUIRE, "agent");
            xb_add(&bar[XB_XGEN(b.x)], 1u);
            asm volatile("s_waitcnt vmcnt(0)" ::: "memory");
        } else {
            XB_SPIN(xb_ld(&bar[XB_XGEN(b.x)]) == gen, bar);
            __builtin_amdgcn_fence(__ATOMIC_ACQUIRE, "agent");
            asm volatile("s_waitcnt vmcnt(0)" ::: "memory");
        }
    }
    __syncthreads();
}

namespace pg8 {
constexpr int BM = 256, BK = 64, HALF = 128, HTB = HALF * BK * 2, STAGE_BYTES = 8 * HTB, NXCD = 8, WGM = 8;
__host__ __device__ __forceinline__ int lds_byte(int r, int c) { const int st = (r >> 4) * 2 + (c >> 5), rr = r & 15, cc = c & 31, ob = rr * 64 + cc * 2; return st * 1024 + (ob ^ (((ob >> 9) & 1) << 5)); }
__host__ __device__ __forceinline__ void stage_rc(int b, int& R, int& C) { const int st = b / 1024, sb = b % 1024, swz = sb ^ (((sb >> 9) & 1) << 5); R = (st >> 1) * 16 + swz / 64; C = (st & 1) * 32 + (swz % 64) / 2; }
__host__ __device__ __forceinline__ int perm32(int rho) { const int n = rho >> 4, i = rho & 15; return 8 * (i >> 2) + 4 * n + (i & 3); }
typedef int i32x8 __attribute__((ext_vector_type(8)));
__device__ __forceinline__ i32x8 cat8(const bf16x8 a, const bf16x8 b) { const u32x4 x = __builtin_bit_cast(u32x4, a), y = __builtin_bit_cast(u32x4, b); i32x8 r; r[0] = (int)x.x; r[1] = (int)x.y; r[2] = (int)x.z; r[3] = (int)x.w; r[4] = (int)y.x; r[5] = (int)y.y; r[6] = (int)y.z; r[7] = (int)y.w; return r; }
struct Unit { int pm, pn; };
struct Gemm { const bf16_t* A; const bf16_t* Bt; int M, N, K; };
struct StaticOrder {
    int nM, nN, nwg, G, c;
    __device__ void init(int M, int N, int G_, int c_) { nM = M / BM; nN = N / BM; nwg = nM * nN; G = G_; c = c_; }
    __device__ bool next(int i, Unit& u) const {
        const long L = (long)i * G + c; if (L >= nwg) return false;
        int wgid = (int)L; { const int q = nwg / NXCD, r = nwg % NXCD, xcd = wgid % NXCD, off = wgid / NXCD; wgid = (xcd < r ? xcd * (q + 1) : r * (q + 1) + (xcd - r) * q) + off; }
        const int nig = WGM * nN, gid = wgid / nig, fm = gid * WGM, gsz = (nM - fm) < WGM ? (nM - fm) : WGM;
        u.pm = fm + ((wgid % nig) % gsz); u.pn = (wgid % nig) / gsz; return true;
    }
};

template <class Epi, class Sched>
__device__ __forceinline__ void gemm_phase(LAS unsigned char* lds, const Gemm g, const Sched& S, const Epi& E) {
    const int tid_ = otid();
    const int tid = tid_, wid = __builtin_amdgcn_readfirstlane(tid >> 6), lane = tid & 63, wr = wid >> 2, wc = wid & 3, fr = lane & 15, fq = lane >> 4;
    const int K = g.K, nt = K / BK;
    unsigned voffA[2], voffB[2];
#pragma unroll
    for (int i = 0; i < 2; ++i) { int R, C; stage_rc(tid * 16 + i * 8192, R, C); const int Rb = Epi::PERM ? ((R & ~31) + perm32(R & 31)) : R;
        voffA[i] = (unsigned)(R * K + C) * 2u; voffB[i] = (unsigned)(Rb * K + C) * 2u; }
    const size_t kstep = (size_t)(BK * 2);
    const size_t hstep = (size_t)HALF * K * 2;
    const size_t tstep = 2 * hstep;
    const unsigned ldsw = (unsigned)wid * 1024u;
    const int aoff = lds_byte(wr * 64 + fr, fq * 8), boff = lds_byte(wc * 32 + fr, fq * 8);
    const int aoff8 = lds_byte(wr * 64 + fr, (fq >> 1) * 32 + (fq & 1) * 16), boff8 = lds_byte(wc * 32 + fr, (fq >> 1) * 32 + (fq & 1) * 16);
#define PG8_SA(b, h) (((b) * 2 + (h)) * HTB)
#define PG8_SB(b, h) ((4 + (b) * 2 + (h)) * HTB)
#define PG8_STAGE(bufoff, gbase, voff) do { _Pragma("unroll") for (int _i = 0; _i < 2; ++_i) \
        __builtin_amdgcn_global_load_lds((const unsigned*)((const char*)(gbase) + (voff)[_i]), (LAS unsigned*)(lds + (bufoff) + ldsw + _i * 8192), 16, 0, 0); } while (0)
#define PG8_LDA(dst, b, h) do { if constexpr (Epi::FP8) { _Pragma("unroll") for (int m = 0; m < 4; ++m) dst##8[m] = cat8(*(const LAS bf16x8*)(lds + PG8_SA(b, h) + aoff + m * 2048), *(const LAS bf16x8*)(lds + PG8_SA(b, h) + aoff + m * 2048 + 1024)); } \
        else { _Pragma("unroll") for (int m = 0; m < 4; ++m) _Pragma("unroll") for (int k = 0; k < 2; ++k) dst[m][k] = *(const LAS bf16x8*)(lds + PG8_SA(b, h) + aoff + m * 2048 + k * 1024); } } while (0)
#define PG8_LDB(dst, b, h) do { if constexpr (Epi::FP8) { _Pragma("unroll") for (int n = 0; n < 2; ++n) dst##8[n] = cat8(*(const LAS bf16x8*)(lds + PG8_SB(b, h) + boff + n * 2048), *(const LAS bf16x8*)(lds + PG8_SB(b, h) + boff + n * 2048 + 1024)); } \
        else { _Pragma("unroll") for (int n = 0; n < 2; ++n) _Pragma("unroll") for (int k = 0; k < 2; ++k) dst[n][k] = *(const LAS bf16x8*)(lds + PG8_SB(b, h) + boff + n * 2048 + k * 1024); } } while (0)
#define PG8_MMA(ai, bj, At, Bt) do { __builtin_amdgcn_s_setprio(1); _Pragma("unroll") for (int m = 0; m < 4; ++m) _Pragma("unroll") for (int n = 0; n < 2; ++n) { \
        if constexpr (Epi::FP8) { asm volatile("v_mfma_scale_f32_16x16x128_f8f6f4 %0, %1, %2, %0, %3, %3 op_sel_hi:[0,0,0]" : "+v"(acc[ai][bj][m][n]) : "v"(Bt##8[n]), "v"(At##8[m]), "v"(one_scale)); } \
        else { _Pragma("unroll") for (int k = 0; k < 2; ++k) acc[ai][bj][m][n] = __builtin_amdgcn_mfma_f32_16x16x32_bf16(Bt[n][k], At[m][k], acc[ai][bj][m][n], 0, 0, 0); } } \
        __builtin_amdgcn_s_setprio(0); } while (0)
#define PG8_WAIT_V(n) asm volatile("s_waitcnt vmcnt(" #n ")" ::: "memory")
#define PG8_WAIT_L(n) asm volatile("s_waitcnt lgkmcnt(" #n ")" ::: "memory")
#define PG8_BAR __builtin_amdgcn_s_barrier()
#define PG8_SCHED __builtin_amdgcn_sched_barrier(0)
    Unit cur, nxt; int ui = 0;
    if (!S.next(0, cur)) return;
    f32x4 acc[2][2][4][2];
#pragma unroll
    for (int a = 0; a < 2; ++a)
#pragma unroll
        for (int b = 0; b < 2; ++b)
#pragma unroll
            for (int m = 0; m < 4; ++m)
#pragma unroll
                for (int n = 0; n < 2; ++n) acc[a][b][m][n] = (f32x4){0.f, 0.f, 0.f, 0.f};
    bf16x8 At[4][2], B0[2][2], B1[2][2];
    i32x8 At8[4], B08[2], B18[2];
    const int one_scale = 0x7F7F7F7F;
    const char* cA = (const char*)g.A + (size_t)cur.pm * tstep; const char* cB = (const char*)g.Bt + (size_t)cur.pn * tstep;
    PG8_STAGE(PG8_SB(0, 0), cB, voffB); PG8_STAGE(PG8_SA(0, 0), cA, voffA); PG8_STAGE(PG8_SB(0, 1), cB + hstep, voffB); PG8_STAGE(PG8_SA(0, 1), cA + hstep, voffA);
    if (wr == 1) PG8_BAR;
    PG8_WAIT_V(4); PG8_BAR;
    PG8_STAGE(PG8_SB(1, 0), cB + kstep, voffB); PG8_STAGE(PG8_SA(1, 0), cA + kstep, voffA); PG8_STAGE(PG8_SB(1, 1), cB + hstep + kstep, voffB);
    PG8_WAIT_V(6); PG8_BAR;
    for (;;) {
        const bool has_next = S.next(ui + 1, nxt);
        const char* nA = has_next ? (const char*)g.A + (size_t)nxt.pm * tstep : cA; const char* nB = has_next ? (const char*)g.Bt + (size_t)nxt.pn * tstep : cB;
        for (int t = 0; t < nt; t += 2) {
            const bool last = (t == nt - 2);
            const char* a1 = cA + (size_t)(t + 1) * kstep;
            const char* a2 = last ? nA : cA + (size_t)(t + 2) * kstep; const char* b2 = last ? nB : cB + (size_t)(t + 2) * kstep;
            const char* a3 = a2 + kstep; const char* b3 = b2 + kstep;
            PG8_LDB(B0, 0, 0); PG8_SCHED; PG8_LDA(At, 0, 0); PG8_STAGE(PG8_SA(1, 1), a1 + hstep, voffA);
            PG8_WAIT_L(8); PG8_BAR; PG8_WAIT_L(0); PG8_MMA(0, 0, At, B0); PG8_BAR; PG8_SCHED;
            PG8_LDB(B1, 0, 1); PG8_STAGE(PG8_SB(0, 0), b2, voffB);
            PG8_BAR; PG8_WAIT_L(0); PG8_MMA(0, 1, At, B1); PG8_BAR;
            PG8_LDA(At, 0, 1); PG8_STAGE(PG8_SA(0, 0), a2, voffA);
            PG8_BAR; PG8_WAIT_L(0); PG8_MMA(1, 0, At, B0); PG8_BAR; PG8_SCHED;
            PG8_STAGE(PG8_SB(0, 1), b2 + hstep, voffB);
            PG8_WAIT_V(6); PG8_BAR; PG8_MMA(1, 1, At, B1); PG8_BAR;
            PG8_LDB(B0, 1, 0); PG8_SCHED; PG8_LDA(At, 1, 0); PG8_STAGE(PG8_SA(0, 1), a2 + hstep, voffA);
            PG8_WAIT_L(8); PG8_BAR; PG8_WAIT_L(0); PG8_MMA(0, 0, At, B0); PG8_BAR; PG8_SCHED;
            PG8_LDB(B1, 1, 1); PG8_STAGE(PG8_SB(1, 0), b3, voffB);
            PG8_BAR; PG8_WAIT_L(0); PG8_MMA(0, 1, At, B1); PG8_BAR;
            PG8_LDA(At, 1, 1); PG8_STAGE(PG8_SA(1, 0), a3, voffA);
            PG8_BAR; PG8_WAIT_L(0); PG8_MMA(1, 0, At, B0); PG8_BAR; PG8_SCHED;
            PG8_STAGE(PG8_SB(1, 1), b3 + hstep, voffB);
            PG8_WAIT_V(6); PG8_BAR; PG8_MMA(1, 1, At, B1); PG8_BAR;
        }
        if constexpr (Epi::FP8) asm volatile("s_nop 15\n s_nop 15\n s_nop 15" ::: "memory");
        E(acc, cur, wr, wc, fr, fq);
        if (!has_next) break;
#pragma unroll
        for (int a = 0; a < 2; ++a)
#pragma unroll
            for (int b = 0; b < 2; ++b)
#pragma unroll
                for (int m = 0; m < 4; ++m)
#pragma unroll
                    for (int n = 0; n < 2; ++n) acc[a][b][m][n] = (f32x4){0.f, 0.f, 0.f, 0.f};
        cur = nxt; cA = nA; cB = nB; ++ui;
    }
    PG8_WAIT_V(0);
    if (wr == 0) PG8_BAR;
    PG8_BAR;
#undef PG8_SA
#undef PG8_SB
#undef PG8_STAGE
#undef PG8_LDA
#undef PG8_LDB
#undef PG8_MMA
#undef PG8_WAIT_V
#undef PG8_WAIT_L
#undef PG8_BAR
#undef PG8_SCHED
}
}

typedef f32x4 AccT[2][2][4][2];

struct EpiInProj {
    static constexpr bool PERM = true, FP8 = true;
    unsigned char* P;
    const float* sa;
    const unsigned* cmax;
    __device__ __forceinline__ void operator()(const AccT& acc, const pg8::Unit& u, int wr, int wc, int fr, int fq) const {
        const int pn = u.pn;
        bf16_t* base; int ld, lc, act;
        unsigned nbytes;
        if (pn < 28) { const int seg = pn >> 2; base = (bf16_t*)(P + (size_t)seg * SEG); ld = 1024; lc = (pn & 3) * 256; act = (seg < 2) ? 1 : ((seg == 2 || seg == 6) ? 2 : 0); nbytes = (unsigned)SEG; }
        else if (pn < 31) { base = (bf16_t*)(P + P_CU); ld = 768; lc = (pn - 28) * 256; act = 0; nbytes = (unsigned)((size_t)TT * 768 * 2); }
        else { base = (bf16_t*)(P + P_GATES); ld = 6144; lc = (pn - 31) * 256; act = 3; nbytes = (unsigned)((size_t)TT * 6144 * 2); }
        const __amdgpu_buffer_rsrc_t wr_ = wt_rsrc(base, nbytes);
        const int row0 = u.pm * 256 + wr * 64 + fr, col0 = lc + wc * 32 + 8 * fq, gcol0 = u.pn * 256 + wc * 32 + 8 * fq;
        f32x4 cs[2][2];
#pragma unroll
        for (int bj = 0; bj < 2; ++bj)
#pragma unroll
            for (int n = 0; n < 2; ++n) { const u32x4 cb = *(const u32x4*)(cmax + gcol0 + bj * 128 + 4 * n);
                cs[bj][n] = (f32x4){__uint_as_float(cb.x), __uint_as_float(cb.y), __uint_as_float(cb.z), __uint_as_float(cb.w)} * (1.0f / 240.0f); }
        float rscv[2][4];
#pragma unroll
        for (int ai = 0; ai < 2; ++ai)
#pragma unroll
            for (int m = 0; m < 4; ++m) rscv[ai][m] = sa[row0 + ai * 128 + m * 16];
#pragma unroll
        for (int ai = 0; ai < 2; ++ai)
#pragma unroll
            for (int m = 0; m < 4; ++m) {
                const unsigned roff = ((unsigned)(row0 + ai * 128 + m * 16) * (unsigned)ld + (unsigned)col0) * 2u;
                const float rsc = rscv[ai][m];
#pragma unroll
                for (int bj = 0; bj < 2; ++bj) {
                    f32x4 v0 = acc[ai][bj][m][0] * (cs[bj][0] * rsc), v1 = acc[ai][bj][m][1] * (cs[bj][1] * rsc);
                    if (act == 1) {
#pragma unroll
                        for (int j = 0; j < 4; ++j) { v0[j] = gelu_f(v0[j]); v1[j] = gelu_f(v1[j]); }
                    } else if (act == 2) {
#pragma unroll
                        for (int j = 0; j < 4; ++j) { v0[j] = fast_silu(v0[j]); v1[j] = fast_silu(v1[j]); }
                    } else if (act == 3) {
#pragma unroll
                        for (int j = 0; j < 4; ++j) { v0[j] = fast_sigmoid(v0[j]); v1[j] = fast_sigmoid(v1[j]); }
                    }
                    u32x4 w; w.x = cvt_pk_bf16(v0[0], v0[1]); w.y = cvt_pk_bf16(v0[2], v0[3]); w.z = cvt_pk_bf16(v1[0], v1[1]); w.w = cvt_pk_bf16(v1[2], v1[3]);
                    wt_store16(wr_, roff + bj * 256, w);
                }
            }
    }
};
struct EpiGlu {
    static constexpr bool PERM = true, FP8 = false;
    bf16_t* O;
    __device__ __forceinline__ void operator()(const AccT& acc, const pg8::Unit& u, int wr, int wc, int fr, int fq) const {
        const int row0 = u.pm * 256 + wr * 64 + fr, col0 = u.pn * 128 + wc * 32 + 8 * fq;
        const __amdgpu_buffer_rsrc_t wr_ = wt_rsrc(O, (unsigned)((size_t)TT * 768 * 2));
#pragma unroll
        for (int ai = 0; ai < 2; ++ai)
#pragma unroll
            for (int m = 0; m < 4; ++m) {
                f32x4 v0 = acc[ai][0][m][0], v1 = acc[ai][0][m][1]; const f32x4 g0 = acc[ai][1][m][0], g1 = acc[ai][1][m][1];
#pragma unroll
                for (int j = 0; j < 4; ++j) { v0[j] *= fast_sigmoid(g0[j]); v1[j] *= fast_sigmoid(g1[j]); }
                u32x4 w; w.x = cvt_pk_bf16(v0[0], v0[1]); w.y = cvt_pk_bf16(v0[2], v0[3]); w.z = cvt_pk_bf16(v1[0], v1[1]); w.w = cvt_pk_bf16(v1[2], v1[3]);
                wt_store16(wr_, ((unsigned)(row0 + ai * 128 + m * 16) * 768u + (unsigned)col0) * 2u, w);
            }
    }
};
template <bool FIRST> struct EpiMerge {
    static constexpr bool PERM = true, FP8 = false;
    bf16_t* O;
    const bf16_t* G;
    __device__ __forceinline__ void operator()(const AccT& acc, const pg8::Unit& u, int wr, int wc, int fr, int fq) const {
        const int row0 = u.pm * 256 + wr * 64 + fr, col0 = u.pn * 256 + wc * 32 + 8 * fq;
#pragma unroll
        for (int ai = 0; ai < 2; ++ai) {
            u32x4 gwv[4][2], owv[4][2];
#pragma unroll
            for (int m = 0; m < 4; ++m)
#pragma unroll
                for (int bj = 0; bj < 2; ++bj) { const size_t row = (size_t)(row0 + ai * 128 + m * 16);
                    gwv[m][bj] = *(const u32x4*)(G + row * 6144 + col0 + bj * 128);
                    if (!FIRST) owv[m][bj] = *(const u32x4*)(O + row * 2048 + col0 + bj * 128); }
#pragma unroll
            for (int m = 0; m < 4; ++m)
#pragma unroll
                for (int bj = 0; bj < 2; ++bj) { const size_t row = (size_t)(row0 + ai * 128 + m * 16);
                    const u32x4 gw = gwv[m][bj];
                    f32x4 v0 = acc[ai][bj][m][0], v1 = acc[ai][bj][m][1];
                    v0[0] *= bf_lo(gw.x); v0[1] *= bf_hi(gw.x); v0[2] *= bf_lo(gw.y); v0[3] *= bf_hi(gw.y);
                    v1[0] *= bf_lo(gw.z); v1[1] *= bf_hi(gw.z); v1[2] *= bf_lo(gw.w); v1[3] *= bf_hi(gw.w);
                    if (!FIRST) { const u32x4 ow = owv[m][bj];
                        v0[0] += bf_lo(ow.x); v0[1] += bf_hi(ow.x); v0[2] += bf_lo(ow.y); v0[3] += bf_hi(ow.y);
                        v1[0] += bf_lo(ow.z); v1[1] += bf_hi(ow.z); v1[2] += bf_lo(ow.w); v1[3] += bf_hi(ow.w); }
                    u32x4 w; w.x = cvt_pk_bf16(v0[0], v0[1]); w.y = cvt_pk_bf16(v0[2], v0[3]); w.z = cvt_pk_bf16(v1[0], v1[1]); w.w = cvt_pk_bf16(v1[2], v1[3]);
                    *(u32x4*)(O + row * 2048 + col0 + bj * 128) = w; }
        }
    }
};
struct EpiResid {
    static constexpr bool PERM = false, FP8 = false;
    float* XR; float* XC; const float* modl;
    __device__ __forceinline__ void operator()(const AccT& acc, const pg8::Unit& u, int wr, int wc, int fr, int fq) const {
        const int row0 = u.pm * 256 + wr * 64 + fr, col0 = u.pn * 256 + wc * 32 + 4 * fq;
        const int mb = u.pm < 128 ? (u.pm >> 3) : 16;
        const float* gv = modl + (size_t)mb * NMOD + col0;
        float* basep = u.pm < 128 ? XR : (XC - (size_t)TL * D);
        f32x4 gvv[2][2];
#pragma unroll
        for (int bj = 0; bj < 2; ++bj)
#pragma unroll
            for (int n = 0; n < 2; ++n) gvv[bj][n] = *(const f32x4*)(gv + bj * 128 + n * 16);
#pragma unroll
        for (int ai = 0; ai < 2; ++ai) {
            f32x4 xo[4][2][2];
#pragma unroll
            for (int m = 0; m < 4; ++m)
#pragma unroll
                for (int bj = 0; bj < 2; ++bj)
#pragma unroll
                    for (int n = 0; n < 2; ++n) xo[m][bj][n] = *(const f32x4*)(basep + (size_t)(row0 + ai * 128 + m * 16) * D + col0 + bj * 128 + n * 16);
#pragma unroll
            for (int m = 0; m < 4; ++m)
#pragma unroll
                for (int bj = 0; bj < 2; ++bj)
#pragma unroll
                    for (int n = 0; n < 2; ++n) *(f32x4*)(basep + (size_t)(row0 + ai * 128 + m * 16) * D + col0 + bj * 128 + n * 16) = xo[m][bj][n] + gvv[bj][n] * acc[ai][bj][m][n];
        }
    }
};
struct EpiF32 {
    static constexpr bool PERM = false, FP8 = false;
    float* C; int ldc;
    __device__ __forceinline__ void operator()(const AccT& acc, const pg8::Unit& u, int wr, int wc, int fr, int fq) const {
        const int row0 = u.pm * 256 + wr * 64 + fr, col0 = u.pn * 256 + wc * 32 + 4 * fq;
        const __amdgpu_buffer_rsrc_t wr_ = wt_rsrc(C, (unsigned)((size_t)TT * 2048 * 4));
#pragma unroll
        for (int ai = 0; ai < 2; ++ai)
#pragma unroll
            for (int m = 0; m < 4; ++m) {
                float* rowp = C + (size_t)(row0 + ai * 128 + m * 16) * ldc + col0;
#pragma unroll
                for (int bj = 0; bj < 2; ++bj)
#pragma unroll
                    for (int n = 0; n < 2; ++n) wt_store16(wr_, ((unsigned)(row0 + ai * 128 + m * 16) * (unsigned)ldc + (unsigned)(col0 + bj * 128 + n * 16)) * 4u, __builtin_bit_cast(u32x4, acc[ai][bj][m][n]));
            }
    }
};

template <class Epi>
__device__ __forceinline__ void run_gemm(LAS unsigned char* lds, const bf16_t* A, const bf16_t* Bt, int M, int N, int K, const Epi& E) {
    pg8::Gemm g{A, Bt, M, N, K};
    pg8::StaticOrder S; S.init(M, N, (int)gridDim.x, (int)blockIdx.x);
    pg8::gemm_phase<Epi, pg8::StaticOrder>(lds, g, S, E);
}

__device__ __forceinline__ void phase_mod(const Params& p, LAS unsigned char* lds) {
    const int tid_ = otid();
    LAS float* cs = (LAS float*)lds;
    LAS float* red = (LAS float*)(lds + 2048 * 17 * 4);
    const int tid = tid_;
    float* modv = (float*)(p.ws + OFF_MODV);
    if ((int)blockIdx.x >= 96) return;
    for (int i = tid; i < 17 * 2048; i += NTHREADS) { const int r = i >> 11, k = i & 2047; const float c = r < 16 ? p.c[r * 2048 + k] : p.c_ctx[k]; cs[k * 17 + r] = c / (1.0f + __expf(-c)); }
    __syncthreads();
    for (int u = blockIdx.x; u < 96; u += gridDim.x) {
        const int l = u / 48, col = (u % 48) * 256 + (tid & 255), half = tid >> 8;
        const float* w = p.w_mod + (size_t)l * 2048 * NMOD + col;
        float acc[17];
#pragma unroll
        for (int r = 0; r < 17; ++r) acc[r] = 0.f;
        const int k0 = half * 1024;
#pragma unroll 4
        for (int k = k0; k < k0 + 1024; ++k) {
            const float wv = w[(size_t)k * NMOD];
#pragma unroll
            for (int r = 0; r < 17; ++r) acc[r] += cs[k * 17 + r] * wv;
        }
        if (half == 1) {
#pragma unroll
            for (int r = 0; r < 17; ++r) red[(tid & 255) * 17 + r] = acc[r];
        }
        __syncthreads();
        if (half == 0) { const float b = p.b_mod[l * NMOD + col];
#pragma unroll
            for (int r = 0; r < 17; ++r) modv[(size_t)(l * 17 + r) * NMOD + col] = acc[r] + red[(tid & 255) * 17 + r] + b; }
        __syncthreads();
    }
}
__device__ __forceinline__ void phase_prep(const Params& p) {
    const int tid_ = otid();
    const int gt = blockIdx.x * NTHREADS + tid_, nt = gridDim.x * NTHREADS;
    float* lb = (float*)(p.ws + OFF_LB);
    for (int i = gt; i < 2 * 1024; i += nt) { const float x0 = p.lb_logits[i], x1 = p.lb_logits[2048 + i]; lb[i] = 0.f; lb[2048 + i] = 1.0f / (1.0f + expf(x0 - x1)); }
    float* s5lam = (float*)(p.ws + OFF_S5LAM); float* s5bb = (float*)(p.ws + OFF_S5BB);
    for (int i = gt; i < 2 * 2 * 48 * 64; i += nt) {
        const int ldg = i >> 6;
        const double lre = (double)p.lam_re[i], lim = (double)p.lam_im[i], dt = exp((double)p.log_step[ldg]);
        const double er = exp(lre * dt); double sn, cs; sincos(lim * dt, &sn, &cs);
        const double br = er * cs, bi = er * sn;
        s5lam[i * 2] = (float)br; s5lam[i * 2 + 1] = (float)bi;
        const double nr = br - 1.0, ni = bi, den = lre * lre + lim * lim;
        const double cr = (nr * lre + ni * lim) / den, ci = (ni * lre - nr * lim) / den;
        for (int d = 0; d < 16; ++d) { const double xr = (double)p.b_re[(size_t)i * 16 + d], xi = (double)p.b_im[(size_t)i * 16 + d];
            s5bb[(size_t)i * 32 + d] = (float)(cr * xr - ci * xi); s5bb[(size_t)i * 32 + 16 + d] = (float)(cr * xi + ci * xr); }
    }
    float* pe = (float*)(p.ws + OFF_PE);
    for (int i = gt; i < 96 * 1024; i += nt) {
        const int r = i >> 10, cc = i & 1023, j = cc & 511;
        const float pos = (float)(r < 32 ? r : r - 32);
        const float omega = 1.0f / powf(10000.0f, (float)j * (1.0f / 512.0f));
        const float ang = pos * omega;
        pe[i] = cc < 512 ? sinf(ang) : cosf(ang);
    }
}

template <int MAPMODE>
__device__ __forceinline__ void transpose_convert(const float* src, int K, int N, bf16_t* dst, LAS unsigned char* lds) {
    const int tid_ = otid();
    LAS float* tile = (LAS float*)lds;
    const int tid = tid_, nkb = K / 64, nnb = N / 64;
    for (int u = blockIdx.x; u < nkb * nnb; u += gridDim.x) {
        const int kb = u / nnb, nb = u % nnb, k0 = kb * 64, n0 = nb * 64;
        { const int nn = tid & 63, kk = tid >> 6;
#pragma unroll
          for (int i = 0; i < 8; ++i) tile[(kk + i * 8) * 65 + nn] = src[(size_t)(k0 + kk + i * 8) * N + n0 + nn]; }
        __syncthreads();
        { const int kk2 = (tid & 7) * 8, nn2 = tid >> 3; float v[8];
#pragma unroll
          for (int i = 0; i < 8; ++i) v[i] = tile[(kk2 + i) * 65 + nn2];
          int n = n0 + nn2, nr;
          if (MAPMODE == 1) { if (n < 768) nr = (n >> 7) * 256 + (n & 127); else { const int m = n - 768; nr = (m >> 7) * 256 + 128 + (m & 127); } } else nr = n;
          u32x4 w; w.x = cvt_pk_bf16(v[0], v[1]); w.y = cvt_pk_bf16(v[2], v[3]); w.z = cvt_pk_bf16(v[4], v[5]); w.w = cvt_pk_bf16(v[6], v[7]);
          *(u32x4*)(dst + (size_t)nr * K + k0 + kk2) = w; }
        __syncthreads();
    }
}
__device__ __forceinline__ void phase_wscore(const float* wq, const float* sk, bf16_t* dst, LAS unsigned char* lds) {
    const int tid_ = otid();
    LAS float* skt = (LAS float*)lds;
    LAS float* wqt = (LAS float*)(lds + 128 * 129 * 4);
    const int tid = tid_;
    for (int u = blockIdx.x; u < 16 * 32; u += gridDim.x) {
        const int hp = u >> 5, kb = u & 31;
        for (int i = tid; i < 128 * 128; i += NTHREADS) { const int key = i >> 7, e = i & 127; skt[key * 129 + e] = sk[(size_t)hp * 16384 + i]; }
        for (int i = tid; i < 64 * 128; i += NTHREADS) { const int k = i >> 7, e = i & 127; wqt[e * 68 + k] = wq[(size_t)(kb * 64 + k) * 2048 + hp * 128 + e]; }
        __syncthreads();
        const int key = tid & 127, kg = tid >> 7;
        float acc[16];
#pragma unroll
        for (int i = 0; i < 16; ++i) acc[i] = 0.f;
        for (int e = 0; e < 128; ++e) {
            const float s = skt[key * 129 + e];
#pragma unroll
            for (int q = 0; q < 4; ++q) { const f32x4 w4 = *(const LAS f32x4*)(wqt + e * 68 + kg * 16 + q * 4);
                acc[q * 4 + 0] += s * w4[0]; acc[q * 4 + 1] += s * w4[1]; acc[q * 4 + 2] += s * w4[2]; acc[q * 4 + 3] += s * w4[3]; }
        }
        bf16_t* o = dst + (size_t)(hp * 128 + key) * 2048 + kb * 64 + kg * 16;
        u32x4 w0, w1;
        w0.x = cvt_pk_bf16(acc[0], acc[1]); w0.y = cvt_pk_bf16(acc[2], acc[3]); w0.z = cvt_pk_bf16(acc[4], acc[5]); w0.w = cvt_pk_bf16(acc[6], acc[7]);
        w1.x = cvt_pk_bf16(acc[8], acc[9]); w1.y = cvt_pk_bf16(acc[10], acc[11]); w1.z = cvt_pk_bf16(acc[12], acc[13]); w1.w = cvt_pk_bf16(acc[14], acc[15]);
        *(u32x4*)o = w0; *(u32x4*)(o + 8) = w1;
        __syncthreads();
    }
}
__device__ __forceinline__ void phase_colmax(const Params& p) {
    const int tid_ = otid();
    unsigned* cm = (unsigned*)(p.ws + OFF_CMAX);
    const int total = 2 * INC * 16;
    for (int i = blockIdx.x * NTHREADS + tid_; i < total; i += gridDim.x * NTHREADS) {
        const int kc = i / (2 * INC), cidx = i % (2 * INC), l = cidx / INC, n = cidx % INC;
        const float* w = p.w_in + (size_t)l * D * INC + (size_t)(kc * 128) * INC + n;
        float am = 0.f;
#pragma unroll 8
        for (int k = 0; k < 128; ++k) am = fmaxf(am, fabsf(w[(size_t)k * INC]));
        atomicMax(cm + cidx, __float_as_uint(am));
    }
}
__device__ __forceinline__ void transpose_convert_fp8(const float* src, int K, int N, unsigned char* dst, const unsigned* cmax, LAS unsigned char* lds) {
    const int tid_ = otid();
    LAS float* tile = (LAS float*)lds;
    const int tid = tid_, nkb = K / 64, nnb = N / 64;
    for (int u = blockIdx.x; u < nkb * nnb; u += gridDim.x) {
        const int kb = u / nnb, nb = u % nnb, k0 = kb * 64, n0 = nb * 64;
        { const int nn = tid & 63, kk = tid >> 6;
#pragma unroll
          for (int i = 0; i < 8; ++i) tile[(kk + i * 8) * 65 + nn] = src[(size_t)(k0 + kk + i * 8) * N + n0 + nn]; }
        __syncthreads();
        { const int kk2 = (tid & 7) * 8, nn2 = tid >> 3; float v[8];
          const float cmv = __uint_as_float(cmax[n0 + nn2]); const float sc = cmv > 0.f ? 240.0f / cmv : 1.0f;
#pragma unroll
          for (int i = 0; i < 8; ++i) v[i] = tile[(kk2 + i) * 65 + nn2] * sc;
          u32x2 w; w.x = pack_fp8x4(v[0], v[1], v[2], v[3]); w.y = pack_fp8x4(v[4], v[5], v[6], v[7]);
          *(u32x2*)(dst + (size_t)(n0 + nn2) * K + k0 + kk2) = w; }
        __syncthreads();
    }
}
__device__ __forceinline__ void phase_wconv(const Params& p, int l, LAS unsigned char* lds) {
    unsigned char* W = p.ws + OFF_W;
    transpose_convert_fp8(p.w_in + (size_t)l * D * INC, D, INC, W + W_IN, (const unsigned*)(p.ws + OFF_CMAX) + (size_t)l * INC, lds);
    transpose_convert<1>(p.w_glu + (size_t)l * 768 * 1536, 768, 1536, (bf16_t*)(W + W_GLU), lds);
    transpose_convert<0>(p.wa + (size_t)l * 1024 * D, 1024, D, (bf16_t*)(W + W_A), lds);
    transpose_convert<0>(p.wb + (size_t)l * 1024 * D, 1024, D, (bf16_t*)(W + W_B), lds);
    transpose_convert<0>(p.wc + (size_t)l * 768 * D, 768, D, (bf16_t*)(W + W_C), lds);
    transpose_convert<0>(p.wo + (size_t)l * D * D, D, D, (bf16_t*)(W + W_O), lds);
    phase_wscore(p.w_q + (size_t)l * D * D, p.sub_keys + (size_t)l * 16 * 16384, (bf16_t*)(W + W_S), lds);
}
__device__ __forceinline__ void phase_tabconv(const Params& p, int l) {
    const int tid_ = otid();
    const int lane = tid_ & 63, gw = blockIdx.x * 8 + __builtin_amdgcn_readfirstlane(tid_ >> 6), nw = gridDim.x * 8;
    unsigned char* U6 = p.ws + OFF_P + Q_UT; unsigned char* V6 = p.ws + OFF_P + Q_VT;
    float* USC = (float*)(p.ws + OFF_P + Q_USC); float* VSC = (float*)(p.ws + OFF_P + Q_VSC);
    for (int r = gw; r < 32768; r += nw) {
        const bool isv = r >= 16384; const int rr = r & 16383;
        const float* src = (isv ? p.peer_v : p.peer_u) + (size_t)l * 16384 * 2048 + (size_t)rr * 2048;
        f32x4 v[8];
#pragma unroll
        for (int j = 0; j < 8; ++j) v[j] = *(const f32x4*)(src + j * 256 + lane * 4);
        float am = 0.f;
#pragma unroll
        for (int j = 0; j < 8; ++j) am = fmaxf(am, fmaxf(fmaxf(fabsf(v[j][0]), fabsf(v[j][1])), fmaxf(fabsf(v[j][2]), fabsf(v[j][3]))));
#pragma unroll
        for (int o = 32; o >= 1; o >>= 1) am = fmaxf(am, __shfl_xor(am, o));
        const float sc = am > 0.f ? 7.0f / am : 1.0f, inv = am > 0.f ? am * (1.0f / 7.0f) : 1.0f;
        bf16x32_t bv;
#pragma unroll
        for (int j = 0; j < 8; ++j)
#pragma unroll
            for (int c = 0; c < 4; ++c) bv[j * 4 + c] = (__bf16)(v[j][c] * sc);
        const u32x6 pk = __builtin_amdgcn_cvt_scalef32_pk32_fp6_bf16(bv, 1.0f);
        unsigned char* dst = (isv ? V6 : U6) + (size_t)rr * 1536 + lane * 24;
        u32x4 w0; w0.x = pk[0]; w0.y = pk[1]; w0.z = pk[2]; w0.w = pk[3]; u32x2 w1; w1.x = pk[4]; w1.y = pk[5];
        *(u32x4*)dst = w0; *(u32x2*)(dst + 16) = w1;
        if (lane == 0) (isv ? VSC : USC)[rr] = inv;
    }
}

template <int MODE, bool F8OUT = false>
__device__ __forceinline__ void phase_norm(const Params& p, int l, int M, int off_sh, int off_sc) {
    const int tid_ = otid();
    const int lane = tid_ & 63, gw = blockIdx.x * 8 + __builtin_amdgcn_readfirstlane(tid_ >> 6), nw = gridDim.x * 8;
    const float* modv = (const float*)(p.ws + OFF_MODV) + (size_t)l * 17 * NMOD;
    const float* pe = (const float*)(p.ws + OFF_PE);
    float* XC = (float*)(p.ws + OFF_XC);
    bf16_t* H = (bf16_t*)(p.ws + OFF_H);
    for (int r = gw; r < M; r += nw) {
        const bool lat = r < TL;
        const float* src = MODE == 0 ? (lat ? p.x + (size_t)r * D : p.ctx + (size_t)(r - TL) * D) : (lat ? p.out + (size_t)r * D : XC + (size_t)(r - TL) * D);
        f32x4 v[4][2];
#pragma unroll
        for (int j = 0; j < 4; ++j) { v[j][0] = *(const f32x4*)(src + j * 512 + lane * 8); v[j][1] = *(const f32x4*)(src + j * 512 + lane * 8 + 4); }
        if (MODE == 0) {
            if (lat) { const int n = r & 2047, gr = n >> 6, gc = n & 63;
#pragma unroll
                for (int j = 0; j < 4; ++j) { const float* pr = (j < 2) ? pe + (size_t)gr * 1024 + j * 512 + lane * 8 : pe + (size_t)(32 + gc) * 1024 + (j - 2) * 512 + lane * 8;
                    v[j][0] += *(const f32x4*)pr; v[j][1] += *(const f32x4*)(pr + 4); } }
            float* dst = lat ? p.out + (size_t)r * D : XC + (size_t)(r - TL) * D;
#pragma unroll
            for (int j = 0; j < 4; ++j) { *(f32x4*)(dst + j * 512 + lane * 8) = v[j][0]; *(f32x4*)(dst + j * 512 + lane * 8 + 4) = v[j][1]; }
        }
        float ss = 0.f;
#pragma unroll
        for (int j = 0; j < 4; ++j)
#pragma unroll
            for (int h = 0; h < 2; ++h) ss += v[j][h][0] * v[j][h][0] + v[j][h][1] * v[j][h][1] + v[j][h][2] * v[j][h][2] + v[j][h][3] * v[j][h][3];
        ss = wave_sum(ss);
        const float rs = rsqrtf(ss * (1.0f / 2048.0f) + 1e-6f);
        const int mb = lat ? (r >> 11) : 16;
        const float* sh = modv + (size_t)mb * NMOD + off_sh; const float* sc = modv + (size_t)mb * NMOD + off_sc;
        if (F8OUT) {
            float am = 0.f;
#pragma unroll
            for (int j = 0; j < 4; ++j) { const int e = j * 512 + lane * 8;
                const f32x4 s0 = *(const f32x4*)(sc + e), s1 = *(const f32x4*)(sc + e + 4), h0 = *(const f32x4*)(sh + e), h1 = *(const f32x4*)(sh + e + 4);
                v[j][0] = v[j][0] * rs * (s0 + 1.0f) + h0; v[j][1] = v[j][1] * rs * (s1 + 1.0f) + h1;
#pragma unroll
                for (int hh = 0; hh < 2; ++hh) am = fmaxf(am, fmaxf(fmaxf(fabsf(v[j][hh][0]), fabsf(v[j][hh][1])), fmaxf(fabsf(v[j][hh][2]), fabsf(v[j][hh][3])))); }
#pragma unroll
            for (int o = 32; o >= 1; o >>= 1) am = fmaxf(am, __shfl_xor(am, o));
            const float q = am > 0.f ? 240.0f / am : 1.0f;
            unsigned char* H8 = p.ws + OFF_H8 + (size_t)r * D;
#pragma unroll
            for (int j = 0; j < 4; ++j) { u32x2 w; w.x = pack_fp8x4(v[j][0][0] * q, v[j][0][1] * q, v[j][0][2] * q, v[j][0][3] * q); w.y = pack_fp8x4(v[j][1][0] * q, v[j][1][1] * q, v[j][1][2] * q, v[j][1][3] * q);
                *(u32x2*)(H8 + j * 512 + lane * 8) = w; }
            if (lane == 0) ((float*)(p.ws + OFF_HS))[r] = am > 0.f ? am * (1.0f / 240.0f) : 1.0f;
        } else {
#pragma unroll
        for (int j = 0; j < 4; ++j) {
            const int e = j * 512 + lane * 8;
            const f32x4 s0 = *(const f32x4*)(sc + e), s1 = *(const f32x4*)(sc + e + 4), h0 = *(const f32x4*)(sh + e), h1 = *(const f32x4*)(sh + e + 4);
            f32x4 a = v[j][0] * rs * (s0 + 1.0f) + h0, b = v[j][1] * rs * (s1 + 1.0f) + h1;
            u32x4 w; w.x = cvt_pk_bf16(a[0], a[1]); w.y = cvt_pk_bf16(a[2], a[3]); w.z = cvt_pk_bf16(b[0], b[1]); w.w = cvt_pk_bf16(b[2], b[3]);
            *(u32x4*)(H + (size_t)r * D + e) = w;
        }
        }
    }
}
__device__ __forceinline__ bf16x8 mk_bf16x8(unsigned a, unsigned b, unsigned c, unsigned d) { u32x4 q; q.x = a; q.y = b; q.z = c; q.w = d; return __builtin_bit_cast(bf16x8, q); }
__device__ __forceinline__ void phase_hgrn(const Params& p, int l, LAS unsigned char* lds, bool dry = false) {
    const int tid_ = otid();
    const int lane = tid_ & 63, w = __builtin_amdgcn_readfirstlane(tid_ >> 6), q = lane >> 4, m = lane & 15;
    constexpr int OQ = 0, OKH = 4352, OKT = 8704, OIT = 14848, OE = 20992, BUFSZ = 21504;
    unsigned char* P = p.ws + OFF_P;
    const float* lbp = (const float*)(p.ws + OFF_LB) + (size_t)l * 2048;
    const int kch = 16 * w + m;
    for (int u = blockIdx.x; u < 256; u += gridDim.x) {
        const int b = u >> 4, h = (u >> 1) & 7, dir = u & 1;
        const bf16_t* BQ = (const bf16_t*)(P + P_BQ); const bf16_t* BI = (const bf16_t*)(P + P_BI);
        bf16_t* BF = (bf16_t*)(P + (dir ? P_BFB : P_BFF));
        const float lbv = lbp[dir * 1024 + h * 128 + kch];
        f32x4 Sacc[8];
#pragma unroll
        for (int i = 0; i < 8; ++i) Sacc[i] = (f32x4){0.f, 0.f, 0.f, 0.f};
        for (int seg = 0; seg < 2; ++seg) {
            const int len = seg == 0 ? CTXL : SEQ, rbase = seg == 0 ? TL + b * CTXL : b * SEQ, nch = len / 16;
            unsigned short rqA[4], rfA[4], riA[4], rqB[4], rfB[4], riB[4];
#define HG_LOAD(rq, rf, ri, c) do { _Pragma("unroll") for (int j = 0; j < 4; ++j) { const int st = (c) * 16 + 4 * q + j, n = dir ? (len - 1 - st) : st; const size_t o = (size_t)(rbase + n) * 1024 + h * 128 + kch; \
                rq[j] = BQ[o]; rf[j] = BF[o]; ri[j] = BI[o]; } } while (0)
#define HG_STAGE(rq, rf, ri, bufp) do { float fv[4], cb[4]; float run = 0.f; \
                _Pragma("unroll") for (int j = 0; j < 4; ++j) { const float xf = __uint_as_float(((unsigned)rf[j]) << 16); fv[j] = lbv + (1.0f - lbv) * fast_sigmoid(xf); run += flog(fv[j]); cb[j] = run; } \
                const float t0 = __shfl(run, m), t1 = __shfl(run, m + 16), t2 = __shfl(run, m + 32); \
                const float off = (q > 0 ? t0 : 0.f) + (q > 1 ? t1 : 0.f) + (q > 2 ? t2 : 0.f); \
                float qh[4], kh[4]; \
                _Pragma("unroll") for (int j = 0; j < 4; ++j) { const float bb = off + cb[j], bc = fmaxf(bb, -80.0f); qh[j] = __uint_as_float(((unsigned)rq[j]) << 16) * fexp(bc); kh[j] = (1.0f - fv[j]) * fexp(-bc);     \
                    if (j == 3 && q == 3) *(LAS float*)((bufp) + OE + kch * 4) = fexp(bb); } \
                const unsigned q01 = cvt_pk_bf16(qh[0], qh[1]), q23 = cvt_pk_bf16(qh[2], qh[3]), k01 = cvt_pk_bf16(kh[0], kh[1]), k23 = cvt_pk_bf16(kh[2], kh[3]); \
                *(LAS bf16_t*)((bufp) + OQ + (4 * q + 0) * 272 + kch * 2) = (bf16_t)(q01 & 0xffffu); *(LAS bf16_t*)((bufp) + OQ + (4 * q + 1) * 272 + kch * 2) = (bf16_t)(q01 >> 16); \
                *(LAS bf16_t*)((bufp) + OQ + (4 * q + 2) * 272 + kch * 2) = (bf16_t)(q23 & 0xffffu); *(LAS bf16_t*)((bufp) + OQ + (4 * q + 3) * 272 + kch * 2) = (bf16_t)(q23 >> 16); \
                *(LAS bf16_t*)((bufp) + OKH + (4 * q + 0) * 272 + kch * 2) = (bf16_t)(k01 & 0xffffu); *(LAS bf16_t*)((bufp) + OKH + (4 * q + 1) * 272 + kch * 2) = (bf16_t)(k01 >> 16); \
                *(LAS bf16_t*)((bufp) + OKH + (4 * q + 2) * 272 + kch * 2) = (bf16_t)(k23 & 0xffffu); *(LAS bf16_t*)((bufp) + OKH + (4 * q + 3) * 272 + kch * 2) = (bf16_t)(k23 >> 16); \
                u32x2 kt2; kt2.x = k01; kt2.y = k23; *(LAS u32x2*)((bufp) + OKT + kch * 48 + q * 8) = kt2; \
                u32x2 it2; it2.x = (unsigned)ri[0] | ((unsigned)ri[1] << 16); it2.y = (unsigned)ri[2] | ((unsigned)ri[3] << 16); *(LAS u32x2*)((bufp) + OIT + kch * 48 + q * 8) = it2; } while (0)
#define HG_COMPUTE(c) do { \
                LAS unsigned char* buf = lds + ((c) & 1) * BUFSZ; \
                f32x4 at = (f32x4){0.f, 0.f, 0.f, 0.f}; \
                _Pragma("unroll") \
                for (int kb = 0; kb < 4; ++kb) { const bf16x8 a = *(const LAS bf16x8*)(buf + OKH + m * 272 + kb * 64 + q * 16), bq = *(const LAS bf16x8*)(buf + OQ + m * 272 + kb * 64 + q * 16); \
                    at = __builtin_amdgcn_mfma_f32_16x16x32_bf16(a, bq, at, 0, 0, 0); } \
                asm volatile("s_nop 15\n s_nop 15" : "+v"(at)); \
                _Pragma("unroll") \
                for (int r = 0; r < 4; ++r) at[r] = (4 * q + r <= m) ? at[r] : 0.f; \
                const bf16x8 attB = mk_bf16x8(cvt_pk_bf16(at[0], at[1]), cvt_pk_bf16(at[2], at[3]), 0u, 0u); \
                f32x4 oacc = (f32x4){0.f, 0.f, 0.f, 0.f}; \
                _Pragma("unroll") \
                for (int kb = 0; kb < 4; ++kb) { \
                    const bf16x8 a = mk_bf16x8(cvt_pk_bf16(Sacc[2 * kb][0], Sacc[2 * kb][1]), cvt_pk_bf16(Sacc[2 * kb][2], Sacc[2 * kb][3]), cvt_pk_bf16(Sacc[2 * kb + 1][0], Sacc[2 * kb + 1][1]), cvt_pk_bf16(Sacc[2 * kb + 1][2], Sacc[2 * kb + 1][3])); \
                    const u32x2 b0 = *(const LAS u32x2*)(buf + OQ + m * 272 + (32 * kb + 4 * q) * 2), b1 = *(const LAS u32x2*)(buf + OQ + m * 272 + (32 * kb + 16 + 4 * q) * 2); \
                    oacc = __builtin_amdgcn_mfma_f32_16x16x32_bf16(a, mk_bf16x8(b0.x, b0.y, b1.x, b1.y), oacc, 0, 0, 0); } \
                { const u32x2 i0 = *(const LAS u32x2*)(buf + OIT + (16 * w + m) * 48 + q * 8); \
                  oacc = __builtin_amdgcn_mfma_f32_16x16x32_bf16(mk_bf16x8(i0.x, i0.y, 0u, 0u), attB, oacc, 0, 0, 0); } \
                asm volatile("s_nop 15\n s_nop 15" : "+v"(oacc)); \
                { const int st = (c) * 16 + m, n = dir ? (len - 1 - st) : st; \
                  u32x2 o2; o2.x = cvt_pk_bf16(oacc[0], oacc[1]); o2.y = cvt_pk_bf16(oacc[2], oacc[3]); \
                  if (!dry || p.ws == nullptr) *(u32x2*)(BF + (size_t)(rbase + n) * 1024 + h * 128 + 16 * w + 4 * q) = o2; } \
                u32x4 bsu = (u32x4){0u, 0u, 0u, 0u}; \
                if (q < 2) bsu = *(const LAS u32x4*)(buf + OIT + (16 * w + m) * 48 + q * 16); \
                const bf16x8 bs = __builtin_bit_cast(bf16x8, bsu); \
                _Pragma("unroll") \
                for (int kt = 0; kt < 8; ++kt) { u32x4 au = (u32x4){0u, 0u, 0u, 0u}; \
                    if (q < 2) au = *(const LAS u32x4*)(buf + OKT + (16 * kt + m) * 48 + q * 16); \
                    Sacc[kt] = __builtin_amdgcn_mfma_f32_16x16x32_bf16(__builtin_bit_cast(bf16x8, au), bs, Sacc[kt], 0, 0, 0); } \
                asm volatile("s_nop 15\n s_nop 15" : "+v"(Sacc[0]), "+v"(Sacc[1]), "+v"(Sacc[2]), "+v"(Sacc[3]), "+v"(Sacc[4]), "+v"(Sacc[5]), "+v"(Sacc[6]), "+v"(Sacc[7])); \
                _Pragma("unroll") \
                for (int kt = 0; kt < 8; ++kt) Sacc[kt] *= *(const LAS f32x4*)(buf + OE + (16 * kt + 4 * q) * 4); \
                } while (0)
            HG_LOAD(rqA, rfA, riA, 0);
            HG_STAGE(rqA, rfA, riA, lds);
            HG_LOAD(rqA, rfA, riA, 1);
            HG_LOAD(rqB, rfB, riB, 2);
            __syncthreads();
            for (int c = 0; c < nch; c += 2) {
                { HG_STAGE(rqA, rfA, riA, lds + BUFSZ); if (c + 3 < nch) HG_LOAD(rqA, rfA, riA, c + 3); }
                HG_COMPUTE(c);
                __syncthreads();
                if (c + 2 < nch) { HG_STAGE(rqB, rfB, riB, lds); if (c + 4 < nch) HG_LOAD(rqB, rfB, riB, c + 4); }
                HG_COMPUTE(c + 1);
                __syncthreads();
            }
#undef HG_COMPUTE
#undef HG_LOAD
#undef HG_STAGE
        }
        __syncthreads();
    }
}
__device__ __forceinline__ void phase_hcomb(const Params& p, int l, int M, bool dry = false) {
    const int tid_ = otid();
    const int lane = tid_ & 63, gw = blockIdx.x * 8 + __builtin_amdgcn_readfirstlane(tid_ >> 6), nw = gridDim.x * 8;
    unsigned char* P = p.ws + OFF_P;
    bf16_t* OF = (bf16_t*)(P + P_BFF); const bf16_t* OB = (const bf16_t*)(P + P_BFB); const bf16_t* BG = (const bf16_t*)(P + P_BG);
    const float* hg = p.hn_g + (size_t)l * 1024 + lane * 16;
    for (int r = gw; r < M; r += nw) {
        const size_t o = (size_t)r * 1024 + lane * 16;
        float x[16]; float ss = 0.f;
#pragma unroll
        for (int hh = 0; hh < 2; ++hh) { const u32x4 a = *(const u32x4*)(OF + o + hh * 8), bq = *(const u32x4*)(OB + o + hh * 8);
            const unsigned aa[4] = {a.x, a.y, a.z, a.w}, bb[4] = {bq.x, bq.y, bq.z, bq.w};
#pragma unroll
            for (int j = 0; j < 4; ++j) { x[hh * 8 + 2 * j] = bf_lo(aa[j]) + bf_lo(bb[j]); x[hh * 8 + 2 * j + 1] = bf_hi(aa[j]) + bf_hi(bb[j]); } }
#pragma unroll
        for (int j = 0; j < 16; ++j) ss += x[j] * x[j];
        ss += __shfl_xor(ss, 1); ss += __shfl_xor(ss, 2); ss += __shfl_xor(ss, 4);
        const float rs = rsqrtf(ss * (1.0f / 128.0f) + 1e-6f);
#pragma unroll
        for (int hh = 0; hh < 2; ++hh) { const u32x4 gq = *(const u32x4*)(BG + o + hh * 8); const unsigned gg[4] = {gq.x, gq.y, gq.z, gq.w};
            float y[8];
#pragma unroll
            for (int j = 0; j < 4; ++j) { y[2 * j] = x[hh * 8 + 2 * j] * rs * hg[hh * 8 + 2 * j] * bf_lo(gg[j]); y[2 * j + 1] = x[hh * 8 + 2 * j + 1] * rs * hg[hh * 8 + 2 * j + 1] * bf_hi(gg[j]); }
            u32x4 w; w.x = cvt_pk_bf16(y[0], y[1]); w.y = cvt_pk_bf16(y[2], y[3]); w.z = cvt_pk_bf16(y[4], y[5]); w.w = cvt_pk_bf16(y[6], y[7]);
            if (!dry || p.ws == nullptr) *(u32x4*)(OF + o + hh * 8) = w; }
    }
}

__device__ __forceinline__ bf16x8 pack_bf16x8(const float (&v)[8]) {
    const unsigned a = cvt_pk_bf16(v[0], v[1]), b = cvt_pk_bf16(v[2], v[3]), c = cvt_pk_bf16(v[4], v[5]), d = cvt_pk_bf16(v[6], v[7]);
    u32x4 q; q.x = a; q.y = b; q.z = c; q.w = d;
    return __builtin_bit_cast(bf16x8, q);
}
__device__ __forceinline__ void phase_s5(const Params& p, int l, LAS unsigned char* lds) {
    const int tid_ = otid();
    const int lane = tid_ & 63, w = __builtin_amdgcn_readfirstlane(tid_ >> 6);
    if (w >= 6) return;
    LAS float* BU = (LAS float*)(lds + w * 12800);
    LAS unsigned char* XB = lds + w * 12800 + 8448;
    const int lq = lane >> 4, lr = lane & 15;
    const bf16_t* CU = (const bf16_t*)(p.ws + OFF_P + P_CU);
    const float* s5lam = (const float*)(p.ws + OFF_S5LAM); const float* s5bb = (const float*)(p.ws + OFF_S5BB);
    for (int s = w * (int)gridDim.x + (int)blockIdx.x; s < 1536; s += 6 * (int)gridDim.x) {
        const int dir = s & 1, g = (s >> 1) % 48, b = s / 96;
        const int ldg = (l * 2 + dir) * 48 + g;
        const float lre = s5lam[(size_t)(ldg * 64 + lane) * 2], lim = s5lam[(size_t)(ldg * 64 + lane) * 2 + 1];
        bf16x8 bbf[8], cf[4];
#pragma unroll
        for (int nt = 0; nt < 8; ++nt) { const int col = nt * 16 + lr, pp = col >> 1, c = col & 1; float v[8];
#pragma unroll
            for (int j = 0; j < 8; ++j) v[j] = (lq < 2) ? s5bb[(size_t)(ldg * 64 + pp) * 32 + c * 16 + lq * 8 + j] : 0.f;
            bbf[nt] = pack_bf16x8(v); }
#pragma unroll
        for (int kb = 0; kb < 4; ++kb) { float v[8];
#pragma unroll
            for (int j = 0; j < 8; ++j) { const int k = kb * 32 + lq * 8 + j, pp = k >> 1; const size_t ci = ((size_t)ldg * 16 + lr) * 64 + pp;
                v[j] = (k & 1) ? -p.c_im[ci] : p.c_re[ci]; }
            cf[kb] = pack_bf16x8(v); }
        bf16_t* YS = (bf16_t*)(p.ws + OFF_H + (dir ? H_YSB : H_YSF));
        float xr = 0.f, xi = 0.f;
        for (int seg = 0; seg < 2; ++seg) {
            const int len = seg == 0 ? CTXL : SEQ, rbase = seg == 0 ? TL + b * CTXL : b * SEQ, nblk = len / 64;
            u32x4 unext[4];
#pragma unroll
            for (int tt = 0; tt < 4; ++tt) { unext[tt] = (u32x4){0u, 0u, 0u, 0u};
                if (lq < 2) { const int st = tt * 16 + lr, n = dir ? (len - 1 - st) : st; unext[tt] = *(const u32x4*)(CU + (size_t)(rbase + n) * 768 + g * 16 + lq * 8); } }
            for (int blk = 0; blk < nblk; ++blk) {
                u32x4 ucur[4];
#pragma unroll
                for (int tt = 0; tt < 4; ++tt) ucur[tt] = unext[tt];
                if (blk + 1 < nblk && lq < 2) {
#pragma unroll
                    for (int tt = 0; tt < 4; ++tt) { const int st = (blk + 1) * 64 + tt * 16 + lr, n = dir ? (len - 1 - st) : st; unext[tt] = *(const u32x4*)(CU + (size_t)(rbase + n) * 768 + g * 16 + lq * 8); } }
#pragma unroll
                for (int tt = 0; tt < 4; ++tt) {
                    const bf16x8 uf = __builtin_bit_cast(bf16x8, ucur[tt]);
                    f32x4 dd[8];
#pragma unroll
                    for (int nt = 0; nt < 8; ++nt) dd[nt] = __builtin_amdgcn_mfma_f32_16x16x32_bf16(bbf[nt], uf, (f32x4){0.f, 0.f, 0.f, 0.f}, 0, 0, 0);
                    asm volatile("s_nop 15\n s_nop 15" : "+v"(dd[0]), "+v"(dd[1]), "+v"(dd[2]), "+v"(dd[3]), "+v"(dd[4]), "+v"(dd[5]), "+v"(dd[6]), "+v"(dd[7]));
#pragma unroll
                    for (int nt = 0; nt < 8; ++nt) *(LAS f32x4*)(BU + lr * 132 + nt * 16 + lq * 4) = dd[nt];
                    asm volatile("s_waitcnt lgkmcnt(0)" ::: "memory");
                    f32x2 bu[16];
#pragma unroll
                    for (int t = 0; t < 16; ++t) bu[t] = *(const LAS f32x2*)(BU + t * 132 + 2 * lane);
#pragma unroll
                    for (int t = 0; t < 16; ++t) { const float nr = lre * xr - lim * xi + bu[t].x, ni = lre * xi + lim * xr + bu[t].y; xr = nr; xi = ni;
                        *(LAS unsigned*)(XB + t * 272 + lane * 4) = cvt_pk_bf16(xr, xi); }
                    asm volatile("s_waitcnt lgkmcnt(0)" ::: "memory");
                    f32x4 acc = (f32x4){0.f, 0.f, 0.f, 0.f};
#pragma unroll
                    for (int kb = 0; kb < 4; ++kb) { const bf16x8 xf = *(const LAS bf16x8*)(XB + lr * 272 + kb * 64 + lq * 16); acc = __builtin_amdgcn_mfma_f32_16x16x32_bf16(cf[kb], xf, acc, 0, 0, 0); }
                    asm volatile("s_nop 15\n s_nop 15\n s_waitcnt lgkmcnt(0)" : "+v"(acc) :: "memory");
                    const int st = blk * 64 + tt * 16 + lr, n = dir ? (len - 1 - st) : st;
                    u32x2 o; o.x = cvt_pk_bf16(acc[0], acc[1]); o.y = cvt_pk_bf16(acc[2], acc[3]);
                    *(u32x2*)(YS + (size_t)(rbase + n) * 768 + g * 16 + lq * 4) = o;
                }
            }
        }
    }
}
__device__ __forceinline__ void phase_s5post(const Params& p, int l, int M, bool dry = false) {
    const int tid_ = otid();
    const size_t n8 = (size_t)M * 768 / 8;
    bf16_t* YF = (bf16_t*)(p.ws + OFF_H + H_YSF); const bf16_t* YB = (const bf16_t*)(p.ws + OFF_H + H_YSB); const bf16_t* CU = (const bf16_t*)(p.ws + OFF_P + P_CU);
    const float* dsk = p.s5_d + (size_t)l * 768;
    for (size_t i = (size_t)blockIdx.x * NTHREADS + tid_; i < n8; i += (size_t)gridDim.x * NTHREADS) {
        const int c = (int)((i * 8) % 768);
        const u32x4 a = *(const u32x4*)(YF + i * 8), bq = *(const u32x4*)(YB + i * 8), uq = *(const u32x4*)(CU + i * 8);
        const unsigned aa[4] = {a.x, a.y, a.z, a.w}, bb[4] = {bq.x, bq.y, bq.z, bq.w}, uu[4] = {uq.x, uq.y, uq.z, uq.w};
        float y[8];
#pragma unroll
        for (int j = 0; j < 4; ++j) { y[2 * j] = gelu_f(bf_lo(aa[j]) + bf_lo(bb[j]) + dsk[c + 2 * j] * bf_lo(uu[j])); y[2 * j + 1] = gelu_f(bf_hi(aa[j]) + bf_hi(bb[j]) + dsk[c + 2 * j + 1] * bf_hi(uu[j])); }
        u32x4 w; w.x = cvt_pk_bf16(y[0], y[1]); w.y = cvt_pk_bf16(y[2], y[3]); w.z = cvt_pk_bf16(y[4], y[5]); w.w = cvt_pk_bf16(y[6], y[7]);
        if (!dry || p.ws == nullptr) *(u32x4*)(YF + i * 8) = w;
    }
}

__device__ __forceinline__ void phase_gmlp(const Params& p, int l, int M, LAS unsigned char* lds, bool dry = false) {
    const int tid_ = otid();
    LAS unsigned char* Wb = lds;
    LAS unsigned char* Vt = lds + 34816;
    LAS float* st = (LAS float*)(lds + 69632);
    const int tid = tid_, lane = tid & 63, w = __builtin_amdgcn_readfirstlane(tid_ >> 6), q = lane >> 4, m = lane & 15;
    bf16_t* AU = (bf16_t*)(p.ws + OFF_P + P_AU); const bf16_t* AV = (const bf16_t*)(p.ws + OFF_P + P_AV);
    const float* lng = p.ln_g + (size_t)l * 1024; const float* lnb = p.ln_b + (size_t)l * 1024;
    for (int u = blockIdx.x; u < M / 128; u += gridDim.x) {
        const size_t r0 = (size_t)u * 128;
        for (int i = 0; i < 16; ++i) {
            const int s = w * 16 + i; const bf16_t* rp = AV + (r0 + s) * 1024 + lane * 16;
            const u32x4 a = *(const u32x4*)rp, bq = *(const u32x4*)(rp + 8);
            const unsigned aa[8] = {a.x, a.y, a.z, a.w, bq.x, bq.y, bq.z, bq.w};
            float sm = 0.f, sq = 0.f;
#pragma unroll
            for (int j = 0; j < 8; ++j) { const float x0 = bf_lo(aa[j]), x1 = bf_hi(aa[j]); sm += x0 + x1; sq += x0 * x0 + x1 * x1; }
            sm = wave_sum(sm); sq = wave_sum(sq);
            const float mean = sm * (1.0f / 1024.0f), var = fmaxf(sq * (1.0f / 1024.0f) - mean * mean, 0.f);
            if (lane == 0) { st[s * 2] = mean; st[s * 2 + 1] = rsqrtf(var + 1e-6f); }
        }
        __syncthreads();
        for (int g = 0; g < 8; ++g) {
            { const int t = tid >> 2, s0 = (tid & 3) * 32; const float* ws = p.w_s + ((size_t)l * 8 + g) * 16384 + t * 128 + s0;
#pragma unroll
              for (int qq = 0; qq < 4; ++qq) { const f32x4 a = *(const f32x4*)(ws + qq * 8), b4 = *(const f32x4*)(ws + qq * 8 + 4);
                  u32x4 o; o.x = cvt_pk_bf16(a[0], a[1]); o.y = cvt_pk_bf16(a[2], a[3]); o.z = cvt_pk_bf16(b4[0], b4[1]); o.w = cvt_pk_bf16(b4[2], b4[3]);
                  *(LAS u32x4*)(Wb + t * 272 + (s0 + qq * 8) * 2) = o; } }
            { const int s = tid >> 2, c0 = (tid & 3) * 32; const bf16_t* rp = AV + (r0 + s) * 1024 + g * 128 + c0;
              const float mean = st[s * 2], rstd = st[s * 2 + 1];
#pragma unroll
              for (int qq = 0; qq < 4; ++qq) { const u32x4 a = *(const u32x4*)(rp + qq * 8); const unsigned aa[4] = {a.x, a.y, a.z, a.w};
#pragma unroll
                  for (int j = 0; j < 4; ++j) { const int cl = c0 + qq * 8 + 2 * j, c = g * 128 + cl;
                      const unsigned pk = cvt_pk_bf16((bf_lo(aa[j]) - mean) * rstd * lng[c] + lnb[c], (bf_hi(aa[j]) - mean) * rstd * lng[c + 1] + lnb[c + 1]);
                      *(LAS bf16_t*)(Vt + cl * 272 + s * 2) = (bf16_t)(pk & 0xffffu); *(LAS bf16_t*)(Vt + (cl + 1) * 272 + s * 2) = (bf16_t)(pk >> 16); } } }
            __syncthreads();
            bf16x8 af[4];
#pragma unroll
            for (int kb = 0; kb < 4; ++kb) af[kb] = *(const LAS bf16x8*)(Vt + (16 * w + m) * 272 + kb * 64 + q * 16);
            const float* bs = p.b_s + ((size_t)l * 8 + g) * 128;
#pragma unroll
            for (int tt = 0; tt < 8; ++tt) {
                f32x4 acc = (f32x4){0.f, 0.f, 0.f, 0.f};
#pragma unroll
                for (int kb = 0; kb < 4; ++kb) acc = __builtin_amdgcn_mfma_f32_16x16x32_bf16(af[kb], *(const LAS bf16x8*)(Wb + (16 * tt + m) * 272 + kb * 64 + q * 16), acc, 0, 0, 0);
                const float bb = bs[16 * tt + m];
                bf16_t* up = AU + (r0 + 16 * tt + m) * 1024 + g * 128 + 16 * w + 4 * q;
                const u32x2 uw = *(const u32x2*)up;
                const float y0 = (acc[0] + bb) * bf_lo(uw.x), y1 = (acc[1] + bb) * bf_hi(uw.x), y2 = (acc[2] + bb) * bf_lo(uw.y), y3 = (acc[3] + bb) * bf_hi(uw.y);
                u32x2 o; o.x = cvt_pk_bf16(y0, y1); o.y = cvt_pk_bf16(y2, y3);
                if (!dry || p.ws == nullptr) *(u32x2*)up = o;
            }
            __syncthreads();
        }
    }
}

__device__ __forceinline__ unsigned fkey(float x) { const unsigned b = __float_as_uint(x); return b ^ ((b >> 31) ? 0xFFFFFFFFu : 0x80000000u); }
__device__ __forceinline__ int mbcnt64(unsigned long long m) { return __builtin_amdgcn_mbcnt_hi((unsigned)(m >> 32), __builtin_amdgcn_mbcnt_lo((unsigned)m, 0u)); }
template <int NV>
__device__ __forceinline__ int count_ge(const unsigned (&k)[NV], unsigned cand) {
    int cnt = 0;
#pragma unroll
    for (int i = 0; i < NV; ++i) cnt += __popcll(__ballot(k[i] >= cand));
    return cnt;
}
template <int NV>
__device__ __forceinline__ unsigned radix_thr16(const unsigned (&k)[NV], unsigned e0bits) {
    unsigned prefix = 0u; int bit = 31;
    {
        const unsigned c0 = e0bits ^ 0x80000000u, c1 = c0 + 0x00800000u, c2 = c0 + 0x01000000u, c3 = c0 + 0x01800000u;
        const int n0 = count_ge<NV>(k, c0), n1 = count_ge<NV>(k, c1), n2 = count_ge<NV>(k, c2), n3 = count_ge<NV>(k, c3);
        if (n0 >= 16 && n3 < 16) { prefix = (n2 >= 16) ? c2 : ((n1 >= 16) ? c1 : c0); bit = 22;
            const int nn = (n2 >= 16) ? n2 : ((n1 >= 16) ? n1 : n0); if (nn == 16) bit = -1; }
    }
    for (; bit >= 0; --bit) {
        const unsigned cand = prefix | (1u << bit);
        const int cnt = count_ge<NV>(k, cand);
        if (cnt >= 16) prefix = cand;
        if (cnt == 16) break;
    }
    return prefix;
}
__device__ __forceinline__ unsigned umin_(unsigned a, unsigned b) { return a < b ? a : b; }
__device__ __forceinline__ unsigned umax_(unsigned a, unsigned b) { return a > b ? a : b; }
__device__ __forceinline__ unsigned med3u(unsigned x, unsigned y, unsigned z) { return umax_(umin_(x, y), umin_(umax_(x, y), z)); }
__device__ __forceinline__ float unkey(unsigned k) { return __uint_as_float((k & 0x80000000u) ? (k ^ 0x80000000u) : ~k); }
__device__ __forceinline__ void ins16(unsigned (&a)[16], unsigned x) {
#pragma unroll
    for (int s = 15; s >= 1; --s) a[s] = med3u(a[s - 1], x, a[s]);
    a[0] = umax_(a[0], x);
}
__device__ __forceinline__ unsigned sel16(const unsigned (&a)[16], int i) {
    unsigned r = a[0];
#pragma unroll
    for (int t = 1; t < 16; ++t) r = (i == t) ? a[t] : r;
    return r;
}
__device__ __forceinline__ void phase_topk(const Params& p, int M, LAS unsigned char* lds) {
    const int tid_ = otid();
    LAS unsigned* lk = (LAS unsigned*)lds + tid_;
    const int gl = blockIdx.x * NTHREADS + tid_, nl = gridDim.x * NTHREADS;
    const float* SC = (const float*)(p.ws + OFF_P + Q_SC);
    int* IDX = (int*)(p.ws + OFF_P + Q_IDX); float* GATE = (float*)(p.ws + OFF_P + Q_GATE);
    const int ntask = M * 8;
    for (int task = gl; task < ntask; task += nl) {
        const float* sc = SC + (size_t)task * 256;
        unsigned a[16], b[16];
#pragma unroll
        for (int i = 0; i < 16; ++i) { a[i] = 0u; b[i] = 0u; }
#pragma unroll 4
        for (int i4 = 0; i4 < 32; ++i4) {
            const f32x4 va = *(const f32x4*)(sc + i4 * 4), vb = *(const f32x4*)(sc + 128 + i4 * 4);
#pragma unroll
            for (int e = 0; e < 4; ++e) { const unsigned tag = 127u - (unsigned)(i4 * 4 + e);
                ins16(a, (fkey(va[e]) & ~127u) | tag); ins16(b, (fkey(vb[e]) & ~127u) | tag); }
        }
        float fa[16], fb[16];
#pragma unroll
        for (int i = 0; i < 16; ++i) { fa[i] = unkey(a[i] & ~127u); fb[i] = unkey(b[i] & ~127u); }
        unsigned c[16];
#pragma unroll
        for (int i = 0; i < 16; ++i) c[i] = 0u;
#pragma unroll
        for (int i = 0; i < 16; ++i)
#pragma unroll
            for (int j = 0; j < 16; ++j)
                if ((i + 1) * (j + 1) <= 16) ins16(c, (fkey(fa[i] + fb[j]) & ~255u) | (unsigned)(i * 16 + j));
#pragma unroll
        for (int i = 0; i < 16; ++i) { lk[i * 512] = a[i]; lk[(16 + i) * 512] = b[i]; }
        const float mx = unkey(c[0] & ~255u);
        float ev[16]; float sm = 0.f; int id[16];
#pragma unroll
        for (int s = 0; s < 16; ++s) { ev[s] = __expf(unkey(c[s] & ~255u) - mx); sm += ev[s];
            const int ij = (int)(c[s] & 255u);
            const unsigned ka = lk[(ij >> 4) * 512], kb = lk[(16 + (ij & 15)) * 512];
            id[s] = (int)(127u - (ka & 127u)) * 128 + (int)(127u - (kb & 127u)); }
        const float inv = 1.0f / sm;
#pragma unroll
        for (int q = 0; q < 4; ++q) {
            u32x4 iw; iw.x = (unsigned)id[4 * q]; iw.y = (unsigned)id[4 * q + 1]; iw.z = (unsigned)id[4 * q + 2]; iw.w = (unsigned)id[4 * q + 3];
            *(u32x4*)(IDX + (size_t)task * 16 + q * 4) = iw;
            *(f32x4*)(GATE + (size_t)task * 16 + q * 4) = (f32x4){ev[4 * q] * inv, ev[4 * q + 1] * inv, ev[4 * q + 2] * inv, ev[4 * q + 3] * inv};
        }
    }
}

__device__ __forceinline__ float dot2u(unsigned a, unsigned b, float acc) {
    return __builtin_amdgcn_fdot2_f32_bf16(__builtin_bit_cast(bf16x2_t, a), __builtin_bit_cast(bf16x2_t, b), acc, false);
}
__device__ __forceinline__ float dot8(const u32x4 a, const u32x4 b, float acc) {
    acc = dot2u(a.x, b.x, acc); acc = dot2u(a.y, b.y, acc); acc = dot2u(a.z, b.z, acc); acc = dot2u(a.w, b.w, acc);
    return acc;
}
__device__ __forceinline__ void phase_peer(const Params& p, int l, int M, LAS unsigned char* lds, bool dry = false) {
    const int tid_ = otid();
    const int lane = tid_ & 63, wv_ = __builtin_amdgcn_readfirstlane(tid_ >> 6), gw = blockIdx.x * 8 + wv_, nw = gridDim.x * 8;
    LAS float* wl = (LAS float*)(lds + wv_ * 512);
    const bf16_t* H = (const bf16_t*)(p.ws + OFF_H);
    const unsigned char* U6 = p.ws + OFF_P + Q_UT; const unsigned char* V6 = p.ws + OFF_P + Q_VT;
    const float* USC = (const float*)(p.ws + OFF_P + Q_USC); const float* VSC = (const float*)(p.ws + OFF_P + Q_VSC);
    const int* IDX = (const int*)(p.ws + OFF_P + Q_IDX); const float* GATE = (const float*)(p.ws + OFF_P + Q_GATE);
    const float* modl = (const float*)(p.ws + OFF_MODV) + (size_t)l * 17 * NMOD + 10240;
    float* XC = (float*)(p.ws + OFF_XC);
    const unsigned lane24 = (unsigned)lane * 24u;
#define PEER_LOAD(buf, TAB, g) do { const int _is = ((g) < 8) ? id0 : id1; _Pragma("unroll") for (int e = 0; e < 8; ++e) { \
        const int _id = __builtin_amdgcn_readlane(_is, (((g) * 8 + e) & 63)); const unsigned char* _rb = (TAB) + (size_t)(unsigned)_id * 1536u; \
        const u32x4 _a = *(const u32x4*)(_rb + lane24); const u32x2 _b = *(const u32x2*)(_rb + lane24 + 16); \
        buf[e][0] = _a.x; buf[e][1] = _a.y; buf[e][2] = _a.z; buf[e][3] = _a.w; buf[e][4] = _b.x; buf[e][5] = _b.y; } } while (0)
    for (int row = gw; row < M; row += nw) {
        float xf[32];
#pragma unroll
        for (int j = 0; j < 8; ++j) { const u32x2 a = *(const u32x2*)(H + (size_t)row * D + j * 256 + lane * 4);
            xf[4 * j] = bf_lo(a.x); xf[4 * j + 1] = bf_hi(a.x); xf[4 * j + 2] = bf_lo(a.y); xf[4 * j + 3] = bf_hi(a.y); }
        const int id0 = IDX[(size_t)row * 128 + lane], id1 = IDX[(size_t)row * 128 + 64 + lane];
        const float g0 = GATE[(size_t)row * 128 + lane], g1 = GATE[(size_t)row * 128 + 64 + lane];
        const float us0 = USC[id0], us1 = USC[id1];
        const float gv0 = g0 * VSC[id0], gv1 = g1 * VSC[id1];
        u32x6 bA[8];
#pragma unroll 1
        for (int g = 0; g < 16; ++g) {
            PEER_LOAD(bA, U6, g);
            float part[8];
            float chain = 0.f;
#pragma unroll
            for (int e = 0; e < 8; ++e) { asm volatile("" : "+v"(bA[e]), "+v"(chain));
                const f32x32 un = __builtin_amdgcn_cvt_scalef32_pk32_f32_fp6(bA[e], 1.0f);
                float a0 = 0.f, a1 = 0.f;
#pragma unroll
                for (int i = 0; i < 16; ++i) { a0 += un[2 * i] * xf[2 * i]; a1 += un[2 * i + 1] * xf[2 * i + 1]; }
                part[e] = a0 + a1; chain = part[e]; }
            float r4[4];
#pragma unroll
            for (int i = 0; i < 4; ++i) { const bool hi = (lane & 32) != 0; const float keep = hi ? part[i + 4] : part[i], send = hi ? part[i] : part[i + 4]; r4[i] = keep + __shfl_xor(send, 32); }
            float r2[2];
#pragma unroll
            for (int i = 0; i < 2; ++i) { const bool hi = (lane & 16) != 0; const float keep = hi ? r4[i + 2] : r4[i], send = hi ? r4[i] : r4[i + 2]; r2[i] = keep + __shfl_xor(send, 16); }
            float r1;
            { const bool hi = (lane & 8) != 0; const float keep = hi ? r2[1] : r2[0], send = hi ? r2[0] : r2[1]; r1 = keep + __shfl_xor(send, 8); }
            r1 += __shfl_xor(r1, 4); r1 += __shfl_xor(r1, 2); r1 += __shfl_xor(r1, 1);
            const int k = g * 8 + ((lane >> 3) & 7);
            const float usk = __shfl((g < 8) ? us0 : us1, k & 63), gvk = __shfl((g < 8) ? gv0 : gv1, k & 63);
            if ((lane & 7) == 0) wl[k] = gelu_f(r1 * usk) * gvk;
        }
        asm volatile("s_waitcnt lgkmcnt(0)" ::: "memory");
        float out[32];
#pragma unroll
        for (int i = 0; i < 32; ++i) out[i] = 0.f;
#pragma unroll 1
        for (int g = 0; g < 16; ++g) {
            PEER_LOAD(bA, V6, g);
#pragma unroll
            for (int e = 0; e < 8; ++e) { const float wk = wl[g * 8 + e]; asm volatile("" : "+v"(bA[e]), "+v"(out[0]), "+v"(out[9]), "+v"(out[18]), "+v"(out[27]), "+v"(out[31]));
                const f32x32 un = __builtin_amdgcn_cvt_scalef32_pk32_f32_fp6(bA[e], 1.0f);
#pragma unroll
                for (int i = 0; i < 32; ++i) out[i] += wk * un[i]; }
        }
        asm volatile("s_waitcnt lgkmcnt(0)" ::: "memory");
        const bool lat = row < TL; const int mb = lat ? (row >> 11) : 16;
        float* xp = lat ? p.out + (size_t)row * D : XC + (size_t)(row - TL) * D;
        const float* gv = modl + (size_t)mb * NMOD;
        f32x4 xn[8]; float ss = 0.f;
#pragma unroll
        for (int j = 0; j < 8; ++j) { const int e = j * 256 + lane * 4;
            const f32x4 o4 = (f32x4){out[4 * j], out[4 * j + 1], out[4 * j + 2], out[4 * j + 3]};
            xn[j] = *(const f32x4*)(xp + e) + *(const f32x4*)(gv + e) * o4;
            ss += xn[j][0] * xn[j][0] + xn[j][1] * xn[j][1] + xn[j][2] * xn[j][2] + xn[j][3] * xn[j][3]; }
        ss = wave_sum(ss);
        const float rs = rsqrtf(ss * (1.0f / 2048.0f) + 1e-6f);
        if (!dry || p.ws == nullptr) {
            if (l == 0) {
                const float* m1 = (const float*)(p.ws + OFF_MODV) + (size_t)17 * NMOD + (size_t)mb * NMOD;
                float am = 0.f;
#pragma unroll
                for (int j = 0; j < 8; ++j) { const int e = j * 256 + lane * 4;
                    *(f32x4*)(xp + e) = xn[j];
                    xn[j] = xn[j] * rs * (*(const f32x4*)(m1 + 2048 + e) + 1.0f) + *(const f32x4*)(m1 + e);
                    am = fmaxf(am, fmaxf(fmaxf(fabsf(xn[j][0]), fabsf(xn[j][1])), fmaxf(fabsf(xn[j][2]), fabsf(xn[j][3])))); }
#pragma unroll
                for (int o = 32; o >= 1; o >>= 1) am = fmaxf(am, __shfl_xor(am, o));
                const float qs = am > 0.f ? 240.0f / am : 1.0f;
                unsigned char* H8 = p.ws + OFF_H8 + (size_t)row * D;
#pragma unroll
                for (int j = 0; j < 8; ++j) *(unsigned*)(H8 + j * 256 + lane * 4) = pack_fp8x4(xn[j][0] * qs, xn[j][1] * qs, xn[j][2] * qs, xn[j][3] * qs);
                if (lane == 0) ((float*)(p.ws + OFF_HS))[row] = am > 0.f ? am * (1.0f / 240.0f) : 1.0f;
            } else {
#pragma unroll
                for (int j = 0; j < 8; ++j) { const int e = j * 256 + lane * 4; *(f32x4*)(xp + e) = xn[j] * rs * *(const f32x4*)(p.final_g + e); }
            }
        }
    }
#undef PEER_LOAD
}

__device__ __forceinline__ Params load_params() {
    Params r;
#if defined(__HIP_DEVICE_COMPILE__)
    typedef const unsigned long long __attribute__((address_space(4)))* KP;
    KP k = (KP)__builtin_amdgcn_kernarg_segment_ptr();
    asm volatile("" : "+s"(k));
    void** d = (void**)&r;
#pragma unroll
    for (int i = 0; i < (int)(sizeof(Params) / 8); ++i) d[i] = (void*)(__attribute__((address_space(1))) void*)k[i];
#endif
    return r;
}
#define WSP(off) (p.ws + (off))
template <int l>
__device__ __forceinline__ void mega_layer(LAS unsigned char* lds, const XcdBarrier& bar) {
        const int Mrows = (l == 0) ? TT : TL;
        if (l == 0) {
            { const Params p = load_params(); phase_wconv(p, 0, lds); }
            { const Params p = load_params(); phase_norm<0, true>(p, 0, TT, 0, 2048); }
            xcd_barrier(bar);
        }
        { const Params p = load_params(); EpiInProj E{WSP(OFF_P), (const float*)WSP(OFF_HS), (const unsigned*)WSP(OFF_CMAX) + (size_t)l * INC};
          run_gemm(lds, (const bf16_t*)WSP(OFF_H8), (const bf16_t*)WSP(OFF_W + W_IN), TT, INC, D / 2, E); }
        xcd_barrier(bar);
        { const Params p = load_params(); phase_hgrn(p, l, lds); }
        __syncthreads();
        { const Params p = load_params(); phase_s5(p, l, lds); }
        xcd_barrier(bar);
        { const Params p = load_params(); phase_gmlp(p, l, Mrows, lds); }
        { const Params p = load_params(); phase_hcomb(p, l, Mrows); }
        { const Params p = load_params(); phase_s5post(p, l, Mrows); }
        xcd_barrier(bar);
        { const Params p = load_params(); EpiGlu E{(bf16_t*)WSP(OFF_P + P_CU)}; run_gemm(lds, (const bf16_t*)WSP(OFF_H + H_YSF), (const bf16_t*)WSP(OFF_W + W_GLU), Mrows, 1536, 768, E); }
        { const Params p = load_params(); EpiMerge<true> E{(bf16_t*)WSP(OFF_P + P_MERGED), (const bf16_t*)WSP(OFF_P + P_GATES)}; run_gemm(lds, (const bf16_t*)WSP(OFF_P + P_AU), (const bf16_t*)WSP(OFF_W + W_A), Mrows, D, 1024, E); }
        { const Params p = load_params(); EpiMerge<false> E{(bf16_t*)WSP(OFF_P + P_MERGED), (const bf16_t*)WSP(OFF_P + P_GATES) + 2048}; run_gemm(lds, (const bf16_t*)WSP(OFF_P + P_BFF), (const bf16_t*)WSP(OFF_W + W_B), Mrows, D, 1024, E); }
        xcd_barrier(bar);
        { const Params p = load_params(); EpiMerge<false> E{(bf16_t*)WSP(OFF_P + P_MERGED), (const bf16_t*)WSP(OFF_P + P_GATES) + 4096}; run_gemm(lds, (const bf16_t*)WSP(OFF_P + P_CU), (const bf16_t*)WSP(OFF_W + W_C), Mrows, D, 768, E); }
        xcd_barrier(bar);
        { const Params p = load_params(); EpiResid E{p.out, (float*)WSP(OFF_XC), (const float*)WSP(OFF_MODV) + (size_t)l * 17 * NMOD + 4096}; run_gemm(lds, (const bf16_t*)WSP(OFF_P + P_MERGED), (const bf16_t*)WSP(OFF_W + W_O), Mrows, D, D, E); }
        { const Params p = load_params(); phase_tabconv(p, l); }
        xcd_barrier(bar);
        { const Params p = load_params(); phase_norm<1>(p, l, Mrows, 6144, 8192); }
        xcd_barrier(bar);
        { const Params p = load_params(); EpiF32 E{(float*)WSP(OFF_P + Q_SC), 2048}; run_gemm(lds, (const bf16_t*)WSP(OFF_H), (const bf16_t*)WSP(OFF_W + W_S), Mrows, D, D, E); }
        xcd_barrier(bar);
        { const Params p = load_params(); phase_topk(p, Mrows, lds); }
        xcd_barrier(bar);
        { const Params p = load_params(); phase_peer(p, l, Mrows, lds); }
        if (l == 0) {
            __syncthreads();
            { const Params p = load_params(); phase_wconv(p, 1, lds); }
            xcd_barrier(bar);
        }
}
#undef WSP
__global__ void __launch_bounds__(NTHREADS, 2) k_mega(Params p_kernarg_only) {
    extern __shared__ __attribute__((aligned(16))) unsigned char smem[];
    LAS unsigned char* lds = (LAS unsigned char*)smem;
    volatile LAS unsigned* xbw = (volatile LAS unsigned*)(lds + LDS_BYTES - 16);
    if (threadIdx.x == 0) { xbw[0] = 0u; xbw[1] = 0u; xbw[2] = 0u; xbw[3] = 0u; }
    __syncthreads();
    XcdBarrier bar;
    { const Params p = load_params(); bar = xcd_barrier_post((unsigned*)(p.ws + OFF_BAR), xbw); }
#define WSP(off) (p.ws + (off))
    { const Params p = load_params(); phase_colmax(p); }
    { const Params p = load_params(); phase_prep(p); phase_mod(p, lds); }
    xcd_barrier(bar);
    mega_layer<0>(lds, bar);
    mega_layer<1>(lds, bar);
#undef WSP
}

extern "C" void kernel_launch(void* const* d_in, const int* in_sizes, int n_in, void* d_out, int out_size, void* d_ws, size_t ws_size, hipStream_t stream) {
    (void)in_sizes; (void)n_in; (void)out_size; (void)ws_size;
    Params p;
    const float** f = (const float**)&p;
    for (int i = 0; i < 31; ++i) f[i] = (const float*)d_in[i];
    p.out = (float*)d_out; p.ws = (unsigned char*)d_ws;
    static int grid = 0;
    if (!grid) {
        int dev = 0, cus = 0, per_cu = 0;
        (void)hipGetDevice(&dev);
        (void)hipDeviceGetAttribute(&cus, hipDeviceAttributeMultiprocessorCount, dev);
        (void)hipFuncSetAttribute((const void*)k_mega, hipFuncAttributeMaxDynamicSharedMemorySize, LDS_BYTES);
        (void)hipOccupancyMaxActiveBlocksPerMultiprocessor(&per_cu, (const void*)k_mega, NTHREADS, LDS_BYTES);
        grid = (per_cu >= 1 && cus > 0) ? (cus < 256 ? cus : 256) : 256;
    }
    (void)hipMemsetAsync(p.ws + OFF_BAR, 0, XCD_BAR_WORDS * sizeof(unsigned), stream);
    (void)hipMemsetAsync(p.ws + OFF_CMAX, 0, (size_t)2 * INC * sizeof(unsigned), stream);
    hipLaunchKernelGGL(k_mega, dim3(grid), dim3(NTHREADS), LDS_BYTES, stream, p);
}
```

```cpp
#include <hip/hip_runtime.h>
#include <stdint.h>

#define LAS __attribute__((address_space(3)))
typedef unsigned short bf16_t;
typedef short bf16x8 __attribute__((ext_vector_type(8)));
typedef float f32x4 __attribute__((ext_vector_type(4)));
typedef float f32x2 __attribute__((ext_vector_type(2)));
typedef unsigned u32x4 __attribute__((ext_vector_type(4)));
typedef unsigned u32x2 __attribute__((ext_vector_type(2)));
typedef __bf16 bf16x2_t __attribute__((ext_vector_type(2)));
typedef __bf16 bf16x32_t __attribute__((ext_vector_type(32)));
typedef float f32x32 __attribute__((ext_vector_type(32)));
typedef unsigned u32x6 __attribute__((ext_vector_type(6)));

constexpr int D = 2048, NB = 16, SEQ = 2048, CTXL = 256;
constexpr int TL = NB * SEQ;
constexpr int TC = NB * CTXL;
constexpr int TT = TL + TC;
constexpr int INC = 14080;
constexpr int NMOD = 12288;
constexpr int NTHREADS = 512;
constexpr int LDS_BYTES = 160 * 1024;

constexpr size_t OFF_BAR = 0;
constexpr size_t OFF_MODV = 16384;
constexpr size_t OFF_LB = OFF_MODV + (size_t)2 * 17 * NMOD * 4;
constexpr size_t OFF_S5LAM = OFF_LB + 2 * 2 * 1024 * 4;
constexpr size_t OFF_S5BB = OFF_S5LAM + (size_t)2 * 2 * 48 * 64 * 2 * 4;
constexpr size_t OFF_PE = OFF_S5BB + (size_t)2 * 2 * 48 * 64 * 32 * 4;
constexpr size_t OFF_CMAX = (OFF_PE + (size_t)96 * 1024 * 4 + 255) & ~(size_t)255;
constexpr size_t OFF_HS = OFF_CMAX + (size_t)2 * INC * 4;
constexpr size_t OFF_XC = (OFF_HS + (size_t)TT * 4 + 255) & ~(size_t)255;
constexpr size_t OFF_H = OFF_XC + (size_t)TC * D * 4;
constexpr size_t OFF_W = OFF_H + (size_t)TT * D * 2;
constexpr size_t W_IN = 0;
constexpr size_t W_GLU = W_IN + (size_t)INC * D;
constexpr size_t W_A = W_GLU + (size_t)1536 * 768 * 2;
constexpr size_t W_B = W_A + (size_t)2048 * 1024 * 2;
constexpr size_t W_C = W_B + (size_t)2048 * 1024 * 2;
constexpr size_t W_O = W_C + (size_t)2048 * 768 * 2;
constexpr size_t W_S = W_O + (size_t)2048 * 2048 * 2;
constexpr size_t W_TOTAL = W_S + (size_t)2048 * 2048 * 2;
constexpr size_t OFF_P = OFF_W + W_TOTAL;
constexpr size_t SEG = (size_t)TT * 1024 * 2;
constexpr size_t P_AU = 0, P_AV = SEG, P_BQ = 2 * SEG, P_BFF = 3 * SEG, P_BFB = 4 * SEG, P_BI = 5 * SEG, P_BG = 6 * SEG;
constexpr size_t P_CU = 7 * SEG;
constexpr size_t P_GATES = P_CU + (size_t)TT * 768 * 2;
constexpr size_t P_TOTAL = P_GATES + (size_t)TT * 6144 * 2;
constexpr size_t P_MERGED = SEG;
constexpr size_t Q_UT = 0;
constexpr size_t Q_VT = Q_UT + (size_t)16384 * 1536;
constexpr size_t Q_USC = Q_VT + (size_t)16384 * 1536;
constexpr size_t Q_VSC = Q_USC + (size_t)16384 * 4;
constexpr size_t Q_SC = Q_VSC + (size_t)16384 * 4;
constexpr size_t Q_IDX = Q_SC + (size_t)TT * 2048 * 4;
constexpr size_t Q_GATE = Q_IDX + (size_t)TT * 128 * 4;
constexpr size_t H_YSF = 0;
constexpr size_t H_YSB = (size_t)TT * 768 * 2;
constexpr size_t OFF_H8 = OFF_P + P_TOTAL;
constexpr size_t WS_NEEDED = OFF_H8 + (size_t)TT * D;

struct Params {
    const float *x, *c, *ctx, *c_ctx, *w_mod, *b_mod, *w_in, *ln_g, *ln_b, *w_s, *b_s, *lb_logits, *hn_g;
    const float *lam_re, *lam_im, *log_step, *b_re, *b_im, *c_re, *c_im, *s5_d, *w_glu, *wa, *wb, *wc, *wo, *w_q, *sub_keys, *peer_u, *peer_v, *final_g;
    float* out;
    unsigned char* ws;
};

__device__ __forceinline__ float bf_lo(unsigned u) { return __uint_as_float(u << 16); }
__device__ __forceinline__ float bf_hi(unsigned u) { return __uint_as_float(u & 0xffff0000u); }
__device__ __forceinline__ unsigned cvt_pk_bf16(float lo, float hi) { f32x2 v; v.x = lo; v.y = hi; const bf16x2_t b = __builtin_convertvector(v, bf16x2_t); return __builtin_bit_cast(unsigned, b); }
__device__ __forceinline__ float fexp(float x) { return __builtin_amdgcn_exp2f(x * 1.44269504f); }
__device__ __forceinline__ float flog(float x) { return __builtin_amdgcn_logf(x) * 0.693147181f; }
__device__ __forceinline__ float fast_sigmoid(float x) { return __builtin_amdgcn_rcpf(1.0f + fexp(-x)); }
__device__ __forceinline__ float fast_silu(float x) { return x * fast_sigmoid(x); }
__device__ __forceinline__ float gelu_f(float v) {
    const float av = fabsf(v), t = __builtin_amdgcn_rcpf(av * 0.2316418882f + 1.0f);
    float q = t * 0.5307027145f + (-0.7265760135f); q = q * t + 0.7107068705f; q = q * t + (-0.142248368f); q = q * t + 0.127414796f; q = q * t;
    const float e = __builtin_amdgcn_exp2f((v * v) * (-0.72134752044f));
    const float m = v * (q * e);
    return v < 0.f ? m : v - m;
}
__device__ __forceinline__ unsigned pack_fp8x4(float a, float b, float c, float d) {
    int pk = 0; pk = __builtin_amdgcn_cvt_pk_fp8_f32(a, b, pk, false); pk = __builtin_amdgcn_cvt_pk_fp8_f32(c, d, pk, true); return (unsigned)pk;
}
template <int CTRL> __device__ __forceinline__ float dpp_f(float v) { return __int_as_float(__builtin_amdgcn_update_dpp(0, __float_as_int(v), CTRL, 0xF, 0xF, false)); }
__device__ __forceinline__ float row16_max(float v) { v = fmaxf(v, dpp_f<0x128>(v)); v = fmaxf(v, dpp_f<0x124>(v)); v = fmaxf(v, dpp_f<0x122>(v)); v = fmaxf(v, dpp_f<0x121>(v)); return v; }
__device__ __forceinline__ float row16_sum(float v) { v += dpp_f<0x128>(v); v += dpp_f<0x124>(v); v += dpp_f<0x122>(v); v += dpp_f<0x121>(v); return v; }
__device__ __forceinline__ float wave_sum(float v) {
#pragma unroll
    for (int o = 32; o >= 1; o >>= 1) v += __shfl_xor(v, o);
    return v;
}
__device__ __forceinline__ int otid() { int t; asm volatile("v_mov_b32 %0, %1" : "=v"(t) : "v"((int)threadIdx.x)); return t; }


#define XB_TMO      128
#define XB_XCNT(j)  (256  + 64 * (j))
#define XB_XSUB(j)  (1280 + 64 * (j))
#define XB_XGEN(j)  (2304 + 64 * (j))
#define XB_TOP      3328
#define XB_TOPGEN   3392
#define XCD_BAR_WORDS 3456
#define XB_SPIN_CAP (1u << 22)
__device__ __forceinline__ unsigned xb_ld(unsigned* p)              { return __hip_atomic_load(p, __ATOMIC_RELAXED, __HIP_MEMORY_SCOPE_AGENT); }
__device__ __forceinline__ unsigned xb_add(unsigned* p, unsigned v) { return __hip_atomic_fetch_add(p, v, __ATOMIC_RELAXED, __HIP_MEMORY_SCOPE_AGENT); }
__device__ __forceinline__ unsigned xb_xcc_id() { return (unsigned)__builtin_amdgcn_s_getreg((3 << 11) | 20) & 0xFu; }
#define XB_SPIN(cond, bar) do { unsigned _sp = 0; while (cond) { __builtin_amdgcn_s_sleep(1); \
    if ((++_sp & 255u) == 0u) { if (xb_ld(&(bar)[XB_TMO])) break; if (_sp > XB_SPIN_CAP) { atomicAdd(&(bar)[XB_TMO], 1u); break; } } } } while (0)
struct XcdBarrier { unsigned* bar; unsigned x; volatile LAS unsigned* st; };
__device__ __forceinline__ XcdBarrier xcd_barrier_post(unsigned* bar, volatile LAS unsigned* st) {
    XcdBarrier b; b.bar = bar; b.x = xb_xcc_id(); b.st = st;
    if (threadIdx.x == 0) (void)xb_add(&bar[XB_XCNT(b.x)], 1u);
    return b;
}
__device__ __forceinline__ void xcd_barrier_complete(unsigned* bar, unsigned x, unsigned& nloc, unsigned& nx) {
    const unsigned G = gridDim.x * gridDim.y * gridDim.z;
    unsigned sum, cnt, mine, sp = 0u;
    for (;;) {
        sum = 0u; cnt = 0u; mine = 0u;
#pragma unroll
        for (unsigned j = 0; j < 16; ++j) { const unsigned c = xb_ld(&bar[XB_XCNT(j)]); sum += c; cnt += (c > 0u) ? 1u : 0u; mine = (j == x) ? c : mine; }
        if (sum == G) break;
        __builtin_amdgcn_s_sleep(1);
        if ((++sp & 255u) == 0u) { if (xb_ld(&bar[XB_TMO])) break; if (sp > XB_SPIN_CAP) { atomicAdd(&bar[XB_TMO], 1u); break; } }
    }
    nloc = mine > 0u ? mine : 1u; nx = cnt > 0u ? cnt : 1u;
}
__device__ __forceinline__ void xcd_barrier(const XcdBarrier& b) {
    asm volatile("s_waitcnt vmcnt(0)" ::: "memory");
    __syncthreads();
    if (threadIdx.x == 0) {
        unsigned* bar = b.bar;
        __builtin_amdgcn_s_waitcnt(0);
        unsigned nloc = b.st[0], nx = b.st[1];
        if (nloc == 0u) { xcd_barrier_complete(bar, b.x, nloc, nx); b.st[0] = nloc; b.st[1] = nx; }
        const unsigned old = xb_add(&bar[XB_XSUB(b.x)], 1u);
        const unsigned gen = old / nloc;
        if (old + 1u == (gen + 1u) * nloc) {
            __builtin_amdgcn_fence(__ATOMIC_RELEASE, "agent");
            asm volatile("s_waitcnt vmcnt(0)" ::: "memory");
            const unsigned og = xb_add(&bar[XB_TOP], 1u);
            const unsigned tg = og / nx;
            if (og + 1u == (tg + 1u) * nx) xb_add(&bar[XB_TOPGEN], 1u);
            else XB_SPIN(xb_ld(&bar[XB_TOPGEN]) == tg, bar);
            __builtin_amdgcn_fence(__ATOMIC_ACQUIRE, "agent");
            xb_add(&bar[XB_XGEN(b.x)], 1u);
            asm volatile("s_waitcnt vmcnt(0)" ::: "memory");
        } else {
            XB_SPIN(xb_ld(&bar[XB_XGEN(b.x)]) == gen, bar);
            __builtin_amdgcn_fence(__ATOMIC_ACQUIRE, "agent");
            asm volatile("s_waitcnt vmcnt(0)" ::: "memory");
        }
    }
    __syncthreads();
}

namespace pg8 {
constexpr int BM = 256, BK = 64, HALF = 128, HTB = HALF * BK * 2, STAGE_BYTES = 8 * HTB, NXCD = 8, WGM = 8;
__host__ __device__ __forceinline__ int lds_byte(int r, int c) { const int st = (r >> 4) * 2 + (c >> 5), rr = r & 15, cc = c & 31, ob = rr * 64 + cc * 2; return st * 1024 + (ob ^ (((ob >> 9) & 1) << 5)); }
__host__ __device__ __forceinline__ void stage_rc(int b, int& R, int& C) { const int st = b / 1024, sb = b % 1024, swz = sb ^ (((sb >> 9) & 1) << 5); R = (st >> 1) * 16 + swz / 64; C = (st & 1) * 32 + (swz % 64) / 2; }
__host__ __device__ __forceinline__ int perm32(int rho) { const int n = rho >> 4, i = rho & 15; return 8 * (i >> 2) + 4 * n + (i & 3); }
typedef int i32x8 __attribute__((ext_vector_type(8)));
__device__ __forceinline__ i32x8 cat8(const bf16x8 a, const bf16x8 b) { const u32x4 x = __builtin_bit_cast(u32x4, a), y = __builtin_bit_cast(u32x4, b); i32x8 r; r[0] = (int)x.x; r[1] = (int)x.y; r[2] = (int)x.z; r[3] = (int)x.w; r[4] = (int)y.x; r[5] = (int)y.y; r[6] = (int)y.z; r[7] = (int)y.w; return r; }
struct Unit { int pm, pn; };
struct Gemm { const bf16_t* A; const bf16_t* Bt; int M, N, K; };
struct StaticOrder {
    int nM, nN, nwg, G, c;
    __device__ void init(int M, int N, int G_, int c_) { nM = M / BM; nN = N / BM; nwg = nM * nN; G = G_; c = c_; }
    __device__ bool next(int i, Unit& u) const {
        const long L = (long)i * G + c; if (L >= nwg) return false;
        int wgid = (int)L; { const int q = nwg / NXCD, r = nwg % NXCD, xcd = wgid % NXCD, off = wgid / NXCD; wgid = (xcd < r ? xcd * (q + 1) : r * (q + 1) + (xcd - r) * q) + off; }
        const int nig = WGM * nN, gid = wgid / nig, fm = gid * WGM, gsz = (nM - fm) < WGM ? (nM - fm) : WGM;
        u.pm = fm + ((wgid % nig) % gsz); u.pn = (wgid % nig) / gsz; return true;
    }
};

template <class Epi, class Sched>
__device__ __forceinline__ void gemm_phase(LAS unsigned char* lds, const Gemm g, const Sched& S, const Epi& E) {
    const int tid_ = otid();
    const int tid = tid_, wid = __builtin_amdgcn_readfirstlane(tid >> 6), lane = tid & 63, wr = wid >> 2, wc = wid & 3, fr = lane & 15, fq = lane >> 4;
    const int K = g.K, nt = K / BK;
    unsigned voffA[2], voffB[2];
#pragma unroll
    for (int i = 0; i < 2; ++i) { int R, C; stage_rc(tid * 16 + i * 8192, R, C); const int Rb = Epi::PERM ? ((R & ~31) + perm32(R & 31)) : R;
        voffA[i] = (unsigned)(R * K + C) * 2u; voffB[i] = (unsigned)(Rb * K + C) * 2u; }
    const size_t kstep = (size_t)(BK * 2);
    const size_t hstep = (size_t)HALF * K * 2;
    const size_t tstep = 2 * hstep;
    const unsigned ldsw = (unsigned)wid * 1024u;
    const int aoff = lds_byte(wr * 64 + fr, fq * 8), boff = lds_byte(wc * 32 + fr, fq * 8);
    const int aoff8 = lds_byte(wr * 64 + fr, (fq >> 1) * 32 + (fq & 1) * 16), boff8 = lds_byte(wc * 32 + fr, (fq >> 1) * 32 + (fq & 1) * 16);
#define PG8_SA(b, h) (((b) * 2 + (h)) * HTB)
#define PG8_SB(b, h) ((4 + (b) * 2 + (h)) * HTB)
#define PG8_STAGE(bufoff, gbase, voff) do { _Pragma("unroll") for (int _i = 0; _i < 2; ++_i) \
        __builtin_amdgcn_global_load_lds((const unsigned*)((const char*)(gbase) + (voff)[_i]), (LAS unsigned*)(lds + (bufoff) + ldsw + _i * 8192), 16, 0, 0); } while (0)
#define PG8_LDA(dst, b, h) do { if constexpr (Epi::FP8) { _Pragma("unroll") for (int m = 0; m < 4; ++m) dst##8[m] = cat8(*(const LAS bf16x8*)(lds + PG8_SA(b, h) + aoff + m * 2048), *(const LAS bf16x8*)(lds + PG8_SA(b, h) + aoff + m * 2048 + 1024)); } \
        else { _Pragma("unroll") for (int m = 0; m < 4; ++m) _Pragma("unroll") for (int k = 0; k < 2; ++k) dst[m][k] = *(const LAS bf16x8*)(lds + PG8_SA(b, h) + aoff + m * 2048 + k * 1024); } } while (0)
#define PG8_LDB(dst, b, h) do { if constexpr (Epi::FP8) { _Pragma("unroll") for (int n = 0; n < 2; ++n) dst##8[n] = cat8(*(const LAS bf16x8*)(lds + PG8_SB(b, h) + boff + n * 2048), *(const LAS bf16x8*)(lds + PG8_SB(b, h) + boff + n * 2048 + 1024)); } \
        else { _Pragma("unroll") for (int n = 0; n < 2; ++n) _Pragma("unroll") for (int k = 0; k < 2; ++k) dst[n][k] = *(const LAS bf16x8*)(lds + PG8_SB(b, h) + boff + n * 2048 + k * 1024); } } while (0)
#define PG8_MMA(ai, bj, At, Bt) do { __builtin_amdgcn_s_setprio(1); _Pragma("unroll") for (int m = 0; m < 4; ++m) _Pragma("unroll") for (int n = 0; n < 2; ++n) { \
        if constexpr (Epi::FP8) { asm volatile("v_mfma_scale_f32_16x16x128_f8f6f4 %0, %1, %2, %0, %3, %3 op_sel_hi:[0,0,0]" : "+v"(acc[ai][bj][m][n]) : "v"(Bt##8[n]), "v"(At##8[m]), "v"(one_scale)); } \
        else { _Pragma("unroll") for (int k = 0; k < 2; ++k) acc[ai][bj][m][n] = __builtin_amdgcn_mfma_f32_16x16x32_bf16(Bt[n][k], At[m][k], acc[ai][bj][m][n], 0, 0, 0); } } \
        __builtin_amdgcn_s_setprio(0); } while (0)
#define PG8_WAIT_V(n) asm volatile("s_waitcnt vmcnt(" #n ")" ::: "memory")
#define PG8_WAIT_L(n) asm volatile("s_waitcnt lgkmcnt(" #n ")" ::: "memory")
#define PG8_BAR __builtin_amdgcn_s_barrier()
#define PG8_SCHED __builtin_amdgcn_sched_barrier(0)
    Unit cur, nxt; int ui = 0;
    if (!S.next(0, cur)) return;
    f32x4 acc[2][2][4][2];
#pragma unroll
    for (int a = 0; a < 2; ++a)
#pragma unroll
        for (int b = 0; b < 2; ++b)
#pragma unroll
            for (int m = 0; m < 4; ++m)
#pragma unroll
                for (int n = 0; n < 2; ++n) acc[a][b][m][n] = (f32x4){0.f, 0.f, 0.f, 0.f};
    bf16x8 At[4][2], B0[2][2], B1[2][2];
    i32x8 At8[4], B08[2], B18[2];
    const int one_scale = 0x7F7F7F7F;
    const char* cA = (const char*)g.A + (size_t)cur.pm * tstep; const char* cB = (const char*)g.Bt + (size_t)cur.pn * tstep;
    PG8_STAGE(PG8_SB(0, 0), cB, voffB); PG8_STAGE(PG8_SA(0, 0), cA, voffA); PG8_STAGE(PG8_SB(0, 1), cB + hstep, voffB); PG8_STAGE(PG8_SA(0, 1), cA + hstep, voffA);
    if (wr == 1) PG8_BAR;
    PG8_WAIT_V(4); PG8_BAR;
    PG8_STAGE(PG8_SB(1, 0), cB + kstep, voffB); PG8_STAGE(PG8_SA(1, 0), cA + kstep, voffA); PG8_STAGE(PG8_SB(1, 1), cB + hstep + kstep, voffB);
    PG8_WAIT_V(6); PG8_BAR;
    for (;;) {
        const bool has_next = S.next(ui + 1, nxt);
        const char* nA = has_next ? (const char*)g.A + (size_t)nxt.pm * tstep : cA; const char* nB = has_next ? (const char*)g.Bt + (size_t)nxt.pn * tstep : cB;
        for (int t = 0; t < nt; t += 2) {
            const bool last = (t == nt - 2);
            const char* a1 = cA + (size_t)(t + 1) * kstep;
            const char* a2 = last ? nA : cA + (size_t)(t + 2) * kstep; const char* b2 = last ? nB : cB + (size_t)(t + 2) * kstep;
            const char* a3 = a2 + kstep; const char* b3 = b2 + kstep;
            PG8_LDB(B0, 0, 0); PG8_SCHED; PG8_LDA(At, 0, 0); PG8_STAGE(PG8_SA(1, 1), a1 + hstep, voffA);
            PG8_WAIT_L(8); PG8_BAR; PG8_WAIT_L(0); PG8_MMA(0, 0, At, B0); PG8_BAR; PG8_SCHED;
            PG8_LDB(B1, 0, 1); PG8_STAGE(PG8_SB(0, 0), b2, voffB);
            PG8_BAR; PG8_WAIT_L(0); PG8_MMA(0, 1, At, B1); PG8_BAR;
            PG8_LDA(At, 0, 1); PG8_STAGE(PG8_SA(0, 0), a2, voffA);
            PG8_BAR; PG8_WAIT_L(0); PG8_MMA(1, 0, At, B0); PG8_BAR; PG8_SCHED;
            PG8_STAGE(PG8_SB(0, 1), b2 + hstep, voffB);
            PG8_WAIT_V(6); PG8_BAR; PG8_MMA(1, 1, At, B1); PG8_BAR;
            PG8_LDB(B0, 1, 0); PG8_SCHED; PG8_LDA(At, 1, 0); PG8_STAGE(PG8_SA(0, 1), a2 + hstep, voffA);
            PG8_WAIT_L(8); PG8_BAR; PG8_WAIT_L(0); PG8_MMA(0, 0, At, B0); PG8_BAR; PG8_SCHED;
            PG8_LDB(B1, 1, 1); PG8_STAGE(PG8_SB(1, 0), b3, voffB);
            PG8_BAR; PG8_WAIT_L(0); PG8_MMA(0, 1, At, B1); PG8_BAR;
            PG8_LDA(At, 1, 1); PG8_STAGE(PG8_SA(1, 0), a3, voffA);
            PG8_BAR; PG8_WAIT_L(0); PG8_MMA(1, 0, At, B0); PG8_BAR; PG8_SCHED;
            PG8_STAGE(PG8_SB(1, 1), b3 + hstep, voffB);
            PG8_WAIT_V(6); PG8_BAR; PG8_MMA(1, 1, At, B1); PG8_BAR;
        }
        if constexpr (Epi::FP8) asm volatile("s_nop 15\n s_nop 15\n s_nop 15" ::: "memory");
        E(acc, cur, wr, wc, fr, fq);
        if (!has_next) break;
#pragma unroll
        for (int a = 0; a < 2; ++a)
#pragma unroll
            for (int b = 0; b < 2; ++b)
#pragma unroll
                for (int m = 0; m < 4; ++m)
#pragma unroll
                    for (int n = 0; n < 2; ++n) acc[a][b][m][n] = (f32x4){0.f, 0.f, 0.f, 0.f};
        cur = nxt; cA = nA; cB = nB; ++ui;
    }
    PG8_WAIT_V(0);
    if (wr == 0) PG8_BAR;
    PG8_BAR;
#undef PG8_SA
#undef PG8_SB
#undef PG8_STAGE
#undef PG8_LDA
#undef PG8_LDB
#undef PG8_MMA
#undef PG8_WAIT_V
#undef PG8_WAIT_L
#undef PG8_BAR
#undef PG8_SCHED
}
}

typedef f32x4 AccT[2][2][4][2];

struct EpiInProj {
    static constexpr bool PERM = true, FP8 = true;
    unsigned char* P;
    const float* sa;
    const unsigned* cmax;
    __device__ __forceinline__ void operator()(const AccT& acc, const pg8::Unit& u, int wr, int wc, int fr, int fq) const {
        const int pn = u.pn;
        bf16_t* base; int ld, lc, act;
        if (pn < 28) { const int seg = pn >> 2; base = (bf16_t*)(P + (size_t)seg * SEG); ld = 1024; lc = (pn & 3) * 256; act = (seg < 2) ? 1 : ((seg == 2 || seg == 6) ? 2 : 0); }
        else if (pn < 31) { base = (bf16_t*)(P + P_CU); ld = 768; lc = (pn - 28) * 256; act = 0; }
        else { base = (bf16_t*)(P + P_GATES); ld = 6144; lc = (pn - 31) * 256; act = 3; }
        const int row0 = u.pm * 256 + wr * 64 + fr, col0 = lc + wc * 32 + 8 * fq, gcol0 = u.pn * 256 + wc * 32 + 8 * fq;
        f32x4 cs[2][2];
#pragma unroll
        for (int bj = 0; bj < 2; ++bj)
#pragma unroll
            for (int n = 0; n < 2; ++n) { const u32x4 cb = *(const u32x4*)(cmax + gcol0 + bj * 128 + 4 * n);
                cs[bj][n] = (f32x4){__uint_as_float(cb.x), __uint_as_float(cb.y), __uint_as_float(cb.z), __uint_as_float(cb.w)} * (1.0f / 240.0f); }
        float rscv[2][4];
#pragma unroll
        for (int ai = 0; ai < 2; ++ai)
#pragma unroll
            for (int m = 0; m < 4; ++m) rscv[ai][m] = sa[row0 + ai * 128 + m * 16];
#pragma unroll
        for (int ai = 0; ai < 2; ++ai)
#pragma unroll
            for (int m = 0; m < 4; ++m) {
                bf16_t* rowp = base + (size_t)(row0 + ai * 128 + m * 16) * ld + col0;
                const float rsc = rscv[ai][m];
#pragma unroll
                for (int bj = 0; bj < 2; ++bj) {
                    f32x4 v0 = acc[ai][bj][m][0] * (cs[bj][0] * rsc), v1 = acc[ai][bj][m][1] * (cs[bj][1] * rsc);
                    if (act == 1) {
#pragma unroll
                        for (int j = 0; j < 4; ++j) { v0[j] = gelu_f(v0[j]); v1[j] = gelu_f(v1[j]); }
                    } else if (act == 2) {
#pragma unroll
                        for (int j = 0; j < 4; ++j) { v0[j] = fast_silu(v0[j]); v1[j] = fast_silu(v1[j]); }
                    } else if (act == 3) {
#pragma unroll
                        for (int j = 0; j < 4; ++j) { v0[j] = fast_sigmoid(v0[j]); v1[j] = fast_sigmoid(v1[j]); }
                    }
                    u32x4 w; w.x = cvt_pk_bf16(v0[0], v0[1]); w.y = cvt_pk_bf16(v0[2], v0[3]); w.z = cvt_pk_bf16(v1[0], v1[1]); w.w = cvt_pk_bf16(v1[2], v1[3]);
                    *(u32x4*)(rowp + bj * 128) = w;
                }
            }
    }
};
struct EpiGlu {
    static constexpr bool PERM = true, FP8 = false;
    bf16_t* O;
    __device__ __forceinline__ void operator()(const AccT& acc, const pg8::Unit& u, int wr, int wc, int fr, int fq) const {
        const int row0 = u.pm * 256 + wr * 64 + fr, col0 = u.pn * 128 + wc * 32 + 8 * fq;
#pragma unroll
        for (int ai = 0; ai < 2; ++ai)
#pragma unroll
            for (int m = 0; m < 4; ++m) {
                f32x4 v0 = acc[ai][0][m][0], v1 = acc[ai][0][m][1]; const f32x4 g0 = acc[ai][1][m][0], g1 = acc[ai][1][m][1];
#pragma unroll
                for (int j = 0; j < 4; ++j) { v0[j] *= fast_sigmoid(g0[j]); v1[j] *= fast_sigmoid(g1[j]); }
                u32x4 w; w.x = cvt_pk_bf16(v0[0], v0[1]); w.y = cvt_pk_bf16(v0[2], v0[3]); w.z = cvt_pk_bf16(v1[0], v1[1]); w.w = cvt_pk_bf16(v1[2], v1[3]);
                *(u32x4*)(O + (size_t)(row0 + ai * 128 + m * 16) * 768 + col0) = w;
            }
    }
};
template <bool FIRST> struct EpiMerge {
    static constexpr bool PERM = true, FP8 = false;
    bf16_t* O;
    const bf16_t* G;
    __device__ __forceinline__ void operator()(const AccT& acc, const pg8::Unit& u, int wr, int wc, int fr, int fq) const {
        const int row0 = u.pm * 256 + wr * 64 + fr, col0 = u.pn * 256 + wc * 32 + 8 * fq;
#pragma unroll
        for (int ai = 0; ai < 2; ++ai) {
            u32x4 gwv[4][2], owv[4][2];
#pragma unroll
            for (int m = 0; m < 4; ++m)
#pragma unroll
                for (int bj = 0; bj < 2; ++bj) { const size_t row = (size_t)(row0 + ai * 128 + m * 16);
                    gwv[m][bj] = *(const u32x4*)(G + row * 6144 + col0 + bj * 128);
                    if (!FIRST) owv[m][bj] = *(const u32x4*)(O + row * 2048 + col0 + bj * 128); }
#pragma unroll
            for (int m = 0; m < 4; ++m)
#pragma unroll
                for (int bj = 0; bj < 2; ++bj) { const size_t row = (size_t)(row0 + ai * 128 + m * 16);
                    const u32x4 gw = gwv[m][bj];
                    f32x4 v0 = acc[ai][bj][m][0], v1 = acc[ai][bj][m][1];
                    v0[0] *= bf_lo(gw.x); v0[1] *= bf_hi(gw.x); v0[2] *= bf_lo(gw.y); v0[3] *= bf_hi(gw.y);
                    v1[0] *= bf_lo(gw.z); v1[1] *= bf_hi(gw.z); v1[2] *= bf_lo(gw.w); v1[3] *= bf_hi(gw.w);
                    if (!FIRST) { const u32x4 ow = owv[m][bj];
                        v0[0] += bf_lo(ow.x); v0[1] += bf_hi(ow.x); v0[2] += bf_lo(ow.y); v0[3] += bf_hi(ow.y);
                        v1[0] += bf_lo(ow.z); v1[1] += bf_hi(ow.z); v1[2] += bf_lo(ow.w); v1[3] += bf_hi(ow.w); }
                    u32x4 w; w.x = cvt_pk_bf16(v0[0], v0[1]); w.y = cvt_pk_bf16(v0[2], v0[3]); w.z = cvt_pk_bf16(v1[0], v1[1]); w.w = cvt_pk_bf16(v1[2], v1[3]);
                    *(u32x4*)(O + row * 2048 + col0 + bj * 128) = w; }
        }
    }
};
struct EpiResid {
    static constexpr bool PERM = false, FP8 = false;
    float* XR; float* XC; const float* modl;
    __device__ __forceinline__ void operator()(const AccT& acc, const pg8::Unit& u, int wr, int wc, int fr, int fq) const {
        const int row0 = u.pm * 256 + wr * 64 + fr, col0 = u.pn * 256 + wc * 32 + 4 * fq;
        const int mb = u.pm < 128 ? (u.pm >> 3) : 16;
        const float* gv = modl + (size_t)mb * NMOD + col0;
        float* basep = u.pm < 128 ? XR : (XC - (size_t)TL * D);
        f32x4 gvv[2][2];
#pragma unroll
        for (int bj = 0; bj < 2; ++bj)
#pragma unroll
            for (int n = 0; n < 2; ++n) gvv[bj][n] = *(const f32x4*)(gv + bj * 128 + n * 16);
#pragma unroll
        for (int ai = 0; ai < 2; ++ai) {
            f32x4 xo[4][2][2];
#pragma unroll
            for (int m = 0; m < 4; ++m)
#pragma unroll
                for (int bj = 0; bj < 2; ++bj)
#pragma unroll
                    for (int n = 0; n < 2; ++n) xo[m][bj][n] = *(const f32x4*)(basep + (size_t)(row0 + ai * 128 + m * 16) * D + col0 + bj * 128 + n * 16);
#pragma unroll
            for (int m = 0; m < 4; ++m)
#pragma unroll
                for (int bj = 0; bj < 2; ++bj)
#pragma unroll
                    for (int n = 0; n < 2; ++n) *(f32x4*)(basep + (size_t)(row0 + ai * 128 + m * 16) * D + col0 + bj * 128 + n * 16) = xo[m][bj][n] + gvv[bj][n] * acc[ai][bj][m][n];
        }
    }
};
struct EpiF32 {
    static constexpr bool PERM = false, FP8 = false;
    float* C; int ldc;
    __device__ __forceinline__ void operator()(const AccT& acc, const pg8::Unit& u, int wr, int wc, int fr, int fq) const {
        const int row0 = u.pm * 256 + wr * 64 + fr, col0 = u.pn * 256 + wc * 32 + 4 * fq;
#pragma unroll
        for (int ai = 0; ai < 2; ++ai)
#pragma unroll
            for (int m = 0; m < 4; ++m) {
                float* rowp = C + (size_t)(row0 + ai * 128 + m * 16) * ldc + col0;
#pragma unroll
                for (int bj = 0; bj < 2; ++bj)
#pragma unroll
                    for (int n = 0; n < 2; ++n) *(f32x4*)(rowp + bj * 128 + n * 16) = acc[ai][bj][m][n];
            }
    }
};

template <class Epi>
__device__ __forceinline__ void run_gemm(LAS unsigned char* lds, const bf16_t* A, const bf16_t* Bt, int M, int N, int K, const Epi& E) {
    pg8::Gemm g{A, Bt, M, N, K};
    pg8::StaticOrder S; S.init(M, N, (int)gridDim.x, (int)blockIdx.x);
    pg8::gemm_phase<Epi, pg8::StaticOrder>(lds, g, S, E);
}

__device__ __forceinline__ void phase_mod(const Params& p, LAS unsigned char* lds) {
    const int tid_ = otid();
    LAS float* cs = (LAS float*)lds;
    LAS float* red = (LAS float*)(lds + 2048 * 17 * 4);
    const int tid = tid_;
    float* modv = (float*)(p.ws + OFF_MODV);
    if ((int)blockIdx.x >= 96) return;
    for (int i = tid; i < 17 * 2048; i += NTHREADS) { const int r = i >> 11, k = i & 2047; const float c = r < 16 ? p.c[r * 2048 + k] : p.c_ctx[k]; cs[k * 17 + r] = c / (1.0f + __expf(-c)); }
    __syncthreads();
    for (int u = blockIdx.x; u < 96; u += gridDim.x) {
        const int l = u / 48, col = (u % 48) * 256 + (tid & 255), half = tid >> 8;
        const float* w = p.w_mod + (size_t)l * 2048 * NMOD + col;
        float acc[17];
#pragma unroll
        for (int r = 0; r < 17; ++r) acc[r] = 0.f;
        const int k0 = half * 1024;
#pragma unroll 4
        for (int k = k0; k < k0 + 1024; ++k) {
            const float wv = w[(size_t)k * NMOD];
#pragma unroll
            for (int r = 0; r < 17; ++r) acc[r] += cs[k * 17 + r] * wv;
        }
        if (half == 1) {
#pragma unroll
            for (int r = 0; r < 17; ++r) red[(tid & 255) * 17 + r] = acc[r];
        }
        __syncthreads();
        if (half == 0) { const float b = p.b_mod[l * NMOD + col];
#pragma unroll
            for (int r = 0; r < 17; ++r) modv[(size_t)(l * 17 + r) * NMOD + col] = acc[r] + red[(tid & 255) * 17 + r] + b; }
        __syncthreads();
    }
}
__device__ __forceinline__ void phase_prep(const Params& p) {
    const int tid_ = otid();
    const int gt = blockIdx.x * NTHREADS + tid_, nt = gridDim.x * NTHREADS;
    float* lb = (float*)(p.ws + OFF_LB);
    for (int i = gt; i < 2 * 1024; i += nt) { const float x0 = p.lb_logits[i], x1 = p.lb_logits[2048 + i]; lb[i] = 0.f; lb[2048 + i] = 1.0f / (1.0f + expf(x0 - x1)); }
    float* s5lam = (float*)(p.ws + OFF_S5LAM); float* s5bb = (float*)(p.ws + OFF_S5BB);
    for (int i = gt; i < 2 * 2 * 48 * 64; i += nt) {
        const int ldg = i >> 6;
        const double lre = (double)p.lam_re[i], lim = (double)p.lam_im[i], dt = exp((double)p.log_step[ldg]);
        const double er = exp(lre * dt); double sn, cs; sincos(lim * dt, &sn, &cs);
        const double br = er * cs, bi = er * sn;
        s5lam[i * 2] = (float)br; s5lam[i * 2 + 1] = (float)bi;
        const double nr = br - 1.0, ni = bi, den = lre * lre + lim * lim;
        const double cr = (nr * lre + ni * lim) / den, ci = (ni * lre - nr * lim) / den;
        for (int d = 0; d < 16; ++d) { const double xr = (double)p.b_re[(size_t)i * 16 + d], xi = (double)p.b_im[(size_t)i * 16 + d];
            s5bb[(size_t)i * 32 + d] = (float)(cr * xr - ci * xi); s5bb[(size_t)i * 32 + 16 + d] = (float)(cr * xi + ci * xr); }
    }
    float* pe = (float*)(p.ws + OFF_PE);
    for (int i = gt; i < 96 * 1024; i += nt) {
        const int r = i >> 10, cc = i & 1023, j = cc & 511;
        const float pos = (float)(r < 32 ? r : r - 32);
        const float omega = 1.0f / powf(10000.0f, (float)j * (1.0f / 512.0f));
        const float ang = pos * omega;
        pe[i] = cc < 512 ? sinf(ang) : cosf(ang);
    }
}

template <int MAPMODE>
__device__ __forceinline__ void transpose_convert(const float* src, int K, int N, bf16_t* dst, LAS unsigned char* lds) {
    const int tid_ = otid();
    LAS float* tile = (LAS float*)lds;
    const int tid = tid_, nkb = K / 64, nnb = N / 64;
    for (int u = blockIdx.x; u < nkb * nnb; u += gridDim.x) {
        const int kb = u / nnb, nb = u % nnb, k0 = kb * 64, n0 = nb * 64;
        { const int nn = tid & 63, kk = tid >> 6;
#pragma unroll
          for (int i = 0; i < 8; ++i) tile[(kk + i * 8) * 65 + nn] = src[(size_t)(k0 + kk + i * 8) * N + n0 + nn]; }
        __syncthreads();
        { const int kk2 = (tid & 7) * 8, nn2 = tid >> 3; float v[8];
#pragma unroll
          for (int i = 0; i < 8; ++i) v[i] = tile[(kk2 + i) * 65 + nn2];
          int n = n0 + nn2, nr;
          if (MAPMODE == 1) { if (n < 768) nr = (n >> 7) * 256 + (n & 127); else { const int m = n - 768; nr = (m >> 7) * 256 + 128 + (m & 127); } } else nr = n;
          u32x4 w; w.x = cvt_pk_bf16(v[0], v[1]); w.y = cvt_pk_bf16(v[2], v[3]); w.z = cvt_pk_bf16(v[4], v[5]); w.w = cvt_pk_bf16(v[6], v[7]);
          *(u32x4*)(dst + (size_t)nr * K + k0 + kk2) = w; }
        __syncthreads();
    }
}
__device__ __forceinline__ void phase_wscore(const float* wq, const float* sk, bf16_t* dst, LAS unsigned char* lds) {
    const int tid_ = otid();
    LAS float* skt = (LAS float*)lds;
    LAS float* wqt = (LAS float*)(lds + 128 * 129 * 4);
    const int tid = tid_;
    for (int u = blockIdx.x; u < 16 * 32; u += gridDim.x) {
        const int hp = u >> 5, kb = u & 31;
        for (int i = tid; i < 128 * 128; i += NTHREADS) { const int key = i >> 7, e = i & 127; skt[key * 129 + e] = sk[(size_t)hp * 16384 + i]; }
        for (int i = tid; i < 64 * 128; i += NTHREADS) { const int k = i >> 7, e = i & 127; wqt[e * 68 + k] = wq[(size_t)(kb * 64 + k) * 2048 + hp * 128 + e]; }
        __syncthreads();
        const int key = tid & 127, kg = tid >> 7;
        float acc[16];
#pragma unroll
        for (int i = 0; i < 16; ++i) acc[i] = 0.f;
        for (int e = 0; e < 128; ++e) {
            const float s = skt[key * 129 + e];
#pragma unroll
            for (int q = 0; q < 4; ++q) { const f32x4 w4 = *(const LAS f32x4*)(wqt + e * 68 + kg * 16 + q * 4);
                acc[q * 4 + 0] += s * w4[0]; acc[q * 4 + 1] += s * w4[1]; acc[q * 4 + 2] += s * w4[2]; acc[q * 4 + 3] += s * w4[3]; }
        }
        bf16_t* o = dst + (size_t)(hp * 128 + key) * 2048 + kb * 64 + kg * 16;
        u32x4 w0, w1;
        w0.x = cvt_pk_bf16(acc[0], acc[1]); w0.y = cvt_pk_bf16(acc[2], acc[3]); w0.z = cvt_pk_bf16(acc[4], acc[5]); w0.w = cvt_pk_bf16(acc[6], acc[7]);
        w1.x = cvt_pk_bf16(acc[8], acc[9]); w1.y = cvt_pk_bf16(acc[10], acc[11]); w1.z = cvt_pk_bf16(acc[12], acc[13]); w1.w = cvt_pk_bf16(acc[14], acc[15]);
        *(u32x4*)o = w0; *(u32x4*)(o + 8) = w1;
        __syncthreads();
    }
}
__device__ __forceinline__ void phase_colmax(const Params& p) {
    const int tid_ = otid();
    unsigned* cm = (unsigned*)(p.ws + OFF_CMAX);
    const int total = 2 * INC * 16;
    for (int i = blockIdx.x * NTHREADS + tid_; i < total; i += gridDim.x * NTHREADS) {
        const int kc = i / (2 * INC), cidx = i % (2 * INC), l = cidx / INC, n = cidx % INC;
        const float* w = p.w_in + (size_t)l * D * INC + (size_t)(kc * 128) * INC + n;
        float am = 0.f;
#pragma unroll 8
        for (int k = 0; k < 128; ++k) am = fmaxf(am, fabsf(w[(size_t)k * INC]));
        atomicMax(cm + cidx, __float_as_uint(am));
    }
}
__device__ __forceinline__ void transpose_convert_fp8(const float* src, int K, int N, unsigned char* dst, const unsigned* cmax, LAS unsigned char* lds) {
    const int tid_ = otid();
    LAS float* tile = (LAS float*)lds;
    const int tid = tid_, nkb = K / 64, nnb = N / 64;
    for (int u = blockIdx.x; u < nkb * nnb; u += gridDim.x) {
        const int kb = u / nnb, nb = u % nnb, k0 = kb * 64, n0 = nb * 64;
        { const int nn = tid & 63, kk = tid >> 6;
#pragma unroll
          for (int i = 0; i < 8; ++i) tile[(kk + i * 8) * 65 + nn] = src[(size_t)(k0 + kk + i * 8) * N + n0 + nn]; }
        __syncthreads();
        { const int kk2 = (tid & 7) * 8, nn2 = tid >> 3; float v[8];
          const float cmv = __uint_as_float(cmax[n0 + nn2]); const float sc = cmv > 0.f ? 240.0f / cmv : 1.0f;
#pragma unroll
          for (int i = 0; i < 8; ++i) v[i] = tile[(kk2 + i) * 65 + nn2] * sc;
          u32x2 w; w.x = pack_fp8x4(v[0], v[1], v[2], v[3]); w.y = pack_fp8x4(v[4], v[5], v[6], v[7]);
          *(u32x2*)(dst + (size_t)(n0 + nn2) * K + k0 + kk2) = w; }
        __syncthreads();
    }
}
__device__ __forceinline__ void phase_wconv(const Params& p, int l, LAS unsigned char* lds) {
    unsigned char* W = p.ws + OFF_W;
    transpose_convert_fp8(p.w_in + (size_t)l * D * INC, D, INC, W + W_IN, (const unsigned*)(p.ws + OFF_CMAX) + (size_t)l * INC, lds);
    transpose_convert<1>(p.w_glu + (size_t)l * 768 * 1536, 768, 1536, (bf16_t*)(W + W_GLU), lds);
    transpose_convert<0>(p.wa + (size_t)l * 1024 * D, 1024, D, (bf16_t*)(W + W_A), lds);
    transpose_convert<0>(p.wb + (size_t)l * 1024 * D, 1024, D, (bf16_t*)(W + W_B), lds);
    transpose_convert<0>(p.wc + (size_t)l * 768 * D, 768, D, (bf16_t*)(W + W_C), lds);
    transpose_convert<0>(p.wo + (size_t)l * D * D, D, D, (bf16_t*)(W + W_O), lds);
    phase_wscore(p.w_q + (size_t)l * D * D, p.sub_keys + (size_t)l * 16 * 16384, (bf16_t*)(W + W_S), lds);
}
__device__ __forceinline__ void phase_tabconv(const Params& p, int l) {
    const int tid_ = otid();
    const int lane = tid_ & 63, gw = blockIdx.x * 8 + __builtin_amdgcn_readfirstlane(tid_ >> 6), nw = gridDim.x * 8;
    unsigned char* U6 = p.ws + OFF_P + Q_UT; unsigned char* V6 = p.ws + OFF_P + Q_VT;
    float* USC = (float*)(p.ws + OFF_P + Q_USC); float* VSC = (float*)(p.ws + OFF_P + Q_VSC);
    for (int r = gw; r < 32768; r += nw) {
        const bool isv = r >= 16384; const int rr = r & 16383;
        const float* src = (isv ? p.peer_v : p.peer_u) + (size_t)l * 16384 * 2048 + (size_t)rr * 2048;
        f32x4 v[8];
#pragma unroll
        for (int j = 0; j < 8; ++j) v[j] = *(const f32x4*)(src + j * 256 + lane * 4);
        float am = 0.f;
#pragma unroll
        for (int j = 0; j < 8; ++j) am = fmaxf(am, fmaxf(fmaxf(fabsf(v[j][0]), fabsf(v[j][1])), fmaxf(fabsf(v[j][2]), fabsf(v[j][3]))));
#pragma unroll
        for (int o = 32; o >= 1; o >>= 1) am = fmaxf(am, __shfl_xor(am, o));
        const float sc = am > 0.f ? 7.0f / am : 1.0f, inv = am > 0.f ? am * (1.0f / 7.0f) : 1.0f;
        bf16x32_t bv;
#pragma unroll
        for (int j = 0; j < 8; ++j)
#pragma unroll
            for (int c = 0; c < 4; ++c) bv[j * 4 + c] = (__bf16)(v[j][c] * sc);
        const u32x6 pk = __builtin_amdgcn_cvt_scalef32_pk32_fp6_bf16(bv, 1.0f);
        unsigned char* dst = (isv ? V6 : U6) + (size_t)rr * 1536 + lane * 24;
        u32x4 w0; w0.x = pk[0]; w0.y = pk[1]; w0.z = pk[2]; w0.w = pk[3]; u32x2 w1; w1.x = pk[4]; w1.y = pk[5];
        *(u32x4*)dst = w0; *(u32x2*)(dst + 16) = w1;
        if (lane == 0) (isv ? VSC : USC)[rr] = inv;
    }
}

template <int MODE, bool F8OUT = false>
__device__ __forceinline__ void phase_norm(const Params& p, int l, int M, int off_sh, int off_sc) {
    const int tid_ = otid();
    const int lane = tid_ & 63, gw = blockIdx.x * 8 + __builtin_amdgcn_readfirstlane(tid_ >> 6), nw = gridDim.x * 8;
    const float* modv = (const float*)(p.ws + OFF_MODV) + (size_t)l * 17 * NMOD;
    const float* pe = (const float*)(p.ws + OFF_PE);
    float* XC = (float*)(p.ws + OFF_XC);
    bf16_t* H = (bf16_t*)(p.ws + OFF_H);
    for (int r = gw; r < M; r += nw) {
        const bool lat = r < TL;
        const float* src = MODE == 0 ? (lat ? p.x + (size_t)r * D : p.ctx + (size_t)(r - TL) * D) : (lat ? p.out + (size_t)r * D : XC + (size_t)(r - TL) * D);
        f32x4 v[4][2];
#pragma unroll
        for (int j = 0; j < 4; ++j) { v[j][0] = *(const f32x4*)(src + j * 512 + lane * 8); v[j][1] = *(const f32x4*)(src + j * 512 + lane * 8 + 4); }
        if (MODE == 0) {
            if (lat) { const int n = r & 2047, gr = n >> 6, gc = n & 63;
#pragma unroll
                for (int j = 0; j < 4; ++j) { const float* pr = (j < 2) ? pe + (size_t)gr * 1024 + j * 512 + lane * 8 : pe + (size_t)(32 + gc) * 1024 + (j - 2) * 512 + lane * 8;
                    v[j][0] += *(const f32x4*)pr; v[j][1] += *(const f32x4*)(pr + 4); } }
            float* dst = lat ? p.out + (size_t)r * D : XC + (size_t)(r - TL) * D;
#pragma unroll
            for (int j = 0; j < 4; ++j) { *(f32x4*)(dst + j * 512 + lane * 8) = v[j][0]; *(f32x4*)(dst + j * 512 + lane * 8 + 4) = v[j][1]; }
        }
        float ss = 0.f;
#pragma unroll
        for (int j = 0; j < 4; ++j)
#pragma unroll
            for (int h = 0; h < 2; ++h) ss += v[j][h][0] * v[j][h][0] + v[j][h][1] * v[j][h][1] + v[j][h][2] * v[j][h][2] + v[j][h][3] * v[j][h][3];
        ss = wave_sum(ss);
        const float rs = rsqrtf(ss * (1.0f / 2048.0f) + 1e-6f);
        const int mb = lat ? (r >> 11) : 16;
        const float* sh = modv + (size_t)mb * NMOD + off_sh; const float* sc = modv + (size_t)mb * NMOD + off_sc;
        if (F8OUT) {
            float am = 0.f;
#pragma unroll
            for (int j = 0; j < 4; ++j) { const int e = j * 512 + lane * 8;
                const f32x4 s0 = *(const f32x4*)(sc + e), s1 = *(const f32x4*)(sc + e + 4), h0 = *(const f32x4*)(sh + e), h1 = *(const f32x4*)(sh + e + 4);
                v[j][0] = v[j][0] * rs * (s0 + 1.0f) + h0; v[j][1] = v[j][1] * rs * (s1 + 1.0f) + h1;
#pragma unroll
                for (int hh = 0; hh < 2; ++hh) am = fmaxf(am, fmaxf(fmaxf(fabsf(v[j][hh][0]), fabsf(v[j][hh][1])), fmaxf(fabsf(v[j][hh][2]), fabsf(v[j][hh][3])))); }
#pragma unroll
            for (int o = 32; o >= 1; o >>= 1) am = fmaxf(am, __shfl_xor(am, o));
            const float q = am > 0.f ? 240.0f / am : 1.0f;
            unsigned char* H8 = p.ws + OFF_H8 + (size_t)r * D;
#pragma unroll
            for (int j = 0; j < 4; ++j) { u32x2 w; w.x = pack_fp8x4(v[j][0][0] * q, v[j][0][1] * q, v[j][0][2] * q, v[j][0][3] * q); w.y = pack_fp8x4(v[j][1][0] * q, v[j][1][1] * q, v[j][1][2] * q, v[j][1][3] * q);
                *(u32x2*)(H8 + j * 512 + lane * 8) = w; }
            if (lane == 0) ((float*)(p.ws + OFF_HS))[r] = am > 0.f ? am * (1.0f / 240.0f) : 1.0f;
        } else {
#pragma unroll
        for (int j = 0; j < 4; ++j) {
            const int e = j * 512 + lane * 8;
            const f32x4 s0 = *(const f32x4*)(sc + e), s1 = *(const f32x4*)(sc + e + 4), h0 = *(const f32x4*)(sh + e), h1 = *(const f32x4*)(sh + e + 4);
            f32x4 a = v[j][0] * rs * (s0 + 1.0f) + h0, b = v[j][1] * rs * (s1 + 1.0f) + h1;
            u32x4 w; w.x = cvt_pk_bf16(a[0], a[1]); w.y = cvt_pk_bf16(a[2], a[3]); w.z = cvt_pk_bf16(b[0], b[1]); w.w = cvt_pk_bf16(b[2], b[3]);
            *(u32x4*)(H + (size_t)r * D + e) = w;
        }
        }
    }
}
__device__ __forceinline__ bf16x8 mk_bf16x8(unsigned a, unsigned b, unsigned c, unsigned d) { u32x4 q; q.x = a; q.y = b; q.z = c; q.w = d; return __builtin_bit_cast(bf16x8, q); }
__device__ __forceinline__ void phase_hgrn(const Params& p, int l, LAS unsigned char* lds, bool dry = false) {
    const int tid_ = otid();
    const int lane = tid_ & 63, w = __builtin_amdgcn_readfirstlane(tid_ >> 6), q = lane >> 4, m = lane & 15;
    constexpr int OQ = 0, OKH = 4352, OKT = 8704, OIT = 14848, OE = 20992, BUFSZ = 21504, RAWOFF = 2 * 21504, RAWSZ = 3 * 4352;
    unsigned char* P = p.ws + OFF_P;
    const float* lbp = (const float*)(p.ws + OFF_LB) + (size_t)l * 2048;
    const int kch = 16 * w + m;
    for (int u = blockIdx.x; u < 256; u += gridDim.x) {
        const int b = u >> 4, h = (u >> 1) & 7, dir = u & 1;
        const bf16_t* BQ = (const bf16_t*)(P + P_BQ); const bf16_t* BI = (const bf16_t*)(P + P_BI);
        bf16_t* BF = (bf16_t*)(P + (dir ? P_BFB : P_BFF));
        const float lbv = lbp[dir * 1024 + h * 128 + kch];
        f32x4 Sacc[8];
#pragma unroll
        for (int i = 0; i < 8; ++i) Sacc[i] = (f32x4){0.f, 0.f, 0.f, 0.f};
        for (int seg = 0; seg < 2; ++seg) {
            const int len = seg == 0 ? CTXL : SEQ, rbase = seg == 0 ? TL + b * CTXL : b * SEQ, nch = len / 16;
            u32x4 g0 = (u32x4){0u, 0u, 0u, 0u}, g1 = g0;
            const int gs = (tid_ & 255) >> 4, gc8 = (tid_ & 15) * 8;
#define HG_GLOAD(c) do { const int st = (c) * 16 + gs, n = dir ? (len - 1 - st) : st; const size_t o = (size_t)(rbase + n) * 1024 + h * 128 + gc8; \
                if (tid_ < 256) { g0 = *(const u32x4*)(BQ + o); g1 = *(const u32x4*)(BF + o); } else { g0 = *(const u32x4*)(BI + o); } } while (0)
#define HG_RAWW(c) do { LAS unsigned char* rw = lds + RAWOFF + ((c) & 1) * RAWSZ + gs * 272 + gc8 * 2; \
                if (tid_ < 256) { *(LAS u32x4*)(rw) = g0; *(LAS u32x4*)(rw + 4352) = g1; } else { *(LAS u32x4*)(rw + 8704) = g0; } } while (0)
#define HG_STAGE(c, bufp) do { float fv[4], cb[4]; float run = 0.f; unsigned short rq[4], rf[4], ri[4]; \
                { const LAS unsigned char* rr = lds + RAWOFF + ((c) & 1) * RAWSZ + kch * 2; _Pragma("unroll") for (int j = 0; j < 4; ++j) { rq[j] = *(const LAS bf16_t*)(rr + (4 * q + j) * 272); rf[j] = *(const LAS bf16_t*)(rr + 4352 + (4 * q + j) * 272); ri[j] = *(const LAS bf16_t*)(rr + 8704 + (4 * q + j) * 272); } } \
                _Pragma("unroll") for (int j = 0; j < 4; ++j) { const float xf = __uint_as_float(((unsigned)rf[j]) << 16); fv[j] = lbv + (1.0f - lbv) * fast_sigmoid(xf); run += flog(fv[j]); cb[j] = run; } \
                const float t0 = __shfl(run, m), t1 = __shfl(run, m + 16), t2 = __shfl(run, m + 32); \
                const float off = (q > 0 ? t0 : 0.f) + (q > 1 ? t1 : 0.f) + (q > 2 ? t2 : 0.f); \
                float qh[4], kh[4]; \
                _Pragma("unroll") for (int j = 0; j < 4; ++j) { const float bb = off + cb[j], bc = fmaxf(bb, -80.0f); qh[j] = __uint_as_float(((unsigned)rq[j]) << 16) * fexp(bc); kh[j] = (1.0f - fv[j]) * fexp(-bc);     \
                    if (j == 3 && q == 3) *(LAS float*)((bufp) + OE + kch * 4) = fexp(bb); } \
                const unsigned q01 = cvt_pk_bf16(qh[0], qh[1]), q23 = cvt_pk_bf16(qh[2], qh[3]), k01 = cvt_pk_bf16(kh[0], kh[1]), k23 = cvt_pk_bf16(kh[2], kh[3]); \
                *(LAS bf16_t*)((bufp) + OQ + (4 * q + 0) * 272 + kch * 2) = (bf16_t)(q01 & 0xffffu); *(LAS bf16_t*)((bufp) + OQ + (4 * q + 1) * 272 + kch * 2) = (bf16_t)(q01 >> 16); \
                *(LAS bf16_t*)((bufp) + OQ + (4 * q + 2) * 272 + kch * 2) = (bf16_t)(q23 & 0xffffu); *(LAS bf16_t*)((bufp) + OQ + (4 * q + 3) * 272 + kch * 2) = (bf16_t)(q23 >> 16); \
                *(LAS bf16_t*)((bufp) + OKH + (4 * q + 0) * 272 + kch * 2) = (bf16_t)(k01 & 0xffffu); *(LAS bf16_t*)((bufp) + OKH + (4 * q + 1) * 272 + kch * 2) = (bf16_t)(k01 >> 16); \
                *(LAS bf16_t*)((bufp) + OKH + (4 * q + 2) * 272 + kch * 2) = (bf16_t)(k23 & 0xffffu); *(LAS bf16_t*)((bufp) + OKH + (4 * q + 3) * 272 + kch * 2) = (bf16_t)(k23 >> 16); \
                u32x2 kt2; kt2.x = k01; kt2.y = k23; *(LAS u32x2*)((bufp) + OKT + kch * 48 + q * 8) = kt2; \
                u32x2 it2; it2.x = (unsigned)ri[0] | ((unsigned)ri[1] << 16); it2.y = (unsigned)ri[2] | ((unsigned)ri[3] << 16); *(LAS u32x2*)((bufp) + OIT + kch * 48 + q * 8) = it2; } while (0)
#define HG_COMPUTE(c) do { \
                LAS unsigned char* buf = lds + ((c) & 1) * BUFSZ; \
                f32x4 at = (f32x4){0.f, 0.f, 0.f, 0.f}; \
                _Pragma("unroll") \
                for (int kb = 0; kb < 4; ++kb) { const bf16x8 a = *(const LAS bf16x8*)(buf + OKH + m * 272 + kb * 64 + q * 16), bq = *(const LAS bf16x8*)(buf + OQ + m * 272 + kb * 64 + q * 16); \
                    at = __builtin_amdgcn_mfma_f32_16x16x32_bf16(a, bq, at, 0, 0, 0); } \
                asm volatile("s_nop 15\n s_nop 15" : "+v"(at)); \
                _Pragma("unroll") \
                for (int r = 0; r < 4; ++r) at[r] = (4 * q + r <= m) ? at[r] : 0.f; \
                const bf16x8 attB = mk_bf16x8(cvt_pk_bf16(at[0], at[1]), cvt_pk_bf16(at[2], at[3]), 0u, 0u); \
                f32x4 oacc = (f32x4){0.f, 0.f, 0.f, 0.f}; \
                _Pragma("unroll") \
                for (int kb = 0; kb < 4; ++kb) { \
                    const bf16x8 a = mk_bf16x8(cvt_pk_bf16(Sacc[2 * kb][0], Sacc[2 * kb][1]), cvt_pk_bf16(Sacc[2 * kb][2], Sacc[2 * kb][3]), cvt_pk_bf16(Sacc[2 * kb + 1][0], Sacc[2 * kb + 1][1]), cvt_pk_bf16(Sacc[2 * kb + 1][2], Sacc[2 * kb + 1][3])); \
                    const u32x2 b0 = *(const LAS u32x2*)(buf + OQ + m * 272 + (32 * kb + 4 * q) * 2), b1 = *(const LAS u32x2*)(buf + OQ + m * 272 + (32 * kb + 16 + 4 * q) * 2); \
                    oacc = __builtin_amdgcn_mfma_f32_16x16x32_bf16(a, mk_bf16x8(b0.x, b0.y, b1.x, b1.y), oacc, 0, 0, 0); } \
                { const u32x2 i0 = *(const LAS u32x2*)(buf + OIT + (16 * w + m) * 48 + q * 8); \
                  oacc = __builtin_amdgcn_mfma_f32_16x16x32_bf16(mk_bf16x8(i0.x, i0.y, 0u, 0u), attB, oacc, 0, 0, 0); } \
                asm volatile("s_nop 15\n s_nop 15" : "+v"(oacc)); \
                { const int st = (c) * 16 + m, n = dir ? (len - 1 - st) : st; \
                  u32x2 o2; o2.x = cvt_pk_bf16(oacc[0], oacc[1]); o2.y = cvt_pk_bf16(oacc[2], oacc[3]); \
                  if (!dry || p.ws == nullptr) *(u32x2*)(BF + (size_t)(rbase + n) * 1024 + h * 128 + 16 * w + 4 * q) = o2; } \
                u32x4 bsu = (u32x4){0u, 0u, 0u, 0u}; \
                if (q < 2) bsu = *(const LAS u32x4*)(buf + OIT + (16 * w + m) * 48 + q * 16); \
                const bf16x8 bs = __builtin_bit_cast(bf16x8, bsu); \
                _Pragma("unroll") \
                for (int kt = 0; kt < 8; ++kt) { u32x4 au = (u32x4){0u, 0u, 0u, 0u}; \
                    if (q < 2) au = *(const LAS u32x4*)(buf + OKT + (16 * kt + m) * 48 + q * 16); \
                    Sacc[kt] = __builtin_amdgcn_mfma_f32_16x16x32_bf16(__builtin_bit_cast(bf16x8, au), bs, Sacc[kt], 0, 0, 0); } \
                asm volatile("s_nop 15\n s_nop 15" : "+v"(Sacc[0]), "+v"(Sacc[1]), "+v"(Sacc[2]), "+v"(Sacc[3]), "+v"(Sacc[4]), "+v"(Sacc[5]), "+v"(Sacc[6]), "+v"(Sacc[7])); \
                _Pragma("unroll") \
                for (int kt = 0; kt < 8; ++kt) Sacc[kt] *= *(const LAS f32x4*)(buf + OE + (16 * kt + 4 * q) * 4); \
                } while (0)
            HG_GLOAD(0); HG_RAWW(0);
            if (nch > 1) { HG_GLOAD(1); HG_RAWW(1); }
            if (nch > 2) HG_GLOAD(2);
            __syncthreads();
            HG_STAGE(0, lds);
            __syncthreads();
            for (int c = 0; c < nch; ++c) {
                if (c + 2 < nch) { HG_RAWW(c + 2); if (c + 3 < nch) HG_GLOAD(c + 3); }
                if (c + 1 < nch) HG_STAGE(c + 1, lds + ((c + 1) & 1) * BUFSZ);
                HG_COMPUTE(c);
                __syncthreads();
            }
#undef HG_COMPUTE
#undef HG_GLOAD
#undef HG_RAWW
#undef HG_STAGE
        }
        __syncthreads();
    }
}
__device__ __forceinline__ void phase_hcomb(const Params& p, int l, int M, bool dry = false) {
    const int tid_ = otid();
    const int lane = tid_ & 63, gw = blockIdx.x * 8 + __builtin_amdgcn_readfirstlane(tid_ >> 6), nw = gridDim.x * 8;
    unsigned char* P = p.ws + OFF_P;
    bf16_t* OF = (bf16_t*)(P + P_BFF); const bf16_t* OB = (const bf16_t*)(P + P_BFB); const bf16_t* BG = (const bf16_t*)(P + P_BG);
    const float* hg = p.hn_g + (size_t)l * 1024 + lane * 16;
    for (int r = gw; r < M; r += nw) {
        const size_t o = (size_t)r * 1024 + lane * 16;
        float x[16]; float ss = 0.f;
#pragma unroll
        for (int hh = 0; hh < 2; ++hh) { const u32x4 a = *(const u32x4*)(OF + o + hh * 8), bq = *(const u32x4*)(OB + o + hh * 8);
            const unsigned aa[4] = {a.x, a.y, a.z, a.w}, bb[4] = {bq.x, bq.y, bq.z, bq.w};
#pragma unroll
            for (int j = 0; j < 4; ++j) { x[hh * 8 + 2 * j] = bf_lo(aa[j]) + bf_lo(bb[j]); x[hh * 8 + 2 * j + 1] = bf_hi(aa[j]) + bf_hi(bb[j]); } }
#pragma unroll
        for (int j = 0; j < 16; ++j) ss += x[j] * x[j];
        ss += __shfl_xor(ss, 1); ss += __shfl_xor(ss, 2); ss += __shfl_xor(ss, 4);
        const float rs = rsqrtf(ss * (1.0f / 128.0f) + 1e-6f);
#pragma unroll
        for (int hh = 0; hh < 2; ++hh) { const u32x4 gq = *(const u32x4*)(BG + o + hh * 8); const unsigned gg[4] = {gq.x, gq.y, gq.z, gq.w};
            float y[8];
#pragma unroll
            for (int j = 0; j < 4; ++j) { y[2 * j] = x[hh * 8 + 2 * j] * rs * hg[hh * 8 + 2 * j] * bf_lo(gg[j]); y[2 * j + 1] = x[hh * 8 + 2 * j + 1] * rs * hg[hh * 8 + 2 * j + 1] * bf_hi(gg[j]); }
            u32x4 w; w.x = cvt_pk_bf16(y[0], y[1]); w.y = cvt_pk_bf16(y[2], y[3]); w.z = cvt_pk_bf16(y[4], y[5]); w.w = cvt_pk_bf16(y[6], y[7]);
            if (!dry || p.ws == nullptr) *(u32x4*)(OF + o + hh * 8) = w; }
    }
}

__device__ __forceinline__ bf16x8 pack_bf16x8(const float (&v)[8]) {
    const unsigned a = cvt_pk_bf16(v[0], v[1]), b = cvt_pk_bf16(v[2], v[3]), c = cvt_pk_bf16(v[4], v[5]), d = cvt_pk_bf16(v[6], v[7]);
    u32x4 q; q.x = a; q.y = b; q.z = c; q.w = d;
    return __builtin_bit_cast(bf16x8, q);
}
__device__ __forceinline__ void phase_s5(const Params& p, int l, LAS unsigned char* lds) {
    const int tid_ = otid();
    const int lane = tid_ & 63, w = __builtin_amdgcn_readfirstlane(tid_ >> 6);
    if (w >= 6) return;
    LAS float* BU = (LAS float*)(lds + w * 12800);
    LAS unsigned char* XB = lds + w * 12800 + 8448;
    const int lq = lane >> 4, lr = lane & 15;
    const bf16_t* CU = (const bf16_t*)(p.ws + OFF_P + P_CU);
    const float* s5lam = (const float*)(p.ws + OFF_S5LAM); const float* s5bb = (const float*)(p.ws + OFF_S5BB);
    for (int s = w * (int)gridDim.x + (int)blockIdx.x; s < 1536; s += 6 * (int)gridDim.x) {
        const int dir = s & 1, g = (s >> 1) % 48, b = s / 96;
        const int ldg = (l * 2 + dir) * 48 + g;
        const float lre = s5lam[(size_t)(ldg * 64 + lane) * 2], lim = s5lam[(size_t)(ldg * 64 + lane) * 2 + 1];
        bf16x8 bbf[8], cf[4];
#pragma unroll
        for (int nt = 0; nt < 8; ++nt) { const int col = nt * 16 + lr, pp = col >> 1, c = col & 1; float v[8];
#pragma unroll
            for (int j = 0; j < 8; ++j) v[j] = (lq < 2) ? s5bb[(size_t)(ldg * 64 + pp) * 32 + c * 16 + lq * 8 + j] : 0.f;
            bbf[nt] = pack_bf16x8(v); }
#pragma unroll
        for (int kb = 0; kb < 4; ++kb) { float v[8];
#pragma unroll
            for (int j = 0; j < 8; ++j) { const int k = kb * 32 + lq * 8 + j, pp = k >> 1; const size_t ci = ((size_t)ldg * 16 + lr) * 64 + pp;
                v[j] = (k & 1) ? -p.c_im[ci] : p.c_re[ci]; }
            cf[kb] = pack_bf16x8(v); }
        bf16_t* YS = (bf16_t*)(p.ws + OFF_H + (dir ? H_YSB : H_YSF));
        float xr = 0.f, xi = 0.f;
        for (int seg = 0; seg < 2; ++seg) {
            const int len = seg == 0 ? CTXL : SEQ, rbase = seg == 0 ? TL + b * CTXL : b * SEQ, nblk = len / 64;
            u32x4 unext[4];
#pragma unroll
            for (int tt = 0; tt < 4; ++tt) { unext[tt] = (u32x4){0u, 0u, 0u, 0u};
                if (lq < 2) { const int st = tt * 16 + lr, n = dir ? (len - 1 - st) : st; unext[tt] = *(const u32x4*)(CU + (size_t)(rbase + n) * 768 + g * 16 + lq * 8); } }
            for (int blk = 0; blk < nblk; ++blk) {
                u32x4 ucur[4];
#pragma unroll
                for (int tt = 0; tt < 4; ++tt) ucur[tt] = unext[tt];
                if (blk + 1 < nblk && lq < 2) {
#pragma unroll
                    for (int tt = 0; tt < 4; ++tt) { const int st = (blk + 1) * 64 + tt * 16 + lr, n = dir ? (len - 1 - st) : st; unext[tt] = *(const u32x4*)(CU + (size_t)(rbase + n) * 768 + g * 16 + lq * 8); } }
#pragma unroll
                for (int tt = 0; tt < 4; ++tt) {
                    const bf16x8 uf = __builtin_bit_cast(bf16x8, ucur[tt]);
                    f32x4 dd[8];
#pragma unroll
                    for (int nt = 0; nt < 8; ++nt) dd[nt] = __builtin_amdgcn_mfma_f32_16x16x32_bf16(bbf[nt], uf, (f32x4){0.f, 0.f, 0.f, 0.f}, 0, 0, 0);
                    asm volatile("s_nop 15\n s_nop 15" : "+v"(dd[0]), "+v"(dd[1]), "+v"(dd[2]), "+v"(dd[3]), "+v"(dd[4]), "+v"(dd[5]), "+v"(dd[6]), "+v"(dd[7]));
#pragma unroll
                    for (int nt = 0; nt < 8; ++nt) *(LAS f32x4*)(BU + lr * 132 + nt * 16 + lq * 4) = dd[nt];
                    asm volatile("s_waitcnt lgkmcnt(0)" ::: "memory");
                    f32x2 bu[16];
#pragma unroll
                    for (int t = 0; t < 16; ++t) bu[t] = *(const LAS f32x2*)(BU + t * 132 + 2 * lane);
#pragma unroll
                    for (int t = 0; t < 16; ++t) { const float nr = lre * xr - lim * xi + bu[t].x, ni = lre * xi + lim * xr + bu[t].y; xr = nr; xi = ni;
                        *(LAS unsigned*)(XB + t * 272 + lane * 4) = cvt_pk_bf16(xr, xi); }
                    asm volatile("s_waitcnt lgkmcnt(0)" ::: "memory");
                    f32x4 acc = (f32x4){0.f, 0.f, 0.f, 0.f};
#pragma unroll
                    for (int kb = 0; kb < 4; ++kb) { const bf16x8 xf = *(const LAS bf16x8*)(XB + lr * 272 + kb * 64 + lq * 16); acc = __builtin_amdgcn_mfma_f32_16x16x32_bf16(cf[kb], xf, acc, 0, 0, 0); }
                    asm volatile("s_nop 15\n s_nop 15\n s_waitcnt lgkmcnt(0)" : "+v"(acc) :: "memory");
                    const int st = blk * 64 + tt * 16 + lr, n = dir ? (len - 1 - st) : st;
                    u32x2 o; o.x = cvt_pk_bf16(acc[0], acc[1]); o.y = cvt_pk_bf16(acc[2], acc[3]);
                    *(u32x2*)(YS + (size_t)(rbase + n) * 768 + g * 16 + lq * 4) = o;
                }
            }
        }
    }
}
__device__ __forceinline__ void phase_s5post(const Params& p, int l, int M, bool dry = false) {
    const int tid_ = otid();
    const size_t n8 = (size_t)M * 768 / 8;
    bf16_t* YF = (bf16_t*)(p.ws + OFF_H + H_YSF); const bf16_t* YB = (const bf16_t*)(p.ws + OFF_H + H_YSB); const bf16_t* CU = (const bf16_t*)(p.ws + OFF_P + P_CU);
    const float* dsk = p.s5_d + (size_t)l * 768;
    for (size_t i = (size_t)blockIdx.x * NTHREADS + tid_; i < n8; i += (size_t)gridDim.x * NTHREADS) {
        const int c = (int)((i * 8) % 768);
        const u32x4 a = *(const u32x4*)(YF + i * 8), bq = *(const u32x4*)(YB + i * 8), uq = *(const u32x4*)(CU + i * 8);
        const unsigned aa[4] = {a.x, a.y, a.z, a.w}, bb[4] = {bq.x, bq.y, bq.z, bq.w}, uu[4] = {uq.x, uq.y, uq.z, uq.w};
        float y[8];
#pragma unroll
        for (int j = 0; j < 4; ++j) { y[2 * j] = gelu_f(bf_lo(aa[j]) + bf_lo(bb[j]) + dsk[c + 2 * j] * bf_lo(uu[j])); y[2 * j + 1] = gelu_f(bf_hi(aa[j]) + bf_hi(bb[j]) + dsk[c + 2 * j + 1] * bf_hi(uu[j])); }
        u32x4 w; w.x = cvt_pk_bf16(y[0], y[1]); w.y = cvt_pk_bf16(y[2], y[3]); w.z = cvt_pk_bf16(y[4], y[5]); w.w = cvt_pk_bf16(y[6], y[7]);
        if (!dry || p.ws == nullptr) *(u32x4*)(YF + i * 8) = w;
    }
}

__device__ __forceinline__ void phase_gmlp(const Params& p, int l, int M, LAS unsigned char* lds, bool dry = false) {
    const int tid_ = otid();
    LAS unsigned char* Wb = lds;
    LAS unsigned char* Vt = lds + 34816;
    LAS float* st = (LAS float*)(lds + 69632);
    const int tid = tid_, lane = tid & 63, w = __builtin_amdgcn_readfirstlane(tid_ >> 6), q = lane >> 4, m = lane & 15;
    bf16_t* AU = (bf16_t*)(p.ws + OFF_P + P_AU); const bf16_t* AV = (const bf16_t*)(p.ws + OFF_P + P_AV);
    const float* lng = p.ln_g + (size_t)l * 1024; const float* lnb = p.ln_b + (size_t)l * 1024;
    for (int u = blockIdx.x; u < M / 128; u += gridDim.x) {
        const size_t r0 = (size_t)u * 128;
        for (int i = 0; i < 16; ++i) {
            const int s = w * 16 + i; const bf16_t* rp = AV + (r0 + s) * 1024 + lane * 16;
            const u32x4 a = *(const u32x4*)rp, bq = *(const u32x4*)(rp + 8);
            const unsigned aa[8] = {a.x, a.y, a.z, a.w, bq.x, bq.y, bq.z, bq.w};
            float sm = 0.f, sq = 0.f;
#pragma unroll
            for (int j = 0; j < 8; ++j) { const float x0 = bf_lo(aa[j]), x1 = bf_hi(aa[j]); sm += x0 + x1; sq += x0 * x0 + x1 * x1; }
            sm = wave_sum(sm); sq = wave_sum(sq);
            const float mean = sm * (1.0f / 1024.0f), var = fmaxf(sq * (1.0f / 1024.0f) - mean * mean, 0.f);
            if (lane == 0) { st[s * 2] = mean; st[s * 2 + 1] = rsqrtf(var + 1e-6f); }
        }
        __syncthreads();
        for (int g = 0; g < 8; ++g) {
            { const int t = tid >> 2, s0 = (tid & 3) * 32; const float* ws = p.w_s + ((size_t)l * 8 + g) * 16384 + t * 128 + s0;
#pragma unroll
              for (int qq = 0; qq < 4; ++qq) { const f32x4 a = *(const f32x4*)(ws + qq * 8), b4 = *(const f32x4*)(ws + qq * 8 + 4);
                  u32x4 o; o.x = cvt_pk_bf16(a[0], a[1]); o.y = cvt_pk_bf16(a[2], a[3]); o.z = cvt_pk_bf16(b4[0], b4[1]); o.w = cvt_pk_bf16(b4[2], b4[3]);
                  *(LAS u32x4*)(Wb + t * 272 + (s0 + qq * 8) * 2) = o; } }
            { const int s = tid >> 2, c0 = (tid & 3) * 32; const bf16_t* rp = AV + (r0 + s) * 1024 + g * 128 + c0;
              const float mean = st[s * 2], rstd = st[s * 2 + 1];
#pragma unroll
              for (int qq = 0; qq < 4; ++qq) { const u32x4 a = *(const u32x4*)(rp + qq * 8); const unsigned aa[4] = {a.x, a.y, a.z, a.w};
#pragma unroll
                  for (int j = 0; j < 4; ++j) { const int cl = c0 + qq * 8 + 2 * j, c = g * 128 + cl;
                      const unsigned pk = cvt_pk_bf16((bf_lo(aa[j]) - mean) * rstd * lng[c] + lnb[c], (bf_hi(aa[j]) - mean) * rstd * lng[c + 1] + lnb[c + 1]);
                      *(LAS bf16_t*)(Vt + cl * 272 + s * 2) = (bf16_t)(pk & 0xffffu); *(LAS bf16_t*)(Vt + (cl + 1) * 272 + s * 2) = (bf16_t)(pk >> 16); } } }
            __syncthreads();
            bf16x8 af[4];
#pragma unroll
            for (int kb = 0; kb < 4; ++kb) af[kb] = *(const LAS bf16x8*)(Vt + (16 * w + m) * 272 + kb * 64 + q * 16);
            const float* bs = p.b_s + ((size_t)l * 8 + g) * 128;
#pragma unroll
            for (int tt = 0; tt < 8; ++tt) {
                f32x4 acc = (f32x4){0.f, 0.f, 0.f, 0.f};
#pragma unroll
                for (int kb = 0; kb < 4; ++kb) acc = __builtin_amdgcn_mfma_f32_16x16x32_bf16(af[kb], *(const LAS bf16x8*)(Wb + (16 * tt + m) * 272 + kb * 64 + q * 16), acc, 0, 0, 0);
                const float bb = bs[16 * tt + m];
                bf16_t* up = AU + (r0 + 16 * tt + m) * 1024 + g * 128 + 16 * w + 4 * q;
                const u32x2 uw = *(const u32x2*)up;
                const float y0 = (acc[0] + bb) * bf_lo(uw.x), y1 = (acc[1] + bb) * bf_hi(uw.x), y2 = (acc[2] + bb) * bf_lo(uw.y), y3 = (acc[3] + bb) * bf_hi(uw.y);
                u32x2 o; o.x = cvt_pk_bf16(y0, y1); o.y = cvt_pk_bf16(y2, y3);
                if (!dry || p.ws == nullptr) *(u32x2*)up = o;
            }
            __syncthreads();
        }
    }
}

__device__ __forceinline__ unsigned fkey(float x) { const unsigned b = __float_as_uint(x); return b ^ ((b >> 31) ? 0xFFFFFFFFu : 0x80000000u); }
__device__ __forceinline__ int mbcnt64(unsigned long long m) { return __builtin_amdgcn_mbcnt_hi((unsigned)(m >> 32), __builtin_amdgcn_mbcnt_lo((unsigned)m, 0u)); }
template <int NV>
__device__ __forceinline__ int count_ge(const unsigned (&k)[NV], unsigned cand) {
    int cnt = 0;
#pragma unroll
    for (int i = 0; i < NV; ++i) cnt += __popcll(__ballot(k[i] >= cand));
    return cnt;
}
template <int NV>
__device__ __forceinline__ unsigned radix_thr16(const unsigned (&k)[NV], unsigned e0bits) {
    unsigned prefix = 0u; int bit = 31;
    {
        const unsigned c0 = e0bits ^ 0x80000000u, c1 = c0 + 0x00800000u, c2 = c0 + 0x01000000u, c3 = c0 + 0x01800000u;
        const int n0 = count_ge<NV>(k, c0), n1 = count_ge<NV>(k, c1), n2 = count_ge<NV>(k, c2), n3 = count_ge<NV>(k, c3);
        if (n0 >= 16 && n3 < 16) { prefix = (n2 >= 16) ? c2 : ((n1 >= 16) ? c1 : c0); bit = 22;
            const int nn = (n2 >= 16) ? n2 : ((n1 >= 16) ? n1 : n0); if (nn == 16) bit = -1; }
    }
    for (; bit >= 0; --bit) {
        const unsigned cand = prefix | (1u << bit);
        const int cnt = count_ge<NV>(k, cand);
        if (cnt >= 16) prefix = cand;
        if (cnt == 16) break;
    }
    return prefix;
}
__device__ __forceinline__ unsigned umin_(unsigned a, unsigned b) { return a < b ? a : b; }
__device__ __forceinline__ unsigned umax_(unsigned a, unsigned b) { return a > b ? a : b; }
__device__ __forceinline__ unsigned med3u(unsigned x, unsigned y, unsigned z) { return umax_(umin_(x, y), umin_(umax_(x, y), z)); }
__device__ __forceinline__ float unkey(unsigned k) { return __uint_as_float((k & 0x80000000u) ? (k ^ 0x80000000u) : ~k); }
__device__ __forceinline__ void ins16(unsigned (&a)[16], unsigned x) {
#pragma unroll
    for (int s = 15; s >= 1; --s) a[s] = med3u(a[s - 1], x, a[s]);
    a[0] = umax_(a[0], x);
}
__device__ __forceinline__ unsigned sel16(const unsigned (&a)[16], int i) {
    unsigned r = a[0];
#pragma unroll
    for (int t = 1; t < 16; ++t) r = (i == t) ? a[t] : r;
    return r;
}
__device__ __forceinline__ void phase_topk(const Params& p, int M, LAS unsigned char* lds) {
    const int tid_ = otid();
    LAS unsigned* lk = (LAS unsigned*)lds + tid_;
    const int gl = blockIdx.x * NTHREADS + tid_, nl = gridDim.x * NTHREADS;
    const float* SC = (const float*)(p.ws + OFF_P + Q_SC);
    int* IDX = (int*)(p.ws + OFF_P + Q_IDX); float* GATE = (float*)(p.ws + OFF_P + Q_GATE);
    const int ntask = M * 8;
    for (int task = gl; task < ntask; task += nl) {
        const float* sc = SC + (size_t)task * 256;
        unsigned a[16], b[16];
#pragma unroll
        for (int i = 0; i < 16; ++i) { a[i] = 0u; b[i] = 0u; }
#pragma unroll 4
        for (int i4 = 0; i4 < 32; ++i4) {
            const f32x4 va = *(const f32x4*)(sc + i4 * 4), vb = *(const f32x4*)(sc + 128 + i4 * 4);
#pragma unroll
            for (int e = 0; e < 4; ++e) { const unsigned tag = 127u - (unsigned)(i4 * 4 + e);
                ins16(a, (fkey(va[e]) & ~127u) | tag); ins16(b, (fkey(vb[e]) & ~127u) | tag); }
        }
        float fa[16], fb[16];
#pragma unroll
        for (int i = 0; i < 16; ++i) { fa[i] = unkey(a[i] & ~127u); fb[i] = unkey(b[i] & ~127u); }
        unsigned c[16];
#pragma unroll
        for (int i = 0; i < 16; ++i) c[i] = 0u;
#pragma unroll
        for (int i = 0; i < 16; ++i)
#pragma unroll
            for (int j = 0; j < 16; ++j)
                if ((i + 1) * (j + 1) <= 16) ins16(c, (fkey(fa[i] + fb[j]) & ~255u) | (unsigned)(i * 16 + j));
#pragma unroll
        for (int i = 0; i < 16; ++i) { lk[i * 512] = a[i]; lk[(16 + i) * 512] = b[i]; }
        const float mx = unkey(c[0] & ~255u);
        float ev[16]; float sm = 0.f; int id[16];
#pragma unroll
        for (int s = 0; s < 16; ++s) { ev[s] = __expf(unkey(c[s] & ~255u) - mx); sm += ev[s];
            const int ij = (int)(c[s] & 255u);
            const unsigned ka = lk[(ij >> 4) * 512], kb = lk[(16 + (ij & 15)) * 512];
            id[s] = (int)(127u - (ka & 127u)) * 128 + (int)(127u - (kb & 127u)); }
        const float inv = 1.0f / sm;
#pragma unroll
        for (int q = 0; q < 4; ++q) {
            u32x4 iw; iw.x = (unsigned)id[4 * q]; iw.y = (unsigned)id[4 * q + 1]; iw.z = (unsigned)id[4 * q + 2]; iw.w = (unsigned)id[4 * q + 3];
            *(u32x4*)(IDX + (size_t)task * 16 + q * 4) = iw;
            *(f32x4*)(GATE + (size_t)task * 16 + q * 4) = (f32x4){ev[4 * q] * inv, ev[4 * q + 1] * inv, ev[4 * q + 2] * inv, ev[4 * q + 3] * inv};
        }
    }
}

__device__ __forceinline__ float dot2u(unsigned a, unsigned b, float acc) {
    return __builtin_amdgcn_fdot2_f32_bf16(__builtin_bit_cast(bf16x2_t, a), __builtin_bit_cast(bf16x2_t, b), acc, false);
}
__device__ __forceinline__ float dot8(const u32x4 a, const u32x4 b, float acc) {
    acc = dot2u(a.x, b.x, acc); acc = dot2u(a.y, b.y, acc); acc = dot2u(a.z, b.z, acc); acc = dot2u(a.w, b.w, acc);
    return acc;
}
__device__ __forceinline__ void phase_peer(const Params& p, int l, int M, LAS unsigned char* lds, bool dry = false) {
    const int tid_ = otid();
    const int lane = tid_ & 63, wv_ = __builtin_amdgcn_readfirstlane(tid_ >> 6), gw = blockIdx.x * 8 + wv_, nw = gridDim.x * 8;
    LAS float* wl = (LAS float*)(lds + wv_ * 512);
    const bf16_t* H = (const bf16_t*)(p.ws + OFF_H);
    const unsigned char* U6 = p.ws + OFF_P + Q_UT; const unsigned char* V6 = p.ws + OFF_P + Q_VT;
    const float* USC = (const float*)(p.ws + OFF_P + Q_USC); const float* VSC = (const float*)(p.ws + OFF_P + Q_VSC);
    const int* IDX = (const int*)(p.ws + OFF_P + Q_IDX); const float* GATE = (const float*)(p.ws + OFF_P + Q_GATE);
    const float* modl = (const float*)(p.ws + OFF_MODV) + (size_t)l * 17 * NMOD + 10240;
    float* XC = (float*)(p.ws + OFF_XC);
    const unsigned lane24 = (unsigned)lane * 24u;
#define PEER_LOAD(buf, TAB, g) do { const int _is = ((g) < 8) ? id0 : id1; _Pragma("unroll") for (int e = 0; e < 8; ++e) { \
        const int _id = __builtin_amdgcn_readlane(_is, (((g) * 8 + e) & 63)); const unsigned char* _rb = (TAB) + (size_t)(unsigned)_id * 1536u; \
        const u32x4 _a = *(const u32x4*)(_rb + lane24); const u32x2 _b = *(const u32x2*)(_rb + lane24 + 16); \
        buf[e][0] = _a.x; buf[e][1] = _a.y; buf[e][2] = _a.z; buf[e][3] = _a.w; buf[e][4] = _b.x; buf[e][5] = _b.y; } } while (0)
    for (int row = gw; row < M; row += nw) {
        float xf[32];
#pragma unroll
        for (int j = 0; j < 8; ++j) { const u32x2 a = *(const u32x2*)(H + (size_t)row * D + j * 256 + lane * 4);
            xf[4 * j] = bf_lo(a.x); xf[4 * j + 1] = bf_hi(a.x); xf[4 * j + 2] = bf_lo(a.y); xf[4 * j + 3] = bf_hi(a.y); }
        const int id0 = IDX[(size_t)row * 128 + lane], id1 = IDX[(size_t)row * 128 + 64 + lane];
        const float g0 = GATE[(size_t)row * 128 + lane], g1 = GATE[(size_t)row * 128 + 64 + lane];
        const float us0 = USC[id0], us1 = USC[id1];
        const float gv0 = g0 * VSC[id0], gv1 = g1 * VSC[id1];
        u32x6 bA[8];
#pragma unroll 1
        for (int g = 0; g < 16; ++g) {
            PEER_LOAD(bA, U6, g);
            float part[8];
            float chain = 0.f;
#pragma unroll
            for (int e = 0; e < 8; ++e) { asm volatile("" : "+v"(bA[e]), "+v"(chain));
                const f32x32 un = __builtin_amdgcn_cvt_scalef32_pk32_f32_fp6(bA[e], 1.0f);
                float a0 = 0.f, a1 = 0.f;
#pragma unroll
                for (int i = 0; i < 16; ++i) { a0 += un[2 * i] * xf[2 * i]; a1 += un[2 * i + 1] * xf[2 * i + 1]; }
                part[e] = a0 + a1; chain = part[e]; }
            float r4[4];
#pragma unroll
            for (int i = 0; i < 4; ++i) { const bool hi = (lane & 32) != 0; const float keep = hi ? part[i + 4] : part[i], send = hi ? part[i] : part[i + 4]; r4[i] = keep + __shfl_xor(send, 32); }
            float r2[2];
#pragma unroll
            for (int i = 0; i < 2; ++i) { const bool hi = (lane & 16) != 0; const float keep = hi ? r4[i + 2] : r4[i], send = hi ? r4[i] : r4[i + 2]; r2[i] = keep + __shfl_xor(send, 16); }
            float r1;
            { const bool hi = (lane & 8) != 0; const float keep = hi ? r2[1] : r2[0], send = hi ? r2[0] : r2[1]; r1 = keep + __shfl_xor(send, 8); }
            r1 += __shfl_xor(r1, 4); r1 += __shfl_xor(r1, 2); r1 += __shfl_xor(r1, 1);
            const int k = g * 8 + ((lane >> 3) & 7);
            const float usk = __shfl((g < 8) ? us0 : us1, k & 63), gvk = __shfl((g < 8) ? gv0 : gv1, k & 63);
            if ((lane & 7) == 0) wl[k] = gelu_f(r1 * usk) * gvk;
        }
        asm volatile("s_waitcnt lgkmcnt(0)" ::: "memory");
        float out[32];
#pragma unroll
        for (int i = 0; i < 32; ++i) out[i] = 0.f;
#pragma unroll 1
        for (int g = 0; g < 16; ++g) {
            PEER_LOAD(bA, V6, g);
#pragma unroll
            for (int e = 0; e < 8; ++e) { const float wk = wl[g * 8 + e]; asm volatile("" : "+v"(bA[e]), "+v"(out[0]), "+v"(out[9]), "+v"(out[18]), "+v"(out[27]), "+v"(out[31]));
                const f32x32 un = __builtin_amdgcn_cvt_scalef32_pk32_f32_fp6(bA[e], 1.0f);
#pragma unroll
                for (int i = 0; i < 32; ++i) out[i] += wk * un[i]; }
        }
        asm volatile("s_waitcnt lgkmcnt(0)" ::: "memory");
        const bool lat = row < TL; const int mb = lat ? (row >> 11) : 16;
        float* xp = lat ? p.out + (size_t)row * D : XC + (size_t)(row - TL) * D;
        const float* gv = modl + (size_t)mb * NMOD;
        f32x4 xn[8]; float ss = 0.f;
#pragma unroll
        for (int j = 0; j < 8; ++j) { const int e = j * 256 + lane * 4;
            const f32x4 o4 = (f32x4){out[4 * j], out[4 * j + 1], out[4 * j + 2], out[4 * j + 3]};
            xn[j] = *(const f32x4*)(xp + e) + *(const f32x4*)(gv + e) * o4;
            ss += xn[j][0] * xn[j][0] + xn[j][1] * xn[j][1] + xn[j][2] * xn[j][2] + xn[j][3] * xn[j][3]; }
        ss = wave_sum(ss);
        const float rs = rsqrtf(ss * (1.0f / 2048.0f) + 1e-6f);
        if (!dry || p.ws == nullptr) {
            if (l == 0) {
                const float* m1 = (const float*)(p.ws + OFF_MODV) + (size_t)17 * NMOD + (size_t)mb * NMOD;
                float am = 0.f;
#pragma unroll
                for (int j = 0; j < 8; ++j) { const int e = j * 256 + lane * 4;
                    *(f32x4*)(xp + e) = xn[j];
                    xn[j] = xn[j] * rs * (*(const f32x4*)(m1 + 2048 + e) + 1.0f) + *(const f32x4*)(m1 + e);
                    am = fmaxf(am, fmaxf(fmaxf(fabsf(xn[j][0]), fabsf(xn[j][1])), fmaxf(fabsf(xn[j][2]), fabsf(xn[j][3])))); }
#pragma unroll
                for (int o = 32; o >= 1; o >>= 1) am = fmaxf(am, __shfl_xor(am, o));
                const float qs = am > 0.f ? 240.0f / am : 1.0f;
                unsigned char* H8 = p.ws + OFF_H8 + (size_t)row * D;
#pragma unroll
                for (int j = 0; j < 8; ++j) *(unsigned*)(H8 + j * 256 + lane * 4) = pack_fp8x4(xn[j][0] * qs, xn[j][1] * qs, xn[j][2] * qs, xn[j][3] * qs);
                if (lane == 0) ((float*)(p.ws + OFF_HS))[row] = am > 0.f ? am * (1.0f / 240.0f) : 1.0f;
            } else {
#pragma unroll
                for (int j = 0; j < 8; ++j) { const int e = j * 256 + lane * 4; *(f32x4*)(xp + e) = xn[j] * rs * *(const f32x4*)(p.final_g + e); }
            }
        }
    }
#undef PEER_LOAD
}

__device__ __forceinline__ Params load_params() {
    Params r;
#if defined(__HIP_DEVICE_COMPILE__)
    typedef const unsigned long long __attribute__((address_space(4)))* KP;
    KP k = (KP)__builtin_amdgcn_kernarg_segment_ptr();
    asm volatile("" : "+s"(k));
    void** d = (void**)&r;
#pragma unroll
    for (int i = 0; i < (int)(sizeof(Params) / 8); ++i) d[i] = (void*)(__attribute__((address_space(1))) void*)k[i];
#endif
    return r;
}
#define WSP(off) (p.ws + (off))
template <int l>
__device__ __forceinline__ void mega_layer(LAS unsigned char* lds, const XcdBarrier& bar) {
        const int Mrows = (l == 0) ? TT : TL;
        if (l == 0) {
            { const Params p = load_params(); phase_wconv(p, 0, lds); }
            { const Params p = load_params(); phase_norm<0, true>(p, 0, TT, 0, 2048); }
            xcd_barrier(bar);
        }
        { const Params p = load_params(); EpiInProj E{WSP(OFF_P), (const float*)WSP(OFF_HS), (const unsigned*)WSP(OFF_CMAX) + (size_t)l * INC};
          run_gemm(lds, (const bf16_t*)WSP(OFF_H8), (const bf16_t*)WSP(OFF_W + W_IN), TT, INC, D / 2, E); }
        xcd_barrier(bar);
        { const Params p = load_params(); phase_hgrn(p, l, lds); }
        __syncthreads();
        { const Params p = load_params(); phase_s5(p, l, lds); }
        xcd_barrier(bar);
        { const Params p = load_params(); phase_gmlp(p, l, Mrows, lds); }
        { const Params p = load_params(); phase_hcomb(p, l, Mrows); }
        { const Params p = load_params(); phase_s5post(p, l, Mrows); }
        xcd_barrier(bar);
        { const Params p = load_params(); EpiGlu E{(bf16_t*)WSP(OFF_P + P_CU)}; run_gemm(lds, (const bf16_t*)WSP(OFF_H + H_YSF), (const bf16_t*)WSP(OFF_W + W_GLU), Mrows, 1536, 768, E); }
        { const Params p = load_params(); EpiMerge<true> E{(bf16_t*)WSP(OFF_P + P_MERGED), (const bf16_t*)WSP(OFF_P + P_GATES)}; run_gemm(lds, (const bf16_t*)WSP(OFF_P + P_AU), (const bf16_t*)WSP(OFF_W + W_A), Mrows, D, 1024, E); }
        { const Params p = load_params(); EpiMerge<false> E{(bf16_t*)WSP(OFF_P + P_MERGED), (const bf16_t*)WSP(OFF_P + P_GATES) + 2048}; run_gemm(lds, (const bf16_t*)WSP(OFF_P + P_BFF), (const bf16_t*)WSP(OFF_W + W_B), Mrows, D, 1024, E); }
        xcd_barrier(bar);
        { const Params p = load_params(); EpiMerge<false> E{(bf16_t*)WSP(OFF_P + P_MERGED), (const bf16_t*)WSP(OFF_P + P_GATES) + 4096}; run_gemm(lds, (const bf16_t*)WSP(OFF_P + P_CU), (const bf16_t*)WSP(OFF_W + W_C), Mrows, D, 768, E); }
        xcd_barrier(bar);
        { const Params p = load_params(); EpiResid E{p.out, (float*)WSP(OFF_XC), (const float*)WSP(OFF_MODV) + (size_t)l * 17 * NMOD + 4096}; run_gemm(lds, (const bf16_t*)WSP(OFF_P + P_MERGED), (const bf16_t*)WSP(OFF_W + W_O), Mrows, D, D, E); }
        { const Params p = load_params(); phase_tabconv(p, l); }
        xcd_barrier(bar);
        { const Params p = load_params(); phase_norm<1>(p, l, Mrows, 6144, 8192); }
        xcd_barrier(bar);
        { const Params p = load_params(); EpiF32 E{(float*)WSP(OFF_P + Q_SC), 2048}; run_gemm(lds, (const bf16_t*)WSP(OFF_H), (const bf16_t*)WSP(OFF_W + W_S), Mrows, D, D, E); }
        xcd_barrier(bar);
        { const Params p = load_params(); phase_topk(p, Mrows, lds); }
        xcd_barrier(bar);
        { const Params p = load_params(); phase_peer(p, l, Mrows, lds); }
        if (l == 0) {
            __syncthreads();
            { const Params p = load_params(); phase_wconv(p, 1, lds); }
            xcd_barrier(bar);
        }
}
#undef WSP
__global__ void __launch_bounds__(NTHREADS, 2) k_mega(Params p_kernarg_only) {
    extern __shared__ __attribute__((aligned(16))) unsigned char smem[];
    LAS unsigned char* lds = (LAS unsigned char*)smem;
    volatile LAS unsigned* xbw = (volatile LAS unsigned*)(lds + LDS_BYTES - 16);
    if (threadIdx.x == 0) { xbw[0] = 0u; xbw[1] = 0u; xbw[2] = 0u; xbw[3] = 0u; }
    __syncthreads();
    XcdBarrier bar;
    { const Params p = load_params(); bar = xcd_barrier_post((unsigned*)(p.ws + OFF_BAR), xbw); }
#define WSP(off) (p.ws + (off))
    { const Params p = load_params(); phase_colmax(p); }
    { const Params p = load_params(); phase_prep(p); phase_mod(p, lds); }
    xcd_barrier(bar);
    mega_layer<0>(lds, bar);
    mega_layer<1>(lds, bar);
#undef WSP
}

extern "C" void kernel_launch(void* const* d_in, const int* in_sizes, int n_in, void* d_out, int out_size, void* d_ws, size_t ws_size, hipStream_t stream) {
    (void)in_sizes; (void)n_in; (void)out_size; (void)ws_size;
    Params p;
    const float** f = (const float**)&p;
    for (int i = 0; i < 31; ++i) f[i] = (const float*)d_in[i];
    p.out = (float*)d_out; p.ws = (unsigned char*)d_ws;
    static int grid = 0;
    if (!grid) {
        int dev = 0, cus = 0, per_cu = 0;
        (void)hipGetDevice(&dev);
        (void)hipDeviceGetAttribute(&cus, hipDeviceAttributeMultiprocessorCount, dev);
        (void)hipFuncSetAttribute((const void*)k_mega, hipFuncAttributeMaxDynamicSharedMemorySize, LDS_BYTES);
        (void)hipOccupancyMaxActiveBlocksPerMultiprocessor(&per_cu, (const void*)k_mega, NTHREADS, LDS_BYTES);
        grid = (per_cu >= 1 && cus > 0) ? (cus < 256 ? cus : 256) : 256;
    }
    (void)hipMemsetAsync(p.ws + OFF_BAR, 0, XCD_BAR_WORDS * sizeof(unsigned), stream);
    (void)hipMemsetAsync(p.ws + OFF_CMAX, 0, (size_t)2 * INC * sizeof(unsigned), stream);
    hipLaunchKernelGGL(k_mega, dim3(grid), dim3(NTHREADS), LDS_BYTES, stream, p);
}
```

```cpp
#include <hip/hip_runtime.h>
#include <stdint.h>

#define LAS __attribute__((address_space(3)))
typedef unsigned short bf16_t;
typedef short bf16x8 __attribute__((ext_vector_type(8)));
typedef float f32x4 __attribute__((ext_vector_type(4)));
typedef float f32x2 __attribute__((ext_vector_type(2)));
typedef unsigned u32x4 __attribute__((ext_vector_type(4)));
typedef unsigned u32x2 __attribute__((ext_vector_type(2)));
typedef __bf16 bf16x2_t __attribute__((ext_vector_type(2)));
typedef __bf16 bf16x32_t __attribute__((ext_vector_type(32)));
typedef float f32x32 __attribute__((ext_vector_type(32)));
typedef unsigned u32x6 __attribute__((ext_vector_type(6)));
typedef unsigned u32x16 __attribute__((ext_vector_type(16)));

constexpr int D = 2048, NB = 16, SEQ = 2048, CTXL = 256;
constexpr int TL = NB * SEQ;
constexpr int TC = NB * CTXL;
constexpr int TT = TL + TC;
constexpr int INC = 14080;
constexpr int NMOD = 12288;
constexpr int NTHREADS = 512;
constexpr int LDS_BYTES = 160 * 1024;

constexpr size_t OFF_BAR = 0;
constexpr size_t OFF_MODV = 16384;
constexpr size_t OFF_LB = OFF_MODV + (size_t)2 * 17 * NMOD * 4;
constexpr size_t OFF_S5LAM = OFF_LB + 2 * 2 * 1024 * 4;
constexpr size_t OFF_S5BB = OFF_S5LAM + (size_t)2 * 2 * 48 * 64 * 2 * 4;
constexpr size_t OFF_PE = OFF_S5BB + (size_t)2 * 2 * 48 * 64 * 32 * 4;
constexpr size_t OFF_CMAX = (OFF_PE + (size_t)96 * 1024 * 4 + 255) & ~(size_t)255;
constexpr size_t OFF_HS = OFF_CMAX + (size_t)2 * INC * 4;
constexpr size_t OFF_XC = (OFF_HS + (size_t)TT * 4 + 255) & ~(size_t)255;
constexpr size_t OFF_H = OFF_XC + (size_t)TC * D * 4;
constexpr size_t OFF_W = OFF_H + (size_t)TT * D * 2;
constexpr size_t W_IN = 0;
constexpr size_t W_GLU = W_IN + (size_t)INC * D;
constexpr size_t W_A = W_GLU + (size_t)1536 * 768 * 2;
constexpr size_t W_B = W_A + (size_t)2048 * 1024 * 2;
constexpr size_t W_C = W_B + (size_t)2048 * 1024 * 2;
constexpr size_t W_O = W_C + (size_t)2048 * 768 * 2;
constexpr size_t W_S = W_O + (size_t)2048 * 2048 * 2;
constexpr size_t W_TOTAL = W_S + (size_t)2048 * 2048 * 2;
constexpr size_t OFF_P = OFF_W + W_TOTAL;
constexpr size_t SEG = (size_t)TT * 1024 * 2;
constexpr size_t P_AU = 0, P_AV = SEG, P_BQ = 2 * SEG, P_BFF = 3 * SEG, P_BFB = 4 * SEG, P_BI = 5 * SEG, P_BG = 6 * SEG;
constexpr size_t P_CU = 7 * SEG;
constexpr size_t P_GATES = P_CU + (size_t)TT * 768 * 2;
constexpr size_t P_TOTAL = P_GATES + (size_t)TT * 6144 * 2;
constexpr size_t P_MERGED = SEG;
constexpr size_t Q_UT = 0;
constexpr size_t Q_VT = Q_UT + (size_t)16384 * 1536;
constexpr size_t Q_USC = Q_VT + (size_t)16384 * 1536;
constexpr size_t Q_VSC = Q_USC + (size_t)16384 * 4;
constexpr size_t Q_SC = Q_VSC + (size_t)16384 * 4;
constexpr size_t Q_IDX = Q_SC + (size_t)TT * 2048 * 4;
constexpr size_t Q_GATE = Q_IDX + (size_t)TT * 128 * 4;
constexpr size_t H_YSF = 0;
constexpr size_t H_YSB = (size_t)TT * 768 * 2;
constexpr size_t OFF_H8 = OFF_P + P_TOTAL;
constexpr size_t WS_NEEDED = OFF_H8 + (size_t)TT * D;

struct Params {
    const float *x, *c, *ctx, *c_ctx, *w_mod, *b_mod, *w_in, *ln_g, *ln_b, *w_s, *b_s, *lb_logits, *hn_g;
    const float *lam_re, *lam_im, *log_step, *b_re, *b_im, *c_re, *c_im, *s5_d, *w_glu, *wa, *wb, *wc, *wo, *w_q, *sub_keys, *peer_u, *peer_v, *final_g;
    float* out;
    unsigned char* ws;
};

__device__ __forceinline__ float bf_lo(unsigned u) { return __uint_as_float(u << 16); }
__device__ __forceinline__ float bf_hi(unsigned u) { return __uint_as_float(u & 0xffff0000u); }
__device__ __forceinline__ unsigned cvt_pk_bf16(float lo, float hi) { f32x2 v; v.x = lo; v.y = hi; const bf16x2_t b = __builtin_convertvector(v, bf16x2_t); return __builtin_bit_cast(unsigned, b); }
__device__ __forceinline__ float fexp(float x) { return __builtin_amdgcn_exp2f(x * 1.44269504f); }
__device__ __forceinline__ float flog(float x) { return __builtin_amdgcn_logf(x) * 0.693147181f; }
__device__ __forceinline__ float fast_sigmoid(float x) { return __builtin_amdgcn_rcpf(1.0f + fexp(-x)); }
__device__ __forceinline__ float fast_silu(float x) { return x * fast_sigmoid(x); }
__device__ __forceinline__ float gelu_f(float v) {
    const float av = fabsf(v), t = __builtin_amdgcn_rcpf(av * 0.2316418882f + 1.0f);
    float q = t * 0.5307027145f + (-0.7265760135f); q = q * t + 0.7107068705f; q = q * t + (-0.142248368f); q = q * t + 0.127414796f; q = q * t;
    const float e = __builtin_amdgcn_exp2f((v * v) * (-0.72134752044f));
    const float m = v * (q * e);
    return v < 0.f ? m : v - m;
}
__device__ __forceinline__ unsigned pack_fp8x4(float a, float b, float c, float d) {
    int pk = 0; pk = __builtin_amdgcn_cvt_pk_fp8_f32(a, b, pk, false); pk = __builtin_amdgcn_cvt_pk_fp8_f32(c, d, pk, true); return (unsigned)pk;
}
template <int CTRL> __device__ __forceinline__ float dpp_f(float v) { return __int_as_float(__builtin_amdgcn_update_dpp(0, __float_as_int(v), CTRL, 0xF, 0xF, false)); }
__device__ __forceinline__ float row16_max(float v) { v = fmaxf(v, dpp_f<0x128>(v)); v = fmaxf(v, dpp_f<0x124>(v)); v = fmaxf(v, dpp_f<0x122>(v)); v = fmaxf(v, dpp_f<0x121>(v)); return v; }
__device__ __forceinline__ float row16_sum(float v) { v += dpp_f<0x128>(v); v += dpp_f<0x124>(v); v += dpp_f<0x122>(v); v += dpp_f<0x121>(v); return v; }
__device__ __forceinline__ float wave_sum(float v) {
#pragma unroll
    for (int o = 32; o >= 1; o >>= 1) v += __shfl_xor(v, o);
    return v;
}
__device__ __forceinline__ int otid() { int t; asm volatile("v_mov_b32 %0, %1" : "=v"(t) : "v"((int)threadIdx.x)); return t; }


#define XB_TMO      128
#define XB_XCNT(j)  (256  + 64 * (j))
#define XB_XSUB(j)  (1280 + 64 * (j))
#define XB_XGEN(j)  (2304 + 64 * (j))
#define XB_TOP      3328
#define XB_TOPGEN   3392
#define XCD_BAR_WORDS 3456
#define XB_SPIN_CAP (1u << 22)
__device__ __forceinline__ unsigned xb_ld(unsigned* p)              { return __hip_atomic_load(p, __ATOMIC_RELAXED, __HIP_MEMORY_SCOPE_AGENT); }
__device__ __forceinline__ unsigned xb_add(unsigned* p, unsigned v) { return __hip_atomic_fetch_add(p, v, __ATOMIC_RELAXED, __HIP_MEMORY_SCOPE_AGENT); }
__device__ __forceinline__ unsigned xb_xcc_id() { return (unsigned)__builtin_amdgcn_s_getreg((3 << 11) | 20) & 0xFu; }
#define XB_SPIN(cond, bar) do { unsigned _sp = 0; while (cond) { __builtin_amdgcn_s_sleep(1); \
    if ((++_sp & 255u) == 0u) { if (xb_ld(&(bar)[XB_TMO])) break; if (_sp > XB_SPIN_CAP) { atomicAdd(&(bar)[XB_TMO], 1u); break; } } } } while (0)
struct XcdBarrier { unsigned* bar; unsigned x; volatile LAS unsigned* st; };
__device__ __forceinline__ XcdBarrier xcd_barrier_post(unsigned* bar, volatile LAS unsigned* st) {
    XcdBarrier b; b.bar = bar; b.x = xb_xcc_id(); b.st = st;
    if (threadIdx.x == 0) (void)xb_add(&bar[XB_XCNT(b.x)], 1u);
    return b;
}
__device__ __forceinline__ void xcd_barrier_complete(unsigned* bar, unsigned x, unsigned& nloc, unsigned& nx) {
    const unsigned G = gridDim.x * gridDim.y * gridDim.z;
    unsigned sum, cnt, mine, sp = 0u;
    for (;;) {
        sum = 0u; cnt = 0u; mine = 0u;
#pragma unroll
        for (unsigned j = 0; j < 16; ++j) { const unsigned c = xb_ld(&bar[XB_XCNT(j)]); sum += c; cnt += (c > 0u) ? 1u : 0u; mine = (j == x) ? c : mine; }
        if (sum == G) break;
        __builtin_amdgcn_s_sleep(1);
        if ((++sp & 255u) == 0u) { if (xb_ld(&bar[XB_TMO])) break; if (sp > XB_SPIN_CAP) { atomicAdd(&bar[XB_TMO], 1u); break; } }
    }
    nloc = mine > 0u ? mine : 1u; nx = cnt > 0u ? cnt : 1u;
}
__device__ __forceinline__ void xcd_barrier(const XcdBarrier& b) {
    asm volatile("s_waitcnt vmcnt(0)" ::: "memory");
    __syncthreads();
    if (threadIdx.x == 0) {
        unsigned* bar = b.bar;
        __builtin_amdgcn_s_waitcnt(0);
        unsigned nloc = b.st[0], nx = b.st[1];
        if (nloc == 0u) { xcd_barrier_complete(bar, b.x, nloc, nx); b.st[0] = nloc; b.st[1] = nx; }
        const unsigned old = xb_add(&bar[XB_XSUB(b.x)], 1u);
        const unsigned gen = old / nloc;
        if (old + 1u == (gen + 1u) * nloc) {
            __builtin_amdgcn_fence(__ATOMIC_RELEASE, "agent");
            asm volatile("s_waitcnt vmcnt(0)" ::: "memory");
            const unsigned og = xb_add(&bar[XB_TOP], 1u);
            const unsigned tg = og / nx;
            if (og + 1u == (tg + 1u) * nx) xb_add(&bar[XB_TOPGEN], 1u);
            else XB_SPIN(xb_ld(&bar[XB_TOPGEN]) == tg, bar);
            __builtin_amdgcn_fence(__ATOMIC_ACQUIRE, "agent");
            xb_add(&bar[XB_XGEN(b.x)], 1u);
            asm volatile("s_waitcnt vmcnt(0)" ::: "memory");
        } else {
            XB_SPIN(xb_ld(&bar[XB_XGEN(b.x)]) == gen, bar);
            __builtin_amdgcn_fence(__ATOMIC_ACQUIRE, "agent");
            asm volatile("s_waitcnt vmcnt(0)" ::: "memory");
        }
    }
    __syncthreads();
}

namespace pg8 {
constexpr int BM = 256, BK = 64, HALF = 128, HTB = HALF * BK * 2, STAGE_BYTES = 8 * HTB, NXCD = 8, WGM = 8;
__host__ __device__ __forceinline__ int lds_byte(int r, int c) { const int st = (r >> 4) * 2 + (c >> 5), rr = r & 15, cc = c & 31, ob = rr * 64 + cc * 2; return st * 1024 + (ob ^ (((ob >> 9) & 1) << 5)); }
__host__ __device__ __forceinline__ void stage_rc(int b, int& R, int& C) { const int st = b / 1024, sb = b % 1024, swz = sb ^ (((sb >> 9) & 1) << 5); R = (st >> 1) * 16 + swz / 64; C = (st & 1) * 32 + (swz % 64) / 2; }
__host__ __device__ __forceinline__ int perm32(int rho) { const int n = rho >> 4, i = rho & 15; return 8 * (i >> 2) + 4 * n + (i & 3); }
typedef int i32x8 __attribute__((ext_vector_type(8)));
__device__ __forceinline__ i32x8 cat8(const bf16x8 a, const bf16x8 b) { const u32x4 x = __builtin_bit_cast(u32x4, a), y = __builtin_bit_cast(u32x4, b); i32x8 r; r[0] = (int)x.x; r[1] = (int)x.y; r[2] = (int)x.z; r[3] = (int)x.w; r[4] = (int)y.x; r[5] = (int)y.y; r[6] = (int)y.z; r[7] = (int)y.w; return r; }
struct Unit { int pm, pn; };
struct Gemm { const bf16_t* A; const bf16_t* Bt; int M, N, K; };
struct StaticOrder {
    int nM, nN, nwg, G, c;
    __device__ void init(int M, int N, int G_, int c_) { nM = M / BM; nN = N / BM; nwg = nM * nN; G = G_; c = c_; }
    __device__ bool next(int i, Unit& u) const {
        const long L = (long)i * G + c; if (L >= nwg) return false;
        int wgid = (int)L; { const int q = nwg / NXCD, r = nwg % NXCD, xcd = wgid % NXCD, off = wgid / NXCD; wgid = (xcd < r ? xcd * (q + 1) : r * (q + 1) + (xcd - r) * q) + off; }
        const int nig = WGM * nN, gid = wgid / nig, fm = gid * WGM, gsz = (nM - fm) < WGM ? (nM - fm) : WGM;
        u.pm = fm + ((wgid % nig) % gsz); u.pn = (wgid % nig) / gsz; return true;
    }
};

template <class Epi, class Sched>
__device__ __forceinline__ void gemm_phase(LAS unsigned char* lds, const Gemm g, const Sched& S, const Epi& E) {
    const int tid_ = otid();
    const int tid = tid_, wid = __builtin_amdgcn_readfirstlane(tid >> 6), lane = tid & 63, wr = wid >> 2, wc = wid & 3, fr = lane & 15, fq = lane >> 4;
    const int K = g.K, nt = K / BK;
    unsigned voffA[2], voffB[2];
#pragma unroll
    for (int i = 0; i < 2; ++i) { int R, C; stage_rc(tid * 16 + i * 8192, R, C); const int Rb = Epi::PERM ? ((R & ~31) + perm32(R & 31)) : R;
        voffA[i] = (unsigned)(R * K + C) * 2u; voffB[i] = (unsigned)(Rb * K + C) * 2u; }
    const size_t kstep = (size_t)(BK * 2);
    const size_t hstep = (size_t)HALF * K * 2;
    const size_t tstep = 2 * hstep;
    const unsigned ldsw = (unsigned)wid * 1024u;
    const int aoff = lds_byte(wr * 64 + fr, fq * 8), boff = lds_byte(wc * 32 + fr, fq * 8);
    const int aoff8 = lds_byte(wr * 64 + fr, (fq >> 1) * 32 + (fq & 1) * 16), boff8 = lds_byte(wc * 32 + fr, (fq >> 1) * 32 + (fq & 1) * 16);
#define PG8_SA(b, h) (((b) * 2 + (h)) * HTB)
#define PG8_SB(b, h) ((4 + (b) * 2 + (h)) * HTB)
#define PG8_STAGE(bufoff, gbase, voff) do { _Pragma("unroll") for (int _i = 0; _i < 2; ++_i) \
        __builtin_amdgcn_global_load_lds((const unsigned*)((const char*)(gbase) + (voff)[_i]), (LAS unsigned*)(lds + (bufoff) + ldsw + _i * 8192), 16, 0, 0); } while (0)
#define PG8_LDA(dst, b, h) do { if constexpr (Epi::FP8) { _Pragma("unroll") for (int m = 0; m < 4; ++m) dst##8[m] = cat8(*(const LAS bf16x8*)(lds + PG8_SA(b, h) + aoff + m * 2048), *(const LAS bf16x8*)(lds + PG8_SA(b, h) + aoff + m * 2048 + 1024)); } \
        else { _Pragma("unroll") for (int m = 0; m < 4; ++m) _Pragma("unroll") for (int k = 0; k < 2; ++k) dst[m][k] = *(const LAS bf16x8*)(lds + PG8_SA(b, h) + aoff + m * 2048 + k * 1024); } } while (0)
#define PG8_LDB(dst, b, h) do { if constexpr (Epi::FP8) { _Pragma("unroll") for (int n = 0; n < 2; ++n) dst##8[n] = cat8(*(const LAS bf16x8*)(lds + PG8_SB(b, h) + boff + n * 2048), *(const LAS bf16x8*)(lds + PG8_SB(b, h) + boff + n * 2048 + 1024)); } \
        else { _Pragma("unroll") for (int n = 0; n < 2; ++n) _Pragma("unroll") for (int k = 0; k < 2; ++k) dst[n][k] = *(const LAS bf16x8*)(lds + PG8_SB(b, h) + boff + n * 2048 + k * 1024); } } while (0)
#define PG8_MMA(ai, bj, At, Bt) do { __builtin_amdgcn_s_setprio(1); _Pragma("unroll") for (int m = 0; m < 4; ++m) _Pragma("unroll") for (int n = 0; n < 2; ++n) { \
        if constexpr (Epi::FP8) { asm volatile("v_mfma_scale_f32_16x16x128_f8f6f4 %0, %1, %2, %0, %3, %3 op_sel_hi:[0,0,0]" : "+v"(acc[ai][bj][m][n]) : "v"(Bt##8[n]), "v"(At##8[m]), "v"(one_scale)); } \
        else { _Pragma("unroll") for (int k = 0; k < 2; ++k) acc[ai][bj][m][n] = __builtin_amdgcn_mfma_f32_16x16x32_bf16(Bt[n][k], At[m][k], acc[ai][bj][m][n], 0, 0, 0); } } \
        __builtin_amdgcn_s_setprio(0); } while (0)
#define PG8_WAIT_V(n) asm volatile("s_waitcnt vmcnt(" #n ")" ::: "memory")
#define PG8_WAIT_L(n) asm volatile("s_waitcnt lgkmcnt(" #n ")" ::: "memory")
#define PG8_BAR __builtin_amdgcn_s_barrier()
#define PG8_SCHED __builtin_amdgcn_sched_barrier(0)
    Unit cur, nxt; int ui = 0;
    if (!S.next(0, cur)) return;
    f32x4 acc[2][2][4][2];
#pragma unroll
    for (int a = 0; a < 2; ++a)
#pragma unroll
        for (int b = 0; b < 2; ++b)
#pragma unroll
            for (int m = 0; m < 4; ++m)
#pragma unroll
                for (int n = 0; n < 2; ++n) acc[a][b][m][n] = (f32x4){0.f, 0.f, 0.f, 0.f};
    bf16x8 At[4][2], B0[2][2], B1[2][2];
    i32x8 At8[4], B08[2], B18[2];
    const int one_scale = 0x7F7F7F7F;
    const char* cA = (const char*)g.A + (size_t)cur.pm * tstep; const char* cB = (const char*)g.Bt + (size_t)cur.pn * tstep;
    PG8_STAGE(PG8_SB(0, 0), cB, voffB); PG8_STAGE(PG8_SA(0, 0), cA, voffA); PG8_STAGE(PG8_SB(0, 1), cB + hstep, voffB); PG8_STAGE(PG8_SA(0, 1), cA + hstep, voffA);
    if (wr == 1) PG8_BAR;
    PG8_WAIT_V(4); PG8_BAR;
    PG8_STAGE(PG8_SB(1, 0), cB + kstep, voffB); PG8_STAGE(PG8_SA(1, 0), cA + kstep, voffA); PG8_STAGE(PG8_SB(1, 1), cB + hstep + kstep, voffB);
    PG8_WAIT_V(6); PG8_BAR;
    for (;;) {
        const bool has_next = S.next(ui + 1, nxt);
        const char* nA = has_next ? (const char*)g.A + (size_t)nxt.pm * tstep : cA; const char* nB = has_next ? (const char*)g.Bt + (size_t)nxt.pn * tstep : cB;
        for (int t = 0; t < nt; t += 2) {
            const bool last = (t == nt - 2);
            const char* a1 = cA + (size_t)(t + 1) * kstep;
            const char* a2 = last ? nA : cA + (size_t)(t + 2) * kstep; const char* b2 = last ? nB : cB + (size_t)(t + 2) * kstep;
            const char* a3 = a2 + kstep; const char* b3 = b2 + kstep;
            PG8_LDB(B0, 0, 0); PG8_SCHED; PG8_LDA(At, 0, 0); PG8_STAGE(PG8_SA(1, 1), a1 + hstep, voffA);
            PG8_WAIT_L(8); PG8_BAR; PG8_WAIT_L(0); PG8_MMA(0, 0, At, B0); PG8_BAR; PG8_SCHED;
            PG8_LDB(B1, 0, 1); PG8_STAGE(PG8_SB(0, 0), b2, voffB);
            PG8_BAR; PG8_WAIT_L(0); PG8_MMA(0, 1, At, B1); PG8_BAR;
            PG8_LDA(At, 0, 1); PG8_STAGE(PG8_SA(0, 0), a2, voffA);
            PG8_BAR; PG8_WAIT_L(0); PG8_MMA(1, 0, At, B0); PG8_BAR; PG8_SCHED;
            PG8_STAGE(PG8_SB(0, 1), b2 + hstep, voffB);
            PG8_WAIT_V(6); PG8_BAR; PG8_MMA(1, 1, At, B1); PG8_BAR;
            PG8_LDB(B0, 1, 0); PG8_SCHED; PG8_LDA(At, 1, 0); PG8_STAGE(PG8_SA(0, 1), a2 + hstep, voffA);
            PG8_WAIT_L(8); PG8_BAR; PG8_WAIT_L(0); PG8_MMA(0, 0, At, B0); PG8_BAR; PG8_SCHED;
            PG8_LDB(B1, 1, 1); PG8_STAGE(PG8_SB(1, 0), b3, voffB);
            PG8_BAR; PG8_WAIT_L(0); PG8_MMA(0, 1, At, B1); PG8_BAR;
            PG8_LDA(At, 1, 1); PG8_STAGE(PG8_SA(1, 0), a3, voffA);
            PG8_BAR; PG8_WAIT_L(0); PG8_MMA(1, 0, At, B0); PG8_BAR; PG8_SCHED;
            PG8_STAGE(PG8_SB(1, 1), b3 + hstep, voffB);
            PG8_WAIT_V(6); PG8_BAR; PG8_MMA(1, 1, At, B1); PG8_BAR;
        }
        if constexpr (Epi::FP8) asm volatile("s_nop 15\n s_nop 15\n s_nop 15" ::: "memory");
        E(acc, cur, wr, wc, fr, fq);
        if (!has_next) break;
#pragma unroll
        for (int a = 0; a < 2; ++a)
#pragma unroll
            for (int b = 0; b < 2; ++b)
#pragma unroll
                for (int m = 0; m < 4; ++m)
#pragma unroll
                    for (int n = 0; n < 2; ++n) acc[a][b][m][n] = (f32x4){0.f, 0.f, 0.f, 0.f};
        cur = nxt; cA = nA; cB = nB; ++ui;
    }
    PG8_WAIT_V(0);
    if (wr == 0) PG8_BAR;
    PG8_BAR;
#undef PG8_SA
#undef PG8_SB
#undef PG8_STAGE
#undef PG8_LDA
#undef PG8_LDB
#undef PG8_MMA
#undef PG8_WAIT_V
#undef PG8_WAIT_L
#undef PG8_BAR
#undef PG8_SCHED
}
}

typedef f32x4 AccT[2][2][4][2];

struct EpiInProj {
    static constexpr bool PERM = true, FP8 = true;
    unsigned char* P;
    const float* sa;
    const unsigned* cmax;
    __device__ __forceinline__ void operator()(const AccT& acc, const pg8::Unit& u, int wr, int wc, int fr, int fq) const {
        const int pn = u.pn;
        bf16_t* base; int ld, lc, act;
        if (pn < 28) { const int seg = pn >> 2; base = (bf16_t*)(P + (size_t)seg * SEG); ld = 1024; lc = (pn & 3) * 256; act = (seg < 2) ? 1 : ((seg == 2 || seg == 6) ? 2 : 0); }
        else if (pn < 31) { base = (bf16_t*)(P + P_CU); ld = 768; lc = (pn - 28) * 256; act = 0; }
        else { base = (bf16_t*)(P + P_GATES); ld = 6144; lc = (pn - 31) * 256; act = 3; }
        const int row0 = u.pm * 256 + wr * 64 + fr, col0 = lc + wc * 32 + 8 * fq, gcol0 = u.pn * 256 + wc * 32 + 8 * fq;
        f32x4 cs[2][2];
#pragma unroll
        for (int bj = 0; bj < 2; ++bj)
#pragma unroll
            for (int n = 0; n < 2; ++n) { const u32x4 cb = *(const u32x4*)(cmax + gcol0 + bj * 128 + 4 * n);
                cs[bj][n] = (f32x4){__uint_as_float(cb.x), __uint_as_float(cb.y), __uint_as_float(cb.z), __uint_as_float(cb.w)} * (1.0f / 240.0f); }
        float rscv[2][4];
#pragma unroll
        for (int ai = 0; ai < 2; ++ai)
#pragma unroll
            for (int m = 0; m < 4; ++m) rscv[ai][m] = sa[row0 + ai * 128 + m * 16];
#pragma unroll
        for (int ai = 0; ai < 2; ++ai)
#pragma unroll
            for (int m = 0; m < 4; ++m) {
                bf16_t* rowp = base + (size_t)(row0 + ai * 128 + m * 16) * ld + col0;
                const float rsc = rscv[ai][m];
#pragma unroll
                for (int bj = 0; bj < 2; ++bj) {
                    f32x4 v0 = acc[ai][bj][m][0] * (cs[bj][0] * rsc), v1 = acc[ai][bj][m][1] * (cs[bj][1] * rsc);
                    if (act == 1) {
#pragma unroll
                        for (int j = 0; j < 4; ++j) { v0[j] = gelu_f(v0[j]); v1[j] = gelu_f(v1[j]); }
                    } else if (act == 2) {
#pragma unroll
                        for (int j = 0; j < 4; ++j) { v0[j] = fast_silu(v0[j]); v1[j] = fast_silu(v1[j]); }
                    } else if (act == 3) {
#pragma unroll
                        for (int j = 0; j < 4; ++j) { v0[j] = fast_sigmoid(v0[j]); v1[j] = fast_sigmoid(v1[j]); }
                    }
                    u32x4 w; w.x = cvt_pk_bf16(v0[0], v0[1]); w.y = cvt_pk_bf16(v0[2], v0[3]); w.z = cvt_pk_bf16(v1[0], v1[1]); w.w = cvt_pk_bf16(v1[2], v1[3]);
                    *(u32x4*)(rowp + bj * 128) = w;
                }
            }
    }
};
struct EpiGlu {
    static constexpr bool PERM = true, FP8 = false;
    bf16_t* O;
    __device__ __forceinline__ void operator()(const AccT& acc, const pg8::Unit& u, int wr, int wc, int fr, int fq) const {
        const int row0 = u.pm * 256 + wr * 64 + fr, col0 = u.pn * 128 + wc * 32 + 8 * fq;
#pragma unroll
        for (int ai = 0; ai < 2; ++ai)
#pragma unroll
            for (int m = 0; m < 4; ++m) {
                f32x4 v0 = acc[ai][0][m][0], v1 = acc[ai][0][m][1]; const f32x4 g0 = acc[ai][1][m][0], g1 = acc[ai][1][m][1];
#pragma unroll
                for (int j = 0; j < 4; ++j) { v0[j] *= fast_sigmoid(g0[j]); v1[j] *= fast_sigmoid(g1[j]); }
                u32x4 w; w.x = cvt_pk_bf16(v0[0], v0[1]); w.y = cvt_pk_bf16(v0[2], v0[3]); w.z = cvt_pk_bf16(v1[0], v1[1]); w.w = cvt_pk_bf16(v1[2], v1[3]);
                *(u32x4*)(O + (size_t)(row0 + ai * 128 + m * 16) * 768 + col0) = w;
            }
    }
};
template <bool FIRST> struct EpiMerge {
    static constexpr bool PERM = true, FP8 = false;
    bf16_t* O;
    const bf16_t* G;
    __device__ __forceinline__ void operator()(const AccT& acc, const pg8::Unit& u, int wr, int wc, int fr, int fq) const {
        const int row0 = u.pm * 256 + wr * 64 + fr, col0 = u.pn * 256 + wc * 32 + 8 * fq;
#pragma unroll
        for (int ai = 0; ai < 2; ++ai) {
            u32x4 gwv[4][2], owv[4][2];
#pragma unroll
            for (int m = 0; m < 4; ++m)
#pragma unroll
                for (int bj = 0; bj < 2; ++bj) { const size_t row = (size_t)(row0 + ai * 128 + m * 16);
                    gwv[m][bj] = *(const u32x4*)(G + row * 6144 + col0 + bj * 128);
                    if (!FIRST) owv[m][bj] = *(const u32x4*)(O + row * 2048 + col0 + bj * 128); }
#pragma unroll
            for (int m = 0; m < 4; ++m)
#pragma unroll
                for (int bj = 0; bj < 2; ++bj) { const size_t row = (size_t)(row0 + ai * 128 + m * 16);
                    const u32x4 gw = gwv[m][bj];
                    f32x4 v0 = acc[ai][bj][m][0], v1 = acc[ai][bj][m][1];
                    v0[0] *= bf_lo(gw.x); v0[1] *= bf_hi(gw.x); v0[2] *= bf_lo(gw.y); v0[3] *= bf_hi(gw.y);
                    v1[0] *= bf_lo(gw.z); v1[1] *= bf_hi(gw.z); v1[2] *= bf_lo(gw.w); v1[3] *= bf_hi(gw.w);
                    if (!FIRST) { const u32x4 ow = owv[m][bj];
                        v0[0] += bf_lo(ow.x); v0[1] += bf_hi(ow.x); v0[2] += bf_lo(ow.y); v0[3] += bf_hi(ow.y);
                        v1[0] += bf_lo(ow.z); v1[1] += bf_hi(ow.z); v1[2] += bf_lo(ow.w); v1[3] += bf_hi(ow.w); }
                    u32x4 w; w.x = cvt_pk_bf16(v0[0], v0[1]); w.y = cvt_pk_bf16(v0[2], v0[3]); w.z = cvt_pk_bf16(v1[0], v1[1]); w.w = cvt_pk_bf16(v1[2], v1[3]);
                    *(u32x4*)(O + row * 2048 + col0 + bj * 128) = w; }
        }
    }
};
struct EpiResid {
    static constexpr bool PERM = false, FP8 = false;
    float* XR; float* XC; const float* modl;
    __device__ __forceinline__ void operator()(const AccT& acc, const pg8::Unit& u, int wr, int wc, int fr, int fq) const {
        const int row0 = u.pm * 256 + wr * 64 + fr, col0 = u.pn * 256 + wc * 32 + 4 * fq;
        const int mb = u.pm < 128 ? (u.pm >> 3) : 16;
        const float* gv = modl + (size_t)mb * NMOD + col0;
        float* basep = u.pm < 128 ? XR : (XC - (size_t)TL * D);
        f32x4 gvv[2][2];
#pragma unroll
        for (int bj = 0; bj < 2; ++bj)
#pragma unroll
            for (int n = 0; n < 2; ++n) gvv[bj][n] = *(const f32x4*)(gv + bj * 128 + n * 16);
#pragma unroll
        for (int ai = 0; ai < 2; ++ai) {
            f32x4 xo[4][2][2];
#pragma unroll
            for (int m = 0; m < 4; ++m)
#pragma unroll
                for (int bj = 0; bj < 2; ++bj)
#pragma unroll
                    for (int n = 0; n < 2; ++n) xo[m][bj][n] = *(const f32x4*)(basep + (size_t)(row0 + ai * 128 + m * 16) * D + col0 + bj * 128 + n * 16);
#pragma unroll
            for (int m = 0; m < 4; ++m)
#pragma unroll
                for (int bj = 0; bj < 2; ++bj)
#pragma unroll
                    for (int n = 0; n < 2; ++n) *(f32x4*)(basep + (size_t)(row0 + ai * 128 + m * 16) * D + col0 + bj * 128 + n * 16) = xo[m][bj][n] + gvv[bj][n] * acc[ai][bj][m][n];
        }
    }
};
struct EpiF32 {
    static constexpr bool PERM = false, FP8 = false;
    float* C; int ldc;
    __device__ __forceinline__ void operator()(const AccT& acc, const pg8::Unit& u, int wr, int wc, int fr, int fq) const {
        const int row0 = u.pm * 256 + wr * 64 + fr, col0 = u.pn * 256 + wc * 32 + 4 * fq;
#pragma unroll
        for (int ai = 0; ai < 2; ++ai)
#pragma unroll
            for (int m = 0; m < 4; ++m) {
                float* rowp = C + (size_t)(row0 + ai * 128 + m * 16) * ldc + col0;
#pragma unroll
                for (int bj = 0; bj < 2; ++bj)
#pragma unroll
                    for (int n = 0; n < 2; ++n) *(f32x4*)(rowp + bj * 128 + n * 16) = acc[ai][bj][m][n];
            }
    }
};

template <class Epi>
__device__ __forceinline__ void run_gemm(LAS unsigned char* lds, const bf16_t* A, const bf16_t* Bt, int M, int N, int K, const Epi& E) {
    pg8::Gemm g{A, Bt, M, N, K};
    pg8::StaticOrder S; S.init(M, N, (int)gridDim.x, (int)blockIdx.x);
    pg8::gemm_phase<Epi, pg8::StaticOrder>(lds, g, S, E);
}

__device__ __forceinline__ void phase_mod(const Params& p, LAS unsigned char* lds) {
    const int tid_ = otid();
    LAS float* cs = (LAS float*)lds;
    LAS float* red = (LAS float*)(lds + 2048 * 17 * 4);
    const int tid = tid_;
    float* modv = (float*)(p.ws + OFF_MODV);
    if ((int)blockIdx.x >= 96) return;
    for (int i = tid; i < 17 * 2048; i += NTHREADS) { const int r = i >> 11, k = i & 2047; const float c = r < 16 ? p.c[r * 2048 + k] : p.c_ctx[k]; cs[k * 17 + r] = c / (1.0f + __expf(-c)); }
    __syncthreads();
    for (int u = blockIdx.x; u < 96; u += gridDim.x) {
        const int l = u / 48, col = (u % 48) * 256 + (tid & 255), half = tid >> 8;
        const float* w = p.w_mod + (size_t)l * 2048 * NMOD + col;
        float acc[17];
#pragma unroll
        for (int r = 0; r < 17; ++r) acc[r] = 0.f;
        const int k0 = half * 1024;
#pragma unroll 4
        for (int k = k0; k < k0 + 1024; ++k) {
            const float wv = w[(size_t)k * NMOD];
#pragma unroll
            for (int r = 0; r < 17; ++r) acc[r] += cs[k * 17 + r] * wv;
        }
        if (half == 1) {
#pragma unroll
            for (int r = 0; r < 17; ++r) red[(tid & 255) * 17 + r] = acc[r];
        }
        __syncthreads();
        if (half == 0) { const float b = p.b_mod[l * NMOD + col];
#pragma unroll
            for (int r = 0; r < 17; ++r) modv[(size_t)(l * 17 + r) * NMOD + col] = acc[r] + red[(tid & 255) * 17 + r] + b; }
        __syncthreads();
    }
}
__device__ __forceinline__ void phase_prep(const Params& p) {
    const int tid_ = otid();
    const int gt = blockIdx.x * NTHREADS + tid_, nt = gridDim.x * NTHREADS;
    float* lb = (float*)(p.ws + OFF_LB);
    for (int i = gt; i < 2 * 1024; i += nt) { const float x0 = p.lb_logits[i], x1 = p.lb_logits[2048 + i]; lb[i] = 0.f; lb[2048 + i] = 1.0f / (1.0f + expf(x0 - x1)); }
    float* s5lam = (float*)(p.ws + OFF_S5LAM); float* s5bb = (float*)(p.ws + OFF_S5BB);
    for (int i = gt; i < 2 * 2 * 48 * 64; i += nt) {
        const int ldg = i >> 6;
        const double lre = (double)p.lam_re[i], lim = (double)p.lam_im[i], dt = exp((double)p.log_step[ldg]);
        const double er = exp(lre * dt); double sn, cs; sincos(lim * dt, &sn, &cs);
        const double br = er * cs, bi = er * sn;
        s5lam[i * 2] = (float)br; s5lam[i * 2 + 1] = (float)bi;
        const double nr = br - 1.0, ni = bi, den = lre * lre + lim * lim;
        const double cr = (nr * lre + ni * lim) / den, ci = (ni * lre - nr * lim) / den;
        for (int d = 0; d < 16; ++d) { const double xr = (double)p.b_re[(size_t)i * 16 + d], xi = (double)p.b_im[(size_t)i * 16 + d];
            s5bb[(size_t)i * 32 + d] = (float)(cr * xr - ci * xi); s5bb[(size_t)i * 32 + 16 + d] = (float)(cr * xi + ci * xr); }
    }
    float* pe = (float*)(p.ws + OFF_PE);
    for (int i = gt; i < 96 * 1024; i += nt) {
        const int r = i >> 10, cc = i & 1023, j = cc & 511;
        const float pos = (float)(r < 32 ? r : r - 32);
        const float omega = 1.0f / powf(10000.0f, (float)j * (1.0f / 512.0f));
        const float ang = pos * omega;
        pe[i] = cc < 512 ? sinf(ang) : cosf(ang);
    }
}

template <int MAPMODE>
__device__ __forceinline__ void transpose_convert(const float* src, int K, int N, bf16_t* dst, LAS unsigned char* lds) {
    const int tid_ = otid();
    LAS float* tile = (LAS float*)lds;
    const int tid = tid_, nkb = K / 64, nnb = N / 64;
    for (int u = blockIdx.x; u < nkb * nnb; u += gridDim.x) {
        const int kb = u / nnb, nb = u % nnb, k0 = kb * 64, n0 = nb * 64;
        { const int nn = tid & 63, kk = tid >> 6;
#pragma unroll
          for (int i = 0; i < 8; ++i) tile[(kk + i * 8) * 65 + nn] = src[(size_t)(k0 + kk + i * 8) * N + n0 + nn]; }
        __syncthreads();
        { const int kk2 = (tid & 7) * 8, nn2 = tid >> 3; float v[8];
#pragma unroll
          for (int i = 0; i < 8; ++i) v[i] = tile[(kk2 + i) * 65 + nn2];
          int n = n0 + nn2, nr;
          if (MAPMODE == 1) { if (n < 768) nr = (n >> 7) * 256 + (n & 127); else { const int m = n - 768; nr = (m >> 7) * 256 + 128 + (m & 127); } } else nr = n;
          u32x4 w; w.x = cvt_pk_bf16(v[0], v[1]); w.y = cvt_pk_bf16(v[2], v[3]); w.z = cvt_pk_bf16(v[4], v[5]); w.w = cvt_pk_bf16(v[6], v[7]);
          *(u32x4*)(dst + (size_t)nr * K + k0 + kk2) = w; }
        __syncthreads();
    }
}
__device__ __forceinline__ void phase_wscore(const float* wq, const float* sk, bf16_t* dst, LAS unsigned char* lds) {
    const int tid_ = otid();
    LAS float* skt = (LAS float*)lds;
    LAS float* wqt = (LAS float*)(lds + 128 * 129 * 4);
    const int tid = tid_;
    for (int u = blockIdx.x; u < 16 * 32; u += gridDim.x) {
        const int hp = u >> 5, kb = u & 31;
        for (int i = tid; i < 128 * 128; i += NTHREADS) { const int key = i >> 7, e = i & 127; skt[key * 129 + e] = sk[(size_t)hp * 16384 + i]; }
        for (int i = tid; i < 64 * 128; i += NTHREADS) { const int k = i >> 7, e = i & 127; wqt[e * 68 + k] = wq[(size_t)(kb * 64 + k) * 2048 + hp * 128 + e]; }
        __syncthreads();
        const int key = tid & 127, kg = tid >> 7;
        float acc[16];
#pragma unroll
        for (int i = 0; i < 16; ++i) acc[i] = 0.f;
        for (int e = 0; e < 128; ++e) {
            const float s = skt[key * 129 + e];
#pragma unroll
            for (int q = 0; q < 4; ++q) { const f32x4 w4 = *(const LAS f32x4*)(wqt + e * 68 + kg * 16 + q * 4);
                acc[q * 4 + 0] += s * w4[0]; acc[q * 4 + 1] += s * w4[1]; acc[q * 4 + 2] += s * w4[2]; acc[q * 4 + 3] += s * w4[3]; }
        }
        bf16_t* o = dst + (size_t)(hp * 128 + key) * 2048 + kb * 64 + kg * 16;
        u32x4 w0, w1;
        w0.x = cvt_pk_bf16(acc[0], acc[1]); w0.y = cvt_pk_bf16(acc[2], acc[3]); w0.z = cvt_pk_bf16(acc[4], acc[5]); w0.w = cvt_pk_bf16(acc[6], acc[7]);
        w1.x = cvt_pk_bf16(acc[8], acc[9]); w1.y = cvt_pk_bf16(acc[10], acc[11]); w1.z = cvt_pk_bf16(acc[12], acc[13]); w1.w = cvt_pk_bf16(acc[14], acc[15]);
        *(u32x4*)o = w0; *(u32x4*)(o + 8) = w1;
        __syncthreads();
    }
}
__device__ __forceinline__ void phase_colmax(const Params& p) {
    const int tid_ = otid();
    unsigned* cm = (unsigned*)(p.ws + OFF_CMAX);
    const int total = 2 * INC * 16;
    for (int i = blockIdx.x * NTHREADS + tid_; i < total; i += gridDim.x * NTHREADS) {
        const int kc = i / (2 * INC), cidx = i % (2 * INC), l = cidx / INC, n = cidx % INC;
        const float* w = p.w_in + (size_t)l * D * INC + (size_t)(kc * 128) * INC + n;
        float am = 0.f;
#pragma unroll 8
        for (int k = 0; k < 128; ++k) am = fmaxf(am, fabsf(w[(size_t)k * INC]));
        atomicMax(cm + cidx, __float_as_uint(am));
    }
}
__device__ __forceinline__ void transpose_convert_fp8(const float* src, int K, int N, unsigned char* dst, const unsigned* cmax, LAS unsigned char* lds) {
    const int tid_ = otid();
    LAS float* tile = (LAS float*)lds;
    const int tid = tid_, nkb = K / 64, nnb = N / 64;
    for (int u = blockIdx.x; u < nkb * nnb; u += gridDim.x) {
        const int kb = u / nnb, nb = u % nnb, k0 = kb * 64, n0 = nb * 64;
        { const int nn = tid & 63, kk = tid >> 6;
#pragma unroll
          for (int i = 0; i < 8; ++i) tile[(kk + i * 8) * 65 + nn] = src[(size_t)(k0 + kk + i * 8) * N + n0 + nn]; }
        __syncthreads();
        { const int kk2 = (tid & 7) * 8, nn2 = tid >> 3; float v[8];
          const float cmv = __uint_as_float(cmax[n0 + nn2]); const float sc = cmv > 0.f ? 240.0f / cmv : 1.0f;
#pragma unroll
          for (int i = 0; i < 8; ++i) v[i] = tile[(kk2 + i) * 65 + nn2] * sc;
          u32x2 w; w.x = pack_fp8x4(v[0], v[1], v[2], v[3]); w.y = pack_fp8x4(v[4], v[5], v[6], v[7]);
          *(u32x2*)(dst + (size_t)(n0 + nn2) * K + k0 + kk2) = w; }
        __syncthreads();
    }
}
__device__ __forceinline__ void phase_wconv(const Params& p, int l, LAS unsigned char* lds) {
    unsigned char* W = p.ws + OFF_W;
    transpose_convert_fp8(p.w_in + (size_t)l * D * INC, D, INC, W + W_IN, (const unsigned*)(p.ws + OFF_CMAX) + (size_t)l * INC, lds);
    transpose_convert<1>(p.w_glu + (size_t)l * 768 * 1536, 768, 1536, (bf16_t*)(W + W_GLU), lds);
    transpose_convert<0>(p.wa + (size_t)l * 1024 * D, 1024, D, (bf16_t*)(W + W_A), lds);
    transpose_convert<0>(p.wb + (size_t)l * 1024 * D, 1024, D, (bf16_t*)(W + W_B), lds);
    transpose_convert<0>(p.wc + (size_t)l * 768 * D, 768, D, (bf16_t*)(W + W_C), lds);
    transpose_convert<0>(p.wo + (size_t)l * D * D, D, D, (bf16_t*)(W + W_O), lds);
    phase_wscore(p.w_q + (size_t)l * D * D, p.sub_keys + (size_t)l * 16 * 16384, (bf16_t*)(W + W_S), lds);
}
__device__ __forceinline__ void phase_tabconv(const Params& p, int l) {
    const int tid_ = otid();
    const int lane = tid_ & 63, gw = blockIdx.x * 8 + __builtin_amdgcn_readfirstlane(tid_ >> 6), nw = gridDim.x * 8;
    unsigned char* U6 = p.ws + OFF_P + Q_UT; unsigned char* V6 = p.ws + OFF_P + Q_VT;
    float* USC = (float*)(p.ws + OFF_P + Q_USC); float* VSC = (float*)(p.ws + OFF_P + Q_VSC);
    for (int r = gw; r < 32768; r += nw) {
        const bool isv = r >= 16384; const int rr = r & 16383;
        const float* src = (isv ? p.peer_v : p.peer_u) + (size_t)l * 16384 * 2048 + (size_t)rr * 2048;
        f32x4 v[8];
#pragma unroll
        for (int j = 0; j < 8; ++j) v[j] = *(const f32x4*)(src + j * 256 + lane * 4);
        float am = 0.f;
#pragma unroll
        for (int j = 0; j < 8; ++j) am = fmaxf(am, fmaxf(fmaxf(fabsf(v[j][0]), fabsf(v[j][1])), fmaxf(fabsf(v[j][2]), fabsf(v[j][3]))));
#pragma unroll
        for (int o = 32; o >= 1; o >>= 1) am = fmaxf(am, __shfl_xor(am, o));
        const float sc = am > 0.f ? 7.0f / am : 1.0f, inv = am > 0.f ? am * (1.0f / 7.0f) : 1.0f;
        bf16x32_t bv;
#pragma unroll
        for (int j = 0; j < 8; ++j)
#pragma unroll
            for (int c = 0; c < 4; ++c) bv[j * 4 + c] = (__bf16)(v[j][c] * sc);
        const u32x6 pk = __builtin_amdgcn_cvt_scalef32_pk32_fp6_bf16(bv, 1.0f);
        unsigned char* dst = (isv ? V6 : U6) + (size_t)rr * 1536 + lane * 24;
        u32x4 w0; w0.x = pk[0]; w0.y = pk[1]; w0.z = pk[2]; w0.w = pk[3]; u32x2 w1; w1.x = pk[4]; w1.y = pk[5];
        *(u32x4*)dst = w0; *(u32x2*)(dst + 16) = w1;
        if (lane == 0) (isv ? VSC : USC)[rr] = inv;
    }
}

template <int MODE, bool F8OUT = false>
__device__ __forceinline__ void phase_norm(const Params& p, int l, int M, int off_sh, int off_sc) {
    const int tid_ = otid();
    const int lane = tid_ & 63, gw = blockIdx.x * 8 + __builtin_amdgcn_readfirstlane(tid_ >> 6), nw = gridDim.x * 8;
    const float* modv = (const float*)(p.ws + OFF_MODV) + (size_t)l * 17 * NMOD;
    const float* pe = (const float*)(p.ws + OFF_PE);
    float* XC = (float*)(p.ws + OFF_XC);
    bf16_t* H = (bf16_t*)(p.ws + OFF_H);
    for (int r = gw; r < M; r += nw) {
        const bool lat = r < TL;
        const float* src = MODE == 0 ? (lat ? p.x + (size_t)r * D : p.ctx + (size_t)(r - TL) * D) : (lat ? p.out + (size_t)r * D : XC + (size_t)(r - TL) * D);
        f32x4 v[4][2];
#pragma unroll
        for (int j = 0; j < 4; ++j) { v[j][0] = *(const f32x4*)(src + j * 512 + lane * 8); v[j][1] = *(const f32x4*)(src + j * 512 + lane * 8 + 4); }
        if (MODE == 0) {
            if (lat) { const int n = r & 2047, gr = n >> 6, gc = n & 63;
#pragma unroll
                for (int j = 0; j < 4; ++j) { const float* pr = (j < 2) ? pe + (size_t)gr * 1024 + j * 512 + lane * 8 : pe + (size_t)(32 + gc) * 1024 + (j - 2) * 512 + lane * 8;
                    v[j][0] += *(const f32x4*)pr; v[j][1] += *(const f32x4*)(pr + 4); } }
            float* dst = lat ? p.out + (size_t)r * D : XC + (size_t)(r - TL) * D;
#pragma unroll
            for (int j = 0; j < 4; ++j) { *(f32x4*)(dst + j * 512 + lane * 8) = v[j][0]; *(f32x4*)(dst + j * 512 + lane * 8 + 4) = v[j][1]; }
        }
        float ss = 0.f;
#pragma unroll
        for (int j = 0; j < 4; ++j)
#pragma unroll
            for (int h = 0; h < 2; ++h) ss += v[j][h][0] * v[j][h][0] + v[j][h][1] * v[j][h][1] + v[j][h][2] * v[j][h][2] + v[j][h][3] * v[j][h][3];
        ss = wave_sum(ss);
        const float rs = rsqrtf(ss * (1.0f / 2048.0f) + 1e-6f);
        const int mb = lat ? (r >> 11) : 16;
        const float* sh = modv + (size_t)mb * NMOD + off_sh; const float* sc = modv + (size_t)mb * NMOD + off_sc;
        if (F8OUT) {
            float am = 0.f;
#pragma unroll
            for (int j = 0; j < 4; ++j) { const int e = j * 512 + lane * 8;
                const f32x4 s0 = *(const f32x4*)(sc + e), s1 = *(const f32x4*)(sc + e + 4), h0 = *(const f32x4*)(sh + e), h1 = *(const f32x4*)(sh + e + 4);
                v[j][0] = v[j][0] * rs * (s0 + 1.0f) + h0; v[j][1] = v[j][1] * rs * (s1 + 1.0f) + h1;
#pragma unroll
                for (int hh = 0; hh < 2; ++hh) am = fmaxf(am, fmaxf(fmaxf(fabsf(v[j][hh][0]), fabsf(v[j][hh][1])), fmaxf(fabsf(v[j][hh][2]), fabsf(v[j][hh][3])))); }
#pragma unroll
            for (int o = 32; o >= 1; o >>= 1) am = fmaxf(am, __shfl_xor(am, o));
            const float q = am > 0.f ? 240.0f / am : 1.0f;
            unsigned char* H8 = p.ws + OFF_H8 + (size_t)r * D;
#pragma unroll
            for (int j = 0; j < 4; ++j) { u32x2 w; w.x = pack_fp8x4(v[j][0][0] * q, v[j][0][1] * q, v[j][0][2] * q, v[j][0][3] * q); w.y = pack_fp8x4(v[j][1][0] * q, v[j][1][1] * q, v[j][1][2] * q, v[j][1][3] * q);
                *(u32x2*)(H8 + j * 512 + lane * 8) = w; }
            if (lane == 0) ((float*)(p.ws + OFF_HS))[r] = am > 0.f ? am * (1.0f / 240.0f) : 1.0f;
        } else {
#pragma unroll
        for (int j = 0; j < 4; ++j) {
            const int e = j * 512 + lane * 8;
            const f32x4 s0 = *(const f32x4*)(sc + e), s1 = *(const f32x4*)(sc + e + 4), h0 = *(const f32x4*)(sh + e), h1 = *(const f32x4*)(sh + e + 4);
            f32x4 a = v[j][0] * rs * (s0 + 1.0f) + h0, b = v[j][1] * rs * (s1 + 1.0f) + h1;
            u32x4 w; w.x = cvt_pk_bf16(a[0], a[1]); w.y = cvt_pk_bf16(a[2], a[3]); w.z = cvt_pk_bf16(b[0], b[1]); w.w = cvt_pk_bf16(b[2], b[3]);
            *(u32x4*)(H + (size_t)r * D + e) = w;
        }
        }
    }
}
__device__ __forceinline__ bf16x8 mk_bf16x8(unsigned a, unsigned b, unsigned c, unsigned d) { u32x4 q; q.x = a; q.y = b; q.z = c; q.w = d; return __builtin_bit_cast(bf16x8, q); }
__device__ __forceinline__ void phase_hgrn(const Params& p, int l, LAS unsigned char* lds, bool dry = false) {
    const int tid_ = otid();
    const int lane = tid_ & 63, w = __builtin_amdgcn_readfirstlane(tid_ >> 6), q = lane >> 4, m = lane & 15;
    constexpr int OQ = 0, OKH = 4352, OKT = 8704, OIT = 14848, OE = 20992, BUFSZ = 21504, RAWOFF = 2 * 21504, RAWSZ = 3 * 4352;
    unsigned char* P = p.ws + OFF_P;
    const float* lbp = (const float*)(p.ws + OFF_LB) + (size_t)l * 2048;
    const int kch = 16 * w + m;
    for (int u = blockIdx.x; u < 256; u += gridDim.x) {
        const int b = u >> 4, h = (u >> 1) & 7, dir = u & 1;
        const bf16_t* BQ = (const bf16_t*)(P + P_BQ); const bf16_t* BI = (const bf16_t*)(P + P_BI);
        bf16_t* BF = (bf16_t*)(P + (dir ? P_BFB : P_BFF));
        const float lbv = lbp[dir * 1024 + h * 128 + kch];
        f32x4 Sacc[8];
#pragma unroll
        for (int i = 0; i < 8; ++i) Sacc[i] = (f32x4){0.f, 0.f, 0.f, 0.f};
        for (int seg = 0; seg < 2; ++seg) {
            const int len = seg == 0 ? CTXL : SEQ, rbase = seg == 0 ? TL + b * CTXL : b * SEQ, nch = len / 16;
            u32x4 g0 = (u32x4){0u, 0u, 0u, 0u}, g1 = g0;
            const int gs = (tid_ & 255) >> 4, gc8 = (tid_ & 15) * 8;
#define HG_GLOAD(c) do { const int st = (c) * 16 + gs, n = dir ? (len - 1 - st) : st; const size_t o = (size_t)(rbase + n) * 1024 + h * 128 + gc8; \
                if (tid_ < 256) { g0 = *(const u32x4*)(BQ + o); g1 = *(const u32x4*)(BF + o); } else { g0 = *(const u32x4*)(BI + o); } } while (0)
#define HG_RAWW(c) do { LAS unsigned char* rw = lds + RAWOFF + ((c) & 1) * RAWSZ + gs * 272 + gc8 * 2; \
                if (tid_ < 256) { *(LAS u32x4*)(rw) = g0; *(LAS u32x4*)(rw + 4352) = g1; } else { *(LAS u32x4*)(rw + 8704) = g0; } } while (0)
#define HG_STAGE(c, bufp) do { float fv[4], cb[4]; float run = 0.f; unsigned short rq[4], rf[4], ri[4]; \
                { const LAS unsigned char* rr = lds + RAWOFF + ((c) & 1) * RAWSZ + kch * 2; _Pragma("unroll") for (int j = 0; j < 4; ++j) { rq[j] = *(const LAS bf16_t*)(rr + (4 * q + j) * 272); rf[j] = *(const LAS bf16_t*)(rr + 4352 + (4 * q + j) * 272); ri[j] = *(const LAS bf16_t*)(rr + 8704 + (4 * q + j) * 272); } } \
                _Pragma("unroll") for (int j = 0; j < 4; ++j) { const float xf = __uint_as_float(((unsigned)rf[j]) << 16); fv[j] = lbv + (1.0f - lbv) * fast_sigmoid(xf); run += flog(fv[j]); cb[j] = run; } \
                const float t0 = __shfl(run, m), t1 = __shfl(run, m + 16), t2 = __shfl(run, m + 32); \
                const float off = (q > 0 ? t0 : 0.f) + (q > 1 ? t1 : 0.f) + (q > 2 ? t2 : 0.f); \
                float qh[4], kh[4]; \
                _Pragma("unroll") for (int j = 0; j < 4; ++j) { const float bb = off + cb[j], bc = fmaxf(bb, -80.0f); qh[j] = __uint_as_float(((unsigned)rq[j]) << 16) * fexp(bc); kh[j] = (1.0f - fv[j]) * fexp(-bc);     \
                    if (j == 3 && q == 3) *(LAS float*)((bufp) + OE + kch * 4) = fexp(bb); } \
                const unsigned q01 = cvt_pk_bf16(qh[0], qh[1]), q23 = cvt_pk_bf16(qh[2], qh[3]), k01 = cvt_pk_bf16(kh[0], kh[1]), k23 = cvt_pk_bf16(kh[2], kh[3]); \
                *(LAS bf16_t*)((bufp) + OQ + (4 * q + 0) * 272 + kch * 2) = (bf16_t)(q01 & 0xffffu); *(LAS bf16_t*)((bufp) + OQ + (4 * q + 1) * 272 + kch * 2) = (bf16_t)(q01 >> 16); \
                *(LAS bf16_t*)((bufp) + OQ + (4 * q + 2) * 272 + kch * 2) = (bf16_t)(q23 & 0xffffu); *(LAS bf16_t*)((bufp) + OQ + (4 * q + 3) * 272 + kch * 2) = (bf16_t)(q23 >> 16); \
                *(LAS bf16_t*)((bufp) + OKH + (4 * q + 0) * 272 + kch * 2) = (bf16_t)(k01 & 0xffffu); *(LAS bf16_t*)((bufp) + OKH + (4 * q + 1) * 272 + kch * 2) = (bf16_t)(k01 >> 16); \
                *(LAS bf16_t*)((bufp) + OKH + (4 * q + 2) * 272 + kch * 2) = (bf16_t)(k23 & 0xffffu); *(LAS bf16_t*)((bufp) + OKH + (4 * q + 3) * 272 + kch * 2) = (bf16_t)(k23 >> 16); \
                u32x2 kt2; kt2.x = k01; kt2.y = k23; *(LAS u32x2*)((bufp) + OKT + kch * 48 + q * 8) = kt2; \
                u32x2 it2; it2.x = (unsigned)ri[0] | ((unsigned)ri[1] << 16); it2.y = (unsigned)ri[2] | ((unsigned)ri[3] << 16); *(LAS u32x2*)((bufp) + OIT + kch * 48 + q * 8) = it2; } while (0)
#define HG_COMPUTE(c) do { \
                LAS unsigned char* buf = lds + ((c) & 1) * BUFSZ; \
                f32x4 at = (f32x4){0.f, 0.f, 0.f, 0.f}; \
                _Pragma("unroll") \
                for (int kb = 0; kb < 4; ++kb) { const bf16x8 a = *(const LAS bf16x8*)(buf + OKH + m * 272 + kb * 64 + q * 16), bq = *(const LAS bf16x8*)(buf + OQ + m * 272 + kb * 64 + q * 16); \
                    at = __builtin_amdgcn_mfma_f32_16x16x32_bf16(a, bq, at, 0, 0, 0); } \
                asm volatile("s_nop 15\n s_nop 15" : "+v"(at)); \
                _Pragma("unroll") \
                for (int r = 0; r < 4; ++r) at[r] = (4 * q + r <= m) ? at[r] : 0.f; \
                const bf16x8 attB = mk_bf16x8(cvt_pk_bf16(at[0], at[1]), cvt_pk_bf16(at[2], at[3]), 0u, 0u); \
                f32x4 oacc = (f32x4){0.f, 0.f, 0.f, 0.f}; \
                _Pragma("unroll") \
                for (int kb = 0; kb < 4; ++kb) { \
                    const bf16x8 a = mk_bf16x8(cvt_pk_bf16(Sacc[2 * kb][0], Sacc[2 * kb][1]), cvt_pk_bf16(Sacc[2 * kb][2], Sacc[2 * kb][3]), cvt_pk_bf16(Sacc[2 * kb + 1][0], Sacc[2 * kb + 1][1]), cvt_pk_bf16(Sacc[2 * kb + 1][2], Sacc[2 * kb + 1][3])); \
                    const u32x2 b0 = *(const LAS u32x2*)(buf + OQ + m * 272 + (32 * kb + 4 * q) * 2), b1 = *(const LAS u32x2*)(buf + OQ + m * 272 + (32 * kb + 16 + 4 * q) * 2); \
                    oacc = __builtin_amdgcn_mfma_f32_16x16x32_bf16(a, mk_bf16x8(b0.x, b0.y, b1.x, b1.y), oacc, 0, 0, 0); } \
                { const u32x2 i0 = *(const LAS u32x2*)(buf + OIT + (16 * w + m) * 48 + q * 8); \
                  oacc = __builtin_amdgcn_mfma_f32_16x16x32_bf16(mk_bf16x8(i0.x, i0.y, 0u, 0u), attB, oacc, 0, 0, 0); } \
                asm volatile("s_nop 15\n s_nop 15" : "+v"(oacc)); \
                { const int st = (c) * 16 + m, n = dir ? (len - 1 - st) : st; \
                  u32x2 o2; o2.x = cvt_pk_bf16(oacc[0], oacc[1]); o2.y = cvt_pk_bf16(oacc[2], oacc[3]); \
                  if (!dry || p.ws == nullptr) *(u32x2*)(BF + (size_t)(rbase + n) * 1024 + h * 128 + 16 * w + 4 * q) = o2; } \
                u32x4 bsu = (u32x4){0u, 0u, 0u, 0u}; \
                if (q < 2) bsu = *(const LAS u32x4*)(buf + OIT + (16 * w + m) * 48 + q * 16); \
                const bf16x8 bs = __builtin_bit_cast(bf16x8, bsu); \
                _Pragma("unroll") \
                for (int kt = 0; kt < 8; ++kt) { u32x4 au = (u32x4){0u, 0u, 0u, 0u}; \
                    if (q < 2) au = *(const LAS u32x4*)(buf + OKT + (16 * kt + m) * 48 + q * 16); \
                    Sacc[kt] = __builtin_amdgcn_mfma_f32_16x16x32_bf16(__builtin_bit_cast(bf16x8, au), bs, Sacc[kt], 0, 0, 0); } \
                asm volatile("s_nop 15\n s_nop 15" : "+v"(Sacc[0]), "+v"(Sacc[1]), "+v"(Sacc[2]), "+v"(Sacc[3]), "+v"(Sacc[4]), "+v"(Sacc[5]), "+v"(Sacc[6]), "+v"(Sacc[7])); \
                _Pragma("unroll") \
                for (int kt = 0; kt < 8; ++kt) Sacc[kt] *= *(const LAS f32x4*)(buf + OE + (16 * kt + 4 * q) * 4); \
                } while (0)
            HG_GLOAD(0); HG_RAWW(0);
            if (nch > 1) { HG_GLOAD(1); HG_RAWW(1); }
            if (nch > 2) HG_GLOAD(2);
            __syncthreads();
            HG_STAGE(0, lds);
            __syncthreads();
            for (int c = 0; c < nch; ++c) {
                if (c + 2 < nch) { HG_RAWW(c + 2); if (c + 3 < nch) HG_GLOAD(c + 3); }
                if (c + 1 < nch) HG_STAGE(c + 1, lds + ((c + 1) & 1) * BUFSZ);
                HG_COMPUTE(c);
                __syncthreads();
            }
#undef HG_COMPUTE
#undef HG_GLOAD
#undef HG_RAWW
#undef HG_STAGE
        }
        __syncthreads();
    }
}
__device__ __forceinline__ void phase_hcomb(const Params& p, int l, int M, bool dry = false) {
    const int tid_ = otid();
    const int lane = tid_ & 63, gw = blockIdx.x * 8 + __builtin_amdgcn_readfirstlane(tid_ >> 6), nw = gridDim.x * 8;
    unsigned char* P = p.ws + OFF_P;
    bf16_t* OF = (bf16_t*)(P + P_BFF); const bf16_t* OB = (const bf16_t*)(P + P_BFB); const bf16_t* BG = (const bf16_t*)(P + P_BG);
    const float* hg = p.hn_g + (size_t)l * 1024 + lane * 16;
    for (int r = gw; r < M; r += nw) {
        const size_t o = (size_t)r * 1024 + lane * 16;
        float x[16]; float ss = 0.f;
#pragma unroll
        for (int hh = 0; hh < 2; ++hh) { const u32x4 a = *(const u32x4*)(OF + o + hh * 8), bq = *(const u32x4*)(OB + o + hh * 8);
            const unsigned aa[4] = {a.x, a.y, a.z, a.w}, bb[4] = {bq.x, bq.y, bq.z, bq.w};
#pragma unroll
            for (int j = 0; j < 4; ++j) { x[hh * 8 + 2 * j] = bf_lo(aa[j]) + bf_lo(bb[j]); x[hh * 8 + 2 * j + 1] = bf_hi(aa[j]) + bf_hi(bb[j]); } }
#pragma unroll
        for (int j = 0; j < 16; ++j) ss += x[j] * x[j];
        ss += __shfl_xor(ss, 1); ss += __shfl_xor(ss, 2); ss += __shfl_xor(ss, 4);
        const float rs = rsqrtf(ss * (1.0f / 128.0f) + 1e-6f);
#pragma unroll
        for (int hh = 0; hh < 2; ++hh) { const u32x4 gq = *(const u32x4*)(BG + o + hh * 8); const unsigned gg[4] = {gq.x, gq.y, gq.z, gq.w};
            float y[8];
#pragma unroll
            for (int j = 0; j < 4; ++j) { y[2 * j] = x[hh * 8 + 2 * j] * rs * hg[hh * 8 + 2 * j] * bf_lo(gg[j]); y[2 * j + 1] = x[hh * 8 + 2 * j + 1] * rs * hg[hh * 8 + 2 * j + 1] * bf_hi(gg[j]); }
            u32x4 w; w.x = cvt_pk_bf16(y[0], y[1]); w.y = cvt_pk_bf16(y[2], y[3]); w.z = cvt_pk_bf16(y[4], y[5]); w.w = cvt_pk_bf16(y[6], y[7]);
            if (!dry || p.ws == nullptr) *(u32x4*)(OF + o + hh * 8) = w; }
    }
}

__device__ __forceinline__ bf16x8 pack_bf16x8(const float (&v)[8]) {
    const unsigned a = cvt_pk_bf16(v[0], v[1]), b = cvt_pk_bf16(v[2], v[3]), c = cvt_pk_bf16(v[4], v[5]), d = cvt_pk_bf16(v[6], v[7]);
    u32x4 q; q.x = a; q.y = b; q.z = c; q.w = d;
    return __builtin_bit_cast(bf16x8, q);
}
__device__ __forceinline__ void phase_s5(const Params& p, int l, LAS unsigned char* lds) {
    const int tid_ = otid();
    const int lane = tid_ & 63, w = __builtin_amdgcn_readfirstlane(tid_ >> 6);
    if (w >= 6) return;
    LAS float* BU = (LAS float*)(lds + w * 12800);
    LAS unsigned char* XB = lds + w * 12800 + 8448;
    const int lq = lane >> 4, lr = lane & 15;
    const bf16_t* CU = (const bf16_t*)(p.ws + OFF_P + P_CU);
    const float* s5lam = (const float*)(p.ws + OFF_S5LAM); const float* s5bb = (const float*)(p.ws + OFF_S5BB);
    for (int s = w * (int)gridDim.x + (int)blockIdx.x; s < 1536; s += 6 * (int)gridDim.x) {
        const int dir = s & 1, g = (s >> 1) % 48, b = s / 96;
        const int ldg = (l * 2 + dir) * 48 + g;
        const float lre = s5lam[(size_t)(ldg * 64 + lane) * 2], lim = s5lam[(size_t)(ldg * 64 + lane) * 2 + 1];
        bf16x8 bbf[8], cf[4];
#pragma unroll
        for (int nt = 0; nt < 8; ++nt) { const int col = nt * 16 + lr, pp = col >> 1, c = col & 1; float v[8];
#pragma unroll
            for (int j = 0; j < 8; ++j) v[j] = (lq < 2) ? s5bb[(size_t)(ldg * 64 + pp) * 32 + c * 16 + lq * 8 + j] : 0.f;
            bbf[nt] = pack_bf16x8(v); }
#pragma unroll
        for (int kb = 0; kb < 4; ++kb) { float v[8];
#pragma unroll
            for (int j = 0; j < 8; ++j) { const int k = kb * 32 + lq * 8 + j, pp = k >> 1; const size_t ci = ((size_t)ldg * 16 + lr) * 64 + pp;
                v[j] = (k & 1) ? -p.c_im[ci] : p.c_re[ci]; }
            cf[kb] = pack_bf16x8(v); }
        bf16_t* YS = (bf16_t*)(p.ws + OFF_H + (dir ? H_YSB : H_YSF));
        float xr = 0.f, xi = 0.f;
        for (int seg = 0; seg < 2; ++seg) {
            const int len = seg == 0 ? CTXL : SEQ, rbase = seg == 0 ? TL + b * CTXL : b * SEQ, nblk = len / 64;
            u32x4 unext[4];
#pragma unroll
            for (int tt = 0; tt < 4; ++tt) { unext[tt] = (u32x4){0u, 0u, 0u, 0u};
                if (lq < 2) { const int st = tt * 16 + lr, n = dir ? (len - 1 - st) : st; unext[tt] = *(const u32x4*)(CU + (size_t)(rbase + n) * 768 + g * 16 + lq * 8); } }
            for (int blk = 0; blk < nblk; ++blk) {
                u32x4 ucur[4];
#pragma unroll
                for (int tt = 0; tt < 4; ++tt) ucur[tt] = unext[tt];
                if (blk + 1 < nblk && lq < 2) {
#pragma unroll
                    for (int tt = 0; tt < 4; ++tt) { const int st = (blk + 1) * 64 + tt * 16 + lr, n = dir ? (len - 1 - st) : st; unext[tt] = *(const u32x4*)(CU + (size_t)(rbase + n) * 768 + g * 16 + lq * 8); } }
#pragma unroll
                for (int tt = 0; tt < 4; ++tt) {
                    const bf16x8 uf = __builtin_bit_cast(bf16x8, ucur[tt]);
                    f32x4 dd[8];
#pragma unroll
                    for (int nt = 0; nt < 8; ++nt) dd[nt] = __builtin_amdgcn_mfma_f32_16x16x32_bf16(bbf[nt], uf, (f32x4){0.f, 0.f, 0.f, 0.f}, 0, 0, 0);
                    asm volatile("s_nop 15\n s_nop 15" : "+v"(dd[0]), "+v"(dd[1]), "+v"(dd[2]), "+v"(dd[3]), "+v"(dd[4]), "+v"(dd[5]), "+v"(dd[6]), "+v"(dd[7]));
#pragma unroll
                    for (int nt = 0; nt < 8; ++nt) *(LAS f32x4*)(BU + lr * 132 + nt * 16 + lq * 4) = dd[nt];
                    asm volatile("s_waitcnt lgkmcnt(0)" ::: "memory");
                    f32x2 bu[16];
#pragma unroll
                    for (int t = 0; t < 16; ++t) bu[t] = *(const LAS f32x2*)(BU + t * 132 + 2 * lane);
#pragma unroll
                    for (int t = 0; t < 16; ++t) { const float nr = lre * xr - lim * xi + bu[t].x, ni = lre * xi + lim * xr + bu[t].y; xr = nr; xi = ni;
                        *(LAS unsigned*)(XB + t * 272 + lane * 4) = cvt_pk_bf16(xr, xi); }
                    asm volatile("s_waitcnt lgkmcnt(0)" ::: "memory");
                    f32x4 acc = (f32x4){0.f, 0.f, 0.f, 0.f};
#pragma unroll
                    for (int kb = 0; kb < 4; ++kb) { const bf16x8 xf = *(const LAS bf16x8*)(XB + lr * 272 + kb * 64 + lq * 16); acc = __builtin_amdgcn_mfma_f32_16x16x32_bf16(cf[kb], xf, acc, 0, 0, 0); }
                    asm volatile("s_nop 15\n s_nop 15\n s_waitcnt lgkmcnt(0)" : "+v"(acc) :: "memory");
                    const int st = blk * 64 + tt * 16 + lr, n = dir ? (len - 1 - st) : st;
                    u32x2 o; o.x = cvt_pk_bf16(acc[0], acc[1]); o.y = cvt_pk_bf16(acc[2], acc[3]);
                    *(u32x2*)(YS + (size_t)(rbase + n) * 768 + g * 16 + lq * 4) = o;
                }
            }
        }
    }
}
__device__ __forceinline__ void phase_s5post(const Params& p, int l, int M, bool dry = false) {
    const int tid_ = otid();
    const size_t n8 = (size_t)M * 768 / 8;
    bf16_t* YF = (bf16_t*)(p.ws + OFF_H + H_YSF); const bf16_t* YB = (const bf16_t*)(p.ws + OFF_H + H_YSB); const bf16_t* CU = (const bf16_t*)(p.ws + OFF_P + P_CU);
    const float* dsk = p.s5_d + (size_t)l * 768;
    for (size_t i = (size_t)blockIdx.x * NTHREADS + tid_; i < n8; i += (size_t)gridDim.x * NTHREADS) {
        const int c = (int)((i * 8) % 768);
        const u32x4 a = *(const u32x4*)(YF + i * 8), bq = *(const u32x4*)(YB + i * 8), uq = *(const u32x4*)(CU + i * 8);
        const unsigned aa[4] = {a.x, a.y, a.z, a.w}, bb[4] = {bq.x, bq.y, bq.z, bq.w}, uu[4] = {uq.x, uq.y, uq.z, uq.w};
        float y[8];
#pragma unroll
        for (int j = 0; j < 4; ++j) { y[2 * j] = gelu_f(bf_lo(aa[j]) + bf_lo(bb[j]) + dsk[c + 2 * j] * bf_lo(uu[j])); y[2 * j + 1] = gelu_f(bf_hi(aa[j]) + bf_hi(bb[j]) + dsk[c + 2 * j + 1] * bf_hi(uu[j])); }
        u32x4 w; w.x = cvt_pk_bf16(y[0], y[1]); w.y = cvt_pk_bf16(y[2], y[3]); w.z = cvt_pk_bf16(y[4], y[5]); w.w = cvt_pk_bf16(y[6], y[7]);
        if (!dry || p.ws == nullptr) *(u32x4*)(YF + i * 8) = w;
    }
}

__device__ __forceinline__ void phase_gmlp(const Params& p, int l, int M, LAS unsigned char* lds, bool dry = false) {
    const int tid_ = otid();
    LAS unsigned char* Wb = lds;
    LAS unsigned char* Vt = lds + 34816;
    LAS float* st = (LAS float*)(lds + 69632);
    const int tid = tid_, lane = tid & 63, w = __builtin_amdgcn_readfirstlane(tid_ >> 6), q = lane >> 4, m = lane & 15;
    bf16_t* AU = (bf16_t*)(p.ws + OFF_P + P_AU); const bf16_t* AV = (const bf16_t*)(p.ws + OFF_P + P_AV);
    const float* lng = p.ln_g + (size_t)l * 1024; const float* lnb = p.ln_b + (size_t)l * 1024;
    for (int u = blockIdx.x; u < M / 128; u += gridDim.x) {
        const size_t r0 = (size_t)u * 128;
        for (int i = 0; i < 16; ++i) {
            const int s = w * 16 + i; const bf16_t* rp = AV + (r0 + s) * 1024 + lane * 16;
            const u32x4 a = *(const u32x4*)rp, bq = *(const u32x4*)(rp + 8);
            const unsigned aa[8] = {a.x, a.y, a.z, a.w, bq.x, bq.y, bq.z, bq.w};
            float sm = 0.f, sq = 0.f;
#pragma unroll
            for (int j = 0; j < 8; ++j) { const float x0 = bf_lo(aa[j]), x1 = bf_hi(aa[j]); sm += x0 + x1; sq += x0 * x0 + x1 * x1; }
            sm = wave_sum(sm); sq = wave_sum(sq);
            const float mean = sm * (1.0f / 1024.0f), var = fmaxf(sq * (1.0f / 1024.0f) - mean * mean, 0.f);
            if (lane == 0) { st[s * 2] = mean; st[s * 2 + 1] = rsqrtf(var + 1e-6f); }
        }
        __syncthreads();
        for (int g = 0; g < 8; ++g) {
            { const int t = tid >> 2, s0 = (tid & 3) * 32; const float* ws = p.w_s + ((size_t)l * 8 + g) * 16384 + t * 128 + s0;
#pragma unroll
              for (int qq = 0; qq < 4; ++qq) { const f32x4 a = *(const f32x4*)(ws + qq * 8), b4 = *(const f32x4*)(ws + qq * 8 + 4);
                  u32x4 o; o.x = cvt_pk_bf16(a[0], a[1]); o.y = cvt_pk_bf16(a[2], a[3]); o.z = cvt_pk_bf16(b4[0], b4[1]); o.w = cvt_pk_bf16(b4[2], b4[3]);
                  *(LAS u32x4*)(Wb + t * 272 + (s0 + qq * 8) * 2) = o; } }
            { const int s = tid >> 2, c0 = (tid & 3) * 32; const bf16_t* rp = AV + (r0 + s) * 1024 + g * 128 + c0;
              const float mean = st[s * 2], rstd = st[s * 2 + 1];
#pragma unroll
              for (int qq = 0; qq < 4; ++qq) { const u32x4 a = *(const u32x4*)(rp + qq * 8); const unsigned aa[4] = {a.x, a.y, a.z, a.w};
#pragma unroll
                  for (int j = 0; j < 4; ++j) { const int cl = c0 + qq * 8 + 2 * j, c = g * 128 + cl;
                      const unsigned pk = cvt_pk_bf16((bf_lo(aa[j]) - mean) * rstd * lng[c] + lnb[c], (bf_hi(aa[j]) - mean) * rstd * lng[c + 1] + lnb[c + 1]);
                      *(LAS bf16_t*)(Vt + cl * 272 + s * 2) = (bf16_t)(pk & 0xffffu); *(LAS bf16_t*)(Vt + (cl + 1) * 272 + s * 2) = (bf16_t)(pk >> 16); } } }
            __syncthreads();
            bf16x8 af[4];
#pragma unroll
            for (int kb = 0; kb < 4; ++kb) af[kb] = *(const LAS bf16x8*)(Vt + (16 * w + m) * 272 + kb * 64 + q * 16);
            const float* bs = p.b_s + ((size_t)l * 8 + g) * 128;
#pragma unroll
            for (int tt = 0; tt < 8; ++tt) {
                f32x4 acc = (f32x4){0.f, 0.f, 0.f, 0.f};
#pragma unroll
                for (int kb = 0; kb < 4; ++kb) acc = __builtin_amdgcn_mfma_f32_16x16x32_bf16(af[kb], *(const LAS bf16x8*)(Wb + (16 * tt + m) * 272 + kb * 64 + q * 16), acc, 0, 0, 0);
                const float bb = bs[16 * tt + m];
                bf16_t* up = AU + (r0 + 16 * tt + m) * 1024 + g * 128 + 16 * w + 4 * q;
                const u32x2 uw = *(const u32x2*)up;
                const float y0 = (acc[0] + bb) * bf_lo(uw.x), y1 = (acc[1] + bb) * bf_hi(uw.x), y2 = (acc[2] + bb) * bf_lo(uw.y), y3 = (acc[3] + bb) * bf_hi(uw.y);
                u32x2 o; o.x = cvt_pk_bf16(y0, y1); o.y = cvt_pk_bf16(y2, y3);
                if (!dry || p.ws == nullptr) *(u32x2*)up = o;
            }
            __syncthreads();
        }
    }
}

__device__ __forceinline__ unsigned fkey(float x) { const unsigned b = __float_as_uint(x); return b ^ ((b >> 31) ? 0xFFFFFFFFu : 0x80000000u); }
__device__ __forceinline__ int mbcnt64(unsigned long long m) { return __builtin_amdgcn_mbcnt_hi((unsigned)(m >> 32), __builtin_amdgcn_mbcnt_lo((unsigned)m, 0u)); }
template <int NV>
__device__ __forceinline__ int count_ge(const unsigned (&k)[NV], unsigned cand) {
    int cnt = 0;
#pragma unroll
    for (int i = 0; i < NV; ++i) cnt += __popcll(__ballot(k[i] >= cand));
    return cnt;
}
template <int NV>
__device__ __forceinline__ unsigned radix_thr16(const unsigned (&k)[NV], unsigned e0bits) {
    unsigned prefix = 0u; int bit = 31;
    {
        const unsigned c0 = e0bits ^ 0x80000000u, c1 = c0 + 0x00800000u, c2 = c0 + 0x01000000u, c3 = c0 + 0x01800000u;
        const int n0 = count_ge<NV>(k, c0), n1 = count_ge<NV>(k, c1), n2 = count_ge<NV>(k, c2), n3 = count_ge<NV>(k, c3);
        if (n0 >= 16 && n3 < 16) { prefix = (n2 >= 16) ? c2 : ((n1 >= 16) ? c1 : c0); bit = 22;
            const int nn = (n2 >= 16) ? n2 : ((n1 >= 16) ? n1 : n0); if (nn == 16) bit = -1; }
    }
    for (; bit >= 0; --bit) {
        const unsigned cand = prefix | (1u << bit);
        const int cnt = count_ge<NV>(k, cand);
        if (cnt >= 16) prefix = cand;
        if (cnt == 16) break;
    }
    return prefix;
}
__device__ __forceinline__ unsigned umin_(unsigned a, unsigned b) { return a < b ? a : b; }
__device__ __forceinline__ unsigned umax_(unsigned a, unsigned b) { return a > b ? a : b; }
__device__ __forceinline__ unsigned med3u(unsigned x, unsigned y, unsigned z) { return umax_(umin_(x, y), umin_(umax_(x, y), z)); }
__device__ __forceinline__ float unkey(unsigned k) { return __uint_as_float((k & 0x80000000u) ? (k ^ 0x80000000u) : ~k); }
__device__ __forceinline__ void ins16(unsigned (&a)[16], unsigned x) {
#pragma unroll
    for (int s = 15; s >= 1; --s) a[s] = med3u(a[s - 1], x, a[s]);
    a[0] = umax_(a[0], x);
}
__device__ __forceinline__ unsigned sel16(const unsigned (&a)[16], int i) {
    unsigned r = a[0];
#pragma unroll
    for (int t = 1; t < 16; ++t) r = (i == t) ? a[t] : r;
    return r;
}
__device__ __forceinline__ void phase_topk(const Params& p, int M, LAS unsigned char* lds) {
    const int tid_ = otid();
    LAS unsigned* lk = (LAS unsigned*)lds + tid_;
    const int gl = blockIdx.x * NTHREADS + tid_, nl = gridDim.x * NTHREADS;
    const float* SC = (const float*)(p.ws + OFF_P + Q_SC);
    int* IDX = (int*)(p.ws + OFF_P + Q_IDX); float* GATE = (float*)(p.ws + OFF_P + Q_GATE);
    const int ntask = M * 8;
    for (int task = gl; task < ntask; task += nl) {
        const float* sc = SC + (size_t)task * 256;
        unsigned a[16], b[16];
#pragma unroll
        for (int i = 0; i < 16; ++i) { a[i] = 0u; b[i] = 0u; }
#pragma unroll 4
        for (int i4 = 0; i4 < 32; ++i4) {
            const f32x4 va = *(const f32x4*)(sc + i4 * 4), vb = *(const f32x4*)(sc + 128 + i4 * 4);
#pragma unroll
            for (int e = 0; e < 4; ++e) { const unsigned tag = 127u - (unsigned)(i4 * 4 + e);
                ins16(a, (fkey(va[e]) & ~127u) | tag); ins16(b, (fkey(vb[e]) & ~127u) | tag); }
        }
        float fa[16], fb[16];
#pragma unroll
        for (int i = 0; i < 16; ++i) { fa[i] = unkey(a[i] & ~127u); fb[i] = unkey(b[i] & ~127u); }
        unsigned c[16];
#pragma unroll
        for (int i = 0; i < 16; ++i) c[i] = 0u;
#pragma unroll
        for (int i = 0; i < 16; ++i)
#pragma unroll
            for (int j = 0; j < 16; ++j)
                if ((i + 1) * (j + 1) <= 16) ins16(c, (fkey(fa[i] + fb[j]) & ~255u) | (unsigned)(i * 16 + j));
#pragma unroll
        for (int i = 0; i < 16; ++i) { lk[i * 512] = a[i]; lk[(16 + i) * 512] = b[i]; }
        const float mx = unkey(c[0] & ~255u);
        float ev[16]; float sm = 0.f; int id[16];
#pragma unroll
        for (int s = 0; s < 16; ++s) { ev[s] = __expf(unkey(c[s] & ~255u) - mx); sm += ev[s];
            const int ij = (int)(c[s] & 255u);
            const unsigned ka = lk[(ij >> 4) * 512], kb = lk[(16 + (ij & 15)) * 512];
            id[s] = (int)(127u - (ka & 127u)) * 128 + (int)(127u - (kb & 127u)); }
        const float inv = 1.0f / sm;
#pragma unroll
        for (int q = 0; q < 4; ++q) {
            u32x4 iw; iw.x = (unsigned)id[4 * q]; iw.y = (unsigned)id[4 * q + 1]; iw.z = (unsigned)id[4 * q + 2]; iw.w = (unsigned)id[4 * q + 3];
            *(u32x4*)(IDX + (size_t)task * 16 + q * 4) = iw;
            *(f32x4*)(GATE + (size_t)task * 16 + q * 4) = (f32x4){ev[4 * q] * inv, ev[4 * q + 1] * inv, ev[4 * q + 2] * inv, ev[4 * q + 3] * inv};
        }
    }
}

__device__ __forceinline__ float dot2u(unsigned a, unsigned b, float acc) {
    return __builtin_amdgcn_fdot2_f32_bf16(__builtin_bit_cast(bf16x2_t, a), __builtin_bit_cast(bf16x2_t, b), acc, false);
}
__device__ __forceinline__ float dot8(const u32x4 a, const u32x4 b, float acc) {
    acc = dot2u(a.x, b.x, acc); acc = dot2u(a.y, b.y, acc); acc = dot2u(a.z, b.z, acc); acc = dot2u(a.w, b.w, acc);
    return acc;
}
__device__ __forceinline__ void phase_peer(const Params& p, int l, int M, LAS unsigned char* lds, bool dry = false) {
    const int tid_ = otid();
    const int lane = tid_ & 63, wv_ = __builtin_amdgcn_readfirstlane(tid_ >> 6), gw = blockIdx.x * 8 + wv_, nw = gridDim.x * 8;
    LAS float* wl = (LAS float*)(lds + wv_ * 512);
    const bf16_t* H = (const bf16_t*)(p.ws + OFF_H);
    const unsigned char* U6 = p.ws + OFF_P + Q_UT; const unsigned char* V6 = p.ws + OFF_P + Q_VT;
    const float* USC = (const float*)(p.ws + OFF_P + Q_USC); const float* VSC = (const float*)(p.ws + OFF_P + Q_VSC);
    const int* IDX = (const int*)(p.ws + OFF_P + Q_IDX); const float* GATE = (const float*)(p.ws + OFF_P + Q_GATE);
    const float* modl = (const float*)(p.ws + OFF_MODV) + (size_t)l * 17 * NMOD + 10240;
    float* XC = (float*)(p.ws + OFF_XC);
    const unsigned lane24 = (unsigned)lane * 24u;
#define PEER_LOAD(buf, TAB, g) do { const int _is = ((g) < 8) ? id0 : id1; _Pragma("unroll") for (int e = 0; e < 8; ++e) { \
        const int _id = __builtin_amdgcn_readlane(_is, (((g) * 8 + e) & 63)); const unsigned char* _rb = (TAB) + (size_t)(unsigned)_id * 1536u; \
        const u32x4 _a = *(const u32x4*)(_rb + lane24); const u32x2 _b = *(const u32x2*)(_rb + lane24 + 16); \
        buf[e][0] = _a.x; buf[e][1] = _a.y; buf[e][2] = _a.z; buf[e][3] = _a.w; buf[e][4] = _b.x; buf[e][5] = _b.y; } } while (0)
    for (int row = gw; row < M; row += nw) {
        unsigned xw[16];
#pragma unroll
        for (int j = 0; j < 8; ++j) { const u32x2 a = *(const u32x2*)(H + (size_t)row * D + j * 256 + lane * 4); xw[2 * j] = a.x; xw[2 * j + 1] = a.y; }
        const int id0 = IDX[(size_t)row * 128 + lane], id1 = IDX[(size_t)row * 128 + 64 + lane];
        const float g0 = GATE[(size_t)row * 128 + lane], g1 = GATE[(size_t)row * 128 + 64 + lane];
        const float us0 = USC[id0], us1 = USC[id1];
        const float gv0 = g0 * VSC[id0], gv1 = g1 * VSC[id1];
        u32x6 bA[8];
#pragma unroll 1
        for (int g = 0; g < 16; ++g) {
            PEER_LOAD(bA, U6, g);
            float part[8];
            float chain = 0.f;
#pragma unroll
            for (int e = 0; e < 8; ++e) { asm volatile("" : "+v"(bA[e]), "+v"(chain));
                const bf16x32_t ub = __builtin_amdgcn_cvt_scalef32_pk32_bf16_fp6(bA[e], 1.0f);
                const u32x16 uw = __builtin_bit_cast(u32x16, ub);
                float a0 = 0.f, a1 = 0.f;
#pragma unroll
                for (int i = 0; i < 8; ++i) { const unsigned w0 = uw[2 * i], w1 = uw[2 * i + 1]; a0 = dot2u(w0, xw[2 * i], a0); a1 = dot2u(w1, xw[2 * i + 1], a1); }
                part[e] = a0 + a1; chain = part[e]; }
            float r4[4];
#pragma unroll
            for (int i = 0; i < 4; ++i) { const bool hi = (lane & 32) != 0; const float keep = hi ? part[i + 4] : part[i], send = hi ? part[i] : part[i + 4]; r4[i] = keep + __shfl_xor(send, 32); }
            float r2[2];
#pragma unroll
            for (int i = 0; i < 2; ++i) { const bool hi = (lane & 16) != 0; const float keep = hi ? r4[i + 2] : r4[i], send = hi ? r4[i] : r4[i + 2]; r2[i] = keep + __shfl_xor(send, 16); }
            float r1;
            { const bool hi = (lane & 8) != 0; const float keep = hi ? r2[1] : r2[0], send = hi ? r2[0] : r2[1]; r1 = keep + __shfl_xor(send, 8); }
            r1 += __shfl_xor(r1, 4); r1 += __shfl_xor(r1, 2); r1 += __shfl_xor(r1, 1);
            const int k = g * 8 + ((lane >> 3) & 7);
            const float usk = __shfl((g < 8) ? us0 : us1, k & 63), gvk = __shfl((g < 8) ? gv0 : gv1, k & 63);
            if ((lane & 7) == 0) wl[k] = gelu_f(r1 * usk) * gvk;
        }
        asm volatile("s_waitcnt lgkmcnt(0)" ::: "memory");
        float out[32];
#pragma unroll
        for (int i = 0; i < 32; ++i) out[i] = 0.f;
#pragma unroll 1
        for (int g = 0; g < 16; ++g) {
            PEER_LOAD(bA, V6, g);
#pragma unroll
            for (int e = 0; e < 8; ++e) { const float wk = wl[g * 8 + e]; asm volatile("" : "+v"(bA[e]), "+v"(out[0]), "+v"(out[9]), "+v"(out[18]), "+v"(out[27]), "+v"(out[31]));
                const f32x32 un = __builtin_amdgcn_cvt_scalef32_pk32_f32_fp6(bA[e], 1.0f);
#pragma unroll
                for (int i = 0; i < 32; ++i) out[i] += wk * un[i]; }
        }
        asm volatile("s_waitcnt lgkmcnt(0)" ::: "memory");
        const bool lat = row < TL; const int mb = lat ? (row >> 11) : 16;
        float* xp = lat ? p.out + (size_t)row * D : XC + (size_t)(row - TL) * D;
        const float* gv = modl + (size_t)mb * NMOD;
        f32x4 xn[8]; float ss = 0.f;
#pragma unroll
        for (int j = 0; j < 8; ++j) { const int e = j * 256 + lane * 4;
            const f32x4 o4 = (f32x4){out[4 * j], out[4 * j + 1], out[4 * j + 2], out[4 * j + 3]};
            xn[j] = *(const f32x4*)(xp + e) + *(const f32x4*)(gv + e) * o4;
            ss += xn[j][0] * xn[j][0] + xn[j][1] * xn[j][1] + xn[j][2] * xn[j][2] + xn[j][3] * xn[j][3]; }
        ss = wave_sum(ss);
        const float rs = rsqrtf(ss * (1.0f / 2048.0f) + 1e-6f);
        if (!dry || p.ws == nullptr) {
            if (l == 0) {
                const float* m1 = (const float*)(p.ws + OFF_MODV) + (size_t)17 * NMOD + (size_t)mb * NMOD;
                float am = 0.f;
#pragma unroll
                for (int j = 0; j < 8; ++j) { const int e = j * 256 + lane * 4;
                    *(f32x4*)(xp + e) = xn[j];
                    xn[j] = xn[j] * rs * (*(const f32x4*)(m1 + 2048 + e) + 1.0f) + *(const f32x4*)(m1 + e);
                    am = fmaxf(am, fmaxf(fmaxf(fabsf(xn[j][0]), fabsf(xn[j][1])), fmaxf(fabsf(xn[j][2]), fabsf(xn[j][3])))); }
#pragma unroll
                for (int o = 32; o >= 1; o >>= 1) am = fmaxf(am, __shfl_xor(am, o));
                const float qs = am > 0.f ? 240.0f / am : 1.0f;
                unsigned char* H8 = p.ws + OFF_H8 + (size_t)row * D;
#pragma unroll
                for (int j = 0; j < 8; ++j) *(unsigned*)(H8 + j * 256 + lane * 4) = pack_fp8x4(xn[j][0] * qs, xn[j][1] * qs, xn[j][2] * qs, xn[j][3] * qs);
                if (lane == 0) ((float*)(p.ws + OFF_HS))[row] = am > 0.f ? am * (1.0f / 240.0f) : 1.0f;
            } else {
#pragma unroll
                for (int j = 0; j < 8; ++j) { const int e = j * 256 + lane * 4; *(f32x4*)(xp + e) = xn[j] * rs * *(const f32x4*)(p.final_g + e); }
            }
        }
    }
#undef PEER_LOAD
}

__device__ __forceinline__ Params load_params() {
    Params r;
#if defined(__HIP_DEVICE_COMPILE__)
    typedef const unsigned long long __attribute__((address_space(4)))* KP;
    KP k = (KP)__builtin_amdgcn_kernarg_segment_ptr();
    asm volatile("" : "+s"(k));
    void** d = (void**)&r;
#pragma unroll
    for (int i = 0; i < (int)(sizeof(Params) / 8); ++i) d[i] = (void*)(__attribute__((address_space(1))) void*)k[i];
#endif
    return r;
}
#define WSP(off) (p.ws + (off))
template <int l>
__device__ __forceinline__ void mega_layer(LAS unsigned char* lds, const XcdBarrier& bar) {
        const int Mrows = (l == 0) ? TT : TL;
        if (l == 0) {
            { const Params p = load_params(); phase_wconv(p, 0, lds); }
            { const Params p = load_params(); phase_norm<0, true>(p, 0, TT, 0, 2048); }
            xcd_barrier(bar);
        }
        { const Params p = load_params(); EpiInProj E{WSP(OFF_P), (const float*)WSP(OFF_HS), (const unsigned*)WSP(OFF_CMAX) + (size_t)l * INC};
          run_gemm(lds, (const bf16_t*)WSP(OFF_H8), (const bf16_t*)WSP(OFF_W + W_IN), TT, INC, D / 2, E); }
        xcd_barrier(bar);
        { const Params p = load_params(); phase_hgrn(p, l, lds); }
        __syncthreads();
        { const Params p = load_params(); phase_s5(p, l, lds); }
        xcd_barrier(bar);
        { const Params p = load_params(); phase_gmlp(p, l, Mrows, lds); }
        { const Params p = load_params(); phase_hcomb(p, l, Mrows); }
        { const Params p = load_params(); phase_s5post(p, l, Mrows); }
        xcd_barrier(bar);
        { const Params p = load_params(); EpiGlu E{(bf16_t*)WSP(OFF_P + P_CU)}; run_gemm(lds, (const bf16_t*)WSP(OFF_H + H_YSF), (const bf16_t*)WSP(OFF_W + W_GLU), Mrows, 1536, 768, E); }
        { const Params p = load_params(); EpiMerge<true> E{(bf16_t*)WSP(OFF_P + P_MERGED), (const bf16_t*)WSP(OFF_P + P_GATES)}; run_gemm(lds, (const bf16_t*)WSP(OFF_P + P_AU), (const bf16_t*)WSP(OFF_W + W_A), Mrows, D, 1024, E); }
        { const Params p = load_params(); EpiMerge<false> E{(bf16_t*)WSP(OFF_P + P_MERGED), (const bf16_t*)WSP(OFF_P + P_GATES) + 2048}; run_gemm(lds, (const bf16_t*)WSP(OFF_P + P_BFF), (const bf16_t*)WSP(OFF_W + W_B), Mrows, D, 1024, E); }
        xcd_barrier(bar);
        { const Params p = load_params(); EpiMerge<false> E{(bf16_t*)WSP(OFF_P + P_MERGED), (const bf16_t*)WSP(OFF_P + P_GATES) + 4096}; run_gemm(lds, (const bf16_t*)WSP(OFF_P + P_CU), (const bf16_t*)WSP(OFF_W + W_C), Mrows, D, 768, E); }
        xcd_barrier(bar);
        { const Params p = load_params(); EpiResid E{p.out, (float*)WSP(OFF_XC), (const float*)WSP(OFF_MODV) + (size_t)l * 17 * NMOD + 4096}; run_gemm(lds, (const bf16_t*)WSP(OFF_P + P_MERGED), (const bf16_t*)WSP(OFF_W + W_O), Mrows, D, D, E); }
        { const Params p = load_params(); phase_tabconv(p, l); }
        xcd_barrier(bar);
        { const Params p = load_params(); phase_norm<1>(p, l, Mrows, 6144, 8192); }
        xcd_barrier(bar);
        { const Params p = load_params(); EpiF32 E{(float*)WSP(OFF_P + Q_SC), 2048}; run_gemm(lds, (const bf16_t*)WSP(OFF_H), (const bf16_t*)WSP(OFF_W + W_S), Mrows, D, D, E); }
        xcd_barrier(bar);
        { const Params p = load_params(); phase_topk(p, Mrows, lds); }
        xcd_barrier(bar);
        { const Params p = load_params(); phase_peer(p, l, Mrows, lds); }
        if (l == 0) {
            __syncthreads();
            { const Params p = load_params(); phase_wconv(p, 1, lds); }
            xcd_barrier(bar);
        }
}
#undef WSP
__global__ void __launch_bounds__(NTHREADS, 2) k_mega(Params p_kernarg_only) {
    extern __shared__ __attribute__((aligned(16))) unsigned char smem[];
    LAS unsigned char* lds = (LAS unsigned char*)smem;
    volatile LAS unsigned* xbw = (volatile LAS unsigned*)(lds + LDS_BYTES - 16);
    if (threadIdx.x == 0) { xbw[0] = 0u; xbw[1] = 0u; xbw[2] = 0u; xbw[3] = 0u; }
    __syncthreads();
    XcdBarrier bar;
    { const Params p = load_params(); bar = xcd_barrier_post((unsigned*)(p.ws + OFF_BAR), xbw); }
#define WSP(off) (p.ws + (off))
    { const Params p = load_params(); phase_colmax(p); }
    { const Params p = load_params(); phase_prep(p); phase_mod(p, lds); }
    xcd_barrier(bar);
    mega_layer<0>(lds, bar);
    mega_layer<1>(lds, bar);
#undef WSP
}

extern "C" void kernel_launch(void* const* d_in, const int* in_sizes, int n_in, void* d_out, int out_size, void* d_ws, size_t ws_size, hipStream_t stream) {
    (void)in_sizes; (void)n_in; (void)out_size; (void)ws_size;
    Params p;
    const float** f = (const float**)&p;
    for (int i = 0; i < 31; ++i) f[i] = (const float*)d_in[i];
    p.out = (float*)d_out; p.ws = (unsigned char*)d_ws;
    static int grid = 0;
    if (!grid) {
        int dev = 0, cus = 0, per_cu = 0;
        (void)hipGetDevice(&dev);
        (void)hipDeviceGetAttribute(&cus, hipDeviceAttributeMultiprocessorCount, dev);
        (void)hipFuncSetAttribute((const void*)k_mega, hipFuncAttributeMaxDynamicSharedMemorySize, LDS_BYTES);
        (void)hipOccupancyMaxActiveBlocksPerMultiprocessor(&per_cu, (const void*)k_mega, NTHREADS, LDS_BYTES);
        grid = (per_cu >= 1 && cus > 0) ? (cus < 256 ? cus : 256) : 256;
    }
    (void)hipMemsetAsync(p.ws + OFF_BAR, 0, XCD_BAR_WORDS * sizeof(unsigned), stream);
    (void)hipMemsetAsync(p.ws + OFF_CMAX, 0, (size_t)2 * INC * sizeof(unsigned), stream);
    hipLaunchKernelGGL(k_mega, dim3(grid), dim3(NTHREADS), LDS_BYTES, stream, p);
}
```

```cpp
#include <hip/hip_runtime.h>
#include <stdint.h>

#define LAS __attribute__((address_space(3)))
typedef unsigned short bf16_t;
typedef short bf16x8 __attribute__((ext_vector_type(8)));
typedef float f32x4 __attribute__((ext_vector_type(4)));
typedef float f32x2 __attribute__((ext_vector_type(2)));
typedef unsigned u32x4 __attribute__((ext_vector_type(4)));
typedef unsigned u32x2 __attribute__((ext_vector_type(2)));
typedef __bf16 bf16x2_t __attribute__((ext_vector_type(2)));
typedef __bf16 bf16x32_t __attribute__((ext_vector_type(32)));
typedef float f32x32 __attribute__((ext_vector_type(32)));
typedef unsigned u32x6 __attribute__((ext_vector_type(6)));
typedef unsigned u32x16 __attribute__((ext_vector_type(16)));

constexpr int D = 2048, NB = 16, SEQ = 2048, CTXL = 256;
constexpr int TL = NB * SEQ;
constexpr int TC = NB * CTXL;
constexpr int TT = TL + TC;
constexpr int INC = 14080;
constexpr int NMOD = 12288;
constexpr int NTHREADS = 512;
constexpr int LDS_BYTES = 160 * 1024;

constexpr size_t OFF_BAR = 0;
constexpr size_t OFF_MODV = 16384;
constexpr size_t OFF_LB = OFF_MODV + (size_t)2 * 17 * NMOD * 4;
constexpr size_t OFF_S5LAM = OFF_LB + 2 * 2 * 1024 * 4;
constexpr size_t OFF_S5BB = OFF_S5LAM + (size_t)2 * 2 * 48 * 64 * 2 * 4;
constexpr size_t OFF_PE = OFF_S5BB + (size_t)2 * 2 * 48 * 64 * 32 * 4;
constexpr size_t OFF_CMAX = (OFF_PE + (size_t)96 * 1024 * 4 + 255) & ~(size_t)255;
constexpr size_t OFF_HS = OFF_CMAX + (size_t)2 * INC * 4;
constexpr size_t OFF_XC = (OFF_HS + (size_t)TT * 4 + 255) & ~(size_t)255;
constexpr size_t OFF_H = OFF_XC + (size_t)TC * D * 4;
constexpr size_t OFF_W = OFF_H + (size_t)TT * D * 2;
constexpr size_t W_IN = 0;
constexpr size_t W_GLU = W_IN + (size_t)INC * D;
constexpr size_t W_A = W_GLU + (size_t)1536 * 768 * 2;
constexpr size_t W_B = W_A + (size_t)2048 * 1024 * 2;
constexpr size_t W_C = W_B + (size_t)2048 * 1024 * 2;
constexpr size_t W_O = W_C + (size_t)2048 * 768 * 2;
constexpr size_t W_S = W_O + (size_t)2048 * 2048 * 2;
constexpr size_t W_TOTAL = W_S + (size_t)2048 * 2048 * 2;
constexpr size_t OFF_P = OFF_W + W_TOTAL;
constexpr size_t SEG = (size_t)TT * 1024 * 2;
constexpr size_t P_AU = 0, P_AV = SEG, P_BQ = 2 * SEG, P_BFF = 3 * SEG, P_BFB = 4 * SEG, P_BI = 5 * SEG, P_BG = 6 * SEG;
constexpr size_t P_CU = 7 * SEG;
constexpr size_t P_GATES = P_CU + (size_t)TT * 768 * 2;
constexpr size_t P_TOTAL = P_GATES + (size_t)TT * 6144 * 2;
constexpr size_t P_MERGED = SEG;
constexpr size_t Q_UT = 0;
constexpr size_t Q_VT = Q_UT + (size_t)16384 * 1536;
constexpr size_t Q_USC = Q_VT + (size_t)16384 * 1536;
constexpr size_t Q_VSC = Q_USC + (size_t)16384 * 4;
constexpr size_t Q_SC = Q_VSC + (size_t)16384 * 4;
constexpr size_t Q_IDX = Q_SC + (size_t)TT * 2048 * 4;
constexpr size_t Q_GATE = Q_IDX + (size_t)TT * 128 * 4;
constexpr size_t H_YSF = 0;
constexpr size_t H_YSB = (size_t)TT * 768 * 2;
constexpr size_t OFF_H8 = OFF_P + P_TOTAL;
constexpr size_t WS_NEEDED = OFF_H8 + (size_t)TT * D;

struct Params {
    const float *x, *c, *ctx, *c_ctx, *w_mod, *b_mod, *w_in, *ln_g, *ln_b, *w_s, *b_s, *lb_logits, *hn_g;
    const float *lam_re, *lam_im, *log_step, *b_re, *b_im, *c_re, *c_im, *s5_d, *w_glu, *wa, *wb, *wc, *wo, *w_q, *sub_keys, *peer_u, *peer_v, *final_g;
    float* out;
    unsigned char* ws;
};

__device__ __forceinline__ float bf_lo(unsigned u) { return __uint_as_float(u << 16); }
__device__ __forceinline__ float bf_hi(unsigned u) { return __uint_as_float(u & 0xffff0000u); }
__device__ __forceinline__ unsigned cvt_pk_bf16(float lo, float hi) { f32x2 v; v.x = lo; v.y = hi; const bf16x2_t b = __builtin_convertvector(v, bf16x2_t); return __builtin_bit_cast(unsigned, b); }
__device__ __forceinline__ float fexp(float x) { return __builtin_amdgcn_exp2f(x * 1.44269504f); }
__device__ __forceinline__ float flog(float x) { return __builtin_amdgcn_logf(x) * 0.693147181f; }
__device__ __forceinline__ float fast_sigmoid(float x) { return __builtin_amdgcn_rcpf(1.0f + fexp(-x)); }
__device__ __forceinline__ float fast_silu(float x) { return x * fast_sigmoid(x); }
__device__ __forceinline__ float gelu_f(float v) {
    const float av = fabsf(v), t = __builtin_amdgcn_rcpf(av * 0.2316418882f + 1.0f);
    float q = t * 0.5307027145f + (-0.7265760135f); q = q * t + 0.7107068705f; q = q * t + (-0.142248368f); q = q * t + 0.127414796f; q = q * t;
    const float e = __builtin_amdgcn_exp2f((v * v) * (-0.72134752044f));
    const float m = v * (q * e);
    return v < 0.f ? m : v - m;
}
__device__ __forceinline__ unsigned pack_fp8x4(float a, float b, float c, float d) {
    int pk = 0; pk = __builtin_amdgcn_cvt_pk_fp8_f32(a, b, pk, false); pk = __builtin_amdgcn_cvt_pk_fp8_f32(c, d, pk, true); return (unsigned)pk;
}
template <int CTRL> __device__ __forceinline__ float dpp_f(float v) { return __int_as_float(__builtin_amdgcn_update_dpp(0, __float_as_int(v), CTRL, 0xF, 0xF, false)); }
__device__ __forceinline__ float row16_max(float v) { v = fmaxf(v, dpp_f<0x128>(v)); v = fmaxf(v, dpp_f<0x124>(v)); v = fmaxf(v, dpp_f<0x122>(v)); v = fmaxf(v, dpp_f<0x121>(v)); return v; }
__device__ __forceinline__ float row16_sum(float v) { v += dpp_f<0x128>(v); v += dpp_f<0x124>(v); v += dpp_f<0x122>(v); v += dpp_f<0x121>(v); return v; }
__device__ __forceinline__ float wave_sum(float v) {
#pragma unroll
    for (int o = 32; o >= 1; o >>= 1) v += __shfl_xor(v, o);
    return v;
}
__device__ __forceinline__ int otid() { int t; asm volatile("v_mov_b32 %0, %1" : "=v"(t) : "v"((int)threadIdx.x)); return t; }


#define XB_TMO      128
#define XB_XCNT(j)  (256  + 64 * (j))
#define XB_XSUB(j)  (1280 + 64 * (j))
#define XB_XGEN(j)  (2304 + 64 * (j))
#define XB_TOP      3328
#define XB_TOPGEN   3392
#define XCD_BAR_WORDS 3456
#define XB_SPIN_CAP (1u << 22)
__device__ __forceinline__ unsigned xb_ld(unsigned* p)              { return __hip_atomic_load(p, __ATOMIC_RELAXED, __HIP_MEMORY_SCOPE_AGENT); }
__device__ __forceinline__ unsigned xb_add(unsigned* p, unsigned v) { return __hip_atomic_fetch_add(p, v, __ATOMIC_RELAXED, __HIP_MEMORY_SCOPE_AGENT); }
__device__ __forceinline__ unsigned xb_xcc_id() { return (unsigned)__builtin_amdgcn_s_getreg((3 << 11) | 20) & 0xFu; }
#define XB_SPIN(cond, bar) do { unsigned _sp = 0; while (cond) { __builtin_amdgcn_s_sleep(1); \
    if ((++_sp & 255u) == 0u) { if (xb_ld(&(bar)[XB_TMO])) break; if (_sp > XB_SPIN_CAP) { atomicAdd(&(bar)[XB_TMO], 1u); break; } } } } while (0)
struct XcdBarrier { unsigned* bar; unsigned x; volatile LAS unsigned* st; };
__device__ __forceinline__ XcdBarrier xcd_barrier_post(unsigned* bar, volatile LAS unsigned* st) {
    XcdBarrier b; b.bar = bar; b.x = xb_xcc_id(); b.st = st;
    if (threadIdx.x == 0) (void)xb_add(&bar[XB_XCNT(b.x)], 1u);
    return b;
}
__device__ __forceinline__ void xcd_barrier_complete(unsigned* bar, unsigned x, unsigned& nloc, unsigned& nx) {
    const unsigned G = gridDim.x * gridDim.y * gridDim.z;
    unsigned sum, cnt, mine, sp = 0u;
    for (;;) {
        sum = 0u; cnt = 0u; mine = 0u;
#pragma unroll
        for (unsigned j = 0; j < 16; ++j) { const unsigned c = xb_ld(&bar[XB_XCNT(j)]); sum += c; cnt += (c > 0u) ? 1u : 0u; mine = (j == x) ? c : mine; }
        if (sum == G) break;
        __builtin_amdgcn_s_sleep(1);
        if ((++sp & 255u) == 0u) { if (xb_ld(&bar[XB_TMO])) break; if (sp > XB_SPIN_CAP) { atomicAdd(&bar[XB_TMO], 1u); break; } }
    }
    nloc = mine > 0u ? mine : 1u; nx = cnt > 0u ? cnt : 1u;
}
__device__ __forceinline__ void xcd_barrier(const XcdBarrier& b) {
    asm volatile("s_waitcnt vmcnt(0)" ::: "memory");
    __syncthreads();
    if (threadIdx.x == 0) {
        unsigned* bar = b.bar;
        __builtin_amdgcn_s_waitcnt(0);
        unsigned nloc = b.st[0], nx = b.st[1];
        if (nloc == 0u) { xcd_barrier_complete(bar, b.x, nloc, nx); b.st[0] = nloc; b.st[1] = nx; }
        const unsigned old = xb_add(&bar[XB_XSUB(b.x)], 1u);
        const unsigned gen = old / nloc;
        if (old + 1u == (gen + 1u) * nloc) {
            __builtin_amdgcn_fence(__ATOMIC_RELEASE, "agent");
            asm volatile("s_waitcnt vmcnt(0)" ::: "memory");
            const unsigned og = xb_add(&bar[XB_TOP], 1u);
            const unsigned tg = og / nx;
            if (og + 1u == (tg + 1u) * nx) xb_add(&bar[XB_TOPGEN], 1u);
            else XB_SPIN(xb_ld(&bar[XB_TOPGEN]) == tg, bar);
            __builtin_amdgcn_fence(__ATOMIC_ACQUIRE, "agent");
            xb_add(&bar[XB_XGEN(b.x)], 1u);
            asm volatile("s_waitcnt vmcnt(0)" ::: "memory");
        } else {
            XB_SPIN(xb_ld(&bar[XB_XGEN(b.x)]) == gen, bar);
            __builtin_amdgcn_fence(__ATOMIC_ACQUIRE, "agent");
            asm volatile("s_waitcnt vmcnt(0)" ::: "memory");
        }
    }
    __syncthreads();
}

namespace pg8 {
constexpr int BM = 256, BK = 64, HALF = 128, HTB = HALF * BK * 2, STAGE_BYTES = 8 * HTB, NXCD = 8, WGM = 8;
__host__ __device__ __forceinline__ int lds_byte(int r, int c) { const int st = (r >> 4) * 2 + (c >> 5), rr = r & 15, cc = c & 31, ob = rr * 64 + cc * 2; return st * 1024 + (ob ^ (((ob >> 9) & 1) << 5)); }
__host__ __device__ __forceinline__ void stage_rc(int b, int& R, int& C) { const int st = b / 1024, sb = b % 1024, swz = sb ^ (((sb >> 9) & 1) << 5); R = (st >> 1) * 16 + swz / 64; C = (st & 1) * 32 + (swz % 64) / 2; }
__host__ __device__ __forceinline__ int perm32(int rho) { const int n = rho >> 4, i = rho & 15; return 8 * (i >> 2) + 4 * n + (i & 3); }
typedef int i32x8 __attribute__((ext_vector_type(8)));
__device__ __forceinline__ i32x8 cat8(const bf16x8 a, const bf16x8 b) { const u32x4 x = __builtin_bit_cast(u32x4, a), y = __builtin_bit_cast(u32x4, b); i32x8 r; r[0] = (int)x.x; r[1] = (int)x.y; r[2] = (int)x.z; r[3] = (int)x.w; r[4] = (int)y.x; r[5] = (int)y.y; r[6] = (int)y.z; r[7] = (int)y.w; return r; }
struct Unit { int pm, pn; };
struct Gemm { const bf16_t* A; const bf16_t* Bt; int M, N, K; };
struct StaticOrder {
    int nM, nN, nwg, G, c;
    __device__ void init(int M, int N, int G_, int c_) { nM = M / BM; nN = N / BM; nwg = nM * nN; G = G_; c = c_; }
    __device__ bool next(int i, Unit& u) const {
        const long L = (long)i * G + c; if (L >= nwg) return false;
        int wgid = (int)L; { const int q = nwg / NXCD, r = nwg % NXCD, xcd = wgid % NXCD, off = wgid / NXCD; wgid = (xcd < r ? xcd * (q + 1) : r * (q + 1) + (xcd - r) * q) + off; }
        const int nig = WGM * nN, gid = wgid / nig, fm = gid * WGM, gsz = (nM - fm) < WGM ? (nM - fm) : WGM;
        u.pm = fm + ((wgid % nig) % gsz); u.pn = (wgid % nig) / gsz; return true;
    }
};

template <class Epi, class Sched>
__device__ __forceinline__ void gemm_phase(LAS unsigned char* lds, const Gemm g, const Sched& S, const Epi& E) {
    const int tid_ = otid();
    const int tid = tid_, wid = __builtin_amdgcn_readfirstlane(tid >> 6), lane = tid & 63, wr = wid >> 2, wc = wid & 3, fr = lane & 15, fq = lane >> 4;
    const int K = g.K, nt = K / BK;
    unsigned voffA[2], voffB[2];
#pragma unroll
    for (int i = 0; i < 2; ++i) { int R, C; stage_rc(tid * 16 + i * 8192, R, C); const int Rb = Epi::PERM ? ((R & ~31) + perm32(R & 31)) : R;
        voffA[i] = (unsigned)(R * K + C) * 2u; voffB[i] = (unsigned)(Rb * K + C) * 2u; }
    const size_t kstep = (size_t)(BK * 2);
    const size_t hstep = (size_t)HALF * K * 2;
    const size_t tstep = 2 * hstep;
    const unsigned ldsw = (unsigned)wid * 1024u;
    const int aoff = lds_byte(wr * 64 + fr, fq * 8), boff = lds_byte(wc * 32 + fr, fq * 8);
    const int aoff8 = lds_byte(wr * 64 + fr, (fq >> 1) * 32 + (fq & 1) * 16), boff8 = lds_byte(wc * 32 + fr, (fq >> 1) * 32 + (fq & 1) * 16);
#define PG8_SA(b, h) (((b) * 2 + (h)) * HTB)
#define PG8_SB(b, h) ((4 + (b) * 2 + (h)) * HTB)
#define PG8_STAGE(bufoff, gbase, voff) do { _Pragma("unroll") for (int _i = 0; _i < 2; ++_i) \
        __builtin_amdgcn_global_load_lds((const unsigned*)((const char*)(gbase) + (voff)[_i]), (LAS unsigned*)(lds + (bufoff) + ldsw + _i * 8192), 16, 0, 0); } while (0)
#define PG8_LDA(dst, b, h) do { if constexpr (Epi::FP8) { _Pragma("unroll") for (int m = 0; m < 4; ++m) dst##8[m] = cat8(*(const LAS bf16x8*)(lds + PG8_SA(b, h) + aoff + m * 2048), *(const LAS bf16x8*)(lds + PG8_SA(b, h) + aoff + m * 2048 + 1024)); } \
        else { _Pragma("unroll") for (int m = 0; m < 4; ++m) _Pragma("unroll") for (int k = 0; k < 2; ++k) dst[m][k] = *(const LAS bf16x8*)(lds + PG8_SA(b, h) + aoff + m * 2048 + k * 1024); } } while (0)
#define PG8_LDB(dst, b, h) do { if constexpr (Epi::FP8) { _Pragma("unroll") for (int n = 0; n < 2; ++n) dst##8[n] = cat8(*(const LAS bf16x8*)(lds + PG8_SB(b, h) + boff + n * 2048), *(const LAS bf16x8*)(lds + PG8_SB(b, h) + boff + n * 2048 + 1024)); } \
        else { _Pragma("unroll") for (int n = 0; n < 2; ++n) _Pragma("unroll") for (int k = 0; k < 2; ++k) dst[n][k] = *(const LAS bf16x8*)(lds + PG8_SB(b, h) + boff + n * 2048 + k * 1024); } } while (0)
#define PG8_MMA(ai, bj, At, Bt) do { __builtin_amdgcn_s_setprio(1); _Pragma("unroll") for (int m = 0; m < 4; ++m) _Pragma("unroll") for (int n = 0; n < 2; ++n) { \
        if constexpr (Epi::FP8) { asm volatile("v_mfma_scale_f32_16x16x128_f8f6f4 %0, %1, %2, %0, %3, %3 op_sel_hi:[0,0,0]" : "+v"(acc[ai][bj][m][n]) : "v"(Bt##8[n]), "v"(At##8[m]), "v"(one_scale)); } \
        else { _Pragma("unroll") for (int k = 0; k < 2; ++k) acc[ai][bj][m][n] = __builtin_amdgcn_mfma_f32_16x16x32_bf16(Bt[n][k], At[m][k], acc[ai][bj][m][n], 0, 0, 0); } } \
        __builtin_amdgcn_s_setprio(0); } while (0)
#define PG8_WAIT_V(n) asm volatile("s_waitcnt vmcnt(" #n ")" ::: "memory")
#define PG8_WAIT_L(n) asm volatile("s_waitcnt lgkmcnt(" #n ")" ::: "memory")
#define PG8_BAR __builtin_amdgcn_s_barrier()
#define PG8_SCHED __builtin_amdgcn_sched_barrier(0)
    Unit cur, nxt; int ui = 0;
    if (!S.next(0, cur)) return;
    f32x4 acc[2][2][4][2];
#pragma unroll
    for (int a = 0; a < 2; ++a)
#pragma unroll
        for (int b = 0; b < 2; ++b)
#pragma unroll
            for (int m = 0; m < 4; ++m)
#pragma unroll
                for (int n = 0; n < 2; ++n) acc[a][b][m][n] = (f32x4){0.f, 0.f, 0.f, 0.f};
    bf16x8 At[4][2], B0[2][2], B1[2][2];
    i32x8 At8[4], B08[2], B18[2];
    const int one_scale = 0x7F7F7F7F;
    const char* cA = (const char*)g.A + (size_t)cur.pm * tstep; const char* cB = (const char*)g.Bt + (size_t)cur.pn * tstep;
    PG8_STAGE(PG8_SB(0, 0), cB, voffB); PG8_STAGE(PG8_SA(0, 0), cA, voffA); PG8_STAGE(PG8_SB(0, 1), cB + hstep, voffB); PG8_STAGE(PG8_SA(0, 1), cA + hstep, voffA);
    if (wr == 1) PG8_BAR;
    PG8_WAIT_V(4); PG8_BAR;
    PG8_STAGE(PG8_SB(1, 0), cB + kstep, voffB); PG8_STAGE(PG8_SA(1, 0), cA + kstep, voffA); PG8_STAGE(PG8_SB(1, 1), cB + hstep + kstep, voffB);
    PG8_WAIT_V(6); PG8_BAR;
    for (;;) {
        const bool has_next = S.next(ui + 1, nxt);
        const char* nA = has_next ? (const char*)g.A + (size_t)nxt.pm * tstep : cA; const char* nB = has_next ? (const char*)g.Bt + (size_t)nxt.pn * tstep : cB;
        for (int t = 0; t < nt; t += 2) {
            const bool last = (t == nt - 2);
            const char* a1 = cA + (size_t)(t + 1) * kstep;
            const char* a2 = last ? nA : cA + (size_t)(t + 2) * kstep; const char* b2 = last ? nB : cB + (size_t)(t + 2) * kstep;
            const char* a3 = a2 + kstep; const char* b3 = b2 + kstep;
            PG8_LDB(B0, 0, 0); PG8_SCHED; PG8_LDA(At, 0, 0); PG8_STAGE(PG8_SA(1, 1), a1 + hstep, voffA);
            PG8_WAIT_L(8); PG8_BAR; PG8_WAIT_L(0); PG8_MMA(0, 0, At, B0); PG8_BAR; PG8_SCHED;
            PG8_LDB(B1, 0, 1); PG8_STAGE(PG8_SB(0, 0), b2, voffB);
            PG8_BAR; PG8_WAIT_L(0); PG8_MMA(0, 1, At, B1); PG8_BAR;
            PG8_LDA(At, 0, 1); PG8_STAGE(PG8_SA(0, 0), a2, voffA);
            PG8_BAR; PG8_WAIT_L(0); PG8_MMA(1, 0, At, B0); PG8_BAR; PG8_SCHED;
            PG8_STAGE(PG8_SB(0, 1), b2 + hstep, voffB);
            PG8_WAIT_V(6); PG8_BAR; PG8_MMA(1, 1, At, B1); PG8_BAR;
            PG8_LDB(B0, 1, 0); PG8_SCHED; PG8_LDA(At, 1, 0); PG8_STAGE(PG8_SA(0, 1), a2 + hstep, voffA);
            PG8_WAIT_L(8); PG8_BAR; PG8_WAIT_L(0); PG8_MMA(0, 0, At, B0); PG8_BAR; PG8_SCHED;
            PG8_LDB(B1, 1, 1); PG8_STAGE(PG8_SB(1, 0), b3, voffB);
            PG8_BAR; PG8_WAIT_L(0); PG8_MMA(0, 1, At, B1); PG8_BAR;
            PG8_LDA(At, 1, 1); PG8_STAGE(PG8_SA(1, 0), a3, voffA);
            PG8_BAR; PG8_WAIT_L(0); PG8_MMA(1, 0, At, B0); PG8_BAR; PG8_SCHED;
            PG8_STAGE(PG8_SB(1, 1), b3 + hstep, voffB);
            PG8_WAIT_V(6); PG8_BAR; PG8_MMA(1, 1, At, B1); PG8_BAR;
        }
        if constexpr (Epi::FP8) asm volatile("s_nop 15\n s_nop 15\n s_nop 15" ::: "memory");
        E(acc, cur, wr, wc, fr, fq);
        if (!has_next) break;
#pragma unroll
        for (int a = 0; a < 2; ++a)
#pragma unroll
            for (int b = 0; b < 2; ++b)
#pragma unroll
                for (int m = 0; m < 4; ++m)
#pragma unroll
                    for (int n = 0; n < 2; ++n) acc[a][b][m][n] = (f32x4){0.f, 0.f, 0.f, 0.f};
        cur = nxt; cA = nA; cB = nB; ++ui;
    }
    PG8_WAIT_V(0);
    if (wr == 0) PG8_BAR;
    PG8_BAR;
#undef PG8_SA
#undef PG8_SB
#undef PG8_STAGE
#undef PG8_LDA
#undef PG8_LDB
#undef PG8_MMA
#undef PG8_WAIT_V
#undef PG8_WAIT_L
#undef PG8_BAR
#undef PG8_SCHED
}
}

typedef f32x4 AccT[2][2][4][2];

struct EpiInProj {
    static constexpr bool PERM = true, FP8 = true;
    unsigned char* P;
    const float* sa;
    const unsigned* cmax;
    __device__ __forceinline__ void operator()(const AccT& acc, const pg8::Unit& u, int wr, int wc, int fr, int fq) const {
        const int pn = u.pn;
        bf16_t* base; int ld, lc, act;
        if (pn < 28) { const int seg = pn >> 2; base = (bf16_t*)(P + (size_t)seg * SEG); ld = 1024; lc = (pn & 3) * 256; act = (seg < 2) ? 1 : ((seg == 2 || seg == 6) ? 2 : 0); }
        else if (pn < 31) { base = (bf16_t*)(P + P_CU); ld = 768; lc = (pn - 28) * 256; act = 0; }
        else { base = (bf16_t*)(P + P_GATES); ld = 6144; lc = (pn - 31) * 256; act = 3; }
        const int row0 = u.pm * 256 + wr * 64 + fr, col0 = lc + wc * 32 + 8 * fq, gcol0 = u.pn * 256 + wc * 32 + 8 * fq;
        f32x4 cs[2][2];
#pragma unroll
        for (int bj = 0; bj < 2; ++bj)
#pragma unroll
            for (int n = 0; n < 2; ++n) { const u32x4 cb = *(const u32x4*)(cmax + gcol0 + bj * 128 + 4 * n);
                cs[bj][n] = (f32x4){__uint_as_float(cb.x), __uint_as_float(cb.y), __uint_as_float(cb.z), __uint_as_float(cb.w)} * (1.0f / 240.0f); }
        float rscv[2][4];
#pragma unroll
        for (int ai = 0; ai < 2; ++ai)
#pragma unroll
            for (int m = 0; m < 4; ++m) rscv[ai][m] = sa[row0 + ai * 128 + m * 16];
#pragma unroll
        for (int ai = 0; ai < 2; ++ai)
#pragma unroll
            for (int m = 0; m < 4; ++m) {
                bf16_t* rowp = base + (size_t)(row0 + ai * 128 + m * 16) * ld + col0;
                const float rsc = rscv[ai][m];
#pragma unroll
                for (int bj = 0; bj < 2; ++bj) {
                    f32x4 v0 = acc[ai][bj][m][0] * (cs[bj][0] * rsc), v1 = acc[ai][bj][m][1] * (cs[bj][1] * rsc);
                    if (act == 1) {
#pragma unroll
                        for (int j = 0; j < 4; ++j) { v0[j] = gelu_f(v0[j]); v1[j] = gelu_f(v1[j]); }
                    } else if (act == 2) {
#pragma unroll
                        for (int j = 0; j < 4; ++j) { v0[j] = fast_silu(v0[j]); v1[j] = fast_silu(v1[j]); }
                    } else if (act == 3) {
#pragma unroll
                        for (int j = 0; j < 4; ++j) { v0[j] = fast_sigmoid(v0[j]); v1[j] = fast_sigmoid(v1[j]); }
                    }
                    u32x4 w; w.x = cvt_pk_bf16(v0[0], v0[1]); w.y = cvt_pk_bf16(v0[2], v0[3]); w.z = cvt_pk_bf16(v1[0], v1[1]); w.w = cvt_pk_bf16(v1[2], v1[3]);
                    *(u32x4*)(rowp + bj * 128) = w;
                }
            }
    }
};
struct EpiGlu {
    static constexpr bool PERM = true, FP8 = false;
    bf16_t* O;
    __device__ __forceinline__ void operator()(const AccT& acc, const pg8::Unit& u, int wr, int wc, int fr, int fq) const {
        const int row0 = u.pm * 256 + wr * 64 + fr, col0 = u.pn * 128 + wc * 32 + 8 * fq;
#pragma unroll
        for (int ai = 0; ai < 2; ++ai)
#pragma unroll
            for (int m = 0; m < 4; ++m) {
                f32x4 v0 = acc[ai][0][m][0], v1 = acc[ai][0][m][1]; const f32x4 g0 = acc[ai][1][m][0], g1 = acc[ai][1][m][1];
#pragma unroll
                for (int j = 0; j < 4; ++j) { v0[j] *= fast_sigmoid(g0[j]); v1[j] *= fast_sigmoid(g1[j]); }
                u32x4 w; w.x = cvt_pk_bf16(v0[0], v0[1]); w.y = cvt_pk_bf16(v0[2], v0[3]); w.z = cvt_pk_bf16(v1[0], v1[1]); w.w = cvt_pk_bf16(v1[2], v1[3]);
                *(u32x4*)(O + (size_t)(row0 + ai * 128 + m * 16) * 768 + col0) = w;
            }
    }
};
template <bool FIRST> struct EpiMerge {
    static constexpr bool PERM = true, FP8 = false;
    bf16_t* O;
    const bf16_t* G;
    __device__ __forceinline__ void operator()(const AccT& acc, const pg8::Unit& u, int wr, int wc, int fr, int fq) const {
        const int row0 = u.pm * 256 + wr * 64 + fr, col0 = u.pn * 256 + wc * 32 + 8 * fq;
#pragma unroll
        for (int ai = 0; ai < 2; ++ai) {
            u32x4 gwv[4][2], owv[4][2];
#pragma unroll
            for (int m = 0; m < 4; ++m)
#pragma unroll
                for (int bj = 0; bj < 2; ++bj) { const size_t row = (size_t)(row0 + ai * 128 + m * 16);
                    gwv[m][bj] = *(const u32x4*)(G + row * 6144 + col0 + bj * 128);
                    if (!FIRST) owv[m][bj] = *(const u32x4*)(O + row * 2048 + col0 + bj * 128); }
#pragma unroll
            for (int m = 0; m < 4; ++m)
#pragma unroll
                for (int bj = 0; bj < 2; ++bj) { const size_t row = (size_t)(row0 + ai * 128 + m * 16);
                    const u32x4 gw = gwv[m][bj];
                    f32x4 v0 = acc[ai][bj][m][0], v1 = acc[ai][bj][m][1];
                    v0[0] *= bf_lo(gw.x); v0[1] *= bf_hi(gw.x); v0[2] *= bf_lo(gw.y); v0[3] *= bf_hi(gw.y);
                    v1[0] *= bf_lo(gw.z); v1[1] *= bf_hi(gw.z); v1[2] *= bf_lo(gw.w); v1[3] *= bf_hi(gw.w);
                    if (!FIRST) { const u32x4 ow = owv[m][bj];
                        v0[0] += bf_lo(ow.x); v0[1] += bf_hi(ow.x); v0[2] += bf_lo(ow.y); v0[3] += bf_hi(ow.y);
                        v1[0] += bf_lo(ow.z); v1[1] += bf_hi(ow.z); v1[2] += bf_lo(ow.w); v1[3] += bf_hi(ow.w); }
                    u32x4 w; w.x = cvt_pk_bf16(v0[0], v0[1]); w.y = cvt_pk_bf16(v0[2], v0[3]); w.z = cvt_pk_bf16(v1[0], v1[1]); w.w = cvt_pk_bf16(v1[2], v1[3]);
                    *(u32x4*)(O + row * 2048 + col0 + bj * 128) = w; }
        }
    }
};
struct EpiResid {
    static constexpr bool PERM = false, FP8 = false;
    float* XR; float* XC; const float* modl;
    __device__ __forceinline__ void operator()(const AccT& acc, const pg8::Unit& u, int wr, int wc, int fr, int fq) const {
        const int row0 = u.pm * 256 + wr * 64 + fr, col0 = u.pn * 256 + wc * 32 + 4 * fq;
        const int mb = u.pm < 128 ? (u.pm >> 3) : 16;
        const float* gv = modl + (size_t)mb * NMOD + col0;
        float* basep = u.pm < 128 ? XR : (XC - (size_t)TL * D);
        f32x4 gvv[2][2];
#pragma unroll
        for (int bj = 0; bj < 2; ++bj)
#pragma unroll
            for (int n = 0; n < 2; ++n) gvv[bj][n] = *(const f32x4*)(gv + bj * 128 + n * 16);
#pragma unroll
        for (int ai = 0; ai < 2; ++ai) {
            f32x4 xo[4][2][2];
#pragma unroll
            for (int m = 0; m < 4; ++m)
#pragma unroll
                for (int bj = 0; bj < 2; ++bj)
#pragma unroll
                    for (int n = 0; n < 2; ++n) xo[m][bj][n] = *(const f32x4*)(basep + (size_t)(row0 + ai * 128 + m * 16) * D + col0 + bj * 128 + n * 16);
#pragma unroll
            for (int m = 0; m < 4; ++m)
#pragma unroll
                for (int bj = 0; bj < 2; ++bj)
#pragma unroll
                    for (int n = 0; n < 2; ++n) *(f32x4*)(basep + (size_t)(row0 + ai * 128 + m * 16) * D + col0 + bj * 128 + n * 16) = xo[m][bj][n] + gvv[bj][n] * acc[ai][bj][m][n];
        }
    }
};
struct EpiF32 {
    static constexpr bool PERM = false, FP8 = false;
    float* C; int ldc;
    __device__ __forceinline__ void operator()(const AccT& acc, const pg8::Unit& u, int wr, int wc, int fr, int fq) const {
        const int row0 = u.pm * 256 + wr * 64 + fr, col0 = u.pn * 256 + wc * 32 + 4 * fq;
#pragma unroll
        for (int ai = 0; ai < 2; ++ai)
#pragma unroll
            for (int m = 0; m < 4; ++m) {
                float* rowp = C + (size_t)(row0 + ai * 128 + m * 16) * ldc + col0;
#pragma unroll
                for (int bj = 0; bj < 2; ++bj)
#pragma unroll
                    for (int n = 0; n < 2; ++n) *(f32x4*)(rowp + bj * 128 + n * 16) = acc[ai][bj][m][n];
            }
    }
};

template <class Epi>
__device__ __forceinline__ void run_gemm(LAS unsigned char* lds, const bf16_t* A, const bf16_t* Bt, int M, int N, int K, const Epi& E) {
    pg8::Gemm g{A, Bt, M, N, K};
    pg8::StaticOrder S; S.init(M, N, (int)gridDim.x, (int)blockIdx.x);
    pg8::gemm_phase<Epi, pg8::StaticOrder>(lds, g, S, E);
}

__device__ __forceinline__ void phase_mod(const Params& p, LAS unsigned char* lds) {
    const int tid_ = otid();
    LAS float* cs = (LAS float*)lds;
    LAS float* red = (LAS float*)(lds + 2048 * 17 * 4);
    const int tid = tid_;
    float* modv = (float*)(p.ws + OFF_MODV);
    for (int i = tid; i < 17 * 2048; i += NTHREADS) { const int r = i >> 11, k = i & 2047; const float c = r < 16 ? p.c[r * 2048 + k] : p.c_ctx[k]; cs[k * 17 + r] = c / (1.0f + __expf(-c)); }
    __syncthreads();
    const int lane = tid & 63, wv = tid >> 6, cq = lane & 7, kg = wv * 8 + (lane >> 3);
    for (int u = blockIdx.x; u < 768; u += gridDim.x) {
        const int l = u / 384, c0 = (u % 384) * 32;
        const float* w = p.w_mod + (size_t)l * 2048 * NMOD + (size_t)kg * NMOD + c0 + cq * 4;
        f32x4 acc[17];
#pragma unroll
        for (int r = 0; r < 17; ++r) acc[r] = (f32x4){0.f, 0.f, 0.f, 0.f};
#pragma unroll 8
        for (int j = 0; j < 32; ++j) {
            const f32x4 w4 = *(const f32x4*)(w + (size_t)j * 64 * NMOD);
            const LAS float* cr = cs + (kg + 64 * j) * 17;
#pragma unroll
            for (int r = 0; r < 17; ++r) acc[r] += w4 * cr[r];
        }
#pragma unroll
        for (int r = 0; r < 17; ++r)
#pragma unroll
            for (int c = 0; c < 4; ++c) { float v = acc[r][c]; v += __shfl_xor(v, 8); v += __shfl_xor(v, 16); v += __shfl_xor(v, 32);
                if (lane < 8) red[(wv * 32 + cq * 4 + c) * 17 + r] = v; }
        __syncthreads();
        for (int o = tid; o < 32 * 17; o += NTHREADS) { const int col = o & 31, r = o >> 5;
            float sum = p.b_mod[l * NMOD + c0 + col];
#pragma unroll
            for (int q = 0; q < 8; ++q) sum += red[(q * 32 + col) * 17 + r];
            modv[(size_t)(l * 17 + r) * NMOD + c0 + col] = sum; }
        __syncthreads();
    }
}
__device__ __forceinline__ void phase_prep(const Params& p) {
    const int tid_ = otid();
    const int gt = blockIdx.x * NTHREADS + tid_, nt = gridDim.x * NTHREADS;
    float* lb = (float*)(p.ws + OFF_LB);
    for (int i = gt; i < 2 * 1024; i += nt) { const float x0 = p.lb_logits[i], x1 = p.lb_logits[2048 + i]; lb[i] = 0.f; lb[2048 + i] = 1.0f / (1.0f + expf(x0 - x1)); }
    float* s5lam = (float*)(p.ws + OFF_S5LAM); float* s5bb = (float*)(p.ws + OFF_S5BB);
    for (int i = gt; i < 2 * 2 * 48 * 64; i += nt) {
        const int ldg = i >> 6;
        const double lre = (double)p.lam_re[i], lim = (double)p.lam_im[i], dt = exp((double)p.log_step[ldg]);
        const double er = exp(lre * dt); double sn, cs; sincos(lim * dt, &sn, &cs);
        const double br = er * cs, bi = er * sn;
        s5lam[i * 2] = (float)br; s5lam[i * 2 + 1] = (float)bi;
        const double nr = br - 1.0, ni = bi, den = lre * lre + lim * lim;
        const double cr = (nr * lre + ni * lim) / den, ci = (ni * lre - nr * lim) / den;
        for (int d = 0; d < 16; ++d) { const double xr = (double)p.b_re[(size_t)i * 16 + d], xi = (double)p.b_im[(size_t)i * 16 + d];
            s5bb[(size_t)i * 32 + d] = (float)(cr * xr - ci * xi); s5bb[(size_t)i * 32 + 16 + d] = (float)(cr * xi + ci * xr); }
    }
    float* pe = (float*)(p.ws + OFF_PE);
    for (int i = gt; i < 96 * 1024; i += nt) {
        const int r = i >> 10, cc = i & 1023, j = cc & 511;
        const float pos = (float)(r < 32 ? r : r - 32);
        const float omega = 1.0f / powf(10000.0f, (float)j * (1.0f / 512.0f));
        const float ang = pos * omega;
        pe[i] = cc < 512 ? sinf(ang) : cosf(ang);
    }
}

template <int MAPMODE>
__device__ __forceinline__ void transpose_convert(const float* src, int K, int N, bf16_t* dst, LAS unsigned char* lds) {
    const int tid_ = otid();
    LAS float* tile = (LAS float*)lds;
    const int tid = tid_, nkb = K / 64, nnb = N / 64;
    for (int u = blockIdx.x; u < nkb * nnb; u += gridDim.x) {
        const int kb = u / nnb, nb = u % nnb, k0 = kb * 64, n0 = nb * 64;
        { const int nn = tid & 63, kk = tid >> 6;
#pragma unroll
          for (int i = 0; i < 8; ++i) tile[(kk + i * 8) * 65 + nn] = src[(size_t)(k0 + kk + i * 8) * N + n0 + nn]; }
        __syncthreads();
        { const int kk2 = (tid & 7) * 8, nn2 = tid >> 3; float v[8];
#pragma unroll
          for (int i = 0; i < 8; ++i) v[i] = tile[(kk2 + i) * 65 + nn2];
          int n = n0 + nn2, nr;
          if (MAPMODE == 1) { if (n < 768) nr = (n >> 7) * 256 + (n & 127); else { const int m = n - 768; nr = (m >> 7) * 256 + 128 + (m & 127); } } else nr = n;
          u32x4 w; w.x = cvt_pk_bf16(v[0], v[1]); w.y = cvt_pk_bf16(v[2], v[3]); w.z = cvt_pk_bf16(v[4], v[5]); w.w = cvt_pk_bf16(v[6], v[7]);
          *(u32x4*)(dst + (size_t)nr * K + k0 + kk2) = w; }
        __syncthreads();
    }
}
__device__ __forceinline__ void phase_wscore(const float* wq, const float* sk, bf16_t* dst, LAS unsigned char* lds) {
    const int tid_ = otid();
    LAS float* skt = (LAS float*)lds;
    LAS float* wqt = (LAS float*)(lds + 128 * 129 * 4);
    const int tid = tid_;
    for (int u = blockIdx.x; u < 16 * 32; u += gridDim.x) {
        const int hp = u >> 5, kb = u & 31;
        for (int i = tid; i < 128 * 128; i += NTHREADS) { const int key = i >> 7, e = i & 127; skt[key * 129 + e] = sk[(size_t)hp * 16384 + i]; }
        for (int i = tid; i < 64 * 128; i += NTHREADS) { const int k = i >> 7, e = i & 127; wqt[e * 68 + k] = wq[(size_t)(kb * 64 + k) * 2048 + hp * 128 + e]; }
        __syncthreads();
        const int key = tid & 127, kg = tid >> 7;
        float acc[16];
#pragma unroll
        for (int i = 0; i < 16; ++i) acc[i] = 0.f;
        for (int e = 0; e < 128; ++e) {
            const float s = skt[key * 129 + e];
#pragma unroll
            for (int q = 0; q < 4; ++q) { const f32x4 w4 = *(const LAS f32x4*)(wqt + e * 68 + kg * 16 + q * 4);
                acc[q * 4 + 0] += s * w4[0]; acc[q * 4 + 1] += s * w4[1]; acc[q * 4 + 2] += s * w4[2]; acc[q * 4 + 3] += s * w4[3]; }
        }
        bf16_t* o = dst + (size_t)(hp * 128 + key) * 2048 + kb * 64 + kg * 16;
        u32x4 w0, w1;
        w0.x = cvt_pk_bf16(acc[0], acc[1]); w0.y = cvt_pk_bf16(acc[2], acc[3]); w0.z = cvt_pk_bf16(acc[4], acc[5]); w0.w = cvt_pk_bf16(acc[6], acc[7]);
        w1.x = cvt_pk_bf16(acc[8], acc[9]); w1.y = cvt_pk_bf16(acc[10], acc[11]); w1.z = cvt_pk_bf16(acc[12], acc[13]); w1.w = cvt_pk_bf16(acc[14], acc[15]);
        *(u32x4*)o = w0; *(u32x4*)(o + 8) = w1;
        __syncthreads();
    }
}
__device__ __forceinline__ void phase_colmax(const Params& p) {
    const int tid_ = otid();
    unsigned* cm = (unsigned*)(p.ws + OFF_CMAX);
    const int total = 2 * (INC / 4) * 16;
    for (int i = blockIdx.x * NTHREADS + tid_; i < total; i += gridDim.x * NTHREADS) {
        const int kc = i / (2 * (INC / 4)), cidx = i % (2 * (INC / 4)), l = cidx / (INC / 4), nq = cidx % (INC / 4);
        const float* w = p.w_in + (size_t)l * D * INC + (size_t)(kc * 128) * INC + nq * 4;
        f32x4 am = (f32x4){0.f, 0.f, 0.f, 0.f};
#pragma unroll 16
        for (int k = 0; k < 128; ++k) { const f32x4 v = *(const f32x4*)(w + (size_t)k * INC);
            am[0] = fmaxf(am[0], fabsf(v[0])); am[1] = fmaxf(am[1], fabsf(v[1])); am[2] = fmaxf(am[2], fabsf(v[2])); am[3] = fmaxf(am[3], fabsf(v[3])); }
        unsigned* o = cm + l * INC + nq * 4;
        atomicMax(o, __float_as_uint(am[0])); atomicMax(o + 1, __float_as_uint(am[1])); atomicMax(o + 2, __float_as_uint(am[2])); atomicMax(o + 3, __float_as_uint(am[3]));
    }
}
__device__ __forceinline__ void transpose_convert_fp8(const float* src, int K, int N, unsigned char* dst, const unsigned* cmax, LAS unsigned char* lds) {
    const int tid_ = otid();
    LAS float* tile = (LAS float*)lds;
    const int tid = tid_, nkb = K / 64, nnb = N / 64;
    for (int u = blockIdx.x; u < nkb * nnb; u += gridDim.x) {
        const int kb = u / nnb, nb = u % nnb, k0 = kb * 64, n0 = nb * 64;
        { const int nn = tid & 63, kk = tid >> 6;
#pragma unroll
          for (int i = 0; i < 8; ++i) tile[(kk + i * 8) * 65 + nn] = src[(size_t)(k0 + kk + i * 8) * N + n0 + nn]; }
        __syncthreads();
        { const int kk2 = (tid & 7) * 8, nn2 = tid >> 3; float v[8];
          const float cmv = __uint_as_float(cmax[n0 + nn2]); const float sc = cmv > 0.f ? 240.0f / cmv : 1.0f;
#pragma unroll
          for (int i = 0; i < 8; ++i) v[i] = tile[(kk2 + i) * 65 + nn2] * sc;
          u32x2 w; w.x = pack_fp8x4(v[0], v[1], v[2], v[3]); w.y = pack_fp8x4(v[4], v[5], v[6], v[7]);
          *(u32x2*)(dst + (size_t)(n0 + nn2) * K + k0 + kk2) = w; }
        __syncthreads();
    }
}
__device__ __forceinline__ void phase_wconv(const Params& p, int l, LAS unsigned char* lds) {
    unsigned char* W = p.ws + OFF_W;
    transpose_convert_fp8(p.w_in + (size_t)l * D * INC, D, INC, W + W_IN, (const unsigned*)(p.ws + OFF_CMAX) + (size_t)l * INC, lds);
    transpose_convert<1>(p.w_glu + (size_t)l * 768 * 1536, 768, 1536, (bf16_t*)(W + W_GLU), lds);
    transpose_convert<0>(p.wa + (size_t)l * 1024 * D, 1024, D, (bf16_t*)(W + W_A), lds);
    transpose_convert<0>(p.wb + (size_t)l * 1024 * D, 1024, D, (bf16_t*)(W + W_B), lds);
    transpose_convert<0>(p.wc + (size_t)l * 768 * D, 768, D, (bf16_t*)(W + W_C), lds);
    transpose_convert<0>(p.wo + (size_t)l * D * D, D, D, (bf16_t*)(W + W_O), lds);
    phase_wscore(p.w_q + (size_t)l * D * D, p.sub_keys + (size_t)l * 16 * 16384, (bf16_t*)(W + W_S), lds);
}
__device__ __forceinline__ void phase_tabconv(const Params& p, int l) {
    const int tid_ = otid();
    const int lane = tid_ & 63, gw = blockIdx.x * 8 + __builtin_amdgcn_readfirstlane(tid_ >> 6), nw = gridDim.x * 8;
    unsigned char* U6 = p.ws + OFF_P + Q_UT; unsigned char* V6 = p.ws + OFF_P + Q_VT;
    float* USC = (float*)(p.ws + OFF_P + Q_USC); float* VSC = (float*)(p.ws + OFF_P + Q_VSC);
    for (int r = gw; r < 32768; r += nw) {
        const bool isv = r >= 16384; const int rr = r & 16383;
        const float* src = (isv ? p.peer_v : p.peer_u) + (size_t)l * 16384 * 2048 + (size_t)rr * 2048;
        f32x4 v[8];
#pragma unroll
        for (int j = 0; j < 8; ++j) v[j] = *(const f32x4*)(src + j * 256 + lane * 4);
        float am = 0.f;
#pragma unroll
        for (int j = 0; j < 8; ++j) am = fmaxf(am, fmaxf(fmaxf(fabsf(v[j][0]), fabsf(v[j][1])), fmaxf(fabsf(v[j][2]), fabsf(v[j][3]))));
#pragma unroll
        for (int o = 32; o >= 1; o >>= 1) am = fmaxf(am, __shfl_xor(am, o));
        const float sc = am > 0.f ? 7.0f / am : 1.0f, inv = am > 0.f ? am * (1.0f / 7.0f) : 1.0f;
        bf16x32_t bv;
#pragma unroll
        for (int j = 0; j < 8; ++j)
#pragma unroll
            for (int c = 0; c < 4; ++c) bv[j * 4 + c] = (__bf16)(v[j][c] * sc);
        const u32x6 pk = __builtin_amdgcn_cvt_scalef32_pk32_fp6_bf16(bv, 1.0f);
        unsigned char* dst = (isv ? V6 : U6) + (size_t)rr * 1536 + lane * 24;
        u32x4 w0; w0.x = pk[0]; w0.y = pk[1]; w0.z = pk[2]; w0.w = pk[3]; u32x2 w1; w1.x = pk[4]; w1.y = pk[5];
        *(u32x4*)dst = w0; *(u32x2*)(dst + 16) = w1;
        if (lane == 0) (isv ? VSC : USC)[rr] = inv;
    }
}

template <int MODE, bool F8OUT = false>
__device__ __forceinline__ void phase_norm(const Params& p, int l, int M, int off_sh, int off_sc) {
    const int tid_ = otid();
    const int lane = tid_ & 63, gw = blockIdx.x * 8 + __builtin_amdgcn_readfirstlane(tid_ >> 6), nw = gridDim.x * 8;
    const float* modv = (const float*)(p.ws + OFF_MODV) + (size_t)l * 17 * NMOD;
    const float* pe = (const float*)(p.ws + OFF_PE);
    float* XC = (float*)(p.ws + OFF_XC);
    bf16_t* H = (bf16_t*)(p.ws + OFF_H);
    for (int r = gw; r < M; r += nw) {
        const bool lat = r < TL;
        const float* src = MODE == 0 ? (lat ? p.x + (size_t)r * D : p.ctx + (size_t)(r - TL) * D) : (lat ? p.out + (size_t)r * D : XC + (size_t)(r - TL) * D);
        f32x4 v[4][2];
#pragma unroll
        for (int j = 0; j < 4; ++j) { v[j][0] = *(const f32x4*)(src + j * 512 + lane * 8); v[j][1] = *(const f32x4*)(src + j * 512 + lane * 8 + 4); }
        if (MODE == 0) {
            if (lat) { const int n = r & 2047, gr = n >> 6, gc = n & 63;
#pragma unroll
                for (int j = 0; j < 4; ++j) { const float* pr = (j < 2) ? pe + (size_t)gr * 1024 + j * 512 + lane * 8 : pe + (size_t)(32 + gc) * 1024 + (j - 2) * 512 + lane * 8;
                    v[j][0] += *(const f32x4*)pr; v[j][1] += *(const f32x4*)(pr + 4); } }
            float* dst = lat ? p.out + (size_t)r * D : XC + (size_t)(r - TL) * D;
#pragma unroll
            for (int j = 0; j < 4; ++j) { *(f32x4*)(dst + j * 512 + lane * 8) = v[j][0]; *(f32x4*)(dst + j * 512 + lane * 8 + 4) = v[j][1]; }
        }
        float ss = 0.f;
#pragma unroll
        for (int j = 0; j < 4; ++j)
#pragma unroll
            for (int h = 0; h < 2; ++h) ss += v[j][h][0] * v[j][h][0] + v[j][h][1] * v[j][h][1] + v[j][h][2] * v[j][h][2] + v[j][h][3] * v[j][h][3];
        ss = wave_sum(ss);
        const float rs = rsqrtf(ss * (1.0f / 2048.0f) + 1e-6f);
        const int mb = lat ? (r >> 11) : 16;
        const float* sh = modv + (size_t)mb * NMOD + off_sh; const float* sc = modv + (size_t)mb * NMOD + off_sc;
        if (F8OUT) {
            float am = 0.f;
#pragma unroll
            for (int j = 0; j < 4; ++j) { const int e = j * 512 + lane * 8;
                const f32x4 s0 = *(const f32x4*)(sc + e), s1 = *(const f32x4*)(sc + e + 4), h0 = *(const f32x4*)(sh + e), h1 = *(const f32x4*)(sh + e + 4);
                v[j][0] = v[j][0] * rs * (s0 + 1.0f) + h0; v[j][1] = v[j][1] * rs * (s1 + 1.0f) + h1;
#pragma unroll
                for (int hh = 0; hh < 2; ++hh) am = fmaxf(am, fmaxf(fmaxf(fabsf(v[j][hh][0]), fabsf(v[j][hh][1])), fmaxf(fabsf(v[j][hh][2]), fabsf(v[j][hh][3])))); }
#pragma unroll
            for (int o = 32; o >= 1; o >>= 1) am = fmaxf(am, __shfl_xor(am, o));
            const float q = am > 0.f ? 240.0f / am : 1.0f;
            unsigned char* H8 = p.ws + OFF_H8 + (size_t)r * D;
#pragma unroll
            for (int j = 0; j < 4; ++j) { u32x2 w; w.x = pack_fp8x4(v[j][0][0] * q, v[j][0][1] * q, v[j][0][2] * q, v[j][0][3] * q); w.y = pack_fp8x4(v[j][1][0] * q, v[j][1][1] * q, v[j][1][2] * q, v[j][1][3] * q);
                *(u32x2*)(H8 + j * 512 + lane * 8) = w; }
            if (lane == 0) ((float*)(p.ws + OFF_HS))[r] = am > 0.f ? am * (1.0f / 240.0f) : 1.0f;
        } else {
#pragma unroll
        for (int j = 0; j < 4; ++j) {
            const int e = j * 512 + lane * 8;
            const f32x4 s0 = *(const f32x4*)(sc + e), s1 = *(const f32x4*)(sc + e + 4), h0 = *(const f32x4*)(sh + e), h1 = *(const f32x4*)(sh + e + 4);
            f32x4 a = v[j][0] * rs * (s0 + 1.0f) + h0, b = v[j][1] * rs * (s1 + 1.0f) + h1;
            u32x4 w; w.x = cvt_pk_bf16(a[0], a[1]); w.y = cvt_pk_bf16(a[2], a[3]); w.z = cvt_pk_bf16(b[0], b[1]); w.w = cvt_pk_bf16(b[2], b[3]);
            *(u32x4*)(H + (size_t)r * D + e) = w;
        }
        }
    }
}
__device__ __forceinline__ bf16x8 mk_bf16x8(unsigned a, unsigned b, unsigned c, unsigned d) { u32x4 q; q.x = a; q.y = b; q.z = c; q.w = d; return __builtin_bit_cast(bf16x8, q); }
__device__ __forceinline__ void phase_hgrn(const Params& p, int l, LAS unsigned char* lds, bool dry = false) {
    const int tid_ = otid();
    const int lane = tid_ & 63, w = __builtin_amdgcn_readfirstlane(tid_ >> 6), q = lane >> 4, m = lane & 15;
    constexpr int OQ = 0, OKH = 4352, OKT = 8704, OIT = 14848, OE = 20992, BUFSZ = 21504, RAWOFF = 2 * 21504, RAWSZ = 3 * 4352;
    unsigned char* P = p.ws + OFF_P;
    const float* lbp = (const float*)(p.ws + OFF_LB) + (size_t)l * 2048;
    const int kch = 16 * w + m;
    for (int u = blockIdx.x; u < 256; u += gridDim.x) {
        const int b = u >> 4, h = (u >> 1) & 7, dir = u & 1;
        const bf16_t* BQ = (const bf16_t*)(P + P_BQ); const bf16_t* BI = (const bf16_t*)(P + P_BI);
        bf16_t* BF = (bf16_t*)(P + (dir ? P_BFB : P_BFF));
        const float lbv = lbp[dir * 1024 + h * 128 + kch];
        f32x4 Sacc[8];
#pragma unroll
        for (int i = 0; i < 8; ++i) Sacc[i] = (f32x4){0.f, 0.f, 0.f, 0.f};
        for (int seg = 0; seg < 2; ++seg) {
            const int len = seg == 0 ? CTXL : SEQ, rbase = seg == 0 ? TL + b * CTXL : b * SEQ, nch = len / 16;
            u32x4 g0 = (u32x4){0u, 0u, 0u, 0u}, g1 = g0;
            const int gs = (tid_ & 255) >> 4, gc8 = (tid_ & 15) * 8;
#define HG_GLOAD(c) do { const int st = (c) * 16 + gs, n = dir ? (len - 1 - st) : st; const size_t o = (size_t)(rbase + n) * 1024 + h * 128 + gc8; \
                if (tid_ < 256) { g0 = *(const u32x4*)(BQ + o); g1 = *(const u32x4*)(BF + o); } else { g0 = *(const u32x4*)(BI + o); } } while (0)
#define HG_RAWW(c) do { LAS unsigned char* rw = lds + RAWOFF + ((c) & 1) * RAWSZ + gs * 272 + gc8 * 2; \
                if (tid_ < 256) { *(LAS u32x4*)(rw) = g0; *(LAS u32x4*)(rw + 4352) = g1; } else { *(LAS u32x4*)(rw + 8704) = g0; } } while (0)
#define HG_STAGE(c, bufp) do { float fv[4], cb[4]; float run = 0.f; unsigned short rq[4], rf[4], ri[4]; \
                { const LAS unsigned char* rr = lds + RAWOFF + ((c) & 1) * RAWSZ + kch * 2; _Pragma("unroll") for (int j = 0; j < 4; ++j) { rq[j] = *(const LAS bf16_t*)(rr + (4 * q + j) * 272); rf[j] = *(const LAS bf16_t*)(rr + 4352 + (4 * q + j) * 272); ri[j] = *(const LAS bf16_t*)(rr + 8704 + (4 * q + j) * 272); } } \
                _Pragma("unroll") for (int j = 0; j < 4; ++j) { const float xf = __uint_as_float(((unsigned)rf[j]) << 16); fv[j] = lbv + (1.0f - lbv) * fast_sigmoid(xf); run += flog(fv[j]); cb[j] = run; } \
                const float t0 = __shfl(run, m), t1 = __shfl(run, m + 16), t2 = __shfl(run, m + 32); \
                const float off = (q > 0 ? t0 : 0.f) + (q > 1 ? t1 : 0.f) + (q > 2 ? t2 : 0.f); \
                float qh[4], kh[4]; \
                _Pragma("unroll") for (int j = 0; j < 4; ++j) { const float bb = off + cb[j], bc = fmaxf(bb, -80.0f); qh[j] = __uint_as_float(((unsigned)rq[j]) << 16) * fexp(bc); kh[j] = (1.0f - fv[j]) * fexp(-bc);     \
                    if (j == 3 && q == 3) *(LAS float*)((bufp) + OE + kch * 4) = fexp(bb); } \
                const unsigned q01 = cvt_pk_bf16(qh[0], qh[1]), q23 = cvt_pk_bf16(qh[2], qh[3]), k01 = cvt_pk_bf16(kh[0], kh[1]), k23 = cvt_pk_bf16(kh[2], kh[3]); \
                *(LAS bf16_t*)((bufp) + OQ + (4 * q + 0) * 272 + kch * 2) = (bf16_t)(q01 & 0xffffu); *(LAS bf16_t*)((bufp) + OQ + (4 * q + 1) * 272 + kch * 2) = (bf16_t)(q01 >> 16); \
                *(LAS bf16_t*)((bufp) + OQ + (4 * q + 2) * 272 + kch * 2) = (bf16_t)(q23 & 0xffffu); *(LAS bf16_t*)((bufp) + OQ + (4 * q + 3) * 272 + kch * 2) = (bf16_t)(q23 >> 16); \
                *(LAS bf16_t*)((bufp) + OKH + (4 * q + 0) * 272 + kch * 2) = (bf16_t)(k01 & 0xffffu); *(LAS bf16_t*)((bufp) + OKH + (4 * q + 1) * 272 + kch * 2) = (bf16_t)(k01 >> 16); \
                *(LAS bf16_t*)((bufp) + OKH + (4 * q + 2) * 272 + kch * 2) = (bf16_t)(k23 & 0xffffu); *(LAS bf16_t*)((bufp) + OKH + (4 * q + 3) * 272 + kch * 2) = (bf16_t)(k23 >> 16); \
                u32x2 kt2; kt2.x = k01; kt2.y = k23; *(LAS u32x2*)((bufp) + OKT + kch * 48 + q * 8) = kt2; \
                u32x2 it2; it2.x = (unsigned)ri[0] | ((unsigned)ri[1] << 16); it2.y = (unsigned)ri[2] | ((unsigned)ri[3] << 16); *(LAS u32x2*)((bufp) + OIT + kch * 48 + q * 8) = it2; } while (0)
#define HG_COMPUTE(c) do { \
                LAS unsigned char* buf = lds + ((c) & 1) * BUFSZ; \
                f32x4 at = (f32x4){0.f, 0.f, 0.f, 0.f}; \
                _Pragma("unroll") \
                for (int kb = 0; kb < 4; ++kb) { const bf16x8 a = *(const LAS bf16x8*)(buf + OKH + m * 272 + kb * 64 + q * 16), bq = *(const LAS bf16x8*)(buf + OQ + m * 272 + kb * 64 + q * 16); \
                    at = __builtin_amdgcn_mfma_f32_16x16x32_bf16(a, bq, at, 0, 0, 0); } \
                asm volatile("s_nop 15\n s_nop 15" : "+v"(at)); \
                _Pragma("unroll") \
                for (int r = 0; r < 4; ++r) at[r] = (4 * q + r <= m) ? at[r] : 0.f; \
                const bf16x8 attB = mk_bf16x8(cvt_pk_bf16(at[0], at[1]), cvt_pk_bf16(at[2], at[3]), 0u, 0u); \
                f32x4 oacc = (f32x4){0.f, 0.f, 0.f, 0.f}; \
                _Pragma("unroll") \
                for (int kb = 0; kb < 4; ++kb) { \
                    const bf16x8 a = mk_bf16x8(cvt_pk_bf16(Sacc[2 * kb][0], Sacc[2 * kb][1]), cvt_pk_bf16(Sacc[2 * kb][2], Sacc[2 * kb][3]), cvt_pk_bf16(Sacc[2 * kb + 1][0], Sacc[2 * kb + 1][1]), cvt_pk_bf16(Sacc[2 * kb + 1][2], Sacc[2 * kb + 1][3])); \
                    const u32x2 b0 = *(const LAS u32x2*)(buf + OQ + m * 272 + (32 * kb + 4 * q) * 2), b1 = *(const LAS u32x2*)(buf + OQ + m * 272 + (32 * kb + 16 + 4 * q) * 2); \
                    oacc = __builtin_amdgcn_mfma_f32_16x16x32_bf16(a, mk_bf16x8(b0.x, b0.y, b1.x, b1.y), oacc, 0, 0, 0); } \
                { const u32x2 i0 = *(const LAS u32x2*)(buf + OIT + (16 * w + m) * 48 + q * 8); \
                  oacc = __builtin_amdgcn_mfma_f32_16x16x32_bf16(mk_bf16x8(i0.x, i0.y, 0u, 0u), attB, oacc, 0, 0, 0); } \
                asm volatile("s_nop 15\n s_nop 15" : "+v"(oacc)); \
                { const int st = (c) * 16 + m, n = dir ? (len - 1 - st) : st; \
                  u32x2 o2; o2.x = cvt_pk_bf16(oacc[0], oacc[1]); o2.y = cvt_pk_bf16(oacc[2], oacc[3]); \
                  if (!dry || p.ws == nullptr) *(u32x2*)(BF + (size_t)(rbase + n) * 1024 + h * 128 + 16 * w + 4 * q) = o2; } \
                u32x4 bsu = (u32x4){0u, 0u, 0u, 0u}; \
                if (q < 2) bsu = *(const LAS u32x4*)(buf + OIT + (16 * w + m) * 48 + q * 16); \
                const bf16x8 bs = __builtin_bit_cast(bf16x8, bsu); \
                _Pragma("unroll") \
                for (int kt = 0; kt < 8; ++kt) { u32x4 au = (u32x4){0u, 0u, 0u, 0u}; \
                    if (q < 2) au = *(const LAS u32x4*)(buf + OKT + (16 * kt + m) * 48 + q * 16); \
                    Sacc[kt] = __builtin_amdgcn_mfma_f32_16x16x32_bf16(__builtin_bit_cast(bf16x8, au), bs, Sacc[kt], 0, 0, 0); } \
                asm volatile("s_nop 15\n s_nop 15" : "+v"(Sacc[0]), "+v"(Sacc[1]), "+v"(Sacc[2]), "+v"(Sacc[3]), "+v"(Sacc[4]), "+v"(Sacc[5]), "+v"(Sacc[6]), "+v"(Sacc[7])); \
                _Pragma("unroll") \
                for (int kt = 0; kt < 8; ++kt) Sacc[kt] *= *(const LAS f32x4*)(buf + OE + (16 * kt + 4 * q) * 4); \
                } while (0)
            HG_GLOAD(0); HG_RAWW(0);
            if (nch > 1) { HG_GLOAD(1); HG_RAWW(1); }
            if (nch > 2) HG_GLOAD(2);
            __syncthreads();
            HG_STAGE(0, lds);
            __syncthreads();
            for (int c = 0; c < nch; ++c) {
                if (c + 2 < nch) { HG_RAWW(c + 2); if (c + 3 < nch) HG_GLOAD(c + 3); }
                if (c + 1 < nch) HG_STAGE(c + 1, lds + ((c + 1) & 1) * BUFSZ);
                HG_COMPUTE(c);
                __syncthreads();
            }
#undef HG_COMPUTE
#undef HG_GLOAD
#undef HG_RAWW
#undef HG_STAGE
        }
        __syncthreads();
    }
}
__device__ __forceinline__ void phase_hcomb(const Params& p, int l, int M, bool dry = false) {
    const int tid_ = otid();
    const int lane = tid_ & 63, gw = blockIdx.x * 8 + __builtin_amdgcn_readfirstlane(tid_ >> 6), nw = gridDim.x * 8;
    unsigned char* P = p.ws + OFF_P;
    bf16_t* OF = (bf16_t*)(P + P_BFF); const bf16_t* OB = (const bf16_t*)(P + P_BFB); const bf16_t* BG = (const bf16_t*)(P + P_BG);
    const float* hg = p.hn_g + (size_t)l * 1024 + lane * 16;
    for (int r = gw; r < M; r += nw) {
        const size_t o = (size_t)r * 1024 + lane * 16;
        float x[16]; float ss = 0.f;
#pragma unroll
        for (int hh = 0; hh < 2; ++hh) { const u32x4 a = *(const u32x4*)(OF + o + hh * 8), bq = *(const u32x4*)(OB + o + hh * 8);
            const unsigned aa[4] = {a.x, a.y, a.z, a.w}, bb[4] = {bq.x, bq.y, bq.z, bq.w};
#pragma unroll
            for (int j = 0; j < 4; ++j) { x[hh * 8 + 2 * j] = bf_lo(aa[j]) + bf_lo(bb[j]); x[hh * 8 + 2 * j + 1] = bf_hi(aa[j]) + bf_hi(bb[j]); } }
#pragma unroll
        for (int j = 0; j < 16; ++j) ss += x[j] * x[j];
        ss += __shfl_xor(ss, 1); ss += __shfl_xor(ss, 2); ss += __shfl_xor(ss, 4);
        const float rs = rsqrtf(ss * (1.0f / 128.0f) + 1e-6f);
#pragma unroll
        for (int hh = 0; hh < 2; ++hh) { const u32x4 gq = *(const u32x4*)(BG + o + hh * 8); const unsigned gg[4] = {gq.x, gq.y, gq.z, gq.w};
            float y[8];
#pragma unroll
            for (int j = 0; j < 4; ++j) { y[2 * j] = x[hh * 8 + 2 * j] * rs * hg[hh * 8 + 2 * j] * bf_lo(gg[j]); y[2 * j + 1] = x[hh * 8 + 2 * j + 1] * rs * hg[hh * 8 + 2 * j + 1] * bf_hi(gg[j]); }
            u32x4 w; w.x = cvt_pk_bf16(y[0], y[1]); w.y = cvt_pk_bf16(y[2], y[3]); w.z = cvt_pk_bf16(y[4], y[5]); w.w = cvt_pk_bf16(y[6], y[7]);
            if (!dry || p.ws == nullptr) *(u32x4*)(OF + o + hh * 8) = w; }
    }
}

__device__ __forceinline__ bf16x8 pack_bf16x8(const float (&v)[8]) {
    const unsigned a = cvt_pk_bf16(v[0], v[1]), b = cvt_pk_bf16(v[2], v[3]), c = cvt_pk_bf16(v[4], v[5]), d = cvt_pk_bf16(v[6], v[7]);
    u32x4 q; q.x = a; q.y = b; q.z = c; q.w = d;
    return __builtin_bit_cast(bf16x8, q);
}
__device__ __forceinline__ void phase_s5(const Params& p, int l, LAS unsigned char* lds) {
    const int tid_ = otid();
    const int lane = tid_ & 63, w = __builtin_amdgcn_readfirstlane(tid_ >> 6);
    if (w >= 6) return;
    LAS float* BU = (LAS float*)(lds + w * 12800);
    LAS unsigned char* XB = lds + w * 12800 + 8448;
    const int lq = lane >> 4, lr = lane & 15;
    const bf16_t* CU = (const bf16_t*)(p.ws + OFF_P + P_CU);
    const float* s5lam = (const float*)(p.ws + OFF_S5LAM); const float* s5bb = (const float*)(p.ws + OFF_S5BB);
    for (int s = w * (int)gridDim.x + (int)blockIdx.x; s < 1536; s += 6 * (int)gridDim.x) {
        const int dir = s & 1, g = (s >> 1) % 48, b = s / 96;
        const int ldg = (l * 2 + dir) * 48 + g;
        const float lre = s5lam[(size_t)(ldg * 64 + lane) * 2], lim = s5lam[(size_t)(ldg * 64 + lane) * 2 + 1];
        bf16x8 bbf[8], cf[4];
#pragma unroll
        for (int nt = 0; nt < 8; ++nt) { const int col = nt * 16 + lr, pp = col >> 1, c = col & 1; float v[8];
#pragma unroll
            for (int j = 0; j < 8; ++j) v[j] = (lq < 2) ? s5bb[(size_t)(ldg * 64 + pp) * 32 + c * 16 + lq * 8 + j] : 0.f;
            bbf[nt] = pack_bf16x8(v); }
#pragma unroll
        for (int kb = 0; kb < 4; ++kb) { float v[8];
#pragma unroll
            for (int j = 0; j < 8; ++j) { const int k = kb * 32 + lq * 8 + j, pp = k >> 1; const size_t ci = ((size_t)ldg * 16 + lr) * 64 + pp;
                v[j] = (k & 1) ? -p.c_im[ci] : p.c_re[ci]; }
            cf[kb] = pack_bf16x8(v); }
        bf16_t* YS = (bf16_t*)(p.ws + OFF_H + (dir ? H_YSB : H_YSF));
        float xr = 0.f, xi = 0.f;
        for (int seg = 0; seg < 2; ++seg) {
            const int len = seg == 0 ? CTXL : SEQ, rbase = seg == 0 ? TL + b * CTXL : b * SEQ, nblk = len / 64;
            u32x4 unext[4];
#pragma unroll
            for (int tt = 0; tt < 4; ++tt) { unext[tt] = (u32x4){0u, 0u, 0u, 0u};
                if (lq < 2) { const int st = tt * 16 + lr, n = dir ? (len - 1 - st) : st; unext[tt] = *(const u32x4*)(CU + (size_t)(rbase + n) * 768 + g * 16 + lq * 8); } }
            for (int blk = 0; blk < nblk; ++blk) {
                u32x4 ucur[4];
#pragma unroll
                for (int tt = 0; tt < 4; ++tt) ucur[tt] = unext[tt];
                if (blk + 1 < nblk && lq < 2) {
#pragma unroll
                    for (int tt = 0; tt < 4; ++tt) { const int st = (blk + 1) * 64 + tt * 16 + lr, n = dir ? (len - 1 - st) : st; unext[tt] = *(const u32x4*)(CU + (size_t)(rbase + n) * 768 + g * 16 + lq * 8); } }
#pragma unroll
                for (int tt = 0; tt < 4; ++tt) {
                    const bf16x8 uf = __builtin_bit_cast(bf16x8, ucur[tt]);
                    f32x4 dd[8];
#pragma unroll
                    for (int nt = 0; nt < 8; ++nt) dd[nt] = __builtin_amdgcn_mfma_f32_16x16x32_bf16(bbf[nt], uf, (f32x4){0.f, 0.f, 0.f, 0.f}, 0, 0, 0);
                    asm volatile("s_nop 15\n s_nop 15" : "+v"(dd[0]), "+v"(dd[1]), "+v"(dd[2]), "+v"(dd[3]), "+v"(dd[4]), "+v"(dd[5]), "+v"(dd[6]), "+v"(dd[7]));
#pragma unroll
                    for (int nt = 0; nt < 8; ++nt) *(LAS f32x4*)(BU + lr * 132 + nt * 16 + lq * 4) = dd[nt];
                    asm volatile("s_waitcnt lgkmcnt(0)" ::: "memory");
                    f32x2 bu[16];
#pragma unroll
                    for (int t = 0; t < 16; ++t) bu[t] = *(const LAS f32x2*)(BU + t * 132 + 2 * lane);
#pragma unroll
                    for (int t = 0; t < 16; ++t) { const float nr = lre * xr - lim * xi + bu[t].x, ni = lre * xi + lim * xr + bu[t].y; xr = nr; xi = ni;
                        *(LAS unsigned*)(XB + t * 272 + lane * 4) = cvt_pk_bf16(xr, xi); }
                    asm volatile("s_waitcnt lgkmcnt(0)" ::: "memory");
                    f32x4 acc = (f32x4){0.f, 0.f, 0.f, 0.f};
#pragma unroll
                    for (int kb = 0; kb < 4; ++kb) { const bf16x8 xf = *(const LAS bf16x8*)(XB + lr * 272 + kb * 64 + lq * 16); acc = __builtin_amdgcn_mfma_f32_16x16x32_bf16(cf[kb], xf, acc, 0, 0, 0); }
                    asm volatile("s_nop 15\n s_nop 15\n s_waitcnt lgkmcnt(0)" : "+v"(acc) :: "memory");
                    const int st = blk * 64 + tt * 16 + lr, n = dir ? (len - 1 - st) : st;
                    u32x2 o; o.x = cvt_pk_bf16(acc[0], acc[1]); o.y = cvt_pk_bf16(acc[2], acc[3]);
                    *(u32x2*)(YS + (size_t)(rbase + n) * 768 + g * 16 + lq * 4) = o;
                }
            }
        }
    }
}
__device__ __forceinline__ void phase_s5post(const Params& p, int l, int M, bool dry = false) {
    const int tid_ = otid();
    const size_t n8 = (size_t)M * 768 / 8;
    bf16_t* YF = (bf16_t*)(p.ws + OFF_H + H_YSF); const bf16_t* YB = (const bf16_t*)(p.ws + OFF_H + H_YSB); const bf16_t* CU = (const bf16_t*)(p.ws + OFF_P + P_CU);
    const float* dsk = p.s5_d + (size_t)l * 768;
    for (size_t i = (size_t)blockIdx.x * NTHREADS + tid_; i < n8; i += (size_t)gridDim.x * NTHREADS) {
        const int c = (int)((i * 8) % 768);
        const u32x4 a = *(const u32x4*)(YF + i * 8), bq = *(const u32x4*)(YB + i * 8), uq = *(const u32x4*)(CU + i * 8);
        const unsigned aa[4] = {a.x, a.y, a.z, a.w}, bb[4] = {bq.x, bq.y, bq.z, bq.w}, uu[4] = {uq.x, uq.y, uq.z, uq.w};
        float y[8];
#pragma unroll
        for (int j = 0; j < 4; ++j) { y[2 * j] = gelu_f(bf_lo(aa[j]) + bf_lo(bb[j]) + dsk[c + 2 * j] * bf_lo(uu[j])); y[2 * j + 1] = gelu_f(bf_hi(aa[j]) + bf_hi(bb[j]) + dsk[c + 2 * j + 1] * bf_hi(uu[j])); }
        u32x4 w; w.x = cvt_pk_bf16(y[0], y[1]); w.y = cvt_pk_bf16(y[2], y[3]); w.z = cvt_pk_bf16(y[4], y[5]); w.w = cvt_pk_bf16(y[6], y[7]);
        if (!dry || p.ws == nullptr) *(u32x4*)(YF + i * 8) = w;
    }
}

__device__ __forceinline__ void phase_gmlp(const Params& p, int l, int M, LAS unsigned char* lds, bool dry = false) {
    const int tid_ = otid();
    LAS unsigned char* Wb = lds;
    LAS unsigned char* Vt = lds + 34816;
    LAS float* st = (LAS float*)(lds + 69632);
    const int tid = tid_, lane = tid & 63, w = __builtin_amdgcn_readfirstlane(tid_ >> 6), q = lane >> 4, m = lane & 15;
    bf16_t* AU = (bf16_t*)(p.ws + OFF_P + P_AU); const bf16_t* AV = (const bf16_t*)(p.ws + OFF_P + P_AV);
    const float* lng = p.ln_g + (size_t)l * 1024; const float* lnb = p.ln_b + (size_t)l * 1024;
    for (int u = blockIdx.x; u < M / 128; u += gridDim.x) {
        const size_t r0 = (size_t)u * 128;
        for (int i = 0; i < 16; ++i) {
            const int s = w * 16 + i; const bf16_t* rp = AV + (r0 + s) * 1024 + lane * 16;
            const u32x4 a = *(const u32x4*)rp, bq = *(const u32x4*)(rp + 8);
            const unsigned aa[8] = {a.x, a.y, a.z, a.w, bq.x, bq.y, bq.z, bq.w};
            float sm = 0.f, sq = 0.f;
#pragma unroll
            for (int j = 0; j < 8; ++j) { const float x0 = bf_lo(aa[j]), x1 = bf_hi(aa[j]); sm += x0 + x1; sq += x0 * x0 + x1 * x1; }
            sm = wave_sum(sm); sq = wave_sum(sq);
            const float mean = sm * (1.0f / 1024.0f), var = fmaxf(sq * (1.0f / 1024.0f) - mean * mean, 0.f);
            if (lane == 0) { st[s * 2] = mean; st[s * 2 + 1] = rsqrtf(var + 1e-6f); }
        }
        __syncthreads();
        for (int g = 0; g < 8; ++g) {
            { const int t = tid >> 2, s0 = (tid & 3) * 32; const float* ws = p.w_s + ((size_t)l * 8 + g) * 16384 + t * 128 + s0;
#pragma unroll
              for (int qq = 0; qq < 4; ++qq) { const f32x4 a = *(const f32x4*)(ws + qq * 8), b4 = *(const f32x4*)(ws + qq * 8 + 4);
                  u32x4 o; o.x = cvt_pk_bf16(a[0], a[1]); o.y = cvt_pk_bf16(a[2], a[3]); o.z = cvt_pk_bf16(b4[0], b4[1]); o.w = cvt_pk_bf16(b4[2], b4[3]);
                  *(LAS u32x4*)(Wb + t * 272 + (s0 + qq * 8) * 2) = o; } }
            { const int s = tid >> 2, c0 = (tid & 3) * 32; const bf16_t* rp = AV + (r0 + s) * 1024 + g * 128 + c0;
              const float mean = st[s * 2], rstd = st[s * 2 + 1];
#pragma unroll
              for (int qq = 0; qq < 4; ++qq) { const u32x4 a = *(const u32x4*)(rp + qq * 8); const unsigned aa[4] = {a.x, a.y, a.z, a.w};
#pragma unroll
                  for (int j = 0; j < 4; ++j) { const int cl = c0 + qq * 8 + 2 * j, c = g * 128 + cl;
                      const unsigned pk = cvt_pk_bf16((bf_lo(aa[j]) - mean) * rstd * lng[c] + lnb[c], (bf_hi(aa[j]) - mean) * rstd * lng[c + 1] + lnb[c + 1]);
                      *(LAS bf16_t*)(Vt + cl * 272 + s * 2) = (bf16_t)(pk & 0xffffu); *(LAS bf16_t*)(Vt + (cl + 1) * 272 + s * 2) = (bf16_t)(pk >> 16); } } }
            __syncthreads();
            bf16x8 af[4];
#pragma unroll
            for (int kb = 0; kb < 4; ++kb) af[kb] = *(const LAS bf16x8*)(Vt + (16 * w + m) * 272 + kb * 64 + q * 16);
            const float* bs = p.b_s + ((size_t)l * 8 + g) * 128;
#pragma unroll
            for (int tt = 0; tt < 8; ++tt) {
                f32x4 acc = (f32x4){0.f, 0.f, 0.f, 0.f};
#pragma unroll
                for (int kb = 0; kb < 4; ++kb) acc = __builtin_amdgcn_mfma_f32_16x16x32_bf16(af[kb], *(const LAS bf16x8*)(Wb + (16 * tt + m) * 272 + kb * 64 + q * 16), acc, 0, 0, 0);
                const float bb = bs[16 * tt + m];
                bf16_t* up = AU + (r0 + 16 * tt + m) * 1024 + g * 128 + 16 * w + 4 * q;
                const u32x2 uw = *(const u32x2*)up;
                const float y0 = (acc[0] + bb) * bf_lo(uw.x), y1 = (acc[1] + bb) * bf_hi(uw.x), y2 = (acc[2] + bb) * bf_lo(uw.y), y3 = (acc[3] + bb) * bf_hi(uw.y);
                u32x2 o; o.x = cvt_pk_bf16(y0, y1); o.y = cvt_pk_bf16(y2, y3);
                if (!dry || p.ws == nullptr) *(u32x2*)up = o;
            }
            __syncthreads();
        }
    }
}

__device__ __forceinline__ unsigned fkey(float x) { const unsigned b = __float_as_uint(x); return b ^ ((b >> 31) ? 0xFFFFFFFFu : 0x80000000u); }
__device__ __forceinline__ int mbcnt64(unsigned long long m) { return __builtin_amdgcn_mbcnt_hi((unsigned)(m >> 32), __builtin_amdgcn_mbcnt_lo((unsigned)m, 0u)); }
template <int NV>
__device__ __forceinline__ int count_ge(const unsigned (&k)[NV], unsigned cand) {
    int cnt = 0;
#pragma unroll
    for (int i = 0; i < NV; ++i) cnt += __popcll(__ballot(k[i] >= cand));
    return cnt;
}
template <int NV>
__device__ __forceinline__ unsigned radix_thr16(const unsigned (&k)[NV], unsigned e0bits) {
    unsigned prefix = 0u; int bit = 31;
    {
        const unsigned c0 = e0bits ^ 0x80000000u, c1 = c0 + 0x00800000u, c2 = c0 + 0x01000000u, c3 = c0 + 0x01800000u;
        const int n0 = count_ge<NV>(k, c0), n1 = count_ge<NV>(k, c1), n2 = count_ge<NV>(k, c2), n3 = count_ge<NV>(k, c3);
        if (n0 >= 16 && n3 < 16) { prefix = (n2 >= 16) ? c2 : ((n1 >= 16) ? c1 : c0); bit = 22;
            const int nn = (n2 >= 16) ? n2 : ((n1 >= 16) ? n1 : n0); if (nn == 16) bit = -1; }
    }
    for (; bit >= 0; --bit) {
        const unsigned cand = prefix | (1u << bit);
        const int cnt = count_ge<NV>(k, cand);
        if (cnt >= 16) prefix = cand;
        if (cnt == 16) break;
    }
    return prefix;
}
__device__ __forceinline__ unsigned umin_(unsigned a, unsigned b) { return a < b ? a : b; }
__device__ __forceinline__ unsigned umax_(unsigned a, unsigned b) { return a > b ? a : b; }
__device__ __forceinline__ unsigned med3u(unsigned x, unsigned y, unsigned z) { return umax_(umin_(x, y), umin_(umax_(x, y), z)); }
__device__ __forceinline__ float unkey(unsigned k) { return __uint_as_float((k & 0x80000000u) ? (k ^ 0x80000000u) : ~k); }
__device__ __forceinline__ void ins16(unsigned (&a)[16], unsigned x) {
#pragma unroll
    for (int s = 15; s >= 1; --s) a[s] = med3u(a[s - 1], x, a[s]);
    a[0] = umax_(a[0], x);
}
__device__ __forceinline__ unsigned sel16(const unsigned (&a)[16], int i) {
    unsigned r = a[0];
#pragma unroll
    for (int t = 1; t < 16; ++t) r = (i == t) ? a[t] : r;
    return r;
}
__device__ __forceinline__ void phase_topk(const Params& p, int M, LAS unsigned char* lds) {
    const int tid_ = otid();
    LAS unsigned* lk = (LAS unsigned*)lds + tid_;
    const int gl = blockIdx.x * NTHREADS + tid_, nl = gridDim.x * NTHREADS;
    const float* SC = (const float*)(p.ws + OFF_P + Q_SC);
    int* IDX = (int*)(p.ws + OFF_P + Q_IDX); float* GATE = (float*)(p.ws + OFF_P + Q_GATE);
    const int ntask = M * 8;
    for (int task = gl; task < ntask; task += nl) {
        const float* sc = SC + (size_t)task * 256;
        unsigned a[16], b[16];
#pragma unroll
        for (int i = 0; i < 16; ++i) { a[i] = 0u; b[i] = 0u; }
#pragma unroll 4
        for (int i4 = 0; i4 < 32; ++i4) {
            const f32x4 va = *(const f32x4*)(sc + i4 * 4), vb = *(const f32x4*)(sc + 128 + i4 * 4);
#pragma unroll
            for (int e = 0; e < 4; ++e) { const unsigned tag = 127u - (unsigned)(i4 * 4 + e);
                ins16(a, (fkey(va[e]) & ~127u) | tag); ins16(b, (fkey(vb[e]) & ~127u) | tag); }
        }
        float fa[16], fb[16];
#pragma unroll
        for (int i = 0; i < 16; ++i) { fa[i] = unkey(a[i] & ~127u); fb[i] = unkey(b[i] & ~127u); }
        unsigned c[16];
#pragma unroll
        for (int i = 0; i < 16; ++i) c[i] = 0u;
#pragma unroll
        for (int i = 0; i < 16; ++i)
#pragma unroll
            for (int j = 0; j < 16; ++j)
                if ((i + 1) * (j + 1) <= 16) ins16(c, (fkey(fa[i] + fb[j]) & ~255u) | (unsigned)(i * 16 + j));
#pragma unroll
        for (int i = 0; i < 16; ++i) { lk[i * 512] = a[i]; lk[(16 + i) * 512] = b[i]; }
        const float mx = unkey(c[0] & ~255u);
        float ev[16]; float sm = 0.f; int id[16];
#pragma unroll
        for (int s = 0; s < 16; ++s) { ev[s] = __expf(unkey(c[s] & ~255u) - mx); sm += ev[s];
            const int ij = (int)(c[s] & 255u);
            const unsigned ka = lk[(ij >> 4) * 512], kb = lk[(16 + (ij & 15)) * 512];
            id[s] = (int)(127u - (ka & 127u)) * 128 + (int)(127u - (kb & 127u)); }
        const float inv = 1.0f / sm;
#pragma unroll
        for (int q = 0; q < 4; ++q) {
            u32x4 iw; iw.x = (unsigned)id[4 * q]; iw.y = (unsigned)id[4 * q + 1]; iw.z = (unsigned)id[4 * q + 2]; iw.w = (unsigned)id[4 * q + 3];
            *(u32x4*)(IDX + (size_t)task * 16 + q * 4) = iw;
            *(f32x4*)(GATE + (size_t)task * 16 + q * 4) = (f32x4){ev[4 * q] * inv, ev[4 * q + 1] * inv, ev[4 * q + 2] * inv, ev[4 * q + 3] * inv};
        }
    }
}

__device__ __forceinline__ float dot2u(unsigned a, unsigned b, float acc) {
    return __builtin_amdgcn_fdot2_f32_bf16(__builtin_bit_cast(bf16x2_t, a), __builtin_bit_cast(bf16x2_t, b), acc, false);
}
__device__ __forceinline__ float dot8(const u32x4 a, const u32x4 b, float acc) {
    acc = dot2u(a.x, b.x, acc); acc = dot2u(a.y, b.y, acc); acc = dot2u(a.z, b.z, acc); acc = dot2u(a.w, b.w, acc);
    return acc;
}
__device__ __forceinline__ void phase_peer(const Params& p, int l, int M, LAS unsigned char* lds, bool dry = false) {
    const int tid_ = otid();
    const int lane = tid_ & 63, wv_ = __builtin_amdgcn_readfirstlane(tid_ >> 6), gw = blockIdx.x * 8 + wv_, nw = gridDim.x * 8;
    LAS float* wl = (LAS float*)(lds + wv_ * 512);
    const bf16_t* H = (const bf16_t*)(p.ws + OFF_H);
    const unsigned char* U6 = p.ws + OFF_P + Q_UT; const unsigned char* V6 = p.ws + OFF_P + Q_VT;
    const float* USC = (const float*)(p.ws + OFF_P + Q_USC); const float* VSC = (const float*)(p.ws + OFF_P + Q_VSC);
    const int* IDX = (const int*)(p.ws + OFF_P + Q_IDX); const float* GATE = (const float*)(p.ws + OFF_P + Q_GATE);
    const float* modl = (const float*)(p.ws + OFF_MODV) + (size_t)l * 17 * NMOD + 10240;
    float* XC = (float*)(p.ws + OFF_XC);
    const unsigned lane24 = (unsigned)lane * 24u;
#define PEER_LOAD(buf, TAB, g) do { const int _is = ((g) < 8) ? id0 : id1; _Pragma("unroll") for (int e = 0; e < 8; ++e) { \
        const int _id = __builtin_amdgcn_readlane(_is, (((g) * 8 + e) & 63)); const unsigned char* _rb = (TAB) + (size_t)(unsigned)_id * 1536u; \
        const u32x4 _a = *(const u32x4*)(_rb + lane24); const u32x2 _b = *(const u32x2*)(_rb + lane24 + 16); \
        buf[e][0] = _a.x; buf[e][1] = _a.y; buf[e][2] = _a.z; buf[e][3] = _a.w; buf[e][4] = _b.x; buf[e][5] = _b.y; } } while (0)
    for (int row = gw; row < M; row += nw) {
        unsigned xw[16];
#pragma unroll
        for (int j = 0; j < 8; ++j) { const u32x2 a = *(const u32x2*)(H + (size_t)row * D + j * 256 + lane * 4); xw[2 * j] = a.x; xw[2 * j + 1] = a.y; }
        const int id0 = IDX[(size_t)row * 128 + lane], id1 = IDX[(size_t)row * 128 + 64 + lane];
        const float g0 = GATE[(size_t)row * 128 + lane], g1 = GATE[(size_t)row * 128 + 64 + lane];
        const float us0 = USC[id0], us1 = USC[id1];
        const float gv0 = g0 * VSC[id0], gv1 = g1 * VSC[id1];
        u32x6 bA[8];
#pragma unroll 1
        for (int g = 0; g < 16; ++g) {
            PEER_LOAD(bA, U6, g);
            float part[8];
            float chain = 0.f;
#pragma unroll
            for (int e = 0; e < 8; ++e) { asm volatile("" : "+v"(bA[e]), "+v"(chain));
                const bf16x32_t ub = __builtin_amdgcn_cvt_scalef32_pk32_bf16_fp6(bA[e], 1.0f);
                const u32x16 uw = __builtin_bit_cast(u32x16, ub);
                float a0 = 0.f, a1 = 0.f;
#pragma unroll
                for (int i = 0; i < 8; ++i) { const unsigned w0 = uw[2 * i], w1 = uw[2 * i + 1]; a0 = dot2u(w0, xw[2 * i], a0); a1 = dot2u(w1, xw[2 * i + 1], a1); }
                part[e] = a0 + a1; chain = part[e]; }
            float r4[4];
#pragma unroll
            for (int i = 0; i < 4; ++i) { const bool hi = (lane & 32) != 0; const float keep = hi ? part[i + 4] : part[i], send = hi ? part[i] : part[i + 4]; r4[i] = keep + __shfl_xor(send, 32); }
            float r2[2];
#pragma unroll
            for (int i = 0; i < 2; ++i) { const bool hi = (lane & 16) != 0; const float keep = hi ? r4[i + 2] : r4[i], send = hi ? r4[i] : r4[i + 2]; r2[i] = keep + __shfl_xor(send, 16); }
            float r1;
            { const bool hi = (lane & 8) != 0; const float keep = hi ? r2[1] : r2[0], send = hi ? r2[0] : r2[1]; r1 = keep + __shfl_xor(send, 8); }
            r1 += __shfl_xor(r1, 4); r1 += __shfl_xor(r1, 2); r1 += __shfl_xor(r1, 1);
            const int k = g * 8 + ((lane >> 3) & 7);
            const float usk = __shfl((g < 8) ? us0 : us1, k & 63), gvk = __shfl((g < 8) ? gv0 : gv1, k & 63);
            if ((lane & 7) == 0) wl[k] = gelu_f(r1 * usk) * gvk;
        }
        asm volatile("s_waitcnt lgkmcnt(0)" ::: "memory");
        float out[32];
#pragma unroll
        for (int i = 0; i < 32; ++i) out[i] = 0.f;
#pragma unroll 1
        for (int g = 0; g < 16; ++g) {
            PEER_LOAD(bA, V6, g);
#pragma unroll
            for (int e = 0; e < 8; ++e) { const float wk = wl[g * 8 + e]; asm volatile("" : "+v"(bA[e]), "+v"(out[0]), "+v"(out[9]), "+v"(out[18]), "+v"(out[27]), "+v"(out[31]));
                const f32x32 un = __builtin_amdgcn_cvt_scalef32_pk32_f32_fp6(bA[e], 1.0f);
#pragma unroll
                for (int i = 0; i < 32; ++i) out[i] += wk * un[i]; }
        }
        asm volatile("s_waitcnt lgkmcnt(0)" ::: "memory");
        const bool lat = row < TL; const int mb = lat ? (row >> 11) : 16;
        float* xp = lat ? p.out + (size_t)row * D : XC + (size_t)(row - TL) * D;
        const float* gv = modl + (size_t)mb * NMOD;
        f32x4 xn[8]; float ss = 0.f;
#pragma unroll
        for (int j = 0; j < 8; ++j) { const int e = j * 256 + lane * 4;
            const f32x4 o4 = (f32x4){out[4 * j], out[4 * j + 1], out[4 * j + 2], out[4 * j + 3]};
            xn[j] = *(const f32x4*)(xp + e) + *(const f32x4*)(gv + e) * o4;
            ss += xn[j][0] * xn[j][0] + xn[j][1] * xn[j][1] + xn[j][2] * xn[j][2] + xn[j][3] * xn[j][3]; }
        ss = wave_sum(ss);
        const float rs = rsqrtf(ss * (1.0f / 2048.0f) + 1e-6f);
        if (!dry || p.ws == nullptr) {
            if (l == 0) {
                const float* m1 = (const float*)(p.ws + OFF_MODV) + (size_t)17 * NMOD + (size_t)mb * NMOD;
                float am = 0.f;
#pragma unroll
                for (int j = 0; j < 8; ++j) { const int e = j * 256 + lane * 4;
                    *(f32x4*)(xp + e) = xn[j];
                    xn[j] = xn[j] * rs * (*(const f32x4*)(m1 + 2048 + e) + 1.0f) + *(const f32x4*)(m1 + e);
                    am = fmaxf(am, fmaxf(fmaxf(fabsf(xn[j][0]), fabsf(xn[j][1])), fmaxf(fabsf(xn[j][2]), fabsf(xn[j][3])))); }
#pragma unroll
                for (int o = 32; o >= 1; o >>= 1) am = fmaxf(am, __shfl_xor(am, o));
                const float qs = am > 0.f ? 240.0f / am : 1.0f;
                unsigned char* H8 = p.ws + OFF_H8 + (size_t)row * D;
#pragma unroll
                for (int j = 0; j < 8; ++j) *(unsigned*)(H8 + j * 256 + lane * 4) = pack_fp8x4(xn[j][0] * qs, xn[j][1] * qs, xn[j][2] * qs, xn[j][3] * qs);
                if (lane == 0) ((float*)(p.ws + OFF_HS))[row] = am > 0.f ? am * (1.0f / 240.0f) : 1.0f;
            } else {
#pragma unroll
                for (int j = 0; j < 8; ++j) { const int e = j * 256 + lane * 4; *(f32x4*)(xp + e) = xn[j] * rs * *(const f32x4*)(p.final_g + e); }
            }
        }
    }
#undef PEER_LOAD
}

__device__ __forceinline__ Params load_params() {
    Params r;
#if defined(__HIP_DEVICE_COMPILE__)
    typedef const unsigned long long __attribute__((address_space(4)))* KP;
    KP k = (KP)__builtin_amdgcn_kernarg_segment_ptr();
    asm volatile("" : "+s"(k));
    void** d = (void**)&r;
#pragma unroll
    for (int i = 0; i < (int)(sizeof(Params) / 8); ++i) d[i] = (void*)(__attribute__((address_space(1))) void*)k[i];
#endif
    return r;
}
#define WSP(off) (p.ws + (off))
template <int l>
__device__ __forceinline__ void mega_layer(LAS unsigned char* lds, const XcdBarrier& bar) {
        const int Mrows = (l == 0) ? TT : TL;
        if (l == 0) {
            { const Params p = load_params(); phase_wconv(p, 0, lds); }
            { const Params p = load_params(); phase_norm<0, true>(p, 0, TT, 0, 2048); }
            xcd_barrier(bar);
        }
        { const Params p = load_params(); EpiInProj E{WSP(OFF_P), (const float*)WSP(OFF_HS), (const unsigned*)WSP(OFF_CMAX) + (size_t)l * INC};
          run_gemm(lds, (const bf16_t*)WSP(OFF_H8), (const bf16_t*)WSP(OFF_W + W_IN), TT, INC, D / 2, E); }
        xcd_barrier(bar);
        { const Params p = load_params(); phase_hgrn(p, l, lds); }
        __syncthreads();
        { const Params p = load_params(); phase_s5(p, l, lds); }
        xcd_barrier(bar);
        { const Params p = load_params(); phase_gmlp(p, l, Mrows, lds); }
        { const Params p = load_params(); phase_hcomb(p, l, Mrows); }
        { const Params p = load_params(); phase_s5post(p, l, Mrows); }
        xcd_barrier(bar);
        { const Params p = load_params(); EpiGlu E{(bf16_t*)WSP(OFF_P + P_CU)}; run_gemm(lds, (const bf16_t*)WSP(OFF_H + H_YSF), (const bf16_t*)WSP(OFF_W + W_GLU), Mrows, 1536, 768, E); }
        { const Params p = load_params(); EpiMerge<true> E{(bf16_t*)WSP(OFF_P + P_MERGED), (const bf16_t*)WSP(OFF_P + P_GATES)}; run_gemm(lds, (const bf16_t*)WSP(OFF_P + P_AU), (const bf16_t*)WSP(OFF_W + W_A), Mrows, D, 1024, E); }
        { const Params p = load_params(); EpiMerge<false> E{(bf16_t*)WSP(OFF_P + P_MERGED), (const bf16_t*)WSP(OFF_P + P_GATES) + 2048}; run_gemm(lds, (const bf16_t*)WSP(OFF_P + P_BFF), (const bf16_t*)WSP(OFF_W + W_B), Mrows, D, 1024, E); }
        xcd_barrier(bar);
        { const Params p = load_params(); EpiMerge<false> E{(bf16_t*)WSP(OFF_P + P_MERGED), (const bf16_t*)WSP(OFF_P + P_GATES) + 4096}; run_gemm(lds, (const bf16_t*)WSP(OFF_P + P_CU), (const bf16_t*)WSP(OFF_W + W_C), Mrows, D, 768, E); }
        xcd_barrier(bar);
        { const Params p = load_params(); EpiResid E{p.out, (float*)WSP(OFF_XC), (const float*)WSP(OFF_MODV) + (size_t)l * 17 * NMOD + 4096}; run_gemm(lds, (const bf16_t*)WSP(OFF_P + P_MERGED), (const bf16_t*)WSP(OFF_W + W_O), Mrows, D, D, E); }
        { const Params p = load_params(); phase_tabconv(p, l); }
        xcd_barrier(bar);
        { const Params p = load_params(); phase_norm<1>(p, l, Mrows, 6144, 8192); }
        xcd_barrier(bar);
        { const Params p = load_params(); EpiF32 E{(float*)WSP(OFF_P + Q_SC), 2048}; run_gemm(lds, (const bf16_t*)WSP(OFF_H), (const bf16_t*)WSP(OFF_W + W_S), Mrows, D, D, E); }
        xcd_barrier(bar);
        { const Params p = load_params(); phase_topk(p, Mrows, lds); }
        xcd_barrier(bar);
        { const Params p = load_params(); phase_peer(p, l, Mrows, lds); }
        if (l == 0) {
            __syncthreads();
            { const Params p = load_params(); phase_wconv(p, 1, lds); }
            xcd_barrier(bar);
        }
}
#undef WSP
__global__ void __launch_bounds__(NTHREADS, 2) k_mega(Params p_kernarg_only) {
    extern __shared__ __attribute__((aligned(16))) unsigned char smem[];
    LAS unsigned char* lds = (LAS unsigned char*)smem;
    volatile LAS unsigned* xbw = (volatile LAS unsigned*)(lds + LDS_BYTES - 16);
    if (threadIdx.x == 0) { xbw[0] = 0u; xbw[1] = 0u; xbw[2] = 0u; xbw[3] = 0u; }
    __syncthreads();
    XcdBarrier bar;
    { const Params p = load_params(); bar = xcd_barrier_post((unsigned*)(p.ws + OFF_BAR), xbw); }
#define WSP(off) (p.ws + (off))
    { const Params p = load_params(); phase_colmax(p); }
    { const Params p = load_params(); phase_prep(p); phase_mod(p, lds); }
    xcd_barrier(bar);
    mega_layer<0>(lds, bar);
    mega_layer<1>(lds, bar);
#undef WSP
}

extern "C" void kernel_launch(void* const* d_in, const int* in_sizes, int n_in, void* d_out, int out_size, void* d_ws, size_t ws_size, hipStream_t stream) {
    (void)in_sizes; (void)n_in; (void)out_size; (void)ws_size;
    Params p;
    const float** f = (const float**)&p;
    for (int i = 0; i < 31; ++i) f[i] = (const float*)d_in[i];
    p.out = (float*)d_out; p.ws = (unsigned char*)d_ws;
    static int grid = 0;
    if (!grid) {
        int dev = 0, cus = 0, per_cu = 0;
        (void)hipGetDevice(&dev);
        (void)hipDeviceGetAttribute(&cus, hipDeviceAttributeMultiprocessorCount, dev);
        (void)hipFuncSetAttribute((const void*)k_mega, hipFuncAttributeMaxDynamicSharedMemorySize, LDS_BYTES);
        (void)hipOccupancyMaxActiveBlocksPerMultiprocessor(&per_cu, (const void*)k_mega, NTHREADS, LDS_BYTES);
        grid = (per_cu >= 1 && cus > 0) ? (cus < 256 ? cus : 256) : 256;
    }
    (void)hipMemsetAsync(p.ws + OFF_BAR, 0, XCD_BAR_WORDS * sizeof(unsigned), stream);
    (void)hipMemsetAsync(p.ws + OFF_CMAX, 0, (size_t)2 * INC * sizeof(unsigned), stream);
    hipLaunchKernelGGL(k_mega, dim3(grid), dim3(NTHREADS), LDS_BYTES, stream, p);
}
```

```cpp
#include <hip/hip_runtime.h>
#include <stdint.h>

#define LAS __attribute__((address_space(3)))
typedef unsigned short bf16_t;
typedef short bf16x8 __attribute__((ext_vector_type(8)));
typedef float f32x4 __attribute__((ext_vector_type(4)));
typedef float f32x2 __attribute__((ext_vector_type(2)));
typedef unsigned u32x4 __attribute__((ext_vector_type(4)));
typedef unsigned u32x2 __attribute__((ext_vector_type(2)));
typedef __bf16 bf16x2_t __attribute__((ext_vector_type(2)));
typedef __bf16 bf16x32_t __attribute__((ext_vector_type(32)));
typedef float f32x32 __attribute__((ext_vector_type(32)));
typedef unsigned u32x6 __attribute__((ext_vector_type(6)));
typedef unsigned u32x16 __attribute__((ext_vector_type(16)));

constexpr int D = 2048, NB = 16, SEQ = 2048, CTXL = 256;
constexpr int TL = NB * SEQ;
constexpr int TC = NB * CTXL;
constexpr int TT = TL + TC;
constexpr int INC = 14080;
constexpr int NMOD = 12288;
constexpr int NTHREADS = 512;
constexpr int LDS_BYTES = 160 * 1024;

constexpr size_t OFF_BAR = 0;
constexpr size_t OFF_CMAX = 16384;
constexpr size_t OFF_MODV = OFF_CMAX + (size_t)2 * INC * 4;
constexpr size_t OFF_LB = OFF_MODV + (size_t)2 * 17 * NMOD * 4;
constexpr size_t OFF_S5LAM = OFF_LB + 2 * 2 * 1024 * 4;
constexpr size_t OFF_S5BB = OFF_S5LAM + (size_t)2 * 2 * 48 * 64 * 2 * 4;
constexpr size_t OFF_PE = OFF_S5BB + (size_t)2 * 2 * 48 * 64 * 32 * 4;
constexpr size_t OFF_HS = (OFF_PE + (size_t)96 * 1024 * 4 + 255) & ~(size_t)255;
constexpr size_t OFF_XC = (OFF_HS + (size_t)TT * 4 + 255) & ~(size_t)255;
constexpr size_t OFF_H = OFF_XC + (size_t)TC * D * 4;
constexpr size_t OFF_W = OFF_H + (size_t)TT * D * 2;
constexpr size_t W_IN = 0;
constexpr size_t W_GLU = W_IN + (size_t)INC * D;
constexpr size_t W_A = W_GLU + (size_t)1536 * 768 * 2;
constexpr size_t W_B = W_A + (size_t)2048 * 1024 * 2;
constexpr size_t W_C = W_B + (size_t)2048 * 1024 * 2;
constexpr size_t W_O = W_C + (size_t)2048 * 768 * 2;
constexpr size_t W_S = W_O + (size_t)2048 * 2048 * 2;
constexpr size_t W_TOTAL = W_S + (size_t)2048 * 2048 * 2;
constexpr size_t OFF_P = OFF_W + W_TOTAL;
constexpr size_t SEG = (size_t)TT * 1024 * 2;
constexpr size_t P_AU = 0, P_AV = SEG, P_BQ = 2 * SEG, P_BFF = 3 * SEG, P_BFB = 4 * SEG, P_BI = 5 * SEG, P_BG = 6 * SEG;
constexpr size_t P_CU = 7 * SEG;
constexpr size_t P_GATES = P_CU + (size_t)TT * 768 * 2;
constexpr size_t P_TOTAL = P_GATES + (size_t)TT * 6144 * 2;
constexpr size_t P_MERGED = SEG;
constexpr size_t Q_UT = 0;
constexpr size_t Q_VT = Q_UT + (size_t)16384 * 1536;
constexpr size_t Q_USC = Q_VT + (size_t)16384 * 1536;
constexpr size_t Q_VSC = Q_USC + (size_t)16384 * 4;
constexpr size_t Q_SC = Q_VSC + (size_t)16384 * 4;
constexpr size_t Q_IDX = Q_SC + (size_t)TT * 2048 * 4;
constexpr size_t Q_GATE = Q_IDX + (size_t)TT * 128 * 4;
constexpr size_t H_YSF = 0;
constexpr size_t H_YSB = (size_t)TT * 768 * 2;
constexpr size_t OFF_H8 = OFF_P + P_TOTAL;
constexpr size_t WS_NEEDED = OFF_H8 + (size_t)TT * D;

struct Params {
    const float *x, *c, *ctx, *c_ctx, *w_mod, *b_mod, *w_in, *ln_g, *ln_b, *w_s, *b_s, *lb_logits, *hn_g;
    const float *lam_re, *lam_im, *log_step, *b_re, *b_im, *c_re, *c_im, *s5_d, *w_glu, *wa, *wb, *wc, *wo, *w_q, *sub_keys, *peer_u, *peer_v, *final_g;
    float* out;
    unsigned char* ws;
};

__device__ __forceinline__ float bf_lo(unsigned u) { return __uint_as_float(u << 16); }
__device__ __forceinline__ float bf_hi(unsigned u) { return __uint_as_float(u & 0xffff0000u); }
__device__ __forceinline__ unsigned cvt_pk_bf16(float lo, float hi) { f32x2 v; v.x = lo; v.y = hi; const bf16x2_t b = __builtin_convertvector(v, bf16x2_t); return __builtin_bit_cast(unsigned, b); }
__device__ __forceinline__ float fexp(float x) { return __builtin_amdgcn_exp2f(x * 1.44269504f); }
__device__ __forceinline__ float flog(float x) { return __builtin_amdgcn_logf(x) * 0.693147181f; }
__device__ __forceinline__ float fast_sigmoid(float x) { return __builtin_amdgcn_rcpf(1.0f + fexp(-x)); }
__device__ __forceinline__ float fast_silu(float x) { return x * fast_sigmoid(x); }
__device__ __forceinline__ float gelu_f(float v) {
    const float av = fabsf(v), t = __builtin_amdgcn_rcpf(av * 0.2316418882f + 1.0f);
    float q = t * 0.5307027145f + (-0.7265760135f); q = q * t + 0.7107068705f; q = q * t + (-0.142248368f); q = q * t + 0.127414796f; q = q * t;
    const float e = __builtin_amdgcn_exp2f((v * v) * (-0.72134752044f));
    const float m = v * (q * e);
    return v < 0.f ? m : v - m;
}
__device__ __forceinline__ unsigned pack_fp8x4(float a, float b, float c, float d) {
    int pk = 0; pk = __builtin_amdgcn_cvt_pk_fp8_f32(a, b, pk, false); pk = __builtin_amdgcn_cvt_pk_fp8_f32(c, d, pk, true); return (unsigned)pk;
}
template <int CTRL> __device__ __forceinline__ float dpp_f(float v) { return __int_as_float(__builtin_amdgcn_update_dpp(0, __float_as_int(v), CTRL, 0xF, 0xF, false)); }
__device__ __forceinline__ float row16_max(float v) { v = fmaxf(v, dpp_f<0x128>(v)); v = fmaxf(v, dpp_f<0x124>(v)); v = fmaxf(v, dpp_f<0x122>(v)); v = fmaxf(v, dpp_f<0x121>(v)); return v; }
__device__ __forceinline__ float row16_sum(float v) { v += dpp_f<0x128>(v); v += dpp_f<0x124>(v); v += dpp_f<0x122>(v); v += dpp_f<0x121>(v); return v; }
__device__ __forceinline__ float wave_sum(float v) {
#pragma unroll
    for (int o = 32; o >= 1; o >>= 1) v += __shfl_xor(v, o);
    return v;
}
__device__ __forceinline__ int otid() { int t; asm volatile("v_mov_b32 %0, %1" : "=v"(t) : "v"((int)threadIdx.x)); return t; }


#define XB_TMO      128
#define XB_XCNT(j)  (256  + 64 * (j))
#define XB_XSUB(j)  (1280 + 64 * (j))
#define XB_XGEN(j)  (2304 + 64 * (j))
#define XB_TOP      3328
#define XB_TOPGEN   3392
#define XCD_BAR_WORDS 3456
#define XB_SPIN_CAP (1u << 22)
__device__ __forceinline__ unsigned xb_ld(unsigned* p)              { return __hip_atomic_load(p, __ATOMIC_RELAXED, __HIP_MEMORY_SCOPE_AGENT); }
__device__ __forceinline__ unsigned xb_add(unsigned* p, unsigned v) { return __hip_atomic_fetch_add(p, v, __ATOMIC_RELAXED, __HIP_MEMORY_SCOPE_AGENT); }
__device__ __forceinline__ unsigned xb_xcc_id() { return (unsigned)__builtin_amdgcn_s_getreg((3 << 11) | 20) & 0xFu; }
#define XB_SPIN(cond, bar) do { unsigned _sp = 0; while (cond) { __builtin_amdgcn_s_sleep(1); \
    if ((++_sp & 255u) == 0u) { if (xb_ld(&(bar)[XB_TMO])) break; if (_sp > XB_SPIN_CAP) { atomicAdd(&(bar)[XB_TMO], 1u); break; } } } } while (0)
struct XcdBarrier { unsigned* bar; unsigned x; volatile LAS unsigned* st; };
__device__ __forceinline__ XcdBarrier xcd_barrier_post(unsigned* bar, volatile LAS unsigned* st) {
    XcdBarrier b; b.bar = bar; b.x = xb_xcc_id(); b.st = st;
    if (threadIdx.x == 0) (void)xb_add(&bar[XB_XCNT(b.x)], 1u);
    return b;
}
__device__ __forceinline__ void xcd_barrier_complete(unsigned* bar, unsigned x, unsigned& nloc, unsigned& nx) {
    const unsigned G = gridDim.x * gridDim.y * gridDim.z;
    unsigned sum, cnt, mine, sp = 0u;
    for (;;) {
        sum = 0u; cnt = 0u; mine = 0u;
#pragma unroll
        for (unsigned j = 0; j < 16; ++j) { const unsigned c = xb_ld(&bar[XB_XCNT(j)]); sum += c; cnt += (c > 0u) ? 1u : 0u; mine = (j == x) ? c : mine; }
        if (sum == G) break;
        __builtin_amdgcn_s_sleep(1);
        if ((++sp & 255u) == 0u) { if (xb_ld(&bar[XB_TMO])) break; if (sp > XB_SPIN_CAP) { atomicAdd(&bar[XB_TMO], 1u); break; } }
    }
    nloc = mine > 0u ? mine : 1u; nx = cnt > 0u ? cnt : 1u;
}
__device__ __forceinline__ void xcd_barrier(const XcdBarrier& b) {
    asm volatile("s_waitcnt vmcnt(0)" ::: "memory");
    __syncthreads();
    if (threadIdx.x == 0) {
        unsigned* bar = b.bar;
        __builtin_amdgcn_s_waitcnt(0);
        unsigned nloc = b.st[0], nx = b.st[1];
        if (nloc == 0u) { xcd_barrier_complete(bar, b.x, nloc, nx); b.st[0] = nloc; b.st[1] = nx; }
        const unsigned old = xb_add(&bar[XB_XSUB(b.x)], 1u);
        const unsigned gen = old / nloc;
        if (old + 1u == (gen + 1u) * nloc) {
            __builtin_amdgcn_fence(__ATOMIC_RELEASE, "agent");
            asm volatile("s_waitcnt vmcnt(0)" ::: "memory");
            const unsigned og = xb_add(&bar[XB_TOP], 1u);
            const unsigned tg = og / nx;
            if (og + 1u == (tg + 1u) * nx) xb_add(&bar[XB_TOPGEN], 1u);
            else XB_SPIN(xb_ld(&bar[XB_TOPGEN]) == tg, bar);
            __builtin_amdgcn_fence(__ATOMIC_ACQUIRE, "agent");
            xb_add(&bar[XB_XGEN(b.x)], 1u);
            asm volatile("s_waitcnt vmcnt(0)" ::: "memory");
        } else {
            XB_SPIN(xb_ld(&bar[XB_XGEN(b.x)]) == gen, bar);
            __builtin_amdgcn_fence(__ATOMIC_ACQUIRE, "agent");
            asm volatile("s_waitcnt vmcnt(0)" ::: "memory");
        }
    }
    __syncthreads();
}

namespace pg8 {
constexpr int BM = 256, BK = 64, HALF = 128, HTB = HALF * BK * 2, STAGE_BYTES = 8 * HTB, NXCD = 8, WGM = 8;
__host__ __device__ __forceinline__ int lds_byte(int r, int c) { const int st = (r >> 4) * 2 + (c >> 5), rr = r & 15, cc = c & 31, ob = rr * 64 + cc * 2; return st * 1024 + (ob ^ (((ob >> 9) & 1) << 5)); }
__host__ __device__ __forceinline__ void stage_rc(int b, int& R, int& C) { const int st = b / 1024, sb = b % 1024, swz = sb ^ (((sb >> 9) & 1) << 5); R = (st >> 1) * 16 + swz / 64; C = (st & 1) * 32 + (swz % 64) / 2; }
__host__ __device__ __forceinline__ int perm32(int rho) { const int n = rho >> 4, i = rho & 15; return 8 * (i >> 2) + 4 * n + (i & 3); }
typedef int i32x8 __attribute__((ext_vector_type(8)));
__device__ __forceinline__ i32x8 cat8(const bf16x8 a, const bf16x8 b) { const u32x4 x = __builtin_bit_cast(u32x4, a), y = __builtin_bit_cast(u32x4, b); i32x8 r; r[0] = (int)x.x; r[1] = (int)x.y; r[2] = (int)x.z; r[3] = (int)x.w; r[4] = (int)y.x; r[5] = (int)y.y; r[6] = (int)y.z; r[7] = (int)y.w; return r; }
struct Unit { int pm, pn; };
struct Gemm { const bf16_t* A; const bf16_t* Bt; int M, N, K; };
struct StaticOrder {
    int nM, nN, nwg, G, c;
    __device__ void init(int M, int N, int G_, int c_) { nM = M / BM; nN = N / BM; nwg = nM * nN; G = G_; c = c_; }
    __device__ bool next(int i, Unit& u) const {
        const long L = (long)i * G + c; if (L >= nwg) return false;
        int wgid = (int)L; { const int q = nwg / NXCD, r = nwg % NXCD, xcd = wgid % NXCD, off = wgid / NXCD; wgid = (xcd < r ? xcd * (q + 1) : r * (q + 1) + (xcd - r) * q) + off; }
        const int nig = WGM * nN, gid = wgid / nig, fm = gid * WGM, gsz = (nM - fm) < WGM ? (nM - fm) : WGM;
        u.pm = fm + ((wgid % nig) % gsz); u.pn = (wgid % nig) / gsz; return true;
    }
};

template <class Epi, class Sched>
__device__ __forceinline__ void gemm_phase(LAS unsigned char* lds, const Gemm g, const Sched& S, const Epi& E) {
    const int tid_ = otid();
    const int tid = tid_, wid = __builtin_amdgcn_readfirstlane(tid >> 6), lane = tid & 63, wr = wid >> 2, wc = wid & 3, fr = lane & 15, fq = lane >> 4;
    const int K = g.K, nt = K / BK;
    unsigned voffA[2], voffB[2];
#pragma unroll
    for (int i = 0; i < 2; ++i) { int R, C; stage_rc(tid * 16 + i * 8192, R, C); const int Rb = Epi::PERM ? ((R & ~31) + perm32(R & 31)) : R;
        voffA[i] = (unsigned)(R * K + C) * 2u; voffB[i] = (unsigned)(Rb * K + C) * 2u; }
    const size_t kstep = (size_t)(BK * 2);
    const size_t hstep = (size_t)HALF * K * 2;
    const size_t tstep = 2 * hstep;
    const unsigned ldsw = (unsigned)wid * 1024u;
    const int aoff = lds_byte(wr * 64 + fr, fq * 8), boff = lds_byte(wc * 32 + fr, fq * 8);
    const int aoff8 = lds_byte(wr * 64 + fr, (fq >> 1) * 32 + (fq & 1) * 16), boff8 = lds_byte(wc * 32 + fr, (fq >> 1) * 32 + (fq & 1) * 16);
#define PG8_SA(b, h) (((b) * 2 + (h)) * HTB)
#define PG8_SB(b, h) ((4 + (b) * 2 + (h)) * HTB)
#define PG8_STAGE(bufoff, gbase, voff) do { _Pragma("unroll") for (int _i = 0; _i < 2; ++_i) \
        __builtin_amdgcn_global_load_lds((const unsigned*)((const char*)(gbase) + (voff)[_i]), (LAS unsigned*)(lds + (bufoff) + ldsw + _i * 8192), 16, 0, 0); } while (0)
#define PG8_LDA(dst, b, h) do { if constexpr (Epi::FP8) { _Pragma("unroll") for (int m = 0; m < 4; ++m) dst##8[m] = cat8(*(const LAS bf16x8*)(lds + PG8_SA(b, h) + aoff + m * 2048), *(const LAS bf16x8*)(lds + PG8_SA(b, h) + aoff + m * 2048 + 1024)); } \
        else { _Pragma("unroll") for (int m = 0; m < 4; ++m) _Pragma("unroll") for (int k = 0; k < 2; ++k) dst[m][k] = *(const LAS bf16x8*)(lds + PG8_SA(b, h) + aoff + m * 2048 + k * 1024); } } while (0)
#define PG8_LDB(dst, b, h) do { if constexpr (Epi::FP8) { _Pragma("unroll") for (int n = 0; n < 2; ++n) dst##8[n] = cat8(*(const LAS bf16x8*)(lds + PG8_SB(b, h) + boff + n * 2048), *(const LAS bf16x8*)(lds + PG8_SB(b, h) + boff + n * 2048 + 1024)); } \
        else { _Pragma("unroll") for (int n = 0; n < 2; ++n) _Pragma("unroll") for (int k = 0; k < 2; ++k) dst[n][k] = *(const LAS bf16x8*)(lds + PG8_SB(b, h) + boff + n * 2048 + k * 1024); } } while (0)
#define PG8_MMA(ai, bj, At, Bt) do { __builtin_amdgcn_s_setprio(1); _Pragma("unroll") for (int m = 0; m < 4; ++m) _Pragma("unroll") for (int n = 0; n < 2; ++n) { \
        if constexpr (Epi::FP8) { asm volatile("v_mfma_scale_f32_16x16x128_f8f6f4 %0, %1, %2, %0, %3, %3 op_sel_hi:[0,0,0]" : "+v"(acc[ai][bj][m][n]) : "v"(Bt##8[n]), "v"(At##8[m]), "v"(one_scale)); } \
        else { _Pragma("unroll") for (int k = 0; k < 2; ++k) acc[ai][bj][m][n] = __builtin_amdgcn_mfma_f32_16x16x32_bf16(Bt[n][k], At[m][k], acc[ai][bj][m][n], 0, 0, 0); } } \
        __builtin_amdgcn_s_setprio(0); } while (0)
#define PG8_WAIT_V(n) asm volatile("s_waitcnt vmcnt(" #n ")" ::: "memory")
#define PG8_WAIT_L(n) asm volatile("s_waitcnt lgkmcnt(" #n ")" ::: "memory")
#define PG8_BAR __builtin_amdgcn_s_barrier()
#define PG8_SCHED __builtin_amdgcn_sched_barrier(0)
    Unit cur, nxt; int ui = 0;
    if (!S.next(0, cur)) return;
    f32x4 acc[2][2][4][2];
#pragma unroll
    for (int a = 0; a < 2; ++a)
#pragma unroll
        for (int b = 0; b < 2; ++b)
#pragma unroll
            for (int m = 0; m < 4; ++m)
#pragma unroll
                for (int n = 0; n < 2; ++n) acc[a][b][m][n] = (f32x4){0.f, 0.f, 0.f, 0.f};
    bf16x8 At[4][2], B0[2][2], B1[2][2];
    i32x8 At8[4], B08[2], B18[2];
    const int one_scale = 0x7F7F7F7F;
    const char* cA = (const char*)g.A + (size_t)cur.pm * tstep; const char* cB = (const char*)g.Bt + (size_t)cur.pn * tstep;
    PG8_STAGE(PG8_SB(0, 0), cB, voffB); PG8_STAGE(PG8_SA(0, 0), cA, voffA); PG8_STAGE(PG8_SB(0, 1), cB + hstep, voffB); PG8_STAGE(PG8_SA(0, 1), cA + hstep, voffA);
    if (wr == 1) PG8_BAR;
    PG8_WAIT_V(4); PG8_BAR;
    PG8_STAGE(PG8_SB(1, 0), cB + kstep, voffB); PG8_STAGE(PG8_SA(1, 0), cA + kstep, voffA); PG8_STAGE(PG8_SB(1, 1), cB + hstep + kstep, voffB);
    PG8_WAIT_V(6); PG8_BAR;
    for (;;) {
        const bool has_next = S.next(ui + 1, nxt);
        const char* nA = has_next ? (const char*)g.A + (size_t)nxt.pm * tstep : cA; const char* nB = has_next ? (const char*)g.Bt + (size_t)nxt.pn * tstep : cB;
        for (int t = 0; t < nt; t += 2) {
            const bool last = (t == nt - 2);
            const char* a1 = cA + (size_t)(t + 1) * kstep;
            const char* a2 = last ? nA : cA + (size_t)(t + 2) * kstep; const char* b2 = last ? nB : cB + (size_t)(t + 2) * kstep;
            const char* a3 = a2 + kstep; const char* b3 = b2 + kstep;
            PG8_LDB(B0, 0, 0); PG8_SCHED; PG8_LDA(At, 0, 0); PG8_STAGE(PG8_SA(1, 1), a1 + hstep, voffA);
            PG8_WAIT_L(8); PG8_BAR; PG8_WAIT_L(0); PG8_MMA(0, 0, At, B0); PG8_BAR; PG8_SCHED;
            PG8_LDB(B1, 0, 1); PG8_STAGE(PG8_SB(0, 0), b2, voffB);
            PG8_BAR; PG8_WAIT_L(0); PG8_MMA(0, 1, At, B1); PG8_BAR;
            PG8_LDA(At, 0, 1); PG8_STAGE(PG8_SA(0, 0), a2, voffA);
            PG8_BAR; PG8_WAIT_L(0); PG8_MMA(1, 0, At, B0); PG8_BAR; PG8_SCHED;
            PG8_STAGE(PG8_SB(0, 1), b2 + hstep, voffB);
            PG8_WAIT_V(6); PG8_BAR; PG8_MMA(1, 1, At, B1); PG8_BAR;
            PG8_LDB(B0, 1, 0); PG8_SCHED; PG8_LDA(At, 1, 0); PG8_STAGE(PG8_SA(0, 1), a2 + hstep, voffA);
            PG8_WAIT_L(8); PG8_BAR; PG8_WAIT_L(0); PG8_MMA(0, 0, At, B0); PG8_BAR; PG8_SCHED;
            PG8_LDB(B1, 1, 1); PG8_STAGE(PG8_SB(1, 0), b3, voffB);
            PG8_BAR; PG8_WAIT_L(0); PG8_MMA(0, 1, At, B1); PG8_BAR;
            PG8_LDA(At, 1, 1); PG8_STAGE(PG8_SA(1, 0), a3, voffA);
            PG8_BAR; PG8_WAIT_L(0); PG8_MMA(1, 0, At, B0); PG8_BAR; PG8_SCHED;
            PG8_STAGE(PG8_SB(1, 1), b3 + hstep, voffB);
            PG8_WAIT_V(6); PG8_BAR; PG8_MMA(1, 1, At, B1); PG8_BAR;
        }
        if constexpr (Epi::FP8) asm volatile("s_nop 15\n s_nop 15\n s_nop 15" ::: "memory");
        E(acc, cur, wr, wc, fr, fq);
        if (!has_next) break;
#pragma unroll
        for (int a = 0; a < 2; ++a)
#pragma unroll
            for (int b = 0; b < 2; ++b)
#pragma unroll
                for (int m = 0; m < 4; ++m)
#pragma unroll
                    for (int n = 0; n < 2; ++n) acc[a][b][m][n] = (f32x4){0.f, 0.f, 0.f, 0.f};
        cur = nxt; cA = nA; cB = nB; ++ui;
    }
    PG8_WAIT_V(0);
    if (wr == 0) PG8_BAR;
    PG8_BAR;
#undef PG8_SA
#undef PG8_SB
#undef PG8_STAGE
#undef PG8_LDA
#undef PG8_LDB
#undef PG8_MMA
#undef PG8_WAIT_V
#undef PG8_WAIT_L
#undef PG8_BAR
#undef PG8_SCHED
}
}

typedef f32x4 AccT[2][2][4][2];

struct EpiInProj {
    static constexpr bool PERM = true, FP8 = true;
    unsigned char* P;
    const float* sa;
    const unsigned* cmax;
    __device__ __forceinline__ void operator()(const AccT& acc, const pg8::Unit& u, int wr, int wc, int fr, int fq) const {
        const int pn = u.pn;
        bf16_t* base; int ld, lc, act;
        if (pn < 28) { const int seg = pn >> 2; base = (bf16_t*)(P + (size_t)seg * SEG); ld = 1024; lc = (pn & 3) * 256; act = (seg < 2) ? 1 : ((seg == 2 || seg == 6) ? 2 : 0); }
        else if (pn < 31) { base = (bf16_t*)(P + P_CU); ld = 768; lc = (pn - 28) * 256; act = 0; }
        else { base = (bf16_t*)(P + P_GATES); ld = 6144; lc = (pn - 31) * 256; act = 3; }
        const int row0 = u.pm * 256 + wr * 64 + fr, col0 = lc + wc * 32 + 8 * fq, gcol0 = u.pn * 256 + wc * 32 + 8 * fq;
        f32x4 cs[2][2];
#pragma unroll
        for (int bj = 0; bj < 2; ++bj)
#pragma unroll
            for (int n = 0; n < 2; ++n) { const u32x4 cb = *(const u32x4*)(cmax + gcol0 + bj * 128 + 4 * n);
                cs[bj][n] = (f32x4){__uint_as_float(cb.x), __uint_as_float(cb.y), __uint_as_float(cb.z), __uint_as_float(cb.w)} * (1.0f / 240.0f); }
        float rscv[2][4];
#pragma unroll
        for (int ai = 0; ai < 2; ++ai)
#pragma unroll
            for (int m = 0; m < 4; ++m) rscv[ai][m] = sa[row0 + ai * 128 + m * 16];
#pragma unroll
        for (int ai = 0; ai < 2; ++ai)
#pragma unroll
            for (int m = 0; m < 4; ++m) {
                bf16_t* rowp = base + (size_t)(row0 + ai * 128 + m * 16) * ld + col0;
                const float rsc = rscv[ai][m];
#pragma unroll
                for (int bj = 0; bj < 2; ++bj) {
                    f32x4 v0 = acc[ai][bj][m][0] * (cs[bj][0] * rsc), v1 = acc[ai][bj][m][1] * (cs[bj][1] * rsc);
                    if (act == 1) {
#pragma unroll
                        for (int j = 0; j < 4; ++j) { v0[j] = gelu_f(v0[j]); v1[j] = gelu_f(v1[j]); }
                    } else if (act == 2) {
#pragma unroll
                        for (int j = 0; j < 4; ++j) { v0[j] = fast_silu(v0[j]); v1[j] = fast_silu(v1[j]); }
                    } else if (act == 3) {
#pragma unroll
                        for (int j = 0; j < 4; ++j) { v0[j] = fast_sigmoid(v0[j]); v1[j] = fast_sigmoid(v1[j]); }
                    }
                    u32x4 w; w.x = cvt_pk_bf16(v0[0], v0[1]); w.y = cvt_pk_bf16(v0[2], v0[3]); w.z = cvt_pk_bf16(v1[0], v1[1]); w.w = cvt_pk_bf16(v1[2], v1[3]);
                    *(u32x4*)(rowp + bj * 128) = w;
                }
            }
    }
};
struct EpiGlu {
    static constexpr bool PERM = true, FP8 = false;
    bf16_t* O;
    __device__ __forceinline__ void operator()(const AccT& acc, const pg8::Unit& u, int wr, int wc, int fr, int fq) const {
        const int row0 = u.pm * 256 + wr * 64 + fr, col0 = u.pn * 128 + wc * 32 + 8 * fq;
#pragma unroll
        for (int ai = 0; ai < 2; ++ai)
#pragma unroll
            for (int m = 0; m < 4; ++m) {
                f32x4 v0 = acc[ai][0][m][0], v1 = acc[ai][0][m][1]; const f32x4 g0 = acc[ai][1][m][0], g1 = acc[ai][1][m][1];
#pragma unroll
                for (int j = 0; j < 4; ++j) { v0[j] *= fast_sigmoid(g0[j]); v1[j] *= fast_sigmoid(g1[j]); }
                u32x4 w; w.x = cvt_pk_bf16(v0[0], v0[1]); w.y = cvt_pk_bf16(v0[2], v0[3]); w.z = cvt_pk_bf16(v1[0], v1[1]); w.w = cvt_pk_bf16(v1[2], v1[3]);
                *(u32x4*)(O + (size_t)(row0 + ai * 128 + m * 16) * 768 + col0) = w;
            }
    }
};
template <bool FIRST> struct EpiMerge {
    static constexpr bool PERM = true, FP8 = false;
    bf16_t* O;
    const bf16_t* G;
    __device__ __forceinline__ void operator()(const AccT& acc, const pg8::Unit& u, int wr, int wc, int fr, int fq) const {
        const int row0 = u.pm * 256 + wr * 64 + fr, col0 = u.pn * 256 + wc * 32 + 8 * fq;
#pragma unroll
        for (int ai = 0; ai < 2; ++ai) {
            u32x4 gwv[4][2], owv[4][2];
#pragma unroll
            for (int m = 0; m < 4; ++m)
#pragma unroll
                for (int bj = 0; bj < 2; ++bj) { const size_t row = (size_t)(row0 + ai * 128 + m * 16);
                    gwv[m][bj] = *(const u32x4*)(G + row * 6144 + col0 + bj * 128);
                    if (!FIRST) owv[m][bj] = *(const u32x4*)(O + row * 2048 + col0 + bj * 128); }
#pragma unroll
            for (int m = 0; m < 4; ++m)
#pragma unroll
                for (int bj = 0; bj < 2; ++bj) { const size_t row = (size_t)(row0 + ai * 128 + m * 16);
                    const u32x4 gw = gwv[m][bj];
                    f32x4 v0 = acc[ai][bj][m][0], v1 = acc[ai][bj][m][1];
                    v0[0] *= bf_lo(gw.x); v0[1] *= bf_hi(gw.x); v0[2] *= bf_lo(gw.y); v0[3] *= bf_hi(gw.y);
                    v1[0] *= bf_lo(gw.z); v1[1] *= bf_hi(gw.z); v1[2] *= bf_lo(gw.w); v1[3] *= bf_hi(gw.w);
                    if (!FIRST) { const u32x4 ow = owv[m][bj];
                        v0[0] += bf_lo(ow.x); v0[1] += bf_hi(ow.x); v0[2] += bf_lo(ow.y); v0[3] += bf_hi(ow.y);
                        v1[0] += bf_lo(ow.z); v1[1] += bf_hi(ow.z); v1[2] += bf_lo(ow.w); v1[3] += bf_hi(ow.w); }
                    u32x4 w; w.x = cvt_pk_bf16(v0[0], v0[1]); w.y = cvt_pk_bf16(v0[2], v0[3]); w.z = cvt_pk_bf16(v1[0], v1[1]); w.w = cvt_pk_bf16(v1[2], v1[3]);
                    *(u32x4*)(O + row * 2048 + col0 + bj * 128) = w; }
        }
    }
};
struct EpiResid {
    static constexpr bool PERM = false, FP8 = false;
    float* XR; float* XC; const float* modl;
    __device__ __forceinline__ void operator()(const AccT& acc, const pg8::Unit& u, int wr, int wc, int fr, int fq) const {
        const int row0 = u.pm * 256 + wr * 64 + fr, col0 = u.pn * 256 + wc * 32 + 4 * fq;
        const int mb = u.pm < 128 ? (u.pm >> 3) : 16;
        const float* gv = modl + (size_t)mb * NMOD + col0;
        float* basep = u.pm < 128 ? XR : (XC - (size_t)TL * D);
        f32x4 gvv[2][2];
#pragma unroll
        for (int bj = 0; bj < 2; ++bj)
#pragma unroll
            for (int n = 0; n < 2; ++n) gvv[bj][n] = *(const f32x4*)(gv + bj * 128 + n * 16);
#pragma unroll
        for (int ai = 0; ai < 2; ++ai) {
            f32x4 xo[4][2][2];
#pragma unroll
            for (int m = 0; m < 4; ++m)
#pragma unroll
                for (int bj = 0; bj < 2; ++bj)
#pragma unroll
                    for (int n = 0; n < 2; ++n) xo[m][bj][n] = *(const f32x4*)(basep + (size_t)(row0 + ai * 128 + m * 16) * D + col0 + bj * 128 + n * 16);
#pragma unroll
            for (int m = 0; m < 4; ++m)
#pragma unroll
                for (int bj = 0; bj < 2; ++bj)
#pragma unroll
                    for (int n = 0; n < 2; ++n) *(f32x4*)(basep + (size_t)(row0 + ai * 128 + m * 16) * D + col0 + bj * 128 + n * 16) = xo[m][bj][n] + gvv[bj][n] * acc[ai][bj][m][n];
        }
    }
};
struct EpiF32 {
    static constexpr bool PERM = false, FP8 = false;
    float* C; int ldc;
    __device__ __forceinline__ void operator()(const AccT& acc, const pg8::Unit& u, int wr, int wc, int fr, int fq) const {
        const int row0 = u.pm * 256 + wr * 64 + fr, col0 = u.pn * 256 + wc * 32 + 4 * fq;
#pragma unroll
        for (int ai = 0; ai < 2; ++ai)
#pragma unroll
            for (int m = 0; m < 4; ++m) {
                float* rowp = C + (size_t)(row0 + ai * 128 + m * 16) * ldc + col0;
#pragma unroll
                for (int bj = 0; bj < 2; ++bj)
#pragma unroll
                    for (int n = 0; n < 2; ++n) *(f32x4*)(rowp + bj * 128 + n * 16) = acc[ai][bj][m][n];
            }
    }
};

template <class Epi>
__device__ __forceinline__ void run_gemm(LAS unsigned char* lds, const bf16_t* A, const bf16_t* Bt, int M, int N, int K, const Epi& E, int rot = 0) {
    pg8::Gemm g{A, Bt, M, N, K};
    const int G_ = (int)gridDim.x; int c_ = (int)blockIdx.x - rot; if (c_ < 0) c_ += G_;
    pg8::StaticOrder S; S.init(M, N, G_, c_);
    pg8::gemm_phase<Epi, pg8::StaticOrder>(lds, g, S, E);
}

__device__ __forceinline__ void phase_mod(const Params& p, LAS unsigned char* lds) {
    const int tid_ = otid();
    LAS float* cs = (LAS float*)lds;
    LAS float* red = (LAS float*)(lds + 2048 * 17 * 4);
    const int tid = tid_;
    float* modv = (float*)(p.ws + OFF_MODV);
    for (int i = tid; i < 17 * 2048; i += NTHREADS) { const int r = i >> 11, k = i & 2047; const float c = r < 16 ? p.c[r * 2048 + k] : p.c_ctx[k]; cs[k * 17 + r] = c / (1.0f + __expf(-c)); }
    __syncthreads();
    const int lane = tid & 63, wv = tid >> 6, cq = lane & 7, kg = wv * 8 + (lane >> 3);
    for (int u = blockIdx.x; u < 768; u += gridDim.x) {
        const int l = u / 384, c0 = (u % 384) * 32;
        const float* w = p.w_mod + (size_t)l * 2048 * NMOD + (size_t)kg * NMOD + c0 + cq * 4;
        f32x4 acc[17];
#pragma unroll
        for (int r = 0; r < 17; ++r) acc[r] = (f32x4){0.f, 0.f, 0.f, 0.f};
#pragma unroll 8
        for (int j = 0; j < 32; ++j) {
            const f32x4 w4 = *(const f32x4*)(w + (size_t)j * 64 * NMOD);
            const LAS float* cr = cs + (kg + 64 * j) * 17;
#pragma unroll
            for (int r = 0; r < 17; ++r) acc[r] += w4 * cr[r];
        }
#pragma unroll
        for (int r = 0; r < 17; ++r)
#pragma unroll
            for (int c = 0; c < 4; ++c) { float v = acc[r][c]; v += __shfl_xor(v, 8); v += __shfl_xor(v, 16); v += __shfl_xor(v, 32);
                if (lane < 8) red[(wv * 32 + cq * 4 + c) * 17 + r] = v; }
        __syncthreads();
        for (int o = tid; o < 32 * 17; o += NTHREADS) { const int col = o & 31, r = o >> 5;
            float sum = p.b_mod[l * NMOD + c0 + col];
#pragma unroll
            for (int q = 0; q < 8; ++q) sum += red[(q * 32 + col) * 17 + r];
            modv[(size_t)(l * 17 + r) * NMOD + c0 + col] = sum; }
        __syncthreads();
    }
}
__device__ __forceinline__ void phase_prep(const Params& p) {
    const int tid_ = otid();
    const int gt = blockIdx.x * NTHREADS + tid_, nt = gridDim.x * NTHREADS;
    float* lb = (float*)(p.ws + OFF_LB);
    for (int i = gt; i < 2 * 1024; i += nt) { const float x0 = p.lb_logits[i], x1 = p.lb_logits[2048 + i]; lb[i] = 0.f; lb[2048 + i] = 1.0f / (1.0f + expf(x0 - x1)); }
    float* s5lam = (float*)(p.ws + OFF_S5LAM); float* s5bb = (float*)(p.ws + OFF_S5BB);
    for (int i = gt; i < 2 * 2 * 48 * 64; i += nt) {
        const int ldg = i >> 6;
        const double lre = (double)p.lam_re[i], lim = (double)p.lam_im[i], dt = exp((double)p.log_step[ldg]);
        const double er = exp(lre * dt); double sn, cs; sincos(lim * dt, &sn, &cs);
        const double br = er * cs, bi = er * sn;
        s5lam[i * 2] = (float)br; s5lam[i * 2 + 1] = (float)bi;
        const double nr = br - 1.0, ni = bi, den = lre * lre + lim * lim;
        const double cr = (nr * lre + ni * lim) / den, ci = (ni * lre - nr * lim) / den;
        for (int d = 0; d < 16; ++d) { const double xr = (double)p.b_re[(size_t)i * 16 + d], xi = (double)p.b_im[(size_t)i * 16 + d];
            s5bb[(size_t)i * 32 + d] = (float)(cr * xr - ci * xi); s5bb[(size_t)i * 32 + 16 + d] = (float)(cr * xi + ci * xr); }
    }
    float* pe = (float*)(p.ws + OFF_PE);
    for (int i = gt; i < 96 * 1024; i += nt) {
        const int r = i >> 10, cc = i & 1023, j = cc & 511;
        const float pos = (float)(r < 32 ? r : r - 32);
        const float omega = 1.0f / powf(10000.0f, (float)j * (1.0f / 512.0f));
        const float ang = pos * omega;
        pe[i] = cc < 512 ? sinf(ang) : cosf(ang);
    }
}

template <int MAPMODE>
__device__ __forceinline__ void transpose_convert(const float* src, int K, int N, bf16_t* dst, LAS unsigned char* lds) {
    const int tid_ = otid();
    LAS float* tile = (LAS float*)lds;
    const int tid = tid_, nkb = K / 64, nnb = N / 64;
    for (int u = blockIdx.x; u < nkb * nnb; u += gridDim.x) {
        const int kb = u / nnb, nb = u % nnb, k0 = kb * 64, n0 = nb * 64;
        { const int nn = tid & 63, kk = tid >> 6;
#pragma unroll
          for (int i = 0; i < 8; ++i) tile[(kk + i * 8) * 65 + nn] = src[(size_t)(k0 + kk + i * 8) * N + n0 + nn]; }
        __syncthreads();
        { const int kk2 = (tid & 7) * 8, nn2 = tid >> 3; float v[8];
#pragma unroll
          for (int i = 0; i < 8; ++i) v[i] = tile[(kk2 + i) * 65 + nn2];
          int n = n0 + nn2, nr;
          if (MAPMODE == 1) { if (n < 768) nr = (n >> 7) * 256 + (n & 127); else { const int m = n - 768; nr = (m >> 7) * 256 + 128 + (m & 127); } } else nr = n;
          u32x4 w; w.x = cvt_pk_bf16(v[0], v[1]); w.y = cvt_pk_bf16(v[2], v[3]); w.z = cvt_pk_bf16(v[4], v[5]); w.w = cvt_pk_bf16(v[6], v[7]);
          *(u32x4*)(dst + (size_t)nr * K + k0 + kk2) = w; }
        __syncthreads();
    }
}
__device__ __forceinline__ void phase_wscore(const float* wq, const float* sk, bf16_t* dst, LAS unsigned char* lds) {
    const int tid_ = otid();
    LAS float* skt = (LAS float*)lds;
    LAS float* wqt = (LAS float*)(lds + 128 * 129 * 4);
    const int tid = tid_;
    for (int u = blockIdx.x; u < 16 * 32; u += gridDim.x) {
        const int hp = u >> 5, kb = u & 31;
        for (int i = tid; i < 128 * 128; i += NTHREADS) { const int key = i >> 7, e = i & 127; skt[key * 129 + e] = sk[(size_t)hp * 16384 + i]; }
        for (int i = tid; i < 64 * 128; i += NTHREADS) { const int k = i >> 7, e = i & 127; wqt[e * 68 + k] = wq[(size_t)(kb * 64 + k) * 2048 + hp * 128 + e]; }
        __syncthreads();
        const int key = tid & 127, kg = tid >> 7;
        float acc[16];
#pragma unroll
        for (int i = 0; i < 16; ++i) acc[i] = 0.f;
        for (int e = 0; e < 128; ++e) {
            const float s = skt[key * 129 + e];
#pragma unroll
            for (int q = 0; q < 4; ++q) { const f32x4 w4 = *(const LAS f32x4*)(wqt + e * 68 + kg * 16 + q * 4);
                acc[q * 4 + 0] += s * w4[0]; acc[q * 4 + 1] += s * w4[1]; acc[q * 4 + 2] += s * w4[2]; acc[q * 4 + 3] += s * w4[3]; }
        }
        bf16_t* o = dst + (size_t)(hp * 128 + key) * 2048 + kb * 64 + kg * 16;
        u32x4 w0, w1;
        w0.x = cvt_pk_bf16(acc[0], acc[1]); w0.y = cvt_pk_bf16(acc[2], acc[3]); w0.z = cvt_pk_bf16(acc[4], acc[5]); w0.w = cvt_pk_bf16(acc[6], acc[7]);
        w1.x = cvt_pk_bf16(acc[8], acc[9]); w1.y = cvt_pk_bf16(acc[10], acc[11]); w1.z = cvt_pk_bf16(acc[12], acc[13]); w1.w = cvt_pk_bf16(acc[14], acc[15]);
        *(u32x4*)o = w0; *(u32x4*)(o + 8) = w1;
        __syncthreads();
    }
}
__device__ __forceinline__ void phase_colmax(const Params& p) {
    const int tid_ = otid();
    unsigned* cm = (unsigned*)(p.ws + OFF_CMAX);
    const int total = 2 * (INC / 4) * 16;
    for (int i = blockIdx.x * NTHREADS + tid_; i < total; i += gridDim.x * NTHREADS) {
        const int kc = i / (2 * (INC / 4)), cidx = i % (2 * (INC / 4)), l = cidx / (INC / 4), nq = cidx % (INC / 4);
        const float* w = p.w_in + (size_t)l * D * INC + (size_t)(kc * 128) * INC + nq * 4;
        f32x4 am = (f32x4){0.f, 0.f, 0.f, 0.f};
#pragma unroll 16
        for (int k = 0; k < 128; ++k) { const f32x4 v = *(const f32x4*)(w + (size_t)k * INC);
            am[0] = fmaxf(am[0], fabsf(v[0])); am[1] = fmaxf(am[1], fabsf(v[1])); am[2] = fmaxf(am[2], fabsf(v[2])); am[3] = fmaxf(am[3], fabsf(v[3])); }
        unsigned* o = cm + l * INC + nq * 4;
        atomicMax(o, __float_as_uint(am[0])); atomicMax(o + 1, __float_as_uint(am[1])); atomicMax(o + 2, __float_as_uint(am[2])); atomicMax(o + 3, __float_as_uint(am[3]));
    }
}
__device__ __forceinline__ void transpose_convert_fp8(const float* src, int K, int N, unsigned char* dst, const unsigned* cmax, LAS unsigned char* lds) {
    const int tid_ = otid();
    LAS float* tile = (LAS float*)lds;
    const int tid = tid_, nkb = K / 64, nnb = N / 64;
    for (int u = blockIdx.x; u < nkb * nnb; u += gridDim.x) {
        const int kb = u / nnb, nb = u % nnb, k0 = kb * 64, n0 = nb * 64;
        { const int nn = tid & 63, kk = tid >> 6;
#pragma unroll
          for (int i = 0; i < 8; ++i) tile[(kk + i * 8) * 65 + nn] = src[(size_t)(k0 + kk + i * 8) * N + n0 + nn]; }
        __syncthreads();
        { const int kk2 = (tid & 7) * 8, nn2 = tid >> 3; float v[8];
          const float cmv = __uint_as_float(cmax[n0 + nn2]); const float sc = cmv > 0.f ? 240.0f / cmv : 1.0f;
#pragma unroll
          for (int i = 0; i < 8; ++i) v[i] = tile[(kk2 + i) * 65 + nn2] * sc;
          u32x2 w; w.x = pack_fp8x4(v[0], v[1], v[2], v[3]); w.y = pack_fp8x4(v[4], v[5], v[6], v[7]);
          *(u32x2*)(dst + (size_t)(n0 + nn2) * K + k0 + kk2) = w; }
        __syncthreads();
    }
}
__device__ __forceinline__ void phase_wconv(const Params& p, int l, LAS unsigned char* lds) {
    unsigned char* W = p.ws + OFF_W;
    transpose_convert_fp8(p.w_in + (size_t)l * D * INC, D, INC, W + W_IN, (const unsigned*)(p.ws + OFF_CMAX) + (size_t)l * INC, lds);
    transpose_convert<1>(p.w_glu + (size_t)l * 768 * 1536, 768, 1536, (bf16_t*)(W + W_GLU), lds);
    transpose_convert<0>(p.wa + (size_t)l * 1024 * D, 1024, D, (bf16_t*)(W + W_A), lds);
    transpose_convert<0>(p.wb + (size_t)l * 1024 * D, 1024, D, (bf16_t*)(W + W_B), lds);
    transpose_convert<0>(p.wc + (size_t)l * 768 * D, 768, D, (bf16_t*)(W + W_C), lds);
    transpose_convert<0>(p.wo + (size_t)l * D * D, D, D, (bf16_t*)(W + W_O), lds);
    phase_wscore(p.w_q + (size_t)l * D * D, p.sub_keys + (size_t)l * 16 * 16384, (bf16_t*)(W + W_S), lds);
}
__device__ __forceinline__ void phase_tabconv(const Params& p, int l) {
    const int tid_ = otid();
    const int lane = tid_ & 63, gw = blockIdx.x * 8 + __builtin_amdgcn_readfirstlane(tid_ >> 6), nw = gridDim.x * 8;
    unsigned char* U6 = p.ws + OFF_P + Q_UT; unsigned char* V6 = p.ws + OFF_P + Q_VT;
    float* USC = (float*)(p.ws + OFF_P + Q_USC); float* VSC = (float*)(p.ws + OFF_P + Q_VSC);
    for (int r = gw; r < 32768; r += nw) {
        const bool isv = r >= 16384; const int rr = r & 16383;
        const float* src = (isv ? p.peer_v : p.peer_u) + (size_t)l * 16384 * 2048 + (size_t)rr * 2048;
        f32x4 v[8];
#pragma unroll
        for (int j = 0; j < 8; ++j) v[j] = *(const f32x4*)(src + j * 256 + lane * 4);
        float am = 0.f;
#pragma unroll
        for (int j = 0; j < 8; ++j) am = fmaxf(am, fmaxf(fmaxf(fabsf(v[j][0]), fabsf(v[j][1])), fmaxf(fabsf(v[j][2]), fabsf(v[j][3]))));
#pragma unroll
        for (int o = 32; o >= 1; o >>= 1) am = fmaxf(am, __shfl_xor(am, o));
        const float sc = am > 0.f ? 7.0f / am : 1.0f, inv = am > 0.f ? am * (1.0f / 7.0f) : 1.0f;
        bf16x32_t bv;
#pragma unroll
        for (int j = 0; j < 8; ++j)
#pragma unroll
            for (int c = 0; c < 4; ++c) bv[j * 4 + c] = (__bf16)(v[j][c] * sc);
        const u32x6 pk = __builtin_amdgcn_cvt_scalef32_pk32_fp6_bf16(bv, 1.0f);
        unsigned char* dst = (isv ? V6 : U6) + (size_t)rr * 1536 + lane * 24;
        u32x4 w0; w0.x = pk[0]; w0.y = pk[1]; w0.z = pk[2]; w0.w = pk[3]; u32x2 w1; w1.x = pk[4]; w1.y = pk[5];
        *(u32x4*)dst = w0; *(u32x2*)(dst + 16) = w1;
        if (lane == 0) (isv ? VSC : USC)[rr] = inv;
    }
}

template <int MODE, bool F8OUT = false>
__device__ __forceinline__ void phase_norm(const Params& p, int l, int M, int off_sh, int off_sc) {
    const int tid_ = otid();
    const int lane = tid_ & 63, gw = blockIdx.x * 8 + __builtin_amdgcn_readfirstlane(tid_ >> 6), nw = gridDim.x * 8;
    const float* modv = (const float*)(p.ws + OFF_MODV) + (size_t)l * 17 * NMOD;
    const float* pe = (const float*)(p.ws + OFF_PE);
    float* XC = (float*)(p.ws + OFF_XC);
    bf16_t* H = (bf16_t*)(p.ws + OFF_H);
    for (int r = gw; r < M; r += nw) {
        const bool lat = r < TL;
        const float* src = MODE == 0 ? (lat ? p.x + (size_t)r * D : p.ctx + (size_t)(r - TL) * D) : (lat ? p.out + (size_t)r * D : XC + (size_t)(r - TL) * D);
        f32x4 v[4][2];
#pragma unroll
        for (int j = 0; j < 4; ++j) { v[j][0] = *(const f32x4*)(src + j * 512 + lane * 8); v[j][1] = *(const f32x4*)(src + j * 512 + lane * 8 + 4); }
        if (MODE == 0) {
            if (lat) { const int n = r & 2047, gr = n >> 6, gc = n & 63;
#pragma unroll
                for (int j = 0; j < 4; ++j) { const float* pr = (j < 2) ? pe + (size_t)gr * 1024 + j * 512 + lane * 8 : pe + (size_t)(32 + gc) * 1024 + (j - 2) * 512 + lane * 8;
                    v[j][0] += *(const f32x4*)pr; v[j][1] += *(const f32x4*)(pr + 4); } }
            float* dst = lat ? p.out + (size_t)r * D : XC + (size_t)(r - TL) * D;
#pragma unroll
            for (int j = 0; j < 4; ++j) { *(f32x4*)(dst + j * 512 + lane * 8) = v[j][0]; *(f32x4*)(dst + j * 512 + lane * 8 + 4) = v[j][1]; }
        }
        float ss = 0.f;
#pragma unroll
        for (int j = 0; j < 4; ++j)
#pragma unroll
            for (int h = 0; h < 2; ++h) ss += v[j][h][0] * v[j][h][0] + v[j][h][1] * v[j][h][1] + v[j][h][2] * v[j][h][2] + v[j][h][3] * v[j][h][3];
        ss = wave_sum(ss);
        const float rs = rsqrtf(ss * (1.0f / 2048.0f) + 1e-6f);
        const int mb = lat ? (r >> 11) : 16;
        const float* sh = modv + (size_t)mb * NMOD + off_sh; const float* sc = modv + (size_t)mb * NMOD + off_sc;
        if (F8OUT) {
            float am = 0.f;
#pragma unroll
            for (int j = 0; j < 4; ++j) { const int e = j * 512 + lane * 8;
                const f32x4 s0 = *(const f32x4*)(sc + e), s1 = *(const f32x4*)(sc + e + 4), h0 = *(const f32x4*)(sh + e), h1 = *(const f32x4*)(sh + e + 4);
                v[j][0] = v[j][0] * rs * (s0 + 1.0f) + h0; v[j][1] = v[j][1] * rs * (s1 + 1.0f) + h1;
#pragma unroll
                for (int hh = 0; hh < 2; ++hh) am = fmaxf(am, fmaxf(fmaxf(fabsf(v[j][hh][0]), fabsf(v[j][hh][1])), fmaxf(fabsf(v[j][hh][2]), fabsf(v[j][hh][3])))); }
#pragma unroll
            for (int o = 32; o >= 1; o >>= 1) am = fmaxf(am, __shfl_xor(am, o));
            const float q = am > 0.f ? 240.0f / am : 1.0f;
            unsigned char* H8 = p.ws + OFF_H8 + (size_t)r * D;
#pragma unroll
            for (int j = 0; j < 4; ++j) { u32x2 w; w.x = pack_fp8x4(v[j][0][0] * q, v[j][0][1] * q, v[j][0][2] * q, v[j][0][3] * q); w.y = pack_fp8x4(v[j][1][0] * q, v[j][1][1] * q, v[j][1][2] * q, v[j][1][3] * q);
                *(u32x2*)(H8 + j * 512 + lane * 8) = w; }
            if (lane == 0) ((float*)(p.ws + OFF_HS))[r] = am > 0.f ? am * (1.0f / 240.0f) : 1.0f;
        } else {
#pragma unroll
        for (int j = 0; j < 4; ++j) {
            const int e = j * 512 + lane * 8;
            const f32x4 s0 = *(const f32x4*)(sc + e), s1 = *(const f32x4*)(sc + e + 4), h0 = *(const f32x4*)(sh + e), h1 = *(const f32x4*)(sh + e + 4);
            f32x4 a = v[j][0] * rs * (s0 + 1.0f) + h0, b = v[j][1] * rs * (s1 + 1.0f) + h1;
            u32x4 w; w.x = cvt_pk_bf16(a[0], a[1]); w.y = cvt_pk_bf16(a[2], a[3]); w.z = cvt_pk_bf16(b[0], b[1]); w.w = cvt_pk_bf16(b[2], b[3]);
            *(u32x4*)(H + (size_t)r * D + e) = w;
        }
        }
    }
}
__device__ __forceinline__ bf16x8 mk_bf16x8(unsigned a, unsigned b, unsigned c, unsigned d) { u32x4 q; q.x = a; q.y = b; q.z = c; q.w = d; return __builtin_bit_cast(bf16x8, q); }
__device__ __forceinline__ void phase_hgrn(const Params& p, int l, LAS unsigned char* lds, bool dry = false) {
    const int tid_ = otid();
    const int lane = tid_ & 63, w = __builtin_amdgcn_readfirstlane(tid_ >> 6), q = lane >> 4, m = lane & 15;
    constexpr int OQ = 0, OKH = 4352, OKT = 8704, OIT = 14848, OE = 20992, BUFSZ = 21504, RAWOFF = 2 * 21504, RAWSZ = 3 * 4352;
    unsigned char* P = p.ws + OFF_P;
    const float* lbp = (const float*)(p.ws + OFF_LB) + (size_t)l * 2048;
    const int kch = 16 * w + m;
    for (int u = blockIdx.x; u < 256; u += gridDim.x) {
        const int b = u >> 4, h = (u >> 1) & 7, dir = u & 1;
        const bf16_t* BQ = (const bf16_t*)(P + P_BQ); const bf16_t* BI = (const bf16_t*)(P + P_BI);
        bf16_t* BF = (bf16_t*)(P + (dir ? P_BFB : P_BFF));
        const float lbv = lbp[dir * 1024 + h * 128 + kch];
        f32x4 Sacc[8];
#pragma unroll
        for (int i = 0; i < 8; ++i) Sacc[i] = (f32x4){0.f, 0.f, 0.f, 0.f};
        for (int seg = 0; seg < 2; ++seg) {
            const int len = seg == 0 ? CTXL : SEQ, rbase = seg == 0 ? TL + b * CTXL : b * SEQ, nch = len / 16;
            u32x4 g0 = (u32x4){0u, 0u, 0u, 0u}, g1 = g0;
            const int gs = (tid_ & 255) >> 4, gc8 = (tid_ & 15) * 8;
#define HG_GLOAD(c) do { const int st = (c) * 16 + gs, n = dir ? (len - 1 - st) : st; const size_t o = (size_t)(rbase + n) * 1024 + h * 128 + gc8; \
                if (tid_ < 256) { g0 = *(const u32x4*)(BQ + o); g1 = *(const u32x4*)(BF + o); } else { g0 = *(const u32x4*)(BI + o); } } while (0)
#define HG_RAWW(c) do { LAS unsigned char* rw = lds + RAWOFF + ((c) & 1) * RAWSZ + gs * 272 + gc8 * 2; \
                if (tid_ < 256) { *(LAS u32x4*)(rw) = g0; *(LAS u32x4*)(rw + 4352) = g1; } else { *(LAS u32x4*)(rw + 8704) = g0; } } while (0)
#define HG_STAGE(c, bufp) do { float fv[4], cb[4]; float run = 0.f; unsigned short rq[4], rf[4], ri[4]; \
                { const LAS unsigned char* rr = lds + RAWOFF + ((c) & 1) * RAWSZ + kch * 2; _Pragma("unroll") for (int j = 0; j < 4; ++j) { rq[j] = *(const LAS bf16_t*)(rr + (4 * q + j) * 272); rf[j] = *(const LAS bf16_t*)(rr + 4352 + (4 * q + j) * 272); ri[j] = *(const LAS bf16_t*)(rr + 8704 + (4 * q + j) * 272); } } \
                _Pragma("unroll") for (int j = 0; j < 4; ++j) { const float xf = __uint_as_float(((unsigned)rf[j]) << 16); fv[j] = lbv + (1.0f - lbv) * fast_sigmoid(xf); run += flog(fv[j]); cb[j] = run; } \
                const float t0 = __shfl(run, m), t1 = __shfl(run, m + 16), t2 = __shfl(run, m + 32); \
                const float off = (q > 0 ? t0 : 0.f) + (q > 1 ? t1 : 0.f) + (q > 2 ? t2 : 0.f); \
                float qh[4], kh[4]; \
                _Pragma("unroll") for (int j = 0; j < 4; ++j) { const float bb = off + cb[j], bc = fmaxf(bb, -80.0f); qh[j] = __uint_as_float(((unsigned)rq[j]) << 16) * fexp(bc); kh[j] = (1.0f - fv[j]) * fexp(-bc);     \
                    if (j == 3 && q == 3) *(LAS float*)((bufp) + OE + kch * 4) = fexp(bb); } \
                const unsigned q01 = cvt_pk_bf16(qh[0], qh[1]), q23 = cvt_pk_bf16(qh[2], qh[3]), k01 = cvt_pk_bf16(kh[0], kh[1]), k23 = cvt_pk_bf16(kh[2], kh[3]); \
                *(LAS bf16_t*)((bufp) + OQ + (4 * q + 0) * 272 + kch * 2) = (bf16_t)(q01 & 0xffffu); *(LAS bf16_t*)((bufp) + OQ + (4 * q + 1) * 272 + kch * 2) = (bf16_t)(q01 >> 16); \
                *(LAS bf16_t*)((bufp) + OQ + (4 * q + 2) * 272 + kch * 2) = (bf16_t)(q23 & 0xffffu); *(LAS bf16_t*)((bufp) + OQ + (4 * q + 3) * 272 + kch * 2) = (bf16_t)(q23 >> 16); \
                *(LAS bf16_t*)((bufp) + OKH + (4 * q + 0) * 272 + kch * 2) = (bf16_t)(k01 & 0xffffu); *(LAS bf16_t*)((bufp) + OKH + (4 * q + 1) * 272 + kch * 2) = (bf16_t)(k01 >> 16); \
                *(LAS bf16_t*)((bufp) + OKH + (4 * q + 2) * 272 + kch * 2) = (bf16_t)(k23 & 0xffffu); *(LAS bf16_t*)((bufp) + OKH + (4 * q + 3) * 272 + kch * 2) = (bf16_t)(k23 >> 16); \
                u32x2 kt2; kt2.x = k01; kt2.y = k23; *(LAS u32x2*)((bufp) + OKT + kch * 48 + q * 8) = kt2; \
                u32x2 it2; it2.x = (unsigned)ri[0] | ((unsigned)ri[1] << 16); it2.y = (unsigned)ri[2] | ((unsigned)ri[3] << 16); *(LAS u32x2*)((bufp) + OIT + kch * 48 + q * 8) = it2; } while (0)
#define HG_COMPUTE(c) do { \
                LAS unsigned char* buf = lds + ((c) & 1) * BUFSZ; \
                f32x4 at = (f32x4){0.f, 0.f, 0.f, 0.f}; \
                _Pragma("unroll") \
                for (int kb = 0; kb < 4; ++kb) { const bf16x8 a = *(const LAS bf16x8*)(buf + OKH + m * 272 + kb * 64 + q * 16), bq = *(const LAS bf16x8*)(buf + OQ + m * 272 + kb * 64 + q * 16); \
                    at = __builtin_amdgcn_mfma_f32_16x16x32_bf16(a, bq, at, 0, 0, 0); } \
                asm volatile("s_nop 15\n s_nop 15" : "+v"(at)); \
                _Pragma("unroll") \
                for (int r = 0; r < 4; ++r) at[r] = (4 * q + r <= m) ? at[r] : 0.f; \
                const bf16x8 attB = mk_bf16x8(cvt_pk_bf16(at[0], at[1]), cvt_pk_bf16(at[2], at[3]), 0u, 0u); \
                f32x4 oacc = (f32x4){0.f, 0.f, 0.f, 0.f}; \
                _Pragma("unroll") \
                for (int kb = 0; kb < 4; ++kb) { \
                    const bf16x8 a = mk_bf16x8(cvt_pk_bf16(Sacc[2 * kb][0], Sacc[2 * kb][1]), cvt_pk_bf16(Sacc[2 * kb][2], Sacc[2 * kb][3]), cvt_pk_bf16(Sacc[2 * kb + 1][0], Sacc[2 * kb + 1][1]), cvt_pk_bf16(Sacc[2 * kb + 1][2], Sacc[2 * kb + 1][3])); \
                    const u32x2 b0 = *(const LAS u32x2*)(buf + OQ + m * 272 + (32 * kb + 4 * q) * 2), b1 = *(const LAS u32x2*)(buf + OQ + m * 272 + (32 * kb + 16 + 4 * q) * 2); \
                    oacc = __builtin_amdgcn_mfma_f32_16x16x32_bf16(a, mk_bf16x8(b0.x, b0.y, b1.x, b1.y), oacc, 0, 0, 0); } \
                { const u32x2 i0 = *(const LAS u32x2*)(buf + OIT + (16 * w + m) * 48 + q * 8); \
                  oacc = __builtin_amdgcn_mfma_f32_16x16x32_bf16(mk_bf16x8(i0.x, i0.y, 0u, 0u), attB, oacc, 0, 0, 0); } \
                asm volatile("s_nop 15\n s_nop 15" : "+v"(oacc)); \
                { const int st = (c) * 16 + m, n = dir ? (len - 1 - st) : st; \
                  u32x2 o2; o2.x = cvt_pk_bf16(oacc[0], oacc[1]); o2.y = cvt_pk_bf16(oacc[2], oacc[3]); \
                  if (!dry || p.ws == nullptr) *(u32x2*)(BF + (size_t)(rbase + n) * 1024 + h * 128 + 16 * w + 4 * q) = o2; } \
                u32x4 bsu = (u32x4){0u, 0u, 0u, 0u}; \
                if (q < 2) bsu = *(const LAS u32x4*)(buf + OIT + (16 * w + m) * 48 + q * 16); \
                const bf16x8 bs = __builtin_bit_cast(bf16x8, bsu); \
                _Pragma("unroll") \
                for (int kt = 0; kt < 8; ++kt) { u32x4 au = (u32x4){0u, 0u, 0u, 0u}; \
                    if (q < 2) au = *(const LAS u32x4*)(buf + OKT + (16 * kt + m) * 48 + q * 16); \
                    Sacc[kt] = __builtin_amdgcn_mfma_f32_16x16x32_bf16(__builtin_bit_cast(bf16x8, au), bs, Sacc[kt], 0, 0, 0); } \
                asm volatile("s_nop 15\n s_nop 15" : "+v"(Sacc[0]), "+v"(Sacc[1]), "+v"(Sacc[2]), "+v"(Sacc[3]), "+v"(Sacc[4]), "+v"(Sacc[5]), "+v"(Sacc[6]), "+v"(Sacc[7])); \
                _Pragma("unroll") \
                for (int kt = 0; kt < 8; ++kt) Sacc[kt] *= *(const LAS f32x4*)(buf + OE + (16 * kt + 4 * q) * 4); \
                } while (0)
            HG_GLOAD(0); HG_RAWW(0);
            if (nch > 1) { HG_GLOAD(1); HG_RAWW(1); }
            if (nch > 2) HG_GLOAD(2);
            __syncthreads();
            HG_STAGE(0, lds);
            __syncthreads();
            for (int c = 0; c < nch; ++c) {
                if (c + 2 < nch) { HG_RAWW(c + 2); if (c + 3 < nch) HG_GLOAD(c + 3); }
                if (c + 1 < nch) HG_STAGE(c + 1, lds + ((c + 1) & 1) * BUFSZ);
                HG_COMPUTE(c);
                __syncthreads();
            }
#undef HG_COMPUTE
#undef HG_GLOAD
#undef HG_RAWW
#undef HG_STAGE
        }
        __syncthreads();
    }
}
__device__ __forceinline__ void phase_hcomb(const Params& p, int l, int M, bool dry = false) {
    const int tid_ = otid();
    const int lane = tid_ & 63, gw = blockIdx.x * 8 + __builtin_amdgcn_readfirstlane(tid_ >> 6), nw = gridDim.x * 8;
    unsigned char* P = p.ws + OFF_P;
    bf16_t* OF = (bf16_t*)(P + P_BFF); const bf16_t* OB = (const bf16_t*)(P + P_BFB); const bf16_t* BG = (const bf16_t*)(P + P_BG);
    const float* hg = p.hn_g + (size_t)l * 1024 + lane * 16;
    for (int r = gw; r < M; r += nw) {
        const size_t o = (size_t)r * 1024 + lane * 16;
        float x[16]; float ss = 0.f;
#pragma unroll
        for (int hh = 0; hh < 2; ++hh) { const u32x4 a = *(const u32x4*)(OF + o + hh * 8), bq = *(const u32x4*)(OB + o + hh * 8);
            const unsigned aa[4] = {a.x, a.y, a.z, a.w}, bb[4] = {bq.x, bq.y, bq.z, bq.w};
#pragma unroll
            for (int j = 0; j < 4; ++j) { x[hh * 8 + 2 * j] = bf_lo(aa[j]) + bf_lo(bb[j]); x[hh * 8 + 2 * j + 1] = bf_hi(aa[j]) + bf_hi(bb[j]); } }
#pragma unroll
        for (int j = 0; j < 16; ++j) ss += x[j] * x[j];
        ss += __shfl_xor(ss, 1); ss += __shfl_xor(ss, 2); ss += __shfl_xor(ss, 4);
        const float rs = rsqrtf(ss * (1.0f / 128.0f) + 1e-6f);
#pragma unroll
        for (int hh = 0; hh < 2; ++hh) { const u32x4 gq = *(const u32x4*)(BG + o + hh * 8); const unsigned gg[4] = {gq.x, gq.y, gq.z, gq.w};
            float y[8];
#pragma unroll
            for (int j = 0; j < 4; ++j) { y[2 * j] = x[hh * 8 + 2 * j] * rs * hg[hh * 8 + 2 * j] * bf_lo(gg[j]); y[2 * j + 1] = x[hh * 8 + 2 * j + 1] * rs * hg[hh * 8 + 2 * j + 1] * bf_hi(gg[j]); }
            u32x4 w; w.x = cvt_pk_bf16(y[0], y[1]); w.y = cvt_pk_bf16(y[2], y[3]); w.z = cvt_pk_bf16(y[4], y[5]); w.w = cvt_pk_bf16(y[6], y[7]);
            if (!dry || p.ws == nullptr) *(u32x4*)(OF + o + hh * 8) = w; }
    }
}

__device__ __forceinline__ bf16x8 pack_bf16x8(const float (&v)[8]) {
    const unsigned a = cvt_pk_bf16(v[0], v[1]), b = cvt_pk_bf16(v[2], v[3]), c = cvt_pk_bf16(v[4], v[5]), d = cvt_pk_bf16(v[6], v[7]);
    u32x4 q; q.x = a; q.y = b; q.z = c; q.w = d;
    return __builtin_bit_cast(bf16x8, q);
}
__device__ __forceinline__ void phase_s5(const Params& p, int l, LAS unsigned char* lds) {
    const int tid_ = otid();
    const int lane = tid_ & 63, w = __builtin_amdgcn_readfirstlane(tid_ >> 6);
    if (w >= 6) return;
    LAS float* BU = (LAS float*)(lds + w * 12800);
    LAS unsigned char* XB = lds + w * 12800 + 8448;
    const int lq = lane >> 4, lr = lane & 15;
    const bf16_t* CU = (const bf16_t*)(p.ws + OFF_P + P_CU);
    const float* s5lam = (const float*)(p.ws + OFF_S5LAM); const float* s5bb = (const float*)(p.ws + OFF_S5BB);
    for (int s = w * (int)gridDim.x + (int)blockIdx.x; s < 1536; s += 6 * (int)gridDim.x) {
        const int dir = s & 1, g = (s >> 1) % 48, b = s / 96;
        const int ldg = (l * 2 + dir) * 48 + g;
        const float lre = s5lam[(size_t)(ldg * 64 + lane) * 2], lim = s5lam[(size_t)(ldg * 64 + lane) * 2 + 1];
        bf16x8 bbf[8], cf[4];
#pragma unroll
        for (int nt = 0; nt < 8; ++nt) { const int col = nt * 16 + lr, pp = col >> 1, c = col & 1; float v[8];
#pragma unroll
            for (int j = 0; j < 8; ++j) v[j] = (lq < 2) ? s5bb[(size_t)(ldg * 64 + pp) * 32 + c * 16 + lq * 8 + j] : 0.f;
            bbf[nt] = pack_bf16x8(v); }
#pragma unroll
        for (int kb = 0; kb < 4; ++kb) { float v[8];
#pragma unroll
            for (int j = 0; j < 8; ++j) { const int k = kb * 32 + lq * 8 + j, pp = k >> 1; const size_t ci = ((size_t)ldg * 16 + lr) * 64 + pp;
                v[j] = (k & 1) ? -p.c_im[ci] : p.c_re[ci]; }
            cf[kb] = pack_bf16x8(v); }
        bf16_t* YS = (bf16_t*)(p.ws + OFF_H + (dir ? H_YSB : H_YSF));
        float xr = 0.f, xi = 0.f;
        for (int seg = 0; seg < 2; ++seg) {
            const int len = seg == 0 ? CTXL : SEQ, rbase = seg == 0 ? TL + b * CTXL : b * SEQ, nblk = len / 64;
            u32x4 unext[4];
#pragma unroll
            for (int tt = 0; tt < 4; ++tt) { unext[tt] = (u32x4){0u, 0u, 0u, 0u};
                if (lq < 2) { const int st = tt * 16 + lr, n = dir ? (len - 1 - st) : st; unext[tt] = *(const u32x4*)(CU + (size_t)(rbase + n) * 768 + g * 16 + lq * 8); } }
            for (int blk = 0; blk < nblk; ++blk) {
                u32x4 ucur[4];
#pragma unroll
                for (int tt = 0; tt < 4; ++tt) ucur[tt] = unext[tt];
                if (blk + 1 < nblk && lq < 2) {
#pragma unroll
                    for (int tt = 0; tt < 4; ++tt) { const int st = (blk + 1) * 64 + tt * 16 + lr, n = dir ? (len - 1 - st) : st; unext[tt] = *(const u32x4*)(CU + (size_t)(rbase + n) * 768 + g * 16 + lq * 8); } }
#pragma unroll
                for (int tt = 0; tt < 4; ++tt) {
                    const bf16x8 uf = __builtin_bit_cast(bf16x8, ucur[tt]);
                    f32x4 dd[8];
#pragma unroll
                    for (int nt = 0; nt < 8; ++nt) dd[nt] = __builtin_amdgcn_mfma_f32_16x16x32_bf16(bbf[nt], uf, (f32x4){0.f, 0.f, 0.f, 0.f}, 0, 0, 0);
                    asm volatile("s_nop 15\n s_nop 15" : "+v"(dd[0]), "+v"(dd[1]), "+v"(dd[2]), "+v"(dd[3]), "+v"(dd[4]), "+v"(dd[5]), "+v"(dd[6]), "+v"(dd[7]));
#pragma unroll
                    for (int nt = 0; nt < 8; ++nt) *(LAS f32x4*)(BU + lr * 132 + nt * 16 + lq * 4) = dd[nt];
                    asm volatile("s_waitcnt lgkmcnt(0)" ::: "memory");
                    f32x2 bu[16];
#pragma unroll
                    for (int t = 0; t < 16; ++t) bu[t] = *(const LAS f32x2*)(BU + t * 132 + 2 * lane);
#pragma unroll
                    for (int t = 0; t < 16; ++t) { const float nr = lre * xr - lim * xi + bu[t].x, ni = lre * xi + lim * xr + bu[t].y; xr = nr; xi = ni;
                        *(LAS unsigned*)(XB + t * 272 + lane * 4) = cvt_pk_bf16(xr, xi); }
                    asm volatile("s_waitcnt lgkmcnt(0)" ::: "memory");
                    f32x4 acc = (f32x4){0.f, 0.f, 0.f, 0.f};
#pragma unroll
                    for (int kb = 0; kb < 4; ++kb) { const bf16x8 xf = *(const LAS bf16x8*)(XB + lr * 272 + kb * 64 + lq * 16); acc = __builtin_amdgcn_mfma_f32_16x16x32_bf16(cf[kb], xf, acc, 0, 0, 0); }
                    asm volatile("s_nop 15\n s_nop 15\n s_waitcnt lgkmcnt(0)" : "+v"(acc) :: "memory");
                    const int st = blk * 64 + tt * 16 + lr, n = dir ? (len - 1 - st) : st;
                    u32x2 o; o.x = cvt_pk_bf16(acc[0], acc[1]); o.y = cvt_pk_bf16(acc[2], acc[3]);
                    *(u32x2*)(YS + (size_t)(rbase + n) * 768 + g * 16 + lq * 4) = o;
                }
            }
        }
    }
}
__device__ __forceinline__ void phase_s5post(const Params& p, int l, int M, bool dry = false) {
    const int tid_ = otid();
    const size_t n8 = (size_t)M * 768 / 8;
    bf16_t* YF = (bf16_t*)(p.ws + OFF_H + H_YSF); const bf16_t* YB = (const bf16_t*)(p.ws + OFF_H + H_YSB); const bf16_t* CU = (const bf16_t*)(p.ws + OFF_P + P_CU);
    const float* dsk = p.s5_d + (size_t)l * 768;
    for (size_t i = (size_t)blockIdx.x * NTHREADS + tid_; i < n8; i += (size_t)gridDim.x * NTHREADS) {
        const int c = (int)((i * 8) % 768);
        const u32x4 a = *(const u32x4*)(YF + i * 8), bq = *(const u32x4*)(YB + i * 8), uq = *(const u32x4*)(CU + i * 8);
        const unsigned aa[4] = {a.x, a.y, a.z, a.w}, bb[4] = {bq.x, bq.y, bq.z, bq.w}, uu[4] = {uq.x, uq.y, uq.z, uq.w};
        float y[8];
#pragma unroll
        for (int j = 0; j < 4; ++j) { y[2 * j] = gelu_f(bf_lo(aa[j]) + bf_lo(bb[j]) + dsk[c + 2 * j] * bf_lo(uu[j])); y[2 * j + 1] = gelu_f(bf_hi(aa[j]) + bf_hi(bb[j]) + dsk[c + 2 * j + 1] * bf_hi(uu[j])); }
        u32x4 w; w.x = cvt_pk_bf16(y[0], y[1]); w.y = cvt_pk_bf16(y[2], y[3]); w.z = cvt_pk_bf16(y[4], y[5]); w.w = cvt_pk_bf16(y[6], y[7]);
        if (!dry || p.ws == nullptr) *(u32x4*)(YF + i * 8) = w;
    }
}

__device__ __forceinline__ void phase_gmlp(const Params& p, int l, int M, LAS unsigned char* lds, bool dry = false) {
    const int tid_ = otid();
    LAS unsigned char* Wb = lds;
    LAS unsigned char* Vt = lds + 34816;
    LAS float* st = (LAS float*)(lds + 69632);
    const int tid = tid_, lane = tid & 63, w = __builtin_amdgcn_readfirstlane(tid_ >> 6), q = lane >> 4, m = lane & 15;
    bf16_t* AU = (bf16_t*)(p.ws + OFF_P + P_AU); const bf16_t* AV = (const bf16_t*)(p.ws + OFF_P + P_AV);
    const float* lng = p.ln_g + (size_t)l * 1024; const float* lnb = p.ln_b + (size_t)l * 1024;
    const int nch = M / 128, G_ = (int)gridDim.x, nfull = (nch / G_) * G_, nitem = nfull + (nch - nfull) * 8;
    for (int it = blockIdx.x; it < nitem; it += G_) {
        const int u = it < nfull ? it : nfull + ((it - nfull) >> 3), g0 = it < nfull ? 0 : ((it - nfull) & 7), g1 = it < nfull ? 8 : g0 + 1;
        const size_t r0 = (size_t)u * 128;
        for (int i = 0; i < 16; ++i) {
            const int s = w * 16 + i; const bf16_t* rp = AV + (r0 + s) * 1024 + lane * 16;
            const u32x4 a = *(const u32x4*)rp, bq = *(const u32x4*)(rp + 8);
            const unsigned aa[8] = {a.x, a.y, a.z, a.w, bq.x, bq.y, bq.z, bq.w};
            float sm = 0.f, sq = 0.f;
#pragma unroll
            for (int j = 0; j < 8; ++j) { const float x0 = bf_lo(aa[j]), x1 = bf_hi(aa[j]); sm += x0 + x1; sq += x0 * x0 + x1 * x1; }
            sm = wave_sum(sm); sq = wave_sum(sq);
            const float mean = sm * (1.0f / 1024.0f), var = fmaxf(sq * (1.0f / 1024.0f) - mean * mean, 0.f);
            if (lane == 0) { st[s * 2] = mean; st[s * 2 + 1] = rsqrtf(var + 1e-6f); }
        }
        __syncthreads();
        for (int g = g0; g < g1; ++g) {
            { const int t = tid >> 2, s0 = (tid & 3) * 32; const float* ws = p.w_s + ((size_t)l * 8 + g) * 16384 + t * 128 + s0;
#pragma unroll
              for (int qq = 0; qq < 4; ++qq) { const f32x4 a = *(const f32x4*)(ws + qq * 8), b4 = *(const f32x4*)(ws + qq * 8 + 4);
                  u32x4 o; o.x = cvt_pk_bf16(a[0], a[1]); o.y = cvt_pk_bf16(a[2], a[3]); o.z = cvt_pk_bf16(b4[0], b4[1]); o.w = cvt_pk_bf16(b4[2], b4[3]);
                  *(LAS u32x4*)(Wb + t * 272 + (s0 + qq * 8) * 2) = o; } }
            { const int s = tid >> 2, c0 = (tid & 3) * 32; const bf16_t* rp = AV + (r0 + s) * 1024 + g * 128 + c0;
              const float mean = st[s * 2], rstd = st[s * 2 + 1];
#pragma unroll
              for (int qq = 0; qq < 4; ++qq) { const u32x4 a = *(const u32x4*)(rp + qq * 8); const unsigned aa[4] = {a.x, a.y, a.z, a.w};
#pragma unroll
                  for (int j = 0; j < 4; ++j) { const int cl = c0 + qq * 8 + 2 * j, c = g * 128 + cl;
                      const unsigned pk = cvt_pk_bf16((bf_lo(aa[j]) - mean) * rstd * lng[c] + lnb[c], (bf_hi(aa[j]) - mean) * rstd * lng[c + 1] + lnb[c + 1]);
                      *(LAS bf16_t*)(Vt + cl * 272 + s * 2) = (bf16_t)(pk & 0xffffu); *(LAS bf16_t*)(Vt + (cl + 1) * 272 + s * 2) = (bf16_t)(pk >> 16); } } }
            __syncthreads();
            bf16x8 af[4];
#pragma unroll
            for (int kb = 0; kb < 4; ++kb) af[kb] = *(const LAS bf16x8*)(Vt + (16 * w + m) * 272 + kb * 64 + q * 16);
            const float* bs = p.b_s + ((size_t)l * 8 + g) * 128;
#pragma unroll
            for (int tt = 0; tt < 8; ++tt) {
                f32x4 acc = (f32x4){0.f, 0.f, 0.f, 0.f};
#pragma unroll
                for (int kb = 0; kb < 4; ++kb) acc = __builtin_amdgcn_mfma_f32_16x16x32_bf16(af[kb], *(const LAS bf16x8*)(Wb + (16 * tt + m) * 272 + kb * 64 + q * 16), acc, 0, 0, 0);
                const float bb = bs[16 * tt + m];
                bf16_t* up = AU + (r0 + 16 * tt + m) * 1024 + g * 128 + 16 * w + 4 * q;
                const u32x2 uw = *(const u32x2*)up;
                const float y0 = (acc[0] + bb) * bf_lo(uw.x), y1 = (acc[1] + bb) * bf_hi(uw.x), y2 = (acc[2] + bb) * bf_lo(uw.y), y3 = (acc[3] + bb) * bf_hi(uw.y);
                u32x2 o; o.x = cvt_pk_bf16(y0, y1); o.y = cvt_pk_bf16(y2, y3);
                if (!dry || p.ws == nullptr) *(u32x2*)up = o;
            }
            __syncthreads();
        }
    }
}

__device__ __forceinline__ unsigned fkey(float x) { const unsigned b = __float_as_uint(x); return b ^ ((b >> 31) ? 0xFFFFFFFFu : 0x80000000u); }
__device__ __forceinline__ int mbcnt64(unsigned long long m) { return __builtin_amdgcn_mbcnt_hi((unsigned)(m >> 32), __builtin_amdgcn_mbcnt_lo((unsigned)m, 0u)); }
template <int NV>
__device__ __forceinline__ int count_ge(const unsigned (&k)[NV], unsigned cand) {
    int cnt = 0;
#pragma unroll
    for (int i = 0; i < NV; ++i) cnt += __popcll(__ballot(k[i] >= cand));
    return cnt;
}
template <int NV>
__device__ __forceinline__ unsigned radix_thr16(const unsigned (&k)[NV], unsigned e0bits) {
    unsigned prefix = 0u; int bit = 31;
    {
        const unsigned c0 = e0bits ^ 0x80000000u, c1 = c0 + 0x00800000u, c2 = c0 + 0x01000000u, c3 = c0 + 0x01800000u;
        const int n0 = count_ge<NV>(k, c0), n1 = count_ge<NV>(k, c1), n2 = count_ge<NV>(k, c2), n3 = count_ge<NV>(k, c3);
        if (n0 >= 16 && n3 < 16) { prefix = (n2 >= 16) ? c2 : ((n1 >= 16) ? c1 : c0); bit = 22;
            const int nn = (n2 >= 16) ? n2 : ((n1 >= 16) ? n1 : n0); if (nn == 16) bit = -1; }
    }
    for (; bit >= 0; --bit) {
        const unsigned cand = prefix | (1u << bit);
        const int cnt = count_ge<NV>(k, cand);
        if (cnt >= 16) prefix = cand;
        if (cnt == 16) break;
    }
    return prefix;
}
__device__ __forceinline__ unsigned umin_(unsigned a, unsigned b) { return a < b ? a : b; }
__device__ __forceinline__ unsigned umax_(unsigned a, unsigned b) { return a > b ? a : b; }
__device__ __forceinline__ unsigned med3u(unsigned x, unsigned y, unsigned z) { return umax_(umin_(x, y), umin_(umax_(x, y), z)); }
__device__ __forceinline__ float unkey(unsigned k) { return __uint_as_float((k & 0x80000000u) ? (k ^ 0x80000000u) : ~k); }
__device__ __forceinline__ void ins16(unsigned (&a)[16], unsigned x) {
#pragma unroll
    for (int s = 15; s >= 1; --s) a[s] = med3u(a[s - 1], x, a[s]);
    a[0] = umax_(a[0], x);
}
__device__ __forceinline__ unsigned sel16(const unsigned (&a)[16], int i) {
    unsigned r = a[0];
#pragma unroll
    for (int t = 1; t < 16; ++t) r = (i == t) ? a[t] : r;
    return r;
}
__device__ __forceinline__ void phase_topk(const Params& p, int M, LAS unsigned char* lds) {
    const int tid_ = otid();
    LAS unsigned* lk = (LAS unsigned*)lds + tid_;
    const int gl = blockIdx.x * NTHREADS + tid_, nl = gridDim.x * NTHREADS;
    const float* SC = (const float*)(p.ws + OFF_P + Q_SC);
    int* IDX = (int*)(p.ws + OFF_P + Q_IDX); float* GATE = (float*)(p.ws + OFF_P + Q_GATE);
    const int ntask = M * 8;
    for (int task = gl; task < ntask; task += nl) {
        const float* sc = SC + (size_t)task * 256;
        unsigned a[16], b[16];
#pragma unroll
        for (int i = 0; i < 16; ++i) { a[i] = 0u; b[i] = 0u; }
#pragma unroll 4
        for (int i4 = 0; i4 < 32; ++i4) {
            const f32x4 va = *(const f32x4*)(sc + i4 * 4), vb = *(const f32x4*)(sc + 128 + i4 * 4);
#pragma unroll
            for (int e = 0; e < 4; ++e) { const unsigned tag = 127u - (unsigned)(i4 * 4 + e);
                ins16(a, (fkey(va[e]) & ~127u) | tag); ins16(b, (fkey(vb[e]) & ~127u) | tag); }
        }
        float fa[16], fb[16];
#pragma unroll
        for (int i = 0; i < 16; ++i) { fa[i] = unkey(a[i] & ~127u); fb[i] = unkey(b[i] & ~127u); }
        unsigned c[16];
#pragma unroll
        for (int i = 0; i < 16; ++i) c[i] = 0u;
#pragma unroll
        for (int i = 0; i < 16; ++i)
#pragma unroll
            for (int j = 0; j < 16; ++j)
                if ((i + 1) * (j + 1) <= 16) ins16(c, (fkey(fa[i] + fb[j]) & ~255u) | (unsigned)(i * 16 + j));
#pragma unroll
        for (int i = 0; i < 16; ++i) { lk[i * 512] = a[i]; lk[(16 + i) * 512] = b[i]; }
        const float mx = unkey(c[0] & ~255u);
        float ev[16]; float sm = 0.f; int id[16];
#pragma unroll
        for (int s = 0; s < 16; ++s) { ev[s] = __expf(unkey(c[s] & ~255u) - mx); sm += ev[s];
            const int ij = (int)(c[s] & 255u);
            const unsigned ka = lk[(ij >> 4) * 512], kb = lk[(16 + (ij & 15)) * 512];
            id[s] = (int)(127u - (ka & 127u)) * 128 + (int)(127u - (kb & 127u)); }
        const float inv = 1.0f / sm;
#pragma unroll
        for (int q = 0; q < 4; ++q) {
            u32x4 iw; iw.x = (unsigned)id[4 * q]; iw.y = (unsigned)id[4 * q + 1]; iw.z = (unsigned)id[4 * q + 2]; iw.w = (unsigned)id[4 * q + 3];
            *(u32x4*)(IDX + (size_t)task * 16 + q * 4) = iw;
            *(f32x4*)(GATE + (size_t)task * 16 + q * 4) = (f32x4){ev[4 * q] * inv, ev[4 * q + 1] * inv, ev[4 * q + 2] * inv, ev[4 * q + 3] * inv};
        }
    }
}

__device__ __forceinline__ float dot2u(unsigned a, unsigned b, float acc) {
    return __builtin_amdgcn_fdot2_f32_bf16(__builtin_bit_cast(bf16x2_t, a), __builtin_bit_cast(bf16x2_t, b), acc, false);
}
__device__ __forceinline__ float dot8(const u32x4 a, const u32x4 b, float acc) {
    acc = dot2u(a.x, b.x, acc); acc = dot2u(a.y, b.y, acc); acc = dot2u(a.z, b.z, acc); acc = dot2u(a.w, b.w, acc);
    return acc;
}
__device__ __forceinline__ void phase_peer(const Params& p, int l, int M, LAS unsigned char* lds, bool dry = false) {
    const int tid_ = otid();
    const int lane = tid_ & 63, wv_ = __builtin_amdgcn_readfirstlane(tid_ >> 6), gw = blockIdx.x * 8 + wv_, nw = gridDim.x * 8;
    LAS float* wl = (LAS float*)(lds + wv_ * 512);
    const bf16_t* H = (const bf16_t*)(p.ws + OFF_H);
    const unsigned char* U6 = p.ws + OFF_P + Q_UT; const unsigned char* V6 = p.ws + OFF_P + Q_VT;
    const float* USC = (const float*)(p.ws + OFF_P + Q_USC); const float* VSC = (const float*)(p.ws + OFF_P + Q_VSC);
    const int* IDX = (const int*)(p.ws + OFF_P + Q_IDX); const float* GATE = (const float*)(p.ws + OFF_P + Q_GATE);
    const float* modl = (const float*)(p.ws + OFF_MODV) + (size_t)l * 17 * NMOD + 10240;
    float* XC = (float*)(p.ws + OFF_XC);
    const unsigned lane24 = (unsigned)lane * 24u;
#define PEER_LOAD(buf, TAB, g) do { const int _is = ((g) < 8) ? id0 : id1; _Pragma("unroll") for (int e = 0; e < 8; ++e) { \
        const int _id = __builtin_amdgcn_readlane(_is, (((g) * 8 + e) & 63)); const unsigned char* _rb = (TAB) + (size_t)(unsigned)_id * 1536u; \
        const u32x4 _a = *(const u32x4*)(_rb + lane24); const u32x2 _b = *(const u32x2*)(_rb + lane24 + 16); \
        buf[e][0] = _a.x; buf[e][1] = _a.y; buf[e][2] = _a.z; buf[e][3] = _a.w; buf[e][4] = _b.x; buf[e][5] = _b.y; } } while (0)
    for (int row = gw; row < M; row += nw) {
        unsigned xw[16];
#pragma unroll
        for (int j = 0; j < 8; ++j) { const u32x2 a = *(const u32x2*)(H + (size_t)row * D + j * 256 + lane * 4); xw[2 * j] = a.x; xw[2 * j + 1] = a.y; }
        const int id0 = IDX[(size_t)row * 128 + lane], id1 = IDX[(size_t)row * 128 + 64 + lane];
        const float g0 = GATE[(size_t)row * 128 + lane], g1 = GATE[(size_t)row * 128 + 64 + lane];
        const float us0 = USC[id0], us1 = USC[id1];
        const float gv0 = g0 * VSC[id0], gv1 = g1 * VSC[id1];
        u32x6 bA[8];
#pragma unroll 1
        for (int g = 0; g < 16; ++g) {
            PEER_LOAD(bA, U6, g);
            float part[8];
            float chain = 0.f;
#pragma unroll
            for (int e = 0; e < 8; ++e) { asm volatile("" : "+v"(bA[e]), "+v"(chain));
                const bf16x32_t ub = __builtin_amdgcn_cvt_scalef32_pk32_bf16_fp6(bA[e], 1.0f);
                const u32x16 uw = __builtin_bit_cast(u32x16, ub);
                float a0 = 0.f, a1 = 0.f;
#pragma unroll
                for (int i = 0; i < 8; ++i) { const unsigned w0 = uw[2 * i], w1 = uw[2 * i + 1]; a0 = dot2u(w0, xw[2 * i], a0); a1 = dot2u(w1, xw[2 * i + 1], a1); }
                part[e] = a0 + a1; chain = part[e]; }
            float r4[4];
#pragma unroll
            for (int i = 0; i < 4; ++i) { const bool hi = (lane & 32) != 0; const float keep = hi ? part[i + 4] : part[i], send = hi ? part[i] : part[i + 4]; r4[i] = keep + __shfl_xor(send, 32); }
            float r2[2];
#pragma unroll
            for (int i = 0; i < 2; ++i) { const bool hi = (lane & 16) != 0; const float keep = hi ? r4[i + 2] : r4[i], send = hi ? r4[i] : r4[i + 2]; r2[i] = keep + __shfl_xor(send, 16); }
            float r1;
            { const bool hi = (lane & 8) != 0; const float keep = hi ? r2[1] : r2[0], send = hi ? r2[0] : r2[1]; r1 = keep + __shfl_xor(send, 8); }
            r1 += __shfl_xor(r1, 4); r1 += __shfl_xor(r1, 2); r1 += __shfl_xor(r1, 1);
            const int k = g * 8 + ((lane >> 3) & 7);
            const float usk = __shfl((g < 8) ? us0 : us1, k & 63), gvk = __shfl((g < 8) ? gv0 : gv1, k & 63);
            if ((lane & 7) == 0) wl[k] = gelu_f(r1 * usk) * gvk;
        }
        asm volatile("s_waitcnt lgkmcnt(0)" ::: "memory");
        float out[32];
#pragma unroll
        for (int i = 0; i < 32; ++i) out[i] = 0.f;
#pragma unroll 1
        for (int g = 0; g < 16; ++g) {
            PEER_LOAD(bA, V6, g);
#pragma unroll
            for (int e = 0; e < 8; ++e) { const float wk = wl[g * 8 + e]; asm volatile("" : "+v"(bA[e]), "+v"(out[0]), "+v"(out[9]), "+v"(out[18]), "+v"(out[27]), "+v"(out[31]));
                const f32x32 un = __builtin_amdgcn_cvt_scalef32_pk32_f32_fp6(bA[e], 1.0f);
#pragma unroll
                for (int i = 0; i < 32; ++i) out[i] += wk * un[i]; }
        }
        asm volatile("s_waitcnt lgkmcnt(0)" ::: "memory");
        const bool lat = row < TL; const int mb = lat ? (row >> 11) : 16;
        float* xp = lat ? p.out + (size_t)row * D : XC + (size_t)(row - TL) * D;
        const float* gv = modl + (size_t)mb * NMOD;
        f32x4 xn[8]; float ss = 0.f;
#pragma unroll
        for (int j = 0; j < 8; ++j) { const int e = j * 256 + lane * 4;
            const f32x4 o4 = (f32x4){out[4 * j], out[4 * j + 1], out[4 * j + 2], out[4 * j + 3]};
            xn[j] = *(const f32x4*)(xp + e) + *(const f32x4*)(gv + e) * o4;
            ss += xn[j][0] * xn[j][0] + xn[j][1] * xn[j][1] + xn[j][2] * xn[j][2] + xn[j][3] * xn[j][3]; }
        ss = wave_sum(ss);
        const float rs = rsqrtf(ss * (1.0f / 2048.0f) + 1e-6f);
        if (!dry || p.ws == nullptr) {
            if (l == 0) {
                const float* m1 = (const float*)(p.ws + OFF_MODV) + (size_t)17 * NMOD + (size_t)mb * NMOD;
                float am = 0.f;
#pragma unroll
                for (int j = 0; j < 8; ++j) { const int e = j * 256 + lane * 4;
                    *(f32x4*)(xp + e) = xn[j];
                    xn[j] = xn[j] * rs * (*(const f32x4*)(m1 + 2048 + e) + 1.0f) + *(const f32x4*)(m1 + e);
                    am = fmaxf(am, fmaxf(fmaxf(fabsf(xn[j][0]), fabsf(xn[j][1])), fmaxf(fabsf(xn[j][2]), fabsf(xn[j][3])))); }
#pragma unroll
                for (int o = 32; o >= 1; o >>= 1) am = fmaxf(am, __shfl_xor(am, o));
                const float qs = am > 0.f ? 240.0f / am : 1.0f;
                unsigned char* H8 = p.ws + OFF_H8 + (size_t)row * D;
#pragma unroll
                for (int j = 0; j < 8; ++j) *(unsigned*)(H8 + j * 256 + lane * 4) = pack_fp8x4(xn[j][0] * qs, xn[j][1] * qs, xn[j][2] * qs, xn[j][3] * qs);
                if (lane == 0) ((float*)(p.ws + OFF_HS))[row] = am > 0.f ? am * (1.0f / 240.0f) : 1.0f;
            } else {
#pragma unroll
                for (int j = 0; j < 8; ++j) { const int e = j * 256 + lane * 4; *(f32x4*)(xp + e) = xn[j] * rs * *(const f32x4*)(p.final_g + e); }
            }
        }
    }
#undef PEER_LOAD
}

__device__ __forceinline__ Params load_params() {
    Params r;
#if defined(__HIP_DEVICE_COMPILE__)
    typedef const unsigned long long __attribute__((address_space(4)))* KP;
    KP k = (KP)__builtin_amdgcn_kernarg_segment_ptr();
    asm volatile("" : "+s"(k));
    void** d = (void**)&r;
#pragma unroll
    for (int i = 0; i < (int)(sizeof(Params) / 8); ++i) d[i] = (void*)(__attribute__((address_space(1))) void*)k[i];
#endif
    return r;
}
#define WSP(off) (p.ws + (off))
template <int l>
__device__ __forceinline__ void mega_layer(LAS unsigned char* lds, const XcdBarrier& bar) {
        const int Mrows = (l == 0) ? TT : TL;
        const int GLU_ROT = (((Mrows / 256) * 6) % (int)gridDim.x) & ~7;
        if (l == 0) {
            { const Params p = load_params(); phase_wconv(p, 0, lds); }
            { const Params p = load_params(); phase_norm<0, true>(p, 0, TT, 0, 2048); }
            xcd_barrier(bar);
        }
        { const Params p = load_params(); EpiInProj E{WSP(OFF_P), (const float*)WSP(OFF_HS), (const unsigned*)WSP(OFF_CMAX) + (size_t)l * INC};
          run_gemm(lds, (const bf16_t*)WSP(OFF_H8), (const bf16_t*)WSP(OFF_W + W_IN), TT, INC, D / 2, E); }
        xcd_barrier(bar);
        { const Params p = load_params(); phase_hgrn(p, l, lds); }
        __syncthreads();
        { const Params p = load_params(); phase_s5(p, l, lds); }
        xcd_barrier(bar);
        { const Params p = load_params(); phase_gmlp(p, l, Mrows, lds); }
        { const Params p = load_params(); phase_hcomb(p, l, Mrows); }
        { const Params p = load_params(); phase_s5post(p, l, Mrows); }
        xcd_barrier(bar);
        { const Params p = load_params(); EpiGlu E{(bf16_t*)WSP(OFF_P + P_CU)}; run_gemm(lds, (const bf16_t*)WSP(OFF_H + H_YSF), (const bf16_t*)WSP(OFF_W + W_GLU), Mrows, 1536, 768, E); }
        { const Params p = load_params(); EpiMerge<true> E{(bf16_t*)WSP(OFF_P + P_MERGED), (const bf16_t*)WSP(OFF_P + P_GATES)}; run_gemm(lds, (const bf16_t*)WSP(OFF_P + P_AU), (const bf16_t*)WSP(OFF_W + W_A), Mrows, D, 1024, E, GLU_ROT); }
        { const Params p = load_params(); EpiMerge<false> E{(bf16_t*)WSP(OFF_P + P_MERGED), (const bf16_t*)WSP(OFF_P + P_GATES) + 2048}; run_gemm(lds, (const bf16_t*)WSP(OFF_P + P_BFF), (const bf16_t*)WSP(OFF_W + W_B), Mrows, D, 1024, E, GLU_ROT); }
        xcd_barrier(bar);
        { const Params p = load_params(); EpiMerge<false> E{(bf16_t*)WSP(OFF_P + P_MERGED), (const bf16_t*)WSP(OFF_P + P_GATES) + 4096}; run_gemm(lds, (const bf16_t*)WSP(OFF_P + P_CU), (const bf16_t*)WSP(OFF_W + W_C), Mrows, D, 768, E); }
        xcd_barrier(bar);
        { const Params p = load_params(); EpiResid E{p.out, (float*)WSP(OFF_XC), (const float*)WSP(OFF_MODV) + (size_t)l * 17 * NMOD + 4096}; run_gemm(lds, (const bf16_t*)WSP(OFF_P + P_MERGED), (const bf16_t*)WSP(OFF_W + W_O), Mrows, D, D, E); }
        { const Params p = load_params(); phase_tabconv(p, l); }
        xcd_barrier(bar);
        { const Params p = load_params(); phase_norm<1>(p, l, Mrows, 6144, 8192); }
        xcd_barrier(bar);
        { const Params p = load_params(); EpiF32 E{(float*)WSP(OFF_P + Q_SC), 2048}; run_gemm(lds, (const bf16_t*)WSP(OFF_H), (const bf16_t*)WSP(OFF_W + W_S), Mrows, D, D, E); }
        xcd_barrier(bar);
        { const Params p = load_params(); phase_topk(p, Mrows, lds); }
        xcd_barrier(bar);
        { const Params p = load_params(); phase_peer(p, l, Mrows, lds); }
        if (l == 0) {
            __syncthreads();
            { const Params p = load_params(); phase_wconv(p, 1, lds); }
            xcd_barrier(bar);
        }
}
#undef WSP
__global__ void __launch_bounds__(NTHREADS, 2) k_mega(Params p_kernarg_only) {
    extern __shared__ __attribute__((aligned(16))) unsigned char smem[];
    LAS unsigned char* lds = (LAS unsigned char*)smem;
    volatile LAS unsigned* xbw = (volatile LAS unsigned*)(lds + LDS_BYTES - 16);
    if (threadIdx.x == 0) { xbw[0] = 0u; xbw[1] = 0u; xbw[2] = 0u; xbw[3] = 0u; }
    __syncthreads();
    XcdBarrier bar;
    { const Params p = load_params(); bar = xcd_barrier_post((unsigned*)(p.ws + OFF_BAR), xbw); }
#define WSP(off) (p.ws + (off))
    { const Params p = load_params(); phase_colmax(p); }
    { const Params p = load_params(); phase_prep(p); phase_mod(p, lds); }
    xcd_barrier(bar);
    mega_layer<0>(lds, bar);
    mega_layer<1>(lds, bar);
#undef WSP
}

extern "C" void kernel_launch(void* const* d_in, const int* in_sizes, int n_in, void* d_out, int out_size, void* d_ws, size_t ws_size, hipStream_t stream) {
    (void)in_sizes; (void)n_in; (void)out_size; (void)ws_size;
    Params p;
    const float** f = (const float**)&p;
    for (int i = 0; i < 31; ++i) f[i] = (const float*)d_in[i];
    p.out = (float*)d_out; p.ws = (unsigned char*)d_ws;
    static int grid = 0;
    if (!grid) {
        int dev = 0, cus = 0, per_cu = 0;
        (void)hipGetDevice(&dev);
        (void)hipDeviceGetAttribute(&cus, hipDeviceAttributeMultiprocessorCount, dev);
        (void)hipFuncSetAttribute((const void*)k_mega, hipFuncAttributeMaxDynamicSharedMemorySize, LDS_BYTES);
        (void)hipOccupancyMaxActiveBlocksPerMultiprocessor(&per_cu, (const void*)k_mega, NTHREADS, LDS_BYTES);
        grid = (per_cu >= 1 && cus > 0) ? (cus < 256 ? cus : 256) : 256;
    }
    (void)hipMemsetAsync(p.ws + OFF_BAR, 0, OFF_MODV, stream);
    hipLaunchKernelGGL(k_mega, dim3(grid), dim3(NTHREADS), LDS_BYTES, stream, p);
}
```

```cpp
#include <hip/hip_runtime.h>
#include <stdint.h>

#define LAS __attribute__((address_space(3)))
typedef unsigned short bf16_t;
typedef short bf16x8 __attribute__((ext_vector_type(8)));
typedef float f32x4 __attribute__((ext_vector_type(4)));
typedef float f32x2 __attribute__((ext_vector_type(2)));
typedef unsigned u32x4 __attribute__((ext_vector_type(4)));
typedef unsigned u32x2 __attribute__((ext_vector_type(2)));
typedef __bf16 bf16x2_t __attribute__((ext_vector_type(2)));
typedef __bf16 bf16x32_t __attribute__((ext_vector_type(32)));
typedef float f32x32 __attribute__((ext_vector_type(32)));
typedef unsigned u32x6 __attribute__((ext_vector_type(6)));
typedef unsigned u32x16 __attribute__((ext_vector_type(16)));

constexpr int D = 2048, NB = 16, SEQ = 2048, CTXL = 256;
constexpr int TL = NB * SEQ;
constexpr int TC = NB * CTXL;
constexpr int TT = TL + TC;
constexpr int INC = 14080;
constexpr int NMOD = 12288;
constexpr int NTHREADS = 512;
constexpr int LDS_BYTES = 160 * 1024;

constexpr size_t OFF_BAR = 0;
constexpr size_t OFF_CMAX = 16384;
constexpr size_t OFF_MODV = OFF_CMAX + (size_t)2 * INC * 4;
constexpr size_t OFF_LB = OFF_MODV + (size_t)2 * 17 * NMOD * 4;
constexpr size_t OFF_S5LAM = OFF_LB + 2 * 2 * 1024 * 4;
constexpr size_t OFF_S5BB = OFF_S5LAM + (size_t)2 * 2 * 48 * 64 * 2 * 4;
constexpr size_t OFF_PE = OFF_S5BB + (size_t)2 * 2 * 48 * 64 * 32 * 4;
constexpr size_t OFF_HS = (OFF_PE + (size_t)96 * 1024 * 4 + 255) & ~(size_t)255;
constexpr size_t OFF_XC = (OFF_HS + (size_t)TT * 4 + 255) & ~(size_t)255;
constexpr size_t OFF_H = OFF_XC + (size_t)TC * D * 4;
constexpr size_t OFF_W = OFF_H + (size_t)TT * D * 2;
constexpr size_t W_IN = 0;
constexpr size_t W_GLU = W_IN + (size_t)INC * D;
constexpr size_t W_A = W_GLU + (size_t)1536 * 768 * 2;
constexpr size_t W_B = W_A + (size_t)2048 * 1024 * 2;
constexpr size_t W_C = W_B + (size_t)2048 * 1024 * 2;
constexpr size_t W_O = W_C + (size_t)2048 * 768 * 2;
constexpr size_t W_S = W_O + (size_t)2048 * 2048 * 2;
constexpr size_t W_TOTAL = W_S + (size_t)2048 * 2048 * 2;
constexpr size_t OFF_P = OFF_W + W_TOTAL;
constexpr size_t SEG = (size_t)TT * 1024 * 2;
constexpr size_t P_AU = 0, P_AV = SEG, P_BQ = 2 * SEG, P_BFF = 3 * SEG, P_BFB = 4 * SEG, P_BI = 5 * SEG, P_BG = 6 * SEG;
constexpr size_t P_CU = 7 * SEG;
constexpr size_t P_GATES = P_CU + (size_t)TT * 768 * 2;
constexpr size_t P_TOTAL = P_GATES + (size_t)TT * 6144 * 2;
constexpr size_t P_MERGED = SEG;
constexpr size_t Q_UT = 0;
constexpr size_t Q_VT = Q_UT + (size_t)16384 * 1536;
constexpr size_t Q_USC = Q_VT + (size_t)16384 * 1536;
constexpr size_t Q_VSC = Q_USC + (size_t)16384 * 4;
constexpr size_t Q_SC = Q_VSC + (size_t)16384 * 4;
constexpr size_t Q_IDX = Q_SC + (size_t)TT * 2048 * 4;
constexpr size_t Q_GATE = Q_IDX + (size_t)TT * 128 * 4;
constexpr size_t H_YSF = 0;
constexpr size_t H_YSB = (size_t)TT * 768 * 2;
constexpr size_t OFF_H8 = OFF_P + P_TOTAL;
constexpr size_t WS_NEEDED = OFF_H8 + (size_t)TT * D;

struct Params {
    const float *x, *c, *ctx, *c_ctx, *w_mod, *b_mod, *w_in, *ln_g, *ln_b, *w_s, *b_s, *lb_logits, *hn_g;
    const float *lam_re, *lam_im, *log_step, *b_re, *b_im, *c_re, *c_im, *s5_d, *w_glu, *wa, *wb, *wc, *wo, *w_q, *sub_keys, *peer_u, *peer_v, *final_g;
    float* out;
    unsigned char* ws;
};

__device__ __forceinline__ float bf_lo(unsigned u) { return __uint_as_float(u << 16); }
__device__ __forceinline__ float bf_hi(unsigned u) { return __uint_as_float(u & 0xffff0000u); }
__device__ __forceinline__ unsigned cvt_pk_bf16(float lo, float hi) { f32x2 v; v.x = lo; v.y = hi; const bf16x2_t b = __builtin_convertvector(v, bf16x2_t); return __builtin_bit_cast(unsigned, b); }
__device__ __forceinline__ float fexp(float x) { return __builtin_amdgcn_exp2f(x * 1.44269504f); }
__device__ __forceinline__ float flog(float x) { return __builtin_amdgcn_logf(x) * 0.693147181f; }
__device__ __forceinline__ float fast_sigmoid(float x) { return __builtin_amdgcn_rcpf(1.0f + fexp(-x)); }
__device__ __forceinline__ float fast_silu(float x) { return x * fast_sigmoid(x); }
__device__ __forceinline__ float gelu_f(float v) {
    const float av = fabsf(v), t = __builtin_amdgcn_rcpf(av * 0.2316418882f + 1.0f);
    float q = t * 0.5307027145f + (-0.7265760135f); q = q * t + 0.7107068705f; q = q * t + (-0.142248368f); q = q * t + 0.127414796f; q = q * t;
    const float e = __builtin_amdgcn_exp2f((v * v) * (-0.72134752044f));
    const float m = v * (q * e);
    return v < 0.f ? m : v - m;
}
__device__ __forceinline__ unsigned pack_fp8x4(float a, float b, float c, float d) {
    int pk = 0; pk = __builtin_amdgcn_cvt_pk_fp8_f32(a, b, pk, false); pk = __builtin_amdgcn_cvt_pk_fp8_f32(c, d, pk, true); return (unsigned)pk;
}
template <int CTRL> __device__ __forceinline__ float dpp_f(float v) { return __int_as_float(__builtin_amdgcn_update_dpp(0, __float_as_int(v), CTRL, 0xF, 0xF, false)); }
__device__ __forceinline__ float row16_max(float v) { v = fmaxf(v, dpp_f<0x128>(v)); v = fmaxf(v, dpp_f<0x124>(v)); v = fmaxf(v, dpp_f<0x122>(v)); v = fmaxf(v, dpp_f<0x121>(v)); return v; }
__device__ __forceinline__ float row16_sum(float v) { v += dpp_f<0x128>(v); v += dpp_f<0x124>(v); v += dpp_f<0x122>(v); v += dpp_f<0x121>(v); return v; }
__device__ __forceinline__ float wave_sum(float v) {
#pragma unroll
    for (int o = 32; o >= 1; o >>= 1) v += __shfl_xor(v, o);
    return v;
}
__device__ __forceinline__ int otid() { int t; asm volatile("v_mov_b32 %0, %1" : "=v"(t) : "v"((int)threadIdx.x)); return t; }


#define XB_TMO      128
#define XB_XCNT(j)  (256  + 64 * (j))
#define XB_XSUB(j)  (1280 + 64 * (j))
#define XB_XGEN(j)  (2304 + 64 * (j))
#define XB_TOP      3328
#define XB_TOPGEN   3392
#define XCD_BAR_WORDS 3456
#define XB_SPIN_CAP (1u << 22)
__device__ __forceinline__ unsigned xb_ld(unsigned* p)              { return __hip_atomic_load(p, __ATOMIC_RELAXED, __HIP_MEMORY_SCOPE_AGENT); }
__device__ __forceinline__ unsigned xb_add(unsigned* p, unsigned v) { return __hip_atomic_fetch_add(p, v, __ATOMIC_RELAXED, __HIP_MEMORY_SCOPE_AGENT); }
__device__ __forceinline__ unsigned xb_xcc_id() { return (unsigned)__builtin_amdgcn_s_getreg((3 << 11) | 20) & 0xFu; }
#define XB_SPIN(cond, bar) do { unsigned _sp = 0; while (cond) { __builtin_amdgcn_s_sleep(1); \
    if ((++_sp & 255u) == 0u) { if (xb_ld(&(bar)[XB_TMO])) break; if (_sp > XB_SPIN_CAP) { atomicAdd(&(bar)[XB_TMO], 1u); break; } } } } while (0)
struct XcdBarrier { unsigned* bar; unsigned x; volatile LAS unsigned* st; };
__device__ __forceinline__ XcdBarrier xcd_barrier_post(unsigned* bar, volatile LAS unsigned* st) {
    XcdBarrier b; b.bar = bar; b.x = xb_xcc_id(); b.st = st;
    if (threadIdx.x == 0) (void)xb_add(&bar[XB_XCNT(b.x)], 1u);
    return b;
}
__device__ __forceinline__ void xcd_barrier_complete(unsigned* bar, unsigned x, unsigned& nloc, unsigned& nx) {
    const unsigned G = gridDim.x * gridDim.y * gridDim.z;
    unsigned sum, cnt, mine, sp = 0u;
    for (;;) {
        sum = 0u; cnt = 0u; mine = 0u;
#pragma unroll
        for (unsigned j = 0; j < 16; ++j) { const unsigned c = xb_ld(&bar[XB_XCNT(j)]); sum += c; cnt += (c > 0u) ? 1u : 0u; mine = (j == x) ? c : mine; }
        if (sum == G) break;
        __builtin_amdgcn_s_sleep(1);
        if ((++sp & 255u) == 0u) { if (xb_ld(&bar[XB_TMO])) break; if (sp > XB_SPIN_CAP) { atomicAdd(&bar[XB_TMO], 1u); break; } }
    }
    nloc = mine > 0u ? mine : 1u; nx = cnt > 0u ? cnt : 1u;
}
__device__ __forceinline__ void xcd_barrier(const XcdBarrier& b) {
    asm volatile("s_waitcnt vmcnt(0)" ::: "memory");
    __syncthreads();
    if (threadIdx.x == 0) {
        unsigned* bar = b.bar;
        __builtin_amdgcn_s_waitcnt(0);
        unsigned nloc = b.st[0], nx = b.st[1];
        if (nloc == 0u) { xcd_barrier_complete(bar, b.x, nloc, nx); b.st[0] = nloc; b.st[1] = nx; }
        const unsigned old = xb_add(&bar[XB_XSUB(b.x)], 1u);
        const unsigned gen = old / nloc;
        if (old + 1u == (gen + 1u) * nloc) {
            __builtin_amdgcn_fence(__ATOMIC_RELEASE, "agent");
            asm volatile("s_waitcnt vmcnt(0)" ::: "memory");
            const unsigned og = xb_add(&bar[XB_TOP], 1u);
            const unsigned tg = og / nx;
            if (og + 1u == (tg + 1u) * nx) xb_add(&bar[XB_TOPGEN], 1u);
            else XB_SPIN(xb_ld(&bar[XB_TOPGEN]) == tg, bar);
            __builtin_amdgcn_fence(__ATOMIC_ACQUIRE, "agent");
            xb_add(&bar[XB_XGEN(b.x)], 1u);
            asm volatile("s_waitcnt vmcnt(0)" ::: "memory");
        } else {
            XB_SPIN(xb_ld(&bar[XB_XGEN(b.x)]) == gen, bar);
            __builtin_amdgcn_fence(__ATOMIC_ACQUIRE, "agent");
            asm volatile("s_waitcnt vmcnt(0)" ::: "memory");
        }
    }
    __syncthreads();
}

namespace pg8 {
constexpr int BM = 256, BK = 64, HALF = 128, HTB = HALF * BK * 2, STAGE_BYTES = 8 * HTB, NXCD = 8, WGM = 8;
__host__ __device__ __forceinline__ int lds_byte(int r, int c) { const int st = (r >> 4) * 2 + (c >> 5), rr = r & 15, cc = c & 31, ob = rr * 64 + cc * 2; return st * 1024 + (ob ^ (((ob >> 9) & 1) << 5)); }
__host__ __device__ __forceinline__ void stage_rc(int b, int& R, int& C) { const int st = b / 1024, sb = b % 1024, swz = sb ^ (((sb >> 9) & 1) << 5); R = (st >> 1) * 16 + swz / 64; C = (st & 1) * 32 + (swz % 64) / 2; }
__host__ __device__ __forceinline__ int perm32(int rho) { const int n = rho >> 4, i = rho & 15; return 8 * (i >> 2) + 4 * n + (i & 3); }
typedef int i32x8 __attribute__((ext_vector_type(8)));
__device__ __forceinline__ i32x8 cat8(const bf16x8 a, const bf16x8 b) { const u32x4 x = __builtin_bit_cast(u32x4, a), y = __builtin_bit_cast(u32x4, b); i32x8 r; r[0] = (int)x.x; r[1] = (int)x.y; r[2] = (int)x.z; r[3] = (int)x.w; r[4] = (int)y.x; r[5] = (int)y.y; r[6] = (int)y.z; r[7] = (int)y.w; return r; }
struct Unit { int pm, pn; };
struct Gemm { const bf16_t* A; const bf16_t* Bt; int M, N, K; };
struct StaticOrder {
    int nM, nN, nwg, G, c;
    __device__ void init(int M, int N, int G_, int c_) { nM = M / BM; nN = N / BM; nwg = nM * nN; G = G_; c = c_; }
    __device__ bool next(int i, Unit& u) const {
        const long L = (long)i * G + c; if (L >= nwg) return false;
        int wgid = (int)L; { const int q = nwg / NXCD, r = nwg % NXCD, xcd = wgid % NXCD, off = wgid / NXCD; wgid = (xcd < r ? xcd * (q + 1) : r * (q + 1) + (xcd - r) * q) + off; }
        const int nig = WGM * nN, gid = wgid / nig, fm = gid * WGM, gsz = (nM - fm) < WGM ? (nM - fm) : WGM;
        u.pm = fm + ((wgid % nig) % gsz); u.pn = (wgid % nig) / gsz; return true;
    }
};

template <class Epi, class Sched>
__device__ __forceinline__ void gemm_phase(LAS unsigned char* lds, const Gemm g, const Sched& S, const Epi& E) {
    const int tid_ = otid();
    const int tid = tid_, wid = __builtin_amdgcn_readfirstlane(tid >> 6), lane = tid & 63, wr = wid >> 2, wc = wid & 3, fr = lane & 15, fq = lane >> 4;
    const int K = g.K, nt = K / BK;
    unsigned voffA[2], voffB[2];
#pragma unroll
    for (int i = 0; i < 2; ++i) { int R, C; stage_rc(tid * 16 + i * 8192, R, C); const int Rb = Epi::PERM ? ((R & ~31) + perm32(R & 31)) : R;
        voffA[i] = (unsigned)(R * K + C) * 2u; voffB[i] = (unsigned)(Rb * K + C) * 2u; }
    const size_t kstep = (size_t)(BK * 2);
    const size_t hstep = (size_t)HALF * K * 2;
    const size_t tstep = 2 * hstep;
    const unsigned ldsw = (unsigned)wid * 1024u;
    const int aoff = lds_byte(wr * 64 + fr, fq * 8), boff = lds_byte(wc * 32 + fr, fq * 8);
    const int aoff8 = lds_byte(wr * 64 + fr, (fq >> 1) * 32 + (fq & 1) * 16), boff8 = lds_byte(wc * 32 + fr, (fq >> 1) * 32 + (fq & 1) * 16);
#define PG8_SA(b, h) (((b) * 2 + (h)) * HTB)
#define PG8_SB(b, h) ((4 + (b) * 2 + (h)) * HTB)
#define PG8_STAGE(bufoff, gbase, voff) do { _Pragma("unroll") for (int _i = 0; _i < 2; ++_i) \
        __builtin_amdgcn_global_load_lds((const unsigned*)((const char*)(gbase) + (voff)[_i]), (LAS unsigned*)(lds + (bufoff) + ldsw + _i * 8192), 16, 0, 0); } while (0)
#define PG8_LDA(dst, b, h) do { if constexpr (Epi::FP8) { _Pragma("unroll") for (int m = 0; m < 4; ++m) dst##8[m] = cat8(*(const LAS bf16x8*)(lds + PG8_SA(b, h) + aoff + m * 2048), *(const LAS bf16x8*)(lds + PG8_SA(b, h) + aoff + m * 2048 + 1024)); } \
        else { _Pragma("unroll") for (int m = 0; m < 4; ++m) _Pragma("unroll") for (int k = 0; k < 2; ++k) dst[m][k] = *(const LAS bf16x8*)(lds + PG8_SA(b, h) + aoff + m * 2048 + k * 1024); } } while (0)
#define PG8_LDB(dst, b, h) do { if constexpr (Epi::FP8) { _Pragma("unroll") for (int n = 0; n < 2; ++n) dst##8[n] = cat8(*(const LAS bf16x8*)(lds + PG8_SB(b, h) + boff + n * 2048), *(const LAS bf16x8*)(lds + PG8_SB(b, h) + boff + n * 2048 + 1024)); } \
        else { _Pragma("unroll") for (int n = 0; n < 2; ++n) _Pragma("unroll") for (int k = 0; k < 2; ++k) dst[n][k] = *(const LAS bf16x8*)(lds + PG8_SB(b, h) + boff + n * 2048 + k * 1024); } } while (0)
#define PG8_MMA(ai, bj, At, Bt) do { __builtin_amdgcn_s_setprio(1); _Pragma("unroll") for (int m = 0; m < 4; ++m) _Pragma("unroll") for (int n = 0; n < 2; ++n) { \
        if constexpr (Epi::FP8) { asm volatile("v_mfma_scale_f32_16x16x128_f8f6f4 %0, %1, %2, %0, %3, %3 op_sel_hi:[0,0,0]" : "+v"(acc[ai][bj][m][n]) : "v"(Bt##8[n]), "v"(At##8[m]), "v"(one_scale)); } \
        else { _Pragma("unroll") for (int k = 0; k < 2; ++k) acc[ai][bj][m][n] = __builtin_amdgcn_mfma_f32_16x16x32_bf16(Bt[n][k], At[m][k], acc[ai][bj][m][n], 0, 0, 0); } } \
        __builtin_amdgcn_s_setprio(0); } while (0)
#define PG8_WAIT_V(n) asm volatile("s_waitcnt vmcnt(" #n ")" ::: "memory")
#define PG8_WAIT_L(n) asm volatile("s_waitcnt lgkmcnt(" #n ")" ::: "memory")
#define PG8_BAR __builtin_amdgcn_s_barrier()
#define PG8_SCHED __builtin_amdgcn_sched_barrier(0)
    Unit cur, nxt; int ui = 0;
    if (!S.next(0, cur)) return;
    f32x4 acc[2][2][4][2];
#pragma unroll
    for (int a = 0; a < 2; ++a)
#pragma unroll
        for (int b = 0; b < 2; ++b)
#pragma unroll
            for (int m = 0; m < 4; ++m)
#pragma unroll
                for (int n = 0; n < 2; ++n) acc[a][b][m][n] = (f32x4){0.f, 0.f, 0.f, 0.f};
    bf16x8 At[4][2], B0[2][2], B1[2][2];
    i32x8 At8[4], B08[2], B18[2];
    const int one_scale = 0x7F7F7F7F;
    const char* cA = (const char*)g.A + (size_t)cur.pm * tstep; const char* cB = (const char*)g.Bt + (size_t)cur.pn * tstep;
    PG8_STAGE(PG8_SB(0, 0), cB, voffB); PG8_STAGE(PG8_SA(0, 0), cA, voffA); PG8_STAGE(PG8_SB(0, 1), cB + hstep, voffB); PG8_STAGE(PG8_SA(0, 1), cA + hstep, voffA);
    if (wr == 1) PG8_BAR;
    PG8_WAIT_V(4); PG8_BAR;
    PG8_STAGE(PG8_SB(1, 0), cB + kstep, voffB); PG8_STAGE(PG8_SA(1, 0), cA + kstep, voffA); PG8_STAGE(PG8_SB(1, 1), cB + hstep + kstep, voffB);
    PG8_WAIT_V(6); PG8_BAR;
    for (;;) {
        const bool has_next = S.next(ui + 1, nxt);
        const char* nA = has_next ? (const char*)g.A + (size_t)nxt.pm * tstep : cA; const char* nB = has_next ? (const char*)g.Bt + (size_t)nxt.pn * tstep : cB;
        for (int t = 0; t < nt; t += 2) {
            const bool last = (t == nt - 2);
            const char* a1 = cA + (size_t)(t + 1) * kstep;
            const char* a2 = last ? nA : cA + (size_t)(t + 2) * kstep; const char* b2 = last ? nB : cB + (size_t)(t + 2) * kstep;
            const char* a3 = a2 + kstep; const char* b3 = b2 + kstep;
            PG8_LDB(B0, 0, 0); PG8_SCHED; PG8_LDA(At, 0, 0); PG8_STAGE(PG8_SA(1, 1), a1 + hstep, voffA);
            PG8_WAIT_L(8); PG8_BAR; PG8_WAIT_L(0); PG8_MMA(0, 0, At, B0); PG8_BAR; PG8_SCHED;
            PG8_LDB(B1, 0, 1); PG8_STAGE(PG8_SB(0, 0), b2, voffB);
            PG8_BAR; PG8_WAIT_L(0); PG8_MMA(0, 1, At, B1); PG8_BAR;
            PG8_LDA(At, 0, 1); PG8_STAGE(PG8_SA(0, 0), a2, voffA);
            PG8_BAR; PG8_WAIT_L(0); PG8_MMA(1, 0, At, B0); PG8_BAR; PG8_SCHED;
            PG8_STAGE(PG8_SB(0, 1), b2 + hstep, voffB);
            PG8_WAIT_V(6); PG8_BAR; PG8_MMA(1, 1, At, B1); PG8_BAR;
            PG8_LDB(B0, 1, 0); PG8_SCHED; PG8_LDA(At, 1, 0); PG8_STAGE(PG8_SA(0, 1), a2 + hstep, voffA);
            PG8_WAIT_L(8); PG8_BAR; PG8_WAIT_L(0); PG8_MMA(0, 0, At, B0); PG8_BAR; PG8_SCHED;
            PG8_LDB(B1, 1, 1); PG8_STAGE(PG8_SB(1, 0), b3, voffB);
            PG8_BAR; PG8_WAIT_L(0); PG8_MMA(0, 1, At, B1); PG8_BAR;
            PG8_LDA(At, 1, 1); PG8_STAGE(PG8_SA(1, 0), a3, voffA);
            PG8_BAR; PG8_WAIT_L(0); PG8_MMA(1, 0, At, B0); PG8_BAR; PG8_SCHED;
            PG8_STAGE(PG8_SB(1, 1), b3 + hstep, voffB);
            PG8_WAIT_V(6); PG8_BAR; PG8_MMA(1, 1, At, B1); PG8_BAR;
        }
        if constexpr (Epi::FP8) asm volatile("s_nop 15\n s_nop 15\n s_nop 15" ::: "memory");
        E(acc, cur, wr, wc, fr, fq);
        if (!has_next) break;
#pragma unroll
        for (int a = 0; a < 2; ++a)
#pragma unroll
            for (int b = 0; b < 2; ++b)
#pragma unroll
                for (int m = 0; m < 4; ++m)
#pragma unroll
                    for (int n = 0; n < 2; ++n) acc[a][b][m][n] = (f32x4){0.f, 0.f, 0.f, 0.f};
        cur = nxt; cA = nA; cB = nB; ++ui;
    }
    PG8_WAIT_V(0);
    if (wr == 0) PG8_BAR;
    PG8_BAR;
#undef PG8_SA
#undef PG8_SB
#undef PG8_STAGE
#undef PG8_LDA
#undef PG8_LDB
#undef PG8_MMA
#undef PG8_WAIT_V
#undef PG8_WAIT_L
#undef PG8_BAR
#undef PG8_SCHED
}
}

typedef f32x4 AccT[2][2][4][2];

struct EpiInProj {
    static constexpr bool PERM = true, FP8 = true;
    unsigned char* P;
    const float* sa;
    const unsigned* cmax;
    __device__ __forceinline__ void operator()(const AccT& acc, const pg8::Unit& u, int wr, int wc, int fr, int fq) const {
        const int pn = u.pn;
        bf16_t* base; int ld, lc, act;
        if (pn < 28) { const int seg = pn >> 2; base = (bf16_t*)(P + (size_t)seg * SEG); ld = 1024; lc = (pn & 3) * 256; act = (seg < 2) ? 1 : ((seg == 2 || seg == 6) ? 2 : 0); }
        else if (pn < 31) { base = (bf16_t*)(P + P_CU); ld = 768; lc = (pn - 28) * 256; act = 0; }
        else { base = (bf16_t*)(P + P_GATES); ld = 6144; lc = (pn - 31) * 256; act = 3; }
        const int row0 = u.pm * 256 + wr * 64 + fr, col0 = lc + wc * 32 + 8 * fq, gcol0 = u.pn * 256 + wc * 32 + 8 * fq;
        f32x4 cs[2][2];
#pragma unroll
        for (int bj = 0; bj < 2; ++bj)
#pragma unroll
            for (int n = 0; n < 2; ++n) { const u32x4 cb = *(const u32x4*)(cmax + gcol0 + bj * 128 + 4 * n);
                cs[bj][n] = (f32x4){__uint_as_float(cb.x), __uint_as_float(cb.y), __uint_as_float(cb.z), __uint_as_float(cb.w)} * (1.0f / 240.0f); }
        float rscv[2][4];
#pragma unroll
        for (int ai = 0; ai < 2; ++ai)
#pragma unroll
            for (int m = 0; m < 4; ++m) rscv[ai][m] = sa[row0 + ai * 128 + m * 16];
#pragma unroll
        for (int ai = 0; ai < 2; ++ai)
#pragma unroll
            for (int m = 0; m < 4; ++m) {
                bf16_t* rowp = base + (size_t)(row0 + ai * 128 + m * 16) * ld + col0;
                const float rsc = rscv[ai][m];
#pragma unroll
                for (int bj = 0; bj < 2; ++bj) {
                    f32x4 v0 = acc[ai][bj][m][0] * (cs[bj][0] * rsc), v1 = acc[ai][bj][m][1] * (cs[bj][1] * rsc);
                    if (act == 1) {
#pragma unroll
                        for (int j = 0; j < 4; ++j) { v0[j] = gelu_f(v0[j]); v1[j] = gelu_f(v1[j]); }
                    } else if (act == 2) {
#pragma unroll
                        for (int j = 0; j < 4; ++j) { v0[j] = fast_silu(v0[j]); v1[j] = fast_silu(v1[j]); }
                    } else if (act == 3) {
#pragma unroll
                        for (int j = 0; j < 4; ++j) { v0[j] = fast_sigmoid(v0[j]); v1[j] = fast_sigmoid(v1[j]); }
                    }
                    u32x4 w; w.x = cvt_pk_bf16(v0[0], v0[1]); w.y = cvt_pk_bf16(v0[2], v0[3]); w.z = cvt_pk_bf16(v1[0], v1[1]); w.w = cvt_pk_bf16(v1[2], v1[3]);
                    *(u32x4*)(rowp + bj * 128) = w;
                }
            }
    }
};
struct EpiGlu {
    static constexpr bool PERM = true, FP8 = false;
    bf16_t* O;
    __device__ __forceinline__ void operator()(const AccT& acc, const pg8::Unit& u, int wr, int wc, int fr, int fq) const {
        const int row0 = u.pm * 256 + wr * 64 + fr, col0 = u.pn * 128 + wc * 32 + 8 * fq;
#pragma unroll
        for (int ai = 0; ai < 2; ++ai)
#pragma unroll
            for (int m = 0; m < 4; ++m) {
                f32x4 v0 = acc[ai][0][m][0], v1 = acc[ai][0][m][1]; const f32x4 g0 = acc[ai][1][m][0], g1 = acc[ai][1][m][1];
#pragma unroll
                for (int j = 0; j < 4; ++j) { v0[j] *= fast_sigmoid(g0[j]); v1[j] *= fast_sigmoid(g1[j]); }
                u32x4 w; w.x = cvt_pk_bf16(v0[0], v0[1]); w.y = cvt_pk_bf16(v0[2], v0[3]); w.z = cvt_pk_bf16(v1[0], v1[1]); w.w = cvt_pk_bf16(v1[2], v1[3]);
                *(u32x4*)(O + (size_t)(row0 + ai * 128 + m * 16) * 768 + col0) = w;
            }
    }
};
template <bool FIRST> struct EpiMerge {
    static constexpr bool PERM = true, FP8 = false;
    bf16_t* O;
    const bf16_t* G;
    __device__ __forceinline__ void operator()(const AccT& acc, const pg8::Unit& u, int wr, int wc, int fr, int fq) const {
        const int row0 = u.pm * 256 + wr * 64 + fr, col0 = u.pn * 256 + wc * 32 + 8 * fq;
#pragma unroll
        for (int ai = 0; ai < 2; ++ai) {
            u32x4 gwv[4][2], owv[4][2];
#pragma unroll
            for (int m = 0; m < 4; ++m)
#pragma unroll
                for (int bj = 0; bj < 2; ++bj) { const size_t row = (size_t)(row0 + ai * 128 + m * 16);
                    gwv[m][bj] = *(const u32x4*)(G + row * 6144 + col0 + bj * 128);
                    if (!FIRST) owv[m][bj] = *(const u32x4*)(O + row * 2048 + col0 + bj * 128); }
#pragma unroll
            for (int m = 0; m < 4; ++m)
#pragma unroll
                for (int bj = 0; bj < 2; ++bj) { const size_t row = (size_t)(row0 + ai * 128 + m * 16);
                    const u32x4 gw = gwv[m][bj];
                    f32x4 v0 = acc[ai][bj][m][0], v1 = acc[ai][bj][m][1];
                    v0[0] *= bf_lo(gw.x); v0[1] *= bf_hi(gw.x); v0[2] *= bf_lo(gw.y); v0[3] *= bf_hi(gw.y);
                    v1[0] *= bf_lo(gw.z); v1[1] *= bf_hi(gw.z); v1[2] *= bf_lo(gw.w); v1[3] *= bf_hi(gw.w);
                    if (!FIRST) { const u32x4 ow = owv[m][bj];
                        v0[0] += bf_lo(ow.x); v0[1] += bf_hi(ow.x); v0[2] += bf_lo(ow.y); v0[3] += bf_hi(ow.y);
                        v1[0] += bf_lo(ow.z); v1[1] += bf_hi(ow.z); v1[2] += bf_lo(ow.w); v1[3] += bf_hi(ow.w); }
                    u32x4 w; w.x = cvt_pk_bf16(v0[0], v0[1]); w.y = cvt_pk_bf16(v0[2], v0[3]); w.z = cvt_pk_bf16(v1[0], v1[1]); w.w = cvt_pk_bf16(v1[2], v1[3]);
                    *(u32x4*)(O + row * 2048 + col0 + bj * 128) = w; }
        }
    }
};
struct EpiResid {
    static constexpr bool PERM = false, FP8 = false;
    float* XR; float* XC; const float* modl;
    __device__ __forceinline__ void operator()(const AccT& acc, const pg8::Unit& u, int wr, int wc, int fr, int fq) const {
        const int row0 = u.pm * 256 + wr * 64 + fr, col0 = u.pn * 256 + wc * 32 + 4 * fq;
        const int mb = u.pm < 128 ? (u.pm >> 3) : 16;
        const float* gv = modl + (size_t)mb * NMOD + col0;
        float* basep = u.pm < 128 ? XR : (XC - (size_t)TL * D);
        f32x4 gvv[2][2];
#pragma unroll
        for (int bj = 0; bj < 2; ++bj)
#pragma unroll
            for (int n = 0; n < 2; ++n) gvv[bj][n] = *(const f32x4*)(gv + bj * 128 + n * 16);
#pragma unroll
        for (int ai = 0; ai < 2; ++ai) {
            f32x4 xo[4][2][2];
#pragma unroll
            for (int m = 0; m < 4; ++m)
#pragma unroll
                for (int bj = 0; bj < 2; ++bj)
#pragma unroll
                    for (int n = 0; n < 2; ++n) xo[m][bj][n] = *(const f32x4*)(basep + (size_t)(row0 + ai * 128 + m * 16) * D + col0 + bj * 128 + n * 16);
#pragma unroll
            for (int m = 0; m < 4; ++m)
#pragma unroll
                for (int bj = 0; bj < 2; ++bj)
#pragma unroll
                    for (int n = 0; n < 2; ++n) *(f32x4*)(basep + (size_t)(row0 + ai * 128 + m * 16) * D + col0 + bj * 128 + n * 16) = xo[m][bj][n] + gvv[bj][n] * acc[ai][bj][m][n];
        }
    }
};
struct EpiF32 {
    static constexpr bool PERM = false, FP8 = false;
    float* C; int ldc;
    __device__ __forceinline__ void operator()(const AccT& acc, const pg8::Unit& u, int wr, int wc, int fr, int fq) const {
        const int row0 = u.pm * 256 + wr * 64 + fr, col0 = u.pn * 256 + wc * 32 + 4 * fq;
#pragma unroll
        for (int ai = 0; ai < 2; ++ai)
#pragma unroll
            for (int m = 0; m < 4; ++m) {
                float* rowp = C + (size_t)(row0 + ai * 128 + m * 16) * ldc + col0;
#pragma unroll
                for (int bj = 0; bj < 2; ++bj)
#pragma unroll
                    for (int n = 0; n < 2; ++n) *(f32x4*)(rowp + bj * 128 + n * 16) = acc[ai][bj][m][n];
            }
    }
};

template <class Epi>
__device__ __forceinline__ void run_gemm(LAS unsigned char* lds, const bf16_t* A, const bf16_t* Bt, int M, int N, int K, const Epi& E, int rot = 0) {
    pg8::Gemm g{A, Bt, M, N, K};
    const int G_ = (int)gridDim.x; int c_ = (int)blockIdx.x - rot; if (c_ < 0) c_ += G_;
    pg8::StaticOrder S; S.init(M, N, G_, c_);
    pg8::gemm_phase<Epi, pg8::StaticOrder>(lds, g, S, E);
}

__device__ __forceinline__ void phase_mod(const Params& p, LAS unsigned char* lds) {
    const int tid_ = otid();
    LAS float* cs = (LAS float*)lds;
    LAS float* red = (LAS float*)(lds + 2048 * 17 * 4);
    const int tid = tid_;
    float* modv = (float*)(p.ws + OFF_MODV);
    { f32x4 cv[17];
#pragma unroll
      for (int r = 0; r < 17; ++r) cv[r] = *(const f32x4*)((r < 16 ? p.c + r * 2048 : p.c_ctx) + tid * 4);
#pragma unroll
      for (int r = 0; r < 17; ++r)
#pragma unroll
          for (int e = 0; e < 4; ++e) { const float c = cv[r][e]; cs[(tid * 4 + e) * 17 + r] = c / (1.0f + __expf(-c)); } }
    __syncthreads();
    const int lane = tid & 63, wv = tid >> 6, cq = lane & 7, kg = wv * 8 + (lane >> 3);
    for (int u = blockIdx.x; u < 768; u += gridDim.x) {
        const int l = u / 384, c0 = (u % 384) * 32;
        const float* w = p.w_mod + (size_t)l * 2048 * NMOD + (size_t)kg * NMOD + c0 + cq * 4;
        f32x4 acc[17];
#pragma unroll
        for (int r = 0; r < 17; ++r) acc[r] = (f32x4){0.f, 0.f, 0.f, 0.f};
#pragma unroll 16
        for (int j = 0; j < 32; ++j) {
            const f32x4 w4 = *(const f32x4*)(w + (size_t)j * 64 * NMOD);
            const LAS float* cr = cs + (kg + 64 * j) * 17;
#pragma unroll
            for (int r = 0; r < 17; ++r) acc[r] += w4 * cr[r];
        }
#pragma unroll
        for (int r = 0; r < 17; ++r)
#pragma unroll
            for (int c = 0; c < 4; ++c) { float v = acc[r][c]; v += __shfl_xor(v, 8); v += __shfl_xor(v, 16); v += __shfl_xor(v, 32);
                if (lane < 8) red[(wv * 32 + cq * 4 + c) * 17 + r] = v; }
        __syncthreads();
        for (int o = tid; o < 32 * 17; o += NTHREADS) { const int col = o & 31, r = o >> 5;
            float sum = p.b_mod[l * NMOD + c0 + col];
#pragma unroll
            for (int q = 0; q < 8; ++q) sum += red[(q * 32 + col) * 17 + r];
            modv[(size_t)(l * 17 + r) * NMOD + c0 + col] = sum; }
        __syncthreads();
    }
}
__device__ __forceinline__ void phase_prep(const Params& p) {
    const int tid_ = otid();
    const int gt = blockIdx.x * NTHREADS + tid_, nt = gridDim.x * NTHREADS;
    float* lb = (float*)(p.ws + OFF_LB);
    for (int i = gt; i < 2 * 1024; i += nt) { const float x0 = p.lb_logits[i], x1 = p.lb_logits[2048 + i]; lb[i] = 0.f; lb[2048 + i] = 1.0f / (1.0f + expf(x0 - x1)); }
    float* s5lam = (float*)(p.ws + OFF_S5LAM); float* s5bb = (float*)(p.ws + OFF_S5BB);
    for (int i = gt; i < 2 * 2 * 48 * 64; i += nt) {
        const int ldg = i >> 6;
        const double lre = (double)p.lam_re[i], lim = (double)p.lam_im[i], dt = exp((double)p.log_step[ldg]);
        const double er = exp(lre * dt); double sn, cs; sincos(lim * dt, &sn, &cs);
        const double br = er * cs, bi = er * sn;
        s5lam[i * 2] = (float)br; s5lam[i * 2 + 1] = (float)bi;
        const double nr = br - 1.0, ni = bi, den = lre * lre + lim * lim;
        const double cr = (nr * lre + ni * lim) / den, ci = (ni * lre - nr * lim) / den;
        for (int d = 0; d < 16; ++d) { const double xr = (double)p.b_re[(size_t)i * 16 + d], xi = (double)p.b_im[(size_t)i * 16 + d];
            s5bb[(size_t)i * 32 + d] = (float)(cr * xr - ci * xi); s5bb[(size_t)i * 32 + 16 + d] = (float)(cr * xi + ci * xr); }
    }
    float* pe = (float*)(p.ws + OFF_PE);
    for (int i = gt; i < 96 * 1024; i += nt) {
        const int r = i >> 10, cc = i & 1023, j = cc & 511;
        const float pos = (float)(r < 32 ? r : r - 32);
        const float omega = 1.0f / powf(10000.0f, (float)j * (1.0f / 512.0f));
        const float ang = pos * omega;
        pe[i] = cc < 512 ? sinf(ang) : cosf(ang);
    }
}

template <int MAPMODE>
__device__ __forceinline__ void transpose_convert(const float* src, int K, int N, bf16_t* dst, LAS unsigned char* lds) {
    const int tid_ = otid();
    LAS float* tile = (LAS float*)lds;
    const int tid = tid_, nkb = K / 64, nnb = N / 64;
    for (int u = blockIdx.x; u < nkb * nnb; u += gridDim.x) {
        const int kb = u / nnb, nb = u % nnb, k0 = kb * 64, n0 = nb * 64;
        { const int nn = tid & 63, kk = tid >> 6;
#pragma unroll
          for (int i = 0; i < 8; ++i) tile[(kk + i * 8) * 65 + nn] = src[(size_t)(k0 + kk + i * 8) * N + n0 + nn]; }
        __syncthreads();
        { const int kk2 = (tid & 7) * 8, nn2 = tid >> 3; float v[8];
#pragma unroll
          for (int i = 0; i < 8; ++i) v[i] = tile[(kk2 + i) * 65 + nn2];
          int n = n0 + nn2, nr;
          if (MAPMODE == 1) { if (n < 768) nr = (n >> 7) * 256 + (n & 127); else { const int m = n - 768; nr = (m >> 7) * 256 + 128 + (m & 127); } } else nr = n;
          u32x4 w; w.x = cvt_pk_bf16(v[0], v[1]); w.y = cvt_pk_bf16(v[2], v[3]); w.z = cvt_pk_bf16(v[4], v[5]); w.w = cvt_pk_bf16(v[6], v[7]);
          *(u32x4*)(dst + (size_t)nr * K + k0 + kk2) = w; }
        __syncthreads();
    }
}
__device__ __forceinline__ void phase_wscore(const float* wq, const float* sk, bf16_t* dst, LAS unsigned char* lds) {
    const int tid_ = otid();
    LAS float* skt = (LAS float*)lds;
    LAS float* wqt = (LAS float*)(lds + 128 * 129 * 4);
    const int tid = tid_;
    for (int u = blockIdx.x; u < 16 * 32; u += gridDim.x) {
        const int hp = u >> 5, kb = u & 31;
        for (int i = tid; i < 128 * 128; i += NTHREADS) { const int key = i >> 7, e = i & 127; skt[key * 129 + e] = sk[(size_t)hp * 16384 + i]; }
        for (int i = tid; i < 64 * 128; i += NTHREADS) { const int k = i >> 7, e = i & 127; wqt[e * 68 + k] = wq[(size_t)(kb * 64 + k) * 2048 + hp * 128 + e]; }
        __syncthreads();
        const int key = tid & 127, kg = tid >> 7;
        float acc[16];
#pragma unroll
        for (int i = 0; i < 16; ++i) acc[i] = 0.f;
        for (int e = 0; e < 128; ++e) {
            const float s = skt[key * 129 + e];
#pragma unroll
            for (int q = 0; q < 4; ++q) { const f32x4 w4 = *(const LAS f32x4*)(wqt + e * 68 + kg * 16 + q * 4);
                acc[q * 4 + 0] += s * w4[0]; acc[q * 4 + 1] += s * w4[1]; acc[q * 4 + 2] += s * w4[2]; acc[q * 4 + 3] += s * w4[3]; }
        }
        bf16_t* o = dst + (size_t)(hp * 128 + key) * 2048 + kb * 64 + kg * 16;
        u32x4 w0, w1;
        w0.x = cvt_pk_bf16(acc[0], acc[1]); w0.y = cvt_pk_bf16(acc[2], acc[3]); w0.z = cvt_pk_bf16(acc[4], acc[5]); w0.w = cvt_pk_bf16(acc[6], acc[7]);
        w1.x = cvt_pk_bf16(acc[8], acc[9]); w1.y = cvt_pk_bf16(acc[10], acc[11]); w1.z = cvt_pk_bf16(acc[12], acc[13]); w1.w = cvt_pk_bf16(acc[14], acc[15]);
        *(u32x4*)o = w0; *(u32x4*)(o + 8) = w1;
        __syncthreads();
    }
}
__device__ __forceinline__ void phase_colmax(const Params& p) {
    const int tid_ = otid();
    unsigned* cm = (unsigned*)(p.ws + OFF_CMAX);
    const int total = 2 * (INC / 4) * 16;
    for (int i = blockIdx.x * NTHREADS + tid_; i < total; i += gridDim.x * NTHREADS) {
        const int kc = i / (2 * (INC / 4)), cidx = i % (2 * (INC / 4)), l = cidx / (INC / 4), nq = cidx % (INC / 4);
        const float* w = p.w_in + (size_t)l * D * INC + (size_t)(kc * 128) * INC + nq * 4;
        f32x4 am = (f32x4){0.f, 0.f, 0.f, 0.f};
#pragma unroll 32
        for (int k = 0; k < 128; ++k) { const f32x4 v = *(const f32x4*)(w + (size_t)k * INC);
            am[0] = fmaxf(am[0], fabsf(v[0])); am[1] = fmaxf(am[1], fabsf(v[1])); am[2] = fmaxf(am[2], fabsf(v[2])); am[3] = fmaxf(am[3], fabsf(v[3])); }
        unsigned* o = cm + l * INC + nq * 4;
        atomicMax(o, __float_as_uint(am[0])); atomicMax(o + 1, __float_as_uint(am[1])); atomicMax(o + 2, __float_as_uint(am[2])); atomicMax(o + 3, __float_as_uint(am[3]));
    }
}
__device__ __forceinline__ void transpose_convert_fp8(const float* src, int K, int N, unsigned char* dst, const unsigned* cmax, LAS unsigned char* lds) {
    const int tid_ = otid();
    LAS float* tile = (LAS float*)lds;
    const int tid = tid_, nkb = K / 64, nnb = N / 64;
    for (int u = blockIdx.x; u < nkb * nnb; u += gridDim.x) {
        const int kb = u / nnb, nb = u % nnb, k0 = kb * 64, n0 = nb * 64;
        { const int nn = tid & 63, kk = tid >> 6;
#pragma unroll
          for (int i = 0; i < 8; ++i) tile[(kk + i * 8) * 65 + nn] = src[(size_t)(k0 + kk + i * 8) * N + n0 + nn]; }
        __syncthreads();
        { const int kk2 = (tid & 7) * 8, nn2 = tid >> 3; float v[8];
          const float cmv = __uint_as_float(cmax[n0 + nn2]); const float sc = cmv > 0.f ? 240.0f / cmv : 1.0f;
#pragma unroll
          for (int i = 0; i < 8; ++i) v[i] = tile[(kk2 + i) * 65 + nn2] * sc;
          u32x2 w; w.x = pack_fp8x4(v[0], v[1], v[2], v[3]); w.y = pack_fp8x4(v[4], v[5], v[6], v[7]);
          *(u32x2*)(dst + (size_t)(n0 + nn2) * K + k0 + kk2) = w; }
        __syncthreads();
    }
}
__device__ __forceinline__ void phase_wconv(const Params& p, int l, LAS unsigned char* lds) {
    unsigned char* W = p.ws + OFF_W;
    transpose_convert_fp8(p.w_in + (size_t)l * D * INC, D, INC, W + W_IN, (const unsigned*)(p.ws + OFF_CMAX) + (size_t)l * INC, lds);
    transpose_convert<1>(p.w_glu + (size_t)l * 768 * 1536, 768, 1536, (bf16_t*)(W + W_GLU), lds);
    transpose_convert<0>(p.wa + (size_t)l * 1024 * D, 1024, D, (bf16_t*)(W + W_A), lds);
    transpose_convert<0>(p.wb + (size_t)l * 1024 * D, 1024, D, (bf16_t*)(W + W_B), lds);
    transpose_convert<0>(p.wc + (size_t)l * 768 * D, 768, D, (bf16_t*)(W + W_C), lds);
    transpose_convert<0>(p.wo + (size_t)l * D * D, D, D, (bf16_t*)(W + W_O), lds);
    phase_wscore(p.w_q + (size_t)l * D * D, p.sub_keys + (size_t)l * 16 * 16384, (bf16_t*)(W + W_S), lds);
}
__device__ __forceinline__ void phase_tabconv(const Params& p, int l) {
    const int tid_ = otid();
    const int lane = tid_ & 63, gw = blockIdx.x * 8 + __builtin_amdgcn_readfirstlane(tid_ >> 6), nw = gridDim.x * 8;
    unsigned char* U6 = p.ws + OFF_P + Q_UT; unsigned char* V6 = p.ws + OFF_P + Q_VT;
    float* USC = (float*)(p.ws + OFF_P + Q_USC); float* VSC = (float*)(p.ws + OFF_P + Q_VSC);
    for (int r = gw; r < 32768; r += nw) {
        const bool isv = r >= 16384; const int rr = r & 16383;
        const float* src = (isv ? p.peer_v : p.peer_u) + (size_t)l * 16384 * 2048 + (size_t)rr * 2048;
        f32x4 v[8];
#pragma unroll
        for (int j = 0; j < 8; ++j) v[j] = *(const f32x4*)(src + j * 256 + lane * 4);
        float am = 0.f;
#pragma unroll
        for (int j = 0; j < 8; ++j) am = fmaxf(am, fmaxf(fmaxf(fabsf(v[j][0]), fabsf(v[j][1])), fmaxf(fabsf(v[j][2]), fabsf(v[j][3]))));
#pragma unroll
        for (int o = 32; o >= 1; o >>= 1) am = fmaxf(am, __shfl_xor(am, o));
        const float sc = am > 0.f ? 7.0f / am : 1.0f, inv = am > 0.f ? am * (1.0f / 7.0f) : 1.0f;
        bf16x32_t bv;
#pragma unroll
        for (int j = 0; j < 8; ++j)
#pragma unroll
            for (int c = 0; c < 4; ++c) bv[j * 4 + c] = (__bf16)(v[j][c] * sc);
        const u32x6 pk = __builtin_amdgcn_cvt_scalef32_pk32_fp6_bf16(bv, 1.0f);
        unsigned char* dst = (isv ? V6 : U6) + (size_t)rr * 1536 + lane * 24;
        u32x4 w0; w0.x = pk[0]; w0.y = pk[1]; w0.z = pk[2]; w0.w = pk[3]; u32x2 w1; w1.x = pk[4]; w1.y = pk[5];
        *(u32x4*)dst = w0; *(u32x2*)(dst + 16) = w1;
        if (lane == 0) (isv ? VSC : USC)[rr] = inv;
    }
}

template <int MODE, bool F8OUT = false>
__device__ __forceinline__ void phase_norm(const Params& p, int l, int M, int off_sh, int off_sc) {
    const int tid_ = otid();
    const int lane = tid_ & 63, gw = blockIdx.x * 8 + __builtin_amdgcn_readfirstlane(tid_ >> 6), nw = gridDim.x * 8;
    const float* modv = (const float*)(p.ws + OFF_MODV) + (size_t)l * 17 * NMOD;
    const float* pe = (const float*)(p.ws + OFF_PE);
    float* XC = (float*)(p.ws + OFF_XC);
    bf16_t* H = (bf16_t*)(p.ws + OFF_H);
    for (int r = gw; r < M; r += nw) {
        const bool lat = r < TL;
        const float* src = MODE == 0 ? (lat ? p.x + (size_t)r * D : p.ctx + (size_t)(r - TL) * D) : (lat ? p.out + (size_t)r * D : XC + (size_t)(r - TL) * D);
        f32x4 v[4][2];
#pragma unroll
        for (int j = 0; j < 4; ++j) { v[j][0] = *(const f32x4*)(src + j * 512 + lane * 8); v[j][1] = *(const f32x4*)(src + j * 512 + lane * 8 + 4); }
        if (MODE == 0) {
            if (lat) { const int n = r & 2047, gr = n >> 6, gc = n & 63;
#pragma unroll
                for (int j = 0; j < 4; ++j) { const float* pr = (j < 2) ? pe + (size_t)gr * 1024 + j * 512 + lane * 8 : pe + (size_t)(32 + gc) * 1024 + (j - 2) * 512 + lane * 8;
                    v[j][0] += *(const f32x4*)pr; v[j][1] += *(const f32x4*)(pr + 4); } }
            float* dst = lat ? p.out + (size_t)r * D : XC + (size_t)(r - TL) * D;
#pragma unroll
            for (int j = 0; j < 4; ++j) { *(f32x4*)(dst + j * 512 + lane * 8) = v[j][0]; *(f32x4*)(dst + j * 512 + lane * 8 + 4) = v[j][1]; }
        }
        float ss = 0.f;
#pragma unroll
        for (int j = 0; j < 4; ++j)
#pragma unroll
            for (int h = 0; h < 2; ++h) ss += v[j][h][0] * v[j][h][0] + v[j][h][1] * v[j][h][1] + v[j][h][2] * v[j][h][2] + v[j][h][3] * v[j][h][3];
        ss = wave_sum(ss);
        const float rs = rsqrtf(ss * (1.0f / 2048.0f) + 1e-6f);
        const int mb = lat ? (r >> 11) : 16;
        const float* sh = modv + (size_t)mb * NMOD + off_sh; const float* sc = modv + (size_t)mb * NMOD + off_sc;
        if (F8OUT) {
            float am = 0.f;
#pragma unroll
            for (int j = 0; j < 4; ++j) { const int e = j * 512 + lane * 8;
                const f32x4 s0 = *(const f32x4*)(sc + e), s1 = *(const f32x4*)(sc + e + 4), h0 = *(const f32x4*)(sh + e), h1 = *(const f32x4*)(sh + e + 4);
                v[j][0] = v[j][0] * rs * (s0 + 1.0f) + h0; v[j][1] = v[j][1] * rs * (s1 + 1.0f) + h1;
#pragma unroll
                for (int hh = 0; hh < 2; ++hh) am = fmaxf(am, fmaxf(fmaxf(fabsf(v[j][hh][0]), fabsf(v[j][hh][1])), fmaxf(fabsf(v[j][hh][2]), fabsf(v[j][hh][3])))); }
#pragma unroll
            for (int o = 32; o >= 1; o >>= 1) am = fmaxf(am, __shfl_xor(am, o));
            const float q = am > 0.f ? 240.0f / am : 1.0f;
            unsigned char* H8 = p.ws + OFF_H8 + (size_t)r * D;
#pragma unroll
            for (int j = 0; j < 4; ++j) { u32x2 w; w.x = pack_fp8x4(v[j][0][0] * q, v[j][0][1] * q, v[j][0][2] * q, v[j][0][3] * q); w.y = pack_fp8x4(v[j][1][0] * q, v[j][1][1] * q, v[j][1][2] * q, v[j][1][3] * q);
                *(u32x2*)(H8 + j * 512 + lane * 8) = w; }
            if (lane == 0) ((float*)(p.ws + OFF_HS))[r] = am > 0.f ? am * (1.0f / 240.0f) : 1.0f;
        } else {
#pragma unroll
        for (int j = 0; j < 4; ++j) {
            const int e = j * 512 + lane * 8;
            const f32x4 s0 = *(const f32x4*)(sc + e), s1 = *(const f32x4*)(sc + e + 4), h0 = *(const f32x4*)(sh + e), h1 = *(const f32x4*)(sh + e + 4);
            f32x4 a = v[j][0] * rs * (s0 + 1.0f) + h0, b = v[j][1] * rs * (s1 + 1.0f) + h1;
            u32x4 w; w.x = cvt_pk_bf16(a[0], a[1]); w.y = cvt_pk_bf16(a[2], a[3]); w.z = cvt_pk_bf16(b[0], b[1]); w.w = cvt_pk_bf16(b[2], b[3]);
            *(u32x4*)(H + (size_t)r * D + e) = w;
        }
        }
    }
}
__device__ __forceinline__ bf16x8 mk_bf16x8(unsigned a, unsigned b, unsigned c, unsigned d) { u32x4 q; q.x = a; q.y = b; q.z = c; q.w = d; return __builtin_bit_cast(bf16x8, q); }
__device__ __forceinline__ void phase_hgrn(const Params& p, int l, LAS unsigned char* lds, bool dry = false) {
    const int tid_ = otid();
    const int lane = tid_ & 63, w = __builtin_amdgcn_readfirstlane(tid_ >> 6), q = lane >> 4, m = lane & 15;
    constexpr int OQ = 0, OKH = 4352, OKT = 8704, OIT = 14848, OE = 20992, BUFSZ = 21504, RAWOFF = 2 * 21504, RAWSZ = 3 * 4352;
    unsigned char* P = p.ws + OFF_P;
    const float* lbp = (const float*)(p.ws + OFF_LB) + (size_t)l * 2048;
    const int kch = 16 * w + m;
    for (int u = blockIdx.x; u < 256; u += gridDim.x) {
        const int b = u >> 4, h = (u >> 1) & 7, dir = u & 1;
        const bf16_t* BQ = (const bf16_t*)(P + P_BQ); const bf16_t* BI = (const bf16_t*)(P + P_BI);
        bf16_t* BF = (bf16_t*)(P + (dir ? P_BFB : P_BFF));
        const float lbv = lbp[dir * 1024 + h * 128 + kch];
        f32x4 Sacc[8];
#pragma unroll
        for (int i = 0; i < 8; ++i) Sacc[i] = (f32x4){0.f, 0.f, 0.f, 0.f};
        for (int seg = 0; seg < 2; ++seg) {
            const int len = seg == 0 ? CTXL : SEQ, rbase = seg == 0 ? TL + b * CTXL : b * SEQ, nch = len / 16;
            u32x4 g0 = (u32x4){0u, 0u, 0u, 0u}, g1 = g0;
            const int gs = (tid_ & 255) >> 4, gc8 = (tid_ & 15) * 8;
#define HG_GLOAD(c) do { const int st = (c) * 16 + gs, n = dir ? (len - 1 - st) : st; const size_t o = (size_t)(rbase + n) * 1024 + h * 128 + gc8; \
                if (tid_ < 256) { g0 = *(const u32x4*)(BQ + o); g1 = *(const u32x4*)(BF + o); } else { g0 = *(const u32x4*)(BI + o); } } while (0)
#define HG_RAWW(c) do { LAS unsigned char* rw = lds + RAWOFF + ((c) & 1) * RAWSZ + gs * 272 + gc8 * 2; \
                if (tid_ < 256) { *(LAS u32x4*)(rw) = g0; *(LAS u32x4*)(rw + 4352) = g1; } else { *(LAS u32x4*)(rw + 8704) = g0; } } while (0)
#define HG_STAGE(c, bufp) do { float fv[4], cb[4]; float run = 0.f; unsigned short rq[4], rf[4], ri[4]; \
                { const LAS unsigned char* rr = lds + RAWOFF + ((c) & 1) * RAWSZ + kch * 2; _Pragma("unroll") for (int j = 0; j < 4; ++j) { rq[j] = *(const LAS bf16_t*)(rr + (4 * q + j) * 272); rf[j] = *(const LAS bf16_t*)(rr + 4352 + (4 * q + j) * 272); ri[j] = *(const LAS bf16_t*)(rr + 8704 + (4 * q + j) * 272); } } \
                _Pragma("unroll") for (int j = 0; j < 4; ++j) { const float xf = __uint_as_float(((unsigned)rf[j]) << 16); fv[j] = lbv + (1.0f - lbv) * fast_sigmoid(xf); run += flog(fv[j]); cb[j] = run; } \
                const float t0 = __shfl(run, m), t1 = __shfl(run, m + 16), t2 = __shfl(run, m + 32); \
                const float off = (q > 0 ? t0 : 0.f) + (q > 1 ? t1 : 0.f) + (q > 2 ? t2 : 0.f); \
                float qh[4], kh[4]; \
                _Pragma("unroll") for (int j = 0; j < 4; ++j) { const float bb = off + cb[j], bc = fmaxf(bb, -80.0f); qh[j] = __uint_as_float(((unsigned)rq[j]) << 16) * fexp(bc); kh[j] = (1.0f - fv[j]) * fexp(-bc);     \
                    if (j == 3 && q == 3) *(LAS float*)((bufp) + OE + kch * 4) = fexp(bb); } \
                const unsigned q01 = cvt_pk_bf16(qh[0], qh[1]), q23 = cvt_pk_bf16(qh[2], qh[3]), k01 = cvt_pk_bf16(kh[0], kh[1]), k23 = cvt_pk_bf16(kh[2], kh[3]); \
                *(LAS bf16_t*)((bufp) + OQ + (4 * q + 0) * 272 + kch * 2) = (bf16_t)(q01 & 0xffffu); *(LAS bf16_t*)((bufp) + OQ + (4 * q + 1) * 272 + kch * 2) = (bf16_t)(q01 >> 16); \
                *(LAS bf16_t*)((bufp) + OQ + (4 * q + 2) * 272 + kch * 2) = (bf16_t)(q23 & 0xffffu); *(LAS bf16_t*)((bufp) + OQ + (4 * q + 3) * 272 + kch * 2) = (bf16_t)(q23 >> 16); \
                *(LAS bf16_t*)((bufp) + OKH + (4 * q + 0) * 272 + kch * 2) = (bf16_t)(k01 & 0xffffu); *(LAS bf16_t*)((bufp) + OKH + (4 * q + 1) * 272 + kch * 2) = (bf16_t)(k01 >> 16); \
                *(LAS bf16_t*)((bufp) + OKH + (4 * q + 2) * 272 + kch * 2) = (bf16_t)(k23 & 0xffffu); *(LAS bf16_t*)((bufp) + OKH + (4 * q + 3) * 272 + kch * 2) = (bf16_t)(k23 >> 16); \
                u32x2 kt2; kt2.x = k01; kt2.y = k23; *(LAS u32x2*)((bufp) + OKT + kch * 48 + q * 8) = kt2; \
                u32x2 it2; it2.x = (unsigned)ri[0] | ((unsigned)ri[1] << 16); it2.y = (unsigned)ri[2] | ((unsigned)ri[3] << 16); *(LAS u32x2*)((bufp) + OIT + kch * 48 + q * 8) = it2; } while (0)
#define HG_COMPUTE(c) do { \
                LAS unsigned char* buf = lds + ((c) & 1) * BUFSZ; \
                f32x4 at = (f32x4){0.f, 0.f, 0.f, 0.f}; \
                _Pragma("unroll") \
                for (int kb = 0; kb < 4; ++kb) { const bf16x8 a = *(const LAS bf16x8*)(buf + OKH + m * 272 + kb * 64 + q * 16), bq = *(const LAS bf16x8*)(buf + OQ + m * 272 + kb * 64 + q * 16); \
                    at = __builtin_amdgcn_mfma_f32_16x16x32_bf16(a, bq, at, 0, 0, 0); } \
                asm volatile("s_nop 15\n s_nop 15" : "+v"(at)); \
                _Pragma("unroll") \
                for (int r = 0; r < 4; ++r) at[r] = (4 * q + r <= m) ? at[r] : 0.f; \
                const bf16x8 attB = mk_bf16x8(cvt_pk_bf16(at[0], at[1]), cvt_pk_bf16(at[2], at[3]), 0u, 0u); \
                f32x4 oacc = (f32x4){0.f, 0.f, 0.f, 0.f}; \
                _Pragma("unroll") \
                for (int kb = 0; kb < 4; ++kb) { \
                    const bf16x8 a = mk_bf16x8(cvt_pk_bf16(Sacc[2 * kb][0], Sacc[2 * kb][1]), cvt_pk_bf16(Sacc[2 * kb][2], Sacc[2 * kb][3]), cvt_pk_bf16(Sacc[2 * kb + 1][0], Sacc[2 * kb + 1][1]), cvt_pk_bf16(Sacc[2 * kb + 1][2], Sacc[2 * kb + 1][3])); \
                    const u32x2 b0 = *(const LAS u32x2*)(buf + OQ + m * 272 + (32 * kb + 4 * q) * 2), b1 = *(const LAS u32x2*)(buf + OQ + m * 272 + (32 * kb + 16 + 4 * q) * 2); \
                    oacc = __builtin_amdgcn_mfma_f32_16x16x32_bf16(a, mk_bf16x8(b0.x, b0.y, b1.x, b1.y), oacc, 0, 0, 0); } \
                { const u32x2 i0 = *(const LAS u32x2*)(buf + OIT + (16 * w + m) * 48 + q * 8); \
                  oacc = __builtin_amdgcn_mfma_f32_16x16x32_bf16(mk_bf16x8(i0.x, i0.y, 0u, 0u), attB, oacc, 0, 0, 0); } \
                asm volatile("s_nop 15\n s_nop 15" : "+v"(oacc)); \
                { const int st = (c) * 16 + m, n = dir ? (len - 1 - st) : st; \
                  u32x2 o2; o2.x = cvt_pk_bf16(oacc[0], oacc[1]); o2.y = cvt_pk_bf16(oacc[2], oacc[3]); \
                  if (!dry || p.ws == nullptr) *(u32x2*)(BF + (size_t)(rbase + n) * 1024 + h * 128 + 16 * w + 4 * q) = o2; } \
                u32x4 bsu = (u32x4){0u, 0u, 0u, 0u}; \
                if (q < 2) bsu = *(const LAS u32x4*)(buf + OIT + (16 * w + m) * 48 + q * 16); \
                const bf16x8 bs = __builtin_bit_cast(bf16x8, bsu); \
                _Pragma("unroll") \
                for (int kt = 0; kt < 8; ++kt) { u32x4 au = (u32x4){0u, 0u, 0u, 0u}; \
                    if (q < 2) au = *(const LAS u32x4*)(buf + OKT + (16 * kt + m) * 48 + q * 16); \
                    Sacc[kt] = __builtin_amdgcn_mfma_f32_16x16x32_bf16(__builtin_bit_cast(bf16x8, au), bs, Sacc[kt], 0, 0, 0); } \
                asm volatile("s_nop 15\n s_nop 15" : "+v"(Sacc[0]), "+v"(Sacc[1]), "+v"(Sacc[2]), "+v"(Sacc[3]), "+v"(Sacc[4]), "+v"(Sacc[5]), "+v"(Sacc[6]), "+v"(Sacc[7])); \
                _Pragma("unroll") \
                for (int kt = 0; kt < 8; ++kt) Sacc[kt] *= *(const LAS f32x4*)(buf + OE + (16 * kt + 4 * q) * 4); \
                } while (0)
            HG_GLOAD(0); HG_RAWW(0);
            if (nch > 1) { HG_GLOAD(1); HG_RAWW(1); }
            if (nch > 2) HG_GLOAD(2);
            __syncthreads();
            HG_STAGE(0, lds);
            __syncthreads();
            for (int c = 0; c < nch; ++c) {
                if (c + 2 < nch) { HG_RAWW(c + 2); if (c + 3 < nch) HG_GLOAD(c + 3); }
                if (c + 1 < nch) HG_STAGE(c + 1, lds + ((c + 1) & 1) * BUFSZ);
                HG_COMPUTE(c);
                __syncthreads();
            }
#undef HG_COMPUTE
#undef HG_GLOAD
#undef HG_RAWW
#undef HG_STAGE
        }
        __syncthreads();
    }
}
__device__ __forceinline__ void phase_hcomb(const Params& p, int l, int M, bool dry = false) {
    const int tid_ = otid();
    const int lane = tid_ & 63, gw = blockIdx.x * 8 + __builtin_amdgcn_readfirstlane(tid_ >> 6), nw = gridDim.x * 8;
    unsigned char* P = p.ws + OFF_P;
    bf16_t* OF = (bf16_t*)(P + P_BFF); const bf16_t* OB = (const bf16_t*)(P + P_BFB); const bf16_t* BG = (const bf16_t*)(P + P_BG);
    const float* hg = p.hn_g + (size_t)l * 1024 + lane * 16;
    for (int r = gw; r < M; r += nw) {
        const size_t o = (size_t)r * 1024 + lane * 16;
        float x[16]; float ss = 0.f;
#pragma unroll
        for (int hh = 0; hh < 2; ++hh) { const u32x4 a = *(const u32x4*)(OF + o + hh * 8), bq = *(const u32x4*)(OB + o + hh * 8);
            const unsigned aa[4] = {a.x, a.y, a.z, a.w}, bb[4] = {bq.x, bq.y, bq.z, bq.w};
#pragma unroll
            for (int j = 0; j < 4; ++j) { x[hh * 8 + 2 * j] = bf_lo(aa[j]) + bf_lo(bb[j]); x[hh * 8 + 2 * j + 1] = bf_hi(aa[j]) + bf_hi(bb[j]); } }
#pragma unroll
        for (int j = 0; j < 16; ++j) ss += x[j] * x[j];
        ss += __shfl_xor(ss, 1); ss += __shfl_xor(ss, 2); ss += __shfl_xor(ss, 4);
        const float rs = rsqrtf(ss * (1.0f / 128.0f) + 1e-6f);
#pragma unroll
        for (int hh = 0; hh < 2; ++hh) { const u32x4 gq = *(const u32x4*)(BG + o + hh * 8); const unsigned gg[4] = {gq.x, gq.y, gq.z, gq.w};
            float y[8];
#pragma unroll
            for (int j = 0; j < 4; ++j) { y[2 * j] = x[hh * 8 + 2 * j] * rs * hg[hh * 8 + 2 * j] * bf_lo(gg[j]); y[2 * j + 1] = x[hh * 8 + 2 * j + 1] * rs * hg[hh * 8 + 2 * j + 1] * bf_hi(gg[j]); }
            u32x4 w; w.x = cvt_pk_bf16(y[0], y[1]); w.y = cvt_pk_bf16(y[2], y[3]); w.z = cvt_pk_bf16(y[4], y[5]); w.w = cvt_pk_bf16(y[6], y[7]);
            if (!dry || p.ws == nullptr) *(u32x4*)(OF + o + hh * 8) = w; }
    }
}

__device__ __forceinline__ bf16x8 pack_bf16x8(const float (&v)[8]) {
    const unsigned a = cvt_pk_bf16(v[0], v[1]), b = cvt_pk_bf16(v[2], v[3]), c = cvt_pk_bf16(v[4], v[5]), d = cvt_pk_bf16(v[6], v[7]);
    u32x4 q; q.x = a; q.y = b; q.z = c; q.w = d;
    return __builtin_bit_cast(bf16x8, q);
}
__device__ __forceinline__ void phase_s5(const Params& p, int l, LAS unsigned char* lds) {
    const int tid_ = otid();
    const int lane = tid_ & 63, w = __builtin_amdgcn_readfirstlane(tid_ >> 6);
    if (w >= 6) return;
    LAS float* BU = (LAS float*)(lds + w * 12800);
    LAS unsigned char* XB = lds + w * 12800 + 8448;
    const int lq = lane >> 4, lr = lane & 15;
    const bf16_t* CU = (const bf16_t*)(p.ws + OFF_P + P_CU);
    const float* s5lam = (const float*)(p.ws + OFF_S5LAM); const float* s5bb = (const float*)(p.ws + OFF_S5BB);
    for (int s = w * (int)gridDim.x + (int)blockIdx.x; s < 1536; s += 6 * (int)gridDim.x) {
        const int dir = s & 1, g = (s >> 1) % 48, b = s / 96;
        const int ldg = (l * 2 + dir) * 48 + g;
        const float lre = s5lam[(size_t)(ldg * 64 + lane) * 2], lim = s5lam[(size_t)(ldg * 64 + lane) * 2 + 1];
        bf16x8 bbf[8], cf[4];
#pragma unroll
        for (int nt = 0; nt < 8; ++nt) { const int col = nt * 16 + lr, pp = col >> 1, c = col & 1; float v[8];
#pragma unroll
            for (int j = 0; j < 8; ++j) v[j] = (lq < 2) ? s5bb[(size_t)(ldg * 64 + pp) * 32 + c * 16 + lq * 8 + j] : 0.f;
            bbf[nt] = pack_bf16x8(v); }
#pragma unroll
        for (int kb = 0; kb < 4; ++kb) { float v[8];
#pragma unroll
            for (int j = 0; j < 8; ++j) { const int k = kb * 32 + lq * 8 + j, pp = k >> 1; const size_t ci = ((size_t)ldg * 16 + lr) * 64 + pp;
                v[j] = (k & 1) ? -p.c_im[ci] : p.c_re[ci]; }
            cf[kb] = pack_bf16x8(v); }
        bf16_t* YS = (bf16_t*)(p.ws + OFF_H + (dir ? H_YSB : H_YSF));
        float xr = 0.f, xi = 0.f;
        for (int seg = 0; seg < 2; ++seg) {
            const int len = seg == 0 ? CTXL : SEQ, rbase = seg == 0 ? TL + b * CTXL : b * SEQ, nblk = len / 64;
            u32x4 unext[4];
#pragma unroll
            for (int tt = 0; tt < 4; ++tt) { unext[tt] = (u32x4){0u, 0u, 0u, 0u};
                if (lq < 2) { const int st = tt * 16 + lr, n = dir ? (len - 1 - st) : st; unext[tt] = *(const u32x4*)(CU + (size_t)(rbase + n) * 768 + g * 16 + lq * 8); } }
            for (int blk = 0; blk < nblk; ++blk) {
                u32x4 ucur[4];
#pragma unroll
                for (int tt = 0; tt < 4; ++tt) ucur[tt] = unext[tt];
                if (blk + 1 < nblk && lq < 2) {
#pragma unroll
                    for (int tt = 0; tt < 4; ++tt) { const int st = (blk + 1) * 64 + tt * 16 + lr, n = dir ? (len - 1 - st) : st; unext[tt] = *(const u32x4*)(CU + (size_t)(rbase + n) * 768 + g * 16 + lq * 8); } }
#pragma unroll
                for (int tt = 0; tt < 4; ++tt) {
                    const bf16x8 uf = __builtin_bit_cast(bf16x8, ucur[tt]);
                    f32x4 dd[8];
#pragma unroll
                    for (int nt = 0; nt < 8; ++nt) dd[nt] = __builtin_amdgcn_mfma_f32_16x16x32_bf16(bbf[nt], uf, (f32x4){0.f, 0.f, 0.f, 0.f}, 0, 0, 0);
                    asm volatile("s_nop 15\n s_nop 15" : "+v"(dd[0]), "+v"(dd[1]), "+v"(dd[2]), "+v"(dd[3]), "+v"(dd[4]), "+v"(dd[5]), "+v"(dd[6]), "+v"(dd[7]));
#pragma unroll
                    for (int nt = 0; nt < 8; ++nt) *(LAS f32x4*)(BU + lr * 132 + nt * 16 + lq * 4) = dd[nt];
                    asm volatile("s_waitcnt lgkmcnt(0)" ::: "memory");
                    f32x2 bu[16];
#pragma unroll
                    for (int t = 0; t < 16; ++t) bu[t] = *(const LAS f32x2*)(BU + t * 132 + 2 * lane);
#pragma unroll
                    for (int t = 0; t < 16; ++t) { const float nr = lre * xr - lim * xi + bu[t].x, ni = lre * xi + lim * xr + bu[t].y; xr = nr; xi = ni;
                        *(LAS unsigned*)(XB + t * 272 + lane * 4) = cvt_pk_bf16(xr, xi); }
                    asm volatile("s_waitcnt lgkmcnt(0)" ::: "memory");
                    f32x4 acc = (f32x4){0.f, 0.f, 0.f, 0.f};
#pragma unroll
                    for (int kb = 0; kb < 4; ++kb) { const bf16x8 xf = *(const LAS bf16x8*)(XB + lr * 272 + kb * 64 + lq * 16); acc = __builtin_amdgcn_mfma_f32_16x16x32_bf16(cf[kb], xf, acc, 0, 0, 0); }
                    asm volatile("s_nop 15\n s_nop 15\n s_waitcnt lgkmcnt(0)" : "+v"(acc) :: "memory");
                    const int st = blk * 64 + tt * 16 + lr, n = dir ? (len - 1 - st) : st;
                    u32x2 o; o.x = cvt_pk_bf16(acc[0], acc[1]); o.y = cvt_pk_bf16(acc[2], acc[3]);
                    *(u32x2*)(YS + (size_t)(rbase + n) * 768 + g * 16 + lq * 4) = o;
                }
            }
        }
    }
}
__device__ __forceinline__ void phase_s5post(const Params& p, int l, int M, bool dry = false) {
    const int tid_ = otid();
    const size_t n8 = (size_t)M * 768 / 8;
    bf16_t* YF = (bf16_t*)(p.ws + OFF_H + H_YSF); const bf16_t* YB = (const bf16_t*)(p.ws + OFF_H + H_YSB); const bf16_t* CU = (const bf16_t*)(p.ws + OFF_P + P_CU);
    const float* dsk = p.s5_d + (size_t)l * 768;
    for (size_t i = (size_t)blockIdx.x * NTHREADS + tid_; i < n8; i += (size_t)gridDim.x * NTHREADS) {
        const int c = (int)((i * 8) % 768);
        const u32x4 a = *(const u32x4*)(YF + i * 8), bq = *(const u32x4*)(YB + i * 8), uq = *(const u32x4*)(CU + i * 8);
        const unsigned aa[4] = {a.x, a.y, a.z, a.w}, bb[4] = {bq.x, bq.y, bq.z, bq.w}, uu[4] = {uq.x, uq.y, uq.z, uq.w};
        float y[8];
#pragma unroll
        for (int j = 0; j < 4; ++j) { y[2 * j] = gelu_f(bf_lo(aa[j]) + bf_lo(bb[j]) + dsk[c + 2 * j] * bf_lo(uu[j])); y[2 * j + 1] = gelu_f(bf_hi(aa[j]) + bf_hi(bb[j]) + dsk[c + 2 * j + 1] * bf_hi(uu[j])); }
        u32x4 w; w.x = cvt_pk_bf16(y[0], y[1]); w.y = cvt_pk_bf16(y[2], y[3]); w.z = cvt_pk_bf16(y[4], y[5]); w.w = cvt_pk_bf16(y[6], y[7]);
        if (!dry || p.ws == nullptr) *(u32x4*)(YF + i * 8) = w;
    }
}

__device__ __forceinline__ void phase_gmlp(const Params& p, int l, int M, LAS unsigned char* lds, bool dry = false) {
    const int tid_ = otid();
    LAS unsigned char* Wb = lds;
    LAS unsigned char* Vt = lds + 34816;
    LAS float* st = (LAS float*)(lds + 69632);
    const int tid = tid_, lane = tid & 63, w = __builtin_amdgcn_readfirstlane(tid_ >> 6), q = lane >> 4, m = lane & 15;
    bf16_t* AU = (bf16_t*)(p.ws + OFF_P + P_AU); const bf16_t* AV = (const bf16_t*)(p.ws + OFF_P + P_AV);
    const float* lng = p.ln_g + (size_t)l * 1024; const float* lnb = p.ln_b + (size_t)l * 1024;
    const int nch = M / 128, G_ = (int)gridDim.x, nfull = (nch / G_) * G_, nitem = nfull + (nch - nfull) * 8;
    for (int it = blockIdx.x; it < nitem; it += G_) {
        const int u = it < nfull ? it : nfull + ((it - nfull) >> 3), g0 = it < nfull ? 0 : ((it - nfull) & 7), g1 = it < nfull ? 8 : g0 + 1;
        const size_t r0 = (size_t)u * 128;
        for (int i = 0; i < 16; ++i) {
            const int s = w * 16 + i; const bf16_t* rp = AV + (r0 + s) * 1024 + lane * 16;
            const u32x4 a = *(const u32x4*)rp, bq = *(const u32x4*)(rp + 8);
            const unsigned aa[8] = {a.x, a.y, a.z, a.w, bq.x, bq.y, bq.z, bq.w};
            float sm = 0.f, sq = 0.f;
#pragma unroll
            for (int j = 0; j < 8; ++j) { const float x0 = bf_lo(aa[j]), x1 = bf_hi(aa[j]); sm += x0 + x1; sq += x0 * x0 + x1 * x1; }
            sm = wave_sum(sm); sq = wave_sum(sq);
            const float mean = sm * (1.0f / 1024.0f), var = fmaxf(sq * (1.0f / 1024.0f) - mean * mean, 0.f);
            if (lane == 0) { st[s * 2] = mean; st[s * 2 + 1] = rsqrtf(var + 1e-6f); }
        }
        __syncthreads();
        for (int g = g0; g < g1; ++g) {
            { const int t = tid >> 2, s0 = (tid & 3) * 32; const float* ws = p.w_s + ((size_t)l * 8 + g) * 16384 + t * 128 + s0;
#pragma unroll
              for (int qq = 0; qq < 4; ++qq) { const f32x4 a = *(const f32x4*)(ws + qq * 8), b4 = *(const f32x4*)(ws + qq * 8 + 4);
                  u32x4 o; o.x = cvt_pk_bf16(a[0], a[1]); o.y = cvt_pk_bf16(a[2], a[3]); o.z = cvt_pk_bf16(b4[0], b4[1]); o.w = cvt_pk_bf16(b4[2], b4[3]);
                  *(LAS u32x4*)(Wb + t * 272 + (s0 + qq * 8) * 2) = o; } }
            { const int s = tid >> 2, c0 = (tid & 3) * 32; const bf16_t* rp = AV + (r0 + s) * 1024 + g * 128 + c0;
              const float mean = st[s * 2], rstd = st[s * 2 + 1];
#pragma unroll
              for (int qq = 0; qq < 4; ++qq) { const u32x4 a = *(const u32x4*)(rp + qq * 8); const unsigned aa[4] = {a.x, a.y, a.z, a.w};
#pragma unroll
                  for (int j = 0; j < 4; ++j) { const int cl = c0 + qq * 8 + 2 * j, c = g * 128 + cl;
                      const unsigned pk = cvt_pk_bf16((bf_lo(aa[j]) - mean) * rstd * lng[c] + lnb[c], (bf_hi(aa[j]) - mean) * rstd * lng[c + 1] + lnb[c + 1]);
                      *(LAS bf16_t*)(Vt + cl * 272 + s * 2) = (bf16_t)(pk & 0xffffu); *(LAS bf16_t*)(Vt + (cl + 1) * 272 + s * 2) = (bf16_t)(pk >> 16); } } }
            __syncthreads();
            bf16x8 af[4];
#pragma unroll
            for (int kb = 0; kb < 4; ++kb) af[kb] = *(const LAS bf16x8*)(Vt + (16 * w + m) * 272 + kb * 64 + q * 16);
            const float* bs = p.b_s + ((size_t)l * 8 + g) * 128;
#pragma unroll
            for (int tt = 0; tt < 8; ++tt) {
                f32x4 acc = (f32x4){0.f, 0.f, 0.f, 0.f};
#pragma unroll
                for (int kb = 0; kb < 4; ++kb) acc = __builtin_amdgcn_mfma_f32_16x16x32_bf16(af[kb], *(const LAS bf16x8*)(Wb + (16 * tt + m) * 272 + kb * 64 + q * 16), acc, 0, 0, 0);
                const float bb = bs[16 * tt + m];
                bf16_t* up = AU + (r0 + 16 * tt + m) * 1024 + g * 128 + 16 * w + 4 * q;
                const u32x2 uw = *(const u32x2*)up;
                const float y0 = (acc[0] + bb) * bf_lo(uw.x), y1 = (acc[1] + bb) * bf_hi(uw.x), y2 = (acc[2] + bb) * bf_lo(uw.y), y3 = (acc[3] + bb) * bf_hi(uw.y);
                u32x2 o; o.x = cvt_pk_bf16(y0, y1); o.y = cvt_pk_bf16(y2, y3);
                if (!dry || p.ws == nullptr) *(u32x2*)up = o;
            }
            __syncthreads();
        }
    }
}

__device__ __forceinline__ unsigned fkey(float x) { const unsigned b = __float_as_uint(x); return b ^ ((b >> 31) ? 0xFFFFFFFFu : 0x80000000u); }
__device__ __forceinline__ int mbcnt64(unsigned long long m) { return __builtin_amdgcn_mbcnt_hi((unsigned)(m >> 32), __builtin_amdgcn_mbcnt_lo((unsigned)m, 0u)); }
template <int NV>
__device__ __forceinline__ int count_ge(const unsigned (&k)[NV], unsigned cand) {
    int cnt = 0;
#pragma unroll
    for (int i = 0; i < NV; ++i) cnt += __popcll(__ballot(k[i] >= cand));
    return cnt;
}
template <int NV>
__device__ __forceinline__ unsigned radix_thr16(const unsigned (&k)[NV], unsigned e0bits) {
    unsigned prefix = 0u; int bit = 31;
    {
        const unsigned c0 = e0bits ^ 0x80000000u, c1 = c0 + 0x00800000u, c2 = c0 + 0x01000000u, c3 = c0 + 0x01800000u;
        const int n0 = count_ge<NV>(k, c0), n1 = count_ge<NV>(k, c1), n2 = count_ge<NV>(k, c2), n3 = count_ge<NV>(k, c3);
        if (n0 >= 16 && n3 < 16) { prefix = (n2 >= 16) ? c2 : ((n1 >= 16) ? c1 : c0); bit = 22;
            const int nn = (n2 >= 16) ? n2 : ((n1 >= 16) ? n1 : n0); if (nn == 16) bit = -1; }
    }
    for (; bit >= 0; --bit) {
        const unsigned cand = prefix | (1u << bit);
        const int cnt = count_ge<NV>(k, cand);
        if (cnt >= 16) prefix = cand;
        if (cnt == 16) break;
    }
    return prefix;
}
__device__ __forceinline__ unsigned umin_(unsigned a, unsigned b) { return a < b ? a : b; }
__device__ __forceinline__ unsigned umax_(unsigned a, unsigned b) { return a > b ? a : b; }
__device__ __forceinline__ unsigned med3u(unsigned x, unsigned y, unsigned z) { return umax_(umin_(x, y), umin_(umax_(x, y), z)); }
__device__ __forceinline__ float unkey(unsigned k) { return __uint_as_float((k & 0x80000000u) ? (k ^ 0x80000000u) : ~k); }
__device__ __forceinline__ void ins16(unsigned (&a)[16], unsigned x) {
#pragma unroll
    for (int s = 15; s >= 1; --s) a[s] = med3u(a[s - 1], x, a[s]);
    a[0] = umax_(a[0], x);
}
__device__ __forceinline__ unsigned sel16(const unsigned (&a)[16], int i) {
    unsigned r = a[0];
#pragma unroll
    for (int t = 1; t < 16; ++t) r = (i == t) ? a[t] : r;
    return r;
}
__device__ __forceinline__ void phase_topk(const Params& p, int M, LAS unsigned char* lds) {
    const int tid_ = otid();
    LAS unsigned* lk = (LAS unsigned*)lds + tid_;
    const int gl = blockIdx.x * NTHREADS + tid_, nl = gridDim.x * NTHREADS;
    const float* SC = (const float*)(p.ws + OFF_P + Q_SC);
    int* IDX = (int*)(p.ws + OFF_P + Q_IDX); float* GATE = (float*)(p.ws + OFF_P + Q_GATE);
    const int ntask = M * 8;
    for (int task = gl; task < ntask; task += nl) {
        const float* sc = SC + (size_t)task * 256;
        unsigned a[16], b[16];
#pragma unroll
        for (int i = 0; i < 16; ++i) { a[i] = 0u; b[i] = 0u; }
#pragma unroll 4
        for (int i4 = 0; i4 < 32; ++i4) {
            const f32x4 va = *(const f32x4*)(sc + i4 * 4), vb = *(const f32x4*)(sc + 128 + i4 * 4);
#pragma unroll
            for (int e = 0; e < 4; ++e) { const unsigned tag = 127u - (unsigned)(i4 * 4 + e);
                ins16(a, (fkey(va[e]) & ~127u) | tag); ins16(b, (fkey(vb[e]) & ~127u) | tag); }
        }
        float fa[16], fb[16];
#pragma unroll
        for (int i = 0; i < 16; ++i) { fa[i] = unkey(a[i] & ~127u); fb[i] = unkey(b[i] & ~127u); }
        unsigned c[16];
#pragma unroll
        for (int i = 0; i < 16; ++i) c[i] = 0u;
#pragma unroll
        for (int i = 0; i < 16; ++i)
#pragma unroll
            for (int j = 0; j < 16; ++j)
                if ((i + 1) * (j + 1) <= 16) ins16(c, (fkey(fa[i] + fb[j]) & ~255u) | (unsigned)(i * 16 + j));
#pragma unroll
        for (int i = 0; i < 16; ++i) { lk[i * 512] = a[i]; lk[(16 + i) * 512] = b[i]; }
        const float mx = unkey(c[0] & ~255u);
        float ev[16]; float sm = 0.f; int id[16];
#pragma unroll
        for (int s = 0; s < 16; ++s) { ev[s] = __expf(unkey(c[s] & ~255u) - mx); sm += ev[s];
            const int ij = (int)(c[s] & 255u);
            const unsigned ka = lk[(ij >> 4) * 512], kb = lk[(16 + (ij & 15)) * 512];
            id[s] = (int)(127u - (ka & 127u)) * 128 + (int)(127u - (kb & 127u)); }
        const float inv = 1.0f / sm;
#pragma unroll
        for (int q = 0; q < 4; ++q) {
            u32x4 iw; iw.x = (unsigned)id[4 * q]; iw.y = (unsigned)id[4 * q + 1]; iw.z = (unsigned)id[4 * q + 2]; iw.w = (unsigned)id[4 * q + 3];
            *(u32x4*)(IDX + (size_t)task * 16 + q * 4) = iw;
            *(f32x4*)(GATE + (size_t)task * 16 + q * 4) = (f32x4){ev[4 * q] * inv, ev[4 * q + 1] * inv, ev[4 * q + 2] * inv, ev[4 * q + 3] * inv};
        }
    }
}

__device__ __forceinline__ float dot2u(unsigned a, unsigned b, float acc) {
    return __builtin_amdgcn_fdot2_f32_bf16(__builtin_bit_cast(bf16x2_t, a), __builtin_bit_cast(bf16x2_t, b), acc, false);
}
__device__ __forceinline__ float dot8(const u32x4 a, const u32x4 b, float acc) {
    acc = dot2u(a.x, b.x, acc); acc = dot2u(a.y, b.y, acc); acc = dot2u(a.z, b.z, acc); acc = dot2u(a.w, b.w, acc);
    return acc;
}
__device__ __forceinline__ void phase_peer(const Params& p, int l, int M, LAS unsigned char* lds, bool dry = false) {
    const int tid_ = otid();
    const int lane = tid_ & 63, wv_ = __builtin_amdgcn_readfirstlane(tid_ >> 6), gw = blockIdx.x * 8 + wv_, nw = gridDim.x * 8;
    LAS float* wl = (LAS float*)(lds + wv_ * 512);
    const bf16_t* H = (const bf16_t*)(p.ws + OFF_H);
    const unsigned char* U6 = p.ws + OFF_P + Q_UT; const unsigned char* V6 = p.ws + OFF_P + Q_VT;
    const float* USC = (const float*)(p.ws + OFF_P + Q_USC); const float* VSC = (const float*)(p.ws + OFF_P + Q_VSC);
    const int* IDX = (const int*)(p.ws + OFF_P + Q_IDX); const float* GATE = (const float*)(p.ws + OFF_P + Q_GATE);
    const float* modl = (const float*)(p.ws + OFF_MODV) + (size_t)l * 17 * NMOD + 10240;
    float* XC = (float*)(p.ws + OFF_XC);
    const unsigned lane24 = (unsigned)lane * 24u;
#define PEER_LOAD(buf, TAB, g) do { const int _is = ((g) < 8) ? id0 : id1; _Pragma("unroll") for (int e = 0; e < 8; ++e) { \
        const int _id = __builtin_amdgcn_readlane(_is, (((g) * 8 + e) & 63)); const unsigned char* _rb = (TAB) + (size_t)(unsigned)_id * 1536u; \
        const u32x4 _a = *(const u32x4*)(_rb + lane24); const u32x2 _b = *(const u32x2*)(_rb + lane24 + 16); \
        buf[e][0] = _a.x; buf[e][1] = _a.y; buf[e][2] = _a.z; buf[e][3] = _a.w; buf[e][4] = _b.x; buf[e][5] = _b.y; } } while (0)
    for (int row = gw; row < M; row += nw) {
        unsigned xw[16];
#pragma unroll
        for (int j = 0; j < 8; ++j) { const u32x2 a = *(const u32x2*)(H + (size_t)row * D + j * 256 + lane * 4); xw[2 * j] = a.x; xw[2 * j + 1] = a.y; }
        const int id0 = IDX[(size_t)row * 128 + lane], id1 = IDX[(size_t)row * 128 + 64 + lane];
        const float g0 = GATE[(size_t)row * 128 + lane], g1 = GATE[(size_t)row * 128 + 64 + lane];
        const float us0 = USC[id0], us1 = USC[id1];
        const float gv0 = g0 * VSC[id0], gv1 = g1 * VSC[id1];
        u32x6 bA[8];
#pragma unroll 1
        for (int g = 0; g < 16; ++g) {
            PEER_LOAD(bA, U6, g);
            float part[8];
            float chain = 0.f;
#pragma unroll
            for (int e = 0; e < 8; ++e) { asm volatile("" : "+v"(bA[e]), "+v"(chain));
                const bf16x32_t ub = __builtin_amdgcn_cvt_scalef32_pk32_bf16_fp6(bA[e], 1.0f);
                const u32x16 uw = __builtin_bit_cast(u32x16, ub);
                float a0 = 0.f, a1 = 0.f;
#pragma unroll
                for (int i = 0; i < 8; ++i) { const unsigned w0 = uw[2 * i], w1 = uw[2 * i + 1]; a0 = dot2u(w0, xw[2 * i], a0); a1 = dot2u(w1, xw[2 * i + 1], a1); }
                part[e] = a0 + a1; chain = part[e]; }
            float r4[4];
#pragma unroll
            for (int i = 0; i < 4; ++i) { const bool hi = (lane & 32) != 0; const float keep = hi ? part[i + 4] : part[i], send = hi ? part[i] : part[i + 4]; r4[i] = keep + __shfl_xor(send, 32); }
            float r2[2];
#pragma unroll
            for (int i = 0; i < 2; ++i) { const bool hi = (lane & 16) != 0; const float keep = hi ? r4[i + 2] : r4[i], send = hi ? r4[i] : r4[i + 2]; r2[i] = keep + __shfl_xor(send, 16); }
            float r1;
            { const bool hi = (lane & 8) != 0; const float keep = hi ? r2[1] : r2[0], send = hi ? r2[0] : r2[1]; r1 = keep + __shfl_xor(send, 8); }
            r1 += __shfl_xor(r1, 4); r1 += __shfl_xor(r1, 2); r1 += __shfl_xor(r1, 1);
            const int k = g * 8 + ((lane >> 3) & 7);
            const float usk = __shfl((g < 8) ? us0 : us1, k & 63), gvk = __shfl((g < 8) ? gv0 : gv1, k & 63);
            if ((lane & 7) == 0) wl[k] = gelu_f(r1 * usk) * gvk;
        }
        asm volatile("s_waitcnt lgkmcnt(0)" ::: "memory");
        float out[32];
#pragma unroll
        for (int i = 0; i < 32; ++i) out[i] = 0.f;
#pragma unroll 1
        for (int g = 0; g < 16; ++g) {
            PEER_LOAD(bA, V6, g);
#pragma unroll
            for (int e = 0; e < 8; ++e) { const float wk = wl[g * 8 + e]; asm volatile("" : "+v"(bA[e]), "+v"(out[0]), "+v"(out[9]), "+v"(out[18]), "+v"(out[27]), "+v"(out[31]));
                const f32x32 un = __builtin_amdgcn_cvt_scalef32_pk32_f32_fp6(bA[e], 1.0f);
#pragma unroll
                for (int i = 0; i < 32; ++i) out[i] += wk * un[i]; }
        }
        asm volatile("s_waitcnt lgkmcnt(0)" ::: "memory");
        const bool lat = row < TL; const int mb = lat ? (row >> 11) : 16;
        float* xp = lat ? p.out + (size_t)row * D : XC + (size_t)(row - TL) * D;
        const float* gv = modl + (size_t)mb * NMOD;
        f32x4 xn[8]; float ss = 0.f;
#pragma unroll
        for (int j = 0; j < 8; ++j) { const int e = j * 256 + lane * 4;
            const f32x4 o4 = (f32x4){out[4 * j], out[4 * j + 1], out[4 * j + 2], out[4 * j + 3]};
            xn[j] = *(const f32x4*)(xp + e) + *(const f32x4*)(gv + e) * o4;
            ss += xn[j][0] * xn[j][0] + xn[j][1] * xn[j][1] + xn[j][2] * xn[j][2] + xn[j][3] * xn[j][3]; }
        ss = wave_sum(ss);
        const float rs = rsqrtf(ss * (1.0f / 2048.0f) + 1e-6f);
        if (!dry || p.ws == nullptr) {
            if (l == 0) {
                const float* m1 = (const float*)(p.ws + OFF_MODV) + (size_t)17 * NMOD + (size_t)mb * NMOD;
                float am = 0.f;
#pragma unroll
                for (int j = 0; j < 8; ++j) { const int e = j * 256 + lane * 4;
                    *(f32x4*)(xp + e) = xn[j];
                    xn[j] = xn[j] * rs * (*(const f32x4*)(m1 + 2048 + e) + 1.0f) + *(const f32x4*)(m1 + e);
                    am = fmaxf(am, fmaxf(fmaxf(fabsf(xn[j][0]), fabsf(xn[j][1])), fmaxf(fabsf(xn[j][2]), fabsf(xn[j][3])))); }
#pragma unroll
                for (int o = 32; o >= 1; o >>= 1) am = fmaxf(am, __shfl_xor(am, o));
                const float qs = am > 0.f ? 240.0f / am : 1.0f;
                unsigned char* H8 = p.ws + OFF_H8 + (size_t)row * D;
#pragma unroll
                for (int j = 0; j < 8; ++j) *(unsigned*)(H8 + j * 256 + lane * 4) = pack_fp8x4(xn[j][0] * qs, xn[j][1] * qs, xn[j][2] * qs, xn[j][3] * qs);
                if (lane == 0) ((float*)(p.ws + OFF_HS))[row] = am > 0.f ? am * (1.0f / 240.0f) : 1.0f;
            } else {
#pragma unroll
                for (int j = 0; j < 8; ++j) { const int e = j * 256 + lane * 4; *(f32x4*)(xp + e) = xn[j] * rs * *(const f32x4*)(p.final_g + e); }
            }
        }
    }
#undef PEER_LOAD
}

__device__ __forceinline__ Params load_params() {
    Params r;
#if defined(__HIP_DEVICE_COMPILE__)
    typedef const unsigned long long __attribute__((address_space(4)))* KP;
    KP k = (KP)__builtin_amdgcn_kernarg_segment_ptr();
    asm volatile("" : "+s"(k));
    void** d = (void**)&r;
#pragma unroll
    for (int i = 0; i < (int)(sizeof(Params) / 8); ++i) d[i] = (void*)(__attribute__((address_space(1))) void*)k[i];
#endif
    return r;
}
#define WSP(off) (p.ws + (off))
template <int l>
__device__ __forceinline__ void mega_layer(LAS unsigned char* lds, const XcdBarrier& bar) {
        const int Mrows = (l == 0) ? TT : TL;
        const int GLU_ROT = (((Mrows / 256) * 6) % (int)gridDim.x) & ~7;
        if (l == 0) {
            { const Params p = load_params(); phase_wconv(p, 0, lds); }
            { const Params p = load_params(); phase_norm<0, true>(p, 0, TT, 0, 2048); }
            xcd_barrier(bar);
        }
        { const Params p = load_params(); EpiInProj E{WSP(OFF_P), (const float*)WSP(OFF_HS), (const unsigned*)WSP(OFF_CMAX) + (size_t)l * INC};
          run_gemm(lds, (const bf16_t*)WSP(OFF_H8), (const bf16_t*)WSP(OFF_W + W_IN), TT, INC, D / 2, E); }
        xcd_barrier(bar);
        { const Params p = load_params(); phase_hgrn(p, l, lds); }
        __syncthreads();
        { const Params p = load_params(); phase_s5(p, l, lds); }
        xcd_barrier(bar);
        { const Params p = load_params(); phase_gmlp(p, l, Mrows, lds); }
        { const Params p = load_params(); phase_hcomb(p, l, Mrows); }
        { const Params p = load_params(); phase_s5post(p, l, Mrows); }
        xcd_barrier(bar);
        { const Params p = load_params(); EpiGlu E{(bf16_t*)WSP(OFF_P + P_CU)}; run_gemm(lds, (const bf16_t*)WSP(OFF_H + H_YSF), (const bf16_t*)WSP(OFF_W + W_GLU), Mrows, 1536, 768, E); }
        { const Params p = load_params(); EpiMerge<true> E{(bf16_t*)WSP(OFF_P + P_MERGED), (const bf16_t*)WSP(OFF_P + P_GATES)}; run_gemm(lds, (const bf16_t*)WSP(OFF_P + P_AU), (const bf16_t*)WSP(OFF_W + W_A), Mrows, D, 1024, E, GLU_ROT); }
        { const Params p = load_params(); EpiMerge<false> E{(bf16_t*)WSP(OFF_P + P_MERGED), (const bf16_t*)WSP(OFF_P + P_GATES) + 2048}; run_gemm(lds, (const bf16_t*)WSP(OFF_P + P_BFF), (const bf16_t*)WSP(OFF_W + W_B), Mrows, D, 1024, E, GLU_ROT); }
        xcd_barrier(bar);
        { const Params p = load_params(); EpiMerge<false> E{(bf16_t*)WSP(OFF_P + P_MERGED), (const bf16_t*)WSP(OFF_P + P_GATES) + 4096}; run_gemm(lds, (const bf16_t*)WSP(OFF_P + P_CU), (const bf16_t*)WSP(OFF_W + W_C), Mrows, D, 768, E); }
        xcd_barrier(bar);
        { const Params p = load_params(); EpiResid E{p.out, (float*)WSP(OFF_XC), (const float*)WSP(OFF_MODV) + (size_t)l * 17 * NMOD + 4096}; run_gemm(lds, (const bf16_t*)WSP(OFF_P + P_MERGED), (const bf16_t*)WSP(OFF_W + W_O), Mrows, D, D, E); }
        { const Params p = load_params(); phase_tabconv(p, l); }
        xcd_barrier(bar);
        { const Params p = load_params(); phase_norm<1>(p, l, Mrows, 6144, 8192); }
        xcd_barrier(bar);
        { const Params p = load_params(); EpiF32 E{(float*)WSP(OFF_P + Q_SC), 2048}; run_gemm(lds, (const bf16_t*)WSP(OFF_H), (const bf16_t*)WSP(OFF_W + W_S), Mrows, D, D, E); }
        xcd_barrier(bar);
        { const Params p = load_params(); phase_topk(p, Mrows, lds); }
        xcd_barrier(bar);
        { const Params p = load_params(); phase_peer(p, l, Mrows, lds); }
        if (l == 0) {
            __syncthreads();
            { const Params p = load_params(); phase_wconv(p, 1, lds); }
            xcd_barrier(bar);
        }
}
#undef WSP
__global__ void __launch_bounds__(NTHREADS, 2) k_mega(Params p_kernarg_only) {
    extern __shared__ __attribute__((aligned(16))) unsigned char smem[];
    LAS unsigned char* lds = (LAS unsigned char*)smem;
    volatile LAS unsigned* xbw = (volatile LAS unsigned*)(lds + LDS_BYTES - 16);
    if (threadIdx.x == 0) { xbw[0] = 0u; xbw[1] = 0u; xbw[2] = 0u; xbw[3] = 0u; }
    __syncthreads();
    XcdBarrier bar;
    { const Params p = load_params(); bar = xcd_barrier_post((unsigned*)(p.ws + OFF_BAR), xbw); }
#define WSP(off) (p.ws + (off))
    { const Params p = load_params(); phase_colmax(p); }
    { const Params p = load_params(); phase_prep(p); phase_mod(p, lds); }
    xcd_barrier(bar);
    mega_layer<0>(lds, bar);
    mega_layer<1>(lds, bar);
#undef WSP
}

extern "C" void kernel_launch(void* const* d_in, const int* in_sizes, int n_in, void* d_out, int out_size, void* d_ws, size_t ws_size, hipStream_t stream) {
    (void)in_sizes; (void)n_in; (void)out_size; (void)ws_size;
    Params p;
    const float** f = (const float**)&p;
    for (int i = 0; i < 31; ++i) f[i] = (const float*)d_in[i];
    p.out = (float*)d_out; p.ws = (unsigned char*)d_ws;
    static int grid = 0;
    if (!grid) {
        int dev = 0, cus = 0, per_cu = 0;
        (void)hipGetDevice(&dev);
        (void)hipDeviceGetAttribute(&cus, hipDeviceAttributeMultiprocessorCount, dev);
        (void)hipFuncSetAttribute((const void*)k_mega, hipFuncAttributeMaxDynamicSharedMemorySize, LDS_BYTES);
        (void)hipOccupancyMaxActiveBlocksPerMultiprocessor(&per_cu, (const void*)k_mega, NTHREADS, LDS_BYTES);
        grid = (per_cu >= 1 && cus > 0) ? (cus < 256 ? cus : 256) : 256;
    }
    (void)hipMemsetAsync(p.ws + OFF_BAR, 0, OFF_MODV, stream);
    hipLaunchKernelGGL(k_mega, dim3(grid), dim3(NTHREADS), LDS_BYTES, stream, p);
}
```

```cpp
#include <hip/hip_runtime.h>
#include <stdint.h>

#define LAS __attribute__((address_space(3)))
typedef unsigned short bf16_t;
typedef short bf16x8 __attribute__((ext_vector_type(8)));
typedef float f32x4 __attribute__((ext_vector_type(4)));
typedef float f32x2 __attribute__((ext_vector_type(2)));
typedef unsigned u32x4 __attribute__((ext_vector_type(4)));
typedef unsigned u32x2 __attribute__((ext_vector_type(2)));
typedef __bf16 bf16x2_t __attribute__((ext_vector_type(2)));
typedef __bf16 bf16x32_t __attribute__((ext_vector_type(32)));
typedef float f32x32 __attribute__((ext_vector_type(32)));
typedef unsigned u32x6 __attribute__((ext_vector_type(6)));
typedef unsigned u32x16 __attribute__((ext_vector_type(16)));

constexpr int D = 2048, NB = 16, SEQ = 2048, CTXL = 256;
constexpr int TL = NB * SEQ;
constexpr int TC = NB * CTXL;
constexpr int TT = TL + TC;
constexpr int INC = 14080;
constexpr int NMOD = 12288;
constexpr int NTHREADS = 512;
constexpr int LDS_BYTES = 160 * 1024;

constexpr size_t OFF_BAR = 0;
constexpr size_t OFF_CMAX = 16384;
constexpr size_t OFF_MODV = OFF_CMAX + (size_t)2 * INC * 4;
constexpr size_t OFF_LB = OFF_MODV + (size_t)2 * 17 * NMOD * 4;
constexpr size_t OFF_S5LAM = OFF_LB + 2 * 2 * 1024 * 4;
constexpr size_t OFF_S5BB = OFF_S5LAM + (size_t)2 * 2 * 48 * 64 * 2 * 4;
constexpr size_t OFF_PE = OFF_S5BB + (size_t)2 * 2 * 48 * 64 * 32 * 4;
constexpr size_t OFF_HS = (OFF_PE + (size_t)96 * 1024 * 4 + 255) & ~(size_t)255;
constexpr size_t OFF_XC = (OFF_HS + (size_t)TT * 4 + 255) & ~(size_t)255;
constexpr size_t OFF_H = OFF_XC + (size_t)TC * D * 4;
constexpr size_t OFF_W = OFF_H + (size_t)TT * D * 2;
constexpr size_t W_IN = 0;
constexpr size_t W_GLU = W_IN + (size_t)INC * D;
constexpr size_t W_A = W_GLU + (size_t)1536 * 768 * 2;
constexpr size_t W_B = W_A + (size_t)2048 * 1024 * 2;
constexpr size_t W_C = W_B + (size_t)2048 * 1024 * 2;
constexpr size_t W_O = W_C + (size_t)2048 * 768 * 2;
constexpr size_t W_S = W_O + (size_t)2048 * 2048 * 2;
constexpr size_t W_TOTAL = W_S + (size_t)2048 * 2048 * 2;
constexpr size_t OFF_P = OFF_W + W_TOTAL;
constexpr size_t SEG = (size_t)TT * 1024 * 2;
constexpr size_t P_AU = 0, P_AV = SEG, P_BQ = 2 * SEG, P_BFF = 3 * SEG, P_BFB = 4 * SEG, P_BI = 5 * SEG, P_BG = 6 * SEG;
constexpr size_t P_CU = 7 * SEG;
constexpr size_t P_GATES = P_CU + (size_t)TT * 768 * 2;
constexpr size_t P_TOTAL = P_GATES + (size_t)TT * 6144 * 2;
constexpr size_t P_MERGED = SEG;
constexpr size_t Q_UT = 0;
constexpr size_t Q_VT = Q_UT + (size_t)16384 * 1536;
constexpr size_t Q_USC = Q_VT + (size_t)16384 * 1536;
constexpr size_t Q_VSC = Q_USC + (size_t)16384 * 4;
constexpr size_t Q_SC = Q_VSC + (size_t)16384 * 4;
constexpr size_t Q_IDX = Q_SC + (size_t)TT * 2048 * 4;
constexpr size_t Q_GATE = Q_IDX + (size_t)TT * 128 * 4;
constexpr size_t H_YSF = 0;
constexpr size_t H_YSB = (size_t)TT * 768 * 2;
constexpr size_t OFF_H8 = OFF_P + P_TOTAL;
constexpr size_t WS_NEEDED = OFF_H8 + (size_t)TT * D;

struct Params {
    const float *x, *c, *ctx, *c_ctx, *w_mod, *b_mod, *w_in, *ln_g, *ln_b, *w_s, *b_s, *lb_logits, *hn_g;
    const float *lam_re, *lam_im, *log_step, *b_re, *b_im, *c_re, *c_im, *s5_d, *w_glu, *wa, *wb, *wc, *wo, *w_q, *sub_keys, *peer_u, *peer_v, *final_g;
    float* out;
    unsigned char* ws;
};

__device__ __forceinline__ float bf_lo(unsigned u) { return __uint_as_float(u << 16); }
__device__ __forceinline__ float bf_hi(unsigned u) { return __uint_as_float(u & 0xffff0000u); }
__device__ __forceinline__ unsigned cvt_pk_bf16(float lo, float hi) { f32x2 v; v.x = lo; v.y = hi; const bf16x2_t b = __builtin_convertvector(v, bf16x2_t); return __builtin_bit_cast(unsigned, b); }
__device__ __forceinline__ float fexp(float x) { return __builtin_amdgcn_exp2f(x * 1.44269504f); }
__device__ __forceinline__ float flog(float x) { return __builtin_amdgcn_logf(x) * 0.693147181f; }
__device__ __forceinline__ float fast_sigmoid(float x) { return __builtin_amdgcn_rcpf(1.0f + fexp(-x)); }
__device__ __forceinline__ float fast_silu(float x) { return x * fast_sigmoid(x); }
__device__ __forceinline__ float gelu_f(float v) {
    const float av = fabsf(v), t = __builtin_amdgcn_rcpf(av * 0.2316418882f + 1.0f);
    float q = t * 0.5307027145f + (-0.7265760135f); q = q * t + 0.7107068705f; q = q * t + (-0.142248368f); q = q * t + 0.127414796f; q = q * t;
    const float e = __builtin_amdgcn_exp2f((v * v) * (-0.72134752044f));
    const float m = v * (q * e);
    return v < 0.f ? m : v - m;
}
__device__ __forceinline__ unsigned pack_fp8x4(float a, float b, float c, float d) {
    int pk = 0; pk = __builtin_amdgcn_cvt_pk_fp8_f32(a, b, pk, false); pk = __builtin_amdgcn_cvt_pk_fp8_f32(c, d, pk, true); return (unsigned)pk;
}
template <int CTRL> __device__ __forceinline__ float dpp_f(float v) { return __int_as_float(__builtin_amdgcn_update_dpp(0, __float_as_int(v), CTRL, 0xF, 0xF, false)); }
__device__ __forceinline__ float row16_max(float v) { v = fmaxf(v, dpp_f<0x128>(v)); v = fmaxf(v, dpp_f<0x124>(v)); v = fmaxf(v, dpp_f<0x122>(v)); v = fmaxf(v, dpp_f<0x121>(v)); return v; }
__device__ __forceinline__ float row16_sum(float v) { v += dpp_f<0x128>(v); v += dpp_f<0x124>(v); v += dpp_f<0x122>(v); v += dpp_f<0x121>(v); return v; }
__device__ __forceinline__ float wave_sum(float v) {
#pragma unroll
    for (int o = 32; o >= 1; o >>= 1) v += __shfl_xor(v, o);
    return v;
}
__device__ __forceinline__ int otid() { int t; asm volatile("v_mov_b32 %0, %1" : "=v"(t) : "v"((int)threadIdx.x)); return t; }


#define XB_TMO      128
#define XB_XCNT(j)  (256  + 64 * (j))
#define XB_XSUB(j)  (1280 + 64 * (j))
#define XB_XGEN(j)  (2304 + 64 * (j))
#define XB_TOP      3328
#define XB_TOPGEN   3392
#define XCD_BAR_WORDS 3456
#define XB_SPIN_CAP (1u << 22)
__device__ __forceinline__ unsigned xb_ld(unsigned* p)              { return __hip_atomic_load(p, __ATOMIC_RELAXED, __HIP_MEMORY_SCOPE_AGENT); }
__device__ __forceinline__ unsigned xb_add(unsigned* p, unsigned v) { return __hip_atomic_fetch_add(p, v, __ATOMIC_RELAXED, __HIP_MEMORY_SCOPE_AGENT); }
__device__ __forceinline__ unsigned xb_xcc_id() { return (unsigned)__builtin_amdgcn_s_getreg((3 << 11) | 20) & 0xFu; }
#define XB_SPIN(cond, bar) do { unsigned _sp = 0; while (cond) { __builtin_amdgcn_s_sleep(1); \
    if ((++_sp & 255u) == 0u) { if (xb_ld(&(bar)[XB_TMO])) break; if (_sp > XB_SPIN_CAP) { atomicAdd(&(bar)[XB_TMO], 1u); break; } } } } while (0)
struct XcdBarrier { unsigned* bar; unsigned x; volatile LAS unsigned* st; };
__device__ __forceinline__ XcdBarrier xcd_barrier_post(unsigned* bar, volatile LAS unsigned* st) {
    XcdBarrier b; b.bar = bar; b.x = xb_xcc_id(); b.st = st;
    if (threadIdx.x == 0) (void)xb_add(&bar[XB_XCNT(b.x)], 1u);
    return b;
}
__device__ __forceinline__ void xcd_barrier_complete(unsigned* bar, unsigned x, unsigned& nloc, unsigned& nx) {
    const unsigned G = gridDim.x * gridDim.y * gridDim.z;
    unsigned sum, cnt, mine, sp = 0u;
    for (;;) {
        sum = 0u; cnt = 0u; mine = 0u;
#pragma unroll
        for (unsigned j = 0; j < 16; ++j) { const unsigned c = xb_ld(&bar[XB_XCNT(j)]); sum += c; cnt += (c > 0u) ? 1u : 0u; mine = (j == x) ? c : mine; }
        if (sum == G) break;
        __builtin_amdgcn_s_sleep(1);
        if ((++sp & 255u) == 0u) { if (xb_ld(&bar[XB_TMO])) break; if (sp > XB_SPIN_CAP) { atomicAdd(&bar[XB_TMO], 1u); break; } }
    }
    nloc = mine > 0u ? mine : 1u; nx = cnt > 0u ? cnt : 1u;
}
__device__ __forceinline__ void xcd_barrier(const XcdBarrier& b) {
    asm volatile("s_waitcnt vmcnt(0)" ::: "memory");
    __syncthreads();
    if (threadIdx.x == 0) {
        unsigned* bar = b.bar;
        __builtin_amdgcn_s_waitcnt(0);
        unsigned nloc = b.st[0], nx = b.st[1];
        if (nloc == 0u) { xcd_barrier_complete(bar, b.x, nloc, nx); b.st[0] = nloc; b.st[1] = nx; }
        const unsigned old = xb_add(&bar[XB_XSUB(b.x)], 1u);
        const unsigned gen = old / nloc;
        if (old + 1u == (gen + 1u) * nloc) {
            __builtin_amdgcn_fence(__ATOMIC_RELEASE, "agent");
            asm volatile("s_waitcnt vmcnt(0)" ::: "memory");
            const unsigned og = xb_add(&bar[XB_TOP], 1u);
            const unsigned tg = og / nx;
            if (og + 1u == (tg + 1u) * nx) xb_add(&bar[XB_TOPGEN], 1u);
            else XB_SPIN(xb_ld(&bar[XB_TOPGEN]) == tg, bar);
            __builtin_amdgcn_fence(__ATOMIC_ACQUIRE, "agent");
            xb_add(&bar[XB_XGEN(b.x)], 1u);
            asm volatile("s_waitcnt vmcnt(0)" ::: "memory");
        } else {
            XB_SPIN(xb_ld(&bar[XB_XGEN(b.x)]) == gen, bar);
            __builtin_amdgcn_fence(__ATOMIC_ACQUIRE, "agent");
            asm volatile("s_waitcnt vmcnt(0)" ::: "memory");
        }
    }
    __syncthreads();
}

namespace pg8 {
constexpr int BM = 256, BK = 64, HALF = 128, HTB = HALF * BK * 2, STAGE_BYTES = 8 * HTB, NXCD = 8, WGM = 8;
__host__ __device__ __forceinline__ int lds_byte(int r, int c) { const int st = (r >> 4) * 2 + (c >> 5), rr = r & 15, cc = c & 31, ob = rr * 64 + cc * 2; return st * 1024 + (ob ^ (((ob >> 9) & 1) << 5)); }
__host__ __device__ __forceinline__ void stage_rc(int b, int& R, int& C) { const int st = b / 1024, sb = b % 1024, swz = sb ^ (((sb >> 9) & 1) << 5); R = (st >> 1) * 16 + swz / 64; C = (st & 1) * 32 + (swz % 64) / 2; }
__host__ __device__ __forceinline__ int perm32(int rho) { const int n = rho >> 4, i = rho & 15; return 8 * (i >> 2) + 4 * n + (i & 3); }
typedef int i32x8 __attribute__((ext_vector_type(8)));
__device__ __forceinline__ i32x8 cat8(const bf16x8 a, const bf16x8 b) { const u32x4 x = __builtin_bit_cast(u32x4, a), y = __builtin_bit_cast(u32x4, b); i32x8 r; r[0] = (int)x.x; r[1] = (int)x.y; r[2] = (int)x.z; r[3] = (int)x.w; r[4] = (int)y.x; r[5] = (int)y.y; r[6] = (int)y.z; r[7] = (int)y.w; return r; }
struct Unit { int pm, pn; };
struct Gemm { const bf16_t* A; const bf16_t* Bt; int M, N, K; };
struct StaticOrder {
    int nM, nN, nwg, G, c;
    __device__ void init(int M, int N, int G_, int c_) { nM = M / BM; nN = N / BM; nwg = nM * nN; G = G_; c = c_; }
    __device__ bool next(int i, Unit& u) const {
        const long L = (long)i * G + c; if (L >= nwg) return false;
        int wgid = (int)L; { const int q = nwg / NXCD, r = nwg % NXCD, xcd = wgid % NXCD, off = wgid / NXCD; wgid = (xcd < r ? xcd * (q + 1) : r * (q + 1) + (xcd - r) * q) + off; }
        const int nig = WGM * nN, gid = wgid / nig, fm = gid * WGM, gsz = (nM - fm) < WGM ? (nM - fm) : WGM;
        u.pm = fm + ((wgid % nig) % gsz); u.pn = (wgid % nig) / gsz; return true;
    }
};

template <class Epi, class Sched>
__device__ __forceinline__ void gemm_phase(LAS unsigned char* lds, const Gemm g, const Sched& S, const Epi& E) {
    const int tid_ = otid();
    const int tid = tid_, wid = __builtin_amdgcn_readfirstlane(tid >> 6), lane = tid & 63, wr = wid >> 2, wc = wid & 3, fr = lane & 15, fq = lane >> 4;
    const int K = g.K, nt = K / BK;
    unsigned voffA[2], voffB[2];
#pragma unroll
    for (int i = 0; i < 2; ++i) { int R, C; stage_rc(tid * 16 + i * 8192, R, C); const int Rb = Epi::PERM ? ((R & ~31) + perm32(R & 31)) : R;
        voffA[i] = (unsigned)(R * K + C) * 2u; voffB[i] = (unsigned)(Rb * K + C) * 2u; }
    const size_t kstep = (size_t)(BK * 2);
    const size_t hstep = (size_t)HALF * K * 2;
    const size_t tstep = 2 * hstep;
    const unsigned ldsw = (unsigned)wid * 1024u;
    const int aoff = lds_byte(wr * 64 + fr, fq * 8), boff = lds_byte(wc * 32 + fr, fq * 8);
    const int aoff8 = lds_byte(wr * 64 + fr, (fq >> 1) * 32 + (fq & 1) * 16), boff8 = lds_byte(wc * 32 + fr, (fq >> 1) * 32 + (fq & 1) * 16);
#define PG8_SA(b, h) (((b) * 2 + (h)) * HTB)
#define PG8_SB(b, h) ((4 + (b) * 2 + (h)) * HTB)
#define PG8_STAGE(bufoff, gbase, voff) do { _Pragma("unroll") for (int _i = 0; _i < 2; ++_i) \
        __builtin_amdgcn_global_load_lds((const unsigned*)((const char*)(gbase) + (voff)[_i]), (LAS unsigned*)(lds + (bufoff) + ldsw + _i * 8192), 16, 0, 0); } while (0)
#define PG8_LDA(dst, b, h) do { if constexpr (Epi::FP8) { _Pragma("unroll") for (int m = 0; m < 4; ++m) dst##8[m] = cat8(*(const LAS bf16x8*)(lds + PG8_SA(b, h) + aoff + m * 2048), *(const LAS bf16x8*)(lds + PG8_SA(b, h) + aoff + m * 2048 + 1024)); } \
        else { _Pragma("unroll") for (int m = 0; m < 4; ++m) _Pragma("unroll") for (int k = 0; k < 2; ++k) dst[m][k] = *(const LAS bf16x8*)(lds + PG8_SA(b, h) + aoff + m * 2048 + k * 1024); } } while (0)
#define PG8_LDB(dst, b, h) do { if constexpr (Epi::FP8) { _Pragma("unroll") for (int n = 0; n < 2; ++n) dst##8[n] = cat8(*(const LAS bf16x8*)(lds + PG8_SB(b, h) + boff + n * 2048), *(const LAS bf16x8*)(lds + PG8_SB(b, h) + boff + n * 2048 + 1024)); } \
        else { _Pragma("unroll") for (int n = 0; n < 2; ++n) _Pragma("unroll") for (int k = 0; k < 2; ++k) dst[n][k] = *(const LAS bf16x8*)(lds + PG8_SB(b, h) + boff + n * 2048 + k * 1024); } } while (0)
#define PG8_MMA(ai, bj, At, Bt) do { __builtin_amdgcn_s_setprio(1); _Pragma("unroll") for (int m = 0; m < 4; ++m) _Pragma("unroll") for (int n = 0; n < 2; ++n) { \
        if constexpr (Epi::FP8) { asm volatile("v_mfma_scale_f32_16x16x128_f8f6f4 %0, %1, %2, %0, %3, %3 op_sel_hi:[0,0,0]" : "+v"(acc[ai][bj][m][n]) : "v"(Bt##8[n]), "v"(At##8[m]), "v"(one_scale)); } \
        else { _Pragma("unroll") for (int k = 0; k < 2; ++k) acc[ai][bj][m][n] = __builtin_amdgcn_mfma_f32_16x16x32_bf16(Bt[n][k], At[m][k], acc[ai][bj][m][n], 0, 0, 0); } } \
        __builtin_amdgcn_s_setprio(0); } while (0)
#define PG8_WAIT_V(n) asm volatile("s_waitcnt vmcnt(" #n ")" ::: "memory")
#define PG8_WAIT_L(n) asm volatile("s_waitcnt lgkmcnt(" #n ")" ::: "memory")
#define PG8_BAR __builtin_amdgcn_s_barrier()
#define PG8_SCHED __builtin_amdgcn_sched_barrier(0)
    Unit cur, nxt; int ui = 0;
    if (!S.next(0, cur)) return;
    f32x4 acc[2][2][4][2];
#pragma unroll
    for (int a = 0; a < 2; ++a)
#pragma unroll
        for (int b = 0; b < 2; ++b)
#pragma unroll
            for (int m = 0; m < 4; ++m)
#pragma unroll
                for (int n = 0; n < 2; ++n) acc[a][b][m][n] = (f32x4){0.f, 0.f, 0.f, 0.f};
    bf16x8 At[4][2], B0[2][2], B1[2][2];
    i32x8 At8[4], B08[2], B18[2];
    const int one_scale = 0x7F7F7F7F;
    const char* cA = (const char*)g.A + (size_t)cur.pm * tstep; const char* cB = (const char*)g.Bt + (size_t)cur.pn * tstep;
    PG8_STAGE(PG8_SB(0, 0), cB, voffB); PG8_STAGE(PG8_SA(0, 0), cA, voffA); PG8_STAGE(PG8_SB(0, 1), cB + hstep, voffB); PG8_STAGE(PG8_SA(0, 1), cA + hstep, voffA);
    if (wr == 1) PG8_BAR;
    PG8_WAIT_V(4); PG8_BAR;
    PG8_STAGE(PG8_SB(1, 0), cB + kstep, voffB); PG8_STAGE(PG8_SA(1, 0), cA + kstep, voffA); PG8_STAGE(PG8_SB(1, 1), cB + hstep + kstep, voffB);
    PG8_WAIT_V(6); PG8_BAR;
    for (;;) {
        const bool has_next = S.next(ui + 1, nxt);
        const char* nA = has_next ? (const char*)g.A + (size_t)nxt.pm * tstep : cA; const char* nB = has_next ? (const char*)g.Bt + (size_t)nxt.pn * tstep : cB;
        for (int t = 0; t < nt; t += 2) {
            const bool last = (t == nt - 2);
            const char* a1 = cA + (size_t)(t + 1) * kstep;
            const char* a2 = last ? nA : cA + (size_t)(t + 2) * kstep; const char* b2 = last ? nB : cB + (size_t)(t + 2) * kstep;
            const char* a3 = a2 + kstep; const char* b3 = b2 + kstep;
            PG8_LDB(B0, 0, 0); PG8_SCHED; PG8_LDA(At, 0, 0); PG8_STAGE(PG8_SA(1, 1), a1 + hstep, voffA);
            PG8_WAIT_L(8); PG8_BAR; PG8_WAIT_L(0); PG8_MMA(0, 0, At, B0); PG8_BAR; PG8_SCHED;
            PG8_LDB(B1, 0, 1); PG8_STAGE(PG8_SB(0, 0), b2, voffB);
            PG8_BAR; PG8_WAIT_L(0); PG8_MMA(0, 1, At, B1); PG8_BAR;
            PG8_LDA(At, 0, 1); PG8_STAGE(PG8_SA(0, 0), a2, voffA);
            PG8_BAR; PG8_WAIT_L(0); PG8_MMA(1, 0, At, B0); PG8_BAR; PG8_SCHED;
            PG8_STAGE(PG8_SB(0, 1), b2 + hstep, voffB);
            PG8_WAIT_V(6); PG8_BAR; PG8_MMA(1, 1, At, B1); PG8_BAR;
            PG8_LDB(B0, 1, 0); PG8_SCHED; PG8_LDA(At, 1, 0); PG8_STAGE(PG8_SA(0, 1), a2 + hstep, voffA);
            PG8_WAIT_L(8); PG8_BAR; PG8_WAIT_L(0); PG8_MMA(0, 0, At, B0); PG8_BAR; PG8_SCHED;
            PG8_LDB(B1, 1, 1); PG8_STAGE(PG8_SB(1, 0), b3, voffB);
            PG8_BAR; PG8_WAIT_L(0); PG8_MMA(0, 1, At, B1); PG8_BAR;
            PG8_LDA(At, 1, 1); PG8_STAGE(PG8_SA(1, 0), a3, voffA);
            PG8_BAR; PG8_WAIT_L(0); PG8_MMA(1, 0, At, B0); PG8_BAR; PG8_SCHED;
            PG8_STAGE(PG8_SB(1, 1), b3 + hstep, voffB);
            PG8_WAIT_V(6); PG8_BAR; PG8_MMA(1, 1, At, B1); PG8_BAR;
        }
        if constexpr (Epi::FP8) asm volatile("s_nop 15\n s_nop 15\n s_nop 15" ::: "memory");
        E(acc, cur, wr, wc, fr, fq);
        if (!has_next) break;
#pragma unroll
        for (int a = 0; a < 2; ++a)
#pragma unroll
            for (int b = 0; b < 2; ++b)
#pragma unroll
                for (int m = 0; m < 4; ++m)
#pragma unroll
                    for (int n = 0; n < 2; ++n) acc[a][b][m][n] = (f32x4){0.f, 0.f, 0.f, 0.f};
        cur = nxt; cA = nA; cB = nB; ++ui;
    }
    PG8_WAIT_V(0);
    if (wr == 0) PG8_BAR;
    PG8_BAR;
#undef PG8_SA
#undef PG8_SB
#undef PG8_STAGE
#undef PG8_LDA
#undef PG8_LDB
#undef PG8_MMA
#undef PG8_WAIT_V
#undef PG8_WAIT_L
#undef PG8_BAR
#undef PG8_SCHED
}
}

typedef f32x4 AccT[2][2][4][2];

struct EpiInProj {
    static constexpr bool PERM = true, FP8 = true;
    unsigned char* P;
    const float* sa;
    const unsigned* cmax;
    __device__ __forceinline__ void operator()(const AccT& acc, const pg8::Unit& u, int wr, int wc, int fr, int fq) const {
        const int pn = u.pn;
        bf16_t* base; int ld, lc, act;
        if (pn < 28) { const int seg = pn >> 2; base = (bf16_t*)(P + (size_t)seg * SEG); ld = 1024; lc = (pn & 3) * 256; act = (seg < 2) ? 1 : ((seg == 2 || seg == 6) ? 2 : 0); }
        else if (pn < 31) { base = (bf16_t*)(P + P_CU); ld = 768; lc = (pn - 28) * 256; act = 0; }
        else { base = (bf16_t*)(P + P_GATES); ld = 6144; lc = (pn - 31) * 256; act = 3; }
        const int row0 = u.pm * 256 + wr * 64 + fr, col0 = lc + wc * 32 + 8 * fq, gcol0 = u.pn * 256 + wc * 32 + 8 * fq;
        f32x4 cs[2][2];
#pragma unroll
        for (int bj = 0; bj < 2; ++bj)
#pragma unroll
            for (int n = 0; n < 2; ++n) { const u32x4 cb = *(const u32x4*)(cmax + gcol0 + bj * 128 + 4 * n);
                cs[bj][n] = (f32x4){__uint_as_float(cb.x), __uint_as_float(cb.y), __uint_as_float(cb.z), __uint_as_float(cb.w)} * (1.0f / 240.0f); }
        float rscv[2][4];
#pragma unroll
        for (int ai = 0; ai < 2; ++ai)
#pragma unroll
            for (int m = 0; m < 4; ++m) rscv[ai][m] = sa[row0 + ai * 128 + m * 16];
#pragma unroll
        for (int ai = 0; ai < 2; ++ai)
#pragma unroll
            for (int m = 0; m < 4; ++m) {
                bf16_t* rowp = base + (size_t)(row0 + ai * 128 + m * 16) * ld + col0;
                const float rsc = rscv[ai][m];
#pragma unroll
                for (int bj = 0; bj < 2; ++bj) {
                    f32x4 v0 = acc[ai][bj][m][0] * (cs[bj][0] * rsc), v1 = acc[ai][bj][m][1] * (cs[bj][1] * rsc);
                    if (act == 1) {
#pragma unroll
                        for (int j = 0; j < 4; ++j) { v0[j] = gelu_f(v0[j]); v1[j] = gelu_f(v1[j]); }
                    } else if (act == 2) {
#pragma unroll
                        for (int j = 0; j < 4; ++j) { v0[j] = fast_silu(v0[j]); v1[j] = fast_silu(v1[j]); }
                    } else if (act == 3) {
#pragma unroll
                        for (int j = 0; j < 4; ++j) { v0[j] = fast_sigmoid(v0[j]); v1[j] = fast_sigmoid(v1[j]); }
                    }
                    u32x4 w; w.x = cvt_pk_bf16(v0[0], v0[1]); w.y = cvt_pk_bf16(v0[2], v0[3]); w.z = cvt_pk_bf16(v1[0], v1[1]); w.w = cvt_pk_bf16(v1[2], v1[3]);
                    *(u32x4*)(rowp + bj * 128) = w;
                }
            }
    }
};
struct EpiGlu {
    static constexpr bool PERM = true, FP8 = false;
    bf16_t* O;
    __device__ __forceinline__ void operator()(const AccT& acc, const pg8::Unit& u, int wr, int wc, int fr, int fq) const {
        const int row0 = u.pm * 256 + wr * 64 + fr, col0 = u.pn * 128 + wc * 32 + 8 * fq;
#pragma unroll
        for (int ai = 0; ai < 2; ++ai)
#pragma unroll
            for (int m = 0; m < 4; ++m) {
                f32x4 v0 = acc[ai][0][m][0], v1 = acc[ai][0][m][1]; const f32x4 g0 = acc[ai][1][m][0], g1 = acc[ai][1][m][1];
#pragma unroll
                for (int j = 0; j < 4; ++j) { v0[j] *= fast_sigmoid(g0[j]); v1[j] *= fast_sigmoid(g1[j]); }
                u32x4 w; w.x = cvt_pk_bf16(v0[0], v0[1]); w.y = cvt_pk_bf16(v0[2], v0[3]); w.z = cvt_pk_bf16(v1[0], v1[1]); w.w = cvt_pk_bf16(v1[2], v1[3]);
                *(u32x4*)(O + (size_t)(row0 + ai * 128 + m * 16) * 768 + col0) = w;
            }
    }
};
template <bool FIRST> struct EpiMerge {
    static constexpr bool PERM = true, FP8 = false;
    bf16_t* O;
    const bf16_t* G;
    __device__ __forceinline__ void operator()(const AccT& acc, const pg8::Unit& u, int wr, int wc, int fr, int fq) const {
        const int row0 = u.pm * 256 + wr * 64 + fr, col0 = u.pn * 256 + wc * 32 + 8 * fq;
#pragma unroll
        for (int ai = 0; ai < 2; ++ai) {
            u32x4 gwv[4][2], owv[4][2];
#pragma unroll
            for (int m = 0; m < 4; ++m)
#pragma unroll
                for (int bj = 0; bj < 2; ++bj) { const size_t row = (size_t)(row0 + ai * 128 + m * 16);
                    gwv[m][bj] = *(const u32x4*)(G + row * 6144 + col0 + bj * 128);
                    if (!FIRST) owv[m][bj] = *(const u32x4*)(O + row * 2048 + col0 + bj * 128); }
#pragma unroll
            for (int m = 0; m < 4; ++m)
#pragma unroll
                for (int bj = 0; bj < 2; ++bj) { const size_t row = (size_t)(row0 + ai * 128 + m * 16);
                    const u32x4 gw = gwv[m][bj];
                    f32x4 v0 = acc[ai][bj][m][0], v1 = acc[ai][bj][m][1];
                    v0[0] *= bf_lo(gw.x); v0[1] *= bf_hi(gw.x); v0[2] *= bf_lo(gw.y); v0[3] *= bf_hi(gw.y);
                    v1[0] *= bf_lo(gw.z); v1[1] *= bf_hi(gw.z); v1[2] *= bf_lo(gw.w); v1[3] *= bf_hi(gw.w);
                    if (!FIRST) { const u32x4 ow = owv[m][bj];
                        v0[0] += bf_lo(ow.x); v0[1] += bf_hi(ow.x); v0[2] += bf_lo(ow.y); v0[3] += bf_hi(ow.y);
                        v1[0] += bf_lo(ow.z); v1[1] += bf_hi(ow.z); v1[2] += bf_lo(ow.w); v1[3] += bf_hi(ow.w); }
                    u32x4 w; w.x = cvt_pk_bf16(v0[0], v0[1]); w.y = cvt_pk_bf16(v0[2], v0[3]); w.z = cvt_pk_bf16(v1[0], v1[1]); w.w = cvt_pk_bf16(v1[2], v1[3]);
                    *(u32x4*)(O + row * 2048 + col0 + bj * 128) = w; }
        }
    }
};
struct EpiResid {
    static constexpr bool PERM = false, FP8 = false;
    float* XR; float* XC; const float* modl;
    __device__ __forceinline__ void operator()(const AccT& acc, const pg8::Unit& u, int wr, int wc, int fr, int fq) const {
        const int row0 = u.pm * 256 + wr * 64 + fr, col0 = u.pn * 256 + wc * 32 + 4 * fq;
        const int mb = u.pm < 128 ? (u.pm >> 3) : 16;
        const float* gv = modl + (size_t)mb * NMOD + col0;
        float* basep = u.pm < 128 ? XR : (XC - (size_t)TL * D);
        f32x4 gvv[2][2];
#pragma unroll
        for (int bj = 0; bj < 2; ++bj)
#pragma unroll
            for (int n = 0; n < 2; ++n) gvv[bj][n] = *(const f32x4*)(gv + bj * 128 + n * 16);
#pragma unroll
        for (int ai = 0; ai < 2; ++ai) {
            f32x4 xo[4][2][2];
#pragma unroll
            for (int m = 0; m < 4; ++m)
#pragma unroll
                for (int bj = 0; bj < 2; ++bj)
#pragma unroll
                    for (int n = 0; n < 2; ++n) xo[m][bj][n] = *(const f32x4*)(basep + (size_t)(row0 + ai * 128 + m * 16) * D + col0 + bj * 128 + n * 16);
#pragma unroll
            for (int m = 0; m < 4; ++m)
#pragma unroll
                for (int bj = 0; bj < 2; ++bj)
#pragma unroll
                    for (int n = 0; n < 2; ++n) *(f32x4*)(basep + (size_t)(row0 + ai * 128 + m * 16) * D + col0 + bj * 128 + n * 16) = xo[m][bj][n] + gvv[bj][n] * acc[ai][bj][m][n];
        }
    }
};
struct EpiF32 {
    static constexpr bool PERM = false, FP8 = false;
    float* C; int ldc;
    __device__ __forceinline__ void operator()(const AccT& acc, const pg8::Unit& u, int wr, int wc, int fr, int fq) const {
        const int row0 = u.pm * 256 + wr * 64 + fr, col0 = u.pn * 256 + wc * 32 + 4 * fq;
#pragma unroll
        for (int ai = 0; ai < 2; ++ai)
#pragma unroll
            for (int m = 0; m < 4; ++m) {
                float* rowp = C + (size_t)(row0 + ai * 128 + m * 16) * ldc + col0;
#pragma unroll
                for (int bj = 0; bj < 2; ++bj)
#pragma unroll
                    for (int n = 0; n < 2; ++n) *(f32x4*)(rowp + bj * 128 + n * 16) = acc[ai][bj][m][n];
            }
    }
};

template <class Epi>
__device__ __forceinline__ void run_gemm(LAS unsigned char* lds, const bf16_t* A, const bf16_t* Bt, int M, int N, int K, const Epi& E, int rot = 0) {
    pg8::Gemm g{A, Bt, M, N, K};
    const int G_ = (int)gridDim.x; int c_ = (int)blockIdx.x - rot; if (c_ < 0) c_ += G_;
    pg8::StaticOrder S; S.init(M, N, G_, c_);
    pg8::gemm_phase<Epi, pg8::StaticOrder>(lds, g, S, E);
}

__device__ __forceinline__ void phase_mod(const Params& p, LAS unsigned char* lds) {
    const int tid_ = otid();
    LAS float* cs = (LAS float*)lds;
    LAS float* red = (LAS float*)(lds + 2048 * 17 * 4);
    const int tid = tid_;
    float* modv = (float*)(p.ws + OFF_MODV);
    { f32x4 cv[17];
#pragma unroll
      for (int r = 0; r < 17; ++r) cv[r] = *(const f32x4*)((r < 16 ? p.c + r * 2048 : p.c_ctx) + tid * 4);
#pragma unroll
      for (int r = 0; r < 17; ++r)
#pragma unroll
          for (int e = 0; e < 4; ++e) { const float c = cv[r][e]; cs[(tid * 4 + e) * 17 + r] = c / (1.0f + __expf(-c)); } }
    __syncthreads();
    const int lane = tid & 63, wv = tid >> 6, cq = lane & 7, kg = wv * 8 + (lane >> 3);
    for (int u = blockIdx.x; u < 768; u += gridDim.x) {
        const int l = u / 384, c0 = (u % 384) * 32;
        const float* w = p.w_mod + (size_t)l * 2048 * NMOD + (size_t)kg * NMOD + c0 + cq * 4;
        f32x4 acc[17];
#pragma unroll
        for (int r = 0; r < 17; ++r) acc[r] = (f32x4){0.f, 0.f, 0.f, 0.f};
#pragma unroll 16
        for (int j = 0; j < 32; ++j) {
            const f32x4 w4 = *(const f32x4*)(w + (size_t)j * 64 * NMOD);
            const LAS float* cr = cs + (kg + 64 * j) * 17;
#pragma unroll
            for (int r = 0; r < 17; ++r) acc[r] += w4 * cr[r];
        }
#pragma unroll
        for (int r = 0; r < 17; ++r)
#pragma unroll
            for (int c = 0; c < 4; ++c) { float v = acc[r][c]; v += __shfl_xor(v, 8); v += __shfl_xor(v, 16); v += __shfl_xor(v, 32);
                if (lane < 8) red[(wv * 32 + cq * 4 + c) * 17 + r] = v; }
        __syncthreads();
        for (int o = tid; o < 32 * 17; o += NTHREADS) { const int col = o & 31, r = o >> 5;
            float sum = p.b_mod[l * NMOD + c0 + col];
#pragma unroll
            for (int q = 0; q < 8; ++q) sum += red[(q * 32 + col) * 17 + r];
            modv[(size_t)(l * 17 + r) * NMOD + c0 + col] = sum; }
        __syncthreads();
    }
}
__device__ __forceinline__ void phase_prep(const Params& p) {
    const int tid_ = otid();
    const int gt = blockIdx.x * NTHREADS + tid_, nt = gridDim.x * NTHREADS;
    float* lb = (float*)(p.ws + OFF_LB);
    for (int i = gt; i < 2 * 1024; i += nt) { const float x0 = p.lb_logits[i], x1 = p.lb_logits[2048 + i]; lb[i] = 0.f; lb[2048 + i] = 1.0f / (1.0f + expf(x0 - x1)); }
    float* s5lam = (float*)(p.ws + OFF_S5LAM); float* s5bb = (float*)(p.ws + OFF_S5BB);
    for (int i = gt; i < 2 * 2 * 48 * 64; i += nt) {
        const int ldg = i >> 6;
        const double lre = (double)p.lam_re[i], lim = (double)p.lam_im[i], dt = exp((double)p.log_step[ldg]);
        const double er = exp(lre * dt); double sn, cs; sincos(lim * dt, &sn, &cs);
        const double br = er * cs, bi = er * sn;
        s5lam[i * 2] = (float)br; s5lam[i * 2 + 1] = (float)bi;
        const double nr = br - 1.0, ni = bi, den = lre * lre + lim * lim;
        const double cr = (nr * lre + ni * lim) / den, ci = (ni * lre - nr * lim) / den;
        for (int d = 0; d < 16; ++d) { const double xr = (double)p.b_re[(size_t)i * 16 + d], xi = (double)p.b_im[(size_t)i * 16 + d];
            s5bb[(size_t)i * 32 + d] = (float)(cr * xr - ci * xi); s5bb[(size_t)i * 32 + 16 + d] = (float)(cr * xi + ci * xr); }
    }
    float* pe = (float*)(p.ws + OFF_PE);
    for (int i = gt; i < 96 * 1024; i += nt) {
        const int r = i >> 10, cc = i & 1023, j = cc & 511;
        const float pos = (float)(r < 32 ? r : r - 32);
        const float omega = 1.0f / powf(10000.0f, (float)j * (1.0f / 512.0f));
        const float ang = pos * omega;
        pe[i] = cc < 512 ? sinf(ang) : cosf(ang);
    }
}

template <int MAPMODE>
__device__ __forceinline__ void transpose_convert(const float* src, int K, int N, bf16_t* dst, LAS unsigned char* lds) {
    const int tid_ = otid();
    LAS float* tile = (LAS float*)lds;
    const int tid = tid_, nkb = K / 64, nnb = N / 64;
    for (int u = blockIdx.x; u < nkb * nnb; u += gridDim.x) {
        const int kb = u / nnb, nb = u % nnb, k0 = kb * 64, n0 = nb * 64;
        { const int nn = tid & 63, kk = tid >> 6;
#pragma unroll
          for (int i = 0; i < 8; ++i) tile[(kk + i * 8) * 65 + nn] = src[(size_t)(k0 + kk + i * 8) * N + n0 + nn]; }
        __syncthreads();
        { const int kk2 = (tid & 7) * 8, nn2 = tid >> 3; float v[8];
#pragma unroll
          for (int i = 0; i < 8; ++i) v[i] = tile[(kk2 + i) * 65 + nn2];
          int n = n0 + nn2, nr;
          if (MAPMODE == 1) { if (n < 768) nr = (n >> 7) * 256 + (n & 127); else { const int m = n - 768; nr = (m >> 7) * 256 + 128 + (m & 127); } } else nr = n;
          u32x4 w; w.x = cvt_pk_bf16(v[0], v[1]); w.y = cvt_pk_bf16(v[2], v[3]); w.z = cvt_pk_bf16(v[4], v[5]); w.w = cvt_pk_bf16(v[6], v[7]);
          *(u32x4*)(dst + (size_t)nr * K + k0 + kk2) = w; }
        __syncthreads();
    }
}
__device__ __forceinline__ void phase_wscore(const float* wq, const float* sk, bf16_t* dst, LAS unsigned char* lds) {
    const int tid_ = otid();
    LAS float* skt = (LAS float*)lds;
    LAS float* wqt = (LAS float*)(lds + 128 * 129 * 4);
    const int tid = tid_;
    for (int u = blockIdx.x; u < 16 * 32; u += gridDim.x) {
        const int hp = u >> 5, kb = u & 31;
        for (int i = tid; i < 128 * 128; i += NTHREADS) { const int key = i >> 7, e = i & 127; skt[key * 129 + e] = sk[(size_t)hp * 16384 + i]; }
        for (int i = tid; i < 64 * 128; i += NTHREADS) { const int k = i >> 7, e = i & 127; wqt[e * 68 + k] = wq[(size_t)(kb * 64 + k) * 2048 + hp * 128 + e]; }
        __syncthreads();
        const int key = tid & 127, kg = tid >> 7;
        float acc[16];
#pragma unroll
        for (int i = 0; i < 16; ++i) acc[i] = 0.f;
        for (int e = 0; e < 128; ++e) {
            const float s = skt[key * 129 + e];
#pragma unroll
            for (int q = 0; q < 4; ++q) { const f32x4 w4 = *(const LAS f32x4*)(wqt + e * 68 + kg * 16 + q * 4);
                acc[q * 4 + 0] += s * w4[0]; acc[q * 4 + 1] += s * w4[1]; acc[q * 4 + 2] += s * w4[2]; acc[q * 4 + 3] += s * w4[3]; }
        }
        bf16_t* o = dst + (size_t)(hp * 128 + key) * 2048 + kb * 64 + kg * 16;
        u32x4 w0, w1;
        w0.x = cvt_pk_bf16(acc[0], acc[1]); w0.y = cvt_pk_bf16(acc[2], acc[3]); w0.z = cvt_pk_bf16(acc[4], acc[5]); w0.w = cvt_pk_bf16(acc[6], acc[7]);
        w1.x = cvt_pk_bf16(acc[8], acc[9]); w1.y = cvt_pk_bf16(acc[10], acc[11]); w1.z = cvt_pk_bf16(acc[12], acc[13]); w1.w = cvt_pk_bf16(acc[14], acc[15]);
        *(u32x4*)o = w0; *(u32x4*)(o + 8) = w1;
        __syncthreads();
    }
}
__device__ __forceinline__ void phase_colmax(const Params& p) {
    const int tid_ = otid();
    unsigned* cm = (unsigned*)(p.ws + OFF_CMAX);
    const int total = 2 * (INC / 4) * 16;
    for (int i = blockIdx.x * NTHREADS + tid_; i < total; i += gridDim.x * NTHREADS) {
        const int kc = i / (2 * (INC / 4)), cidx = i % (2 * (INC / 4)), l = cidx / (INC / 4), nq = cidx % (INC / 4);
        const float* w = p.w_in + (size_t)l * D * INC + (size_t)(kc * 128) * INC + nq * 4;
        f32x4 am = (f32x4){0.f, 0.f, 0.f, 0.f};
#pragma unroll 32
        for (int k = 0; k < 128; ++k) { const f32x4 v = *(const f32x4*)(w + (size_t)k * INC);
            am[0] = fmaxf(am[0], fabsf(v[0])); am[1] = fmaxf(am[1], fabsf(v[1])); am[2] = fmaxf(am[2], fabsf(v[2])); am[3] = fmaxf(am[3], fabsf(v[3])); }
        unsigned* o = cm + l * INC + nq * 4;
        atomicMax(o, __float_as_uint(am[0])); atomicMax(o + 1, __float_as_uint(am[1])); atomicMax(o + 2, __float_as_uint(am[2])); atomicMax(o + 3, __float_as_uint(am[3]));
    }
}
__device__ __forceinline__ void transpose_convert_fp8(const float* src, int K, int N, unsigned char* dst, const unsigned* cmax, LAS unsigned char* lds) {
    const int tid_ = otid();
    LAS float* tile = (LAS float*)lds;
    const int tid = tid_, nkb = K / 64, nnb = N / 64;
    for (int u = blockIdx.x; u < nkb * nnb; u += gridDim.x) {
        const int kb = u / nnb, nb = u % nnb, k0 = kb * 64, n0 = nb * 64;
        { const int nn = tid & 63, kk = tid >> 6;
#pragma unroll
          for (int i = 0; i < 8; ++i) tile[(kk + i * 8) * 65 + nn] = src[(size_t)(k0 + kk + i * 8) * N + n0 + nn]; }
        __syncthreads();
        { const int kk2 = (tid & 7) * 8, nn2 = tid >> 3; float v[8];
          const float cmv = __uint_as_float(cmax[n0 + nn2]); const float sc = cmv > 0.f ? 240.0f / cmv : 1.0f;
#pragma unroll
          for (int i = 0; i < 8; ++i) v[i] = tile[(kk2 + i) * 65 + nn2] * sc;
          u32x2 w; w.x = pack_fp8x4(v[0], v[1], v[2], v[3]); w.y = pack_fp8x4(v[4], v[5], v[6], v[7]);
          *(u32x2*)(dst + (size_t)(n0 + nn2) * K + k0 + kk2) = w; }
        __syncthreads();
    }
}
__device__ __forceinline__ void phase_wconv(const Params& p, int l, LAS unsigned char* lds) {
    unsigned char* W = p.ws + OFF_W;
    transpose_convert_fp8(p.w_in + (size_t)l * D * INC, D, INC, W + W_IN, (const unsigned*)(p.ws + OFF_CMAX) + (size_t)l * INC, lds);
    transpose_convert<1>(p.w_glu + (size_t)l * 768 * 1536, 768, 1536, (bf16_t*)(W + W_GLU), lds);
    transpose_convert<0>(p.wa + (size_t)l * 1024 * D, 1024, D, (bf16_t*)(W + W_A), lds);
    transpose_convert<0>(p.wb + (size_t)l * 1024 * D, 1024, D, (bf16_t*)(W + W_B), lds);
    transpose_convert<0>(p.wc + (size_t)l * 768 * D, 768, D, (bf16_t*)(W + W_C), lds);
    transpose_convert<0>(p.wo + (size_t)l * D * D, D, D, (bf16_t*)(W + W_O), lds);
    phase_wscore(p.w_q + (size_t)l * D * D, p.sub_keys + (size_t)l * 16 * 16384, (bf16_t*)(W + W_S), lds);
}
__device__ __forceinline__ void phase_tabconv(const Params& p, int l) {
    const int tid_ = otid();
    const int lane = tid_ & 63, gw = blockIdx.x * 8 + __builtin_amdgcn_readfirstlane(tid_ >> 6), nw = gridDim.x * 8;
    unsigned char* U6 = p.ws + OFF_P + Q_UT; unsigned char* V6 = p.ws + OFF_P + Q_VT;
    float* USC = (float*)(p.ws + OFF_P + Q_USC); float* VSC = (float*)(p.ws + OFF_P + Q_VSC);
    for (int r = gw; r < 32768; r += nw) {
        const bool isv = r >= 16384; const int rr = r & 16383;
        const float* src = (isv ? p.peer_v : p.peer_u) + (size_t)l * 16384 * 2048 + (size_t)rr * 2048;
        f32x4 v[8];
#pragma unroll
        for (int j = 0; j < 8; ++j) v[j] = *(const f32x4*)(src + j * 256 + lane * 4);
        float am = 0.f;
#pragma unroll
        for (int j = 0; j < 8; ++j) am = fmaxf(am, fmaxf(fmaxf(fabsf(v[j][0]), fabsf(v[j][1])), fmaxf(fabsf(v[j][2]), fabsf(v[j][3]))));
#pragma unroll
        for (int o = 32; o >= 1; o >>= 1) am = fmaxf(am, __shfl_xor(am, o));
        if (isv) {
            const float sc4 = am > 0.f ? 6.0f / am : 1.0f;
            unsigned wd[4] = {0u, 0u, 0u, 0u};
#pragma unroll
            for (int j = 0; j < 8; ++j) {
                if ((j & 1) == 0) { wd[j >> 1] = __builtin_amdgcn_cvt_scalef32_pk_fp4_f32(wd[j >> 1], v[j][0] * sc4, v[j][1] * sc4, 1.0f, 0); wd[j >> 1] = __builtin_amdgcn_cvt_scalef32_pk_fp4_f32(wd[j >> 1], v[j][2] * sc4, v[j][3] * sc4, 1.0f, 1); }
                else { wd[j >> 1] = __builtin_amdgcn_cvt_scalef32_pk_fp4_f32(wd[j >> 1], v[j][0] * sc4, v[j][1] * sc4, 1.0f, 2); wd[j >> 1] = __builtin_amdgcn_cvt_scalef32_pk_fp4_f32(wd[j >> 1], v[j][2] * sc4, v[j][3] * sc4, 1.0f, 3); } }
            u32x4 w4; w4.x = wd[0]; w4.y = wd[1]; w4.z = wd[2]; w4.w = wd[3];
            *(u32x4*)(V6 + (size_t)rr * 1024 + lane * 16) = w4;
            if (lane == 0) VSC[rr] = am > 0.f ? am * (1.0f / 6.0f) : 1.0f;
            continue;
        }
        const float sc = am > 0.f ? 7.0f / am : 1.0f, inv = am > 0.f ? am * (1.0f / 7.0f) : 1.0f;
        bf16x32_t bv;
#pragma unroll
        for (int j = 0; j < 8; ++j)
#pragma unroll
            for (int c = 0; c < 4; ++c) bv[j * 4 + c] = (__bf16)(v[j][c] * sc);
        const u32x6 pk = __builtin_amdgcn_cvt_scalef32_pk32_fp6_bf16(bv, 1.0f);
        unsigned char* dst = U6 + (size_t)rr * 1536 + lane * 24;
        u32x4 w0; w0.x = pk[0]; w0.y = pk[1]; w0.z = pk[2]; w0.w = pk[3]; u32x2 w1; w1.x = pk[4]; w1.y = pk[5];
        *(u32x4*)dst = w0; *(u32x2*)(dst + 16) = w1;
        if (lane == 0) USC[rr] = inv;
    }
}

template <int MODE, bool F8OUT = false>
__device__ __forceinline__ void phase_norm(const Params& p, int l, int M, int off_sh, int off_sc) {
    const int tid_ = otid();
    const int lane = tid_ & 63, gw = blockIdx.x * 8 + __builtin_amdgcn_readfirstlane(tid_ >> 6), nw = gridDim.x * 8;
    const float* modv = (const float*)(p.ws + OFF_MODV) + (size_t)l * 17 * NMOD;
    const float* pe = (const float*)(p.ws + OFF_PE);
    float* XC = (float*)(p.ws + OFF_XC);
    bf16_t* H = (bf16_t*)(p.ws + OFF_H);
    for (int r = gw; r < M; r += nw) {
        const bool lat = r < TL;
        const float* src = MODE == 0 ? (lat ? p.x + (size_t)r * D : p.ctx + (size_t)(r - TL) * D) : (lat ? p.out + (size_t)r * D : XC + (size_t)(r - TL) * D);
        f32x4 v[4][2];
#pragma unroll
        for (int j = 0; j < 4; ++j) { v[j][0] = *(const f32x4*)(src + j * 512 + lane * 8); v[j][1] = *(const f32x4*)(src + j * 512 + lane * 8 + 4); }
        if (MODE == 0) {
            if (lat) { const int n = r & 2047, gr = n >> 6, gc = n & 63;
#pragma unroll
                for (int j = 0; j < 4; ++j) { const float* pr = (j < 2) ? pe + (size_t)gr * 1024 + j * 512 + lane * 8 : pe + (size_t)(32 + gc) * 1024 + (j - 2) * 512 + lane * 8;
                    v[j][0] += *(const f32x4*)pr; v[j][1] += *(const f32x4*)(pr + 4); } }
            float* dst = lat ? p.out + (size_t)r * D : XC + (size_t)(r - TL) * D;
#pragma unroll
            for (int j = 0; j < 4; ++j) { *(f32x4*)(dst + j * 512 + lane * 8) = v[j][0]; *(f32x4*)(dst + j * 512 + lane * 8 + 4) = v[j][1]; }
        }
        float ss = 0.f;
#pragma unroll
        for (int j = 0; j < 4; ++j)
#pragma unroll
            for (int h = 0; h < 2; ++h) ss += v[j][h][0] * v[j][h][0] + v[j][h][1] * v[j][h][1] + v[j][h][2] * v[j][h][2] + v[j][h][3] * v[j][h][3];
        ss = wave_sum(ss);
        const float rs = rsqrtf(ss * (1.0f / 2048.0f) + 1e-6f);
        const int mb = lat ? (r >> 11) : 16;
        const float* sh = modv + (size_t)mb * NMOD + off_sh; const float* sc = modv + (size_t)mb * NMOD + off_sc;
        if (F8OUT) {
            float am = 0.f;
#pragma unroll
            for (int j = 0; j < 4; ++j) { const int e = j * 512 + lane * 8;
                const f32x4 s0 = *(const f32x4*)(sc + e), s1 = *(const f32x4*)(sc + e + 4), h0 = *(const f32x4*)(sh + e), h1 = *(const f32x4*)(sh + e + 4);
                v[j][0] = v[j][0] * rs * (s0 + 1.0f) + h0; v[j][1] = v[j][1] * rs * (s1 + 1.0f) + h1;
#pragma unroll
                for (int hh = 0; hh < 2; ++hh) am = fmaxf(am, fmaxf(fmaxf(fabsf(v[j][hh][0]), fabsf(v[j][hh][1])), fmaxf(fabsf(v[j][hh][2]), fabsf(v[j][hh][3])))); }
#pragma unroll
            for (int o = 32; o >= 1; o >>= 1) am = fmaxf(am, __shfl_xor(am, o));
            const float q = am > 0.f ? 240.0f / am : 1.0f;
            unsigned char* H8 = p.ws + OFF_H8 + (size_t)r * D;
#pragma unroll
            for (int j = 0; j < 4; ++j) { u32x2 w; w.x = pack_fp8x4(v[j][0][0] * q, v[j][0][1] * q, v[j][0][2] * q, v[j][0][3] * q); w.y = pack_fp8x4(v[j][1][0] * q, v[j][1][1] * q, v[j][1][2] * q, v[j][1][3] * q);
                *(u32x2*)(H8 + j * 512 + lane * 8) = w; }
            if (lane == 0) ((float*)(p.ws + OFF_HS))[r] = am > 0.f ? am * (1.0f / 240.0f) : 1.0f;
        } else {
#pragma unroll
        for (int j = 0; j < 4; ++j) {
            const int e = j * 512 + lane * 8;
            const f32x4 s0 = *(const f32x4*)(sc + e), s1 = *(const f32x4*)(sc + e + 4), h0 = *(const f32x4*)(sh + e), h1 = *(const f32x4*)(sh + e + 4);
            f32x4 a = v[j][0] * rs * (s0 + 1.0f) + h0, b = v[j][1] * rs * (s1 + 1.0f) + h1;
            u32x4 w; w.x = cvt_pk_bf16(a[0], a[1]); w.y = cvt_pk_bf16(a[2], a[3]); w.z = cvt_pk_bf16(b[0], b[1]); w.w = cvt_pk_bf16(b[2], b[3]);
            *(u32x4*)(H + (size_t)r * D + e) = w;
        }
        }
    }
}
__device__ __forceinline__ bf16x8 mk_bf16x8(unsigned a, unsigned b, unsigned c, unsigned d) { u32x4 q; q.x = a; q.y = b; q.z = c; q.w = d; return __builtin_bit_cast(bf16x8, q); }
__device__ __forceinline__ void phase_hgrn(const Params& p, int l, LAS unsigned char* lds, bool dry = false) {
    const int tid_ = otid();
    const int lane = tid_ & 63, w = __builtin_amdgcn_readfirstlane(tid_ >> 6), q = lane >> 4, m = lane & 15;
    constexpr int OQ = 0, OKH = 4352, OKT = 8704, OIT = 14848, OE = 20992, BUFSZ = 21504, RAWOFF = 2 * 21504, RAWSZ = 3 * 4352;
    unsigned char* P = p.ws + OFF_P;
    const float* lbp = (const float*)(p.ws + OFF_LB) + (size_t)l * 2048;
    const int kch = 16 * w + m;
    for (int u = blockIdx.x; u < 256; u += gridDim.x) {
        const int b = u >> 4, h = (u >> 1) & 7, dir = u & 1;
        const bf16_t* BQ = (const bf16_t*)(P + P_BQ); const bf16_t* BI = (const bf16_t*)(P + P_BI);
        bf16_t* BF = (bf16_t*)(P + (dir ? P_BFB : P_BFF));
        const float lbv = lbp[dir * 1024 + h * 128 + kch];
        f32x4 Sacc[8];
#pragma unroll
        for (int i = 0; i < 8; ++i) Sacc[i] = (f32x4){0.f, 0.f, 0.f, 0.f};
        for (int seg = 0; seg < 2; ++seg) {
            const int len = seg == 0 ? CTXL : SEQ, rbase = seg == 0 ? TL + b * CTXL : b * SEQ, nch = len / 16;
            u32x4 g0 = (u32x4){0u, 0u, 0u, 0u}, g1 = g0;
            const int gs = (tid_ & 255) >> 4, gc8 = (tid_ & 15) * 8;
#define HG_GLOAD(c) do { const int st = (c) * 16 + gs, n = dir ? (len - 1 - st) : st; const size_t o = (size_t)(rbase + n) * 1024 + h * 128 + gc8; \
                if (tid_ < 256) { g0 = *(const u32x4*)(BQ + o); g1 = *(const u32x4*)(BF + o); } else { g0 = *(const u32x4*)(BI + o); } } while (0)
#define HG_RAWW(c) do { LAS unsigned char* rw = lds + RAWOFF + ((c) & 1) * RAWSZ + gs * 272 + gc8 * 2; \
                if (tid_ < 256) { *(LAS u32x4*)(rw) = g0; *(LAS u32x4*)(rw + 4352) = g1; } else { *(LAS u32x4*)(rw + 8704) = g0; } } while (0)
#define HG_STAGE(c, bufp) do { float fv[4], cb[4]; float run = 0.f; unsigned short rq[4], rf[4], ri[4]; \
                { const LAS unsigned char* rr = lds + RAWOFF + ((c) & 1) * RAWSZ + kch * 2; _Pragma("unroll") for (int j = 0; j < 4; ++j) { rq[j] = *(const LAS bf16_t*)(rr + (4 * q + j) * 272); rf[j] = *(const LAS bf16_t*)(rr + 4352 + (4 * q + j) * 272); ri[j] = *(const LAS bf16_t*)(rr + 8704 + (4 * q + j) * 272); } } \
                _Pragma("unroll") for (int j = 0; j < 4; ++j) { const float xf = __uint_as_float(((unsigned)rf[j]) << 16); fv[j] = lbv + (1.0f - lbv) * fast_sigmoid(xf); run += flog(fv[j]); cb[j] = run; } \
                const float t0 = __shfl(run, m), t1 = __shfl(run, m + 16), t2 = __shfl(run, m + 32); \
                const float off = (q > 0 ? t0 : 0.f) + (q > 1 ? t1 : 0.f) + (q > 2 ? t2 : 0.f); \
                float qh[4], kh[4]; \
                _Pragma("unroll") for (int j = 0; j < 4; ++j) { const float bb = off + cb[j], bc = fmaxf(bb, -80.0f); qh[j] = __uint_as_float(((unsigned)rq[j]) << 16) * fexp(bc); kh[j] = (1.0f - fv[j]) * fexp(-bc);     \
                    if (j == 3 && q == 3) *(LAS float*)((bufp) + OE + kch * 4) = fexp(bb); } \
                const unsigned q01 = cvt_pk_bf16(qh[0], qh[1]), q23 = cvt_pk_bf16(qh[2], qh[3]), k01 = cvt_pk_bf16(kh[0], kh[1]), k23 = cvt_pk_bf16(kh[2], kh[3]); \
                *(LAS bf16_t*)((bufp) + OQ + (4 * q + 0) * 272 + kch * 2) = (bf16_t)(q01 & 0xffffu); *(LAS bf16_t*)((bufp) + OQ + (4 * q + 1) * 272 + kch * 2) = (bf16_t)(q01 >> 16); \
                *(LAS bf16_t*)((bufp) + OQ + (4 * q + 2) * 272 + kch * 2) = (bf16_t)(q23 & 0xffffu); *(LAS bf16_t*)((bufp) + OQ + (4 * q + 3) * 272 + kch * 2) = (bf16_t)(q23 >> 16); \
                *(LAS bf16_t*)((bufp) + OKH + (4 * q + 0) * 272 + kch * 2) = (bf16_t)(k01 & 0xffffu); *(LAS bf16_t*)((bufp) + OKH + (4 * q + 1) * 272 + kch * 2) = (bf16_t)(k01 >> 16); \
                *(LAS bf16_t*)((bufp) + OKH + (4 * q + 2) * 272 + kch * 2) = (bf16_t)(k23 & 0xffffu); *(LAS bf16_t*)((bufp) + OKH + (4 * q + 3) * 272 + kch * 2) = (bf16_t)(k23 >> 16); \
                u32x2 kt2; kt2.x = k01; kt2.y = k23; *(LAS u32x2*)((bufp) + OKT + kch * 48 + q * 8) = kt2; \
                u32x2 it2; it2.x = (unsigned)ri[0] | ((unsigned)ri[1] << 16); it2.y = (unsigned)ri[2] | ((unsigned)ri[3] << 16); *(LAS u32x2*)((bufp) + OIT + kch * 48 + q * 8) = it2; } while (0)
#define HG_COMPUTE(c) do { \
                LAS unsigned char* buf = lds + ((c) & 1) * BUFSZ; \
                f32x4 at = (f32x4){0.f, 0.f, 0.f, 0.f}; \
                _Pragma("unroll") \
                for (int kb = 0; kb < 4; ++kb) { const bf16x8 a = *(const LAS bf16x8*)(buf + OKH + m * 272 + kb * 64 + q * 16), bq = *(const LAS bf16x8*)(buf + OQ + m * 272 + kb * 64 + q * 16); \
                    at = __builtin_amdgcn_mfma_f32_16x16x32_bf16(a, bq, at, 0, 0, 0); } \
                asm volatile("s_nop 15\n s_nop 15" : "+v"(at)); \
                _Pragma("unroll") \
                for (int r = 0; r < 4; ++r) at[r] = (4 * q + r <= m) ? at[r] : 0.f; \
                const bf16x8 attB = mk_bf16x8(cvt_pk_bf16(at[0], at[1]), cvt_pk_bf16(at[2], at[3]), 0u, 0u); \
                f32x4 oacc = (f32x4){0.f, 0.f, 0.f, 0.f}; \
                _Pragma("unroll") \
                for (int kb = 0; kb < 4; ++kb) { \
                    const bf16x8 a = mk_bf16x8(cvt_pk_bf16(Sacc[2 * kb][0], Sacc[2 * kb][1]), cvt_pk_bf16(Sacc[2 * kb][2], Sacc[2 * kb][3]), cvt_pk_bf16(Sacc[2 * kb + 1][0], Sacc[2 * kb + 1][1]), cvt_pk_bf16(Sacc[2 * kb + 1][2], Sacc[2 * kb + 1][3])); \
                    const u32x2 b0 = *(const LAS u32x2*)(buf + OQ + m * 272 + (32 * kb + 4 * q) * 2), b1 = *(const LAS u32x2*)(buf + OQ + m * 272 + (32 * kb + 16 + 4 * q) * 2); \
                    oacc = __builtin_amdgcn_mfma_f32_16x16x32_bf16(a, mk_bf16x8(b0.x, b0.y, b1.x, b1.y), oacc, 0, 0, 0); } \
                { const u32x2 i0 = *(const LAS u32x2*)(buf + OIT + (16 * w + m) * 48 + q * 8); \
                  oacc = __builtin_amdgcn_mfma_f32_16x16x32_bf16(mk_bf16x8(i0.x, i0.y, 0u, 0u), attB, oacc, 0, 0, 0); } \
                asm volatile("s_nop 15\n s_nop 15" : "+v"(oacc)); \
                { const int st = (c) * 16 + m, n = dir ? (len - 1 - st) : st; \
                  u32x2 o2; o2.x = cvt_pk_bf16(oacc[0], oacc[1]); o2.y = cvt_pk_bf16(oacc[2], oacc[3]); \
                  if (!dry || p.ws == nullptr) *(u32x2*)(BF + (size_t)(rbase + n) * 1024 + h * 128 + 16 * w + 4 * q) = o2; } \
                u32x4 bsu = (u32x4){0u, 0u, 0u, 0u}; \
                if (q < 2) bsu = *(const LAS u32x4*)(buf + OIT + (16 * w + m) * 48 + q * 16); \
                const bf16x8 bs = __builtin_bit_cast(bf16x8, bsu); \
                _Pragma("unroll") \
                for (int kt = 0; kt < 8; ++kt) { u32x4 au = (u32x4){0u, 0u, 0u, 0u}; \
                    if (q < 2) au = *(const LAS u32x4*)(buf + OKT + (16 * kt + m) * 48 + q * 16); \
                    Sacc[kt] = __builtin_amdgcn_mfma_f32_16x16x32_bf16(__builtin_bit_cast(bf16x8, au), bs, Sacc[kt], 0, 0, 0); } \
                asm volatile("s_nop 15\n s_nop 15" : "+v"(Sacc[0]), "+v"(Sacc[1]), "+v"(Sacc[2]), "+v"(Sacc[3]), "+v"(Sacc[4]), "+v"(Sacc[5]), "+v"(Sacc[6]), "+v"(Sacc[7])); \
                _Pragma("unroll") \
                for (int kt = 0; kt < 8; ++kt) Sacc[kt] *= *(const LAS f32x4*)(buf + OE + (16 * kt + 4 * q) * 4); \
                } while (0)
            HG_GLOAD(0); HG_RAWW(0);
            if (nch > 1) { HG_GLOAD(1); HG_RAWW(1); }
            if (nch > 2) HG_GLOAD(2);
            __syncthreads();
            HG_STAGE(0, lds);
            __syncthreads();
            for (int c = 0; c < nch; ++c) {
                if (c + 2 < nch) { HG_RAWW(c + 2); if (c + 3 < nch) HG_GLOAD(c + 3); }
                if (c + 1 < nch) HG_STAGE(c + 1, lds + ((c + 1) & 1) * BUFSZ);
                HG_COMPUTE(c);
                __syncthreads();
            }
#undef HG_COMPUTE
#undef HG_GLOAD
#undef HG_RAWW
#undef HG_STAGE
        }
        __syncthreads();
    }
}
__device__ __forceinline__ void phase_hcomb(const Params& p, int l, int M, bool dry = false) {
    const int tid_ = otid();
    const int lane = tid_ & 63, gw = blockIdx.x * 8 + __builtin_amdgcn_readfirstlane(tid_ >> 6), nw = gridDim.x * 8;
    unsigned char* P = p.ws + OFF_P;
    bf16_t* OF = (bf16_t*)(P + P_BFF); const bf16_t* OB = (const bf16_t*)(P + P_BFB); const bf16_t* BG = (const bf16_t*)(P + P_BG);
    const float* hg = p.hn_g + (size_t)l * 1024 + lane * 16;
    for (int r = gw; r < M; r += nw) {
        const size_t o = (size_t)r * 1024 + lane * 16;
        float x[16]; float ss = 0.f;
#pragma unroll
        for (int hh = 0; hh < 2; ++hh) { const u32x4 a = *(const u32x4*)(OF + o + hh * 8), bq = *(const u32x4*)(OB + o + hh * 8);
            const unsigned aa[4] = {a.x, a.y, a.z, a.w}, bb[4] = {bq.x, bq.y, bq.z, bq.w};
#pragma unroll
            for (int j = 0; j < 4; ++j) { x[hh * 8 + 2 * j] = bf_lo(aa[j]) + bf_lo(bb[j]); x[hh * 8 + 2 * j + 1] = bf_hi(aa[j]) + bf_hi(bb[j]); } }
#pragma unroll
        for (int j = 0; j < 16; ++j) ss += x[j] * x[j];
        ss += __shfl_xor(ss, 1); ss += __shfl_xor(ss, 2); ss += __shfl_xor(ss, 4);
        const float rs = rsqrtf(ss * (1.0f / 128.0f) + 1e-6f);
#pragma unroll
        for (int hh = 0; hh < 2; ++hh) { const u32x4 gq = *(const u32x4*)(BG + o + hh * 8); const unsigned gg[4] = {gq.x, gq.y, gq.z, gq.w};
            float y[8];
#pragma unroll
            for (int j = 0; j < 4; ++j) { y[2 * j] = x[hh * 8 + 2 * j] * rs * hg[hh * 8 + 2 * j] * bf_lo(gg[j]); y[2 * j + 1] = x[hh * 8 + 2 * j + 1] * rs * hg[hh * 8 + 2 * j + 1] * bf_hi(gg[j]); }
            u32x4 w; w.x = cvt_pk_bf16(y[0], y[1]); w.y = cvt_pk_bf16(y[2], y[3]); w.z = cvt_pk_bf16(y[4], y[5]); w.w = cvt_pk_bf16(y[6], y[7]);
            if (!dry || p.ws == nullptr) *(u32x4*)(OF + o + hh * 8) = w; }
    }
}

__device__ __forceinline__ bf16x8 pack_bf16x8(const float (&v)[8]) {
    const unsigned a = cvt_pk_bf16(v[0], v[1]), b = cvt_pk_bf16(v[2], v[3]), c = cvt_pk_bf16(v[4], v[5]), d = cvt_pk_bf16(v[6], v[7]);
    u32x4 q; q.x = a; q.y = b; q.z = c; q.w = d;
    return __builtin_bit_cast(bf16x8, q);
}
__device__ __forceinline__ void phase_s5(const Params& p, int l, LAS unsigned char* lds) {
    const int tid_ = otid();
    const int lane = tid_ & 63, w = __builtin_amdgcn_readfirstlane(tid_ >> 6);
    if (w >= 6) return;
    LAS float* BU = (LAS float*)(lds + w * 12800);
    LAS unsigned char* XB = lds + w * 12800 + 8448;
    const int lq = lane >> 4, lr = lane & 15;
    const bf16_t* CU = (const bf16_t*)(p.ws + OFF_P + P_CU);
    const float* s5lam = (const float*)(p.ws + OFF_S5LAM); const float* s5bb = (const float*)(p.ws + OFF_S5BB);
    for (int s = w * (int)gridDim.x + (int)blockIdx.x; s < 1536; s += 6 * (int)gridDim.x) {
        const int dir = s & 1, g = (s >> 1) % 48, b = s / 96;
        const int ldg = (l * 2 + dir) * 48 + g;
        const float lre = s5lam[(size_t)(ldg * 64 + lane) * 2], lim = s5lam[(size_t)(ldg * 64 + lane) * 2 + 1];
        bf16x8 bbf[8], cf[4];
#pragma unroll
        for (int nt = 0; nt < 8; ++nt) { const int col = nt * 16 + lr, pp = col >> 1, c = col & 1; float v[8];
#pragma unroll
            for (int j = 0; j < 8; ++j) v[j] = (lq < 2) ? s5bb[(size_t)(ldg * 64 + pp) * 32 + c * 16 + lq * 8 + j] : 0.f;
            bbf[nt] = pack_bf16x8(v); }
#pragma unroll
        for (int kb = 0; kb < 4; ++kb) { float v[8];
#pragma unroll
            for (int j = 0; j < 8; ++j) { const int k = kb * 32 + lq * 8 + j, pp = k >> 1; const size_t ci = ((size_t)ldg * 16 + lr) * 64 + pp;
                v[j] = (k & 1) ? -p.c_im[ci] : p.c_re[ci]; }
            cf[kb] = pack_bf16x8(v); }
        bf16_t* YS = (bf16_t*)(p.ws + OFF_H + (dir ? H_YSB : H_YSF));
        float xr = 0.f, xi = 0.f;
        for (int seg = 0; seg < 2; ++seg) {
            const int len = seg == 0 ? CTXL : SEQ, rbase = seg == 0 ? TL + b * CTXL : b * SEQ, nblk = len / 64;
            u32x4 unext[4];
#pragma unroll
            for (int tt = 0; tt < 4; ++tt) { unext[tt] = (u32x4){0u, 0u, 0u, 0u};
                if (lq < 2) { const int st = tt * 16 + lr, n = dir ? (len - 1 - st) : st; unext[tt] = *(const u32x4*)(CU + (size_t)(rbase + n) * 768 + g * 16 + lq * 8); } }
            for (int blk = 0; blk < nblk; ++blk) {
                u32x4 ucur[4];
#pragma unroll
                for (int tt = 0; tt < 4; ++tt) ucur[tt] = unext[tt];
                if (blk + 1 < nblk && lq < 2) {
#pragma unroll
                    for (int tt = 0; tt < 4; ++tt) { const int st = (blk + 1) * 64 + tt * 16 + lr, n = dir ? (len - 1 - st) : st; unext[tt] = *(const u32x4*)(CU + (size_t)(rbase + n) * 768 + g * 16 + lq * 8); } }
#pragma unroll
                for (int tt = 0; tt < 4; ++tt) {
                    const bf16x8 uf = __builtin_bit_cast(bf16x8, ucur[tt]);
                    f32x4 dd[8];
#pragma unroll
                    for (int nt = 0; nt < 8; ++nt) dd[nt] = __builtin_amdgcn_mfma_f32_16x16x32_bf16(bbf[nt], uf, (f32x4){0.f, 0.f, 0.f, 0.f}, 0, 0, 0);
                    asm volatile("s_nop 15\n s_nop 15" : "+v"(dd[0]), "+v"(dd[1]), "+v"(dd[2]), "+v"(dd[3]), "+v"(dd[4]), "+v"(dd[5]), "+v"(dd[6]), "+v"(dd[7]));
#pragma unroll
                    for (int nt = 0; nt < 8; ++nt) *(LAS f32x4*)(BU + lr * 132 + nt * 16 + lq * 4) = dd[nt];
                    asm volatile("s_waitcnt lgkmcnt(0)" ::: "memory");
                    f32x2 bu[16];
#pragma unroll
                    for (int t = 0; t < 16; ++t) bu[t] = *(const LAS f32x2*)(BU + t * 132 + 2 * lane);
#pragma unroll
                    for (int t = 0; t < 16; ++t) { const float nr = lre * xr - lim * xi + bu[t].x, ni = lre * xi + lim * xr + bu[t].y; xr = nr; xi = ni;
                        *(LAS unsigned*)(XB + t * 272 + lane * 4) = cvt_pk_bf16(xr, xi); }
                    asm volatile("s_waitcnt lgkmcnt(0)" ::: "memory");
                    f32x4 acc = (f32x4){0.f, 0.f, 0.f, 0.f};
#pragma unroll
                    for (int kb = 0; kb < 4; ++kb) { const bf16x8 xf = *(const LAS bf16x8*)(XB + lr * 272 + kb * 64 + lq * 16); acc = __builtin_amdgcn_mfma_f32_16x16x32_bf16(cf[kb], xf, acc, 0, 0, 0); }
                    asm volatile("s_nop 15\n s_nop 15\n s_waitcnt lgkmcnt(0)" : "+v"(acc) :: "memory");
                    const int st = blk * 64 + tt * 16 + lr, n = dir ? (len - 1 - st) : st;
                    u32x2 o; o.x = cvt_pk_bf16(acc[0], acc[1]); o.y = cvt_pk_bf16(acc[2], acc[3]);
                    *(u32x2*)(YS + (size_t)(rbase + n) * 768 + g * 16 + lq * 4) = o;
                }
            }
        }
    }
}
__device__ __forceinline__ void phase_s5post(const Params& p, int l, int M, bool dry = false) {
    const int tid_ = otid();
    const size_t n8 = (size_t)M * 768 / 8;
    bf16_t* YF = (bf16_t*)(p.ws + OFF_H + H_YSF); const bf16_t* YB = (const bf16_t*)(p.ws + OFF_H + H_YSB); const bf16_t* CU = (const bf16_t*)(p.ws + OFF_P + P_CU);
    const float* dsk = p.s5_d + (size_t)l * 768;
    for (size_t i = (size_t)blockIdx.x * NTHREADS + tid_; i < n8; i += (size_t)gridDim.x * NTHREADS) {
        const int c = (int)((i * 8) % 768);
        const u32x4 a = *(const u32x4*)(YF + i * 8), bq = *(const u32x4*)(YB + i * 8), uq = *(const u32x4*)(CU + i * 8);
        const unsigned aa[4] = {a.x, a.y, a.z, a.w}, bb[4] = {bq.x, bq.y, bq.z, bq.w}, uu[4] = {uq.x, uq.y, uq.z, uq.w};
        float y[8];
#pragma unroll
        for (int j = 0; j < 4; ++j) { y[2 * j] = gelu_f(bf_lo(aa[j]) + bf_lo(bb[j]) + dsk[c + 2 * j] * bf_lo(uu[j])); y[2 * j + 1] = gelu_f(bf_hi(aa[j]) + bf_hi(bb[j]) + dsk[c + 2 * j + 1] * bf_hi(uu[j])); }
        u32x4 w; w.x = cvt_pk_bf16(y[0], y[1]); w.y = cvt_pk_bf16(y[2], y[3]); w.z = cvt_pk_bf16(y[4], y[5]); w.w = cvt_pk_bf16(y[6], y[7]);
        if (!dry || p.ws == nullptr) *(u32x4*)(YF + i * 8) = w;
    }
}

__device__ __forceinline__ void phase_gmlp(const Params& p, int l, int M, LAS unsigned char* lds, bool dry = false) {
    const int tid_ = otid();
    LAS unsigned char* Wb = lds;
    LAS unsigned char* Vt = lds + 34816;
    LAS float* st = (LAS float*)(lds + 69632);
    const int tid = tid_, lane = tid & 63, w = __builtin_amdgcn_readfirstlane(tid_ >> 6), q = lane >> 4, m = lane & 15;
    bf16_t* AU = (bf16_t*)(p.ws + OFF_P + P_AU); const bf16_t* AV = (const bf16_t*)(p.ws + OFF_P + P_AV);
    const float* lng = p.ln_g + (size_t)l * 1024; const float* lnb = p.ln_b + (size_t)l * 1024;
    const int nch = M / 128, G_ = (int)gridDim.x, nfull = (nch / G_) * G_, nitem = nfull + (nch - nfull) * 8;
    for (int it = blockIdx.x; it < nitem; it += G_) {
        const int u = it < nfull ? it : nfull + ((it - nfull) >> 3), g0 = it < nfull ? 0 : ((it - nfull) & 7), g1 = it < nfull ? 8 : g0 + 1;
        const size_t r0 = (size_t)u * 128;
        for (int i = 0; i < 16; ++i) {
            const int s = w * 16 + i; const bf16_t* rp = AV + (r0 + s) * 1024 + lane * 16;
            const u32x4 a = *(const u32x4*)rp, bq = *(const u32x4*)(rp + 8);
            const unsigned aa[8] = {a.x, a.y, a.z, a.w, bq.x, bq.y, bq.z, bq.w};
            float sm = 0.f, sq = 0.f;
#pragma unroll
            for (int j = 0; j < 8; ++j) { const float x0 = bf_lo(aa[j]), x1 = bf_hi(aa[j]); sm += x0 + x1; sq += x0 * x0 + x1 * x1; }
            sm = wave_sum(sm); sq = wave_sum(sq);
            const float mean = sm * (1.0f / 1024.0f), var = fmaxf(sq * (1.0f / 1024.0f) - mean * mean, 0.f);
            if (lane == 0) { st[s * 2] = mean; st[s * 2 + 1] = rsqrtf(var + 1e-6f); }
        }
        __syncthreads();
        for (int g = g0; g < g1; ++g) {
            { const int t = tid >> 2, s0 = (tid & 3) * 32; const float* ws = p.w_s + ((size_t)l * 8 + g) * 16384 + t * 128 + s0;
#pragma unroll
              for (int qq = 0; qq < 4; ++qq) { const f32x4 a = *(const f32x4*)(ws + qq * 8), b4 = *(const f32x4*)(ws + qq * 8 + 4);
                  u32x4 o; o.x = cvt_pk_bf16(a[0], a[1]); o.y = cvt_pk_bf16(a[2], a[3]); o.z = cvt_pk_bf16(b4[0], b4[1]); o.w = cvt_pk_bf16(b4[2], b4[3]);
                  *(LAS u32x4*)(Wb + t * 272 + (s0 + qq * 8) * 2) = o; } }
            { const int s = tid >> 2, c0 = (tid & 3) * 32; const bf16_t* rp = AV + (r0 + s) * 1024 + g * 128 + c0;
              const float mean = st[s * 2], rstd = st[s * 2 + 1];
#pragma unroll
              for (int qq = 0; qq < 4; ++qq) { const u32x4 a = *(const u32x4*)(rp + qq * 8); const unsigned aa[4] = {a.x, a.y, a.z, a.w};
#pragma unroll
                  for (int j = 0; j < 4; ++j) { const int cl = c0 + qq * 8 + 2 * j, c = g * 128 + cl;
                      const unsigned pk = cvt_pk_bf16((bf_lo(aa[j]) - mean) * rstd * lng[c] + lnb[c], (bf_hi(aa[j]) - mean) * rstd * lng[c + 1] + lnb[c + 1]);
                      *(LAS bf16_t*)(Vt + cl * 272 + s * 2) = (bf16_t)(pk & 0xffffu); *(LAS bf16_t*)(Vt + (cl + 1) * 272 + s * 2) = (bf16_t)(pk >> 16); } } }
            __syncthreads();
            bf16x8 af[4];
#pragma unroll
            for (int kb = 0; kb < 4; ++kb) af[kb] = *(const LAS bf16x8*)(Vt + (16 * w + m) * 272 + kb * 64 + q * 16);
            const float* bs = p.b_s + ((size_t)l * 8 + g) * 128;
#pragma unroll
            for (int tt = 0; tt < 8; ++tt) {
                f32x4 acc = (f32x4){0.f, 0.f, 0.f, 0.f};
#pragma unroll
                for (int kb = 0; kb < 4; ++kb) acc = __builtin_amdgcn_mfma_f32_16x16x32_bf16(af[kb], *(const LAS bf16x8*)(Wb + (16 * tt + m) * 272 + kb * 64 + q * 16), acc, 0, 0, 0);
                const float bb = bs[16 * tt + m];
                bf16_t* up = AU + (r0 + 16 * tt + m) * 1024 + g * 128 + 16 * w + 4 * q;
                const u32x2 uw = *(const u32x2*)up;
                const float y0 = (acc[0] + bb) * bf_lo(uw.x), y1 = (acc[1] + bb) * bf_hi(uw.x), y2 = (acc[2] + bb) * bf_lo(uw.y), y3 = (acc[3] + bb) * bf_hi(uw.y);
                u32x2 o; o.x = cvt_pk_bf16(y0, y1); o.y = cvt_pk_bf16(y2, y3);
                if (!dry || p.ws == nullptr) *(u32x2*)up = o;
            }
            __syncthreads();
        }
    }
}

__device__ __forceinline__ unsigned fkey(float x) { const unsigned b = __float_as_uint(x); return b ^ ((b >> 31) ? 0xFFFFFFFFu : 0x80000000u); }
__device__ __forceinline__ int mbcnt64(unsigned long long m) { return __builtin_amdgcn_mbcnt_hi((unsigned)(m >> 32), __builtin_amdgcn_mbcnt_lo((unsigned)m, 0u)); }
template <int NV>
__device__ __forceinline__ int count_ge(const unsigned (&k)[NV], unsigned cand) {
    int cnt = 0;
#pragma unroll
    for (int i = 0; i < NV; ++i) cnt += __popcll(__ballot(k[i] >= cand));
    return cnt;
}
template <int NV>
__device__ __forceinline__ unsigned radix_thr16(const unsigned (&k)[NV], unsigned e0bits) {
    unsigned prefix = 0u; int bit = 31;
    {
        const unsigned c0 = e0bits ^ 0x80000000u, c1 = c0 + 0x00800000u, c2 = c0 + 0x01000000u, c3 = c0 + 0x01800000u;
        const int n0 = count_ge<NV>(k, c0), n1 = count_ge<NV>(k, c1), n2 = count_ge<NV>(k, c2), n3 = count_ge<NV>(k, c3);
        if (n0 >= 16 && n3 < 16) { prefix = (n2 >= 16) ? c2 : ((n1 >= 16) ? c1 : c0); bit = 22;
            const int nn = (n2 >= 16) ? n2 : ((n1 >= 16) ? n1 : n0); if (nn == 16) bit = -1; }
    }
    for (; bit >= 0; --bit) {
        const unsigned cand = prefix | (1u << bit);
        const int cnt = count_ge<NV>(k, cand);
        if (cnt >= 16) prefix = cand;
        if (cnt == 16) break;
    }
    return prefix;
}
__device__ __forceinline__ unsigned umin_(unsigned a, unsigned b) { return a < b ? a : b; }
__device__ __forceinline__ unsigned umax_(unsigned a, unsigned b) { return a > b ? a : b; }
__device__ __forceinline__ unsigned med3u(unsigned x, unsigned y, unsigned z) { return umax_(umin_(x, y), umin_(umax_(x, y), z)); }
__device__ __forceinline__ float unkey(unsigned k) { return __uint_as_float((k & 0x80000000u) ? (k ^ 0x80000000u) : ~k); }
__device__ __forceinline__ void ins16(unsigned (&a)[16], unsigned x) {
#pragma unroll
    for (int s = 15; s >= 1; --s) a[s] = med3u(a[s - 1], x, a[s]);
    a[0] = umax_(a[0], x);
}
__device__ __forceinline__ unsigned sel16(const unsigned (&a)[16], int i) {
    unsigned r = a[0];
#pragma unroll
    for (int t = 1; t < 16; ++t) r = (i == t) ? a[t] : r;
    return r;
}
__device__ __forceinline__ void phase_topk(const Params& p, int M, LAS unsigned char* lds) {
    const int tid_ = otid();
    LAS unsigned* lk = (LAS unsigned*)lds + tid_;
    const int gl = blockIdx.x * NTHREADS + tid_, nl = gridDim.x * NTHREADS;
    const float* SC = (const float*)(p.ws + OFF_P + Q_SC);
    int* IDX = (int*)(p.ws + OFF_P + Q_IDX); float* GATE = (float*)(p.ws + OFF_P + Q_GATE);
    const int ntask = M * 8;
    for (int task = gl; task < ntask; task += nl) {
        const float* sc = SC + (size_t)task * 256;
        unsigned a[16], b[16];
#pragma unroll
        for (int i = 0; i < 16; ++i) { a[i] = 0u; b[i] = 0u; }
#pragma unroll 4
        for (int i4 = 0; i4 < 32; ++i4) {
            const f32x4 va = *(const f32x4*)(sc + i4 * 4), vb = *(const f32x4*)(sc + 128 + i4 * 4);
#pragma unroll
            for (int e = 0; e < 4; ++e) { const unsigned tag = 127u - (unsigned)(i4 * 4 + e);
                ins16(a, (fkey(va[e]) & ~127u) | tag); ins16(b, (fkey(vb[e]) & ~127u) | tag); }
        }
        float fa[16], fb[16];
#pragma unroll
        for (int i = 0; i < 16; ++i) { fa[i] = unkey(a[i] & ~127u); fb[i] = unkey(b[i] & ~127u); }
        unsigned c[16];
#pragma unroll
        for (int i = 0; i < 16; ++i) c[i] = 0u;
#pragma unroll
        for (int i = 0; i < 16; ++i)
#pragma unroll
            for (int j = 0; j < 16; ++j)
                if ((i + 1) * (j + 1) <= 16) ins16(c, (fkey(fa[i] + fb[j]) & ~255u) | (unsigned)(i * 16 + j));
#pragma unroll
        for (int i = 0; i < 16; ++i) { lk[i * 512] = a[i]; lk[(16 + i) * 512] = b[i]; }
        const float mx = unkey(c[0] & ~255u);
        float ev[16]; float sm = 0.f; int id[16];
#pragma unroll
        for (int s = 0; s < 16; ++s) { ev[s] = __expf(unkey(c[s] & ~255u) - mx); sm += ev[s];
            const int ij = (int)(c[s] & 255u);
            const unsigned ka = lk[(ij >> 4) * 512], kb = lk[(16 + (ij & 15)) * 512];
            id[s] = (int)(127u - (ka & 127u)) * 128 + (int)(127u - (kb & 127u)); }
        const float inv = 1.0f / sm;
#pragma unroll
        for (int q = 0; q < 4; ++q) {
            u32x4 iw; iw.x = (unsigned)id[4 * q]; iw.y = (unsigned)id[4 * q + 1]; iw.z = (unsigned)id[4 * q + 2]; iw.w = (unsigned)id[4 * q + 3];
            *(u32x4*)(IDX + (size_t)task * 16 + q * 4) = iw;
            *(f32x4*)(GATE + (size_t)task * 16 + q * 4) = (f32x4){ev[4 * q] * inv, ev[4 * q + 1] * inv, ev[4 * q + 2] * inv, ev[4 * q + 3] * inv};
        }
    }
}

__device__ __forceinline__ float dot2u(unsigned a, unsigned b, float acc) {
    return __builtin_amdgcn_fdot2_f32_bf16(__builtin_bit_cast(bf16x2_t, a), __builtin_bit_cast(bf16x2_t, b), acc, false);
}
__device__ __forceinline__ float dot8(const u32x4 a, const u32x4 b, float acc) {
    acc = dot2u(a.x, b.x, acc); acc = dot2u(a.y, b.y, acc); acc = dot2u(a.z, b.z, acc); acc = dot2u(a.w, b.w, acc);
    return acc;
}
__device__ __forceinline__ void phase_peer(const Params& p, int l, int M, LAS unsigned char* lds, bool dry = false) {
    const int tid_ = otid();
    const int lane = tid_ & 63, wv_ = __builtin_amdgcn_readfirstlane(tid_ >> 6), gw = blockIdx.x * 8 + wv_, nw = gridDim.x * 8;
    LAS float* wl = (LAS float*)(lds + wv_ * 512);
    const bf16_t* H = (const bf16_t*)(p.ws + OFF_H);
    const unsigned char* U6 = p.ws + OFF_P + Q_UT; const unsigned char* V6 = p.ws + OFF_P + Q_VT;
    const float* USC = (const float*)(p.ws + OFF_P + Q_USC); const float* VSC = (const float*)(p.ws + OFF_P + Q_VSC);
    const int* IDX = (const int*)(p.ws + OFF_P + Q_IDX); const float* GATE = (const float*)(p.ws + OFF_P + Q_GATE);
    const float* modl = (const float*)(p.ws + OFF_MODV) + (size_t)l * 17 * NMOD + 10240;
    float* XC = (float*)(p.ws + OFF_XC);
    const unsigned lane24 = (unsigned)lane * 24u, lane16 = (unsigned)lane * 16u;
#define PEER_LOAD(buf, TAB, g) do { const int _is = ((g) < 8) ? id0 : id1; _Pragma("unroll") for (int e = 0; e < 8; ++e) { \
        const int _id = __builtin_amdgcn_readlane(_is, (((g) * 8 + e) & 63)); const unsigned char* _rb = (TAB) + (size_t)(unsigned)_id * 1536u; \
        const u32x4 _a = *(const u32x4*)(_rb + lane24); const u32x2 _b = *(const u32x2*)(_rb + lane24 + 16); \
        buf[e][0] = _a.x; buf[e][1] = _a.y; buf[e][2] = _a.z; buf[e][3] = _a.w; buf[e][4] = _b.x; buf[e][5] = _b.y; } } while (0)
    for (int row = gw; row < M; row += nw) {
        unsigned xw[16];
#pragma unroll
        for (int j = 0; j < 8; ++j) { const u32x2 a = *(const u32x2*)(H + (size_t)row * D + j * 256 + lane * 4); xw[2 * j] = a.x; xw[2 * j + 1] = a.y; }
        const int id0 = IDX[(size_t)row * 128 + lane], id1 = IDX[(size_t)row * 128 + 64 + lane];
        const float g0 = GATE[(size_t)row * 128 + lane], g1 = GATE[(size_t)row * 128 + 64 + lane];
        const float us0 = USC[id0], us1 = USC[id1];
        const float gv0 = g0 * VSC[id0], gv1 = g1 * VSC[id1];
        u32x6 bA[8];
#pragma unroll 1
        for (int g = 0; g < 16; ++g) {
            PEER_LOAD(bA, U6, g);
            float part[8];
            float chain = 0.f;
#pragma unroll
            for (int e = 0; e < 8; ++e) { asm volatile("" : "+v"(bA[e]), "+v"(chain));
                const bf16x32_t ub = __builtin_amdgcn_cvt_scalef32_pk32_bf16_fp6(bA[e], 1.0f);
                const u32x16 uw = __builtin_bit_cast(u32x16, ub);
                float a0 = 0.f, a1 = 0.f;
#pragma unroll
                for (int i = 0; i < 8; ++i) { const unsigned w0 = uw[2 * i], w1 = uw[2 * i + 1]; a0 = dot2u(w0, xw[2 * i], a0); a1 = dot2u(w1, xw[2 * i + 1], a1); }
                part[e] = a0 + a1; chain = part[e]; }
            float r4[4];
#pragma unroll
            for (int i = 0; i < 4; ++i) { const bool hi = (lane & 32) != 0; const float keep = hi ? part[i + 4] : part[i], send = hi ? part[i] : part[i + 4]; r4[i] = keep + __shfl_xor(send, 32); }
            float r2[2];
#pragma unroll
            for (int i = 0; i < 2; ++i) { const bool hi = (lane & 16) != 0; const float keep = hi ? r4[i + 2] : r4[i], send = hi ? r4[i] : r4[i + 2]; r2[i] = keep + __shfl_xor(send, 16); }
            float r1;
            { const bool hi = (lane & 8) != 0; const float keep = hi ? r2[1] : r2[0], send = hi ? r2[0] : r2[1]; r1 = keep + __shfl_xor(send, 8); }
            r1 += __shfl_xor(r1, 4); r1 += __shfl_xor(r1, 2); r1 += __shfl_xor(r1, 1);
            const int k = g * 8 + ((lane >> 3) & 7);
            const float usk = __shfl((g < 8) ? us0 : us1, k & 63), gvk = __shfl((g < 8) ? gv0 : gv1, k & 63);
            if ((lane & 7) == 0) wl[k] = gelu_f(r1 * usk) * gvk;
        }
        asm volatile("s_waitcnt lgkmcnt(0)" ::: "memory");
        float out[32];
#pragma unroll
        for (int i = 0; i < 32; ++i) out[i] = 0.f;
#pragma unroll 1
        for (int g = 0; g < 16; ++g) {
            u32x4 bV[8];
            { const int _is = (g < 8) ? id0 : id1;
#pragma unroll
              for (int e = 0; e < 8; ++e) { const int _id = __builtin_amdgcn_readlane(_is, ((g * 8 + e) & 63)); bV[e] = *(const u32x4*)(V6 + (size_t)(unsigned)_id * 1024u + lane16); } }
#pragma unroll
            for (int e = 0; e < 8; ++e) { const float wk = wl[g * 8 + e]; asm volatile("" : "+v"(bV[e]), "+v"(out[0]), "+v"(out[9]), "+v"(out[18]), "+v"(out[27]), "+v"(out[31]));
                const unsigned wd[4] = {bV[e].x, bV[e].y, bV[e].z, bV[e].w};
#pragma unroll
                for (int d = 0; d < 4; ++d) {
                    const f32x2 f0 = __builtin_amdgcn_cvt_scalef32_pk_f32_fp4(wd[d], 1.0f, 0), f1 = __builtin_amdgcn_cvt_scalef32_pk_f32_fp4(wd[d], 1.0f, 1),
                                f2 = __builtin_amdgcn_cvt_scalef32_pk_f32_fp4(wd[d], 1.0f, 2), f3 = __builtin_amdgcn_cvt_scalef32_pk_f32_fp4(wd[d], 1.0f, 3);
                    out[8 * d + 0] += wk * f0.x; out[8 * d + 1] += wk * f0.y; out[8 * d + 2] += wk * f1.x; out[8 * d + 3] += wk * f1.y;
                    out[8 * d + 4] += wk * f2.x; out[8 * d + 5] += wk * f2.y; out[8 * d + 6] += wk * f3.x; out[8 * d + 7] += wk * f3.y; } }
        }
        asm volatile("s_waitcnt lgkmcnt(0)" ::: "memory");
        const bool lat = row < TL; const int mb = lat ? (row >> 11) : 16;
        float* xp = lat ? p.out + (size_t)row * D : XC + (size_t)(row - TL) * D;
        const float* gv = modl + (size_t)mb * NMOD;
        f32x4 xn[8]; float ss = 0.f;
#pragma unroll
        for (int j = 0; j < 8; ++j) { const int e = j * 256 + lane * 4;
            const f32x4 o4 = (f32x4){out[4 * j], out[4 * j + 1], out[4 * j + 2], out[4 * j + 3]};
            xn[j] = *(const f32x4*)(xp + e) + *(const f32x4*)(gv + e) * o4;
            ss += xn[j][0] * xn[j][0] + xn[j][1] * xn[j][1] + xn[j][2] * xn[j][2] + xn[j][3] * xn[j][3]; }
        ss = wave_sum(ss);
        const float rs = rsqrtf(ss * (1.0f / 2048.0f) + 1e-6f);
        if (!dry || p.ws == nullptr) {
            if (l == 0) {
                const float* m1 = (const float*)(p.ws + OFF_MODV) + (size_t)17 * NMOD + (size_t)mb * NMOD;
                float am = 0.f;
#pragma unroll
                for (int j = 0; j < 8; ++j) { const int e = j * 256 + lane * 4;
                    *(f32x4*)(xp + e) = xn[j];
                    xn[j] = xn[j] * rs * (*(const f32x4*)(m1 + 2048 + e) + 1.0f) + *(const f32x4*)(m1 + e);
                    am = fmaxf(am, fmaxf(fmaxf(fabsf(xn[j][0]), fabsf(xn[j][1])), fmaxf(fabsf(xn[j][2]), fabsf(xn[j][3])))); }
#pragma unroll
                for (int o = 32; o >= 1; o >>= 1) am = fmaxf(am, __shfl_xor(am, o));
                const float qs = am > 0.f ? 240.0f / am : 1.0f;
                unsigned char* H8 = p.ws + OFF_H8 + (size_t)row * D;
#pragma unroll
                for (int j = 0; j < 8; ++j) *(unsigned*)(H8 + j * 256 + lane * 4) = pack_fp8x4(xn[j][0] * qs, xn[j][1] * qs, xn[j][2] * qs, xn[j][3] * qs);
                if (lane == 0) ((float*)(p.ws + OFF_HS))[row] = am > 0.f ? am * (1.0f / 240.0f) : 1.0f;
            } else {
#pragma unroll
                for (int j = 0; j < 8; ++j) { const int e = j * 256 + lane * 4; *(f32x4*)(xp + e) = xn[j] * rs * *(const f32x4*)(p.final_g + e); }
            }
        }
    }
#undef PEER_LOAD
}

__device__ __forceinline__ Params load_params() {
    Params r;
#if defined(__HIP_DEVICE_COMPILE__)
    typedef const unsigned long long __attribute__((address_space(4)))* KP;
    KP k = (KP)__builtin_amdgcn_kernarg_segment_ptr();
    asm volatile("" : "+s"(k));
    void** d = (void**)&r;
#pragma unroll
    for (int i = 0; i < (int)(sizeof(Params) / 8); ++i) d[i] = (void*)(__attribute__((address_space(1))) void*)k[i];
#endif
    return r;
}
#define WSP(off) (p.ws + (off))
template <int l>
__device__ __forceinline__ void mega_layer(LAS unsigned char* lds, const XcdBarrier& bar) {
        const int Mrows = (l == 0) ? TT : TL;
        const int GLU_ROT = (((Mrows / 256) * 6) % (int)gridDim.x) & ~7;
        if (l == 0) {
            { const Params p = load_params(); phase_wconv(p, 0, lds); }
            { const Params p = load_params(); phase_norm<0, true>(p, 0, TT, 0, 2048); }
            xcd_barrier(bar);
        }
        { const Params p = load_params(); EpiInProj E{WSP(OFF_P), (const float*)WSP(OFF_HS), (const unsigned*)WSP(OFF_CMAX) + (size_t)l * INC};
          run_gemm(lds, (const bf16_t*)WSP(OFF_H8), (const bf16_t*)WSP(OFF_W + W_IN), TT, INC, D / 2, E); }
        xcd_barrier(bar);
        { const Params p = load_params(); phase_hgrn(p, l, lds); }
        __syncthreads();
        { const Params p = load_params(); phase_s5(p, l, lds); }
        xcd_barrier(bar);
        { const Params p = load_params(); phase_gmlp(p, l, Mrows, lds); }
        { const Params p = load_params(); phase_hcomb(p, l, Mrows); }
        { const Params p = load_params(); phase_s5post(p, l, Mrows); }
        xcd_barrier(bar);
        { const Params p = load_params(); EpiGlu E{(bf16_t*)WSP(OFF_P + P_CU)}; run_gemm(lds, (const bf16_t*)WSP(OFF_H + H_YSF), (const bf16_t*)WSP(OFF_W + W_GLU), Mrows, 1536, 768, E); }
        { const Params p = load_params(); EpiMerge<true> E{(bf16_t*)WSP(OFF_P + P_MERGED), (const bf16_t*)WSP(OFF_P + P_GATES)}; run_gemm(lds, (const bf16_t*)WSP(OFF_P + P_AU), (const bf16_t*)WSP(OFF_W + W_A), Mrows, D, 1024, E, GLU_ROT); }
        { const Params p = load_params(); EpiMerge<false> E{(bf16_t*)WSP(OFF_P + P_MERGED), (const bf16_t*)WSP(OFF_P + P_GATES) + 2048}; run_gemm(lds, (const bf16_t*)WSP(OFF_P + P_BFF), (const bf16_t*)WSP(OFF_W + W_B), Mrows, D, 1024, E, GLU_ROT); }
        xcd_barrier(bar);
        { const Params p = load_params(); EpiMerge<false> E{(bf16_t*)WSP(OFF_P + P_MERGED), (const bf16_t*)WSP(OFF_P + P_GATES) + 4096}; run_gemm(lds, (const bf16_t*)WSP(OFF_P + P_CU), (const bf16_t*)WSP(OFF_W + W_C), Mrows, D, 768, E); }
        xcd_barrier(bar);
        { const Params p = load_params(); EpiResid E{p.out, (float*)WSP(OFF_XC), (const float*)WSP(OFF_MODV) + (size_t)l * 17 * NMOD + 4096}; run_gemm(lds, (const bf16_t*)WSP(OFF_P + P_MERGED), (const bf16_t*)WSP(OFF_W + W_O), Mrows, D, D, E); }
        { const Params p = load_params(); phase_tabconv(p, l); }
        xcd_barrier(bar);
        { const Params p = load_params(); phase_norm<1>(p, l, Mrows, 6144, 8192); }
        xcd_barrier(bar);
        { const Params p = load_params(); EpiF32 E{(float*)WSP(OFF_P + Q_SC), 2048}; run_gemm(lds, (const bf16_t*)WSP(OFF_H), (const bf16_t*)WSP(OFF_W + W_S), Mrows, D, D, E); }
        xcd_barrier(bar);
        { const Params p = load_params(); phase_topk(p, Mrows, lds); }
        xcd_barrier(bar);
        { const Params p = load_params(); phase_peer(p, l, Mrows, lds); }
        if (l == 0) {
            __syncthreads();
            { const Params p = load_params(); phase_wconv(p, 1, lds); }
            xcd_barrier(bar);
        }
}
#undef WSP
__global__ void __launch_bounds__(NTHREADS, 2) k_mega(Params p_kernarg_only) {
    extern __shared__ __attribute__((aligned(16))) unsigned char smem[];
    LAS unsigned char* lds = (LAS unsigned char*)smem;
    volatile LAS unsigned* xbw = (volatile LAS unsigned*)(lds + LDS_BYTES - 16);
    if (threadIdx.x == 0) { xbw[0] = 0u; xbw[1] = 0u; xbw[2] = 0u; xbw[3] = 0u; }
    __syncthreads();
    XcdBarrier bar;
    { const Params p = load_params(); bar = xcd_barrier_post((unsigned*)(p.ws + OFF_BAR), xbw); }
#define WSP(off) (p.ws + (off))
    { const Params p = load_params(); phase_colmax(p); }
    { const Params p = load_params(); phase_prep(p); phase_mod(p, lds); }
    xcd_barrier(bar);
    mega_layer<0>(lds, bar);
    mega_layer<1>(lds, bar);
#undef WSP
}

extern "C" void kernel_launch(void* const* d_in, const int* in_sizes, int n_in, void* d_out, int out_size, void* d_ws, size_t ws_size, hipStream_t stream) {
    (void)in_sizes; (void)n_in; (void)out_size; (void)ws_size;
    Params p;
    const float** f = (const float**)&p;
    for (int i = 0; i < 31; ++i) f[i] = (const float*)d_in[i];
    p.out = (float*)d_out; p.ws = (unsigned char*)d_ws;
    static int grid = 0;
    if (!grid) {
        int dev = 0, cus = 0, per_cu = 0;
        (void)hipGetDevice(&dev);
        (void)hipDeviceGetAttribute(&cus, hipDeviceAttributeMultiprocessorCount, dev);
        (void)hipFuncSetAttribute((const void*)k_mega, hipFuncAttributeMaxDynamicSharedMemorySize, LDS_BYTES);
        (void)hipOccupancyMaxActiveBlocksPerMultiprocessor(&per_cu, (const void*)k_mega, NTHREADS, LDS_BYTES);
        grid = (per_cu >= 1 && cus > 0) ? (cus < 256 ? cus : 256) : 256;
    }
    (void)hipMemsetAsync(p.ws + OFF_BAR, 0, OFF_MODV, stream);
    hipLaunchKernelGGL(k_mega, dim3(grid), dim3(NTHREADS), LDS_BYTES, stream, p);
}
```

```cpp
#include <hip/hip_runtime.h>
#include <stdint.h>

#define LAS __attribute__((address_space(3)))
typedef unsigned short bf16_t;
typedef short bf16x8 __attribute__((ext_vector_type(8)));
typedef float f32x4 __attribute__((ext_vector_type(4)));
typedef float f32x2 __attribute__((ext_vector_type(2)));
typedef _Float16 h16x2 __attribute__((ext_vector_type(2)));
typedef unsigned u32x4 __attribute__((ext_vector_type(4)));
typedef unsigned u32x2 __attribute__((ext_vector_type(2)));
typedef __bf16 bf16x2_t __attribute__((ext_vector_type(2)));
typedef __bf16 bf16x32_t __attribute__((ext_vector_type(32)));
typedef float f32x32 __attribute__((ext_vector_type(32)));
typedef unsigned u32x6 __attribute__((ext_vector_type(6)));
typedef unsigned u32x16 __attribute__((ext_vector_type(16)));

constexpr int D = 2048, NB = 16, SEQ = 2048, CTXL = 256;
constexpr int TL = NB * SEQ;
constexpr int TC = NB * CTXL;
constexpr int TT = TL + TC;
constexpr int INC = 14080;
constexpr int NMOD = 12288;
constexpr int NTHREADS = 512;
constexpr int LDS_BYTES = 160 * 1024;

constexpr size_t OFF_BAR = 0;
constexpr size_t OFF_CMAX = 16384;
constexpr size_t OFF_MODV = OFF_CMAX + (size_t)2 * INC * 4;
constexpr size_t OFF_LB = OFF_MODV + (size_t)2 * 17 * NMOD * 4;
constexpr size_t OFF_S5LAM = OFF_LB + 2 * 2 * 1024 * 4;
constexpr size_t OFF_S5BB = OFF_S5LAM + (size_t)2 * 2 * 48 * 64 * 2 * 4;
constexpr size_t OFF_PE = OFF_S5BB + (size_t)2 * 2 * 48 * 64 * 32 * 4;
constexpr size_t OFF_HS = (OFF_PE + (size_t)96 * 1024 * 4 + 255) & ~(size_t)255;
constexpr size_t OFF_XC = (OFF_HS + (size_t)TT * 4 + 255) & ~(size_t)255;
constexpr size_t OFF_H = OFF_XC + (size_t)TC * D * 4;
constexpr size_t OFF_W = OFF_H + (size_t)TT * D * 2;
constexpr size_t W_IN = 0;
constexpr size_t W_GLU = W_IN + (size_t)INC * D;
constexpr size_t W_A = W_GLU + (size_t)1536 * 768 * 2;
constexpr size_t W_B = W_A + (size_t)2048 * 1024 * 2;
constexpr size_t W_C = W_B + (size_t)2048 * 1024 * 2;
constexpr size_t W_O = W_C + (size_t)2048 * 768 * 2;
constexpr size_t W_S = W_O + (size_t)2048 * 2048 * 2;
constexpr size_t W_TOTAL = W_S + (size_t)2048 * 2048 * 2;
constexpr size_t OFF_P = OFF_W + W_TOTAL;
constexpr size_t SEG = (size_t)TT * 1024 * 2;
constexpr size_t P_AU = 0, P_AV = SEG, P_BQ = 2 * SEG, P_BFF = 3 * SEG, P_BFB = 4 * SEG, P_BI = 5 * SEG, P_BG = 6 * SEG;
constexpr size_t P_CU = 7 * SEG;
constexpr size_t P_GATES = P_CU + (size_t)TT * 768 * 2;
constexpr size_t P_TOTAL = P_GATES + (size_t)TT * 6144 * 2;
constexpr size_t P_MERGED = SEG;
constexpr size_t Q_UT = 0;
constexpr size_t Q_VT = Q_UT + (size_t)16384 * 1536;
constexpr size_t Q_USC = Q_VT + (size_t)16384 * 1536;
constexpr size_t Q_VSC = Q_USC + (size_t)16384 * 4;
constexpr size_t Q_SC = Q_VSC + (size_t)16384 * 4;
constexpr size_t Q_IDX = Q_SC + (size_t)TT * 2048 * 4;
constexpr size_t Q_GATE = Q_IDX + (size_t)TT * 128 * 4;
constexpr size_t H_YSF = 0;
constexpr size_t H_YSB = (size_t)TT * 768 * 2;
constexpr size_t OFF_H8 = OFF_P + P_TOTAL;
constexpr size_t WS_NEEDED = OFF_H8 + (size_t)TT * D;

struct Params {
    const float *x, *c, *ctx, *c_ctx, *w_mod, *b_mod, *w_in, *ln_g, *ln_b, *w_s, *b_s, *lb_logits, *hn_g;
    const float *lam_re, *lam_im, *log_step, *b_re, *b_im, *c_re, *c_im, *s5_d, *w_glu, *wa, *wb, *wc, *wo, *w_q, *sub_keys, *peer_u, *peer_v, *final_g;
    float* out;
    unsigned char* ws;
};

__device__ __forceinline__ float bf_lo(unsigned u) { return __uint_as_float(u << 16); }
__device__ __forceinline__ float bf_hi(unsigned u) { return __uint_as_float(u & 0xffff0000u); }
__device__ __forceinline__ unsigned cvt_pk_bf16(float lo, float hi) { f32x2 v; v.x = lo; v.y = hi; const bf16x2_t b = __builtin_convertvector(v, bf16x2_t); return __builtin_bit_cast(unsigned, b); }
__device__ __forceinline__ float fexp(float x) { return __builtin_amdgcn_exp2f(x * 1.44269504f); }
__device__ __forceinline__ float flog(float x) { return __builtin_amdgcn_logf(x) * 0.693147181f; }
__device__ __forceinline__ float fast_sigmoid(float x) { return __builtin_amdgcn_rcpf(1.0f + fexp(-x)); }
__device__ __forceinline__ float fast_silu(float x) { return x * fast_sigmoid(x); }
__device__ __forceinline__ float gelu_f(float v) {
    const float av = fabsf(v), t = __builtin_amdgcn_rcpf(av * 0.2316418882f + 1.0f);
    float q = t * 0.5307027145f + (-0.7265760135f); q = q * t + 0.7107068705f; q = q * t + (-0.142248368f); q = q * t + 0.127414796f; q = q * t;
    const float e = __builtin_amdgcn_exp2f((v * v) * (-0.72134752044f));
    const float m = v * (q * e);
    return v < 0.f ? m : v - m;
}
__device__ __forceinline__ unsigned pack_fp8x4(float a, float b, float c, float d) {
    int pk = 0; pk = __builtin_amdgcn_cvt_pk_fp8_f32(a, b, pk, false); pk = __builtin_amdgcn_cvt_pk_fp8_f32(c, d, pk, true); return (unsigned)pk;
}
template <int CTRL> __device__ __forceinline__ float dpp_f(float v) { return __int_as_float(__builtin_amdgcn_update_dpp(0, __float_as_int(v), CTRL, 0xF, 0xF, false)); }
__device__ __forceinline__ float row16_max(float v) { v = fmaxf(v, dpp_f<0x128>(v)); v = fmaxf(v, dpp_f<0x124>(v)); v = fmaxf(v, dpp_f<0x122>(v)); v = fmaxf(v, dpp_f<0x121>(v)); return v; }
__device__ __forceinline__ float row16_sum(float v) { v += dpp_f<0x128>(v); v += dpp_f<0x124>(v); v += dpp_f<0x122>(v); v += dpp_f<0x121>(v); return v; }
__device__ __forceinline__ float wave_sum(float v) {
#pragma unroll
    for (int o = 32; o >= 1; o >>= 1) v += __shfl_xor(v, o);
    return v;
}
__device__ __forceinline__ int otid() { int t; asm volatile("v_mov_b32 %0, %1" : "=v"(t) : "v"((int)threadIdx.x)); return t; }


#define XB_TMO      128
#define XB_XCNT(j)  (256  + 64 * (j))
#define XB_XSUB(j)  (1280 + 64 * (j))
#define XB_XGEN(j)  (2304 + 64 * (j))
#define XB_TOP      3328
#define XB_TOPGEN   3392
#define XCD_BAR_WORDS 3456
#define XB_SPIN_CAP (1u << 22)
__device__ __forceinline__ unsigned xb_ld(unsigned* p)              { return __hip_atomic_load(p, __ATOMIC_RELAXED, __HIP_MEMORY_SCOPE_AGENT); }
__device__ __forceinline__ unsigned xb_add(unsigned* p, unsigned v) { return __hip_atomic_fetch_add(p, v, __ATOMIC_RELAXED, __HIP_MEMORY_SCOPE_AGENT); }
__device__ __forceinline__ unsigned xb_xcc_id() { return (unsigned)__builtin_amdgcn_s_getreg((3 << 11) | 20) & 0xFu; }
#define XB_SPIN(cond, bar) do { unsigned _sp = 0; while (cond) { __builtin_amdgcn_s_sleep(1); \
    if ((++_sp & 255u) == 0u) { if (xb_ld(&(bar)[XB_TMO])) break; if (_sp > XB_SPIN_CAP) { atomicAdd(&(bar)[XB_TMO], 1u); break; } } } } while (0)
struct XcdBarrier { unsigned* bar; unsigned x; volatile LAS unsigned* st; };
__device__ __forceinline__ XcdBarrier xcd_barrier_post(unsigned* bar, volatile LAS unsigned* st) {
    XcdBarrier b; b.bar = bar; b.x = xb_xcc_id(); b.st = st;
    if (threadIdx.x == 0) (void)xb_add(&bar[XB_XCNT(b.x)], 1u);
    return b;
}
__device__ __forceinline__ void xcd_barrier_complete(unsigned* bar, unsigned x, unsigned& nloc, unsigned& nx) {
    const unsigned G = gridDim.x * gridDim.y * gridDim.z;
    unsigned sum, cnt, mine, sp = 0u;
    for (;;) {
        sum = 0u; cnt = 0u; mine = 0u;
#pragma unroll
        for (unsigned j = 0; j < 16; ++j) { const unsigned c = xb_ld(&bar[XB_XCNT(j)]); sum += c; cnt += (c > 0u) ? 1u : 0u; mine = (j == x) ? c : mine; }
        if (sum == G) break;
        __builtin_amdgcn_s_sleep(1);
        if ((++sp & 255u) == 0u) { if (xb_ld(&bar[XB_TMO])) break; if (sp > XB_SPIN_CAP) { atomicAdd(&bar[XB_TMO], 1u); break; } }
    }
    nloc = mine > 0u ? mine : 1u; nx = cnt > 0u ? cnt : 1u;
}
__device__ __forceinline__ void xcd_barrier(const XcdBarrier& b) {
    asm volatile("s_waitcnt vmcnt(0)" ::: "memory");
    __syncthreads();
    if (threadIdx.x == 0) {
        unsigned* bar = b.bar;
        __builtin_amdgcn_s_waitcnt(0);
        unsigned nloc = b.st[0], nx = b.st[1];
        if (nloc == 0u) { xcd_barrier_complete(bar, b.x, nloc, nx); b.st[0] = nloc; b.st[1] = nx; }
        const unsigned old = xb_add(&bar[XB_XSUB(b.x)], 1u);
        const unsigned gen = old / nloc;
        if (old + 1u == (gen + 1u) * nloc) {
            __builtin_amdgcn_fence(__ATOMIC_RELEASE, "agent");
            asm volatile("s_waitcnt vmcnt(0)" ::: "memory");
            const unsigned og = xb_add(&bar[XB_TOP], 1u);
            const unsigned tg = og / nx;
            if (og + 1u == (tg + 1u) * nx) xb_add(&bar[XB_TOPGEN], 1u);
            else XB_SPIN(xb_ld(&bar[XB_TOPGEN]) == tg, bar);
            __builtin_amdgcn_fence(__ATOMIC_ACQUIRE, "agent");
            xb_add(&bar[XB_XGEN(b.x)], 1u);
            asm volatile("s_waitcnt vmcnt(0)" ::: "memory");
        } else {
            XB_SPIN(xb_ld(&bar[XB_XGEN(b.x)]) == gen, bar);
            __builtin_amdgcn_fence(__ATOMIC_ACQUIRE, "agent");
            asm volatile("s_waitcnt vmcnt(0)" ::: "memory");
        }
    }
    __syncthreads();
}

namespace pg8 {
constexpr int BM = 256, BK = 64, HALF = 128, HTB = HALF * BK * 2, STAGE_BYTES = 8 * HTB, NXCD = 8, WGM = 8;
__host__ __device__ __forceinline__ int lds_byte(int r, int c) { const int st = (r >> 4) * 2 + (c >> 5), rr = r & 15, cc = c & 31, ob = rr * 64 + cc * 2; return st * 1024 + (ob ^ (((ob >> 9) & 1) << 5)); }
__host__ __device__ __forceinline__ void stage_rc(int b, int& R, int& C) { const int st = b / 1024, sb = b % 1024, swz = sb ^ (((sb >> 9) & 1) << 5); R = (st >> 1) * 16 + swz / 64; C = (st & 1) * 32 + (swz % 64) / 2; }
__host__ __device__ __forceinline__ int perm32(int rho) { const int n = rho >> 4, i = rho & 15; return 8 * (i >> 2) + 4 * n + (i & 3); }
typedef int i32x8 __attribute__((ext_vector_type(8)));
__device__ __forceinline__ i32x8 cat8(const bf16x8 a, const bf16x8 b) { const u32x4 x = __builtin_bit_cast(u32x4, a), y = __builtin_bit_cast(u32x4, b); i32x8 r; r[0] = (int)x.x; r[1] = (int)x.y; r[2] = (int)x.z; r[3] = (int)x.w; r[4] = (int)y.x; r[5] = (int)y.y; r[6] = (int)y.z; r[7] = (int)y.w; return r; }
struct Unit { int pm, pn; };
struct Gemm { const bf16_t* A; const bf16_t* Bt; int M, N, K; };
struct StaticOrder {
    int nM, nN, nwg, G, c;
    __device__ void init(int M, int N, int G_, int c_) { nM = M / BM; nN = N / BM; nwg = nM * nN; G = G_; c = c_; }
    __device__ bool next(int i, Unit& u) const {
        const long L = (long)i * G + c; if (L >= nwg) return false;
        int wgid = (int)L; { const int q = nwg / NXCD, r = nwg % NXCD, xcd = wgid % NXCD, off = wgid / NXCD; wgid = (xcd < r ? xcd * (q + 1) : r * (q + 1) + (xcd - r) * q) + off; }
        const int nig = WGM * nN, gid = wgid / nig, fm = gid * WGM, gsz = (nM - fm) < WGM ? (nM - fm) : WGM;
        u.pm = fm + ((wgid % nig) % gsz); u.pn = (wgid % nig) / gsz; return true;
    }
};

template <class Epi, class Sched>
__device__ __forceinline__ void gemm_phase(LAS unsigned char* lds, const Gemm g, const Sched& S, const Epi& E) {
    const int tid_ = otid();
    const int tid = tid_, wid = __builtin_amdgcn_readfirstlane(tid >> 6), lane = tid & 63, wr = wid >> 2, wc = wid & 3, fr = lane & 15, fq = lane >> 4;
    const int K = g.K, nt = K / BK;
    unsigned voffA[2], voffB[2];
#pragma unroll
    for (int i = 0; i < 2; ++i) { int R, C; stage_rc(tid * 16 + i * 8192, R, C); const int Rb = Epi::PERM ? ((R & ~31) + perm32(R & 31)) : R;
        voffA[i] = (unsigned)(R * K + C) * 2u; voffB[i] = (unsigned)(Rb * K + C) * 2u; }
    const size_t kstep = (size_t)(BK * 2);
    const size_t hstep = (size_t)HALF * K * 2;
    const size_t tstep = 2 * hstep;
    const unsigned ldsw = (unsigned)wid * 1024u;
    const int aoff = lds_byte(wr * 64 + fr, fq * 8), boff = lds_byte(wc * 32 + fr, fq * 8);
    const int aoff8 = lds_byte(wr * 64 + fr, (fq >> 1) * 32 + (fq & 1) * 16), boff8 = lds_byte(wc * 32 + fr, (fq >> 1) * 32 + (fq & 1) * 16);
#define PG8_SA(b, h) (((b) * 2 + (h)) * HTB)
#define PG8_SB(b, h) ((4 + (b) * 2 + (h)) * HTB)
#define PG8_STAGE(bufoff, gbase, voff) do { _Pragma("unroll") for (int _i = 0; _i < 2; ++_i) \
        __builtin_amdgcn_global_load_lds((const unsigned*)((const char*)(gbase) + (voff)[_i]), (LAS unsigned*)(lds + (bufoff) + ldsw + _i * 8192), 16, 0, 0); } while (0)
#define PG8_LDA(dst, b, h) do { if constexpr (Epi::FP8) { _Pragma("unroll") for (int m = 0; m < 4; ++m) dst##8[m] = cat8(*(const LAS bf16x8*)(lds + PG8_SA(b, h) + aoff + m * 2048), *(const LAS bf16x8*)(lds + PG8_SA(b, h) + aoff + m * 2048 + 1024)); } \
        else { _Pragma("unroll") for (int m = 0; m < 4; ++m) _Pragma("unroll") for (int k = 0; k < 2; ++k) dst[m][k] = *(const LAS bf16x8*)(lds + PG8_SA(b, h) + aoff + m * 2048 + k * 1024); } } while (0)
#define PG8_LDB(dst, b, h) do { if constexpr (Epi::FP8) { _Pragma("unroll") for (int n = 0; n < 2; ++n) dst##8[n] = cat8(*(const LAS bf16x8*)(lds + PG8_SB(b, h) + boff + n * 2048), *(const LAS bf16x8*)(lds + PG8_SB(b, h) + boff + n * 2048 + 1024)); } \
        else { _Pragma("unroll") for (int n = 0; n < 2; ++n) _Pragma("unroll") for (int k = 0; k < 2; ++k) dst[n][k] = *(const LAS bf16x8*)(lds + PG8_SB(b, h) + boff + n * 2048 + k * 1024); } } while (0)
#define PG8_MMA(ai, bj, At, Bt) do { __builtin_amdgcn_s_setprio(1); _Pragma("unroll") for (int m = 0; m < 4; ++m) _Pragma("unroll") for (int n = 0; n < 2; ++n) { \
        if constexpr (Epi::FP8) { asm volatile("v_mfma_scale_f32_16x16x128_f8f6f4 %0, %1, %2, %0, %3, %3 op_sel_hi:[0,0,0]" : "+v"(acc[ai][bj][m][n]) : "v"(Bt##8[n]), "v"(At##8[m]), "v"(one_scale)); } \
        else { _Pragma("unroll") for (int k = 0; k < 2; ++k) acc[ai][bj][m][n] = __builtin_amdgcn_mfma_f32_16x16x32_bf16(Bt[n][k], At[m][k], acc[ai][bj][m][n], 0, 0, 0); } } \
        __builtin_amdgcn_s_setprio(0); } while (0)
#define PG8_WAIT_V(n) asm volatile("s_waitcnt vmcnt(" #n ")" ::: "memory")
#define PG8_WAIT_L(n) asm volatile("s_waitcnt lgkmcnt(" #n ")" ::: "memory")
#define PG8_BAR __builtin_amdgcn_s_barrier()
#define PG8_SCHED __builtin_amdgcn_sched_barrier(0)
    Unit cur, nxt; int ui = 0;
    if (!S.next(0, cur)) return;
    f32x4 acc[2][2][4][2];
#pragma unroll
    for (int a = 0; a < 2; ++a)
#pragma unroll
        for (int b = 0; b < 2; ++b)
#pragma unroll
            for (int m = 0; m < 4; ++m)
#pragma unroll
                for (int n = 0; n < 2; ++n) acc[a][b][m][n] = (f32x4){0.f, 0.f, 0.f, 0.f};
    bf16x8 At[4][2], B0[2][2], B1[2][2];
    i32x8 At8[4], B08[2], B18[2];
    const int one_scale = 0x7F7F7F7F;
    const char* cA = (const char*)g.A + (size_t)cur.pm * tstep; const char* cB = (const char*)g.Bt + (size_t)cur.pn * tstep;
    PG8_STAGE(PG8_SB(0, 0), cB, voffB); PG8_STAGE(PG8_SA(0, 0), cA, voffA); PG8_STAGE(PG8_SB(0, 1), cB + hstep, voffB); PG8_STAGE(PG8_SA(0, 1), cA + hstep, voffA);
    if (wr == 1) PG8_BAR;
    PG8_WAIT_V(4); PG8_BAR;
    PG8_STAGE(PG8_SB(1, 0), cB + kstep, voffB); PG8_STAGE(PG8_SA(1, 0), cA + kstep, voffA); PG8_STAGE(PG8_SB(1, 1), cB + hstep + kstep, voffB);
    PG8_WAIT_V(6); PG8_BAR;
    for (;;) {
        const bool has_next = S.next(ui + 1, nxt);
        const char* nA = has_next ? (const char*)g.A + (size_t)nxt.pm * tstep : cA; const char* nB = has_next ? (const char*)g.Bt + (size_t)nxt.pn * tstep : cB;
        for (int t = 0; t < nt; t += 2) {
            const bool last = (t == nt - 2);
            const char* a1 = cA + (size_t)(t + 1) * kstep;
            const char* a2 = last ? nA : cA + (size_t)(t + 2) * kstep; const char* b2 = last ? nB : cB + (size_t)(t + 2) * kstep;
            const char* a3 = a2 + kstep; const char* b3 = b2 + kstep;
            PG8_LDB(B0, 0, 0); PG8_SCHED; PG8_LDA(At, 0, 0); PG8_STAGE(PG8_SA(1, 1), a1 + hstep, voffA);
            PG8_WAIT_L(8); PG8_BAR; PG8_WAIT_L(0); PG8_MMA(0, 0, At, B0); PG8_BAR; PG8_SCHED;
            PG8_LDB(B1, 0, 1); PG8_STAGE(PG8_SB(0, 0), b2, voffB);
            PG8_BAR; PG8_WAIT_L(0); PG8_MMA(0, 1, At, B1); PG8_BAR;
            PG8_LDA(At, 0, 1); PG8_STAGE(PG8_SA(0, 0), a2, voffA);
            PG8_BAR; PG8_WAIT_L(0); PG8_MMA(1, 0, At, B0); PG8_BAR; PG8_SCHED;
            PG8_STAGE(PG8_SB(0, 1), b2 + hstep, voffB);
            PG8_WAIT_V(6); PG8_BAR; PG8_MMA(1, 1, At, B1); PG8_BAR;
            PG8_LDB(B0, 1, 0); PG8_SCHED; PG8_LDA(At, 1, 0); PG8_STAGE(PG8_SA(0, 1), a2 + hstep, voffA);
            PG8_WAIT_L(8); PG8_BAR; PG8_WAIT_L(0); PG8_MMA(0, 0, At, B0); PG8_BAR; PG8_SCHED;
            PG8_LDB(B1, 1, 1); PG8_STAGE(PG8_SB(1, 0), b3, voffB);
            PG8_BAR; PG8_WAIT_L(0); PG8_MMA(0, 1, At, B1); PG8_BAR;
            PG8_LDA(At, 1, 1); PG8_STAGE(PG8_SA(1, 0), a3, voffA);
            PG8_BAR; PG8_WAIT_L(0); PG8_MMA(1, 0, At, B0); PG8_BAR; PG8_SCHED;
            PG8_STAGE(PG8_SB(1, 1), b3 + hstep, voffB);
            PG8_WAIT_V(6); PG8_BAR; PG8_MMA(1, 1, At, B1); PG8_BAR;
        }
        if constexpr (Epi::FP8) asm volatile("s_nop 15\n s_nop 15\n s_nop 15" ::: "memory");
        E(acc, cur, wr, wc, fr, fq);
        if (!has_next) break;
#pragma unroll
        for (int a = 0; a < 2; ++a)
#pragma unroll
            for (int b = 0; b < 2; ++b)
#pragma unroll
                for (int m = 0; m < 4; ++m)
#pragma unroll
                    for (int n = 0; n < 2; ++n) acc[a][b][m][n] = (f32x4){0.f, 0.f, 0.f, 0.f};
        cur = nxt; cA = nA; cB = nB; ++ui;
    }
    PG8_WAIT_V(0);
    if (wr == 0) PG8_BAR;
    PG8_BAR;
#undef PG8_SA
#undef PG8_SB
#undef PG8_STAGE
#undef PG8_LDA
#undef PG8_LDB
#undef PG8_MMA
#undef PG8_WAIT_V
#undef PG8_WAIT_L
#undef PG8_BAR
#undef PG8_SCHED
}
}

typedef f32x4 AccT[2][2][4][2];

struct EpiInProj {
    static constexpr bool PERM = true, FP8 = true;
    unsigned char* P;
    const float* sa;
    const unsigned* cmax;
    __device__ __forceinline__ void operator()(const AccT& acc, const pg8::Unit& u, int wr, int wc, int fr, int fq) const {
        const int pn = u.pn;
        bf16_t* base; int ld, lc, act;
        if (pn < 28) { const int seg = pn >> 2; base = (bf16_t*)(P + (size_t)seg * SEG); ld = 1024; lc = (pn & 3) * 256; act = (seg < 2) ? 1 : ((seg == 2 || seg == 6) ? 2 : 0); }
        else if (pn < 31) { base = (bf16_t*)(P + P_CU); ld = 768; lc = (pn - 28) * 256; act = 0; }
        else { base = (bf16_t*)(P + P_GATES); ld = 6144; lc = (pn - 31) * 256; act = 3; }
        const int row0 = u.pm * 256 + wr * 64 + fr, col0 = lc + wc * 32 + 8 * fq, gcol0 = u.pn * 256 + wc * 32 + 8 * fq;
        f32x4 cs[2][2];
#pragma unroll
        for (int bj = 0; bj < 2; ++bj)
#pragma unroll
            for (int n = 0; n < 2; ++n) { const u32x4 cb = *(const u32x4*)(cmax + gcol0 + bj * 128 + 4 * n);
                cs[bj][n] = (f32x4){__uint_as_float(cb.x), __uint_as_float(cb.y), __uint_as_float(cb.z), __uint_as_float(cb.w)} * (1.0f / 240.0f); }
        float rscv[2][4];
#pragma unroll
        for (int ai = 0; ai < 2; ++ai)
#pragma unroll
            for (int m = 0; m < 4; ++m) rscv[ai][m] = sa[row0 + ai * 128 + m * 16];
#pragma unroll
        for (int ai = 0; ai < 2; ++ai)
#pragma unroll
            for (int m = 0; m < 4; ++m) {
                bf16_t* rowp = base + (size_t)(row0 + ai * 128 + m * 16) * ld + col0;
                const float rsc = rscv[ai][m];
#pragma unroll
                for (int bj = 0; bj < 2; ++bj) {
                    f32x4 v0 = acc[ai][bj][m][0] * (cs[bj][0] * rsc), v1 = acc[ai][bj][m][1] * (cs[bj][1] * rsc);
                    if (act == 1) {
#pragma unroll
                        for (int j = 0; j < 4; ++j) { v0[j] = gelu_f(v0[j]); v1[j] = gelu_f(v1[j]); }
                    } else if (act == 2) {
#pragma unroll
                        for (int j = 0; j < 4; ++j) { v0[j] = fast_silu(v0[j]); v1[j] = fast_silu(v1[j]); }
                    } else if (act == 3) {
#pragma unroll
                        for (int j = 0; j < 4; ++j) { v0[j] = fast_sigmoid(v0[j]); v1[j] = fast_sigmoid(v1[j]); }
                    }
                    u32x4 w; w.x = cvt_pk_bf16(v0[0], v0[1]); w.y = cvt_pk_bf16(v0[2], v0[3]); w.z = cvt_pk_bf16(v1[0], v1[1]); w.w = cvt_pk_bf16(v1[2], v1[3]);
                    *(u32x4*)(rowp + bj * 128) = w;
                }
            }
    }
};
struct EpiGlu {
    static constexpr bool PERM = true, FP8 = false;
    bf16_t* O;
    __device__ __forceinline__ void operator()(const AccT& acc, const pg8::Unit& u, int wr, int wc, int fr, int fq) const {
        const int row0 = u.pm * 256 + wr * 64 + fr, col0 = u.pn * 128 + wc * 32 + 8 * fq;
#pragma unroll
        for (int ai = 0; ai < 2; ++ai)
#pragma unroll
            for (int m = 0; m < 4; ++m) {
                f32x4 v0 = acc[ai][0][m][0], v1 = acc[ai][0][m][1]; const f32x4 g0 = acc[ai][1][m][0], g1 = acc[ai][1][m][1];
#pragma unroll
                for (int j = 0; j < 4; ++j) { v0[j] *= fast_sigmoid(g0[j]); v1[j] *= fast_sigmoid(g1[j]); }
                u32x4 w; w.x = cvt_pk_bf16(v0[0], v0[1]); w.y = cvt_pk_bf16(v0[2], v0[3]); w.z = cvt_pk_bf16(v1[0], v1[1]); w.w = cvt_pk_bf16(v1[2], v1[3]);
                *(u32x4*)(O + (size_t)(row0 + ai * 128 + m * 16) * 768 + col0) = w;
            }
    }
};
template <bool FIRST> struct EpiMerge {
    static constexpr bool PERM = true, FP8 = false;
    bf16_t* O;
    const bf16_t* G;
    __device__ __forceinline__ void operator()(const AccT& acc, const pg8::Unit& u, int wr, int wc, int fr, int fq) const {
        const int row0 = u.pm * 256 + wr * 64 + fr, col0 = u.pn * 256 + wc * 32 + 8 * fq;
#pragma unroll
        for (int ai = 0; ai < 2; ++ai) {
            u32x4 gwv[4][2], owv[4][2];
#pragma unroll
            for (int m = 0; m < 4; ++m)
#pragma unroll
                for (int bj = 0; bj < 2; ++bj) { const size_t row = (size_t)(row0 + ai * 128 + m * 16);
                    gwv[m][bj] = *(const u32x4*)(G + row * 6144 + col0 + bj * 128);
                    if (!FIRST) owv[m][bj] = *(const u32x4*)(O + row * 2048 + col0 + bj * 128); }
#pragma unroll
            for (int m = 0; m < 4; ++m)
#pragma unroll
                for (int bj = 0; bj < 2; ++bj) { const size_t row = (size_t)(row0 + ai * 128 + m * 16);
                    const u32x4 gw = gwv[m][bj];
                    f32x4 v0 = acc[ai][bj][m][0], v1 = acc[ai][bj][m][1];
                    v0[0] *= bf_lo(gw.x); v0[1] *= bf_hi(gw.x); v0[2] *= bf_lo(gw.y); v0[3] *= bf_hi(gw.y);
                    v1[0] *= bf_lo(gw.z); v1[1] *= bf_hi(gw.z); v1[2] *= bf_lo(gw.w); v1[3] *= bf_hi(gw.w);
                    if (!FIRST) { const u32x4 ow = owv[m][bj];
                        v0[0] += bf_lo(ow.x); v0[1] += bf_hi(ow.x); v0[2] += bf_lo(ow.y); v0[3] += bf_hi(ow.y);
                        v1[0] += bf_lo(ow.z); v1[1] += bf_hi(ow.z); v1[2] += bf_lo(ow.w); v1[3] += bf_hi(ow.w); }
                    u32x4 w; w.x = cvt_pk_bf16(v0[0], v0[1]); w.y = cvt_pk_bf16(v0[2], v0[3]); w.z = cvt_pk_bf16(v1[0], v1[1]); w.w = cvt_pk_bf16(v1[2], v1[3]);
                    *(u32x4*)(O + row * 2048 + col0 + bj * 128) = w; }
        }
    }
};
struct EpiResid {
    static constexpr bool PERM = false, FP8 = false;
    float* XR; float* XC; const float* modl;
    __device__ __forceinline__ void operator()(const AccT& acc, const pg8::Unit& u, int wr, int wc, int fr, int fq) const {
        const int row0 = u.pm * 256 + wr * 64 + fr, col0 = u.pn * 256 + wc * 32 + 4 * fq;
        const int mb = u.pm < 128 ? (u.pm >> 3) : 16;
        const float* gv = modl + (size_t)mb * NMOD + col0;
        float* basep = u.pm < 128 ? XR : (XC - (size_t)TL * D);
        f32x4 gvv[2][2];
#pragma unroll
        for (int bj = 0; bj < 2; ++bj)
#pragma unroll
            for (int n = 0; n < 2; ++n) gvv[bj][n] = *(const f32x4*)(gv + bj * 128 + n * 16);
#pragma unroll
        for (int ai = 0; ai < 2; ++ai) {
            f32x4 xo[4][2][2];
#pragma unroll
            for (int m = 0; m < 4; ++m)
#pragma unroll
                for (int bj = 0; bj < 2; ++bj)
#pragma unroll
                    for (int n = 0; n < 2; ++n) xo[m][bj][n] = *(const f32x4*)(basep + (size_t)(row0 + ai * 128 + m * 16) * D + col0 + bj * 128 + n * 16);
#pragma unroll
            for (int m = 0; m < 4; ++m)
#pragma unroll
                for (int bj = 0; bj < 2; ++bj)
#pragma unroll
                    for (int n = 0; n < 2; ++n) *(f32x4*)(basep + (size_t)(row0 + ai * 128 + m * 16) * D + col0 + bj * 128 + n * 16) = xo[m][bj][n] + gvv[bj][n] * acc[ai][bj][m][n];
        }
    }
};
struct EpiF32 {
    static constexpr bool PERM = false, FP8 = false;
    float* C; int ldc;
    __device__ __forceinline__ void operator()(const AccT& acc, const pg8::Unit& u, int wr, int wc, int fr, int fq) const {
        const int row0 = u.pm * 256 + wr * 64 + fr, col0 = u.pn * 256 + wc * 32 + 4 * fq;
#pragma unroll
        for (int ai = 0; ai < 2; ++ai)
#pragma unroll
            for (int m = 0; m < 4; ++m) {
                float* rowp = C + (size_t)(row0 + ai * 128 + m * 16) * ldc + col0;
#pragma unroll
                for (int bj = 0; bj < 2; ++bj)
#pragma unroll
                    for (int n = 0; n < 2; ++n) *(f32x4*)(rowp + bj * 128 + n * 16) = acc[ai][bj][m][n];
            }
    }
};

template <class Epi>
__device__ __forceinline__ void run_gemm(LAS unsigned char* lds, const bf16_t* A, const bf16_t* Bt, int M, int N, int K, const Epi& E, int rot = 0) {
    pg8::Gemm g{A, Bt, M, N, K};
    const int G_ = (int)gridDim.x; int c_ = (int)blockIdx.x - rot; if (c_ < 0) c_ += G_;
    pg8::StaticOrder S; S.init(M, N, G_, c_);
    pg8::gemm_phase<Epi, pg8::StaticOrder>(lds, g, S, E);
}

__device__ __forceinline__ void phase_mod(const Params& p, LAS unsigned char* lds) {
    const int tid_ = otid();
    LAS float* cs = (LAS float*)lds;
    LAS float* red = (LAS float*)(lds + 2048 * 17 * 4);
    const int tid = tid_;
    float* modv = (float*)(p.ws + OFF_MODV);
    { f32x4 cv[17];
#pragma unroll
      for (int r = 0; r < 17; ++r) cv[r] = *(const f32x4*)((r < 16 ? p.c + r * 2048 : p.c_ctx) + tid * 4);
#pragma unroll
      for (int r = 0; r < 17; ++r)
#pragma unroll
          for (int e = 0; e < 4; ++e) { const float c = cv[r][e]; cs[(tid * 4 + e) * 17 + r] = c / (1.0f + __expf(-c)); } }
    __syncthreads();
    const int lane = tid & 63, wv = tid >> 6, cq = lane & 7, kg = wv * 8 + (lane >> 3);
    for (int u = blockIdx.x; u < 768; u += gridDim.x) {
        const int l = u / 384, c0 = (u % 384) * 32;
        const float* w = p.w_mod + (size_t)l * 2048 * NMOD + (size_t)kg * NMOD + c0 + cq * 4;
        f32x4 acc[17];
#pragma unroll
        for (int r = 0; r < 17; ++r) acc[r] = (f32x4){0.f, 0.f, 0.f, 0.f};
#pragma unroll 16
        for (int j = 0; j < 32; ++j) {
            const f32x4 w4 = *(const f32x4*)(w + (size_t)j * 64 * NMOD);
            const LAS float* cr = cs + (kg + 64 * j) * 17;
#pragma unroll
            for (int r = 0; r < 17; ++r) acc[r] += w4 * cr[r];
        }
#pragma unroll
        for (int r = 0; r < 17; ++r)
#pragma unroll
            for (int c = 0; c < 4; ++c) { float v = acc[r][c]; v += __shfl_xor(v, 8); v += __shfl_xor(v, 16); v += __shfl_xor(v, 32);
                if (lane < 8) red[(wv * 32 + cq * 4 + c) * 17 + r] = v; }
        __syncthreads();
        for (int o = tid; o < 32 * 17; o += NTHREADS) { const int col = o & 31, r = o >> 5;
            float sum = p.b_mod[l * NMOD + c0 + col];
#pragma unroll
            for (int q = 0; q < 8; ++q) sum += red[(q * 32 + col) * 17 + r];
            modv[(size_t)(l * 17 + r) * NMOD + c0 + col] = sum; }
        __syncthreads();
    }
}
__device__ __forceinline__ void phase_prep(const Params& p) {
    const int tid_ = otid();
    const int gt = blockIdx.x * NTHREADS + tid_, nt = gridDim.x * NTHREADS;
    float* lb = (float*)(p.ws + OFF_LB);
    for (int i = gt; i < 2 * 1024; i += nt) { const float x0 = p.lb_logits[i], x1 = p.lb_logits[2048 + i]; lb[i] = 0.f; lb[2048 + i] = 1.0f / (1.0f + expf(x0 - x1)); }
    float* s5lam = (float*)(p.ws + OFF_S5LAM); float* s5bb = (float*)(p.ws + OFF_S5BB);
    for (int i = gt; i < 2 * 2 * 48 * 64; i += nt) {
        const int ldg = i >> 6;
        const double lre = (double)p.lam_re[i], lim = (double)p.lam_im[i], dt = exp((double)p.log_step[ldg]);
        const double er = exp(lre * dt); double sn, cs; sincos(lim * dt, &sn, &cs);
        const double br = er * cs, bi = er * sn;
        s5lam[i * 2] = (float)br; s5lam[i * 2 + 1] = (float)bi;
        const double nr = br - 1.0, ni = bi, den = lre * lre + lim * lim;
        const double cr = (nr * lre + ni * lim) / den, ci = (ni * lre - nr * lim) / den;
        for (int d = 0; d < 16; ++d) { const double xr = (double)p.b_re[(size_t)i * 16 + d], xi = (double)p.b_im[(size_t)i * 16 + d];
            s5bb[(size_t)i * 32 + d] = (float)(cr * xr - ci * xi); s5bb[(size_t)i * 32 + 16 + d] = (float)(cr * xi + ci * xr); }
    }
    float* pe = (float*)(p.ws + OFF_PE);
    for (int i = gt; i < 96 * 1024; i += nt) {
        const int r = i >> 10, cc = i & 1023, j = cc & 511;
        const float pos = (float)(r < 32 ? r : r - 32);
        const float omega = 1.0f / powf(10000.0f, (float)j * (1.0f / 512.0f));
        const float ang = pos * omega;
        pe[i] = cc < 512 ? sinf(ang) : cosf(ang);
    }
}

template <int MAPMODE>
__device__ __forceinline__ void transpose_convert(const float* src, int K, int N, bf16_t* dst, LAS unsigned char* lds) {
    const int tid_ = otid();
    LAS float* tile = (LAS float*)lds;
    const int tid = tid_, nkb = K / 64, nnb = N / 64;
    for (int u = blockIdx.x; u < nkb * nnb; u += gridDim.x) {
        const int kb = u / nnb, nb = u % nnb, k0 = kb * 64, n0 = nb * 64;
        { const int nn = tid & 63, kk = tid >> 6;
#pragma unroll
          for (int i = 0; i < 8; ++i) tile[(kk + i * 8) * 65 + nn] = src[(size_t)(k0 + kk + i * 8) * N + n0 + nn]; }
        __syncthreads();
        { const int kk2 = (tid & 7) * 8, nn2 = tid >> 3; float v[8];
#pragma unroll
          for (int i = 0; i < 8; ++i) v[i] = tile[(kk2 + i) * 65 + nn2];
          int n = n0 + nn2, nr;
          if (MAPMODE == 1) { if (n < 768) nr = (n >> 7) * 256 + (n & 127); else { const int m = n - 768; nr = (m >> 7) * 256 + 128 + (m & 127); } } else nr = n;
          u32x4 w; w.x = cvt_pk_bf16(v[0], v[1]); w.y = cvt_pk_bf16(v[2], v[3]); w.z = cvt_pk_bf16(v[4], v[5]); w.w = cvt_pk_bf16(v[6], v[7]);
          *(u32x4*)(dst + (size_t)nr * K + k0 + kk2) = w; }
        __syncthreads();
    }
}
__device__ __forceinline__ void phase_wscore(const float* wq, const float* sk, bf16_t* dst, LAS unsigned char* lds) {
    const int tid_ = otid();
    LAS float* skt = (LAS float*)lds;
    LAS float* wqt = (LAS float*)(lds + 128 * 129 * 4);
    const int tid = tid_;
    for (int u = blockIdx.x; u < 16 * 32; u += gridDim.x) {
        const int hp = u >> 5, kb = u & 31;
        for (int i = tid; i < 128 * 128; i += NTHREADS) { const int key = i >> 7, e = i & 127; skt[key * 129 + e] = sk[(size_t)hp * 16384 + i]; }
        for (int i = tid; i < 64 * 128; i += NTHREADS) { const int k = i >> 7, e = i & 127; wqt[e * 68 + k] = wq[(size_t)(kb * 64 + k) * 2048 + hp * 128 + e]; }
        __syncthreads();
        const int key = tid & 127, kg = tid >> 7;
        float acc[16];
#pragma unroll
        for (int i = 0; i < 16; ++i) acc[i] = 0.f;
        for (int e = 0; e < 128; ++e) {
            const float s = skt[key * 129 + e];
#pragma unroll
            for (int q = 0; q < 4; ++q) { const f32x4 w4 = *(const LAS f32x4*)(wqt + e * 68 + kg * 16 + q * 4);
                acc[q * 4 + 0] += s * w4[0]; acc[q * 4 + 1] += s * w4[1]; acc[q * 4 + 2] += s * w4[2]; acc[q * 4 + 3] += s * w4[3]; }
        }
        bf16_t* o = dst + (size_t)(hp * 128 + key) * 2048 + kb * 64 + kg * 16;
        u32x4 w0, w1;
        w0.x = cvt_pk_bf16(acc[0], acc[1]); w0.y = cvt_pk_bf16(acc[2], acc[3]); w0.z = cvt_pk_bf16(acc[4], acc[5]); w0.w = cvt_pk_bf16(acc[6], acc[7]);
        w1.x = cvt_pk_bf16(acc[8], acc[9]); w1.y = cvt_pk_bf16(acc[10], acc[11]); w1.z = cvt_pk_bf16(acc[12], acc[13]); w1.w = cvt_pk_bf16(acc[14], acc[15]);
        *(u32x4*)o = w0; *(u32x4*)(o + 8) = w1;
        __syncthreads();
    }
}
__device__ __forceinline__ void phase_colmax(const Params& p) {
    const int tid_ = otid();
    unsigned* cm = (unsigned*)(p.ws + OFF_CMAX);
    const int total = 2 * (INC / 4) * 16;
    for (int i = blockIdx.x * NTHREADS + tid_; i < total; i += gridDim.x * NTHREADS) {
        const int kc = i / (2 * (INC / 4)), cidx = i % (2 * (INC / 4)), l = cidx / (INC / 4), nq = cidx % (INC / 4);
        const float* w = p.w_in + (size_t)l * D * INC + (size_t)(kc * 128) * INC + nq * 4;
        f32x4 am = (f32x4){0.f, 0.f, 0.f, 0.f};
#pragma unroll 32
        for (int k = 0; k < 128; ++k) { const f32x4 v = *(const f32x4*)(w + (size_t)k * INC);
            am[0] = fmaxf(am[0], fabsf(v[0])); am[1] = fmaxf(am[1], fabsf(v[1])); am[2] = fmaxf(am[2], fabsf(v[2])); am[3] = fmaxf(am[3], fabsf(v[3])); }
        unsigned* o = cm + l * INC + nq * 4;
        atomicMax(o, __float_as_uint(am[0])); atomicMax(o + 1, __float_as_uint(am[1])); atomicMax(o + 2, __float_as_uint(am[2])); atomicMax(o + 3, __float_as_uint(am[3]));
    }
}
__device__ __forceinline__ void transpose_convert_fp8(const float* src, int K, int N, unsigned char* dst, const unsigned* cmax, LAS unsigned char* lds) {
    const int tid_ = otid();
    LAS float* tile = (LAS float*)lds;
    const int tid = tid_, nkb = K / 64, nnb = N / 64;
    for (int u = blockIdx.x; u < nkb * nnb; u += gridDim.x) {
        const int kb = u / nnb, nb = u % nnb, k0 = kb * 64, n0 = nb * 64;
        { const int nn = tid & 63, kk = tid >> 6;
#pragma unroll
          for (int i = 0; i < 8; ++i) tile[(kk + i * 8) * 65 + nn] = src[(size_t)(k0 + kk + i * 8) * N + n0 + nn]; }
        __syncthreads();
        { const int kk2 = (tid & 7) * 8, nn2 = tid >> 3; float v[8];
          const float cmv = __uint_as_float(cmax[n0 + nn2]); const float sc = cmv > 0.f ? 240.0f / cmv : 1.0f;
#pragma unroll
          for (int i = 0; i < 8; ++i) v[i] = tile[(kk2 + i) * 65 + nn2] * sc;
          u32x2 w; w.x = pack_fp8x4(v[0], v[1], v[2], v[3]); w.y = pack_fp8x4(v[4], v[5], v[6], v[7]);
          *(u32x2*)(dst + (size_t)(n0 + nn2) * K + k0 + kk2) = w; }
        __syncthreads();
    }
}
__device__ __forceinline__ void phase_wconv(const Params& p, int l, LAS unsigned char* lds) {
    unsigned char* W = p.ws + OFF_W;
    transpose_convert_fp8(p.w_in + (size_t)l * D * INC, D, INC, W + W_IN, (const unsigned*)(p.ws + OFF_CMAX) + (size_t)l * INC, lds);
    transpose_convert<1>(p.w_glu + (size_t)l * 768 * 1536, 768, 1536, (bf16_t*)(W + W_GLU), lds);
    transpose_convert<0>(p.wa + (size_t)l * 1024 * D, 1024, D, (bf16_t*)(W + W_A), lds);
    transpose_convert<0>(p.wb + (size_t)l * 1024 * D, 1024, D, (bf16_t*)(W + W_B), lds);
    transpose_convert<0>(p.wc + (size_t)l * 768 * D, 768, D, (bf16_t*)(W + W_C), lds);
    transpose_convert<0>(p.wo + (size_t)l * D * D, D, D, (bf16_t*)(W + W_O), lds);
    phase_wscore(p.w_q + (size_t)l * D * D, p.sub_keys + (size_t)l * 16 * 16384, (bf16_t*)(W + W_S), lds);
}
__device__ __forceinline__ void phase_tabconv(const Params& p, int l) {
    const int tid_ = otid();
    const int lane = tid_ & 63, gw = blockIdx.x * 8 + __builtin_amdgcn_readfirstlane(tid_ >> 6), nw = gridDim.x * 8;
    unsigned char* U6 = p.ws + OFF_P + Q_UT; unsigned char* V6 = p.ws + OFF_P + Q_VT;
    float* USC = (float*)(p.ws + OFF_P + Q_USC); float* VSC = (float*)(p.ws + OFF_P + Q_VSC);
    for (int r = gw; r < 32768; r += nw) {
        const bool isv = r >= 16384; const int rr = r & 16383;
        const float* src = (isv ? p.peer_v : p.peer_u) + (size_t)l * 16384 * 2048 + (size_t)rr * 2048;
        f32x4 v[8];
#pragma unroll
        for (int j = 0; j < 8; ++j) v[j] = *(const f32x4*)(src + j * 256 + lane * 4);
        float am = 0.f;
#pragma unroll
        for (int j = 0; j < 8; ++j) am = fmaxf(am, fmaxf(fmaxf(fabsf(v[j][0]), fabsf(v[j][1])), fmaxf(fabsf(v[j][2]), fabsf(v[j][3]))));
#pragma unroll
        for (int o = 32; o >= 1; o >>= 1) am = fmaxf(am, __shfl_xor(am, o));
        if (isv) {
            const float sc4 = am > 0.f ? 6.0f / am : 1.0f;
            unsigned wd[4] = {0u, 0u, 0u, 0u};
#pragma unroll
            for (int j = 0; j < 8; ++j) {
                if ((j & 1) == 0) { wd[j >> 1] = __builtin_amdgcn_cvt_scalef32_pk_fp4_f32(wd[j >> 1], v[j][0] * sc4, v[j][1] * sc4, 1.0f, 0); wd[j >> 1] = __builtin_amdgcn_cvt_scalef32_pk_fp4_f32(wd[j >> 1], v[j][2] * sc4, v[j][3] * sc4, 1.0f, 1); }
                else { wd[j >> 1] = __builtin_amdgcn_cvt_scalef32_pk_fp4_f32(wd[j >> 1], v[j][0] * sc4, v[j][1] * sc4, 1.0f, 2); wd[j >> 1] = __builtin_amdgcn_cvt_scalef32_pk_fp4_f32(wd[j >> 1], v[j][2] * sc4, v[j][3] * sc4, 1.0f, 3); } }
            u32x4 w4; w4.x = wd[0]; w4.y = wd[1]; w4.z = wd[2]; w4.w = wd[3];
            *(u32x4*)(V6 + (size_t)rr * 1024 + lane * 16) = w4;
            if (lane == 0) VSC[rr] = am > 0.f ? am * (1.0f / 6.0f) : 1.0f;
            continue;
        }
        const float sc = am > 0.f ? 7.0f / am : 1.0f, inv = am > 0.f ? am * (1.0f / 7.0f) : 1.0f;
        bf16x32_t bv;
#pragma unroll
        for (int j = 0; j < 8; ++j)
#pragma unroll
            for (int c = 0; c < 4; ++c) bv[j * 4 + c] = (__bf16)(v[j][c] * sc);
        const u32x6 pk = __builtin_amdgcn_cvt_scalef32_pk32_fp6_bf16(bv, 1.0f);
        unsigned char* dst = U6 + (size_t)rr * 1536 + lane * 24;
        u32x4 w0; w0.x = pk[0]; w0.y = pk[1]; w0.z = pk[2]; w0.w = pk[3]; u32x2 w1; w1.x = pk[4]; w1.y = pk[5];
        *(u32x4*)dst = w0; *(u32x2*)(dst + 16) = w1;
        if (lane == 0) USC[rr] = inv;
    }
}

template <int MODE, bool F8OUT = false>
__device__ __forceinline__ void phase_norm(const Params& p, int l, int M, int off_sh, int off_sc) {
    const int tid_ = otid();
    const int lane = tid_ & 63, gw = blockIdx.x * 8 + __builtin_amdgcn_readfirstlane(tid_ >> 6), nw = gridDim.x * 8;
    const float* modv = (const float*)(p.ws + OFF_MODV) + (size_t)l * 17 * NMOD;
    const float* pe = (const float*)(p.ws + OFF_PE);
    float* XC = (float*)(p.ws + OFF_XC);
    bf16_t* H = (bf16_t*)(p.ws + OFF_H);
    for (int r = gw; r < M; r += nw) {
        const bool lat = r < TL;
        const float* src = MODE == 0 ? (lat ? p.x + (size_t)r * D : p.ctx + (size_t)(r - TL) * D) : (lat ? p.out + (size_t)r * D : XC + (size_t)(r - TL) * D);
        f32x4 v[4][2];
#pragma unroll
        for (int j = 0; j < 4; ++j) { v[j][0] = *(const f32x4*)(src + j * 512 + lane * 8); v[j][1] = *(const f32x4*)(src + j * 512 + lane * 8 + 4); }
        if (MODE == 0) {
            if (lat) { const int n = r & 2047, gr = n >> 6, gc = n & 63;
#pragma unroll
                for (int j = 0; j < 4; ++j) { const float* pr = (j < 2) ? pe + (size_t)gr * 1024 + j * 512 + lane * 8 : pe + (size_t)(32 + gc) * 1024 + (j - 2) * 512 + lane * 8;
                    v[j][0] += *(const f32x4*)pr; v[j][1] += *(const f32x4*)(pr + 4); } }
            float* dst = lat ? p.out + (size_t)r * D : XC + (size_t)(r - TL) * D;
#pragma unroll
            for (int j = 0; j < 4; ++j) { *(f32x4*)(dst + j * 512 + lane * 8) = v[j][0]; *(f32x4*)(dst + j * 512 + lane * 8 + 4) = v[j][1]; }
        }
        float ss = 0.f;
#pragma unroll
        for (int j = 0; j < 4; ++j)
#pragma unroll
            for (int h = 0; h < 2; ++h) ss += v[j][h][0] * v[j][h][0] + v[j][h][1] * v[j][h][1] + v[j][h][2] * v[j][h][2] + v[j][h][3] * v[j][h][3];
        ss = wave_sum(ss);
        const float rs = rsqrtf(ss * (1.0f / 2048.0f) + 1e-6f);
        const int mb = lat ? (r >> 11) : 16;
        const float* sh = modv + (size_t)mb * NMOD + off_sh; const float* sc = modv + (size_t)mb * NMOD + off_sc;
        if (F8OUT) {
            float am = 0.f;
#pragma unroll
            for (int j = 0; j < 4; ++j) { const int e = j * 512 + lane * 8;
                const f32x4 s0 = *(const f32x4*)(sc + e), s1 = *(const f32x4*)(sc + e + 4), h0 = *(const f32x4*)(sh + e), h1 = *(const f32x4*)(sh + e + 4);
                v[j][0] = v[j][0] * rs * (s0 + 1.0f) + h0; v[j][1] = v[j][1] * rs * (s1 + 1.0f) + h1;
#pragma unroll
                for (int hh = 0; hh < 2; ++hh) am = fmaxf(am, fmaxf(fmaxf(fabsf(v[j][hh][0]), fabsf(v[j][hh][1])), fmaxf(fabsf(v[j][hh][2]), fabsf(v[j][hh][3])))); }
#pragma unroll
            for (int o = 32; o >= 1; o >>= 1) am = fmaxf(am, __shfl_xor(am, o));
            const float q = am > 0.f ? 240.0f / am : 1.0f;
            unsigned char* H8 = p.ws + OFF_H8 + (size_t)r * D;
#pragma unroll
            for (int j = 0; j < 4; ++j) { u32x2 w; w.x = pack_fp8x4(v[j][0][0] * q, v[j][0][1] * q, v[j][0][2] * q, v[j][0][3] * q); w.y = pack_fp8x4(v[j][1][0] * q, v[j][1][1] * q, v[j][1][2] * q, v[j][1][3] * q);
                *(u32x2*)(H8 + j * 512 + lane * 8) = w; }
            if (lane == 0) ((float*)(p.ws + OFF_HS))[r] = am > 0.f ? am * (1.0f / 240.0f) : 1.0f;
        } else {
#pragma unroll
        for (int j = 0; j < 4; ++j) {
            const int e = j * 512 + lane * 8;
            const f32x4 s0 = *(const f32x4*)(sc + e), s1 = *(const f32x4*)(sc + e + 4), h0 = *(const f32x4*)(sh + e), h1 = *(const f32x4*)(sh + e + 4);
            f32x4 a = v[j][0] * rs * (s0 + 1.0f) + h0, b = v[j][1] * rs * (s1 + 1.0f) + h1;
            u32x4 w; w.x = cvt_pk_bf16(a[0], a[1]); w.y = cvt_pk_bf16(a[2], a[3]); w.z = cvt_pk_bf16(b[0], b[1]); w.w = cvt_pk_bf16(b[2], b[3]);
            *(u32x4*)(H + (size_t)r * D + e) = w;
        }
        }
    }
}
__device__ __forceinline__ bf16x8 mk_bf16x8(unsigned a, unsigned b, unsigned c, unsigned d) { u32x4 q; q.x = a; q.y = b; q.z = c; q.w = d; return __builtin_bit_cast(bf16x8, q); }
__device__ __forceinline__ void phase_hgrn(const Params& p, int l, LAS unsigned char* lds, bool dry = false) {
    const int tid_ = otid();
    const int lane = tid_ & 63, w = __builtin_amdgcn_readfirstlane(tid_ >> 6), q = lane >> 4, m = lane & 15;
    constexpr int OQ = 0, OKH = 4352, OKT = 8704, OIT = 14848, OE = 20992, BUFSZ = 21504, RAWOFF = 2 * 21504, RAWSZ = 3 * 4352;
    unsigned char* P = p.ws + OFF_P;
    const float* lbp = (const float*)(p.ws + OFF_LB) + (size_t)l * 2048;
    const int kch = 16 * w + m;
    for (int u = blockIdx.x; u < 256; u += gridDim.x) {
        const int b = u >> 4, h = (u >> 1) & 7, dir = u & 1;
        const bf16_t* BQ = (const bf16_t*)(P + P_BQ); const bf16_t* BI = (const bf16_t*)(P + P_BI);
        bf16_t* BF = (bf16_t*)(P + (dir ? P_BFB : P_BFF));
        const float lbv = lbp[dir * 1024 + h * 128 + kch];
        f32x4 Sacc[8];
#pragma unroll
        for (int i = 0; i < 8; ++i) Sacc[i] = (f32x4){0.f, 0.f, 0.f, 0.f};
        for (int seg = 0; seg < 2; ++seg) {
            const int len = seg == 0 ? CTXL : SEQ, rbase = seg == 0 ? TL + b * CTXL : b * SEQ, nch = len / 16;
            u32x4 g0 = (u32x4){0u, 0u, 0u, 0u}, g1 = g0;
            const int gs = (tid_ & 255) >> 4, gc8 = (tid_ & 15) * 8;
#define HG_GLOAD(c) do { const int st = (c) * 16 + gs, n = dir ? (len - 1 - st) : st; const size_t o = (size_t)(rbase + n) * 1024 + h * 128 + gc8; \
                if (tid_ < 256) { g0 = *(const u32x4*)(BQ + o); g1 = *(const u32x4*)(BF + o); } else { g0 = *(const u32x4*)(BI + o); } } while (0)
#define HG_RAWW(c) do { LAS unsigned char* rw = lds + RAWOFF + ((c) & 1) * RAWSZ + gs * 272 + gc8 * 2; \
                if (tid_ < 256) { *(LAS u32x4*)(rw) = g0; *(LAS u32x4*)(rw + 4352) = g1; } else { *(LAS u32x4*)(rw + 8704) = g0; } } while (0)
#define HG_STAGE(c, bufp) do { float fv[4], cb[4]; float run = 0.f; unsigned short rq[4], rf[4], ri[4]; \
                { const LAS unsigned char* rr = lds + RAWOFF + ((c) & 1) * RAWSZ + kch * 2; _Pragma("unroll") for (int j = 0; j < 4; ++j) { rq[j] = *(const LAS bf16_t*)(rr + (4 * q + j) * 272); rf[j] = *(const LAS bf16_t*)(rr + 4352 + (4 * q + j) * 272); ri[j] = *(const LAS bf16_t*)(rr + 8704 + (4 * q + j) * 272); } } \
                _Pragma("unroll") for (int j = 0; j < 4; ++j) { const float xf = __uint_as_float(((unsigned)rf[j]) << 16); fv[j] = lbv + (1.0f - lbv) * fast_sigmoid(xf); run += flog(fv[j]); cb[j] = run; } \
                const float t0 = __shfl(run, m), t1 = __shfl(run, m + 16), t2 = __shfl(run, m + 32); \
                const float off = (q > 0 ? t0 : 0.f) + (q > 1 ? t1 : 0.f) + (q > 2 ? t2 : 0.f); \
                float qh[4], kh[4]; \
                _Pragma("unroll") for (int j = 0; j < 4; ++j) { const float bb = off + cb[j], bc = fmaxf(bb, -80.0f); qh[j] = __uint_as_float(((unsigned)rq[j]) << 16) * fexp(bc); kh[j] = (1.0f - fv[j]) * fexp(-bc);     \
                    if (j == 3 && q == 3) *(LAS float*)((bufp) + OE + kch * 4) = fexp(bb); } \
                const unsigned q01 = cvt_pk_bf16(qh[0], qh[1]), q23 = cvt_pk_bf16(qh[2], qh[3]), k01 = cvt_pk_bf16(kh[0], kh[1]), k23 = cvt_pk_bf16(kh[2], kh[3]); \
                *(LAS bf16_t*)((bufp) + OQ + (4 * q + 0) * 272 + kch * 2) = (bf16_t)(q01 & 0xffffu); *(LAS bf16_t*)((bufp) + OQ + (4 * q + 1) * 272 + kch * 2) = (bf16_t)(q01 >> 16); \
                *(LAS bf16_t*)((bufp) + OQ + (4 * q + 2) * 272 + kch * 2) = (bf16_t)(q23 & 0xffffu); *(LAS bf16_t*)((bufp) + OQ + (4 * q + 3) * 272 + kch * 2) = (bf16_t)(q23 >> 16); \
                *(LAS bf16_t*)((bufp) + OKH + (4 * q + 0) * 272 + kch * 2) = (bf16_t)(k01 & 0xffffu); *(LAS bf16_t*)((bufp) + OKH + (4 * q + 1) * 272 + kch * 2) = (bf16_t)(k01 >> 16); \
                *(LAS bf16_t*)((bufp) + OKH + (4 * q + 2) * 272 + kch * 2) = (bf16_t)(k23 & 0xffffu); *(LAS bf16_t*)((bufp) + OKH + (4 * q + 3) * 272 + kch * 2) = (bf16_t)(k23 >> 16); \
                u32x2 kt2; kt2.x = k01; kt2.y = k23; *(LAS u32x2*)((bufp) + OKT + kch * 48 + q * 8) = kt2; \
                u32x2 it2; it2.x = (unsigned)ri[0] | ((unsigned)ri[1] << 16); it2.y = (unsigned)ri[2] | ((unsigned)ri[3] << 16); *(LAS u32x2*)((bufp) + OIT + kch * 48 + q * 8) = it2; } while (0)
#define HG_COMPUTE(c) do { \
                LAS unsigned char* buf = lds + ((c) & 1) * BUFSZ; \
                f32x4 at = (f32x4){0.f, 0.f, 0.f, 0.f}; \
                _Pragma("unroll") \
                for (int kb = 0; kb < 4; ++kb) { const bf16x8 a = *(const LAS bf16x8*)(buf + OKH + m * 272 + kb * 64 + q * 16), bq = *(const LAS bf16x8*)(buf + OQ + m * 272 + kb * 64 + q * 16); \
                    at = __builtin_amdgcn_mfma_f32_16x16x32_bf16(a, bq, at, 0, 0, 0); } \
                asm volatile("s_nop 15\n s_nop 15" : "+v"(at)); \
                _Pragma("unroll") \
                for (int r = 0; r < 4; ++r) at[r] = (4 * q + r <= m) ? at[r] : 0.f; \
                const bf16x8 attB = mk_bf16x8(cvt_pk_bf16(at[0], at[1]), cvt_pk_bf16(at[2], at[3]), 0u, 0u); \
                f32x4 oacc = (f32x4){0.f, 0.f, 0.f, 0.f}; \
                _Pragma("unroll") \
                for (int kb = 0; kb < 4; ++kb) { \
                    const bf16x8 a = mk_bf16x8(cvt_pk_bf16(Sacc[2 * kb][0], Sacc[2 * kb][1]), cvt_pk_bf16(Sacc[2 * kb][2], Sacc[2 * kb][3]), cvt_pk_bf16(Sacc[2 * kb + 1][0], Sacc[2 * kb + 1][1]), cvt_pk_bf16(Sacc[2 * kb + 1][2], Sacc[2 * kb + 1][3])); \
                    const u32x2 b0 = *(const LAS u32x2*)(buf + OQ + m * 272 + (32 * kb + 4 * q) * 2), b1 = *(const LAS u32x2*)(buf + OQ + m * 272 + (32 * kb + 16 + 4 * q) * 2); \
                    oacc = __builtin_amdgcn_mfma_f32_16x16x32_bf16(a, mk_bf16x8(b0.x, b0.y, b1.x, b1.y), oacc, 0, 0, 0); } \
                { const u32x2 i0 = *(const LAS u32x2*)(buf + OIT + (16 * w + m) * 48 + q * 8); \
                  oacc = __builtin_amdgcn_mfma_f32_16x16x32_bf16(mk_bf16x8(i0.x, i0.y, 0u, 0u), attB, oacc, 0, 0, 0); } \
                asm volatile("s_nop 15\n s_nop 15" : "+v"(oacc)); \
                { const int st = (c) * 16 + m, n = dir ? (len - 1 - st) : st; \
                  u32x2 o2; o2.x = cvt_pk_bf16(oacc[0], oacc[1]); o2.y = cvt_pk_bf16(oacc[2], oacc[3]); \
                  if (!dry || p.ws == nullptr) *(u32x2*)(BF + (size_t)(rbase + n) * 1024 + h * 128 + 16 * w + 4 * q) = o2; } \
                u32x4 bsu = (u32x4){0u, 0u, 0u, 0u}; \
                if (q < 2) bsu = *(const LAS u32x4*)(buf + OIT + (16 * w + m) * 48 + q * 16); \
                const bf16x8 bs = __builtin_bit_cast(bf16x8, bsu); \
                _Pragma("unroll") \
                for (int kt = 0; kt < 8; ++kt) { u32x4 au = (u32x4){0u, 0u, 0u, 0u}; \
                    if (q < 2) au = *(const LAS u32x4*)(buf + OKT + (16 * kt + m) * 48 + q * 16); \
                    Sacc[kt] = __builtin_amdgcn_mfma_f32_16x16x32_bf16(__builtin_bit_cast(bf16x8, au), bs, Sacc[kt], 0, 0, 0); } \
                asm volatile("s_nop 15\n s_nop 15" : "+v"(Sacc[0]), "+v"(Sacc[1]), "+v"(Sacc[2]), "+v"(Sacc[3]), "+v"(Sacc[4]), "+v"(Sacc[5]), "+v"(Sacc[6]), "+v"(Sacc[7])); \
                _Pragma("unroll") \
                for (int kt = 0; kt < 8; ++kt) Sacc[kt] *= *(const LAS f32x4*)(buf + OE + (16 * kt + 4 * q) * 4); \
                } while (0)
            HG_GLOAD(0); HG_RAWW(0);
            if (nch > 1) { HG_GLOAD(1); HG_RAWW(1); }
            if (nch > 2) HG_GLOAD(2);
            __syncthreads();
            HG_STAGE(0, lds);
            __syncthreads();
            for (int c = 0; c < nch; ++c) {
                if (c + 2 < nch) { HG_RAWW(c + 2); if (c + 3 < nch) HG_GLOAD(c + 3); }
                if (c + 1 < nch) HG_STAGE(c + 1, lds + ((c + 1) & 1) * BUFSZ);
                HG_COMPUTE(c);
                __syncthreads();
            }
#undef HG_COMPUTE
#undef HG_GLOAD
#undef HG_RAWW
#undef HG_STAGE
        }
        __syncthreads();
    }
}
__device__ __forceinline__ void phase_hcomb(const Params& p, int l, int M, bool dry = false) {
    const int tid_ = otid();
    const int lane = tid_ & 63, gw = blockIdx.x * 8 + __builtin_amdgcn_readfirstlane(tid_ >> 6), nw = gridDim.x * 8;
    unsigned char* P = p.ws + OFF_P;
    bf16_t* OF = (bf16_t*)(P + P_BFF); const bf16_t* OB = (const bf16_t*)(P + P_BFB); const bf16_t* BG = (const bf16_t*)(P + P_BG);
    const float* hg = p.hn_g + (size_t)l * 1024 + lane * 16;
    for (int r = gw; r < M; r += nw) {
        const size_t o = (size_t)r * 1024 + lane * 16;
        float x[16]; float ss = 0.f;
#pragma unroll
        for (int hh = 0; hh < 2; ++hh) { const u32x4 a = *(const u32x4*)(OF + o + hh * 8), bq = *(const u32x4*)(OB + o + hh * 8);
            const unsigned aa[4] = {a.x, a.y, a.z, a.w}, bb[4] = {bq.x, bq.y, bq.z, bq.w};
#pragma unroll
            for (int j = 0; j < 4; ++j) { x[hh * 8 + 2 * j] = bf_lo(aa[j]) + bf_lo(bb[j]); x[hh * 8 + 2 * j + 1] = bf_hi(aa[j]) + bf_hi(bb[j]); } }
#pragma unroll
        for (int j = 0; j < 16; ++j) ss += x[j] * x[j];
        ss += __shfl_xor(ss, 1); ss += __shfl_xor(ss, 2); ss += __shfl_xor(ss, 4);
        const float rs = rsqrtf(ss * (1.0f / 128.0f) + 1e-6f);
#pragma unroll
        for (int hh = 0; hh < 2; ++hh) { const u32x4 gq = *(const u32x4*)(BG + o + hh * 8); const unsigned gg[4] = {gq.x, gq.y, gq.z, gq.w};
            float y[8];
#pragma unroll
            for (int j = 0; j < 4; ++j) { y[2 * j] = x[hh * 8 + 2 * j] * rs * hg[hh * 8 + 2 * j] * bf_lo(gg[j]); y[2 * j + 1] = x[hh * 8 + 2 * j + 1] * rs * hg[hh * 8 + 2 * j + 1] * bf_hi(gg[j]); }
            u32x4 w; w.x = cvt_pk_bf16(y[0], y[1]); w.y = cvt_pk_bf16(y[2], y[3]); w.z = cvt_pk_bf16(y[4], y[5]); w.w = cvt_pk_bf16(y[6], y[7]);
            if (!dry || p.ws == nullptr) *(u32x4*)(OF + o + hh * 8) = w; }
    }
}

__device__ __forceinline__ bf16x8 pack_bf16x8(const float (&v)[8]) {
    const unsigned a = cvt_pk_bf16(v[0], v[1]), b = cvt_pk_bf16(v[2], v[3]), c = cvt_pk_bf16(v[4], v[5]), d = cvt_pk_bf16(v[6], v[7]);
    u32x4 q; q.x = a; q.y = b; q.z = c; q.w = d;
    return __builtin_bit_cast(bf16x8, q);
}
__device__ __forceinline__ void phase_s5(const Params& p, int l, LAS unsigned char* lds) {
    const int tid_ = otid();
    const int lane = tid_ & 63, w = __builtin_amdgcn_readfirstlane(tid_ >> 6);
    if (w >= 6) return;
    LAS float* BU = (LAS float*)(lds + w * 12800);
    LAS unsigned char* XB = lds + w * 12800 + 8448;
    const int lq = lane >> 4, lr = lane & 15;
    const bf16_t* CU = (const bf16_t*)(p.ws + OFF_P + P_CU);
    const float* s5lam = (const float*)(p.ws + OFF_S5LAM); const float* s5bb = (const float*)(p.ws + OFF_S5BB);
    for (int s = w * (int)gridDim.x + (int)blockIdx.x; s < 1536; s += 6 * (int)gridDim.x) {
        const int dir = s & 1, g = (s >> 1) % 48, b = s / 96;
        const int ldg = (l * 2 + dir) * 48 + g;
        const float lre = s5lam[(size_t)(ldg * 64 + lane) * 2], lim = s5lam[(size_t)(ldg * 64 + lane) * 2 + 1];
        bf16x8 bbf[8], cf[4];
#pragma unroll
        for (int nt = 0; nt < 8; ++nt) { const int col = nt * 16 + lr, pp = col >> 1, c = col & 1; float v[8];
#pragma unroll
            for (int j = 0; j < 8; ++j) v[j] = (lq < 2) ? s5bb[(size_t)(ldg * 64 + pp) * 32 + c * 16 + lq * 8 + j] : 0.f;
            bbf[nt] = pack_bf16x8(v); }
#pragma unroll
        for (int kb = 0; kb < 4; ++kb) { float v[8];
#pragma unroll
            for (int j = 0; j < 8; ++j) { const int k = kb * 32 + lq * 8 + j, pp = k >> 1; const size_t ci = ((size_t)ldg * 16 + lr) * 64 + pp;
                v[j] = (k & 1) ? -p.c_im[ci] : p.c_re[ci]; }
            cf[kb] = pack_bf16x8(v); }
        bf16_t* YS = (bf16_t*)(p.ws + OFF_H + (dir ? H_YSB : H_YSF));
        float xr = 0.f, xi = 0.f;
        for (int seg = 0; seg < 2; ++seg) {
            const int len = seg == 0 ? CTXL : SEQ, rbase = seg == 0 ? TL + b * CTXL : b * SEQ, nblk = len / 64;
            u32x4 unext[4];
#pragma unroll
            for (int tt = 0; tt < 4; ++tt) { unext[tt] = (u32x4){0u, 0u, 0u, 0u};
                if (lq < 2) { const int st = tt * 16 + lr, n = dir ? (len - 1 - st) : st; unext[tt] = *(const u32x4*)(CU + (size_t)(rbase + n) * 768 + g * 16 + lq * 8); } }
            for (int blk = 0; blk < nblk; ++blk) {
                u32x4 ucur[4];
#pragma unroll
                for (int tt = 0; tt < 4; ++tt) ucur[tt] = unext[tt];
                if (blk + 1 < nblk && lq < 2) {
#pragma unroll
                    for (int tt = 0; tt < 4; ++tt) { const int st = (blk + 1) * 64 + tt * 16 + lr, n = dir ? (len - 1 - st) : st; unext[tt] = *(const u32x4*)(CU + (size_t)(rbase + n) * 768 + g * 16 + lq * 8); } }
#pragma unroll
                for (int tt = 0; tt < 4; ++tt) {
                    const bf16x8 uf = __builtin_bit_cast(bf16x8, ucur[tt]);
                    f32x4 dd[8];
#pragma unroll
                    for (int nt = 0; nt < 8; ++nt) dd[nt] = __builtin_amdgcn_mfma_f32_16x16x32_bf16(bbf[nt], uf, (f32x4){0.f, 0.f, 0.f, 0.f}, 0, 0, 0);
                    asm volatile("s_nop 15\n s_nop 15" : "+v"(dd[0]), "+v"(dd[1]), "+v"(dd[2]), "+v"(dd[3]), "+v"(dd[4]), "+v"(dd[5]), "+v"(dd[6]), "+v"(dd[7]));
#pragma unroll
                    for (int nt = 0; nt < 8; ++nt) *(LAS f32x4*)(BU + lr * 132 + nt * 16 + lq * 4) = dd[nt];
                    asm volatile("s_waitcnt lgkmcnt(0)" ::: "memory");
                    f32x2 bu[16];
#pragma unroll
                    for (int t = 0; t < 16; ++t) bu[t] = *(const LAS f32x2*)(BU + t * 132 + 2 * lane);
#pragma unroll
                    for (int t = 0; t < 16; ++t) { const float nr = lre * xr - lim * xi + bu[t].x, ni = lre * xi + lim * xr + bu[t].y; xr = nr; xi = ni;
                        *(LAS unsigned*)(XB + t * 272 + lane * 4) = cvt_pk_bf16(xr, xi); }
                    asm volatile("s_waitcnt lgkmcnt(0)" ::: "memory");
                    f32x4 acc = (f32x4){0.f, 0.f, 0.f, 0.f};
#pragma unroll
                    for (int kb = 0; kb < 4; ++kb) { const bf16x8 xf = *(const LAS bf16x8*)(XB + lr * 272 + kb * 64 + lq * 16); acc = __builtin_amdgcn_mfma_f32_16x16x32_bf16(cf[kb], xf, acc, 0, 0, 0); }
                    asm volatile("s_nop 15\n s_nop 15\n s_waitcnt lgkmcnt(0)" : "+v"(acc) :: "memory");
                    const int st = blk * 64 + tt * 16 + lr, n = dir ? (len - 1 - st) : st;
                    u32x2 o; o.x = cvt_pk_bf16(acc[0], acc[1]); o.y = cvt_pk_bf16(acc[2], acc[3]);
                    *(u32x2*)(YS + (size_t)(rbase + n) * 768 + g * 16 + lq * 4) = o;
                }
            }
        }
    }
}
__device__ __forceinline__ void phase_s5post(const Params& p, int l, int M, bool dry = false) {
    const int tid_ = otid();
    const size_t n8 = (size_t)M * 768 / 8;
    bf16_t* YF = (bf16_t*)(p.ws + OFF_H + H_YSF); const bf16_t* YB = (const bf16_t*)(p.ws + OFF_H + H_YSB); const bf16_t* CU = (const bf16_t*)(p.ws + OFF_P + P_CU);
    const float* dsk = p.s5_d + (size_t)l * 768;
    for (size_t i = (size_t)blockIdx.x * NTHREADS + tid_; i < n8; i += (size_t)gridDim.x * NTHREADS) {
        const int c = (int)((i * 8) % 768);
        const u32x4 a = *(const u32x4*)(YF + i * 8), bq = *(const u32x4*)(YB + i * 8), uq = *(const u32x4*)(CU + i * 8);
        const unsigned aa[4] = {a.x, a.y, a.z, a.w}, bb[4] = {bq.x, bq.y, bq.z, bq.w}, uu[4] = {uq.x, uq.y, uq.z, uq.w};
        float y[8];
#pragma unroll
        for (int j = 0; j < 4; ++j) { y[2 * j] = gelu_f(bf_lo(aa[j]) + bf_lo(bb[j]) + dsk[c + 2 * j] * bf_lo(uu[j])); y[2 * j + 1] = gelu_f(bf_hi(aa[j]) + bf_hi(bb[j]) + dsk[c + 2 * j + 1] * bf_hi(uu[j])); }
        u32x4 w; w.x = cvt_pk_bf16(y[0], y[1]); w.y = cvt_pk_bf16(y[2], y[3]); w.z = cvt_pk_bf16(y[4], y[5]); w.w = cvt_pk_bf16(y[6], y[7]);
        if (!dry || p.ws == nullptr) *(u32x4*)(YF + i * 8) = w;
    }
}

__device__ __forceinline__ void phase_gmlp(const Params& p, int l, int M, LAS unsigned char* lds, bool dry = false) {
    const int tid_ = otid();
    LAS unsigned char* Wb = lds;
    LAS unsigned char* Vt = lds + 34816;
    LAS float* st = (LAS float*)(lds + 69632);
    const int tid = tid_, lane = tid & 63, w = __builtin_amdgcn_readfirstlane(tid_ >> 6), q = lane >> 4, m = lane & 15;
    bf16_t* AU = (bf16_t*)(p.ws + OFF_P + P_AU); const bf16_t* AV = (const bf16_t*)(p.ws + OFF_P + P_AV);
    const float* lng = p.ln_g + (size_t)l * 1024; const float* lnb = p.ln_b + (size_t)l * 1024;
    const int nch = M / 128, G_ = (int)gridDim.x, nfull = (nch / G_) * G_, nitem = nfull + (nch - nfull) * 8;
    for (int it = blockIdx.x; it < nitem; it += G_) {
        const int u = it < nfull ? it : nfull + ((it - nfull) >> 3), g0 = it < nfull ? 0 : ((it - nfull) & 7), g1 = it < nfull ? 8 : g0 + 1;
        const size_t r0 = (size_t)u * 128;
        for (int i = 0; i < 16; ++i) {
            const int s = w * 16 + i; const bf16_t* rp = AV + (r0 + s) * 1024 + lane * 16;
            const u32x4 a = *(const u32x4*)rp, bq = *(const u32x4*)(rp + 8);
            const unsigned aa[8] = {a.x, a.y, a.z, a.w, bq.x, bq.y, bq.z, bq.w};
            float sm = 0.f, sq = 0.f;
#pragma unroll
            for (int j = 0; j < 8; ++j) { const float x0 = bf_lo(aa[j]), x1 = bf_hi(aa[j]); sm += x0 + x1; sq += x0 * x0 + x1 * x1; }
            sm = wave_sum(sm); sq = wave_sum(sq);
            const float mean = sm * (1.0f / 1024.0f), var = fmaxf(sq * (1.0f / 1024.0f) - mean * mean, 0.f);
            if (lane == 0) { st[s * 2] = mean; st[s * 2 + 1] = rsqrtf(var + 1e-6f); }
        }
        __syncthreads();
        for (int g = g0; g < g1; ++g) {
            { const int t = tid >> 2, s0 = (tid & 3) * 32; const float* ws = p.w_s + ((size_t)l * 8 + g) * 16384 + t * 128 + s0;
#pragma unroll
              for (int qq = 0; qq < 4; ++qq) { const f32x4 a = *(const f32x4*)(ws + qq * 8), b4 = *(const f32x4*)(ws + qq * 8 + 4);
                  u32x4 o; o.x = cvt_pk_bf16(a[0], a[1]); o.y = cvt_pk_bf16(a[2], a[3]); o.z = cvt_pk_bf16(b4[0], b4[1]); o.w = cvt_pk_bf16(b4[2], b4[3]);
                  *(LAS u32x4*)(Wb + t * 272 + (s0 + qq * 8) * 2) = o; } }
            { const int s = tid >> 2, c0 = (tid & 3) * 32; const bf16_t* rp = AV + (r0 + s) * 1024 + g * 128 + c0;
              const float mean = st[s * 2], rstd = st[s * 2 + 1];
#pragma unroll
              for (int qq = 0; qq < 4; ++qq) { const u32x4 a = *(const u32x4*)(rp + qq * 8); const unsigned aa[4] = {a.x, a.y, a.z, a.w};
#pragma unroll
                  for (int j = 0; j < 4; ++j) { const int cl = c0 + qq * 8 + 2 * j, c = g * 128 + cl;
                      const unsigned pk = cvt_pk_bf16((bf_lo(aa[j]) - mean) * rstd * lng[c] + lnb[c], (bf_hi(aa[j]) - mean) * rstd * lng[c + 1] + lnb[c + 1]);
                      *(LAS bf16_t*)(Vt + cl * 272 + s * 2) = (bf16_t)(pk & 0xffffu); *(LAS bf16_t*)(Vt + (cl + 1) * 272 + s * 2) = (bf16_t)(pk >> 16); } } }
            __syncthreads();
            bf16x8 af[4];
#pragma unroll
            for (int kb = 0; kb < 4; ++kb) af[kb] = *(const LAS bf16x8*)(Vt + (16 * w + m) * 272 + kb * 64 + q * 16);
            const float* bs = p.b_s + ((size_t)l * 8 + g) * 128;
#pragma unroll
            for (int tt = 0; tt < 8; ++tt) {
                f32x4 acc = (f32x4){0.f, 0.f, 0.f, 0.f};
#pragma unroll
                for (int kb = 0; kb < 4; ++kb) acc = __builtin_amdgcn_mfma_f32_16x16x32_bf16(af[kb], *(const LAS bf16x8*)(Wb + (16 * tt + m) * 272 + kb * 64 + q * 16), acc, 0, 0, 0);
                const float bb = bs[16 * tt + m];
                bf16_t* up = AU + (r0 + 16 * tt + m) * 1024 + g * 128 + 16 * w + 4 * q;
                const u32x2 uw = *(const u32x2*)up;
                const float y0 = (acc[0] + bb) * bf_lo(uw.x), y1 = (acc[1] + bb) * bf_hi(uw.x), y2 = (acc[2] + bb) * bf_lo(uw.y), y3 = (acc[3] + bb) * bf_hi(uw.y);
                u32x2 o; o.x = cvt_pk_bf16(y0, y1); o.y = cvt_pk_bf16(y2, y3);
                if (!dry || p.ws == nullptr) *(u32x2*)up = o;
            }
            __syncthreads();
        }
    }
}

__device__ __forceinline__ unsigned fkey(float x) { const unsigned b = __float_as_uint(x); return b ^ ((b >> 31) ? 0xFFFFFFFFu : 0x80000000u); }
__device__ __forceinline__ int mbcnt64(unsigned long long m) { return __builtin_amdgcn_mbcnt_hi((unsigned)(m >> 32), __builtin_amdgcn_mbcnt_lo((unsigned)m, 0u)); }
template <int NV>
__device__ __forceinline__ int count_ge(const unsigned (&k)[NV], unsigned cand) {
    int cnt = 0;
#pragma unroll
    for (int i = 0; i < NV; ++i) cnt += __popcll(__ballot(k[i] >= cand));
    return cnt;
}
template <int NV>
__device__ __forceinline__ unsigned radix_thr16(const unsigned (&k)[NV], unsigned e0bits) {
    unsigned prefix = 0u; int bit = 31;
    {
        const unsigned c0 = e0bits ^ 0x80000000u, c1 = c0 + 0x00800000u, c2 = c0 + 0x01000000u, c3 = c0 + 0x01800000u;
        const int n0 = count_ge<NV>(k, c0), n1 = count_ge<NV>(k, c1), n2 = count_ge<NV>(k, c2), n3 = count_ge<NV>(k, c3);
        if (n0 >= 16 && n3 < 16) { prefix = (n2 >= 16) ? c2 : ((n1 >= 16) ? c1 : c0); bit = 22;
            const int nn = (n2 >= 16) ? n2 : ((n1 >= 16) ? n1 : n0); if (nn == 16) bit = -1; }
    }
    for (; bit >= 0; --bit) {
        const unsigned cand = prefix | (1u << bit);
        const int cnt = count_ge<NV>(k, cand);
        if (cnt >= 16) prefix = cand;
        if (cnt == 16) break;
    }
    return prefix;
}
__device__ __forceinline__ unsigned umin_(unsigned a, unsigned b) { return a < b ? a : b; }
__device__ __forceinline__ unsigned umax_(unsigned a, unsigned b) { return a > b ? a : b; }
__device__ __forceinline__ unsigned med3u(unsigned x, unsigned y, unsigned z) { return umax_(umin_(x, y), umin_(umax_(x, y), z)); }
__device__ __forceinline__ float unkey(unsigned k) { return __uint_as_float((k & 0x80000000u) ? (k ^ 0x80000000u) : ~k); }
__device__ __forceinline__ void ins16(unsigned (&a)[16], unsigned x) {
#pragma unroll
    for (int s = 15; s >= 1; --s) a[s] = med3u(a[s - 1], x, a[s]);
    a[0] = umax_(a[0], x);
}
__device__ __forceinline__ unsigned sel16(const unsigned (&a)[16], int i) {
    unsigned r = a[0];
#pragma unroll
    for (int t = 1; t < 16; ++t) r = (i == t) ? a[t] : r;
    return r;
}
__device__ __forceinline__ void phase_topk(const Params& p, int M, LAS unsigned char* lds) {
    const int tid_ = otid();
    LAS unsigned* lk = (LAS unsigned*)lds + tid_;
    const int gl = blockIdx.x * NTHREADS + tid_, nl = gridDim.x * NTHREADS;
    const float* SC = (const float*)(p.ws + OFF_P + Q_SC);
    int* IDX = (int*)(p.ws + OFF_P + Q_IDX); float* GATE = (float*)(p.ws + OFF_P + Q_GATE);
    const int ntask = M * 8;
    for (int task = gl; task < ntask; task += nl) {
        const float* sc = SC + (size_t)task * 256;
        unsigned a[16], b[16];
#pragma unroll
        for (int i = 0; i < 16; ++i) { a[i] = 0u; b[i] = 0u; }
#pragma unroll 4
        for (int i4 = 0; i4 < 32; ++i4) {
            const f32x4 va = *(const f32x4*)(sc + i4 * 4), vb = *(const f32x4*)(sc + 128 + i4 * 4);
#pragma unroll
            for (int e = 0; e < 4; ++e) { const unsigned tag = 127u - (unsigned)(i4 * 4 + e);
                ins16(a, (fkey(va[e]) & ~127u) | tag); ins16(b, (fkey(vb[e]) & ~127u) | tag); }
        }
        float fa[16], fb[16];
#pragma unroll
        for (int i = 0; i < 16; ++i) { fa[i] = unkey(a[i] & ~127u); fb[i] = unkey(b[i] & ~127u); }
        unsigned c[16];
#pragma unroll
        for (int i = 0; i < 16; ++i) c[i] = 0u;
#pragma unroll
        for (int i = 0; i < 16; ++i)
#pragma unroll
            for (int j = 0; j < 16; ++j)
                if ((i + 1) * (j + 1) <= 16) ins16(c, (fkey(fa[i] + fb[j]) & ~255u) | (unsigned)(i * 16 + j));
#pragma unroll
        for (int i = 0; i < 16; ++i) { lk[i * 512] = a[i]; lk[(16 + i) * 512] = b[i]; }
        const float mx = unkey(c[0] & ~255u);
        float ev[16]; float sm = 0.f; int id[16];
#pragma unroll
        for (int s = 0; s < 16; ++s) { ev[s] = __expf(unkey(c[s] & ~255u) - mx); sm += ev[s];
            const int ij = (int)(c[s] & 255u);
            const unsigned ka = lk[(ij >> 4) * 512], kb = lk[(16 + (ij & 15)) * 512];
            id[s] = (int)(127u - (ka & 127u)) * 128 + (int)(127u - (kb & 127u)); }
        const float inv = 1.0f / sm;
#pragma unroll
        for (int q = 0; q < 4; ++q) {
            u32x4 iw; iw.x = (unsigned)id[4 * q]; iw.y = (unsigned)id[4 * q + 1]; iw.z = (unsigned)id[4 * q + 2]; iw.w = (unsigned)id[4 * q + 3];
            *(u32x4*)(IDX + (size_t)task * 16 + q * 4) = iw;
            *(f32x4*)(GATE + (size_t)task * 16 + q * 4) = (f32x4){ev[4 * q] * inv, ev[4 * q + 1] * inv, ev[4 * q + 2] * inv, ev[4 * q + 3] * inv};
        }
    }
}

__device__ __forceinline__ float dot2u(unsigned a, unsigned b, float acc) {
    return __builtin_amdgcn_fdot2_f32_bf16(__builtin_bit_cast(bf16x2_t, a), __builtin_bit_cast(bf16x2_t, b), acc, false);
}
__device__ __forceinline__ float dot8(const u32x4 a, const u32x4 b, float acc) {
    acc = dot2u(a.x, b.x, acc); acc = dot2u(a.y, b.y, acc); acc = dot2u(a.z, b.z, acc); acc = dot2u(a.w, b.w, acc);
    return acc;
}
__device__ __forceinline__ void phase_peer(const Params& p, int l, int M, LAS unsigned char* lds, bool dry = false) {
    const int tid_ = otid();
    const int lane = tid_ & 63, wv_ = __builtin_amdgcn_readfirstlane(tid_ >> 6), gw = blockIdx.x * 8 + wv_, nw = gridDim.x * 8;
    LAS float* wl = (LAS float*)(lds + wv_ * 512);
    const bf16_t* H = (const bf16_t*)(p.ws + OFF_H);
    const unsigned char* U6 = p.ws + OFF_P + Q_UT; const unsigned char* V6 = p.ws + OFF_P + Q_VT;
    const float* USC = (const float*)(p.ws + OFF_P + Q_USC); const float* VSC = (const float*)(p.ws + OFF_P + Q_VSC);
    const int* IDX = (const int*)(p.ws + OFF_P + Q_IDX); const float* GATE = (const float*)(p.ws + OFF_P + Q_GATE);
    const float* modl = (const float*)(p.ws + OFF_MODV) + (size_t)l * 17 * NMOD + 10240;
    float* XC = (float*)(p.ws + OFF_XC);
    const unsigned lane24 = (unsigned)lane * 24u, lane16 = (unsigned)lane * 16u;
#define PEER_LOAD(buf, TAB, g) do { const int _is = ((g) < 8) ? id0 : id1; _Pragma("unroll") for (int e = 0; e < 8; ++e) { \
        const int _id = __builtin_amdgcn_readlane(_is, (((g) * 8 + e) & 63)); const unsigned char* _rb = (TAB) + (size_t)(unsigned)_id * 1536u; \
        const u32x4 _a = *(const u32x4*)(_rb + lane24); const u32x2 _b = *(const u32x2*)(_rb + lane24 + 16); \
        buf[e][0] = _a.x; buf[e][1] = _a.y; buf[e][2] = _a.z; buf[e][3] = _a.w; buf[e][4] = _b.x; buf[e][5] = _b.y; } } while (0)
    for (int row = gw; row < M; row += nw) {
        unsigned xw[16];
#pragma unroll
        for (int j = 0; j < 8; ++j) { const u32x2 a = *(const u32x2*)(H + (size_t)row * D + j * 256 + lane * 4); xw[2 * j] = a.x; xw[2 * j + 1] = a.y; }
        const int id0 = IDX[(size_t)row * 128 + lane], id1 = IDX[(size_t)row * 128 + 64 + lane];
        const float g0 = GATE[(size_t)row * 128 + lane], g1 = GATE[(size_t)row * 128 + 64 + lane];
        const float us0 = USC[id0], us1 = USC[id1];
        const float gv0 = g0 * VSC[id0], gv1 = g1 * VSC[id1];
        u32x6 bA[8];
#pragma unroll 1
        for (int g = 0; g < 16; ++g) {
            PEER_LOAD(bA, U6, g);
            float part[8];
            float chain = 0.f;
#pragma unroll
            for (int e = 0; e < 8; ++e) { asm volatile("" : "+v"(bA[e]), "+v"(chain));
                const bf16x32_t ub = __builtin_amdgcn_cvt_scalef32_pk32_bf16_fp6(bA[e], 1.0f);
                const u32x16 uw = __builtin_bit_cast(u32x16, ub);
                float a0 = 0.f, a1 = 0.f;
#pragma unroll
                for (int i = 0; i < 8; ++i) { const unsigned w0 = uw[2 * i], w1 = uw[2 * i + 1]; a0 = dot2u(w0, xw[2 * i], a0); a1 = dot2u(w1, xw[2 * i + 1], a1); }
                part[e] = a0 + a1; chain = part[e]; }
            float r4[4];
#pragma unroll
            for (int i = 0; i < 4; ++i) { const bool hi = (lane & 32) != 0; const float keep = hi ? part[i + 4] : part[i], send = hi ? part[i] : part[i + 4]; r4[i] = keep + __shfl_xor(send, 32); }
            float r2[2];
#pragma unroll
            for (int i = 0; i < 2; ++i) { const bool hi = (lane & 16) != 0; const float keep = hi ? r4[i + 2] : r4[i], send = hi ? r4[i] : r4[i + 2]; r2[i] = keep + __shfl_xor(send, 16); }
            float r1;
            { const bool hi = (lane & 8) != 0; const float keep = hi ? r2[1] : r2[0], send = hi ? r2[0] : r2[1]; r1 = keep + __shfl_xor(send, 8); }
            r1 += __shfl_xor(r1, 4); r1 += __shfl_xor(r1, 2); r1 += __shfl_xor(r1, 1);
            const int k = g * 8 + ((lane >> 3) & 7);
            const float usk = __shfl((g < 8) ? us0 : us1, k & 63), gvk = __shfl((g < 8) ? gv0 : gv1, k & 63);
            if ((lane & 7) == 0) wl[k] = gelu_f(r1 * usk) * gvk;
        }
        asm volatile("s_waitcnt lgkmcnt(0)" ::: "memory");
        h16x2 oh[16];
#pragma unroll
        for (int i = 0; i < 16; ++i) oh[i] = (h16x2){(_Float16)0.f, (_Float16)0.f};
#pragma unroll 1
        for (int g = 0; g < 16; ++g) {
            u32x4 bV[8];
            { const int _is = (g < 8) ? id0 : id1;
#pragma unroll
              for (int e = 0; e < 8; ++e) { const int _id = __builtin_amdgcn_readlane(_is, ((g * 8 + e) & 63)); bV[e] = *(const u32x4*)(V6 + (size_t)(unsigned)_id * 1024u + lane16); } }
#pragma unroll
            for (int e = 0; e < 8; ++e) { const float wkf = wl[g * 8 + e]; asm volatile("" : "+v"(bV[e]), "+v"(oh[0]), "+v"(oh[5]), "+v"(oh[10]), "+v"(oh[15]));
                const _Float16 wk1 = (_Float16)wkf; const h16x2 wk = (h16x2){wk1, wk1};
                const unsigned wd[4] = {bV[e].x, bV[e].y, bV[e].z, bV[e].w};
#pragma unroll
                for (int d = 0; d < 4; ++d) {
                    oh[4 * d + 0] = __builtin_elementwise_fma(__builtin_bit_cast(h16x2, __builtin_amdgcn_cvt_scalef32_pk_f16_fp4(wd[d], 1.0f, 0)), wk, oh[4 * d + 0]);
                    oh[4 * d + 1] = __builtin_elementwise_fma(__builtin_bit_cast(h16x2, __builtin_amdgcn_cvt_scalef32_pk_f16_fp4(wd[d], 1.0f, 1)), wk, oh[4 * d + 1]);
                    oh[4 * d + 2] = __builtin_elementwise_fma(__builtin_bit_cast(h16x2, __builtin_amdgcn_cvt_scalef32_pk_f16_fp4(wd[d], 1.0f, 2)), wk, oh[4 * d + 2]);
                    oh[4 * d + 3] = __builtin_elementwise_fma(__builtin_bit_cast(h16x2, __builtin_amdgcn_cvt_scalef32_pk_f16_fp4(wd[d], 1.0f, 3)), wk, oh[4 * d + 3]); } }
        }
        float out[32];
#pragma unroll
        for (int i = 0; i < 16; ++i) { out[2 * i] = (float)oh[i].x; out[2 * i + 1] = (float)oh[i].y; }
        asm volatile("s_waitcnt lgkmcnt(0)" ::: "memory");
        const bool lat = row < TL; const int mb = lat ? (row >> 11) : 16;
        float* xp = lat ? p.out + (size_t)row * D : XC + (size_t)(row - TL) * D;
        const float* gv = modl + (size_t)mb * NMOD;
        f32x4 xn[8]; float ss = 0.f;
#pragma unroll
        for (int j = 0; j < 8; ++j) { const int e = j * 256 + lane * 4;
            const f32x4 o4 = (f32x4){out[4 * j], out[4 * j + 1], out[4 * j + 2], out[4 * j + 3]};
            xn[j] = *(const f32x4*)(xp + e) + *(const f32x4*)(gv + e) * o4;
            ss += xn[j][0] * xn[j][0] + xn[j][1] * xn[j][1] + xn[j][2] * xn[j][2] + xn[j][3] * xn[j][3]; }
        ss = wave_sum(ss);
        const float rs = rsqrtf(ss * (1.0f / 2048.0f) + 1e-6f);
        if (!dry || p.ws == nullptr) {
            if (l == 0) {
                const float* m1 = (const float*)(p.ws + OFF_MODV) + (size_t)17 * NMOD + (size_t)mb * NMOD;
                float am = 0.f;
#pragma unroll
                for (int j = 0; j < 8; ++j) { const int e = j * 256 + lane * 4;
                    *(f32x4*)(xp + e) = xn[j];
                    xn[j] = xn[j] * rs * (*(const f32x4*)(m1 + 2048 + e) + 1.0f) + *(const f32x4*)(m1 + e);
                    am = fmaxf(am, fmaxf(fmaxf(fabsf(xn[j][0]), fabsf(xn[j][1])), fmaxf(fabsf(xn[j][2]), fabsf(xn[j][3])))); }
#pragma unroll
                for (int o = 32; o >= 1; o >>= 1) am = fmaxf(am, __shfl_xor(am, o));
                const float qs = am > 0.f ? 240.0f / am : 1.0f;
                unsigned char* H8 = p.ws + OFF_H8 + (size_t)row * D;
#pragma unroll
                for (int j = 0; j < 8; ++j) *(unsigned*)(H8 + j * 256 + lane * 4) = pack_fp8x4(xn[j][0] * qs, xn[j][1] * qs, xn[j][2] * qs, xn[j][3] * qs);
                if (lane == 0) ((float*)(p.ws + OFF_HS))[row] = am > 0.f ? am * (1.0f / 240.0f) : 1.0f;
            } else {
#pragma unroll
                for (int j = 0; j < 8; ++j) { const int e = j * 256 + lane * 4; *(f32x4*)(xp + e) = xn[j] * rs * *(const f32x4*)(p.final_g + e); }
            }
        }
    }
#undef PEER_LOAD
}

__device__ __forceinline__ Params load_params() {
    Params r;
#if defined(__HIP_DEVICE_COMPILE__)
    typedef const unsigned long long __attribute__((address_space(4)))* KP;
    KP k = (KP)__builtin_amdgcn_kernarg_segment_ptr();
    asm volatile("" : "+s"(k));
    void** d = (void**)&r;
#pragma unroll
    for (int i = 0; i < (int)(sizeof(Params) / 8); ++i) d[i] = (void*)(__attribute__((address_space(1))) void*)k[i];
#endif
    return r;
}
#define WSP(off) (p.ws + (off))
template <int l>
__device__ __forceinline__ void mega_layer(LAS unsigned char* lds, const XcdBarrier& bar) {
        const int Mrows = (l == 0) ? TT : TL;
        const int GLU_ROT = (((Mrows / 256) * 6) % (int)gridDim.x) & ~7;
        if (l == 0) {
            { const Params p = load_params(); phase_wconv(p, 0, lds); }
            { const Params p = load_params(); phase_norm<0, true>(p, 0, TT, 0, 2048); }
            xcd_barrier(bar);
        }
        { const Params p = load_params(); EpiInProj E{WSP(OFF_P), (const float*)WSP(OFF_HS), (const unsigned*)WSP(OFF_CMAX) + (size_t)l * INC};
          run_gemm(lds, (const bf16_t*)WSP(OFF_H8), (const bf16_t*)WSP(OFF_W + W_IN), TT, INC, D / 2, E); }
        xcd_barrier(bar);
        { const Params p = load_params(); phase_hgrn(p, l, lds); }
        __syncthreads();
        { const Params p = load_params(); phase_s5(p, l, lds); }
        xcd_barrier(bar);
        { const Params p = load_params(); phase_gmlp(p, l, Mrows, lds); }
        { const Params p = load_params(); phase_hcomb(p, l, Mrows); }
        { const Params p = load_params(); phase_s5post(p, l, Mrows); }
        xcd_barrier(bar);
        { const Params p = load_params(); EpiGlu E{(bf16_t*)WSP(OFF_P + P_CU)}; run_gemm(lds, (const bf16_t*)WSP(OFF_H + H_YSF), (const bf16_t*)WSP(OFF_W + W_GLU), Mrows, 1536, 768, E); }
        { const Params p = load_params(); EpiMerge<true> E{(bf16_t*)WSP(OFF_P + P_MERGED), (const bf16_t*)WSP(OFF_P + P_GATES)}; run_gemm(lds, (const bf16_t*)WSP(OFF_P + P_AU), (const bf16_t*)WSP(OFF_W + W_A), Mrows, D, 1024, E, GLU_ROT); }
        { const Params p = load_params(); EpiMerge<false> E{(bf16_t*)WSP(OFF_P + P_MERGED), (const bf16_t*)WSP(OFF_P + P_GATES) + 2048}; run_gemm(lds, (const bf16_t*)WSP(OFF_P + P_BFF), (const bf16_t*)WSP(OFF_W + W_B), Mrows, D, 1024, E, GLU_ROT); }
        xcd_barrier(bar);
        { const Params p = load_params(); EpiMerge<false> E{(bf16_t*)WSP(OFF_P + P_MERGED), (const bf16_t*)WSP(OFF_P + P_GATES) + 4096}; run_gemm(lds, (const bf16_t*)WSP(OFF_P + P_CU), (const bf16_t*)WSP(OFF_W + W_C), Mrows, D, 768, E); }
        xcd_barrier(bar);
        { const Params p = load_params(); EpiResid E{p.out, (float*)WSP(OFF_XC), (const float*)WSP(OFF_MODV) + (size_t)l * 17 * NMOD + 4096}; run_gemm(lds, (const bf16_t*)WSP(OFF_P + P_MERGED), (const bf16_t*)WSP(OFF_W + W_O), Mrows, D, D, E); }
        { const Params p = load_params(); phase_tabconv(p, l); }
        xcd_barrier(bar);
        { const Params p = load_params(); phase_norm<1>(p, l, Mrows, 6144, 8192); }
        xcd_barrier(bar);
        { const Params p = load_params(); EpiF32 E{(float*)WSP(OFF_P + Q_SC), 2048}; run_gemm(lds, (const bf16_t*)WSP(OFF_H), (const bf16_t*)WSP(OFF_W + W_S), Mrows, D, D, E); }
        xcd_barrier(bar);
        { const Params p = load_params(); phase_topk(p, Mrows, lds); }
        xcd_barrier(bar);
        { const Params p = load_params(); phase_peer(p, l, Mrows, lds); }
        if (l == 0) {
            __syncthreads();
            { const Params p = load_params(); phase_wconv(p, 1, lds); }
            xcd_barrier(bar);
        }
}
#undef WSP
__global__ void __launch_bounds__(NTHREADS, 2) k_mega(Params p_kernarg_only) {
    extern __shared__ __attribute__((aligned(16))) unsigned char smem[];
    LAS unsigned char* lds = (LAS unsigned char*)smem;
    volatile LAS unsigned* xbw = (volatile LAS unsigned*)(lds + LDS_BYTES - 16);
    if (threadIdx.x == 0) { xbw[0] = 0u; xbw[1] = 0u; xbw[2] = 0u; xbw[3] = 0u; }
    __syncthreads();
    XcdBarrier bar;
    { const Params p = load_params(); bar = xcd_barrier_post((unsigned*)(p.ws + OFF_BAR), xbw); }
#define WSP(off) (p.ws + (off))
    { const Params p = load_params(); phase_colmax(p); }
    { const Params p = load_params(); phase_prep(p); phase_mod(p, lds); }
    xcd_barrier(bar);
    mega_layer<0>(lds, bar);
    mega_layer<1>(lds, bar);
#undef WSP
}

extern "C" void kernel_launch(void* const* d_in, const int* in_sizes, int n_in, void* d_out, int out_size, void* d_ws, size_t ws_size, hipStream_t stream) {
    (void)in_sizes; (void)n_in; (void)out_size; (void)ws_size;
    Params p;
    const float** f = (const float**)&p;
    for (int i = 0; i < 31; ++i) f[i] = (const float*)d_in[i];
    p.out = (float*)d_out; p.ws = (unsigned char*)d_ws;
    static int grid = 0;
    if (!grid) {
        int dev = 0, cus = 0, per_cu = 0;
        (void)hipGetDevice(&dev);
        (void)hipDeviceGetAttribute(&cus, hipDeviceAttributeMultiprocessorCount, dev);
        (void)hipFuncSetAttribute((const void*)k_mega, hipFuncAttributeMaxDynamicSharedMemorySize, LDS_BYTES);
        (void)hipOccupancyMaxActiveBlocksPerMultiprocessor(&per_cu, (const void*)k_mega, NTHREADS, LDS_BYTES);
        grid = (per_cu >= 1 && cus > 0) ? (cus < 256 ? cus : 256) : 256;
    }
    (void)hipMemsetAsync(p.ws + OFF_BAR, 0, OFF_MODV, stream);
    hipLaunchKernelGGL(k_mega, dim3(grid), dim3(NTHREADS), LDS_BYTES, stream, p);
}
```

```cpp
#include <hip/hip_runtime.h>
#include <stdint.h>

#define LAS __attribute__((address_space(3)))
typedef unsigned short bf16_t;
typedef short bf16x8 __attribute__((ext_vector_type(8)));
typedef float f32x4 __attribute__((ext_vector_type(4)));
typedef float f32x2 __attribute__((ext_vector_type(2)));
typedef _Float16 h16x2 __attribute__((ext_vector_type(2)));
typedef unsigned u32x4 __attribute__((ext_vector_type(4)));
typedef unsigned u32x2 __attribute__((ext_vector_type(2)));
typedef __bf16 bf16x2_t __attribute__((ext_vector_type(2)));
typedef __bf16 bf16x32_t __attribute__((ext_vector_type(32)));
typedef float f32x32 __attribute__((ext_vector_type(32)));
typedef unsigned u32x6 __attribute__((ext_vector_type(6)));
typedef unsigned u32x16 __attribute__((ext_vector_type(16)));

constexpr int D = 2048, NB = 16, SEQ = 2048, CTXL = 256;
constexpr int TL = NB * SEQ;
constexpr int TC = NB * CTXL;
constexpr int TT = TL + TC;
constexpr int INC = 14080;
constexpr int NMOD = 12288;
constexpr int NTHREADS = 512;
constexpr int LDS_BYTES = 160 * 1024;

constexpr size_t OFF_BAR = 0;
constexpr size_t OFF_CMAX = 16384;
constexpr size_t OFF_MODV = OFF_CMAX + (size_t)2 * INC * 4;
constexpr size_t OFF_LB = OFF_MODV + (size_t)2 * 17 * NMOD * 4;
constexpr size_t OFF_S5LAM = OFF_LB + 2 * 2 * 1024 * 4;
constexpr size_t OFF_S5BB = OFF_S5LAM + (size_t)2 * 2 * 48 * 64 * 2 * 4;
constexpr size_t OFF_PE = OFF_S5BB + (size_t)2 * 2 * 48 * 64 * 32 * 4;
constexpr size_t OFF_HS = (OFF_PE + (size_t)96 * 1024 * 4 + 255) & ~(size_t)255;
constexpr size_t OFF_XC = (OFF_HS + (size_t)TT * 4 + 255) & ~(size_t)255;
constexpr size_t OFF_H = OFF_XC + (size_t)TC * D * 4;
constexpr size_t OFF_W = OFF_H + (size_t)TT * D * 2;
constexpr size_t W_IN = 0;
constexpr size_t W_GLU = W_IN + (size_t)INC * D;
constexpr size_t W_A = W_GLU + (size_t)1536 * 768 * 2;
constexpr size_t W_B = W_A + (size_t)2048 * 1024 * 2;
constexpr size_t W_C = W_B + (size_t)2048 * 1024 * 2;
constexpr size_t W_O = W_C + (size_t)2048 * 768 * 2;
constexpr size_t W_S = W_O + (size_t)2048 * 2048 * 2;
constexpr size_t W_TOTAL = W_S + (size_t)2048 * 2048 * 2;
constexpr size_t OFF_P = OFF_W + W_TOTAL;
constexpr size_t SEG = (size_t)TT * 1024 * 2;
constexpr size_t P_AU = 0, P_AV = SEG, P_BQ = 2 * SEG, P_BFF = 3 * SEG, P_BFB = 4 * SEG, P_BI = 5 * SEG, P_BG = 6 * SEG;
constexpr size_t P_CU = 7 * SEG;
constexpr size_t P_GATES = P_CU + (size_t)TT * 768 * 2;
constexpr size_t P_TOTAL = P_GATES + (size_t)TT * 6144 * 2;
constexpr size_t P_MERGED = SEG;
constexpr size_t Q_UT = 0;
constexpr size_t Q_VT = Q_UT + (size_t)16384 * 1536;
constexpr size_t Q_USC = Q_VT + (size_t)16384 * 1536;
constexpr size_t Q_VSC = Q_USC + (size_t)16384 * 4;
constexpr size_t Q_SC = Q_VSC + (size_t)16384 * 4;
constexpr size_t Q_IDX = Q_SC + (size_t)TT * 2048 * 4;
constexpr size_t Q_GATE = Q_IDX + (size_t)TT * 128 * 4;
constexpr size_t H_YSF = 0;
constexpr size_t H_YSB = (size_t)TT * 768 * 2;
constexpr size_t OFF_H8 = OFF_P + P_TOTAL;
constexpr size_t WS_NEEDED = OFF_H8 + (size_t)TT * D;

struct Params {
    const float *x, *c, *ctx, *c_ctx, *w_mod, *b_mod, *w_in, *ln_g, *ln_b, *w_s, *b_s, *lb_logits, *hn_g;
    const float *lam_re, *lam_im, *log_step, *b_re, *b_im, *c_re, *c_im, *s5_d, *w_glu, *wa, *wb, *wc, *wo, *w_q, *sub_keys, *peer_u, *peer_v, *final_g;
    float* out;
    unsigned char* ws;
};

__device__ __forceinline__ float bf_lo(unsigned u) { return __uint_as_float(u << 16); }
__device__ __forceinline__ float bf_hi(unsigned u) { return __uint_as_float(u & 0xffff0000u); }
__device__ __forceinline__ unsigned cvt_pk_bf16(float lo, float hi) { f32x2 v; v.x = lo; v.y = hi; const bf16x2_t b = __builtin_convertvector(v, bf16x2_t); return __builtin_bit_cast(unsigned, b); }
__device__ __forceinline__ float fexp(float x) { return __builtin_amdgcn_exp2f(x * 1.44269504f); }
__device__ __forceinline__ float flog(float x) { return __builtin_amdgcn_logf(x) * 0.693147181f; }
__device__ __forceinline__ float fast_sigmoid(float x) { return __builtin_amdgcn_rcpf(1.0f + fexp(-x)); }
__device__ __forceinline__ float fast_silu(float x) { return x * fast_sigmoid(x); }
__device__ __forceinline__ float gelu_f(float v) {
    const float av = fabsf(v), t = __builtin_amdgcn_rcpf(av * 0.2316418882f + 1.0f);
    float q = t * 0.5307027145f + (-0.7265760135f); q = q * t + 0.7107068705f; q = q * t + (-0.142248368f); q = q * t + 0.127414796f; q = q * t;
    const float e = __builtin_amdgcn_exp2f((v * v) * (-0.72134752044f));
    const float m = v * (q * e);
    return v < 0.f ? m : v - m;
}
__device__ __forceinline__ unsigned pack_fp8x4(float a, float b, float c, float d) {
    int pk = 0; pk = __builtin_amdgcn_cvt_pk_fp8_f32(a, b, pk, false); pk = __builtin_amdgcn_cvt_pk_fp8_f32(c, d, pk, true); return (unsigned)pk;
}
template <int CTRL> __device__ __forceinline__ float dpp_f(float v) { return __int_as_float(__builtin_amdgcn_update_dpp(0, __float_as_int(v), CTRL, 0xF, 0xF, false)); }
__device__ __forceinline__ float row16_max(float v) { v = fmaxf(v, dpp_f<0x128>(v)); v = fmaxf(v, dpp_f<0x124>(v)); v = fmaxf(v, dpp_f<0x122>(v)); v = fmaxf(v, dpp_f<0x121>(v)); return v; }
__device__ __forceinline__ float row16_sum(float v) { v += dpp_f<0x128>(v); v += dpp_f<0x124>(v); v += dpp_f<0x122>(v); v += dpp_f<0x121>(v); return v; }
__device__ __forceinline__ float wave_sum(float v) {
#pragma unroll
    for (int o = 32; o >= 1; o >>= 1) v += __shfl_xor(v, o);
    return v;
}
__device__ __forceinline__ int otid() { int t; asm volatile("v_mov_b32 %0, %1" : "=v"(t) : "v"((int)threadIdx.x)); return t; }


#define XB_TMO      128
#define XB_XCNT(j)  (256  + 64 * (j))
#define XB_XSUB(j)  (1280 + 64 * (j))
#define XB_XGEN(j)  (2304 + 64 * (j))
#define XB_TOP      3328
#define XB_TOPGEN   3392
#define XCD_BAR_WORDS 3456
#define XB_SPIN_CAP (1u << 22)
__device__ __forceinline__ unsigned xb_ld(unsigned* p)              { return __hip_atomic_load(p, __ATOMIC_RELAXED, __HIP_MEMORY_SCOPE_AGENT); }
__device__ __forceinline__ unsigned xb_add(unsigned* p, unsigned v) { return __hip_atomic_fetch_add(p, v, __ATOMIC_RELAXED, __HIP_MEMORY_SCOPE_AGENT); }
__device__ __forceinline__ unsigned xb_xcc_id() { return (unsigned)__builtin_amdgcn_s_getreg((3 << 11) | 20) & 0xFu; }
#define XB_SPIN(cond, bar) do { unsigned _sp = 0; while (cond) { __builtin_amdgcn_s_sleep(1); \
    if ((++_sp & 255u) == 0u) { if (xb_ld(&(bar)[XB_TMO])) break; if (_sp > XB_SPIN_CAP) { atomicAdd(&(bar)[XB_TMO], 1u); break; } } } } while (0)
struct XcdBarrier { unsigned* bar; unsigned x; volatile LAS unsigned* st; };
__device__ __forceinline__ XcdBarrier xcd_barrier_post(unsigned* bar, volatile LAS unsigned* st) {
    XcdBarrier b; b.bar = bar; b.x = xb_xcc_id(); b.st = st;
    if (threadIdx.x == 0) (void)xb_add(&bar[XB_XCNT(b.x)], 1u);
    return b;
}
__device__ __forceinline__ void xcd_barrier_complete(unsigned* bar, unsigned x, unsigned& nloc, unsigned& nx) {
    const unsigned G = gridDim.x * gridDim.y * gridDim.z;
    unsigned sum, cnt, mine, sp = 0u;
    for (;;) {
        sum = 0u; cnt = 0u; mine = 0u;
#pragma unroll
        for (unsigned j = 0; j < 16; ++j) { const unsigned c = xb_ld(&bar[XB_XCNT(j)]); sum += c; cnt += (c > 0u) ? 1u : 0u; mine = (j == x) ? c : mine; }
        if (sum == G) break;
        __builtin_amdgcn_s_sleep(1);
        if ((++sp & 255u) == 0u) { if (xb_ld(&bar[XB_TMO])) break; if (sp > XB_SPIN_CAP) { atomicAdd(&bar[XB_TMO], 1u); break; } }
    }
    nloc = mine > 0u ? mine : 1u; nx = cnt > 0u ? cnt : 1u;
}
__device__ __forceinline__ void xcd_barrier(const XcdBarrier& b) {
    asm volatile("s_waitcnt vmcnt(0)" ::: "memory");
    __syncthreads();
    if (threadIdx.x == 0) {
        unsigned* bar = b.bar;
        __builtin_amdgcn_s_waitcnt(0);
        unsigned nloc = b.st[0], nx = b.st[1];
        if (nloc == 0u) { xcd_barrier_complete(bar, b.x, nloc, nx); b.st[0] = nloc; b.st[1] = nx; }
        const unsigned old = xb_add(&bar[XB_XSUB(b.x)], 1u);
        const unsigned gen = old / nloc;
        if (old + 1u == (gen + 1u) * nloc) {
            __builtin_amdgcn_fence(__ATOMIC_RELEASE, "agent");
            asm volatile("s_waitcnt vmcnt(0)" ::: "memory");
            const unsigned og = xb_add(&bar[XB_TOP], 1u);
            const unsigned tg = og / nx;
            if (og + 1u == (tg + 1u) * nx) xb_add(&bar[XB_TOPGEN], 1u);
            else XB_SPIN(xb_ld(&bar[XB_TOPGEN]) == tg, bar);
            __builtin_amdgcn_fence(__ATOMIC_ACQUIRE, "agent");
            xb_add(&bar[XB_XGEN(b.x)], 1u);
            asm volatile("s_waitcnt vmcnt(0)" ::: "memory");
        } else {
            XB_SPIN(xb_ld(&bar[XB_XGEN(b.x)]) == gen, bar);
            __builtin_amdgcn_fence(__ATOMIC_ACQUIRE, "agent");
            asm volatile("s_waitcnt vmcnt(0)" ::: "memory");
        }
    }
    __syncthreads();
}

namespace pg8 {
constexpr int BM = 256, BK = 64, HALF = 128, HTB = HALF * BK * 2, STAGE_BYTES = 8 * HTB, NXCD = 8, WGM = 8;
__host__ __device__ __forceinline__ int lds_byte(int r, int c) { const int st = (r >> 4) * 2 + (c >> 5), rr = r & 15, cc = c & 31, ob = rr * 64 + cc * 2; return st * 1024 + (ob ^ (((ob >> 9) & 1) << 5)); }
__host__ __device__ __forceinline__ void stage_rc(int b, int& R, int& C) { const int st = b / 1024, sb = b % 1024, swz = sb ^ (((sb >> 9) & 1) << 5); R = (st >> 1) * 16 + swz / 64; C = (st & 1) * 32 + (swz % 64) / 2; }
__host__ __device__ __forceinline__ int perm32(int rho) { const int n = rho >> 4, i = rho & 15; return 8 * (i >> 2) + 4 * n + (i & 3); }
typedef int i32x8 __attribute__((ext_vector_type(8)));
__device__ __forceinline__ i32x8 cat8(const bf16x8 a, const bf16x8 b) { const u32x4 x = __builtin_bit_cast(u32x4, a), y = __builtin_bit_cast(u32x4, b); i32x8 r; r[0] = (int)x.x; r[1] = (int)x.y; r[2] = (int)x.z; r[3] = (int)x.w; r[4] = (int)y.x; r[5] = (int)y.y; r[6] = (int)y.z; r[7] = (int)y.w; return r; }
struct Unit { int pm, pn; };
struct Gemm { const bf16_t* A; const bf16_t* Bt; int M, N, K; };
struct StaticOrder {
    int nM, nN, nwg, G, c;
    __device__ void init(int M, int N, int G_, int c_) { nM = M / BM; nN = N / BM; nwg = nM * nN; G = G_; c = c_; }
    __device__ bool next(int i, Unit& u) const {
        const long L = (long)i * G + c; if (L >= nwg) return false;
        int wgid = (int)L; { const int q = nwg / NXCD, r = nwg % NXCD, xcd = wgid % NXCD, off = wgid / NXCD; wgid = (xcd < r ? xcd * (q + 1) : r * (q + 1) + (xcd - r) * q) + off; }
        const int nig = WGM * nN, gid = wgid / nig, fm = gid * WGM, gsz = (nM - fm) < WGM ? (nM - fm) : WGM;
        u.pm = fm + ((wgid % nig) % gsz); u.pn = (wgid % nig) / gsz; return true;
    }
};

template <class Epi, class Sched>
__device__ __forceinline__ void gemm_phase(LAS unsigned char* lds, const Gemm g, const Sched& S, const Epi& E) {
    const int tid_ = otid();
    const int tid = tid_, wid = __builtin_amdgcn_readfirstlane(tid >> 6), lane = tid & 63, wr = wid >> 2, wc = wid & 3, fr = lane & 15, fq = lane >> 4;
    const int K = g.K, nt = K / BK;
    unsigned voffA[2], voffB[2];
#pragma unroll
    for (int i = 0; i < 2; ++i) { int R, C; stage_rc(tid * 16 + i * 8192, R, C); const int Rb = Epi::PERM ? ((R & ~31) + perm32(R & 31)) : R;
        voffA[i] = (unsigned)(R * K + C) * 2u; voffB[i] = (unsigned)(Rb * K + C) * 2u; }
    const size_t kstep = (size_t)(BK * 2);
    const size_t hstep = (size_t)HALF * K * 2;
    const size_t tstep = 2 * hstep;
    const unsigned ldsw = (unsigned)wid * 1024u;
    const int aoff = lds_byte(wr * 64 + fr, fq * 8), boff = lds_byte(wc * 32 + fr, fq * 8);
    const int aoff8 = lds_byte(wr * 64 + fr, (fq >> 1) * 32 + (fq & 1) * 16), boff8 = lds_byte(wc * 32 + fr, (fq >> 1) * 32 + (fq & 1) * 16);
#define PG8_SA(b, h) (((b) * 2 + (h)) * HTB)
#define PG8_SB(b, h) ((4 + (b) * 2 + (h)) * HTB)
#define PG8_STAGE(bufoff, gbase, voff) do { _Pragma("unroll") for (int _i = 0; _i < 2; ++_i) \
        __builtin_amdgcn_global_load_lds((const unsigned*)((const char*)(gbase) + (voff)[_i]), (LAS unsigned*)(lds + (bufoff) + ldsw + _i * 8192), 16, 0, 0); } while (0)
#define PG8_LDA(dst, b, h) do { if constexpr (Epi::FP8) { _Pragma("unroll") for (int m = 0; m < 4; ++m) dst##8[m] = cat8(*(const LAS bf16x8*)(lds + PG8_SA(b, h) + aoff + m * 2048), *(const LAS bf16x8*)(lds + PG8_SA(b, h) + aoff + m * 2048 + 1024)); } \
        else { _Pragma("unroll") for (int m = 0; m < 4; ++m) _Pragma("unroll") for (int k = 0; k < 2; ++k) dst[m][k] = *(const LAS bf16x8*)(lds + PG8_SA(b, h) + aoff + m * 2048 + k * 1024); } } while (0)
#define PG8_LDB(dst, b, h) do { if constexpr (Epi::FP8) { _Pragma("unroll") for (int n = 0; n < 2; ++n) dst##8[n] = cat8(*(const LAS bf16x8*)(lds + PG8_SB(b, h) + boff + n * 2048), *(const LAS bf16x8*)(lds + PG8_SB(b, h) + boff + n * 2048 + 1024)); } \
        else { _Pragma("unroll") for (int n = 0; n < 2; ++n) _Pragma("unroll") for (int k = 0; k < 2; ++k) dst[n][k] = *(const LAS bf16x8*)(lds + PG8_SB(b, h) + boff + n * 2048 + k * 1024); } } while (0)
#define PG8_MMA(ai, bj, At, Bt) do { __builtin_amdgcn_s_setprio(1); _Pragma("unroll") for (int m = 0; m < 4; ++m) _Pragma("unroll") for (int n = 0; n < 2; ++n) { \
        if constexpr (Epi::FP8) { asm volatile("v_mfma_scale_f32_16x16x128_f8f6f4 %0, %1, %2, %0, %3, %3 op_sel_hi:[0,0,0]" : "+v"(acc[ai][bj][m][n]) : "v"(Bt##8[n]), "v"(At##8[m]), "v"(one_scale)); } \
        else { _Pragma("unroll") for (int k = 0; k < 2; ++k) acc[ai][bj][m][n] = __builtin_amdgcn_mfma_f32_16x16x32_bf16(Bt[n][k], At[m][k], acc[ai][bj][m][n], 0, 0, 0); } } \
        __builtin_amdgcn_s_setprio(0); } while (0)
#define PG8_WAIT_V(n) asm volatile("s_waitcnt vmcnt(" #n ")" ::: "memory")
#define PG8_WAIT_L(n) asm volatile("s_waitcnt lgkmcnt(" #n ")" ::: "memory")
#define PG8_BAR __builtin_amdgcn_s_barrier()
#define PG8_SCHED __builtin_amdgcn_sched_barrier(0)
    Unit cur, nxt; int ui = 0;
    if (!S.next(0, cur)) return;
    f32x4 acc[2][2][4][2];
#pragma unroll
    for (int a = 0; a < 2; ++a)
#pragma unroll
        for (int b = 0; b < 2; ++b)
#pragma unroll
            for (int m = 0; m < 4; ++m)
#pragma unroll
                for (int n = 0; n < 2; ++n) acc[a][b][m][n] = (f32x4){0.f, 0.f, 0.f, 0.f};
    bf16x8 At[4][2], B0[2][2], B1[2][2];
    i32x8 At8[4], B08[2], B18[2];
    const int one_scale = 0x7F7F7F7F;
    const char* cA = (const char*)g.A + (size_t)cur.pm * tstep; const char* cB = (const char*)g.Bt + (size_t)cur.pn * tstep;
    PG8_STAGE(PG8_SB(0, 0), cB, voffB); PG8_STAGE(PG8_SA(0, 0), cA, voffA); PG8_STAGE(PG8_SB(0, 1), cB + hstep, voffB); PG8_STAGE(PG8_SA(0, 1), cA + hstep, voffA);
    if (wr == 1) PG8_BAR;
    PG8_WAIT_V(4); PG8_BAR;
    PG8_STAGE(PG8_SB(1, 0), cB + kstep, voffB); PG8_STAGE(PG8_SA(1, 0), cA + kstep, voffA); PG8_STAGE(PG8_SB(1, 1), cB + hstep + kstep, voffB);
    PG8_WAIT_V(6); PG8_BAR;
    for (;;) {
        const bool has_next = S.next(ui + 1, nxt);
        const char* nA = has_next ? (const char*)g.A + (size_t)nxt.pm * tstep : cA; const char* nB = has_next ? (const char*)g.Bt + (size_t)nxt.pn * tstep : cB;
        for (int t = 0; t < nt; t += 2) {
            const bool last = (t == nt - 2);
            const char* a1 = cA + (size_t)(t + 1) * kstep;
            const char* a2 = last ? nA : cA + (size_t)(t + 2) * kstep; const char* b2 = last ? nB : cB + (size_t)(t + 2) * kstep;
            const char* a3 = a2 + kstep; const char* b3 = b2 + kstep;
            PG8_LDB(B0, 0, 0); PG8_SCHED; PG8_LDA(At, 0, 0); PG8_STAGE(PG8_SA(1, 1), a1 + hstep, voffA);
            PG8_WAIT_L(8); PG8_BAR; PG8_WAIT_L(0); PG8_MMA(0, 0, At, B0); PG8_BAR; PG8_SCHED;
            PG8_LDB(B1, 0, 1); PG8_STAGE(PG8_SB(0, 0), b2, voffB);
            PG8_BAR; PG8_WAIT_L(0); PG8_MMA(0, 1, At, B1); PG8_BAR;
            PG8_LDA(At, 0, 1); PG8_STAGE(PG8_SA(0, 0), a2, voffA);
            PG8_BAR; PG8_WAIT_L(0); PG8_MMA(1, 0, At, B0); PG8_BAR; PG8_SCHED;
            PG8_STAGE(PG8_SB(0, 1), b2 + hstep, voffB);
            PG8_WAIT_V(6); PG8_BAR; PG8_MMA(1, 1, At, B1); PG8_BAR;
            PG8_LDB(B0, 1, 0); PG8_SCHED; PG8_LDA(At, 1, 0); PG8_STAGE(PG8_SA(0, 1), a2 + hstep, voffA);
            PG8_WAIT_L(8); PG8_BAR; PG8_WAIT_L(0); PG8_MMA(0, 0, At, B0); PG8_BAR; PG8_SCHED;
            PG8_LDB(B1, 1, 1); PG8_STAGE(PG8_SB(1, 0), b3, voffB);
            PG8_BAR; PG8_WAIT_L(0); PG8_MMA(0, 1, At, B1); PG8_BAR;
            PG8_LDA(At, 1, 1); PG8_STAGE(PG8_SA(1, 0), a3, voffA);
            PG8_BAR; PG8_WAIT_L(0); PG8_MMA(1, 0, At, B0); PG8_BAR; PG8_SCHED;
            PG8_STAGE(PG8_SB(1, 1), b3 + hstep, voffB);
            PG8_WAIT_V(6); PG8_BAR; PG8_MMA(1, 1, At, B1); PG8_BAR;
        }
        if constexpr (Epi::FP8) asm volatile("s_nop 15\n s_nop 15\n s_nop 15" ::: "memory");
        E(acc, cur, wr, wc, fr, fq);
        if (!has_next) break;
#pragma unroll
        for (int a = 0; a < 2; ++a)
#pragma unroll
            for (int b = 0; b < 2; ++b)
#pragma unroll
                for (int m = 0; m < 4; ++m)
#pragma unroll
                    for (int n = 0; n < 2; ++n) acc[a][b][m][n] = (f32x4){0.f, 0.f, 0.f, 0.f};
        cur = nxt; cA = nA; cB = nB; ++ui;
    }
    PG8_WAIT_V(0);
    if (wr == 0) PG8_BAR;
    PG8_BAR;
#undef PG8_SA
#undef PG8_SB
#undef PG8_STAGE
#undef PG8_LDA
#undef PG8_LDB
#undef PG8_MMA
#undef PG8_WAIT_V
#undef PG8_WAIT_L
#undef PG8_BAR
#undef PG8_SCHED
}
}

typedef f32x4 AccT[2][2][4][2];

struct EpiInProj {
    static constexpr bool PERM = true, FP8 = true;
    unsigned char* P;
    const float* sa;
    const unsigned* cmax;
    __device__ __forceinline__ void operator()(const AccT& acc, const pg8::Unit& u, int wr, int wc, int fr, int fq) const {
        const int pn = u.pn;
        bf16_t* base; int ld, lc, act;
        if (pn < 28) { const int seg = pn >> 2; base = (bf16_t*)(P + (size_t)seg * SEG); ld = 1024; lc = (pn & 3) * 256; act = (seg < 2) ? 1 : ((seg == 2 || seg == 6) ? 2 : 0); }
        else if (pn < 31) { base = (bf16_t*)(P + P_CU); ld = 768; lc = (pn - 28) * 256; act = 0; }
        else { base = (bf16_t*)(P + P_GATES); ld = 6144; lc = (pn - 31) * 256; act = 3; }
        const int row0 = u.pm * 256 + wr * 64 + fr, col0 = lc + wc * 32 + 8 * fq, gcol0 = u.pn * 256 + wc * 32 + 8 * fq;
        f32x4 cs[2][2];
#pragma unroll
        for (int bj = 0; bj < 2; ++bj)
#pragma unroll
            for (int n = 0; n < 2; ++n) { const u32x4 cb = *(const u32x4*)(cmax + gcol0 + bj * 128 + 4 * n);
                cs[bj][n] = (f32x4){__uint_as_float(cb.x), __uint_as_float(cb.y), __uint_as_float(cb.z), __uint_as_float(cb.w)} * (1.0f / 240.0f); }
        float rscv[2][4];
#pragma unroll
        for (int ai = 0; ai < 2; ++ai)
#pragma unroll
            for (int m = 0; m < 4; ++m) rscv[ai][m] = sa[row0 + ai * 128 + m * 16];
#pragma unroll
        for (int ai = 0; ai < 2; ++ai)
#pragma unroll
            for (int m = 0; m < 4; ++m) {
                bf16_t* rowp = base + (size_t)(row0 + ai * 128 + m * 16) * ld + col0;
                const float rsc = rscv[ai][m];
#pragma unroll
                for (int bj = 0; bj < 2; ++bj) {
                    f32x4 v0 = acc[ai][bj][m][0] * (cs[bj][0] * rsc), v1 = acc[ai][bj][m][1] * (cs[bj][1] * rsc);
                    if (act == 1) {
#pragma unroll
                        for (int j = 0; j < 4; ++j) { v0[j] = gelu_f(v0[j]); v1[j] = gelu_f(v1[j]); }
                    } else if (act == 2) {
#pragma unroll
                        for (int j = 0; j < 4; ++j) { v0[j] = fast_silu(v0[j]); v1[j] = fast_silu(v1[j]); }
                    } else if (act == 3) {
#pragma unroll
                        for (int j = 0; j < 4; ++j) { v0[j] = fast_sigmoid(v0[j]); v1[j] = fast_sigmoid(v1[j]); }
                    }
                    u32x4 w; w.x = cvt_pk_bf16(v0[0], v0[1]); w.y = cvt_pk_bf16(v0[2], v0[3]); w.z = cvt_pk_bf16(v1[0], v1[1]); w.w = cvt_pk_bf16(v1[2], v1[3]);
                    *(u32x4*)(rowp + bj * 128) = w;
                }
            }
    }
};
struct EpiGlu {
    static constexpr bool PERM = true, FP8 = false;
    bf16_t* O;
    __device__ __forceinline__ void operator()(const AccT& acc, const pg8::Unit& u, int wr, int wc, int fr, int fq) const {
        const int row0 = u.pm * 256 + wr * 64 + fr, col0 = u.pn * 128 + wc * 32 + 8 * fq;
#pragma unroll
        for (int ai = 0; ai < 2; ++ai)
#pragma unroll
            for (int m = 0; m < 4; ++m) {
                f32x4 v0 = acc[ai][0][m][0], v1 = acc[ai][0][m][1]; const f32x4 g0 = acc[ai][1][m][0], g1 = acc[ai][1][m][1];
#pragma unroll
                for (int j = 0; j < 4; ++j) { v0[j] *= fast_sigmoid(g0[j]); v1[j] *= fast_sigmoid(g1[j]); }
                u32x4 w; w.x = cvt_pk_bf16(v0[0], v0[1]); w.y = cvt_pk_bf16(v0[2], v0[3]); w.z = cvt_pk_bf16(v1[0], v1[1]); w.w = cvt_pk_bf16(v1[2], v1[3]);
                *(u32x4*)(O + (size_t)(row0 + ai * 128 + m * 16) * 768 + col0) = w;
            }
    }
};
template <bool FIRST> struct EpiMerge {
    static constexpr bool PERM = true, FP8 = false;
    bf16_t* O;
    const bf16_t* G;
    __device__ __forceinline__ void operator()(const AccT& acc, const pg8::Unit& u, int wr, int wc, int fr, int fq) const {
        const int row0 = u.pm * 256 + wr * 64 + fr, col0 = u.pn * 256 + wc * 32 + 8 * fq;
#pragma unroll
        for (int ai = 0; ai < 2; ++ai) {
            u32x4 gwv[4][2], owv[4][2];
#pragma unroll
            for (int m = 0; m < 4; ++m)
#pragma unroll
                for (int bj = 0; bj < 2; ++bj) { const size_t row = (size_t)(row0 + ai * 128 + m * 16);
                    gwv[m][bj] = *(const u32x4*)(G + row * 6144 + col0 + bj * 128);
                    if (!FIRST) owv[m][bj] = *(const u32x4*)(O + row * 2048 + col0 + bj * 128); }
#pragma unroll
            for (int m = 0; m < 4; ++m)
#pragma unroll
                for (int bj = 0; bj < 2; ++bj) { const size_t row = (size_t)(row0 + ai * 128 + m * 16);
                    const u32x4 gw = gwv[m][bj];
                    f32x4 v0 = acc[ai][bj][m][0], v1 = acc[ai][bj][m][1];
                    v0[0] *= bf_lo(gw.x); v0[1] *= bf_hi(gw.x); v0[2] *= bf_lo(gw.y); v0[3] *= bf_hi(gw.y);
                    v1[0] *= bf_lo(gw.z); v1[1] *= bf_hi(gw.z); v1[2] *= bf_lo(gw.w); v1[3] *= bf_hi(gw.w);
                    if (!FIRST) { const u32x4 ow = owv[m][bj];
                        v0[0] += bf_lo(ow.x); v0[1] += bf_hi(ow.x); v0[2] += bf_lo(ow.y); v0[3] += bf_hi(ow.y);
                        v1[0] += bf_lo(ow.z); v1[1] += bf_hi(ow.z); v1[2] += bf_lo(ow.w); v1[3] += bf_hi(ow.w); }
                    u32x4 w; w.x = cvt_pk_bf16(v0[0], v0[1]); w.y = cvt_pk_bf16(v0[2], v0[3]); w.z = cvt_pk_bf16(v1[0], v1[1]); w.w = cvt_pk_bf16(v1[2], v1[3]);
                    *(u32x4*)(O + row * 2048 + col0 + bj * 128) = w; }
        }
    }
};
struct EpiResid {
    static constexpr bool PERM = false, FP8 = false;
    float* XR; float* XC; const float* modl;
    __device__ __forceinline__ void operator()(const AccT& acc, const pg8::Unit& u, int wr, int wc, int fr, int fq) const {
        const int row0 = u.pm * 256 + wr * 64 + fr, col0 = u.pn * 256 + wc * 32 + 4 * fq;
        const int mb = u.pm < 128 ? (u.pm >> 3) : 16;
        const float* gv = modl + (size_t)mb * NMOD + col0;
        float* basep = u.pm < 128 ? XR : (XC - (size_t)TL * D);
        f32x4 gvv[2][2];
#pragma unroll
        for (int bj = 0; bj < 2; ++bj)
#pragma unroll
            for (int n = 0; n < 2; ++n) gvv[bj][n] = *(const f32x4*)(gv + bj * 128 + n * 16);
#pragma unroll
        for (int ai = 0; ai < 2; ++ai) {
            f32x4 xo[4][2][2];
#pragma unroll
            for (int m = 0; m < 4; ++m)
#pragma unroll
                for (int bj = 0; bj < 2; ++bj)
#pragma unroll
                    for (int n = 0; n < 2; ++n) xo[m][bj][n] = *(const f32x4*)(basep + (size_t)(row0 + ai * 128 + m * 16) * D + col0 + bj * 128 + n * 16);
#pragma unroll
            for (int m = 0; m < 4; ++m)
#pragma unroll
                for (int bj = 0; bj < 2; ++bj)
#pragma unroll
                    for (int n = 0; n < 2; ++n) *(f32x4*)(basep + (size_t)(row0 + ai * 128 + m * 16) * D + col0 + bj * 128 + n * 16) = xo[m][bj][n] + gvv[bj][n] * acc[ai][bj][m][n];
        }
    }
};
struct EpiF32 {
    static constexpr bool PERM = false, FP8 = false;
    float* C; int ldc;
    __device__ __forceinline__ void operator()(const AccT& acc, const pg8::Unit& u, int wr, int wc, int fr, int fq) const {
        const int row0 = u.pm * 256 + wr * 64 + fr, col0 = u.pn * 256 + wc * 32 + 4 * fq;
#pragma unroll
        for (int ai = 0; ai < 2; ++ai)
#pragma unroll
            for (int m = 0; m < 4; ++m) {
                float* rowp = C + (size_t)(row0 + ai * 128 + m * 16) * ldc + col0;
#pragma unroll
                for (int bj = 0; bj < 2; ++bj)
#pragma unroll
                    for (int n = 0; n < 2; ++n) *(f32x4*)(rowp + bj * 128 + n * 16) = acc[ai][bj][m][n];
            }
    }
};

template <class Epi>
__device__ __forceinline__ void run_gemm(LAS unsigned char* lds, const bf16_t* A, const bf16_t* Bt, int M, int N, int K, const Epi& E, int rot = 0) {
    pg8::Gemm g{A, Bt, M, N, K};
    const int G_ = (int)gridDim.x; int c_ = (int)blockIdx.x - rot; if (c_ < 0) c_ += G_;
    pg8::StaticOrder S; S.init(M, N, G_, c_);
    pg8::gemm_phase<Epi, pg8::StaticOrder>(lds, g, S, E);
}

__device__ __forceinline__ void phase_mod(const Params& p, LAS unsigned char* lds) {
    const int tid_ = otid();
    LAS float* cs = (LAS float*)lds;
    LAS float* red = (LAS float*)(lds + 2048 * 17 * 4);
    const int tid = tid_;
    float* modv = (float*)(p.ws + OFF_MODV);
    { f32x4 cv[17];
#pragma unroll
      for (int r = 0; r < 17; ++r) cv[r] = *(const f32x4*)((r < 16 ? p.c + r * 2048 : p.c_ctx) + tid * 4);
#pragma unroll
      for (int r = 0; r < 17; ++r)
#pragma unroll
          for (int e = 0; e < 4; ++e) { const float c = cv[r][e]; cs[(tid * 4 + e) * 17 + r] = c / (1.0f + __expf(-c)); } }
    __syncthreads();
    const int lane = tid & 63, wv = tid >> 6, cq = lane & 7, kg = wv * 8 + (lane >> 3);
    for (int u = blockIdx.x; u < 768; u += gridDim.x) {
        const int l = u / 384, c0 = (u % 384) * 32;
        const float* w = p.w_mod + (size_t)l * 2048 * NMOD + (size_t)kg * NMOD + c0 + cq * 4;
        f32x4 acc[17];
#pragma unroll
        for (int r = 0; r < 17; ++r) acc[r] = (f32x4){0.f, 0.f, 0.f, 0.f};
#pragma unroll 16
        for (int j = 0; j < 32; ++j) {
            const f32x4 w4 = *(const f32x4*)(w + (size_t)j * 64 * NMOD);
            const LAS float* cr = cs + (kg + 64 * j) * 17;
#pragma unroll
            for (int r = 0; r < 17; ++r) acc[r] += w4 * cr[r];
        }
#pragma unroll
        for (int r = 0; r < 17; ++r)
#pragma unroll
            for (int c = 0; c < 4; ++c) { float v = acc[r][c]; v += __shfl_xor(v, 8); v += __shfl_xor(v, 16); v += __shfl_xor(v, 32);
                if (lane < 8) red[(wv * 32 + cq * 4 + c) * 17 + r] = v; }
        __syncthreads();
        for (int o = tid; o < 32 * 17; o += NTHREADS) { const int col = o & 31, r = o >> 5;
            float sum = p.b_mod[l * NMOD + c0 + col];
#pragma unroll
            for (int q = 0; q < 8; ++q) sum += red[(q * 32 + col) * 17 + r];
            modv[(size_t)(l * 17 + r) * NMOD + c0 + col] = sum; }
        __syncthreads();
    }
}
__device__ __forceinline__ void phase_prep(const Params& p) {
    const int tid_ = otid();
    const int gt = blockIdx.x * NTHREADS + tid_, nt = gridDim.x * NTHREADS;
    float* lb = (float*)(p.ws + OFF_LB);
    for (int i = gt; i < 2 * 1024; i += nt) { const float x0 = p.lb_logits[i], x1 = p.lb_logits[2048 + i]; lb[i] = 0.f; lb[2048 + i] = 1.0f / (1.0f + expf(x0 - x1)); }
    float* s5lam = (float*)(p.ws + OFF_S5LAM); float* s5bb = (float*)(p.ws + OFF_S5BB);
    for (int i = gt; i < 2 * 2 * 48 * 64; i += nt) {
        const int ldg = i >> 6;
        const double lre = (double)p.lam_re[i], lim = (double)p.lam_im[i], dt = exp((double)p.log_step[ldg]);
        const double er = exp(lre * dt); double sn, cs; sincos(lim * dt, &sn, &cs);
        const double br = er * cs, bi = er * sn;
        s5lam[i * 2] = (float)br; s5lam[i * 2 + 1] = (float)bi;
        const double nr = br - 1.0, ni = bi, den = lre * lre + lim * lim;
        const double cr = (nr * lre + ni * lim) / den, ci = (ni * lre - nr * lim) / den;
        for (int d = 0; d < 16; ++d) { const double xr = (double)p.b_re[(size_t)i * 16 + d], xi = (double)p.b_im[(size_t)i * 16 + d];
            s5bb[(size_t)i * 32 + d] = (float)(cr * xr - ci * xi); s5bb[(size_t)i * 32 + 16 + d] = (float)(cr * xi + ci * xr); }
    }
    float* pe = (float*)(p.ws + OFF_PE);
    for (int i = gt; i < 96 * 1024; i += nt) {
        const int r = i >> 10, cc = i & 1023, j = cc & 511;
        const float pos = (float)(r < 32 ? r : r - 32);
        const float omega = 1.0f / powf(10000.0f, (float)j * (1.0f / 512.0f));
        const float ang = pos * omega;
        pe[i] = cc < 512 ? sinf(ang) : cosf(ang);
    }
}

template <int MAPMODE>
__device__ __forceinline__ void transpose_convert(const float* src, int K, int N, bf16_t* dst, LAS unsigned char* lds) {
    const int tid_ = otid();
    LAS float* tile = (LAS float*)lds;
    const int tid = tid_, nkb = K / 64, nnb = N / 64;
    for (int u = blockIdx.x; u < nkb * nnb; u += gridDim.x) {
        const int kb = u / nnb, nb = u % nnb, k0 = kb * 64, n0 = nb * 64;
        { const int nn = tid & 63, kk = tid >> 6;
#pragma unroll
          for (int i = 0; i < 8; ++i) tile[(kk + i * 8) * 65 + nn] = src[(size_t)(k0 + kk + i * 8) * N + n0 + nn]; }
        __syncthreads();
        { const int kk2 = (tid & 7) * 8, nn2 = tid >> 3; float v[8];
#pragma unroll
          for (int i = 0; i < 8; ++i) v[i] = tile[(kk2 + i) * 65 + nn2];
          int n = n0 + nn2, nr;
          if (MAPMODE == 1) { if (n < 768) nr = (n >> 7) * 256 + (n & 127); else { const int m = n - 768; nr = (m >> 7) * 256 + 128 + (m & 127); } } else nr = n;
          u32x4 w; w.x = cvt_pk_bf16(v[0], v[1]); w.y = cvt_pk_bf16(v[2], v[3]); w.z = cvt_pk_bf16(v[4], v[5]); w.w = cvt_pk_bf16(v[6], v[7]);
          *(u32x4*)(dst + (size_t)nr * K + k0 + kk2) = w; }
        __syncthreads();
    }
}
__device__ __forceinline__ void phase_wscore(const float* wq, const float* sk, bf16_t* dst, LAS unsigned char* lds) {
    const int tid_ = otid();
    LAS float* skt = (LAS float*)lds;
    LAS float* wqt = (LAS float*)(lds + 128 * 129 * 4);
    const int tid = tid_;
    for (int u = blockIdx.x; u < 16 * 32; u += gridDim.x) {
        const int hp = u >> 5, kb = u & 31;
        for (int i = tid; i < 128 * 128; i += NTHREADS) { const int key = i >> 7, e = i & 127; skt[key * 129 + e] = sk[(size_t)hp * 16384 + i]; }
        for (int i = tid; i < 64 * 128; i += NTHREADS) { const int k = i >> 7, e = i & 127; wqt[e * 68 + k] = wq[(size_t)(kb * 64 + k) * 2048 + hp * 128 + e]; }
        __syncthreads();
        const int key = tid & 127, kg = tid >> 7;
        float acc[16];
#pragma unroll
        for (int i = 0; i < 16; ++i) acc[i] = 0.f;
        for (int e = 0; e < 128; ++e) {
            const float s = skt[key * 129 + e];
#pragma unroll
            for (int q = 0; q < 4; ++q) { const f32x4 w4 = *(const LAS f32x4*)(wqt + e * 68 + kg * 16 + q * 4);
                acc[q * 4 + 0] += s * w4[0]; acc[q * 4 + 1] += s * w4[1]; acc[q * 4 + 2] += s * w4[2]; acc[q * 4 + 3] += s * w4[3]; }
        }
        bf16_t* o = dst + (size_t)(hp * 128 + key) * 2048 + kb * 64 + kg * 16;
        u32x4 w0, w1;
        w0.x = cvt_pk_bf16(acc[0], acc[1]); w0.y = cvt_pk_bf16(acc[2], acc[3]); w0.z = cvt_pk_bf16(acc[4], acc[5]); w0.w = cvt_pk_bf16(acc[6], acc[7]);
        w1.x = cvt_pk_bf16(acc[8], acc[9]); w1.y = cvt_pk_bf16(acc[10], acc[11]); w1.z = cvt_pk_bf16(acc[12], acc[13]); w1.w = cvt_pk_bf16(acc[14], acc[15]);
        *(u32x4*)o = w0; *(u32x4*)(o + 8) = w1;
        __syncthreads();
    }
}
__device__ __forceinline__ void phase_colmax(const Params& p) {
    const int tid_ = otid();
    unsigned* cm = (unsigned*)(p.ws + OFF_CMAX);
    const int total = 2 * (INC / 4) * 16;
    for (int i = blockIdx.x * NTHREADS + tid_; i < total; i += gridDim.x * NTHREADS) {
        const int kc = i / (2 * (INC / 4)), cidx = i % (2 * (INC / 4)), l = cidx / (INC / 4), nq = cidx % (INC / 4);
        const float* w = p.w_in + (size_t)l * D * INC + (size_t)(kc * 128) * INC + nq * 4;
        f32x4 am = (f32x4){0.f, 0.f, 0.f, 0.f};
#pragma unroll 32
        for (int k = 0; k < 128; ++k) { const f32x4 v = *(const f32x4*)(w + (size_t)k * INC);
            am[0] = fmaxf(am[0], fabsf(v[0])); am[1] = fmaxf(am[1], fabsf(v[1])); am[2] = fmaxf(am[2], fabsf(v[2])); am[3] = fmaxf(am[3], fabsf(v[3])); }
        unsigned* o = cm + l * INC + nq * 4;
        atomicMax(o, __float_as_uint(am[0])); atomicMax(o + 1, __float_as_uint(am[1])); atomicMax(o + 2, __float_as_uint(am[2])); atomicMax(o + 3, __float_as_uint(am[3]));
    }
}
__device__ __forceinline__ void transpose_convert_fp8(const float* src, int K, int N, unsigned char* dst, const unsigned* cmax, LAS unsigned char* lds) {
    const int tid_ = otid();
    LAS float* tile = (LAS float*)lds;
    const int tid = tid_, nkb = K / 64, nnb = N / 64;
    for (int u = blockIdx.x; u < nkb * nnb; u += gridDim.x) {
        const int kb = u / nnb, nb = u % nnb, k0 = kb * 64, n0 = nb * 64;
        { const int nn = tid & 63, kk = tid >> 6;
#pragma unroll
          for (int i = 0; i < 8; ++i) tile[(kk + i * 8) * 65 + nn] = src[(size_t)(k0 + kk + i * 8) * N + n0 + nn]; }
        __syncthreads();
        { const int kk2 = (tid & 7) * 8, nn2 = tid >> 3; float v[8];
          const float cmv = __uint_as_float(cmax[n0 + nn2]); const float sc = cmv > 0.f ? 240.0f / cmv : 1.0f;
#pragma unroll
          for (int i = 0; i < 8; ++i) v[i] = tile[(kk2 + i) * 65 + nn2] * sc;
          u32x2 w; w.x = pack_fp8x4(v[0], v[1], v[2], v[3]); w.y = pack_fp8x4(v[4], v[5], v[6], v[7]);
          *(u32x2*)(dst + (size_t)(n0 + nn2) * K + k0 + kk2) = w; }
        __syncthreads();
    }
}
__device__ __forceinline__ void phase_wconv(const Params& p, int l, LAS unsigned char* lds) {
    unsigned char* W = p.ws + OFF_W;
    transpose_convert_fp8(p.w_in + (size_t)l * D * INC, D, INC, W + W_IN, (const unsigned*)(p.ws + OFF_CMAX) + (size_t)l * INC, lds);
    transpose_convert<1>(p.w_glu + (size_t)l * 768 * 1536, 768, 1536, (bf16_t*)(W + W_GLU), lds);
    transpose_convert<0>(p.wa + (size_t)l * 1024 * D, 1024, D, (bf16_t*)(W + W_A), lds);
    transpose_convert<0>(p.wb + (size_t)l * 1024 * D, 1024, D, (bf16_t*)(W + W_B), lds);
    transpose_convert<0>(p.wc + (size_t)l * 768 * D, 768, D, (bf16_t*)(W + W_C), lds);
    transpose_convert<0>(p.wo + (size_t)l * D * D, D, D, (bf16_t*)(W + W_O), lds);
    phase_wscore(p.w_q + (size_t)l * D * D, p.sub_keys + (size_t)l * 16 * 16384, (bf16_t*)(W + W_S), lds);
}
__device__ __forceinline__ void phase_tabconv(const Params& p, int l) {
    const int tid_ = otid();
    const int lane = tid_ & 63, gw = blockIdx.x * 8 + __builtin_amdgcn_readfirstlane(tid_ >> 6), nw = gridDim.x * 8;
    unsigned char* U6 = p.ws + OFF_P + Q_UT; unsigned char* V6 = p.ws + OFF_P + Q_VT;
    float* USC = (float*)(p.ws + OFF_P + Q_USC); float* VSC = (float*)(p.ws + OFF_P + Q_VSC);
    for (int r = gw; r < 32768; r += nw) {
        const bool isv = r >= 16384; const int rr = r & 16383;
        const float* src = (isv ? p.peer_v : p.peer_u) + (size_t)l * 16384 * 2048 + (size_t)rr * 2048;
        f32x4 v[8];
#pragma unroll
        for (int j = 0; j < 8; ++j) v[j] = *(const f32x4*)(src + j * 256 + lane * 4);
        float am = 0.f;
#pragma unroll
        for (int j = 0; j < 8; ++j) am = fmaxf(am, fmaxf(fmaxf(fabsf(v[j][0]), fabsf(v[j][1])), fmaxf(fabsf(v[j][2]), fabsf(v[j][3]))));
#pragma unroll
        for (int o = 32; o >= 1; o >>= 1) am = fmaxf(am, __shfl_xor(am, o));
        {
            const float sc4 = am > 0.f ? 6.0f / am : 1.0f;
            unsigned wd[4] = {0u, 0u, 0u, 0u};
#pragma unroll
            for (int j = 0; j < 8; ++j) {
                if ((j & 1) == 0) { wd[j >> 1] = __builtin_amdgcn_cvt_scalef32_pk_fp4_f32(wd[j >> 1], v[j][0] * sc4, v[j][1] * sc4, 1.0f, 0); wd[j >> 1] = __builtin_amdgcn_cvt_scalef32_pk_fp4_f32(wd[j >> 1], v[j][2] * sc4, v[j][3] * sc4, 1.0f, 1); }
                else { wd[j >> 1] = __builtin_amdgcn_cvt_scalef32_pk_fp4_f32(wd[j >> 1], v[j][0] * sc4, v[j][1] * sc4, 1.0f, 2); wd[j >> 1] = __builtin_amdgcn_cvt_scalef32_pk_fp4_f32(wd[j >> 1], v[j][2] * sc4, v[j][3] * sc4, 1.0f, 3); } }
            u32x4 w4; w4.x = wd[0]; w4.y = wd[1]; w4.z = wd[2]; w4.w = wd[3];
            *(u32x4*)((isv ? V6 : U6) + (size_t)rr * 1024 + lane * 16) = w4;
            if (lane == 0) (isv ? VSC : USC)[rr] = am > 0.f ? am * (1.0f / 6.0f) : 1.0f;
        }
    }
}

template <int MODE, bool F8OUT = false>
__device__ __forceinline__ void phase_norm(const Params& p, int l, int M, int off_sh, int off_sc) {
    const int tid_ = otid();
    const int lane = tid_ & 63, gw = blockIdx.x * 8 + __builtin_amdgcn_readfirstlane(tid_ >> 6), nw = gridDim.x * 8;
    const float* modv = (const float*)(p.ws + OFF_MODV) + (size_t)l * 17 * NMOD;
    const float* pe = (const float*)(p.ws + OFF_PE);
    float* XC = (float*)(p.ws + OFF_XC);
    bf16_t* H = (bf16_t*)(p.ws + OFF_H);
    for (int r = gw; r < M; r += nw) {
        const bool lat = r < TL;
        const float* src = MODE == 0 ? (lat ? p.x + (size_t)r * D : p.ctx + (size_t)(r - TL) * D) : (lat ? p.out + (size_t)r * D : XC + (size_t)(r - TL) * D);
        f32x4 v[4][2];
#pragma unroll
        for (int j = 0; j < 4; ++j) { v[j][0] = *(const f32x4*)(src + j * 512 + lane * 8); v[j][1] = *(const f32x4*)(src + j * 512 + lane * 8 + 4); }
        if (MODE == 0) {
            if (lat) { const int n = r & 2047, gr = n >> 6, gc = n & 63;
#pragma unroll
                for (int j = 0; j < 4; ++j) { const float* pr = (j < 2) ? pe + (size_t)gr * 1024 + j * 512 + lane * 8 : pe + (size_t)(32 + gc) * 1024 + (j - 2) * 512 + lane * 8;
                    v[j][0] += *(const f32x4*)pr; v[j][1] += *(const f32x4*)(pr + 4); } }
            float* dst = lat ? p.out + (size_t)r * D : XC + (size_t)(r - TL) * D;
#pragma unroll
            for (int j = 0; j < 4; ++j) { *(f32x4*)(dst + j * 512 + lane * 8) = v[j][0]; *(f32x4*)(dst + j * 512 + lane * 8 + 4) = v[j][1]; }
        }
        float ss = 0.f;
#pragma unroll
        for (int j = 0; j < 4; ++j)
#pragma unroll
            for (int h = 0; h < 2; ++h) ss += v[j][h][0] * v[j][h][0] + v[j][h][1] * v[j][h][1] + v[j][h][2] * v[j][h][2] + v[j][h][3] * v[j][h][3];
        ss = wave_sum(ss);
        const float rs = rsqrtf(ss * (1.0f / 2048.0f) + 1e-6f);
        const int mb = lat ? (r >> 11) : 16;
        const float* sh = modv + (size_t)mb * NMOD + off_sh; const float* sc = modv + (size_t)mb * NMOD + off_sc;
        if (F8OUT) {
            float am = 0.f;
#pragma unroll
            for (int j = 0; j < 4; ++j) { const int e = j * 512 + lane * 8;
                const f32x4 s0 = *(const f32x4*)(sc + e), s1 = *(const f32x4*)(sc + e + 4), h0 = *(const f32x4*)(sh + e), h1 = *(const f32x4*)(sh + e + 4);
                v[j][0] = v[j][0] * rs * (s0 + 1.0f) + h0; v[j][1] = v[j][1] * rs * (s1 + 1.0f) + h1;
#pragma unroll
                for (int hh = 0; hh < 2; ++hh) am = fmaxf(am, fmaxf(fmaxf(fabsf(v[j][hh][0]), fabsf(v[j][hh][1])), fmaxf(fabsf(v[j][hh][2]), fabsf(v[j][hh][3])))); }
#pragma unroll
            for (int o = 32; o >= 1; o >>= 1) am = fmaxf(am, __shfl_xor(am, o));
            const float q = am > 0.f ? 240.0f / am : 1.0f;
            unsigned char* H8 = p.ws + OFF_H8 + (size_t)r * D;
#pragma unroll
            for (int j = 0; j < 4; ++j) { u32x2 w; w.x = pack_fp8x4(v[j][0][0] * q, v[j][0][1] * q, v[j][0][2] * q, v[j][0][3] * q); w.y = pack_fp8x4(v[j][1][0] * q, v[j][1][1] * q, v[j][1][2] * q, v[j][1][3] * q);
                *(u32x2*)(H8 + j * 512 + lane * 8) = w; }
            if (lane == 0) ((float*)(p.ws + OFF_HS))[r] = am > 0.f ? am * (1.0f / 240.0f) : 1.0f;
        } else {
#pragma unroll
        for (int j = 0; j < 4; ++j) {
            const int e = j * 512 + lane * 8;
            const f32x4 s0 = *(const f32x4*)(sc + e), s1 = *(const f32x4*)(sc + e + 4), h0 = *(const f32x4*)(sh + e), h1 = *(const f32x4*)(sh + e + 4);
            f32x4 a = v[j][0] * rs * (s0 + 1.0f) + h0, b = v[j][1] * rs * (s1 + 1.0f) + h1;
            u32x4 w; w.x = cvt_pk_bf16(a[0], a[1]); w.y = cvt_pk_bf16(a[2], a[3]); w.z = cvt_pk_bf16(b[0], b[1]); w.w = cvt_pk_bf16(b[2], b[3]);
            *(u32x4*)(H + (size_t)r * D + e) = w;
        }
        }
    }
}
__device__ __forceinline__ bf16x8 mk_bf16x8(unsigned a, unsigned b, unsigned c, unsigned d) { u32x4 q; q.x = a; q.y = b; q.z = c; q.w = d; return __builtin_bit_cast(bf16x8, q); }
__device__ __forceinline__ void phase_hgrn(const Params& p, int l, LAS unsigned char* lds, bool dry = false) {
    const int tid_ = otid();
    const int lane = tid_ & 63, w = __builtin_amdgcn_readfirstlane(tid_ >> 6), q = lane >> 4, m = lane & 15;
    constexpr int OQ = 0, OKH = 4352, OKT = 8704, OIT = 14848, OE = 20992, BUFSZ = 21504, RAWOFF = 2 * 21504, RAWSZ = 3 * 4352;
    unsigned char* P = p.ws + OFF_P;
    const float* lbp = (const float*)(p.ws + OFF_LB) + (size_t)l * 2048;
    const int kch = 16 * w + m;
    for (int u = blockIdx.x; u < 256; u += gridDim.x) {
        const int b = u >> 4, h = (u >> 1) & 7, dir = u & 1;
        const bf16_t* BQ = (const bf16_t*)(P + P_BQ); const bf16_t* BI = (const bf16_t*)(P + P_BI);
        bf16_t* BF = (bf16_t*)(P + (dir ? P_BFB : P_BFF));
        const float lbv = lbp[dir * 1024 + h * 128 + kch];
        f32x4 Sacc[8];
#pragma unroll
        for (int i = 0; i < 8; ++i) Sacc[i] = (f32x4){0.f, 0.f, 0.f, 0.f};
        for (int seg = 0; seg < 2; ++seg) {
            const int len = seg == 0 ? CTXL : SEQ, rbase = seg == 0 ? TL + b * CTXL : b * SEQ, nch = len / 16;
            u32x4 g0 = (u32x4){0u, 0u, 0u, 0u}, g1 = g0;
            const int gs = (tid_ & 255) >> 4, gc8 = (tid_ & 15) * 8;
#define HG_GLOAD(c) do { const int st = (c) * 16 + gs, n = dir ? (len - 1 - st) : st; const size_t o = (size_t)(rbase + n) * 1024 + h * 128 + gc8; \
                if (tid_ < 256) { g0 = *(const u32x4*)(BQ + o); g1 = *(const u32x4*)(BF + o); } else { g0 = *(const u32x4*)(BI + o); } } while (0)
#define HG_RAWW(c) do { LAS unsigned char* rw = lds + RAWOFF + ((c) & 1) * RAWSZ + gs * 272 + gc8 * 2; \
                if (tid_ < 256) { *(LAS u32x4*)(rw) = g0; *(LAS u32x4*)(rw + 4352) = g1; } else { *(LAS u32x4*)(rw + 8704) = g0; } } while (0)
#define HG_STAGE(c, bufp) do { float fv[4], cb[4]; float run = 0.f; unsigned short rq[4], rf[4], ri[4]; \
                { const LAS unsigned char* rr = lds + RAWOFF + ((c) & 1) * RAWSZ + kch * 2; _Pragma("unroll") for (int j = 0; j < 4; ++j) { rq[j] = *(const LAS bf16_t*)(rr + (4 * q + j) * 272); rf[j] = *(const LAS bf16_t*)(rr + 4352 + (4 * q + j) * 272); ri[j] = *(const LAS bf16_t*)(rr + 8704 + (4 * q + j) * 272); } } \
                _Pragma("unroll") for (int j = 0; j < 4; ++j) { const float xf = __uint_as_float(((unsigned)rf[j]) << 16); fv[j] = lbv + (1.0f - lbv) * fast_sigmoid(xf); run += flog(fv[j]); cb[j] = run; } \
                const float t0 = __shfl(run, m), t1 = __shfl(run, m + 16), t2 = __shfl(run, m + 32); \
                const float off = (q > 0 ? t0 : 0.f) + (q > 1 ? t1 : 0.f) + (q > 2 ? t2 : 0.f); \
                float qh[4], kh[4]; \
                _Pragma("unroll") for (int j = 0; j < 4; ++j) { const float bb = off + cb[j], bc = fmaxf(bb, -80.0f); qh[j] = __uint_as_float(((unsigned)rq[j]) << 16) * fexp(bc); kh[j] = (1.0f - fv[j]) * fexp(-bc);     \
                    if (j == 3 && q == 3) *(LAS float*)((bufp) + OE + kch * 4) = fexp(bb); } \
                const unsigned q01 = cvt_pk_bf16(qh[0], qh[1]), q23 = cvt_pk_bf16(qh[2], qh[3]), k01 = cvt_pk_bf16(kh[0], kh[1]), k23 = cvt_pk_bf16(kh[2], kh[3]); \
                *(LAS bf16_t*)((bufp) + OQ + (4 * q + 0) * 272 + kch * 2) = (bf16_t)(q01 & 0xffffu); *(LAS bf16_t*)((bufp) + OQ + (4 * q + 1) * 272 + kch * 2) = (bf16_t)(q01 >> 16); \
                *(LAS bf16_t*)((bufp) + OQ + (4 * q + 2) * 272 + kch * 2) = (bf16_t)(q23 & 0xffffu); *(LAS bf16_t*)((bufp) + OQ + (4 * q + 3) * 272 + kch * 2) = (bf16_t)(q23 >> 16); \
                *(LAS bf16_t*)((bufp) + OKH + (4 * q + 0) * 272 + kch * 2) = (bf16_t)(k01 & 0xffffu); *(LAS bf16_t*)((bufp) + OKH + (4 * q + 1) * 272 + kch * 2) = (bf16_t)(k01 >> 16); \
                *(LAS bf16_t*)((bufp) + OKH + (4 * q + 2) * 272 + kch * 2) = (bf16_t)(k23 & 0xffffu); *(LAS bf16_t*)((bufp) + OKH + (4 * q + 3) * 272 + kch * 2) = (bf16_t)(k23 >> 16); \
                u32x2 kt2; kt2.x = k01; kt2.y = k23; *(LAS u32x2*)((bufp) + OKT + kch * 48 + q * 8) = kt2; \
                u32x2 it2; it2.x = (unsigned)ri[0] | ((unsigned)ri[1] << 16); it2.y = (unsigned)ri[2] | ((unsigned)ri[3] << 16); *(LAS u32x2*)((bufp) + OIT + kch * 48 + q * 8) = it2; } while (0)
#define HG_COMPUTE(c) do { \
                LAS unsigned char* buf = lds + ((c) & 1) * BUFSZ; \
                f32x4 at = (f32x4){0.f, 0.f, 0.f, 0.f}; \
                _Pragma("unroll") \
                for (int kb = 0; kb < 4; ++kb) { const bf16x8 a = *(const LAS bf16x8*)(buf + OKH + m * 272 + kb * 64 + q * 16), bq = *(const LAS bf16x8*)(buf + OQ + m * 272 + kb * 64 + q * 16); \
                    at = __builtin_amdgcn_mfma_f32_16x16x32_bf16(a, bq, at, 0, 0, 0); } \
                asm volatile("s_nop 15\n s_nop 15" : "+v"(at)); \
                _Pragma("unroll") \
                for (int r = 0; r < 4; ++r) at[r] = (4 * q + r <= m) ? at[r] : 0.f; \
                const bf16x8 attB = mk_bf16x8(cvt_pk_bf16(at[0], at[1]), cvt_pk_bf16(at[2], at[3]), 0u, 0u); \
                f32x4 oacc = (f32x4){0.f, 0.f, 0.f, 0.f}; \
                _Pragma("unroll") \
                for (int kb = 0; kb < 4; ++kb) { \
                    const bf16x8 a = mk_bf16x8(cvt_pk_bf16(Sacc[2 * kb][0], Sacc[2 * kb][1]), cvt_pk_bf16(Sacc[2 * kb][2], Sacc[2 * kb][3]), cvt_pk_bf16(Sacc[2 * kb + 1][0], Sacc[2 * kb + 1][1]), cvt_pk_bf16(Sacc[2 * kb + 1][2], Sacc[2 * kb + 1][3])); \
                    const u32x2 b0 = *(const LAS u32x2*)(buf + OQ + m * 272 + (32 * kb + 4 * q) * 2), b1 = *(const LAS u32x2*)(buf + OQ + m * 272 + (32 * kb + 16 + 4 * q) * 2); \
                    oacc = __builtin_amdgcn_mfma_f32_16x16x32_bf16(a, mk_bf16x8(b0.x, b0.y, b1.x, b1.y), oacc, 0, 0, 0); } \
                { const u32x2 i0 = *(const LAS u32x2*)(buf + OIT + (16 * w + m) * 48 + q * 8); \
                  oacc = __builtin_amdgcn_mfma_f32_16x16x32_bf16(mk_bf16x8(i0.x, i0.y, 0u, 0u), attB, oacc, 0, 0, 0); } \
                asm volatile("s_nop 15\n s_nop 15" : "+v"(oacc)); \
                { const int st = (c) * 16 + m, n = dir ? (len - 1 - st) : st; \
                  u32x2 o2; o2.x = cvt_pk_bf16(oacc[0], oacc[1]); o2.y = cvt_pk_bf16(oacc[2], oacc[3]); \
                  if (!dry || p.ws == nullptr) *(u32x2*)(BF + (size_t)(rbase + n) * 1024 + h * 128 + 16 * w + 4 * q) = o2; } \
                u32x4 bsu = (u32x4){0u, 0u, 0u, 0u}; \
                if (q < 2) bsu = *(const LAS u32x4*)(buf + OIT + (16 * w + m) * 48 + q * 16); \
                const bf16x8 bs = __builtin_bit_cast(bf16x8, bsu); \
                _Pragma("unroll") \
                for (int kt = 0; kt < 8; ++kt) { u32x4 au = (u32x4){0u, 0u, 0u, 0u}; \
                    if (q < 2) au = *(const LAS u32x4*)(buf + OKT + (16 * kt + m) * 48 + q * 16); \
                    Sacc[kt] = __builtin_amdgcn_mfma_f32_16x16x32_bf16(__builtin_bit_cast(bf16x8, au), bs, Sacc[kt], 0, 0, 0); } \
                asm volatile("s_nop 15\n s_nop 15" : "+v"(Sacc[0]), "+v"(Sacc[1]), "+v"(Sacc[2]), "+v"(Sacc[3]), "+v"(Sacc[4]), "+v"(Sacc[5]), "+v"(Sacc[6]), "+v"(Sacc[7])); \
                _Pragma("unroll") \
                for (int kt = 0; kt < 8; ++kt) Sacc[kt] *= *(const LAS f32x4*)(buf + OE + (16 * kt + 4 * q) * 4); \
                } while (0)
            HG_GLOAD(0); HG_RAWW(0);
            if (nch > 1) { HG_GLOAD(1); HG_RAWW(1); }
            if (nch > 2) HG_GLOAD(2);
            __syncthreads();
            HG_STAGE(0, lds);
            __syncthreads();
            for (int c = 0; c < nch; ++c) {
                if (c + 2 < nch) { HG_RAWW(c + 2); if (c + 3 < nch) HG_GLOAD(c + 3); }
                if (c + 1 < nch) HG_STAGE(c + 1, lds + ((c + 1) & 1) * BUFSZ);
                HG_COMPUTE(c);
                __syncthreads();
            }
#undef HG_COMPUTE
#undef HG_GLOAD
#undef HG_RAWW
#undef HG_STAGE
        }
        __syncthreads();
    }
}
__device__ __forceinline__ void phase_hcomb(const Params& p, int l, int M, bool dry = false) {
    const int tid_ = otid();
    const int lane = tid_ & 63, gw = blockIdx.x * 8 + __builtin_amdgcn_readfirstlane(tid_ >> 6), nw = gridDim.x * 8;
    unsigned char* P = p.ws + OFF_P;
    bf16_t* OF = (bf16_t*)(P + P_BFF); const bf16_t* OB = (const bf16_t*)(P + P_BFB); const bf16_t* BG = (const bf16_t*)(P + P_BG);
    const float* hg = p.hn_g + (size_t)l * 1024 + lane * 16;
    for (int r = gw; r < M; r += nw) {
        const size_t o = (size_t)r * 1024 + lane * 16;
        float x[16]; float ss = 0.f;
#pragma unroll
        for (int hh = 0; hh < 2; ++hh) { const u32x4 a = *(const u32x4*)(OF + o + hh * 8), bq = *(const u32x4*)(OB + o + hh * 8);
            const unsigned aa[4] = {a.x, a.y, a.z, a.w}, bb[4] = {bq.x, bq.y, bq.z, bq.w};
#pragma unroll
            for (int j = 0; j < 4; ++j) { x[hh * 8 + 2 * j] = bf_lo(aa[j]) + bf_lo(bb[j]); x[hh * 8 + 2 * j + 1] = bf_hi(aa[j]) + bf_hi(bb[j]); } }
#pragma unroll
        for (int j = 0; j < 16; ++j) ss += x[j] * x[j];
        ss += __shfl_xor(ss, 1); ss += __shfl_xor(ss, 2); ss += __shfl_xor(ss, 4);
        const float rs = rsqrtf(ss * (1.0f / 128.0f) + 1e-6f);
#pragma unroll
        for (int hh = 0; hh < 2; ++hh) { const u32x4 gq = *(const u32x4*)(BG + o + hh * 8); const unsigned gg[4] = {gq.x, gq.y, gq.z, gq.w};
            float y[8];
#pragma unroll
            for (int j = 0; j < 4; ++j) { y[2 * j] = x[hh * 8 + 2 * j] * rs * hg[hh * 8 + 2 * j] * bf_lo(gg[j]); y[2 * j + 1] = x[hh * 8 + 2 * j + 1] * rs * hg[hh * 8 + 2 * j + 1] * bf_hi(gg[j]); }
            u32x4 w; w.x = cvt_pk_bf16(y[0], y[1]); w.y = cvt_pk_bf16(y[2], y[3]); w.z = cvt_pk_bf16(y[4], y[5]); w.w = cvt_pk_bf16(y[6], y[7]);
            if (!dry || p.ws == nullptr) *(u32x4*)(OF + o + hh * 8) = w; }
    }
}

__device__ __forceinline__ bf16x8 pack_bf16x8(const float (&v)[8]) {
    const unsigned a = cvt_pk_bf16(v[0], v[1]), b = cvt_pk_bf16(v[2], v[3]), c = cvt_pk_bf16(v[4], v[5]), d = cvt_pk_bf16(v[6], v[7]);
    u32x4 q; q.x = a; q.y = b; q.z = c; q.w = d;
    return __builtin_bit_cast(bf16x8, q);
}
__device__ __forceinline__ void phase_s5(const Params& p, int l, LAS unsigned char* lds) {
    const int tid_ = otid();
    const int lane = tid_ & 63, w = __builtin_amdgcn_readfirstlane(tid_ >> 6);
    if (w >= 6) return;
    LAS float* BU = (LAS float*)(lds + w * 12800);
    LAS unsigned char* XB = lds + w * 12800 + 8448;
    const int lq = lane >> 4, lr = lane & 15;
    const bf16_t* CU = (const bf16_t*)(p.ws + OFF_P + P_CU);
    const float* s5lam = (const float*)(p.ws + OFF_S5LAM); const float* s5bb = (const float*)(p.ws + OFF_S5BB);
    for (int s = w * (int)gridDim.x + (int)blockIdx.x; s < 1536; s += 6 * (int)gridDim.x) {
        const int dir = s & 1, g = (s >> 1) % 48, b = s / 96;
        const int ldg = (l * 2 + dir) * 48 + g;
        const float lre = s5lam[(size_t)(ldg * 64 + lane) * 2], lim = s5lam[(size_t)(ldg * 64 + lane) * 2 + 1];
        bf16x8 bbf[8], cf[4];
#pragma unroll
        for (int nt = 0; nt < 8; ++nt) { const int col = nt * 16 + lr, pp = col >> 1, c = col & 1; float v[8];
#pragma unroll
            for (int j = 0; j < 8; ++j) v[j] = (lq < 2) ? s5bb[(size_t)(ldg * 64 + pp) * 32 + c * 16 + lq * 8 + j] : 0.f;
            bbf[nt] = pack_bf16x8(v); }
#pragma unroll
        for (int kb = 0; kb < 4; ++kb) { float v[8];
#pragma unroll
            for (int j = 0; j < 8; ++j) { const int k = kb * 32 + lq * 8 + j, pp = k >> 1; const size_t ci = ((size_t)ldg * 16 + lr) * 64 + pp;
                v[j] = (k & 1) ? -p.c_im[ci] : p.c_re[ci]; }
            cf[kb] = pack_bf16x8(v); }
        bf16_t* YS = (bf16_t*)(p.ws + OFF_H + (dir ? H_YSB : H_YSF));
        float xr = 0.f, xi = 0.f;
        for (int seg = 0; seg < 2; ++seg) {
            const int len = seg == 0 ? CTXL : SEQ, rbase = seg == 0 ? TL + b * CTXL : b * SEQ, nblk = len / 64;
            u32x4 unext[4];
#pragma unroll
            for (int tt = 0; tt < 4; ++tt) { unext[tt] = (u32x4){0u, 0u, 0u, 0u};
                if (lq < 2) { const int st = tt * 16 + lr, n = dir ? (len - 1 - st) : st; unext[tt] = *(const u32x4*)(CU + (size_t)(rbase + n) * 768 + g * 16 + lq * 8); } }
            for (int blk = 0; blk < nblk; ++blk) {
                u32x4 ucur[4];
#pragma unroll
                for (int tt = 0; tt < 4; ++tt) ucur[tt] = unext[tt];
                if (blk + 1 < nblk && lq < 2) {
#pragma unroll
                    for (int tt = 0; tt < 4; ++tt) { const int st = (blk + 1) * 64 + tt * 16 + lr, n = dir ? (len - 1 - st) : st; unext[tt] = *(const u32x4*)(CU + (size_t)(rbase + n) * 768 + g * 16 + lq * 8); } }
#pragma unroll
                for (int tt = 0; tt < 4; ++tt) {
                    const bf16x8 uf = __builtin_bit_cast(bf16x8, ucur[tt]);
                    f32x4 dd[8];
#pragma unroll
                    for (int nt = 0; nt < 8; ++nt) dd[nt] = __builtin_amdgcn_mfma_f32_16x16x32_bf16(bbf[nt], uf, (f32x4){0.f, 0.f, 0.f, 0.f}, 0, 0, 0);
                    asm volatile("s_nop 15\n s_nop 15" : "+v"(dd[0]), "+v"(dd[1]), "+v"(dd[2]), "+v"(dd[3]), "+v"(dd[4]), "+v"(dd[5]), "+v"(dd[6]), "+v"(dd[7]));
#pragma unroll
                    for (int nt = 0; nt < 8; ++nt) *(LAS f32x4*)(BU + lr * 132 + nt * 16 + lq * 4) = dd[nt];
                    asm volatile("s_waitcnt lgkmcnt(0)" ::: "memory");
                    f32x2 bu[16];
#pragma unroll
                    for (int t = 0; t < 16; ++t) bu[t] = *(const LAS f32x2*)(BU + t * 132 + 2 * lane);
#pragma unroll
                    for (int t = 0; t < 16; ++t) { const float nr = lre * xr - lim * xi + bu[t].x, ni = lre * xi + lim * xr + bu[t].y; xr = nr; xi = ni;
                        *(LAS unsigned*)(XB + t * 272 + lane * 4) = cvt_pk_bf16(xr, xi); }
                    asm volatile("s_waitcnt lgkmcnt(0)" ::: "memory");
                    f32x4 acc = (f32x4){0.f, 0.f, 0.f, 0.f};
#pragma unroll
                    for (int kb = 0; kb < 4; ++kb) { const bf16x8 xf = *(const LAS bf16x8*)(XB + lr * 272 + kb * 64 + lq * 16); acc = __builtin_amdgcn_mfma_f32_16x16x32_bf16(cf[kb], xf, acc, 0, 0, 0); }
                    asm volatile("s_nop 15\n s_nop 15\n s_waitcnt lgkmcnt(0)" : "+v"(acc) :: "memory");
                    const int st = blk * 64 + tt * 16 + lr, n = dir ? (len - 1 - st) : st;
                    u32x2 o; o.x = cvt_pk_bf16(acc[0], acc[1]); o.y = cvt_pk_bf16(acc[2], acc[3]);
                    *(u32x2*)(YS + (size_t)(rbase + n) * 768 + g * 16 + lq * 4) = o;
                }
            }
        }
    }
}
__device__ __forceinline__ void phase_s5post(const Params& p, int l, int M, bool dry = false) {
    const int tid_ = otid();
    const size_t n8 = (size_t)M * 768 / 8;
    bf16_t* YF = (bf16_t*)(p.ws + OFF_H + H_YSF); const bf16_t* YB = (const bf16_t*)(p.ws + OFF_H + H_YSB); const bf16_t* CU = (const bf16_t*)(p.ws + OFF_P + P_CU);
    const float* dsk = p.s5_d + (size_t)l * 768;
    for (size_t i = (size_t)blockIdx.x * NTHREADS + tid_; i < n8; i += (size_t)gridDim.x * NTHREADS) {
        const int c = (int)((i * 8) % 768);
        const u32x4 a = *(const u32x4*)(YF + i * 8), bq = *(const u32x4*)(YB + i * 8), uq = *(const u32x4*)(CU + i * 8);
        const unsigned aa[4] = {a.x, a.y, a.z, a.w}, bb[4] = {bq.x, bq.y, bq.z, bq.w}, uu[4] = {uq.x, uq.y, uq.z, uq.w};
        float y[8];
#pragma unroll
        for (int j = 0; j < 4; ++j) { y[2 * j] = gelu_f(bf_lo(aa[j]) + bf_lo(bb[j]) + dsk[c + 2 * j] * bf_lo(uu[j])); y[2 * j + 1] = gelu_f(bf_hi(aa[j]) + bf_hi(bb[j]) + dsk[c + 2 * j + 1] * bf_hi(uu[j])); }
        u32x4 w; w.x = cvt_pk_bf16(y[0], y[1]); w.y = cvt_pk_bf16(y[2], y[3]); w.z = cvt_pk_bf16(y[4], y[5]); w.w = cvt_pk_bf16(y[6], y[7]);
        if (!dry || p.ws == nullptr) *(u32x4*)(YF + i * 8) = w;
    }
}

__device__ __forceinline__ void phase_gmlp(const Params& p, int l, int M, LAS unsigned char* lds, bool dry = false) {
    const int tid_ = otid();
    LAS unsigned char* Wb = lds;
    LAS unsigned char* Vt = lds + 34816;
    LAS float* st = (LAS float*)(lds + 69632);
    const int tid = tid_, lane = tid & 63, w = __builtin_amdgcn_readfirstlane(tid_ >> 6), q = lane >> 4, m = lane & 15;
    bf16_t* AU = (bf16_t*)(p.ws + OFF_P + P_AU); const bf16_t* AV = (const bf16_t*)(p.ws + OFF_P + P_AV);
    const float* lng = p.ln_g + (size_t)l * 1024; const float* lnb = p.ln_b + (size_t)l * 1024;
    const int nch = M / 128, G_ = (int)gridDim.x, nfull = (nch / G_) * G_, nitem = nfull + (nch - nfull) * 8;
    for (int it = blockIdx.x; it < nitem; it += G_) {
        const int u = it < nfull ? it : nfull + ((it - nfull) >> 3), g0 = it < nfull ? 0 : ((it - nfull) & 7), g1 = it < nfull ? 8 : g0 + 1;
        const size_t r0 = (size_t)u * 128;
        for (int i = 0; i < 16; ++i) {
            const int s = w * 16 + i; const bf16_t* rp = AV + (r0 + s) * 1024 + lane * 16;
            const u32x4 a = *(const u32x4*)rp, bq = *(const u32x4*)(rp + 8);
            const unsigned aa[8] = {a.x, a.y, a.z, a.w, bq.x, bq.y, bq.z, bq.w};
            float sm = 0.f, sq = 0.f;
#pragma unroll
            for (int j = 0; j < 8; ++j) { const float x0 = bf_lo(aa[j]), x1 = bf_hi(aa[j]); sm += x0 + x1; sq += x0 * x0 + x1 * x1; }
            sm = wave_sum(sm); sq = wave_sum(sq);
            const float mean = sm * (1.0f / 1024.0f), var = fmaxf(sq * (1.0f / 1024.0f) - mean * mean, 0.f);
            if (lane == 0) { st[s * 2] = mean; st[s * 2 + 1] = rsqrtf(var + 1e-6f); }
        }
        __syncthreads();
        for (int g = g0; g < g1; ++g) {
            { const int t = tid >> 2, s0 = (tid & 3) * 32; const float* ws = p.w_s + ((size_t)l * 8 + g) * 16384 + t * 128 + s0;
#pragma unroll
              for (int qq = 0; qq < 4; ++qq) { const f32x4 a = *(const f32x4*)(ws + qq * 8), b4 = *(const f32x4*)(ws + qq * 8 + 4);
                  u32x4 o; o.x = cvt_pk_bf16(a[0], a[1]); o.y = cvt_pk_bf16(a[2], a[3]); o.z = cvt_pk_bf16(b4[0], b4[1]); o.w = cvt_pk_bf16(b4[2], b4[3]);
                  *(LAS u32x4*)(Wb + t * 272 + (s0 + qq * 8) * 2) = o; } }
            { const int s = tid >> 2, c0 = (tid & 3) * 32; const bf16_t* rp = AV + (r0 + s) * 1024 + g * 128 + c0;
              const float mean = st[s * 2], rstd = st[s * 2 + 1];
#pragma unroll
              for (int qq = 0; qq < 4; ++qq) { const u32x4 a = *(const u32x4*)(rp + qq * 8); const unsigned aa[4] = {a.x, a.y, a.z, a.w};
#pragma unroll
                  for (int j = 0; j < 4; ++j) { const int cl = c0 + qq * 8 + 2 * j, c = g * 128 + cl;
                      const unsigned pk = cvt_pk_bf16((bf_lo(aa[j]) - mean) * rstd * lng[c] + lnb[c], (bf_hi(aa[j]) - mean) * rstd * lng[c + 1] + lnb[c + 1]);
                      *(LAS bf16_t*)(Vt + cl * 272 + s * 2) = (bf16_t)(pk & 0xffffu); *(LAS bf16_t*)(Vt + (cl + 1) * 272 + s * 2) = (bf16_t)(pk >> 16); } } }
            __syncthreads();
            bf16x8 af[4];
#pragma unroll
            for (int kb = 0; kb < 4; ++kb) af[kb] = *(const LAS bf16x8*)(Vt + (16 * w + m) * 272 + kb * 64 + q * 16);
            const float* bs = p.b_s + ((size_t)l * 8 + g) * 128;
#pragma unroll
            for (int tt = 0; tt < 8; ++tt) {
                f32x4 acc = (f32x4){0.f, 0.f, 0.f, 0.f};
#pragma unroll
                for (int kb = 0; kb < 4; ++kb) acc = __builtin_amdgcn_mfma_f32_16x16x32_bf16(af[kb], *(const LAS bf16x8*)(Wb + (16 * tt + m) * 272 + kb * 64 + q * 16), acc, 0, 0, 0);
                const float bb = bs[16 * tt + m];
                bf16_t* up = AU + (r0 + 16 * tt + m) * 1024 + g * 128 + 16 * w + 4 * q;
                const u32x2 uw = *(const u32x2*)up;
                const float y0 = (acc[0] + bb) * bf_lo(uw.x), y1 = (acc[1] + bb) * bf_hi(uw.x), y2 = (acc[2] + bb) * bf_lo(uw.y), y3 = (acc[3] + bb) * bf_hi(uw.y);
                u32x2 o; o.x = cvt_pk_bf16(y0, y1); o.y = cvt_pk_bf16(y2, y3);
                if (!dry || p.ws == nullptr) *(u32x2*)up = o;
            }
            __syncthreads();
        }
    }
}

__device__ __forceinline__ unsigned fkey(float x) { const unsigned b = __float_as_uint(x); return b ^ ((b >> 31) ? 0xFFFFFFFFu : 0x80000000u); }
__device__ __forceinline__ int mbcnt64(unsigned long long m) { return __builtin_amdgcn_mbcnt_hi((unsigned)(m >> 32), __builtin_amdgcn_mbcnt_lo((unsigned)m, 0u)); }
template <int NV>
__device__ __forceinline__ int count_ge(const unsigned (&k)[NV], unsigned cand) {
    int cnt = 0;
#pragma unroll
    for (int i = 0; i < NV; ++i) cnt += __popcll(__ballot(k[i] >= cand));
    return cnt;
}
template <int NV>
__device__ __forceinline__ unsigned radix_thr16(const unsigned (&k)[NV], unsigned e0bits) {
    unsigned prefix = 0u; int bit = 31;
    {
        const unsigned c0 = e0bits ^ 0x80000000u, c1 = c0 + 0x00800000u, c2 = c0 + 0x01000000u, c3 = c0 + 0x01800000u;
        const int n0 = count_ge<NV>(k, c0), n1 = count_ge<NV>(k, c1), n2 = count_ge<NV>(k, c2), n3 = count_ge<NV>(k, c3);
        if (n0 >= 16 && n3 < 16) { prefix = (n2 >= 16) ? c2 : ((n1 >= 16) ? c1 : c0); bit = 22;
            const int nn = (n2 >= 16) ? n2 : ((n1 >= 16) ? n1 : n0); if (nn == 16) bit = -1; }
    }
    for (; bit >= 0; --bit) {
        const unsigned cand = prefix | (1u << bit);
        const int cnt = count_ge<NV>(k, cand);
        if (cnt >= 16) prefix = cand;
        if (cnt == 16) break;
    }
    return prefix;
}
__device__ __forceinline__ unsigned umin_(unsigned a, unsigned b) { return a < b ? a : b; }
__device__ __forceinline__ unsigned umax_(unsigned a, unsigned b) { return a > b ? a : b; }
__device__ __forceinline__ unsigned med3u(unsigned x, unsigned y, unsigned z) { return umax_(umin_(x, y), umin_(umax_(x, y), z)); }
__device__ __forceinline__ float unkey(unsigned k) { return __uint_as_float((k & 0x80000000u) ? (k ^ 0x80000000u) : ~k); }
__device__ __forceinline__ void ins16(unsigned (&a)[16], unsigned x) {
#pragma unroll
    for (int s = 15; s >= 1; --s) a[s] = med3u(a[s - 1], x, a[s]);
    a[0] = umax_(a[0], x);
}
__device__ __forceinline__ unsigned sel16(const unsigned (&a)[16], int i) {
    unsigned r = a[0];
#pragma unroll
    for (int t = 1; t < 16; ++t) r = (i == t) ? a[t] : r;
    return r;
}
__device__ __forceinline__ void phase_topk(const Params& p, int M, LAS unsigned char* lds) {
    const int tid_ = otid();
    LAS unsigned* lk = (LAS unsigned*)lds + tid_;
    const int gl = blockIdx.x * NTHREADS + tid_, nl = gridDim.x * NTHREADS;
    const float* SC = (const float*)(p.ws + OFF_P + Q_SC);
    int* IDX = (int*)(p.ws + OFF_P + Q_IDX); float* GATE = (float*)(p.ws + OFF_P + Q_GATE);
    const int ntask = M * 8;
    for (int task = gl; task < ntask; task += nl) {
        const float* sc = SC + (size_t)task * 256;
        unsigned a[16], b[16];
#pragma unroll
        for (int i = 0; i < 16; ++i) { a[i] = 0u; b[i] = 0u; }
#pragma unroll 4
        for (int i4 = 0; i4 < 32; ++i4) {
            const f32x4 va = *(const f32x4*)(sc + i4 * 4), vb = *(const f32x4*)(sc + 128 + i4 * 4);
#pragma unroll
            for (int e = 0; e < 4; ++e) { const unsigned tag = 127u - (unsigned)(i4 * 4 + e);
                ins16(a, (fkey(va[e]) & ~127u) | tag); ins16(b, (fkey(vb[e]) & ~127u) | tag); }
        }
        float fa[16], fb[16];
#pragma unroll
        for (int i = 0; i < 16; ++i) { fa[i] = unkey(a[i] & ~127u); fb[i] = unkey(b[i] & ~127u); }
        unsigned c[16];
#pragma unroll
        for (int i = 0; i < 16; ++i) c[i] = 0u;
#pragma unroll
        for (int i = 0; i < 16; ++i)
#pragma unroll
            for (int j = 0; j < 16; ++j)
                if ((i + 1) * (j + 1) <= 16) ins16(c, (fkey(fa[i] + fb[j]) & ~255u) | (unsigned)(i * 16 + j));
#pragma unroll
        for (int i = 0; i < 16; ++i) { lk[i * 512] = a[i]; lk[(16 + i) * 512] = b[i]; }
        const float mx = unkey(c[0] & ~255u);
        float ev[16]; float sm = 0.f; int id[16];
#pragma unroll
        for (int s = 0; s < 16; ++s) { ev[s] = __expf(unkey(c[s] & ~255u) - mx); sm += ev[s];
            const int ij = (int)(c[s] & 255u);
            const unsigned ka = lk[(ij >> 4) * 512], kb = lk[(16 + (ij & 15)) * 512];
            id[s] = (int)(127u - (ka & 127u)) * 128 + (int)(127u - (kb & 127u)); }
        const float inv = 1.0f / sm;
#pragma unroll
        for (int q = 0; q < 4; ++q) {
            u32x4 iw; iw.x = (unsigned)id[4 * q]; iw.y = (unsigned)id[4 * q + 1]; iw.z = (unsigned)id[4 * q + 2]; iw.w = (unsigned)id[4 * q + 3];
            *(u32x4*)(IDX + (size_t)task * 16 + q * 4) = iw;
            *(f32x4*)(GATE + (size_t)task * 16 + q * 4) = (f32x4){ev[4 * q] * inv, ev[4 * q + 1] * inv, ev[4 * q + 2] * inv, ev[4 * q + 3] * inv};
        }
    }
}

__device__ __forceinline__ float dot2u(unsigned a, unsigned b, float acc) {
    return __builtin_amdgcn_fdot2_f32_bf16(__builtin_bit_cast(bf16x2_t, a), __builtin_bit_cast(bf16x2_t, b), acc, false);
}
__device__ __forceinline__ float dot8(const u32x4 a, const u32x4 b, float acc) {
    acc = dot2u(a.x, b.x, acc); acc = dot2u(a.y, b.y, acc); acc = dot2u(a.z, b.z, acc); acc = dot2u(a.w, b.w, acc);
    return acc;
}
__device__ __forceinline__ void phase_peer(const Params& p, int l, int M, LAS unsigned char* lds, bool dry = false) {
    const int tid_ = otid();
    const int lane = tid_ & 63, wv_ = __builtin_amdgcn_readfirstlane(tid_ >> 6), gw = blockIdx.x * 8 + wv_, nw = gridDim.x * 8;
    LAS float* wl = (LAS float*)(lds + wv_ * 512);
    const bf16_t* H = (const bf16_t*)(p.ws + OFF_H);
    const unsigned char* U6 = p.ws + OFF_P + Q_UT; const unsigned char* V6 = p.ws + OFF_P + Q_VT;
    const float* USC = (const float*)(p.ws + OFF_P + Q_USC); const float* VSC = (const float*)(p.ws + OFF_P + Q_VSC);
    const int* IDX = (const int*)(p.ws + OFF_P + Q_IDX); const float* GATE = (const float*)(p.ws + OFF_P + Q_GATE);
    const float* modl = (const float*)(p.ws + OFF_MODV) + (size_t)l * 17 * NMOD + 10240;
    float* XC = (float*)(p.ws + OFF_XC);
    const unsigned lane24 = (unsigned)lane * 24u, lane16 = (unsigned)lane * 16u;
#define PEER_LOAD(buf, TAB, g) do { const int _is = ((g) < 8) ? id0 : id1; _Pragma("unroll") for (int e = 0; e < 8; ++e) { \
        const int _id = __builtin_amdgcn_readlane(_is, (((g) * 8 + e) & 63)); const unsigned char* _rb = (TAB) + (size_t)(unsigned)_id * 1536u; \
        const u32x4 _a = *(const u32x4*)(_rb + lane24); const u32x2 _b = *(const u32x2*)(_rb + lane24 + 16); \
        buf[e][0] = _a.x; buf[e][1] = _a.y; buf[e][2] = _a.z; buf[e][3] = _a.w; buf[e][4] = _b.x; buf[e][5] = _b.y; } } while (0)
    for (int row = gw; row < M; row += nw) {
        unsigned xw[16];
#pragma unroll
        for (int j = 0; j < 8; ++j) { const u32x2 a = *(const u32x2*)(H + (size_t)row * D + j * 256 + lane * 4); xw[2 * j] = a.x; xw[2 * j + 1] = a.y; }
        const int id0 = IDX[(size_t)row * 128 + lane], id1 = IDX[(size_t)row * 128 + 64 + lane];
        const float g0 = GATE[(size_t)row * 128 + lane], g1 = GATE[(size_t)row * 128 + 64 + lane];
        const float us0 = USC[id0], us1 = USC[id1];
        const float gv0 = g0 * VSC[id0], gv1 = g1 * VSC[id1];
#pragma unroll 1
        for (int g = 0; g < 16; ++g) {
            u32x4 bU[8];
            { const int _is = (g < 8) ? id0 : id1;
#pragma unroll
              for (int e = 0; e < 8; ++e) { const int _id = __builtin_amdgcn_readlane(_is, ((g * 8 + e) & 63)); bU[e] = *(const u32x4*)(U6 + (size_t)(unsigned)_id * 1024u + lane16); } }
            float part[8];
            float chain = 0.f;
#pragma unroll
            for (int e = 0; e < 8; ++e) { asm volatile("" : "+v"(bU[e]), "+v"(chain));
                const unsigned wd[4] = {bU[e].x, bU[e].y, bU[e].z, bU[e].w};
                float a0 = 0.f, a1 = 0.f;
#pragma unroll
                for (int d = 0; d < 4; ++d) {
                    a0 = dot2u(__builtin_bit_cast(unsigned, __builtin_amdgcn_cvt_scalef32_pk_bf16_fp4(wd[d], 1.0f, 0)), xw[4 * d + 0], a0);
                    a1 = dot2u(__builtin_bit_cast(unsigned, __builtin_amdgcn_cvt_scalef32_pk_bf16_fp4(wd[d], 1.0f, 1)), xw[4 * d + 1], a1);
                    a0 = dot2u(__builtin_bit_cast(unsigned, __builtin_amdgcn_cvt_scalef32_pk_bf16_fp4(wd[d], 1.0f, 2)), xw[4 * d + 2], a0);
                    a1 = dot2u(__builtin_bit_cast(unsigned, __builtin_amdgcn_cvt_scalef32_pk_bf16_fp4(wd[d], 1.0f, 3)), xw[4 * d + 3], a1); }
                part[e] = a0 + a1; chain = part[e]; }
            float r4[4];
#pragma unroll
            for (int i = 0; i < 4; ++i) { const bool hi = (lane & 32) != 0; const float keep = hi ? part[i + 4] : part[i], send = hi ? part[i] : part[i + 4]; r4[i] = keep + __shfl_xor(send, 32); }
            float r2[2];
#pragma unroll
            for (int i = 0; i < 2; ++i) { const bool hi = (lane & 16) != 0; const float keep = hi ? r4[i + 2] : r4[i], send = hi ? r4[i] : r4[i + 2]; r2[i] = keep + __shfl_xor(send, 16); }
            float r1;
            { const bool hi = (lane & 8) != 0; const float keep = hi ? r2[1] : r2[0], send = hi ? r2[0] : r2[1]; r1 = keep + __shfl_xor(send, 8); }
            r1 += __shfl_xor(r1, 4); r1 += __shfl_xor(r1, 2); r1 += __shfl_xor(r1, 1);
            const int k = g * 8 + ((lane >> 3) & 7);
            const float usk = __shfl((g < 8) ? us0 : us1, k & 63), gvk = __shfl((g < 8) ? gv0 : gv1, k & 63);
            if ((lane & 7) == 0) wl[k] = gelu_f(r1 * usk) * gvk;
        }
        asm volatile("s_waitcnt lgkmcnt(0)" ::: "memory");
        h16x2 oh[16];
#pragma unroll
        for (int i = 0; i < 16; ++i) oh[i] = (h16x2){(_Float16)0.f, (_Float16)0.f};
#pragma unroll 1
        for (int g = 0; g < 16; ++g) {
            u32x4 bV[8];
            { const int _is = (g < 8) ? id0 : id1;
#pragma unroll
              for (int e = 0; e < 8; ++e) { const int _id = __builtin_amdgcn_readlane(_is, ((g * 8 + e) & 63)); bV[e] = *(const u32x4*)(V6 + (size_t)(unsigned)_id * 1024u + lane16); } }
#pragma unroll
            for (int e = 0; e < 8; ++e) { const float wkf = wl[g * 8 + e]; asm volatile("" : "+v"(bV[e]), "+v"(oh[0]), "+v"(oh[5]), "+v"(oh[10]), "+v"(oh[15]));
                const _Float16 wk1 = (_Float16)wkf; const h16x2 wk = (h16x2){wk1, wk1};
                const unsigned wd[4] = {bV[e].x, bV[e].y, bV[e].z, bV[e].w};
#pragma unroll
                for (int d = 0; d < 4; ++d) {
                    oh[4 * d + 0] = __builtin_elementwise_fma(__builtin_bit_cast(h16x2, __builtin_amdgcn_cvt_scalef32_pk_f16_fp4(wd[d], 1.0f, 0)), wk, oh[4 * d + 0]);
                    oh[4 * d + 1] = __builtin_elementwise_fma(__builtin_bit_cast(h16x2, __builtin_amdgcn_cvt_scalef32_pk_f16_fp4(wd[d], 1.0f, 1)), wk, oh[4 * d + 1]);
                    oh[4 * d + 2] = __builtin_elementwise_fma(__builtin_bit_cast(h16x2, __builtin_amdgcn_cvt_scalef32_pk_f16_fp4(wd[d], 1.0f, 2)), wk, oh[4 * d + 2]);
                    oh[4 * d + 3] = __builtin_elementwise_fma(__builtin_bit_cast(h16x2, __builtin_amdgcn_cvt_scalef32_pk_f16_fp4(wd[d], 1.0f, 3)), wk, oh[4 * d + 3]); } }
        }
        float out[32];
#pragma unroll
        for (int i = 0; i < 16; ++i) { out[2 * i] = (float)oh[i].x; out[2 * i + 1] = (float)oh[i].y; }
        asm volatile("s_waitcnt lgkmcnt(0)" ::: "memory");
        const bool lat = row < TL; const int mb = lat ? (row >> 11) : 16;
        float* xp = lat ? p.out + (size_t)row * D : XC + (size_t)(row - TL) * D;
        const float* gv = modl + (size_t)mb * NMOD;
        f32x4 xn[8]; float ss = 0.f;
#pragma unroll
        for (int j = 0; j < 8; ++j) { const int e = j * 256 + lane * 4;
            const f32x4 o4 = (f32x4){out[4 * j], out[4 * j + 1], out[4 * j + 2], out[4 * j + 3]};
            xn[j] = *(const f32x4*)(xp + e) + *(const f32x4*)(gv + e) * o4;
            ss += xn[j][0] * xn[j][0] + xn[j][1] * xn[j][1] + xn[j][2] * xn[j][2] + xn[j][3] * xn[j][3]; }
        ss = wave_sum(ss);
        const float rs = rsqrtf(ss * (1.0f / 2048.0f) + 1e-6f);
        if (!dry || p.ws == nullptr) {
            if (l == 0) {
                const float* m1 = (const float*)(p.ws + OFF_MODV) + (size_t)17 * NMOD + (size_t)mb * NMOD;
                float am = 0.f;
#pragma unroll
                for (int j = 0; j < 8; ++j) { const int e = j * 256 + lane * 4;
                    *(f32x4*)(xp + e) = xn[j];
                    xn[j] = xn[j] * rs * (*(const f32x4*)(m1 + 2048 + e) + 1.0f) + *(const f32x4*)(m1 + e);
                    am = fmaxf(am, fmaxf(fmaxf(fabsf(xn[j][0]), fabsf(xn[j][1])), fmaxf(fabsf(xn[j][2]), fabsf(xn[j][3])))); }
#pragma unroll
                for (int o = 32; o >= 1; o >>= 1) am = fmaxf(am, __shfl_xor(am, o));
                const float qs = am > 0.f ? 240.0f / am : 1.0f;
                unsigned char* H8 = p.ws + OFF_H8 + (size_t)row * D;
#pragma unroll
                for (int j = 0; j < 8; ++j) *(unsigned*)(H8 + j * 256 + lane * 4) = pack_fp8x4(xn[j][0] * qs, xn[j][1] * qs, xn[j][2] * qs, xn[j][3] * qs);
                if (lane == 0) ((float*)(p.ws + OFF_HS))[row] = am > 0.f ? am * (1.0f / 240.0f) : 1.0f;
            } else {
#pragma unroll
                for (int j = 0; j < 8; ++j) { const int e = j * 256 + lane * 4; *(f32x4*)(xp + e) = xn[j] * rs * *(const f32x4*)(p.final_g + e); }
            }
        }
    }
#undef PEER_LOAD
}

__device__ __forceinline__ Params load_params() {
    Params r;
#if defined(__HIP_DEVICE_COMPILE__)
    typedef const unsigned long long __attribute__((address_space(4)))* KP;
    KP k = (KP)__builtin_amdgcn_kernarg_segment_ptr();
    asm volatile("" : "+s"(k));
    void** d = (void**)&r;
#pragma unroll
    for (int i = 0; i < (int)(sizeof(Params) / 8); ++i) d[i] = (void*)(__attribute__((address_space(1))) void*)k[i];
#endif
    return r;
}
#define WSP(off) (p.ws + (off))
template <int l>
__device__ __forceinline__ void mega_layer(LAS unsigned char* lds, const XcdBarrier& bar) {
        const int Mrows = (l == 0) ? TT : TL;
        const int GLU_ROT = (((Mrows / 256) * 6) % (int)gridDim.x) & ~7;
        if (l == 0) {
            { const Params p = load_params(); phase_wconv(p, 0, lds); }
            { const Params p = load_params(); phase_norm<0, true>(p, 0, TT, 0, 2048); }
            xcd_barrier(bar);
        }
        { const Params p = load_params(); EpiInProj E{WSP(OFF_P), (const float*)WSP(OFF_HS), (const unsigned*)WSP(OFF_CMAX) + (size_t)l * INC};
          run_gemm(lds, (const bf16_t*)WSP(OFF_H8), (const bf16_t*)WSP(OFF_W + W_IN), TT, INC, D / 2, E); }
        xcd_barrier(bar);
        { const Params p = load_params(); phase_hgrn(p, l, lds); }
        __syncthreads();
        { const Params p = load_params(); phase_s5(p, l, lds); }
        xcd_barrier(bar);
        { const Params p = load_params(); phase_gmlp(p, l, Mrows, lds); }
        { const Params p = load_params(); phase_hcomb(p, l, Mrows); }
        { const Params p = load_params(); phase_s5post(p, l, Mrows); }
        xcd_barrier(bar);
        { const Params p = load_params(); EpiGlu E{(bf16_t*)WSP(OFF_P + P_CU)}; run_gemm(lds, (const bf16_t*)WSP(OFF_H + H_YSF), (const bf16_t*)WSP(OFF_W + W_GLU), Mrows, 1536, 768, E); }
        { const Params p = load_params(); EpiMerge<true> E{(bf16_t*)WSP(OFF_P + P_MERGED), (const bf16_t*)WSP(OFF_P + P_GATES)}; run_gemm(lds, (const bf16_t*)WSP(OFF_P + P_AU), (const bf16_t*)WSP(OFF_W + W_A), Mrows, D, 1024, E, GLU_ROT); }
        { const Params p = load_params(); EpiMerge<false> E{(bf16_t*)WSP(OFF_P + P_MERGED), (const bf16_t*)WSP(OFF_P + P_GATES) + 2048}; run_gemm(lds, (const bf16_t*)WSP(OFF_P + P_BFF), (const bf16_t*)WSP(OFF_W + W_B), Mrows, D, 1024, E, GLU_ROT); }
        xcd_barrier(bar);
        { const Params p = load_params(); EpiMerge<false> E{(bf16_t*)WSP(OFF_P + P_MERGED), (const bf16_t*)WSP(OFF_P + P_GATES) + 4096}; run_gemm(lds, (const bf16_t*)WSP(OFF_P + P_CU), (const bf16_t*)WSP(OFF_W + W_C), Mrows, D, 768, E); }
        xcd_barrier(bar);
        { const Params p = load_params(); EpiResid E{p.out, (float*)WSP(OFF_XC), (const float*)WSP(OFF_MODV) + (size_t)l * 17 * NMOD + 4096}; run_gemm(lds, (const bf16_t*)WSP(OFF_P + P_MERGED), (const bf16_t*)WSP(OFF_W + W_O), Mrows, D, D, E); }
        { const Params p = load_params(); phase_tabconv(p, l); }
        xcd_barrier(bar);
        { const Params p = load_params(); phase_norm<1>(p, l, Mrows, 6144, 8192); }
        xcd_barrier(bar);
        { const Params p = load_params(); EpiF32 E{(float*)WSP(OFF_P + Q_SC), 2048}; run_gemm(lds, (const bf16_t*)WSP(OFF_H), (const bf16_t*)WSP(OFF_W + W_S), Mrows, D, D, E); }
        xcd_barrier(bar);
        { const Params p = load_params(); phase_topk(p, Mrows, lds); }
        xcd_barrier(bar);
        { const Params p = load_params(); phase_peer(p, l, Mrows, lds); }
        if (l == 0) {
            __syncthreads();
            { const Params p = load_params(); phase_wconv(p, 1, lds); }
            xcd_barrier(bar);
        }
}
#undef WSP
__global__ void __launch_bounds__(NTHREADS, 2) k_mega(Params p_kernarg_only) {
    extern __shared__ __attribute__((aligned(16))) unsigned char smem[];
    LAS unsigned char* lds = (LAS unsigned char*)smem;
    volatile LAS unsigned* xbw = (volatile LAS unsigned*)(lds + LDS_BYTES - 16);
    if (threadIdx.x == 0) { xbw[0] = 0u; xbw[1] = 0u; xbw[2] = 0u; xbw[3] = 0u; }
    __syncthreads();
    XcdBarrier bar;
    { const Params p = load_params(); bar = xcd_barrier_post((unsigned*)(p.ws + OFF_BAR), xbw); }
#define WSP(off) (p.ws + (off))
    { const Params p = load_params(); phase_colmax(p); }
    { const Params p = load_params(); phase_prep(p); phase_mod(p, lds); }
    xcd_barrier(bar);
    mega_layer<0>(lds, bar);
    mega_layer<1>(lds, bar);
#undef WSP
}

extern "C" void kernel_launch(void* const* d_in, const int* in_sizes, int n_in, void* d_out, int out_size, void* d_ws, size_t ws_size, hipStream_t stream) {
    (void)in_sizes; (void)n_in; (void)out_size; (void)ws_size;
    Params p;
    const float** f = (const float**)&p;
    for (int i = 0; i < 31; ++i) f[i] = (const float*)d_in[i];
    p.out = (float*)d_out; p.ws = (unsigned char*)d_ws;
    static int grid = 0;
    if (!grid) {
        int dev = 0, cus = 0, per_cu = 0;
        (void)hipGetDevice(&dev);
        (void)hipDeviceGetAttribute(&cus, hipDeviceAttributeMultiprocessorCount, dev);
        (void)hipFuncSetAttribute((const void*)k_mega, hipFuncAttributeMaxDynamicSharedMemorySize, LDS_BYTES);
        (void)hipOccupancyMaxActiveBlocksPerMultiprocessor(&per_cu, (const void*)k_mega, NTHREADS, LDS_BYTES);
        grid = (per_cu >= 1 && cus > 0) ? (cus < 256 ? cus : 256) : 256;
    }
    (void)hipMemsetAsync(p.ws + OFF_BAR, 0, OFF_MODV, stream);
    hipLaunchKernelGGL(k_mega, dim3(grid), dim3(NTHREADS), LDS_BYTES, stream, p);
}
```

```cpp
#include <hip/hip_runtime.h>
#include <stdint.h>

#define LAS __attribute__((address_space(3)))
typedef unsigned short bf16_t;
typedef short bf16x8 __attribute__((ext_vector_type(8)));
typedef float f32x4 __attribute__((ext_vector_type(4)));
typedef float f32x2 __attribute__((ext_vector_type(2)));
typedef _Float16 h16x2 __attribute__((ext_vector_type(2)));
typedef unsigned u32x4 __attribute__((ext_vector_type(4)));
typedef unsigned u32x2 __attribute__((ext_vector_type(2)));
typedef __bf16 bf16x2_t __attribute__((ext_vector_type(2)));
typedef __bf16 bf16x32_t __attribute__((ext_vector_type(32)));
typedef float f32x32 __attribute__((ext_vector_type(32)));
typedef unsigned u32x6 __attribute__((ext_vector_type(6)));
typedef unsigned u32x16 __attribute__((ext_vector_type(16)));

constexpr int D = 2048, NB = 16, SEQ = 2048, CTXL = 256;
constexpr int TL = NB * SEQ;
constexpr int TC = NB * CTXL;
constexpr int TT = TL + TC;
constexpr int INC = 14080;
constexpr int NMOD = 12288;
constexpr int NTHREADS = 512;
constexpr int LDS_BYTES = 160 * 1024;

constexpr size_t OFF_BAR = 0;
constexpr size_t OFF_CMAX = 16384;
constexpr size_t OFF_MODV = OFF_CMAX + (size_t)2 * INC * 4;
constexpr size_t OFF_LB = OFF_MODV + (size_t)2 * 17 * NMOD * 4;
constexpr size_t OFF_S5LAM = OFF_LB + 2 * 2 * 1024 * 4;
constexpr size_t OFF_S5BB = OFF_S5LAM + (size_t)2 * 2 * 48 * 64 * 2 * 4;
constexpr size_t OFF_PE = OFF_S5BB + (size_t)2 * 2 * 48 * 64 * 32 * 4;
constexpr size_t OFF_HS = (OFF_PE + (size_t)96 * 1024 * 4 + 255) & ~(size_t)255;
constexpr size_t OFF_XC = (OFF_HS + (size_t)TT * 4 + 255) & ~(size_t)255;
constexpr size_t OFF_H = OFF_XC + (size_t)TC * D * 4;
constexpr size_t OFF_W = OFF_H + (size_t)TT * D * 2;
constexpr size_t W_IN = 0;
constexpr size_t W_GLU = W_IN + (size_t)INC * D;
constexpr size_t W_A = W_GLU + (size_t)1536 * 768 * 2;
constexpr size_t W_B = W_A + (size_t)2048 * 1024 * 2;
constexpr size_t W_C = W_B + (size_t)2048 * 1024 * 2;
constexpr size_t W_O = W_C + (size_t)2048 * 768 * 2;
constexpr size_t W_S = W_O + (size_t)2048 * 2048 * 2;
constexpr size_t W_TOTAL = W_S + (size_t)2048 * 2048 * 2;
constexpr size_t OFF_P = OFF_W + W_TOTAL;
constexpr size_t SEG = (size_t)TT * 1024 * 2;
constexpr size_t P_AU = 0, P_AV = SEG, P_BQ = 2 * SEG, P_BFF = 3 * SEG, P_BFB = 4 * SEG, P_BI = 5 * SEG, P_BG = 6 * SEG;
constexpr size_t P_CU = 7 * SEG;
constexpr size_t P_GATES = P_CU + (size_t)TT * 768 * 2;
constexpr size_t P_TOTAL = P_GATES + (size_t)TT * 6144 * 2;
constexpr size_t P_MERGED = SEG;
constexpr size_t Q_UT = 0;
constexpr size_t Q_VT = Q_UT + (size_t)16384 * 1536;
constexpr size_t Q_USC = Q_VT + (size_t)16384 * 1536;
constexpr size_t Q_VSC = Q_USC + (size_t)16384 * 4;
constexpr size_t Q_SC = Q_VSC + (size_t)16384 * 4;
constexpr size_t Q_IDX = Q_SC + (size_t)TT * 2048 * 4;
constexpr size_t Q_GATE = Q_IDX + (size_t)TT * 128 * 4;
constexpr size_t H_YSF = 0;
constexpr size_t H_YSB = (size_t)TT * 768 * 2;
constexpr size_t OFF_H8 = OFF_P + P_TOTAL;
constexpr size_t WS_NEEDED = OFF_H8 + (size_t)TT * D;

struct Params {
    const float *x, *c, *ctx, *c_ctx, *w_mod, *b_mod, *w_in, *ln_g, *ln_b, *w_s, *b_s, *lb_logits, *hn_g;
    const float *lam_re, *lam_im, *log_step, *b_re, *b_im, *c_re, *c_im, *s5_d, *w_glu, *wa, *wb, *wc, *wo, *w_q, *sub_keys, *peer_u, *peer_v, *final_g;
    float* out;
    unsigned char* ws;
};

__device__ __forceinline__ float bf_lo(unsigned u) { return __uint_as_float(u << 16); }
__device__ __forceinline__ float bf_hi(unsigned u) { return __uint_as_float(u & 0xffff0000u); }
__device__ __forceinline__ unsigned cvt_pk_bf16(float lo, float hi) { f32x2 v; v.x = lo; v.y = hi; const bf16x2_t b = __builtin_convertvector(v, bf16x2_t); return __builtin_bit_cast(unsigned, b); }
__device__ __forceinline__ float fexp(float x) { return __builtin_amdgcn_exp2f(x * 1.44269504f); }
__device__ __forceinline__ float flog(float x) { return __builtin_amdgcn_logf(x) * 0.693147181f; }
__device__ __forceinline__ float fast_sigmoid(float x) { return __builtin_amdgcn_rcpf(1.0f + fexp(-x)); }
__device__ __forceinline__ float fast_silu(float x) { return x * fast_sigmoid(x); }
__device__ __forceinline__ float gelu_f(float v) {
    const float av = fabsf(v), t = __builtin_amdgcn_rcpf(av * 0.2316418882f + 1.0f);
    float q = t * 0.5307027145f + (-0.7265760135f); q = q * t + 0.7107068705f; q = q * t + (-0.142248368f); q = q * t + 0.127414796f; q = q * t;
    const float e = __builtin_amdgcn_exp2f((v * v) * (-0.72134752044f));
    const float m = v * (q * e);
    return v < 0.f ? m : v - m;
}
__device__ __forceinline__ unsigned pack_fp8x4(float a, float b, float c, float d) {
    int pk = 0; pk = __builtin_amdgcn_cvt_pk_fp8_f32(a, b, pk, false); pk = __builtin_amdgcn_cvt_pk_fp8_f32(c, d, pk, true); return (unsigned)pk;
}
template <int CTRL> __device__ __forceinline__ float dpp_f(float v) { return __int_as_float(__builtin_amdgcn_update_dpp(0, __float_as_int(v), CTRL, 0xF, 0xF, false)); }
__device__ __forceinline__ float row16_max(float v) { v = fmaxf(v, dpp_f<0x128>(v)); v = fmaxf(v, dpp_f<0x124>(v)); v = fmaxf(v, dpp_f<0x122>(v)); v = fmaxf(v, dpp_f<0x121>(v)); return v; }
__device__ __forceinline__ float row16_sum(float v) { v += dpp_f<0x128>(v); v += dpp_f<0x124>(v); v += dpp_f<0x122>(v); v += dpp_f<0x121>(v); return v; }
__device__ __forceinline__ float wave_sum(float v) {
#pragma unroll
    for (int o = 32; o >= 1; o >>= 1) v += __shfl_xor(v, o);
    return v;
}
__device__ __forceinline__ int otid() { int t; asm volatile("v_mov_b32 %0, %1" : "=v"(t) : "v"((int)threadIdx.x)); return t; }


#define XB_TMO      128
#define XB_XCNT(j)  (256  + 64 * (j))
#define XB_XSUB(j)  (1280 + 64 * (j))
#define XB_XGEN(j)  (2304 + 64 * (j))
#define XB_TOP      3328
#define XB_TOPGEN   3392
#define XCD_BAR_WORDS 3456
#define XB_SPIN_CAP (1u << 22)
__device__ __forceinline__ unsigned xb_ld(unsigned* p)              { return __hip_atomic_load(p, __ATOMIC_RELAXED, __HIP_MEMORY_SCOPE_AGENT); }
__device__ __forceinline__ unsigned xb_add(unsigned* p, unsigned v) { return __hip_atomic_fetch_add(p, v, __ATOMIC_RELAXED, __HIP_MEMORY_SCOPE_AGENT); }
__device__ __forceinline__ unsigned xb_xcc_id() { return (unsigned)__builtin_amdgcn_s_getreg((3 << 11) | 20) & 0xFu; }
#define XB_SPIN(cond, bar) do { unsigned _sp = 0; while (cond) { __builtin_amdgcn_s_sleep(1); \
    if ((++_sp & 255u) == 0u) { if (xb_ld(&(bar)[XB_TMO])) break; if (_sp > XB_SPIN_CAP) { atomicAdd(&(bar)[XB_TMO], 1u); break; } } } } while (0)
struct XcdBarrier { unsigned* bar; unsigned x; volatile LAS unsigned* st; };
__device__ __forceinline__ XcdBarrier xcd_barrier_post(unsigned* bar, volatile LAS unsigned* st) {
    XcdBarrier b; b.bar = bar; b.x = xb_xcc_id(); b.st = st;
    if (threadIdx.x == 0) (void)xb_add(&bar[XB_XCNT(b.x)], 1u);
    return b;
}
__device__ __forceinline__ void xcd_barrier_complete(unsigned* bar, unsigned x, unsigned& nloc, unsigned& nx) {
    const unsigned G = gridDim.x * gridDim.y * gridDim.z;
    unsigned sum, cnt, mine, sp = 0u;
    for (;;) {
        sum = 0u; cnt = 0u; mine = 0u;
#pragma unroll
        for (unsigned j = 0; j < 16; ++j) { const unsigned c = xb_ld(&bar[XB_XCNT(j)]); sum += c; cnt += (c > 0u) ? 1u : 0u; mine = (j == x) ? c : mine; }
        if (sum == G) break;
        __builtin_amdgcn_s_sleep(1);
        if ((++sp & 255u) == 0u) { if (xb_ld(&bar[XB_TMO])) break; if (sp > XB_SPIN_CAP) { atomicAdd(&bar[XB_TMO], 1u); break; } }
    }
    nloc = mine > 0u ? mine : 1u; nx = cnt > 0u ? cnt : 1u;
}
__device__ __forceinline__ void xcd_barrier(const XcdBarrier& b) {
    asm volatile("s_waitcnt vmcnt(0)" ::: "memory");
    __syncthreads();
    if (threadIdx.x == 0) {
        unsigned* bar = b.bar;
        __builtin_amdgcn_s_waitcnt(0);
        unsigned nloc = b.st[0], nx = b.st[1];
        if (nloc == 0u) { xcd_barrier_complete(bar, b.x, nloc, nx); b.st[0] = nloc; b.st[1] = nx; }
        const unsigned old = xb_add(&bar[XB_XSUB(b.x)], 1u);
        const unsigned gen = old / nloc;
        if (old + 1u == (gen + 1u) * nloc) {
            __builtin_amdgcn_fence(__ATOMIC_RELEASE, "agent");
            asm volatile("s_waitcnt vmcnt(0)" ::: "memory");
            const unsigned og = xb_add(&bar[XB_TOP], 1u);
            const unsigned tg = og / nx;
            if (og + 1u == (tg + 1u) * nx) xb_add(&bar[XB_TOPGEN], 1u);
            else XB_SPIN(xb_ld(&bar[XB_TOPGEN]) == tg, bar);
            __builtin_amdgcn_fence(__ATOMIC_ACQUIRE, "agent");
            xb_add(&bar[XB_XGEN(b.x)], 1u);
            asm volatile("s_waitcnt vmcnt(0)" ::: "memory");
        } else {
            XB_SPIN(xb_ld(&bar[XB_XGEN(b.x)]) == gen, bar);
            __builtin_amdgcn_fence(__ATOMIC_ACQUIRE, "agent");
            asm volatile("s_waitcnt vmcnt(0)" ::: "memory");
        }
    }
    __syncthreads();
}

namespace pg8 {
constexpr int BM = 256, BK = 64, HALF = 128, HTB = HALF * BK * 2, STAGE_BYTES = 8 * HTB, NXCD = 8, WGM = 8;
__host__ __device__ __forceinline__ int lds_byte(int r, int c) { const int st = (r >> 4) * 2 + (c >> 5), rr = r & 15, cc = c & 31, ob = rr * 64 + cc * 2; return st * 1024 + (ob ^ (((ob >> 9) & 1) << 5)); }
__host__ __device__ __forceinline__ void stage_rc(int b, int& R, int& C) { const int st = b / 1024, sb = b % 1024, swz = sb ^ (((sb >> 9) & 1) << 5); R = (st >> 1) * 16 + swz / 64; C = (st & 1) * 32 + (swz % 64) / 2; }
__host__ __device__ __forceinline__ int perm32(int rho) { const int n = rho >> 4, i = rho & 15; return 8 * (i >> 2) + 4 * n + (i & 3); }
typedef int i32x8 __attribute__((ext_vector_type(8)));
__device__ __forceinline__ i32x8 cat8(const bf16x8 a, const bf16x8 b) { const u32x4 x = __builtin_bit_cast(u32x4, a), y = __builtin_bit_cast(u32x4, b); i32x8 r; r[0] = (int)x.x; r[1] = (int)x.y; r[2] = (int)x.z; r[3] = (int)x.w; r[4] = (int)y.x; r[5] = (int)y.y; r[6] = (int)y.z; r[7] = (int)y.w; return r; }
struct Unit { int pm, pn; };
struct Gemm { const bf16_t* A; const bf16_t* Bt; int M, N, K; };
struct StaticOrder {
    int nM, nN, nwg, G, c;
    __device__ void init(int M, int N, int G_, int c_) { nM = M / BM; nN = N / BM; nwg = nM * nN; G = G_; c = c_; }
    __device__ bool next(int i, Unit& u) const {
        const long L = (long)i * G + c; if (L >= nwg) return false;
        int wgid = (int)L; { const int q = nwg / NXCD, r = nwg % NXCD, xcd = wgid % NXCD, off = wgid / NXCD; wgid = (xcd < r ? xcd * (q + 1) : r * (q + 1) + (xcd - r) * q) + off; }
        const int nig = WGM * nN, gid = wgid / nig, fm = gid * WGM, gsz = (nM - fm) < WGM ? (nM - fm) : WGM;
        u.pm = fm + ((wgid % nig) % gsz); u.pn = (wgid % nig) / gsz; return true;
    }
};

template <class Epi, class Sched>
__device__ __forceinline__ void gemm_phase(LAS unsigned char* lds, const Gemm g, const Sched& S, const Epi& E) {
    const int tid_ = otid();
    const int tid = tid_, wid = __builtin_amdgcn_readfirstlane(tid >> 6), lane = tid & 63, wr = wid >> 2, wc = wid & 3, fr = lane & 15, fq = lane >> 4;
    const int K = g.K, nt = K / BK;
    unsigned voffA[2], voffB[2];
#pragma unroll
    for (int i = 0; i < 2; ++i) { int R, C; stage_rc(tid * 16 + i * 8192, R, C); const int Rb = Epi::PERM ? ((R & ~31) + perm32(R & 31)) : R;
        voffA[i] = (unsigned)(R * K + C) * 2u; voffB[i] = (unsigned)(Rb * K + C) * 2u; }
    const size_t kstep = (size_t)(BK * 2);
    const size_t hstep = (size_t)HALF * K * 2;
    const size_t tstep = 2 * hstep;
    const unsigned ldsw = (unsigned)wid * 1024u;
    const int aoff = lds_byte(wr * 64 + fr, fq * 8), boff = lds_byte(wc * 32 + fr, fq * 8);
    const int aoff8 = lds_byte(wr * 64 + fr, (fq >> 1) * 32 + (fq & 1) * 16), boff8 = lds_byte(wc * 32 + fr, (fq >> 1) * 32 + (fq & 1) * 16);
#define PG8_SA(b, h) (((b) * 2 + (h)) * HTB)
#define PG8_SB(b, h) ((4 + (b) * 2 + (h)) * HTB)
#define PG8_STAGE(bufoff, gbase, voff) do { _Pragma("unroll") for (int _i = 0; _i < 2; ++_i) \
        __builtin_amdgcn_global_load_lds((const unsigned*)((const char*)(gbase) + (voff)[_i]), (LAS unsigned*)(lds + (bufoff) + ldsw + _i * 8192), 16, 0, 0); } while (0)
#define PG8_LDA(dst, b, h) do { if constexpr (Epi::FP8) { _Pragma("unroll") for (int m = 0; m < 4; ++m) dst##8[m] = cat8(*(const LAS bf16x8*)(lds + PG8_SA(b, h) + aoff + m * 2048), *(const LAS bf16x8*)(lds + PG8_SA(b, h) + aoff + m * 2048 + 1024)); } \
        else { _Pragma("unroll") for (int m = 0; m < 4; ++m) _Pragma("unroll") for (int k = 0; k < 2; ++k) dst[m][k] = *(const LAS bf16x8*)(lds + PG8_SA(b, h) + aoff + m * 2048 + k * 1024); } } while (0)
#define PG8_LDB(dst, b, h) do { if constexpr (Epi::FP8) { _Pragma("unroll") for (int n = 0; n < 2; ++n) dst##8[n] = cat8(*(const LAS bf16x8*)(lds + PG8_SB(b, h) + boff + n * 2048), *(const LAS bf16x8*)(lds + PG8_SB(b, h) + boff + n * 2048 + 1024)); } \
        else { _Pragma("unroll") for (int n = 0; n < 2; ++n) _Pragma("unroll") for (int k = 0; k < 2; ++k) dst[n][k] = *(const LAS bf16x8*)(lds + PG8_SB(b, h) + boff + n * 2048 + k * 1024); } } while (0)
#define PG8_MMA(ai, bj, At, Bt) do { __builtin_amdgcn_s_setprio(1); _Pragma("unroll") for (int m = 0; m < 4; ++m) _Pragma("unroll") for (int n = 0; n < 2; ++n) { \
        if constexpr (Epi::FP8) { asm volatile("v_mfma_scale_f32_16x16x128_f8f6f4 %0, %1, %2, %0, %3, %3 op_sel_hi:[0,0,0]" : "+v"(acc[ai][bj][m][n]) : "v"(Bt##8[n]), "v"(At##8[m]), "v"(one_scale)); } \
        else { _Pragma("unroll") for (int k = 0; k < 2; ++k) acc[ai][bj][m][n] = __builtin_amdgcn_mfma_f32_16x16x32_bf16(Bt[n][k], At[m][k], acc[ai][bj][m][n], 0, 0, 0); } } \
        __builtin_amdgcn_s_setprio(0); } while (0)
#define PG8_WAIT_V(n) asm volatile("s_waitcnt vmcnt(" #n ")" ::: "memory")
#define PG8_WAIT_L(n) asm volatile("s_waitcnt lgkmcnt(" #n ")" ::: "memory")
#define PG8_BAR __builtin_amdgcn_s_barrier()
#define PG8_SCHED __builtin_amdgcn_sched_barrier(0)
    Unit cur, nxt; int ui = 0;
    if (!S.next(0, cur)) return;
    f32x4 acc[2][2][4][2];
#pragma unroll
    for (int a = 0; a < 2; ++a)
#pragma unroll
        for (int b = 0; b < 2; ++b)
#pragma unroll
            for (int m = 0; m < 4; ++m)
#pragma unroll
                for (int n = 0; n < 2; ++n) acc[a][b][m][n] = (f32x4){0.f, 0.f, 0.f, 0.f};
    bf16x8 At[4][2], B0[2][2], B1[2][2];
    i32x8 At8[4], B08[2], B18[2];
    const int one_scale = 0x7F7F7F7F;
    const char* cA = (const char*)g.A + (size_t)cur.pm * tstep; const char* cB = (const char*)g.Bt + (size_t)cur.pn * tstep;
    PG8_STAGE(PG8_SB(0, 0), cB, voffB); PG8_STAGE(PG8_SA(0, 0), cA, voffA); PG8_STAGE(PG8_SB(0, 1), cB + hstep, voffB); PG8_STAGE(PG8_SA(0, 1), cA + hstep, voffA);
    if (wr == 1) PG8_BAR;
    PG8_WAIT_V(4); PG8_BAR;
    PG8_STAGE(PG8_SB(1, 0), cB + kstep, voffB); PG8_STAGE(PG8_SA(1, 0), cA + kstep, voffA); PG8_STAGE(PG8_SB(1, 1), cB + hstep + kstep, voffB);
    PG8_WAIT_V(6); PG8_BAR;
    for (;;) {
        const bool has_next = S.next(ui + 1, nxt);
        const char* nA = has_next ? (const char*)g.A + (size_t)nxt.pm * tstep : cA; const char* nB = has_next ? (const char*)g.Bt + (size_t)nxt.pn * tstep : cB;
        for (int t = 0; t < nt; t += 2) {
            const bool last = (t == nt - 2);
            const char* a1 = cA + (size_t)(t + 1) * kstep;
            const char* a2 = last ? nA : cA + (size_t)(t + 2) * kstep; const char* b2 = last ? nB : cB + (size_t)(t + 2) * kstep;
            const char* a3 = a2 + kstep; const char* b3 = b2 + kstep;
            PG8_LDB(B0, 0, 0); PG8_SCHED; PG8_LDA(At, 0, 0); PG8_STAGE(PG8_SA(1, 1), a1 + hstep, voffA);
            PG8_WAIT_L(8); PG8_BAR; PG8_WAIT_L(0); PG8_MMA(0, 0, At, B0); PG8_BAR; PG8_SCHED;
            PG8_LDB(B1, 0, 1); PG8_STAGE(PG8_SB(0, 0), b2, voffB);
            PG8_BAR; PG8_WAIT_L(0); PG8_MMA(0, 1, At, B1); PG8_BAR;
            PG8_LDA(At, 0, 1); PG8_STAGE(PG8_SA(0, 0), a2, voffA);
            PG8_BAR; PG8_WAIT_L(0); PG8_MMA(1, 0, At, B0); PG8_BAR; PG8_SCHED;
            PG8_STAGE(PG8_SB(0, 1), b2 + hstep, voffB);
            PG8_WAIT_V(6); PG8_BAR; PG8_MMA(1, 1, At, B1); PG8_BAR;
            PG8_LDB(B0, 1, 0); PG8_SCHED; PG8_LDA(At, 1, 0); PG8_STAGE(PG8_SA(0, 1), a2 + hstep, voffA);
            PG8_WAIT_L(8); PG8_BAR; PG8_WAIT_L(0); PG8_MMA(0, 0, At, B0); PG8_BAR; PG8_SCHED;
            PG8_LDB(B1, 1, 1); PG8_STAGE(PG8_SB(1, 0), b3, voffB);
            PG8_BAR; PG8_WAIT_L(0); PG8_MMA(0, 1, At, B1); PG8_BAR;
            PG8_LDA(At, 1, 1); PG8_STAGE(PG8_SA(1, 0), a3, voffA);
            PG8_BAR; PG8_WAIT_L(0); PG8_MMA(1, 0, At, B0); PG8_BAR; PG8_SCHED;
            PG8_STAGE(PG8_SB(1, 1), b3 + hstep, voffB);
            PG8_WAIT_V(6); PG8_BAR; PG8_MMA(1, 1, At, B1); PG8_BAR;
        }
        if constexpr (Epi::FP8) asm volatile("s_nop 15\n s_nop 15\n s_nop 15" ::: "memory");
        E(acc, cur, wr, wc, fr, fq);
        if (!has_next) break;
#pragma unroll
        for (int a = 0; a < 2; ++a)
#pragma unroll
            for (int b = 0; b < 2; ++b)
#pragma unroll
                for (int m = 0; m < 4; ++m)
#pragma unroll
                    for (int n = 0; n < 2; ++n) acc[a][b][m][n] = (f32x4){0.f, 0.f, 0.f, 0.f};
        cur = nxt; cA = nA; cB = nB; ++ui;
    }
    PG8_WAIT_V(0);
    if (wr == 0) PG8_BAR;
    PG8_BAR;
#undef PG8_SA
#undef PG8_SB
#undef PG8_STAGE
#undef PG8_LDA
#undef PG8_LDB
#undef PG8_MMA
#undef PG8_WAIT_V
#undef PG8_WAIT_L
#undef PG8_BAR
#undef PG8_SCHED
}
}

typedef f32x4 AccT[2][2][4][2];

struct EpiInProj {
    static constexpr bool PERM = true, FP8 = true;
    unsigned char* P;
    const float* sa;
    const unsigned* cmax;
    __device__ __forceinline__ void operator()(const AccT& acc, const pg8::Unit& u, int wr, int wc, int fr, int fq) const {
        const int pn = u.pn;
        bf16_t* base; int ld, lc, act;
        if (pn < 28) { const int seg = pn >> 2; base = (bf16_t*)(P + (size_t)seg * SEG); ld = 1024; lc = (pn & 3) * 256; act = (seg < 2) ? 1 : ((seg == 2 || seg == 6) ? 2 : 0); }
        else if (pn < 31) { base = (bf16_t*)(P + P_CU); ld = 768; lc = (pn - 28) * 256; act = 0; }
        else { base = (bf16_t*)(P + P_GATES); ld = 6144; lc = (pn - 31) * 256; act = 3; }
        const int row0 = u.pm * 256 + wr * 64 + fr, col0 = lc + wc * 32 + 8 * fq, gcol0 = u.pn * 256 + wc * 32 + 8 * fq;
        f32x4 cs[2][2];
#pragma unroll
        for (int bj = 0; bj < 2; ++bj)
#pragma unroll
            for (int n = 0; n < 2; ++n) { const u32x4 cb = *(const u32x4*)(cmax + gcol0 + bj * 128 + 4 * n);
                cs[bj][n] = (f32x4){__uint_as_float(cb.x), __uint_as_float(cb.y), __uint_as_float(cb.z), __uint_as_float(cb.w)} * (1.0f / 240.0f); }
        float rscv[2][4];
#pragma unroll
        for (int ai = 0; ai < 2; ++ai)
#pragma unroll
            for (int m = 0; m < 4; ++m) rscv[ai][m] = sa[row0 + ai * 128 + m * 16];
#pragma unroll
        for (int ai = 0; ai < 2; ++ai)
#pragma unroll
            for (int m = 0; m < 4; ++m) {
                bf16_t* rowp = base + (size_t)(row0 + ai * 128 + m * 16) * ld + col0;
                const float rsc = rscv[ai][m];
#pragma unroll
                for (int bj = 0; bj < 2; ++bj) {
                    f32x4 v0 = acc[ai][bj][m][0] * (cs[bj][0] * rsc), v1 = acc[ai][bj][m][1] * (cs[bj][1] * rsc);
                    if (act == 1) {
#pragma unroll
                        for (int j = 0; j < 4; ++j) { v0[j] = gelu_f(v0[j]); v1[j] = gelu_f(v1[j]); }
                    } else if (act == 2) {
#pragma unroll
                        for (int j = 0; j < 4; ++j) { v0[j] = fast_silu(v0[j]); v1[j] = fast_silu(v1[j]); }
                    } else if (act == 3) {
#pragma unroll
                        for (int j = 0; j < 4; ++j) { v0[j] = fast_sigmoid(v0[j]); v1[j] = fast_sigmoid(v1[j]); }
                    }
                    u32x4 w; w.x = cvt_pk_bf16(v0[0], v0[1]); w.y = cvt_pk_bf16(v0[2], v0[3]); w.z = cvt_pk_bf16(v1[0], v1[1]); w.w = cvt_pk_bf16(v1[2], v1[3]);
                    *(u32x4*)(rowp + bj * 128) = w;
                }
            }
    }
};
struct EpiGlu {
    static constexpr bool PERM = true, FP8 = false;
    bf16_t* O;
    __device__ __forceinline__ void operator()(const AccT& acc, const pg8::Unit& u, int wr, int wc, int fr, int fq) const {
        const int row0 = u.pm * 256 + wr * 64 + fr, col0 = u.pn * 128 + wc * 32 + 8 * fq;
#pragma unroll
        for (int ai = 0; ai < 2; ++ai)
#pragma unroll
            for (int m = 0; m < 4; ++m) {
                f32x4 v0 = acc[ai][0][m][0], v1 = acc[ai][0][m][1]; const f32x4 g0 = acc[ai][1][m][0], g1 = acc[ai][1][m][1];
#pragma unroll
                for (int j = 0; j < 4; ++j) { v0[j] *= fast_sigmoid(g0[j]); v1[j] *= fast_sigmoid(g1[j]); }
                u32x4 w; w.x = cvt_pk_bf16(v0[0], v0[1]); w.y = cvt_pk_bf16(v0[2], v0[3]); w.z = cvt_pk_bf16(v1[0], v1[1]); w.w = cvt_pk_bf16(v1[2], v1[3]);
                *(u32x4*)(O + (size_t)(row0 + ai * 128 + m * 16) * 768 + col0) = w;
            }
    }
};
template <bool FIRST> struct EpiMerge {
    static constexpr bool PERM = true, FP8 = false;
    bf16_t* O;
    const bf16_t* G;
    __device__ __forceinline__ void operator()(const AccT& acc, const pg8::Unit& u, int wr, int wc, int fr, int fq) const {
        const int row0 = u.pm * 256 + wr * 64 + fr, col0 = u.pn * 256 + wc * 32 + 8 * fq;
#pragma unroll
        for (int ai = 0; ai < 2; ++ai) {
            u32x4 gwv[4][2], owv[4][2];
#pragma unroll
            for (int m = 0; m < 4; ++m)
#pragma unroll
                for (int bj = 0; bj < 2; ++bj) { const size_t row = (size_t)(row0 + ai * 128 + m * 16);
                    gwv[m][bj] = *(const u32x4*)(G + row * 6144 + col0 + bj * 128);
                    if (!FIRST) owv[m][bj] = *(const u32x4*)(O + row * 2048 + col0 + bj * 128); }
#pragma unroll
            for (int m = 0; m < 4; ++m)
#pragma unroll
                for (int bj = 0; bj < 2; ++bj) { const size_t row = (size_t)(row0 + ai * 128 + m * 16);
                    const u32x4 gw = gwv[m][bj];
                    f32x4 v0 = acc[ai][bj][m][0], v1 = acc[ai][bj][m][1];
                    v0[0] *= bf_lo(gw.x); v0[1] *= bf_hi(gw.x); v0[2] *= bf_lo(gw.y); v0[3] *= bf_hi(gw.y);
                    v1[0] *= bf_lo(gw.z); v1[1] *= bf_hi(gw.z); v1[2] *= bf_lo(gw.w); v1[3] *= bf_hi(gw.w);
                    if (!FIRST) { const u32x4 ow = owv[m][bj];
                        v0[0] += bf_lo(ow.x); v0[1] += bf_hi(ow.x); v0[2] += bf_lo(ow.y); v0[3] += bf_hi(ow.y);
                        v1[0] += bf_lo(ow.z); v1[1] += bf_hi(ow.z); v1[2] += bf_lo(ow.w); v1[3] += bf_hi(ow.w); }
                    u32x4 w; w.x = cvt_pk_bf16(v0[0], v0[1]); w.y = cvt_pk_bf16(v0[2], v0[3]); w.z = cvt_pk_bf16(v1[0], v1[1]); w.w = cvt_pk_bf16(v1[2], v1[3]);
                    *(u32x4*)(O + row * 2048 + col0 + bj * 128) = w; }
        }
    }
};
struct EpiResid {
    static constexpr bool PERM = false, FP8 = false;
    float* XR; float* XC; const float* modl;
    __device__ __forceinline__ void operator()(const AccT& acc, const pg8::Unit& u, int wr, int wc, int fr, int fq) const {
        const int row0 = u.pm * 256 + wr * 64 + fr, col0 = u.pn * 256 + wc * 32 + 4 * fq;
        const int mb = u.pm < 128 ? (u.pm >> 3) : 16;
        const float* gv = modl + (size_t)mb * NMOD + col0;
        float* basep = u.pm < 128 ? XR : (XC - (size_t)TL * D);
        f32x4 gvv[2][2];
#pragma unroll
        for (int bj = 0; bj < 2; ++bj)
#pragma unroll
            for (int n = 0; n < 2; ++n) gvv[bj][n] = *(const f32x4*)(gv + bj * 128 + n * 16);
#pragma unroll
        for (int ai = 0; ai < 2; ++ai) {
            f32x4 xo[4][2][2];
#pragma unroll
            for (int m = 0; m < 4; ++m)
#pragma unroll
                for (int bj = 0; bj < 2; ++bj)
#pragma unroll
                    for (int n = 0; n < 2; ++n) xo[m][bj][n] = *(const f32x4*)(basep + (size_t)(row0 + ai * 128 + m * 16) * D + col0 + bj * 128 + n * 16);
#pragma unroll
            for (int m = 0; m < 4; ++m)
#pragma unroll
                for (int bj = 0; bj < 2; ++bj)
#pragma unroll
                    for (int n = 0; n < 2; ++n) *(f32x4*)(basep + (size_t)(row0 + ai * 128 + m * 16) * D + col0 + bj * 128 + n * 16) = xo[m][bj][n] + gvv[bj][n] * acc[ai][bj][m][n];
        }
    }
};
struct EpiF32 {
    static constexpr bool PERM = false, FP8 = false;
    float* C; int ldc;
    __device__ __forceinline__ void operator()(const AccT& acc, const pg8::Unit& u, int wr, int wc, int fr, int fq) const {
        const int row0 = u.pm * 256 + wr * 64 + fr, col0 = u.pn * 256 + wc * 32 + 4 * fq;
#pragma unroll
        for (int ai = 0; ai < 2; ++ai)
#pragma unroll
            for (int m = 0; m < 4; ++m) {
                float* rowp = C + (size_t)(row0 + ai * 128 + m * 16) * ldc + col0;
#pragma unroll
                for (int bj = 0; bj < 2; ++bj)
#pragma unroll
                    for (int n = 0; n < 2; ++n) *(f32x4*)(rowp + bj * 128 + n * 16) = acc[ai][bj][m][n];
            }
    }
};

template <class Epi>
__device__ __forceinline__ void run_gemm(LAS unsigned char* lds, const bf16_t* A, const bf16_t* Bt, int M, int N, int K, const Epi& E, int rot = 0) {
    pg8::Gemm g{A, Bt, M, N, K};
    const int G_ = (int)gridDim.x; int c_ = (int)blockIdx.x - rot; if (c_ < 0) c_ += G_;
    pg8::StaticOrder S; S.init(M, N, G_, c_);
    pg8::gemm_phase<Epi, pg8::StaticOrder>(lds, g, S, E);
}

__device__ __forceinline__ void phase_mod(const Params& p, LAS unsigned char* lds) {
    const int tid_ = otid();
    LAS float* cs = (LAS float*)lds;
    LAS float* red = (LAS float*)(lds + 2048 * 17 * 4);
    const int tid = tid_;
    float* modv = (float*)(p.ws + OFF_MODV);
    { f32x4 cv[17];
#pragma unroll
      for (int r = 0; r < 17; ++r) cv[r] = *(const f32x4*)((r < 16 ? p.c + r * 2048 : p.c_ctx) + tid * 4);
#pragma unroll
      for (int r = 0; r < 17; ++r)
#pragma unroll
          for (int e = 0; e < 4; ++e) { const float c = cv[r][e]; cs[(tid * 4 + e) * 17 + r] = c / (1.0f + __expf(-c)); } }
    __syncthreads();
    const int lane = tid & 63, wv = tid >> 6, cq = lane & 7, kg = wv * 8 + (lane >> 3);
    for (int u = blockIdx.x; u < 768; u += gridDim.x) {
        const int l = u / 384, c0 = (u % 384) * 32;
        const float* w = p.w_mod + (size_t)l * 2048 * NMOD + (size_t)kg * NMOD + c0 + cq * 4;
        f32x4 acc[17];
#pragma unroll
        for (int r = 0; r < 17; ++r) acc[r] = (f32x4){0.f, 0.f, 0.f, 0.f};
#pragma unroll 16
        for (int j = 0; j < 32; ++j) {
            const f32x4 w4 = *(const f32x4*)(w + (size_t)j * 64 * NMOD);
            const LAS float* cr = cs + (kg + 64 * j) * 17;
#pragma unroll
            for (int r = 0; r < 17; ++r) acc[r] += w4 * cr[r];
        }
#pragma unroll
        for (int r = 0; r < 17; ++r)
#pragma unroll
            for (int c = 0; c < 4; ++c) { float v = acc[r][c]; v += __shfl_xor(v, 8); v += __shfl_xor(v, 16); v += __shfl_xor(v, 32);
                if (lane < 8) red[(wv * 32 + cq * 4 + c) * 17 + r] = v; }
        __syncthreads();
        for (int o = tid; o < 32 * 17; o += NTHREADS) { const int col = o & 31, r = o >> 5;
            float sum = p.b_mod[l * NMOD + c0 + col];
#pragma unroll
            for (int q = 0; q < 8; ++q) sum += red[(q * 32 + col) * 17 + r];
            modv[(size_t)(l * 17 + r) * NMOD + c0 + col] = sum; }
        __syncthreads();
    }
}
__device__ __forceinline__ void phase_prep(const Params& p) {
    const int tid_ = otid();
    const int gt = blockIdx.x * NTHREADS + tid_, nt = gridDim.x * NTHREADS;
    float* lb = (float*)(p.ws + OFF_LB);
    for (int i = gt; i < 2 * 1024; i += nt) { const float x0 = p.lb_logits[i], x1 = p.lb_logits[2048 + i]; lb[i] = 0.f; lb[2048 + i] = 1.0f / (1.0f + expf(x0 - x1)); }
    float* s5lam = (float*)(p.ws + OFF_S5LAM); float* s5bb = (float*)(p.ws + OFF_S5BB);
    for (int i = gt; i < 2 * 2 * 48 * 64; i += nt) {
        const int ldg = i >> 6;
        const double lre = (double)p.lam_re[i], lim = (double)p.lam_im[i], dt = exp((double)p.log_step[ldg]);
        const double er = exp(lre * dt); double sn, cs; sincos(lim * dt, &sn, &cs);
        const double br = er * cs, bi = er * sn;
        s5lam[i * 2] = (float)br; s5lam[i * 2 + 1] = (float)bi;
        const double nr = br - 1.0, ni = bi, den = lre * lre + lim * lim;
        const double cr = (nr * lre + ni * lim) / den, ci = (ni * lre - nr * lim) / den;
        for (int d = 0; d < 16; ++d) { const double xr = (double)p.b_re[(size_t)i * 16 + d], xi = (double)p.b_im[(size_t)i * 16 + d];
            s5bb[(size_t)i * 32 + d] = (float)(cr * xr - ci * xi); s5bb[(size_t)i * 32 + 16 + d] = (float)(cr * xi + ci * xr); }
    }
    float* pe = (float*)(p.ws + OFF_PE);
    for (int i = gt; i < 96 * 1024; i += nt) {
        const int r = i >> 10, cc = i & 1023, j = cc & 511;
        const float pos = (float)(r < 32 ? r : r - 32);
        const float omega = 1.0f / powf(10000.0f, (float)j * (1.0f / 512.0f));
        const float ang = pos * omega;
        pe[i] = cc < 512 ? sinf(ang) : cosf(ang);
    }
}

template <int MAPMODE>
__device__ __forceinline__ void transpose_convert(const float* src, int K, int N, bf16_t* dst, LAS unsigned char* lds) {
    const int tid_ = otid();
    LAS float* tile = (LAS float*)lds;
    const int tid = tid_, nkb = K / 64, nnb = N / 64;
    for (int u = blockIdx.x; u < nkb * nnb; u += gridDim.x) {
        const int kb = u / nnb, nb = u % nnb, k0 = kb * 64, n0 = nb * 64;
        { const int nn = tid & 63, kk = tid >> 6;
#pragma unroll
          for (int i = 0; i < 8; ++i) tile[(kk + i * 8) * 65 + nn] = src[(size_t)(k0 + kk + i * 8) * N + n0 + nn]; }
        __syncthreads();
        { const int kk2 = (tid & 7) * 8, nn2 = tid >> 3; float v[8];
#pragma unroll
          for (int i = 0; i < 8; ++i) v[i] = tile[(kk2 + i) * 65 + nn2];
          int n = n0 + nn2, nr;
          if (MAPMODE == 1) { if (n < 768) nr = (n >> 7) * 256 + (n & 127); else { const int m = n - 768; nr = (m >> 7) * 256 + 128 + (m & 127); } } else nr = n;
          u32x4 w; w.x = cvt_pk_bf16(v[0], v[1]); w.y = cvt_pk_bf16(v[2], v[3]); w.z = cvt_pk_bf16(v[4], v[5]); w.w = cvt_pk_bf16(v[6], v[7]);
          *(u32x4*)(dst + (size_t)nr * K + k0 + kk2) = w; }
        __syncthreads();
    }
}
__device__ __forceinline__ void phase_wscore(const float* wq, const float* sk, bf16_t* dst, LAS unsigned char* lds) {
    const int tid_ = otid();
    LAS float* skt = (LAS float*)lds;
    LAS float* wqt = (LAS float*)(lds + 128 * 129 * 4);
    const int tid = tid_;
    for (int u = blockIdx.x; u < 16 * 32; u += gridDim.x) {
        const int hp = u >> 5, kb = u & 31;
        for (int i = tid; i < 128 * 128; i += NTHREADS) { const int key = i >> 7, e = i & 127; skt[key * 129 + e] = sk[(size_t)hp * 16384 + i]; }
        for (int i = tid; i < 64 * 128; i += NTHREADS) { const int k = i >> 7, e = i & 127; wqt[e * 68 + k] = wq[(size_t)(kb * 64 + k) * 2048 + hp * 128 + e]; }
        __syncthreads();
        const int key = tid & 127, kg = tid >> 7;
        float acc[16];
#pragma unroll
        for (int i = 0; i < 16; ++i) acc[i] = 0.f;
        for (int e = 0; e < 128; ++e) {
            const float s = skt[key * 129 + e];
#pragma unroll
            for (int q = 0; q < 4; ++q) { const f32x4 w4 = *(const LAS f32x4*)(wqt + e * 68 + kg * 16 + q * 4);
                acc[q * 4 + 0] += s * w4[0]; acc[q * 4 + 1] += s * w4[1]; acc[q * 4 + 2] += s * w4[2]; acc[q * 4 + 3] += s * w4[3]; }
        }
        bf16_t* o = dst + (size_t)(hp * 128 + key) * 2048 + kb * 64 + kg * 16;
        u32x4 w0, w1;
        w0.x = cvt_pk_bf16(acc[0], acc[1]); w0.y = cvt_pk_bf16(acc[2], acc[3]); w0.z = cvt_pk_bf16(acc[4], acc[5]); w0.w = cvt_pk_bf16(acc[6], acc[7]);
        w1.x = cvt_pk_bf16(acc[8], acc[9]); w1.y = cvt_pk_bf16(acc[10], acc[11]); w1.z = cvt_pk_bf16(acc[12], acc[13]); w1.w = cvt_pk_bf16(acc[14], acc[15]);
        *(u32x4*)o = w0; *(u32x4*)(o + 8) = w1;
        __syncthreads();
    }
}
__device__ __forceinline__ void phase_colmax(const Params& p) {
    const int tid_ = otid();
    unsigned* cm = (unsigned*)(p.ws + OFF_CMAX);
    const int total = 2 * (INC / 4) * 16;
    for (int i = blockIdx.x * NTHREADS + tid_; i < total; i += gridDim.x * NTHREADS) {
        const int kc = i / (2 * (INC / 4)), cidx = i % (2 * (INC / 4)), l = cidx / (INC / 4), nq = cidx % (INC / 4);
        const float* w = p.w_in + (size_t)l * D * INC + (size_t)(kc * 128) * INC + nq * 4;
        f32x4 am = (f32x4){0.f, 0.f, 0.f, 0.f};
#pragma unroll 32
        for (int k = 0; k < 128; ++k) { const f32x4 v = *(const f32x4*)(w + (size_t)k * INC);
            am[0] = fmaxf(am[0], fabsf(v[0])); am[1] = fmaxf(am[1], fabsf(v[1])); am[2] = fmaxf(am[2], fabsf(v[2])); am[3] = fmaxf(am[3], fabsf(v[3])); }
        unsigned* o = cm + l * INC + nq * 4;
        atomicMax(o, __float_as_uint(am[0])); atomicMax(o + 1, __float_as_uint(am[1])); atomicMax(o + 2, __float_as_uint(am[2])); atomicMax(o + 3, __float_as_uint(am[3]));
    }
}
__device__ __forceinline__ void transpose_convert_fp8(const float* src, int K, int N, unsigned char* dst, const unsigned* cmax, LAS unsigned char* lds) {
    const int tid_ = otid();
    LAS float* tile = (LAS float*)lds;
    const int tid = tid_, nkb = K / 64, nnb = N / 64;
    for (int u = blockIdx.x; u < nkb * nnb; u += gridDim.x) {
        const int kb = u / nnb, nb = u % nnb, k0 = kb * 64, n0 = nb * 64;
        { const int nn = tid & 63, kk = tid >> 6;
#pragma unroll
          for (int i = 0; i < 8; ++i) tile[(kk + i * 8) * 65 + nn] = src[(size_t)(k0 + kk + i * 8) * N + n0 + nn]; }
        __syncthreads();
        { const int kk2 = (tid & 7) * 8, nn2 = tid >> 3; float v[8];
          const float cmv = __uint_as_float(cmax[n0 + nn2]); const float sc = cmv > 0.f ? 240.0f / cmv : 1.0f;
#pragma unroll
          for (int i = 0; i < 8; ++i) v[i] = tile[(kk2 + i) * 65 + nn2] * sc;
          u32x2 w; w.x = pack_fp8x4(v[0], v[1], v[2], v[3]); w.y = pack_fp8x4(v[4], v[5], v[6], v[7]);
          *(u32x2*)(dst + (size_t)(n0 + nn2) * K + k0 + kk2) = w; }
        __syncthreads();
    }
}
__device__ __forceinline__ void phase_wconv(const Params& p, int l, LAS unsigned char* lds) {
    unsigned char* W = p.ws + OFF_W;
    transpose_convert_fp8(p.w_in + (size_t)l * D * INC, D, INC, W + W_IN, (const unsigned*)(p.ws + OFF_CMAX) + (size_t)l * INC, lds);
    transpose_convert<1>(p.w_glu + (size_t)l * 768 * 1536, 768, 1536, (bf16_t*)(W + W_GLU), lds);
    transpose_convert<0>(p.wa + (size_t)l * 1024 * D, 1024, D, (bf16_t*)(W + W_A), lds);
    transpose_convert<0>(p.wb + (size_t)l * 1024 * D, 1024, D, (bf16_t*)(W + W_B), lds);
    transpose_convert<0>(p.wc + (size_t)l * 768 * D, 768, D, (bf16_t*)(W + W_C), lds);
    transpose_convert<0>(p.wo + (size_t)l * D * D, D, D, (bf16_t*)(W + W_O), lds);
    phase_wscore(p.w_q + (size_t)l * D * D, p.sub_keys + (size_t)l * 16 * 16384, (bf16_t*)(W + W_S), lds);
}
__device__ __forceinline__ void phase_tabconv(const Params& p, int l) {
    const int tid_ = otid();
    const int lane = tid_ & 63, gw = blockIdx.x * 8 + __builtin_amdgcn_readfirstlane(tid_ >> 6), nw = gridDim.x * 8;
    unsigned char* U6 = p.ws + OFF_P + Q_UT; unsigned char* V6 = p.ws + OFF_P + Q_VT;
    float* USC = (float*)(p.ws + OFF_P + Q_USC); float* VSC = (float*)(p.ws + OFF_P + Q_VSC);
    for (int r = gw; r < 32768; r += nw) {
        const bool isv = r >= 16384; const int rr = r & 16383;
        const float* src = (isv ? p.peer_v : p.peer_u) + (size_t)l * 16384 * 2048 + (size_t)rr * 2048;
        f32x4 v[8];
#pragma unroll
        for (int j = 0; j < 8; ++j) v[j] = *(const f32x4*)(src + j * 256 + lane * 4);
        float am = 0.f;
#pragma unroll
        for (int j = 0; j < 8; ++j) am = fmaxf(am, fmaxf(fmaxf(fabsf(v[j][0]), fabsf(v[j][1])), fmaxf(fabsf(v[j][2]), fabsf(v[j][3]))));
#pragma unroll
        for (int o = 32; o >= 1; o >>= 1) am = fmaxf(am, __shfl_xor(am, o));
        {
            const float sc4 = am > 0.f ? 6.0f / am : 1.0f;
            unsigned wd[4] = {0u, 0u, 0u, 0u};
#pragma unroll
            for (int j = 0; j < 8; ++j) {
                if ((j & 1) == 0) { wd[j >> 1] = __builtin_amdgcn_cvt_scalef32_pk_fp4_f32(wd[j >> 1], v[j][0] * sc4, v[j][1] * sc4, 1.0f, 0); wd[j >> 1] = __builtin_amdgcn_cvt_scalef32_pk_fp4_f32(wd[j >> 1], v[j][2] * sc4, v[j][3] * sc4, 1.0f, 1); }
                else { wd[j >> 1] = __builtin_amdgcn_cvt_scalef32_pk_fp4_f32(wd[j >> 1], v[j][0] * sc4, v[j][1] * sc4, 1.0f, 2); wd[j >> 1] = __builtin_amdgcn_cvt_scalef32_pk_fp4_f32(wd[j >> 1], v[j][2] * sc4, v[j][3] * sc4, 1.0f, 3); } }
            u32x4 w4; w4.x = wd[0]; w4.y = wd[1]; w4.z = wd[2]; w4.w = wd[3];
            *(u32x4*)((isv ? V6 : U6) + (size_t)rr * 1024 + lane * 16) = w4;
            if (lane == 0) (isv ? VSC : USC)[rr] = am > 0.f ? am * (1.0f / 6.0f) : 1.0f;
        }
    }
}

template <int MODE, bool F8OUT = false>
__device__ __forceinline__ void phase_norm(const Params& p, int l, int M, int off_sh, int off_sc) {
    const int tid_ = otid();
    const int lane = tid_ & 63, gw = blockIdx.x * 8 + __builtin_amdgcn_readfirstlane(tid_ >> 6), nw = gridDim.x * 8;
    const float* modv = (const float*)(p.ws + OFF_MODV) + (size_t)l * 17 * NMOD;
    const float* pe = (const float*)(p.ws + OFF_PE);
    float* XC = (float*)(p.ws + OFF_XC);
    bf16_t* H = (bf16_t*)(p.ws + OFF_H);
    for (int r = gw; r < M; r += nw) {
        const bool lat = r < TL;
        const float* src = MODE == 0 ? (lat ? p.x + (size_t)r * D : p.ctx + (size_t)(r - TL) * D) : (lat ? p.out + (size_t)r * D : XC + (size_t)(r - TL) * D);
        f32x4 v[4][2];
#pragma unroll
        for (int j = 0; j < 4; ++j) { v[j][0] = *(const f32x4*)(src + j * 512 + lane * 8); v[j][1] = *(const f32x4*)(src + j * 512 + lane * 8 + 4); }
        if (MODE == 0) {
            if (lat) { const int n = r & 2047, gr = n >> 6, gc = n & 63;
#pragma unroll
                for (int j = 0; j < 4; ++j) { const float* pr = (j < 2) ? pe + (size_t)gr * 1024 + j * 512 + lane * 8 : pe + (size_t)(32 + gc) * 1024 + (j - 2) * 512 + lane * 8;
                    v[j][0] += *(const f32x4*)pr; v[j][1] += *(const f32x4*)(pr + 4); } }
            float* dst = lat ? p.out + (size_t)r * D : XC + (size_t)(r - TL) * D;
#pragma unroll
            for (int j = 0; j < 4; ++j) { *(f32x4*)(dst + j * 512 + lane * 8) = v[j][0]; *(f32x4*)(dst + j * 512 + lane * 8 + 4) = v[j][1]; }
        }
        float ss = 0.f;
#pragma unroll
        for (int j = 0; j < 4; ++j)
#pragma unroll
            for (int h = 0; h < 2; ++h) ss += v[j][h][0] * v[j][h][0] + v[j][h][1] * v[j][h][1] + v[j][h][2] * v[j][h][2] + v[j][h][3] * v[j][h][3];
        ss = wave_sum(ss);
        const float rs = rsqrtf(ss * (1.0f / 2048.0f) + 1e-6f);
        const int mb = lat ? (r >> 11) : 16;
        const float* sh = modv + (size_t)mb * NMOD + off_sh; const float* sc = modv + (size_t)mb * NMOD + off_sc;
        if (F8OUT) {
            float am = 0.f;
#pragma unroll
            for (int j = 0; j < 4; ++j) { const int e = j * 512 + lane * 8;
                const f32x4 s0 = *(const f32x4*)(sc + e), s1 = *(const f32x4*)(sc + e + 4), h0 = *(const f32x4*)(sh + e), h1 = *(const f32x4*)(sh + e + 4);
                v[j][0] = v[j][0] * rs * (s0 + 1.0f) + h0; v[j][1] = v[j][1] * rs * (s1 + 1.0f) + h1;
#pragma unroll
                for (int hh = 0; hh < 2; ++hh) am = fmaxf(am, fmaxf(fmaxf(fabsf(v[j][hh][0]), fabsf(v[j][hh][1])), fmaxf(fabsf(v[j][hh][2]), fabsf(v[j][hh][3])))); }
#pragma unroll
            for (int o = 32; o >= 1; o >>= 1) am = fmaxf(am, __shfl_xor(am, o));
            const float q = am > 0.f ? 240.0f / am : 1.0f;
            unsigned char* H8 = p.ws + OFF_H8 + (size_t)r * D;
#pragma unroll
            for (int j = 0; j < 4; ++j) { u32x2 w; w.x = pack_fp8x4(v[j][0][0] * q, v[j][0][1] * q, v[j][0][2] * q, v[j][0][3] * q); w.y = pack_fp8x4(v[j][1][0] * q, v[j][1][1] * q, v[j][1][2] * q, v[j][1][3] * q);
                *(u32x2*)(H8 + j * 512 + lane * 8) = w; }
            if (lane == 0) ((float*)(p.ws + OFF_HS))[r] = am > 0.f ? am * (1.0f / 240.0f) : 1.0f;
        } else {
#pragma unroll
        for (int j = 0; j < 4; ++j) {
            const int e = j * 512 + lane * 8;
            const f32x4 s0 = *(const f32x4*)(sc + e), s1 = *(const f32x4*)(sc + e + 4), h0 = *(const f32x4*)(sh + e), h1 = *(const f32x4*)(sh + e + 4);
            f32x4 a = v[j][0] * rs * (s0 + 1.0f) + h0, b = v[j][1] * rs * (s1 + 1.0f) + h1;
            u32x4 w; w.x = cvt_pk_bf16(a[0], a[1]); w.y = cvt_pk_bf16(a[2], a[3]); w.z = cvt_pk_bf16(b[0], b[1]); w.w = cvt_pk_bf16(b[2], b[3]);
            *(u32x4*)(H + (size_t)r * D + e) = w;
        }
        }
    }
}
__device__ __forceinline__ bf16x8 mk_bf16x8(unsigned a, unsigned b, unsigned c, unsigned d) { u32x4 q; q.x = a; q.y = b; q.z = c; q.w = d; return __builtin_bit_cast(bf16x8, q); }
__device__ __forceinline__ void phase_hgrn(const Params& p, int l, LAS unsigned char* lds, bool dry = false) {
    const int tid_ = otid();
    const int lane = tid_ & 63, w = __builtin_amdgcn_readfirstlane(tid_ >> 6), q = lane >> 4, m = lane & 15;
    constexpr int OQ = 0, OKH = 4352, OKT = 8704, OIT = 14848, OE = 20992, BUFSZ = 21504, RAWOFF = 2 * 21504, RAWSZ = 3 * 4352;
    unsigned char* P = p.ws + OFF_P;
    const float* lbp = (const float*)(p.ws + OFF_LB) + (size_t)l * 2048;
    const int kch = 16 * w + m;
    for (int u = blockIdx.x; u < 256; u += gridDim.x) {
        const int b = u >> 4, h = (u >> 1) & 7, dir = u & 1;
        const bf16_t* BQ = (const bf16_t*)(P + P_BQ); const bf16_t* BI = (const bf16_t*)(P + P_BI);
        bf16_t* BF = (bf16_t*)(P + (dir ? P_BFB : P_BFF));
        const float lbv = lbp[dir * 1024 + h * 128 + kch];
        f32x4 Sacc[8];
#pragma unroll
        for (int i = 0; i < 8; ++i) Sacc[i] = (f32x4){0.f, 0.f, 0.f, 0.f};
        for (int seg = 0; seg < 2; ++seg) {
            const int len = seg == 0 ? CTXL : SEQ, rbase = seg == 0 ? TL + b * CTXL : b * SEQ, nch = len / 16;
            u32x4 g0 = (u32x4){0u, 0u, 0u, 0u}, g1 = g0;
            const int gs = (tid_ & 255) >> 4, gc8 = (tid_ & 15) * 8;
#define HG_GLOAD(c) do { const int st = (c) * 16 + gs, n = dir ? (len - 1 - st) : st; const size_t o = (size_t)(rbase + n) * 1024 + h * 128 + gc8; \
                if (tid_ < 256) { g0 = *(const u32x4*)(BQ + o); g1 = *(const u32x4*)(BF + o); } else { g0 = *(const u32x4*)(BI + o); } } while (0)
#define HG_RAWW(c) do { LAS unsigned char* rw = lds + RAWOFF + ((c) & 1) * RAWSZ + gs * 272 + gc8 * 2; \
                if (tid_ < 256) { *(LAS u32x4*)(rw) = g0; *(LAS u32x4*)(rw + 4352) = g1; } else { *(LAS u32x4*)(rw + 8704) = g0; } } while (0)
#define HG_STAGE(c, bufp) do { float fv[4], cb[4]; float run = 0.f; unsigned short rq[4], rf[4], ri[4]; \
                { const LAS unsigned char* rr = lds + RAWOFF + ((c) & 1) * RAWSZ + kch * 2; _Pragma("unroll") for (int j = 0; j < 4; ++j) { rq[j] = *(const LAS bf16_t*)(rr + (4 * q + j) * 272); rf[j] = *(const LAS bf16_t*)(rr + 4352 + (4 * q + j) * 272); ri[j] = *(const LAS bf16_t*)(rr + 8704 + (4 * q + j) * 272); } } \
                _Pragma("unroll") for (int j = 0; j < 4; ++j) { const float xf = __uint_as_float(((unsigned)rf[j]) << 16); fv[j] = lbv + (1.0f - lbv) * fast_sigmoid(xf); run += flog(fv[j]); cb[j] = run; } \
                const float t0 = __shfl(run, m), t1 = __shfl(run, m + 16), t2 = __shfl(run, m + 32); \
                const float off = (q > 0 ? t0 : 0.f) + (q > 1 ? t1 : 0.f) + (q > 2 ? t2 : 0.f); \
                float qh[4], kh[4]; \
                _Pragma("unroll") for (int j = 0; j < 4; ++j) { const float bb = off + cb[j], bc = fmaxf(bb, -80.0f); qh[j] = __uint_as_float(((unsigned)rq[j]) << 16) * fexp(bc); kh[j] = (1.0f - fv[j]) * fexp(-bc);     \
                    if (j == 3 && q == 3) *(LAS float*)((bufp) + OE + kch * 4) = fexp(bb); } \
                const unsigned q01 = cvt_pk_bf16(qh[0], qh[1]), q23 = cvt_pk_bf16(qh[2], qh[3]), k01 = cvt_pk_bf16(kh[0], kh[1]), k23 = cvt_pk_bf16(kh[2], kh[3]); \
                *(LAS bf16_t*)((bufp) + OQ + (4 * q + 0) * 272 + kch * 2) = (bf16_t)(q01 & 0xffffu); *(LAS bf16_t*)((bufp) + OQ + (4 * q + 1) * 272 + kch * 2) = (bf16_t)(q01 >> 16); \
                *(LAS bf16_t*)((bufp) + OQ + (4 * q + 2) * 272 + kch * 2) = (bf16_t)(q23 & 0xffffu); *(LAS bf16_t*)((bufp) + OQ + (4 * q + 3) * 272 + kch * 2) = (bf16_t)(q23 >> 16); \
                *(LAS bf16_t*)((bufp) + OKH + (4 * q + 0) * 272 + kch * 2) = (bf16_t)(k01 & 0xffffu); *(LAS bf16_t*)((bufp) + OKH + (4 * q + 1) * 272 + kch * 2) = (bf16_t)(k01 >> 16); \
                *(LAS bf16_t*)((bufp) + OKH + (4 * q + 2) * 272 + kch * 2) = (bf16_t)(k23 & 0xffffu); *(LAS bf16_t*)((bufp) + OKH + (4 * q + 3) * 272 + kch * 2) = (bf16_t)(k23 >> 16); \
                u32x2 kt2; kt2.x = k01; kt2.y = k23; *(LAS u32x2*)((bufp) + OKT + kch * 48 + q * 8) = kt2; \
                u32x2 it2; it2.x = (unsigned)ri[0] | ((unsigned)ri[1] << 16); it2.y = (unsigned)ri[2] | ((unsigned)ri[3] << 16); *(LAS u32x2*)((bufp) + OIT + kch * 48 + q * 8) = it2; } while (0)
#define HG_COMPUTE(c) do { \
                LAS unsigned char* buf = lds + ((c) & 1) * BUFSZ; \
                f32x4 at = (f32x4){0.f, 0.f, 0.f, 0.f}; \
                _Pragma("unroll") \
                for (int kb = 0; kb < 4; ++kb) { const bf16x8 a = *(const LAS bf16x8*)(buf + OKH + m * 272 + kb * 64 + q * 16), bq = *(const LAS bf16x8*)(buf + OQ + m * 272 + kb * 64 + q * 16); \
                    at = __builtin_amdgcn_mfma_f32_16x16x32_bf16(a, bq, at, 0, 0, 0); } \
                asm volatile("s_nop 15\n s_nop 15" : "+v"(at)); \
                _Pragma("unroll") \
                for (int r = 0; r < 4; ++r) at[r] = (4 * q + r <= m) ? at[r] : 0.f; \
                const bf16x8 attB = mk_bf16x8(cvt_pk_bf16(at[0], at[1]), cvt_pk_bf16(at[2], at[3]), 0u, 0u); \
                f32x4 oacc = (f32x4){0.f, 0.f, 0.f, 0.f}; \
                _Pragma("unroll") \
                for (int kb = 0; kb < 4; ++kb) { \
                    const bf16x8 a = mk_bf16x8(cvt_pk_bf16(Sacc[2 * kb][0], Sacc[2 * kb][1]), cvt_pk_bf16(Sacc[2 * kb][2], Sacc[2 * kb][3]), cvt_pk_bf16(Sacc[2 * kb + 1][0], Sacc[2 * kb + 1][1]), cvt_pk_bf16(Sacc[2 * kb + 1][2], Sacc[2 * kb + 1][3])); \
                    const u32x2 b0 = *(const LAS u32x2*)(buf + OQ + m * 272 + (32 * kb + 4 * q) * 2), b1 = *(const LAS u32x2*)(buf + OQ + m * 272 + (32 * kb + 16 + 4 * q) * 2); \
                    oacc = __builtin_amdgcn_mfma_f32_16x16x32_bf16(a, mk_bf16x8(b0.x, b0.y, b1.x, b1.y), oacc, 0, 0, 0); } \
                { const u32x2 i0 = *(const LAS u32x2*)(buf + OIT + (16 * w + m) * 48 + q * 8); \
                  oacc = __builtin_amdgcn_mfma_f32_16x16x32_bf16(mk_bf16x8(i0.x, i0.y, 0u, 0u), attB, oacc, 0, 0, 0); } \
                asm volatile("s_nop 15\n s_nop 15" : "+v"(oacc)); \
                { const int st = (c) * 16 + m, n = dir ? (len - 1 - st) : st; \
                  u32x2 o2; o2.x = cvt_pk_bf16(oacc[0], oacc[1]); o2.y = cvt_pk_bf16(oacc[2], oacc[3]); \
                  if (!dry || p.ws == nullptr) *(u32x2*)(BF + (size_t)(rbase + n) * 1024 + h * 128 + 16 * w + 4 * q) = o2; } \
                u32x4 bsu = (u32x4){0u, 0u, 0u, 0u}; \
                if (q < 2) bsu = *(const LAS u32x4*)(buf + OIT + (16 * w + m) * 48 + q * 16); \
                const bf16x8 bs = __builtin_bit_cast(bf16x8, bsu); \
                _Pragma("unroll") \
                for (int kt = 0; kt < 8; ++kt) { u32x4 au = (u32x4){0u, 0u, 0u, 0u}; \
                    if (q < 2) au = *(const LAS u32x4*)(buf + OKT + (16 * kt + m) * 48 + q * 16); \
                    Sacc[kt] = __builtin_amdgcn_mfma_f32_16x16x32_bf16(__builtin_bit_cast(bf16x8, au), bs, Sacc[kt], 0, 0, 0); } \
                asm volatile("s_nop 15\n s_nop 15" : "+v"(Sacc[0]), "+v"(Sacc[1]), "+v"(Sacc[2]), "+v"(Sacc[3]), "+v"(Sacc[4]), "+v"(Sacc[5]), "+v"(Sacc[6]), "+v"(Sacc[7])); \
                _Pragma("unroll") \
                for (int kt = 0; kt < 8; ++kt) Sacc[kt] *= *(const LAS f32x4*)(buf + OE + (16 * kt + 4 * q) * 4); \
                } while (0)
            HG_GLOAD(0); HG_RAWW(0);
            if (nch > 1) { HG_GLOAD(1); HG_RAWW(1); }
            if (nch > 2) HG_GLOAD(2);
            __syncthreads();
            HG_STAGE(0, lds);
            __syncthreads();
            for (int c = 0; c < nch; ++c) {
                if (c + 2 < nch) { HG_RAWW(c + 2); if (c + 3 < nch) HG_GLOAD(c + 3); }
                if (c + 1 < nch) HG_STAGE(c + 1, lds + ((c + 1) & 1) * BUFSZ);
                HG_COMPUTE(c);
                __syncthreads();
            }
#undef HG_COMPUTE
#undef HG_GLOAD
#undef HG_RAWW
#undef HG_STAGE
        }
        __syncthreads();
    }
}
__device__ __forceinline__ void phase_hcomb(const Params& p, int l, int M, bool dry = false) {
    const int tid_ = otid();
    const int lane = tid_ & 63, gw = blockIdx.x * 8 + __builtin_amdgcn_readfirstlane(tid_ >> 6), nw = gridDim.x * 8;
    unsigned char* P = p.ws + OFF_P;
    bf16_t* OF = (bf16_t*)(P + P_BFF); const bf16_t* OB = (const bf16_t*)(P + P_BFB); const bf16_t* BG = (const bf16_t*)(P + P_BG);
    const float* hg = p.hn_g + (size_t)l * 1024 + lane * 16;
    for (int r = gw; r < M; r += nw) {
        const size_t o = (size_t)r * 1024 + lane * 16;
        float x[16]; float ss = 0.f;
#pragma unroll
        for (int hh = 0; hh < 2; ++hh) { const u32x4 a = *(const u32x4*)(OF + o + hh * 8), bq = *(const u32x4*)(OB + o + hh * 8);
            const unsigned aa[4] = {a.x, a.y, a.z, a.w}, bb[4] = {bq.x, bq.y, bq.z, bq.w};
#pragma unroll
            for (int j = 0; j < 4; ++j) { x[hh * 8 + 2 * j] = bf_lo(aa[j]) + bf_lo(bb[j]); x[hh * 8 + 2 * j + 1] = bf_hi(aa[j]) + bf_hi(bb[j]); } }
#pragma unroll
        for (int j = 0; j < 16; ++j) ss += x[j] * x[j];
        ss += __shfl_xor(ss, 1); ss += __shfl_xor(ss, 2); ss += __shfl_xor(ss, 4);
        const float rs = rsqrtf(ss * (1.0f / 128.0f) + 1e-6f);
#pragma unroll
        for (int hh = 0; hh < 2; ++hh) { const u32x4 gq = *(const u32x4*)(BG + o + hh * 8); const unsigned gg[4] = {gq.x, gq.y, gq.z, gq.w};
            float y[8];
#pragma unroll
            for (int j = 0; j < 4; ++j) { y[2 * j] = x[hh * 8 + 2 * j] * rs * hg[hh * 8 + 2 * j] * bf_lo(gg[j]); y[2 * j + 1] = x[hh * 8 + 2 * j + 1] * rs * hg[hh * 8 + 2 * j + 1] * bf_hi(gg[j]); }
            u32x4 w; w.x = cvt_pk_bf16(y[0], y[1]); w.y = cvt_pk_bf16(y[2], y[3]); w.z = cvt_pk_bf16(y[4], y[5]); w.w = cvt_pk_bf16(y[6], y[7]);
            if (!dry || p.ws == nullptr) *(u32x4*)(OF + o + hh * 8) = w; }
    }
}

__device__ __forceinline__ bf16x8 pack_bf16x8(const float (&v)[8]) {
    const unsigned a = cvt_pk_bf16(v[0], v[1]), b = cvt_pk_bf16(v[2], v[3]), c = cvt_pk_bf16(v[4], v[5]), d = cvt_pk_bf16(v[6], v[7]);
    u32x4 q; q.x = a; q.y = b; q.z = c; q.w = d;
    return __builtin_bit_cast(bf16x8, q);
}
__device__ __forceinline__ void phase_s5(const Params& p, int l, LAS unsigned char* lds) {
    const int tid_ = otid();
    const int lane = tid_ & 63, w = __builtin_amdgcn_readfirstlane(tid_ >> 6);
    if (w >= 6) return;
    LAS float* BU = (LAS float*)(lds + w * 12800);
    LAS unsigned char* XB = lds + w * 12800 + 8448;
    const int lq = lane >> 4, lr = lane & 15;
    const bf16_t* CU = (const bf16_t*)(p.ws + OFF_P + P_CU);
    const float* s5lam = (const float*)(p.ws + OFF_S5LAM); const float* s5bb = (const float*)(p.ws + OFF_S5BB);
    for (int s = w * (int)gridDim.x + (int)blockIdx.x; s < 1536; s += 6 * (int)gridDim.x) {
        const int dir = s & 1, g = (s >> 1) % 48, b = s / 96;
        const int ldg = (l * 2 + dir) * 48 + g;
        const float lre = s5lam[(size_t)(ldg * 64 + lane) * 2], lim = s5lam[(size_t)(ldg * 64 + lane) * 2 + 1];
        bf16x8 bbf[8], cf[4];
#pragma unroll
        for (int nt = 0; nt < 8; ++nt) { const int col = nt * 16 + lr, pp = col >> 1, c = col & 1; float v[8];
#pragma unroll
            for (int j = 0; j < 8; ++j) v[j] = (lq < 2) ? s5bb[(size_t)(ldg * 64 + pp) * 32 + c * 16 + lq * 8 + j] : 0.f;
            bbf[nt] = pack_bf16x8(v); }
#pragma unroll
        for (int kb = 0; kb < 4; ++kb) { float v[8];
#pragma unroll
            for (int j = 0; j < 8; ++j) { const int k = kb * 32 + lq * 8 + j, pp = k >> 1; const size_t ci = ((size_t)ldg * 16 + lr) * 64 + pp;
                v[j] = (k & 1) ? -p.c_im[ci] : p.c_re[ci]; }
            cf[kb] = pack_bf16x8(v); }
        bf16_t* YS = (bf16_t*)(p.ws + OFF_H + (dir ? H_YSB : H_YSF));
        float xr = 0.f, xi = 0.f;
        for (int seg = 0; seg < 2; ++seg) {
            const int len = seg == 0 ? CTXL : SEQ, rbase = seg == 0 ? TL + b * CTXL : b * SEQ, nblk = len / 64;
            u32x4 unext[4];
#pragma unroll
            for (int tt = 0; tt < 4; ++tt) { unext[tt] = (u32x4){0u, 0u, 0u, 0u};
                if (lq < 2) { const int st = tt * 16 + lr, n = dir ? (len - 1 - st) : st; unext[tt] = *(const u32x4*)(CU + (size_t)(rbase + n) * 768 + g * 16 + lq * 8); } }
            for (int blk = 0; blk < nblk; ++blk) {
                u32x4 ucur[4];
#pragma unroll
                for (int tt = 0; tt < 4; ++tt) ucur[tt] = unext[tt];
                if (blk + 1 < nblk && lq < 2) {
#pragma unroll
                    for (int tt = 0; tt < 4; ++tt) { const int st = (blk + 1) * 64 + tt * 16 + lr, n = dir ? (len - 1 - st) : st; unext[tt] = *(const u32x4*)(CU + (size_t)(rbase + n) * 768 + g * 16 + lq * 8); } }
#pragma unroll
                for (int tt = 0; tt < 4; ++tt) {
                    const bf16x8 uf = __builtin_bit_cast(bf16x8, ucur[tt]);
                    f32x4 dd[8];
#pragma unroll
                    for (int nt = 0; nt < 8; ++nt) dd[nt] = __builtin_amdgcn_mfma_f32_16x16x32_bf16(bbf[nt], uf, (f32x4){0.f, 0.f, 0.f, 0.f}, 0, 0, 0);
                    asm volatile("s_nop 15\n s_nop 15" : "+v"(dd[0]), "+v"(dd[1]), "+v"(dd[2]), "+v"(dd[3]), "+v"(dd[4]), "+v"(dd[5]), "+v"(dd[6]), "+v"(dd[7]));
#pragma unroll
                    for (int nt = 0; nt < 8; ++nt) *(LAS f32x4*)(BU + lr * 132 + nt * 16 + lq * 4) = dd[nt];
                    asm volatile("s_waitcnt lgkmcnt(0)" ::: "memory");
                    f32x2 bu[16];
#pragma unroll
                    for (int t = 0; t < 16; ++t) bu[t] = *(const LAS f32x2*)(BU + t * 132 + 2 * lane);
#pragma unroll
                    for (int t = 0; t < 16; ++t) { const float nr = lre * xr - lim * xi + bu[t].x, ni = lre * xi + lim * xr + bu[t].y; xr = nr; xi = ni;
                        *(LAS unsigned*)(XB + t * 272 + lane * 4) = cvt_pk_bf16(xr, xi); }
                    asm volatile("s_waitcnt lgkmcnt(0)" ::: "memory");
                    f32x4 acc = (f32x4){0.f, 0.f, 0.f, 0.f};
#pragma unroll
                    for (int kb = 0; kb < 4; ++kb) { const bf16x8 xf = *(const LAS bf16x8*)(XB + lr * 272 + kb * 64 + lq * 16); acc = __builtin_amdgcn_mfma_f32_16x16x32_bf16(cf[kb], xf, acc, 0, 0, 0); }
                    asm volatile("s_nop 15\n s_nop 15\n s_waitcnt lgkmcnt(0)" : "+v"(acc) :: "memory");
                    const int st = blk * 64 + tt * 16 + lr, n = dir ? (len - 1 - st) : st;
                    u32x2 o; o.x = cvt_pk_bf16(acc[0], acc[1]); o.y = cvt_pk_bf16(acc[2], acc[3]);
                    *(u32x2*)(YS + (size_t)(rbase + n) * 768 + g * 16 + lq * 4) = o;
                }
            }
        }
    }
}
__device__ __forceinline__ void phase_s5post(const Params& p, int l, int M, bool dry = false) {
    const int tid_ = otid();
    const size_t n8 = (size_t)M * 768 / 8;
    bf16_t* YF = (bf16_t*)(p.ws + OFF_H + H_YSF); const bf16_t* YB = (const bf16_t*)(p.ws + OFF_H + H_YSB); const bf16_t* CU = (const bf16_t*)(p.ws + OFF_P + P_CU);
    const float* dsk = p.s5_d + (size_t)l * 768;
    for (size_t i = (size_t)blockIdx.x * NTHREADS + tid_; i < n8; i += (size_t)gridDim.x * NTHREADS) {
        const int c = (int)((i * 8) % 768);
        const u32x4 a = *(const u32x4*)(YF + i * 8), bq = *(const u32x4*)(YB + i * 8), uq = *(const u32x4*)(CU + i * 8);
        const unsigned aa[4] = {a.x, a.y, a.z, a.w}, bb[4] = {bq.x, bq.y, bq.z, bq.w}, uu[4] = {uq.x, uq.y, uq.z, uq.w};
        float y[8];
#pragma unroll
        for (int j = 0; j < 4; ++j) { y[2 * j] = gelu_f(bf_lo(aa[j]) + bf_lo(bb[j]) + dsk[c + 2 * j] * bf_lo(uu[j])); y[2 * j + 1] = gelu_f(bf_hi(aa[j]) + bf_hi(bb[j]) + dsk[c + 2 * j + 1] * bf_hi(uu[j])); }
        u32x4 w; w.x = cvt_pk_bf16(y[0], y[1]); w.y = cvt_pk_bf16(y[2], y[3]); w.z = cvt_pk_bf16(y[4], y[5]); w.w = cvt_pk_bf16(y[6], y[7]);
        if (!dry || p.ws == nullptr) *(u32x4*)(YF + i * 8) = w;
    }
}

__device__ __forceinline__ void phase_gmlp(const Params& p, int l, int M, LAS unsigned char* lds, bool dry = false) {
    const int tid_ = otid();
    LAS unsigned char* Wb = lds;
    LAS unsigned char* Vt = lds + 34816;
    LAS float* st = (LAS float*)(lds + 69632);
    const int tid = tid_, lane = tid & 63, w = __builtin_amdgcn_readfirstlane(tid_ >> 6), q = lane >> 4, m = lane & 15;
    bf16_t* AU = (bf16_t*)(p.ws + OFF_P + P_AU); const bf16_t* AV = (const bf16_t*)(p.ws + OFF_P + P_AV);
    const float* lng = p.ln_g + (size_t)l * 1024; const float* lnb = p.ln_b + (size_t)l * 1024;
    const int nch = M / 128, G_ = (int)gridDim.x, nfull = (nch / G_) * G_, nitem = nfull + (nch - nfull) * 8;
    for (int it = blockIdx.x; it < nitem; it += G_) {
        const int u = it < nfull ? it : nfull + ((it - nfull) >> 3), g0 = it < nfull ? 0 : ((it - nfull) & 7), g1 = it < nfull ? 8 : g0 + 1;
        const size_t r0 = (size_t)u * 128;
        for (int i = 0; i < 16; ++i) {
            const int s = w * 16 + i; const bf16_t* rp = AV + (r0 + s) * 1024 + lane * 16;
            const u32x4 a = *(const u32x4*)rp, bq = *(const u32x4*)(rp + 8);
            const unsigned aa[8] = {a.x, a.y, a.z, a.w, bq.x, bq.y, bq.z, bq.w};
            float sm = 0.f, sq = 0.f;
#pragma unroll
            for (int j = 0; j < 8; ++j) { const float x0 = bf_lo(aa[j]), x1 = bf_hi(aa[j]); sm += x0 + x1; sq += x0 * x0 + x1 * x1; }
            sm = wave_sum(sm); sq = wave_sum(sq);
            const float mean = sm * (1.0f / 1024.0f), var = fmaxf(sq * (1.0f / 1024.0f) - mean * mean, 0.f);
            if (lane == 0) { st[s * 2] = mean; st[s * 2 + 1] = rsqrtf(var + 1e-6f); }
        }
        __syncthreads();
        for (int g = g0; g < g1; ++g) {
            { const int t = tid >> 2, s0 = (tid & 3) * 32; const float* ws = p.w_s + ((size_t)l * 8 + g) * 16384 + t * 128 + s0;
#pragma unroll
              for (int qq = 0; qq < 4; ++qq) { const f32x4 a = *(const f32x4*)(ws + qq * 8), b4 = *(const f32x4*)(ws + qq * 8 + 4);
                  u32x4 o; o.x = cvt_pk_bf16(a[0], a[1]); o.y = cvt_pk_bf16(a[2], a[3]); o.z = cvt_pk_bf16(b4[0], b4[1]); o.w = cvt_pk_bf16(b4[2], b4[3]);
                  *(LAS u32x4*)(Wb + t * 272 + (s0 + qq * 8) * 2) = o; } }
            { const int s = tid >> 2, c0 = (tid & 3) * 32; const bf16_t* rp = AV + (r0 + s) * 1024 + g * 128 + c0;
              const float mean = st[s * 2], rstd = st[s * 2 + 1];
#pragma unroll
              for (int qq = 0; qq < 4; ++qq) { const u32x4 a = *(const u32x4*)(rp + qq * 8); const unsigned aa[4] = {a.x, a.y, a.z, a.w};
#pragma unroll
                  for (int j = 0; j < 4; ++j) { const int cl = c0 + qq * 8 + 2 * j, c = g * 128 + cl;
                      const unsigned pk = cvt_pk_bf16((bf_lo(aa[j]) - mean) * rstd * lng[c] + lnb[c], (bf_hi(aa[j]) - mean) * rstd * lng[c + 1] + lnb[c + 1]);
                      *(LAS bf16_t*)(Vt + cl * 272 + s * 2) = (bf16_t)(pk & 0xffffu); *(LAS bf16_t*)(Vt + (cl + 1) * 272 + s * 2) = (bf16_t)(pk >> 16); } } }
            __syncthreads();
            bf16x8 af[4];
#pragma unroll
            for (int kb = 0; kb < 4; ++kb) af[kb] = *(const LAS bf16x8*)(Vt + (16 * w + m) * 272 + kb * 64 + q * 16);
            const float* bs = p.b_s + ((size_t)l * 8 + g) * 128;
#pragma unroll
            for (int tt = 0; tt < 8; ++tt) {
                f32x4 acc = (f32x4){0.f, 0.f, 0.f, 0.f};
#pragma unroll
                for (int kb = 0; kb < 4; ++kb) acc = __builtin_amdgcn_mfma_f32_16x16x32_bf16(af[kb], *(const LAS bf16x8*)(Wb + (16 * tt + m) * 272 + kb * 64 + q * 16), acc, 0, 0, 0);
                const float bb = bs[16 * tt + m];
                bf16_t* up = AU + (r0 + 16 * tt + m) * 1024 + g * 128 + 16 * w + 4 * q;
                const u32x2 uw = *(const u32x2*)up;
                const float y0 = (acc[0] + bb) * bf_lo(uw.x), y1 = (acc[1] + bb) * bf_hi(uw.x), y2 = (acc[2] + bb) * bf_lo(uw.y), y3 = (acc[3] + bb) * bf_hi(uw.y);
                u32x2 o; o.x = cvt_pk_bf16(y0, y1); o.y = cvt_pk_bf16(y2, y3);
                if (!dry || p.ws == nullptr) *(u32x2*)up = o;
            }
            __syncthreads();
        }
    }
}

__device__ __forceinline__ unsigned fkey(float x) { const unsigned b = __float_as_uint(x); return b ^ ((b >> 31) ? 0xFFFFFFFFu : 0x80000000u); }
__device__ __forceinline__ int mbcnt64(unsigned long long m) { return __builtin_amdgcn_mbcnt_hi((unsigned)(m >> 32), __builtin_amdgcn_mbcnt_lo((unsigned)m, 0u)); }
template <int NV>
__device__ __forceinline__ int count_ge(const unsigned (&k)[NV], unsigned cand) {
    int cnt = 0;
#pragma unroll
    for (int i = 0; i < NV; ++i) cnt += __popcll(__ballot(k[i] >= cand));
    return cnt;
}
template <int NV>
__device__ __forceinline__ unsigned radix_thr16(const unsigned (&k)[NV], unsigned e0bits) {
    unsigned prefix = 0u; int bit = 31;
    {
        const unsigned c0 = e0bits ^ 0x80000000u, c1 = c0 + 0x00800000u, c2 = c0 + 0x01000000u, c3 = c0 + 0x01800000u;
        const int n0 = count_ge<NV>(k, c0), n1 = count_ge<NV>(k, c1), n2 = count_ge<NV>(k, c2), n3 = count_ge<NV>(k, c3);
        if (n0 >= 16 && n3 < 16) { prefix = (n2 >= 16) ? c2 : ((n1 >= 16) ? c1 : c0); bit = 22;
            const int nn = (n2 >= 16) ? n2 : ((n1 >= 16) ? n1 : n0); if (nn == 16) bit = -1; }
    }
    for (; bit >= 0; --bit) {
        const unsigned cand = prefix | (1u << bit);
        const int cnt = count_ge<NV>(k, cand);
        if (cnt >= 16) prefix = cand;
        if (cnt == 16) break;
    }
    return prefix;
}
__device__ __forceinline__ unsigned umin_(unsigned a, unsigned b) { return a < b ? a : b; }
__device__ __forceinline__ unsigned umax_(unsigned a, unsigned b) { return a > b ? a : b; }
__device__ __forceinline__ unsigned med3u(unsigned x, unsigned y, unsigned z) { return umax_(umin_(x, y), umin_(umax_(x, y), z)); }
__device__ __forceinline__ float unkey(unsigned k) { return __uint_as_float((k & 0x80000000u) ? (k ^ 0x80000000u) : ~k); }
__device__ __forceinline__ void ins16(unsigned (&a)[16], unsigned x) {
#pragma unroll
    for (int s = 15; s >= 1; --s) a[s] = med3u(a[s - 1], x, a[s]);
    a[0] = umax_(a[0], x);
}
__device__ __forceinline__ unsigned sel16(const unsigned (&a)[16], int i) {
    unsigned r = a[0];
#pragma unroll
    for (int t = 1; t < 16; ++t) r = (i == t) ? a[t] : r;
    return r;
}
__device__ __forceinline__ void phase_topk(const Params& p, int M, LAS unsigned char* lds) {
    const int tid_ = otid();
    LAS unsigned* lk = (LAS unsigned*)lds + tid_;
    const int gl = blockIdx.x * NTHREADS + tid_, nl = gridDim.x * NTHREADS;
    const float* SC = (const float*)(p.ws + OFF_P + Q_SC);
    int* IDX = (int*)(p.ws + OFF_P + Q_IDX); float* GATE = (float*)(p.ws + OFF_P + Q_GATE);
    const int ntask = M * 8;
    for (int task = gl; task < ntask; task += nl) {
        const float* sc = SC + (size_t)task * 256;
        unsigned a[16], b[16];
#pragma unroll
        for (int i = 0; i < 16; ++i) { a[i] = 0u; b[i] = 0u; }
#pragma unroll 4
        for (int i4 = 0; i4 < 32; ++i4) {
            const f32x4 va = *(const f32x4*)(sc + i4 * 4), vb = *(const f32x4*)(sc + 128 + i4 * 4);
#pragma unroll
            for (int e = 0; e < 4; ++e) { const unsigned tag = 127u - (unsigned)(i4 * 4 + e);
                ins16(a, (fkey(va[e]) & ~127u) | tag); ins16(b, (fkey(vb[e]) & ~127u) | tag); }
        }
        float fa[16], fb[16];
#pragma unroll
        for (int i = 0; i < 16; ++i) { fa[i] = unkey(a[i] & ~127u); fb[i] = unkey(b[i] & ~127u); }
        unsigned c[16];
#pragma unroll
        for (int i = 0; i < 16; ++i) c[i] = 0u;
#pragma unroll
        for (int i = 0; i < 16; ++i)
#pragma unroll
            for (int j = 0; j < 16; ++j)
                if ((i + 1) * (j + 1) <= 16) ins16(c, (fkey(fa[i] + fb[j]) & ~255u) | (unsigned)(i * 16 + j));
#pragma unroll
        for (int i = 0; i < 16; ++i) { lk[i * 512] = a[i]; lk[(16 + i) * 512] = b[i]; }
        const float mx = unkey(c[0] & ~255u);
        float ev[16]; float sm = 0.f; int id[16];
#pragma unroll
        for (int s = 0; s < 16; ++s) { ev[s] = __expf(unkey(c[s] & ~255u) - mx); sm += ev[s];
            const int ij = (int)(c[s] & 255u);
            const unsigned ka = lk[(ij >> 4) * 512], kb = lk[(16 + (ij & 15)) * 512];
            id[s] = (int)(127u - (ka & 127u)) * 128 + (int)(127u - (kb & 127u)); }
        const float inv = 1.0f / sm;
#pragma unroll
        for (int q = 0; q < 4; ++q) {
            u32x4 iw; iw.x = (unsigned)id[4 * q]; iw.y = (unsigned)id[4 * q + 1]; iw.z = (unsigned)id[4 * q + 2]; iw.w = (unsigned)id[4 * q + 3];
            *(u32x4*)(IDX + (size_t)task * 16 + q * 4) = iw;
            *(f32x4*)(GATE + (size_t)task * 16 + q * 4) = (f32x4){ev[4 * q] * inv, ev[4 * q + 1] * inv, ev[4 * q + 2] * inv, ev[4 * q + 3] * inv};
        }
    }
}

__device__ __forceinline__ float dot2u(unsigned a, unsigned b, float acc) {
    return __builtin_amdgcn_fdot2_f32_bf16(__builtin_bit_cast(bf16x2_t, a), __builtin_bit_cast(bf16x2_t, b), acc, false);
}
__device__ __forceinline__ float dot8(const u32x4 a, const u32x4 b, float acc) {
    acc = dot2u(a.x, b.x, acc); acc = dot2u(a.y, b.y, acc); acc = dot2u(a.z, b.z, acc); acc = dot2u(a.w, b.w, acc);
    return acc;
}
__device__ __forceinline__ void phase_peer(const Params& p, int l, int M, LAS unsigned char* lds, bool dry = false) {
    const int tid_ = otid();
    const int lane = tid_ & 63, wv_ = __builtin_amdgcn_readfirstlane(tid_ >> 6), gw = blockIdx.x * 8 + wv_, nw = gridDim.x * 8;
    LAS float* wl = (LAS float*)(lds + wv_ * 512);
    const bf16_t* H = (const bf16_t*)(p.ws + OFF_H);
    const unsigned char* U6 = p.ws + OFF_P + Q_UT; const unsigned char* V6 = p.ws + OFF_P + Q_VT;
    const float* USC = (const float*)(p.ws + OFF_P + Q_USC); const float* VSC = (const float*)(p.ws + OFF_P + Q_VSC);
    const int* IDX = (const int*)(p.ws + OFF_P + Q_IDX); const float* GATE = (const float*)(p.ws + OFF_P + Q_GATE);
    const float* modl = (const float*)(p.ws + OFF_MODV) + (size_t)l * 17 * NMOD + 10240;
    float* XC = (float*)(p.ws + OFF_XC);
    const unsigned lane24 = (unsigned)lane * 24u, lane16 = (unsigned)lane * 16u;
#define PEER_LOAD(buf, TAB, g) do { const int _is = ((g) < 8) ? id0 : id1; _Pragma("unroll") for (int e = 0; e < 8; ++e) { \
        const int _id = __builtin_amdgcn_readlane(_is, (((g) * 8 + e) & 63)); const unsigned char* _rb = (TAB) + (size_t)(unsigned)_id * 1536u; \
        const u32x4 _a = *(const u32x4*)(_rb + lane24); const u32x2 _b = *(const u32x2*)(_rb + lane24 + 16); \
        buf[e][0] = _a.x; buf[e][1] = _a.y; buf[e][2] = _a.z; buf[e][3] = _a.w; buf[e][4] = _b.x; buf[e][5] = _b.y; } } while (0)
    for (int row = gw; row < M; row += nw) {
        unsigned xw[16];
#pragma unroll
        for (int j = 0; j < 8; ++j) { const u32x2 a = *(const u32x2*)(H + (size_t)row * D + j * 256 + lane * 4); xw[2 * j] = a.x; xw[2 * j + 1] = a.y; }
        const int id0 = IDX[(size_t)row * 128 + lane], id1 = IDX[(size_t)row * 128 + 64 + lane];
        const float g0 = GATE[(size_t)row * 128 + lane], g1 = GATE[(size_t)row * 128 + 64 + lane];
        const float us0 = USC[id0], us1 = USC[id1];
        const float gv0 = g0 * VSC[id0], gv1 = g1 * VSC[id1];
#pragma unroll 1
        for (int g = 0; g < 8; ++g) {
            u32x4 bU[16];
            { const int _is = (g < 4) ? id0 : id1;
#pragma unroll
              for (int e = 0; e < 16; ++e) { const int _id = __builtin_amdgcn_readlane(_is, ((g * 16 + e) & 63)); bU[e] = *(const u32x4*)(U6 + (size_t)(unsigned)_id * 1024u + lane16); } }
            float part[16];
            float chain = 0.f;
#pragma unroll
            for (int e = 0; e < 16; ++e) { asm volatile("" : "+v"(bU[e]), "+v"(chain));
                const unsigned wd[4] = {bU[e].x, bU[e].y, bU[e].z, bU[e].w};
                float a0 = 0.f, a1 = 0.f;
#pragma unroll
                for (int d = 0; d < 4; ++d) {
                    a0 = dot2u(__builtin_bit_cast(unsigned, __builtin_amdgcn_cvt_scalef32_pk_bf16_fp4(wd[d], 1.0f, 0)), xw[4 * d + 0], a0);
                    a1 = dot2u(__builtin_bit_cast(unsigned, __builtin_amdgcn_cvt_scalef32_pk_bf16_fp4(wd[d], 1.0f, 1)), xw[4 * d + 1], a1);
                    a0 = dot2u(__builtin_bit_cast(unsigned, __builtin_amdgcn_cvt_scalef32_pk_bf16_fp4(wd[d], 1.0f, 2)), xw[4 * d + 2], a0);
                    a1 = dot2u(__builtin_bit_cast(unsigned, __builtin_amdgcn_cvt_scalef32_pk_bf16_fp4(wd[d], 1.0f, 3)), xw[4 * d + 3], a1); }
                part[e] = a0 + a1; chain = part[e]; }
            float r8[8];
#pragma unroll
            for (int i = 0; i < 8; ++i) { const bool hi = (lane & 32) != 0; const float keep = hi ? part[i + 8] : part[i], send = hi ? part[i] : part[i + 8]; r8[i] = keep + __shfl_xor(send, 32); }
            float r4[4];
#pragma unroll
            for (int i = 0; i < 4; ++i) { const bool hi = (lane & 16) != 0; const float keep = hi ? r8[i + 4] : r8[i], send = hi ? r8[i] : r8[i + 4]; r4[i] = keep + __shfl_xor(send, 16); }
            float r2[2];
#pragma unroll
            for (int i = 0; i < 2; ++i) { const bool hi = (lane & 8) != 0; const float keep = hi ? r4[i + 2] : r4[i], send = hi ? r4[i] : r4[i + 2]; r2[i] = keep + __shfl_xor(send, 8); }
            float r1;
            { const bool hi = (lane & 4) != 0; const float keep = hi ? r2[1] : r2[0], send = hi ? r2[0] : r2[1]; r1 = keep + __shfl_xor(send, 4); }
            r1 += __shfl_xor(r1, 2); r1 += __shfl_xor(r1, 1);
            const int k = g * 16 + ((lane >> 2) & 15);
            const float usk = __shfl((g < 4) ? us0 : us1, k & 63), gvk = __shfl((g < 4) ? gv0 : gv1, k & 63);
            if ((lane & 3) == 0) wl[k] = gelu_f(r1 * usk) * gvk;
        }
        asm volatile("s_waitcnt lgkmcnt(0)" ::: "memory");
        h16x2 oh[16];
#pragma unroll
        for (int i = 0; i < 16; ++i) oh[i] = (h16x2){(_Float16)0.f, (_Float16)0.f};
#pragma unroll 1
        for (int g = 0; g < 8; ++g) {
            u32x4 bV[16];
            { const int _is = (g < 4) ? id0 : id1;
#pragma unroll
              for (int e = 0; e < 16; ++e) { const int _id = __builtin_amdgcn_readlane(_is, ((g * 16 + e) & 63)); bV[e] = *(const u32x4*)(V6 + (size_t)(unsigned)_id * 1024u + lane16); } }
#pragma unroll
            for (int e = 0; e < 16; ++e) { const float wkf = wl[g * 16 + e]; asm volatile("" : "+v"(bV[e]), "+v"(oh[0]), "+v"(oh[5]), "+v"(oh[10]), "+v"(oh[15]));
                const _Float16 wk1 = (_Float16)wkf; const h16x2 wk = (h16x2){wk1, wk1};
                const unsigned wd[4] = {bV[e].x, bV[e].y, bV[e].z, bV[e].w};
#pragma unroll
                for (int d = 0; d < 4; ++d) {
                    oh[4 * d + 0] = __builtin_elementwise_fma(__builtin_bit_cast(h16x2, __builtin_amdgcn_cvt_scalef32_pk_f16_fp4(wd[d], 1.0f, 0)), wk, oh[4 * d + 0]);
                    oh[4 * d + 1] = __builtin_elementwise_fma(__builtin_bit_cast(h16x2, __builtin_amdgcn_cvt_scalef32_pk_f16_fp4(wd[d], 1.0f, 1)), wk, oh[4 * d + 1]);
                    oh[4 * d + 2] = __builtin_elementwise_fma(__builtin_bit_cast(h16x2, __builtin_amdgcn_cvt_scalef32_pk_f16_fp4(wd[d], 1.0f, 2)), wk, oh[4 * d + 2]);
                    oh[4 * d + 3] = __builtin_elementwise_fma(__builtin_bit_cast(h16x2, __builtin_amdgcn_cvt_scalef32_pk_f16_fp4(wd[d], 1.0f, 3)), wk, oh[4 * d + 3]); } }
        }
        float out[32];
#pragma unroll
        for (int i = 0; i < 16; ++i) { out[2 * i] = (float)oh[i].x; out[2 * i + 1] = (float)oh[i].y; }
        asm volatile("s_waitcnt lgkmcnt(0)" ::: "memory");
        const bool lat = row < TL; const int mb = lat ? (row >> 11) : 16;
        float* xp = lat ? p.out + (size_t)row * D : XC + (size_t)(row - TL) * D;
        const float* gv = modl + (size_t)mb * NMOD;
        f32x4 xn[8]; float ss = 0.f;
#pragma unroll
        for (int j = 0; j < 8; ++j) { const int e = j * 256 + lane * 4;
            const f32x4 o4 = (f32x4){out[4 * j], out[4 * j + 1], out[4 * j + 2], out[4 * j + 3]};
            xn[j] = *(const f32x4*)(xp + e) + *(const f32x4*)(gv + e) * o4;
            ss += xn[j][0] * xn[j][0] + xn[j][1] * xn[j][1] + xn[j][2] * xn[j][2] + xn[j][3] * xn[j][3]; }
        ss = wave_sum(ss);
        const float rs = rsqrtf(ss * (1.0f / 2048.0f) + 1e-6f);
        if (!dry || p.ws == nullptr) {
            if (l == 0) {
                const float* m1 = (const float*)(p.ws + OFF_MODV) + (size_t)17 * NMOD + (size_t)mb * NMOD;
                float am = 0.f;
#pragma unroll
                for (int j = 0; j < 8; ++j) { const int e = j * 256 + lane * 4;
                    *(f32x4*)(xp + e) = xn[j];
                    xn[j] = xn[j] * rs * (*(const f32x4*)(m1 + 2048 + e) + 1.0f) + *(const f32x4*)(m1 + e);
                    am = fmaxf(am, fmaxf(fmaxf(fabsf(xn[j][0]), fabsf(xn[j][1])), fmaxf(fabsf(xn[j][2]), fabsf(xn[j][3])))); }
#pragma unroll
                for (int o = 32; o >= 1; o >>= 1) am = fmaxf(am, __shfl_xor(am, o));
                const float qs = am > 0.f ? 240.0f / am : 1.0f;
                unsigned char* H8 = p.ws + OFF_H8 + (size_t)row * D;
#pragma unroll
                for (int j = 0; j < 8; ++j) *(unsigned*)(H8 + j * 256 + lane * 4) = pack_fp8x4(xn[j][0] * qs, xn[j][1] * qs, xn[j][2] * qs, xn[j][3] * qs);
                if (lane == 0) ((float*)(p.ws + OFF_HS))[row] = am > 0.f ? am * (1.0f / 240.0f) : 1.0f;
            } else {
#pragma unroll
                for (int j = 0; j < 8; ++j) { const int e = j * 256 + lane * 4; *(f32x4*)(xp + e) = xn[j] * rs * *(const f32x4*)(p.final_g + e); }
            }
        }
    }
#undef PEER_LOAD
}

__device__ __forceinline__ Params load_params() {
    Params r;
#if defined(__HIP_DEVICE_COMPILE__)
    typedef const unsigned long long __attribute__((address_space(4)))* KP;
    KP k = (KP)__builtin_amdgcn_kernarg_segment_ptr();
    asm volatile("" : "+s"(k));
    void** d = (void**)&r;
#pragma unroll
    for (int i = 0; i < (int)(sizeof(Params) / 8); ++i) d[i] = (void*)(__attribute__((address_space(1))) void*)k[i];
#endif
    return r;
}
#define WSP(off) (p.ws + (off))
template <int l>
__device__ __forceinline__ void mega_layer(LAS unsigned char* lds, const XcdBarrier& bar) {
        const int Mrows = (l == 0) ? TT : TL;
        const int GLU_ROT = (((Mrows / 256) * 6) % (int)gridDim.x) & ~7;
        if (l == 0) {
            { const Params p = load_params(); phase_wconv(p, 0, lds); }
            { const Params p = load_params(); phase_norm<0, true>(p, 0, TT, 0, 2048); }
            xcd_barrier(bar);
        }
        { const Params p = load_params(); EpiInProj E{WSP(OFF_P), (const float*)WSP(OFF_HS), (const unsigned*)WSP(OFF_CMAX) + (size_t)l * INC};
          run_gemm(lds, (const bf16_t*)WSP(OFF_H8), (const bf16_t*)WSP(OFF_W + W_IN), TT, INC, D / 2, E); }
        xcd_barrier(bar);
        { const Params p = load_params(); phase_hgrn(p, l, lds); }
        __syncthreads();
        { const Params p = load_params(); phase_s5(p, l, lds); }
        xcd_barrier(bar);
        { const Params p = load_params(); phase_gmlp(p, l, Mrows, lds); }
        { const Params p = load_params(); phase_hcomb(p, l, Mrows); }
        { const Params p = load_params(); phase_s5post(p, l, Mrows); }
        xcd_barrier(bar);
        { const Params p = load_params(); EpiGlu E{(bf16_t*)WSP(OFF_P + P_CU)}; run_gemm(lds, (const bf16_t*)WSP(OFF_H + H_YSF), (const bf16_t*)WSP(OFF_W + W_GLU), Mrows, 1536, 768, E); }
        { const Params p = load_params(); EpiMerge<true> E{(bf16_t*)WSP(OFF_P + P_MERGED), (const bf16_t*)WSP(OFF_P + P_GATES)}; run_gemm(lds, (const bf16_t*)WSP(OFF_P + P_AU), (const bf16_t*)WSP(OFF_W + W_A), Mrows, D, 1024, E, GLU_ROT); }
        { const Params p = load_params(); EpiMerge<false> E{(bf16_t*)WSP(OFF_P + P_MERGED), (const bf16_t*)WSP(OFF_P + P_GATES) + 2048}; run_gemm(lds, (const bf16_t*)WSP(OFF_P + P_BFF), (const bf16_t*)WSP(OFF_W + W_B), Mrows, D, 1024, E, GLU_ROT); }
        xcd_barrier(bar);
        { const Params p = load_params(); EpiMerge<false> E{(bf16_t*)WSP(OFF_P + P_MERGED), (const bf16_t*)WSP(OFF_P + P_GATES) + 4096}; run_gemm(lds, (const bf16_t*)WSP(OFF_P + P_CU), (const bf16_t*)WSP(OFF_W + W_C), Mrows, D, 768, E); }
        xcd_barrier(bar);
        { const Params p = load_params(); EpiResid E{p.out, (float*)WSP(OFF_XC), (const float*)WSP(OFF_MODV) + (size_t)l * 17 * NMOD + 4096}; run_gemm(lds, (const bf16_t*)WSP(OFF_P + P_MERGED), (const bf16_t*)WSP(OFF_W + W_O), Mrows, D, D, E); }
        { const Params p = load_params(); phase_tabconv(p, l); }
        xcd_barrier(bar);
        { const Params p = load_params(); phase_norm<1>(p, l, Mrows, 6144, 8192); }
        xcd_barrier(bar);
        { const Params p = load_params(); EpiF32 E{(float*)WSP(OFF_P + Q_SC), 2048}; run_gemm(lds, (const bf16_t*)WSP(OFF_H), (const bf16_t*)WSP(OFF_W + W_S), Mrows, D, D, E); }
        xcd_barrier(bar);
        { const Params p = load_params(); phase_topk(p, Mrows, lds); }
        xcd_barrier(bar);
        { const Params p = load_params(); phase_peer(p, l, Mrows, lds); }
        if (l == 0) {
            __syncthreads();
            { const Params p = load_params(); phase_wconv(p, 1, lds); }
            xcd_barrier(bar);
        }
}
#undef WSP
__global__ void __launch_bounds__(NTHREADS, 2) k_mega(Params p_kernarg_only) {
    extern __shared__ __attribute__((aligned(16))) unsigned char smem[];
    LAS unsigned char* lds = (LAS unsigned char*)smem;
    volatile LAS unsigned* xbw = (volatile LAS unsigned*)(lds + LDS_BYTES - 16);
    if (threadIdx.x == 0) { xbw[0] = 0u; xbw[1] = 0u; xbw[2] = 0u; xbw[3] = 0u; }
    __syncthreads();
    XcdBarrier bar;
    { const Params p = load_params(); bar = xcd_barrier_post((unsigned*)(p.ws + OFF_BAR), xbw); }
#define WSP(off) (p.ws + (off))
    { const Params p = load_params(); phase_colmax(p); }
    { const Params p = load_params(); phase_prep(p); phase_mod(p, lds); }
    xcd_barrier(bar);
    mega_layer<0>(lds, bar);
    mega_layer<1>(lds, bar);
#undef WSP
}

extern "C" void kernel_launch(void* const* d_in, const int* in_sizes, int n_in, void* d_out, int out_size, void* d_ws, size_t ws_size, hipStream_t stream) {
    (void)in_sizes; (void)n_in; (void)out_size; (void)ws_size;
    Params p;
    const float** f = (const float**)&p;
    for (int i = 0; i < 31; ++i) f[i] = (const float*)d_in[i];
    p.out = (float*)d_out; p.ws = (unsigned char*)d_ws;
    static int grid = 0;
    if (!grid) {
        int dev = 0, cus = 0, per_cu = 0;
        (void)hipGetDevice(&dev);
        (void)hipDeviceGetAttribute(&cus, hipDeviceAttributeMultiprocessorCount, dev);
        (void)hipFuncSetAttribute((const void*)k_mega, hipFuncAttributeMaxDynamicSharedMemorySize, LDS_BYTES);
        (void)hipOccupancyMaxActiveBlocksPerMultiprocessor(&per_cu, (const void*)k_mega, NTHREADS, LDS_BYTES);
        grid = (per_cu >= 1 && cus > 0) ? (cus < 256 ? cus : 256) : 256;
    }
    (void)hipMemsetAsync(p.ws + OFF_BAR, 0, OFF_MODV, stream);
    hipLaunchKernelGGL(k_mega, dim3(grid), dim3(NTHREADS), LDS_BYTES, stream, p);
}
```

```cpp
#include <hip/hip_runtime.h>
#include <stdint.h>

#define LAS __attribute__((address_space(3)))
typedef unsigned short bf16_t;
typedef short bf16x8 __attribute__((ext_vector_type(8)));
typedef float f32x4 __attribute__((ext_vector_type(4)));
typedef float f32x2 __attribute__((ext_vector_type(2)));
typedef _Float16 h16x2 __attribute__((ext_vector_type(2)));
typedef unsigned u32x4 __attribute__((ext_vector_type(4)));
typedef unsigned u32x2 __attribute__((ext_vector_type(2)));
typedef __bf16 bf16x2_t __attribute__((ext_vector_type(2)));
typedef __bf16 bf16x32_t __attribute__((ext_vector_type(32)));
typedef float f32x32 __attribute__((ext_vector_type(32)));
typedef unsigned u32x6 __attribute__((ext_vector_type(6)));
typedef unsigned u32x16 __attribute__((ext_vector_type(16)));

constexpr int D = 2048, NB = 16, SEQ = 2048, CTXL = 256;
constexpr int TL = NB * SEQ;
constexpr int TC = NB * CTXL;
constexpr int TT = TL + TC;
constexpr int INC = 14080;
constexpr int NMOD = 12288;
constexpr int NTHREADS = 512;
constexpr int LDS_BYTES = 160 * 1024;

constexpr size_t OFF_BAR = 0;
constexpr size_t OFF_CMAX = 16384;
constexpr size_t OFF_MODV = OFF_CMAX + (size_t)2 * INC * 4;
constexpr size_t OFF_LB = OFF_MODV + (size_t)2 * 17 * NMOD * 4;
constexpr size_t OFF_S5LAM = OFF_LB + 2 * 2 * 1024 * 4;
constexpr size_t OFF_S5BB = OFF_S5LAM + (size_t)2 * 2 * 48 * 64 * 2 * 4;
constexpr size_t OFF_PE = OFF_S5BB + (size_t)2 * 2 * 48 * 64 * 32 * 4;
constexpr size_t OFF_HS = (OFF_PE + (size_t)96 * 1024 * 4 + 255) & ~(size_t)255;
constexpr size_t OFF_XC = (OFF_HS + (size_t)TT * 4 + 255) & ~(size_t)255;
constexpr size_t OFF_H = OFF_XC + (size_t)TC * D * 4;
constexpr size_t OFF_W = OFF_H + (size_t)TT * D * 2;
constexpr size_t W_IN = 0;
constexpr size_t W_GLU = W_IN + (size_t)INC * D;
constexpr size_t W_A = W_GLU + (size_t)1536 * 768 * 2;
constexpr size_t W_B = W_A + (size_t)2048 * 1024 * 2;
constexpr size_t W_C = W_B + (size_t)2048 * 1024 * 2;
constexpr size_t W_O = W_C + (size_t)2048 * 768 * 2;
constexpr size_t W_S = W_O + (size_t)2048 * 2048 * 2;
constexpr size_t W_TOTAL = W_S + (size_t)2048 * 2048 * 2;
constexpr size_t OFF_P = OFF_W + W_TOTAL;
constexpr size_t SEG = (size_t)TT * 1024 * 2;
constexpr size_t P_AU = 0, P_AV = SEG, P_BQ = 2 * SEG, P_BFF = 3 * SEG, P_BFB = 4 * SEG, P_BI = 5 * SEG, P_BG = 6 * SEG;
constexpr size_t P_CU = 7 * SEG;
constexpr size_t P_GATES = P_CU + (size_t)TT * 768 * 2;
constexpr size_t P_TOTAL = P_GATES + (size_t)TT * 6144 * 2;
constexpr size_t P_MERGED = SEG;
constexpr size_t Q_UT = 0;
constexpr size_t Q_VT = Q_UT + (size_t)16384 * 1536;
constexpr size_t Q_USC = Q_VT + (size_t)16384 * 1536;
constexpr size_t Q_VSC = Q_USC + (size_t)16384 * 4;
constexpr size_t Q_SC = Q_VSC + (size_t)16384 * 4;
constexpr size_t Q_IDX = Q_SC + (size_t)TT * 2048 * 4;
constexpr size_t Q_GATE = Q_IDX + (size_t)TT * 128 * 4;
constexpr size_t H_YSF = 0;
constexpr size_t H_YSB = (size_t)TT * 768 * 2;
constexpr size_t OFF_H8 = OFF_P + P_TOTAL;
constexpr size_t WS_NEEDED = OFF_H8 + (size_t)TT * D;

struct Params {
    const float *x, *c, *ctx, *c_ctx, *w_mod, *b_mod, *w_in, *ln_g, *ln_b, *w_s, *b_s, *lb_logits, *hn_g;
    const float *lam_re, *lam_im, *log_step, *b_re, *b_im, *c_re, *c_im, *s5_d, *w_glu, *wa, *wb, *wc, *wo, *w_q, *sub_keys, *peer_u, *peer_v, *final_g;
    float* out;
    unsigned char* ws;
};

__device__ __forceinline__ float bf_lo(unsigned u) { return __uint_as_float(u << 16); }
__device__ __forceinline__ float bf_hi(unsigned u) { return __uint_as_float(u & 0xffff0000u); }
__device__ __forceinline__ unsigned cvt_pk_bf16(float lo, float hi) { f32x2 v; v.x = lo; v.y = hi; const bf16x2_t b = __builtin_convertvector(v, bf16x2_t); return __builtin_bit_cast(unsigned, b); }
__device__ __forceinline__ float fexp(float x) { return __builtin_amdgcn_exp2f(x * 1.44269504f); }
__device__ __forceinline__ float flog(float x) { return __builtin_amdgcn_logf(x) * 0.693147181f; }
__device__ __forceinline__ float fast_sigmoid(float x) { return __builtin_amdgcn_rcpf(1.0f + fexp(-x)); }
__device__ __forceinline__ float fast_silu(float x) { return x * fast_sigmoid(x); }
__device__ __forceinline__ float gelu_f(float v) {
    const float av = fabsf(v), t = __builtin_amdgcn_rcpf(av * 0.2316418882f + 1.0f);
    float q = t * 0.5307027145f + (-0.7265760135f); q = q * t + 0.7107068705f; q = q * t + (-0.142248368f); q = q * t + 0.127414796f; q = q * t;
    const float e = __builtin_amdgcn_exp2f((v * v) * (-0.72134752044f));
    const float m = v * (q * e);
    return v < 0.f ? m : v - m;
}
__device__ __forceinline__ unsigned pack_fp8x4(float a, float b, float c, float d) {
    int pk = 0; pk = __builtin_amdgcn_cvt_pk_fp8_f32(a, b, pk, false); pk = __builtin_amdgcn_cvt_pk_fp8_f32(c, d, pk, true); return (unsigned)pk;
}
template <int CTRL> __device__ __forceinline__ float dpp_f(float v) { return __int_as_float(__builtin_amdgcn_update_dpp(0, __float_as_int(v), CTRL, 0xF, 0xF, false)); }
__device__ __forceinline__ float row16_max(float v) { v = fmaxf(v, dpp_f<0x128>(v)); v = fmaxf(v, dpp_f<0x124>(v)); v = fmaxf(v, dpp_f<0x122>(v)); v = fmaxf(v, dpp_f<0x121>(v)); return v; }
__device__ __forceinline__ float row16_sum(float v) { v += dpp_f<0x128>(v); v += dpp_f<0x124>(v); v += dpp_f<0x122>(v); v += dpp_f<0x121>(v); return v; }
__device__ __forceinline__ float wave_sum(float v) {
#pragma unroll
    for (int o = 32; o >= 1; o >>= 1) v += __shfl_xor(v, o);
    return v;
}
__device__ __forceinline__ int otid() { int t; asm volatile("v_mov_b32 %0, %1" : "=v"(t) : "v"((int)threadIdx.x)); return t; }


#define XB_TMO      128
#define XB_XCNT(j)  (256  + 64 * (j))
#define XB_XSUB(j)  (1280 + 64 * (j))
#define XB_XGEN(j)  (2304 + 64 * (j))
#define XB_TOP      3328
#define XB_TOPGEN   3392
#define XCD_BAR_WORDS 3456
#define XB_SPIN_CAP (1u << 22)
__device__ __forceinline__ unsigned xb_ld(unsigned* p)              { return __hip_atomic_load(p, __ATOMIC_RELAXED, __HIP_MEMORY_SCOPE_AGENT); }
__device__ __forceinline__ unsigned xb_add(unsigned* p, unsigned v) { return __hip_atomic_fetch_add(p, v, __ATOMIC_RELAXED, __HIP_MEMORY_SCOPE_AGENT); }
__device__ __forceinline__ unsigned xb_xcc_id() { return (unsigned)__builtin_amdgcn_s_getreg((3 << 11) | 20) & 0xFu; }
#define XB_SPIN(cond, bar) do { unsigned _sp = 0; while (cond) { __builtin_amdgcn_s_sleep(1); \
    if ((++_sp & 255u) == 0u) { if (xb_ld(&(bar)[XB_TMO])) break; if (_sp > XB_SPIN_CAP) { atomicAdd(&(bar)[XB_TMO], 1u); break; } } } } while (0)
struct XcdBarrier { unsigned* bar; unsigned x; volatile LAS unsigned* st; };
__device__ __forceinline__ XcdBarrier xcd_barrier_post(unsigned* bar, volatile LAS unsigned* st) {
    XcdBarrier b; b.bar = bar; b.x = xb_xcc_id(); b.st = st;
    if (threadIdx.x == 0) (void)xb_add(&bar[XB_XCNT(b.x)], 1u);
    return b;
}
__device__ __forceinline__ void xcd_barrier_complete(unsigned* bar, unsigned x, unsigned& nloc, unsigned& nx) {
    const unsigned G = gridDim.x * gridDim.y * gridDim.z;
    unsigned sum, cnt, mine, sp = 0u;
    for (;;) {
        sum = 0u; cnt = 0u; mine = 0u;
#pragma unroll
        for (unsigned j = 0; j < 16; ++j) { const unsigned c = xb_ld(&bar[XB_XCNT(j)]); sum += c; cnt += (c > 0u) ? 1u : 0u; mine = (j == x) ? c : mine; }
        if (sum == G) break;
        __builtin_amdgcn_s_sleep(1);
        if ((++sp & 255u) == 0u) { if (xb_ld(&bar[XB_TMO])) break; if (sp > XB_SPIN_CAP) { atomicAdd(&bar[XB_TMO], 1u); break; } }
    }
    nloc = mine > 0u ? mine : 1u; nx = cnt > 0u ? cnt : 1u;
}
__device__ __forceinline__ void xcd_barrier(const XcdBarrier& b) {
    asm volatile("s_waitcnt vmcnt(0)" ::: "memory");
    __syncthreads();
    if (threadIdx.x == 0) {
        unsigned* bar = b.bar;
        __builtin_amdgcn_s_waitcnt(0);
        unsigned nloc = b.st[0], nx = b.st[1];
        if (nloc == 0u) { xcd_barrier_complete(bar, b.x, nloc, nx); b.st[0] = nloc; b.st[1] = nx; }
        const unsigned old = xb_add(&bar[XB_XSUB(b.x)], 1u);
        const unsigned gen = old / nloc;
        if (old + 1u == (gen + 1u) * nloc) {
            __builtin_amdgcn_fence(__ATOMIC_RELEASE, "agent");
            asm volatile("s_waitcnt vmcnt(0)" ::: "memory");
            const unsigned og = xb_add(&bar[XB_TOP], 1u);
            const unsigned tg = og / nx;
            if (og + 1u == (tg + 1u) * nx) xb_add(&bar[XB_TOPGEN], 1u);
            else XB_SPIN(xb_ld(&bar[XB_TOPGEN]) == tg, bar);
            __builtin_amdgcn_fence(__ATOMIC_ACQUIRE, "agent");
            xb_add(&bar[XB_XGEN(b.x)], 1u);
            asm volatile("s_waitcnt vmcnt(0)" ::: "memory");
        } else {
            XB_SPIN(xb_ld(&bar[XB_XGEN(b.x)]) == gen, bar);
            __builtin_amdgcn_fence(__ATOMIC_ACQUIRE, "agent");
            asm volatile("s_waitcnt vmcnt(0)" ::: "memory");
        }
    }
    __syncthreads();
}

namespace pg8 {
constexpr int BM = 256, BK = 64, HALF = 128, HTB = HALF * BK * 2, STAGE_BYTES = 8 * HTB, NXCD = 8, WGM = 8;
__host__ __device__ __forceinline__ int lds_byte(int r, int c) { const int st = (r >> 4) * 2 + (c >> 5), rr = r & 15, cc = c & 31, ob = rr * 64 + cc * 2; return st * 1024 + (ob ^ (((ob >> 9) & 1) << 5)); }
__host__ __device__ __forceinline__ void stage_rc(int b, int& R, int& C) { const int st = b / 1024, sb = b % 1024, swz = sb ^ (((sb >> 9) & 1) << 5); R = (st >> 1) * 16 + swz / 64; C = (st & 1) * 32 + (swz % 64) / 2; }
__host__ __device__ __forceinline__ int perm32(int rho) { const int n = rho >> 4, i = rho & 15; return 8 * (i >> 2) + 4 * n + (i & 3); }
typedef int i32x8 __attribute__((ext_vector_type(8)));
__device__ __forceinline__ i32x8 cat8(const bf16x8 a, const bf16x8 b) { const u32x4 x = __builtin_bit_cast(u32x4, a), y = __builtin_bit_cast(u32x4, b); i32x8 r; r[0] = (int)x.x; r[1] = (int)x.y; r[2] = (int)x.z; r[3] = (int)x.w; r[4] = (int)y.x; r[5] = (int)y.y; r[6] = (int)y.z; r[7] = (int)y.w; return r; }
struct Unit { int pm, pn; };
struct Gemm { const bf16_t* A; const bf16_t* Bt; int M, N, K; };
struct StaticOrder {
    int nM, nN, nwg, G, c;
    __device__ void init(int M, int N, int G_, int c_) { nM = M / BM; nN = N / BM; nwg = nM * nN; G = G_; c = c_; }
    __device__ bool next(int i, Unit& u) const {
        const long L = (long)i * G + c; if (L >= nwg) return false;
        int wgid = (int)L; { const int q = nwg / NXCD, r = nwg % NXCD, xcd = wgid % NXCD, off = wgid / NXCD; wgid = (xcd < r ? xcd * (q + 1) : r * (q + 1) + (xcd - r) * q) + off; }
        const int nig = WGM * nN, gid = wgid / nig, fm = gid * WGM, gsz = (nM - fm) < WGM ? (nM - fm) : WGM;
        u.pm = fm + ((wgid % nig) % gsz); u.pn = (wgid % nig) / gsz; return true;
    }
};

template <class Epi, class Sched>
__device__ __forceinline__ void gemm_phase(LAS unsigned char* lds, const Gemm g, const Sched& S, const Epi& E) {
    const int tid_ = otid();
    const int tid = tid_, wid = __builtin_amdgcn_readfirstlane(tid >> 6), lane = tid & 63, wr = wid >> 2, wc = wid & 3, fr = lane & 15, fq = lane >> 4;
    const int K = g.K, nt = K / BK;
    unsigned voffA[2], voffB[2];
#pragma unroll
    for (int i = 0; i < 2; ++i) { int R, C; stage_rc(tid * 16 + i * 8192, R, C); const int Rb = Epi::PERM ? ((R & ~31) + perm32(R & 31)) : R;
        voffA[i] = (unsigned)(R * K + C) * 2u; voffB[i] = (unsigned)(Rb * K + C) * 2u; }
    const size_t kstep = (size_t)(BK * 2);
    const size_t hstep = (size_t)HALF * K * 2;
    const size_t tstep = 2 * hstep;
    const unsigned ldsw = (unsigned)wid * 1024u;
    const int aoff = lds_byte(wr * 64 + fr, fq * 8), boff = lds_byte(wc * 32 + fr, fq * 8);
    const int aoff8 = lds_byte(wr * 64 + fr, (fq >> 1) * 32 + (fq & 1) * 16), boff8 = lds_byte(wc * 32 + fr, (fq >> 1) * 32 + (fq & 1) * 16);
#define PG8_SA(b, h) (((b) * 2 + (h)) * HTB)
#define PG8_SB(b, h) ((4 + (b) * 2 + (h)) * HTB)
#define PG8_STAGE(bufoff, gbase, voff) do { _Pragma("unroll") for (int _i = 0; _i < 2; ++_i) \
        __builtin_amdgcn_global_load_lds((const unsigned*)((const char*)(gbase) + (voff)[_i]), (LAS unsigned*)(lds + (bufoff) + ldsw + _i * 8192), 16, 0, 0); } while (0)
#define PG8_LDA(dst, b, h) do { if constexpr (Epi::FP8) { _Pragma("unroll") for (int m = 0; m < 4; ++m) dst##8[m] = cat8(*(const LAS bf16x8*)(lds + PG8_SA(b, h) + aoff + m * 2048), *(const LAS bf16x8*)(lds + PG8_SA(b, h) + aoff + m * 2048 + 1024)); } \
        else { _Pragma("unroll") for (int m = 0; m < 4; ++m) _Pragma("unroll") for (int k = 0; k < 2; ++k) dst[m][k] = *(const LAS bf16x8*)(lds + PG8_SA(b, h) + aoff + m * 2048 + k * 1024); } } while (0)
#define PG8_LDB(dst, b, h) do { if constexpr (Epi::FP8) { _Pragma("unroll") for (int n = 0; n < 2; ++n) dst##8[n] = cat8(*(const LAS bf16x8*)(lds + PG8_SB(b, h) + boff + n * 2048), *(const LAS bf16x8*)(lds + PG8_SB(b, h) + boff + n * 2048 + 1024)); } \
        else { _Pragma("unroll") for (int n = 0; n < 2; ++n) _Pragma("unroll") for (int k = 0; k < 2; ++k) dst[n][k] = *(const LAS bf16x8*)(lds + PG8_SB(b, h) + boff + n * 2048 + k * 1024); } } while (0)
#define PG8_MMA(ai, bj, At, Bt) do { __builtin_amdgcn_s_setprio(1); _Pragma("unroll") for (int m = 0; m < 4; ++m) _Pragma("unroll") for (int n = 0; n < 2; ++n) { \
        if constexpr (Epi::FP8) { asm volatile("v_mfma_scale_f32_16x16x128_f8f6f4 %0, %1, %2, %0, %3, %3 op_sel_hi:[0,0,0]" : "+v"(acc[ai][bj][m][n]) : "v"(Bt##8[n]), "v"(At##8[m]), "v"(one_scale)); } \
        else { _Pragma("unroll") for (int k = 0; k < 2; ++k) acc[ai][bj][m][n] = __builtin_amdgcn_mfma_f32_16x16x32_bf16(Bt[n][k], At[m][k], acc[ai][bj][m][n], 0, 0, 0); } } \
        __builtin_amdgcn_s_setprio(0); } while (0)
#define PG8_WAIT_V(n) asm volatile("s_waitcnt vmcnt(" #n ")" ::: "memory")
#define PG8_WAIT_L(n) asm volatile("s_waitcnt lgkmcnt(" #n ")" ::: "memory")
#define PG8_BAR __builtin_amdgcn_s_barrier()
#define PG8_SCHED __builtin_amdgcn_sched_barrier(0)
    Unit cur, nxt; int ui = 0;
    if (!S.next(0, cur)) return;
    f32x4 acc[2][2][4][2];
#pragma unroll
    for (int a = 0; a < 2; ++a)
#pragma unroll
        for (int b = 0; b < 2; ++b)
#pragma unroll
            for (int m = 0; m < 4; ++m)
#pragma unroll
                for (int n = 0; n < 2; ++n) acc[a][b][m][n] = (f32x4){0.f, 0.f, 0.f, 0.f};
    bf16x8 At[4][2], B0[2][2], B1[2][2];
    i32x8 At8[4], B08[2], B18[2];
    const int one_scale = 0x7F7F7F7F;
    const char* cA = (const char*)g.A + (size_t)cur.pm * tstep; const char* cB = (const char*)g.Bt + (size_t)cur.pn * tstep;
    PG8_STAGE(PG8_SB(0, 0), cB, voffB); PG8_STAGE(PG8_SA(0, 0), cA, voffA); PG8_STAGE(PG8_SB(0, 1), cB + hstep, voffB); PG8_STAGE(PG8_SA(0, 1), cA + hstep, voffA);
    if (wr == 1) PG8_BAR;
    PG8_WAIT_V(4); PG8_BAR;
    PG8_STAGE(PG8_SB(1, 0), cB + kstep, voffB); PG8_STAGE(PG8_SA(1, 0), cA + kstep, voffA); PG8_STAGE(PG8_SB(1, 1), cB + hstep + kstep, voffB);
    PG8_WAIT_V(6); PG8_BAR;
    for (;;) {
        const bool has_next = S.next(ui + 1, nxt);
        const char* nA = has_next ? (const char*)g.A + (size_t)nxt.pm * tstep : cA; const char* nB = has_next ? (const char*)g.Bt + (size_t)nxt.pn * tstep : cB;
        for (int t = 0; t < nt; t += 2) {
            const bool last = (t == nt - 2);
            const char* a1 = cA + (size_t)(t + 1) * kstep;
            const char* a2 = last ? nA : cA + (size_t)(t + 2) * kstep; const char* b2 = last ? nB : cB + (size_t)(t + 2) * kstep;
            const char* a3 = a2 + kstep; const char* b3 = b2 + kstep;
            PG8_LDB(B0, 0, 0); PG8_SCHED; PG8_LDA(At, 0, 0); PG8_STAGE(PG8_SA(1, 1), a1 + hstep, voffA);
            PG8_WAIT_L(8); PG8_BAR; PG8_WAIT_L(0); PG8_MMA(0, 0, At, B0); PG8_BAR; PG8_SCHED;
            PG8_LDB(B1, 0, 1); PG8_STAGE(PG8_SB(0, 0), b2, voffB);
            PG8_BAR; PG8_WAIT_L(0); PG8_MMA(0, 1, At, B1); PG8_BAR;
            PG8_LDA(At, 0, 1); PG8_STAGE(PG8_SA(0, 0), a2, voffA);
            PG8_BAR; PG8_WAIT_L(0); PG8_MMA(1, 0, At, B0); PG8_BAR; PG8_SCHED;
            PG8_STAGE(PG8_SB(0, 1), b2 + hstep, voffB);
            PG8_WAIT_V(6); PG8_BAR; PG8_MMA(1, 1, At, B1); PG8_BAR;
            PG8_LDB(B0, 1, 0); PG8_SCHED; PG8_LDA(At, 1, 0); PG8_STAGE(PG8_SA(0, 1), a2 + hstep, voffA);
            PG8_WAIT_L(8); PG8_BAR; PG8_WAIT_L(0); PG8_MMA(0, 0, At, B0); PG8_BAR; PG8_SCHED;
            PG8_LDB(B1, 1, 1); PG8_STAGE(PG8_SB(1, 0), b3, voffB);
            PG8_BAR; PG8_WAIT_L(0); PG8_MMA(0, 1, At, B1); PG8_BAR;
            PG8_LDA(At, 1, 1); PG8_STAGE(PG8_SA(1, 0), a3, voffA);
            PG8_BAR; PG8_WAIT_L(0); PG8_MMA(1, 0, At, B0); PG8_BAR; PG8_SCHED;
            PG8_STAGE(PG8_SB(1, 1), b3 + hstep, voffB);
            PG8_WAIT_V(6); PG8_BAR; PG8_MMA(1, 1, At, B1); PG8_BAR;
        }
        if constexpr (Epi::FP8) asm volatile("s_nop 15\n s_nop 15\n s_nop 15" ::: "memory");
        E(acc, cur, wr, wc, fr, fq);
        if (!has_next) break;
#pragma unroll
        for (int a = 0; a < 2; ++a)
#pragma unroll
            for (int b = 0; b < 2; ++b)
#pragma unroll
                for (int m = 0; m < 4; ++m)
#pragma unroll
                    for (int n = 0; n < 2; ++n) acc[a][b][m][n] = (f32x4){0.f, 0.f, 0.f, 0.f};
        cur = nxt; cA = nA; cB = nB; ++ui;
    }
    PG8_WAIT_V(0);
    if (wr == 0) PG8_BAR;
    PG8_BAR;
#undef PG8_SA
#undef PG8_SB
#undef PG8_STAGE
#undef PG8_LDA
#undef PG8_LDB
#undef PG8_MMA
#undef PG8_WAIT_V
#undef PG8_WAIT_L
#undef PG8_BAR
#undef PG8_SCHED
}
}

typedef f32x4 AccT[2][2][4][2];

struct EpiInProj {
    static constexpr bool PERM = true, FP8 = true;
    unsigned char* P;
    const float* sa;
    const unsigned* cmax;
    __device__ __forceinline__ void operator()(const AccT& acc, const pg8::Unit& u, int wr, int wc, int fr, int fq) const {
        const int pn = u.pn;
        bf16_t* base; int ld, lc, act;
        if (pn < 28) { const int seg = pn >> 2; base = (bf16_t*)(P + (size_t)seg * SEG); ld = 1024; lc = (pn & 3) * 256; act = (seg < 2) ? 1 : ((seg == 2 || seg == 6) ? 2 : 0); }
        else if (pn < 31) { base = (bf16_t*)(P + P_CU); ld = 768; lc = (pn - 28) * 256; act = 0; }
        else { base = (bf16_t*)(P + P_GATES); ld = 6144; lc = (pn - 31) * 256; act = 3; }
        const int row0 = u.pm * 256 + wr * 64 + fr, col0 = lc + wc * 32 + 8 * fq, gcol0 = u.pn * 256 + wc * 32 + 8 * fq;
        f32x4 cs[2][2];
#pragma unroll
        for (int bj = 0; bj < 2; ++bj)
#pragma unroll
            for (int n = 0; n < 2; ++n) { const u32x4 cb = *(const u32x4*)(cmax + gcol0 + bj * 128 + 4 * n);
                cs[bj][n] = (f32x4){__uint_as_float(cb.x), __uint_as_float(cb.y), __uint_as_float(cb.z), __uint_as_float(cb.w)} * (1.0f / 240.0f); }
        float rscv[2][4];
#pragma unroll
        for (int ai = 0; ai < 2; ++ai)
#pragma unroll
            for (int m = 0; m < 4; ++m) rscv[ai][m] = sa[row0 + ai * 128 + m * 16];
#pragma unroll
        for (int ai = 0; ai < 2; ++ai)
#pragma unroll
            for (int m = 0; m < 4; ++m) {
                bf16_t* rowp = base + (size_t)(row0 + ai * 128 + m * 16) * ld + col0;
                const float rsc = rscv[ai][m];
#pragma unroll
                for (int bj = 0; bj < 2; ++bj) {
                    f32x4 v0 = acc[ai][bj][m][0] * (cs[bj][0] * rsc), v1 = acc[ai][bj][m][1] * (cs[bj][1] * rsc);
                    if (act == 1) {
#pragma unroll
                        for (int j = 0; j < 4; ++j) { v0[j] = gelu_f(v0[j]); v1[j] = gelu_f(v1[j]); }
                    } else if (act == 2) {
#pragma unroll
                        for (int j = 0; j < 4; ++j) { v0[j] = fast_silu(v0[j]); v1[j] = fast_silu(v1[j]); }
                    } else if (act == 3) {
#pragma unroll
                        for (int j = 0; j < 4; ++j) { v0[j] = fast_sigmoid(v0[j]); v1[j] = fast_sigmoid(v1[j]); }
                    }
                    u32x4 w; w.x = cvt_pk_bf16(v0[0], v0[1]); w.y = cvt_pk_bf16(v0[2], v0[3]); w.z = cvt_pk_bf16(v1[0], v1[1]); w.w = cvt_pk_bf16(v1[2], v1[3]);
                    *(u32x4*)(rowp + bj * 128) = w;
                }
            }
    }
};
struct EpiGlu {
    static constexpr bool PERM = true, FP8 = false;
    bf16_t* O;
    __device__ __forceinline__ void operator()(const AccT& acc, const pg8::Unit& u, int wr, int wc, int fr, int fq) const {
        const int row0 = u.pm * 256 + wr * 64 + fr, col0 = u.pn * 128 + wc * 32 + 8 * fq;
#pragma unroll
        for (int ai = 0; ai < 2; ++ai)
#pragma unroll
            for (int m = 0; m < 4; ++m) {
                f32x4 v0 = acc[ai][0][m][0], v1 = acc[ai][0][m][1]; const f32x4 g0 = acc[ai][1][m][0], g1 = acc[ai][1][m][1];
#pragma unroll
                for (int j = 0; j < 4; ++j) { v0[j] *= fast_sigmoid(g0[j]); v1[j] *= fast_sigmoid(g1[j]); }
                u32x4 w; w.x = cvt_pk_bf16(v0[0], v0[1]); w.y = cvt_pk_bf16(v0[2], v0[3]); w.z = cvt_pk_bf16(v1[0], v1[1]); w.w = cvt_pk_bf16(v1[2], v1[3]);
                *(u32x4*)(O + (size_t)(row0 + ai * 128 + m * 16) * 768 + col0) = w;
            }
    }
};
template <bool FIRST> struct EpiMerge {
    static constexpr bool PERM = true, FP8 = false;
    bf16_t* O;
    const bf16_t* G;
    __device__ __forceinline__ void operator()(const AccT& acc, const pg8::Unit& u, int wr, int wc, int fr, int fq) const {
        const int row0 = u.pm * 256 + wr * 64 + fr, col0 = u.pn * 256 + wc * 32 + 8 * fq;
        constexpr int NB = FIRST ? 2 : 4, MB_ = FIRST ? 4 : 2;
        u32x4 gwv[2][MB_][2], owv[2][FIRST ? 1 : MB_][2];
#define EM_LOAD(q) do { const int ai_ = (q) / (4 / MB_), m0_ = ((q) % (4 / MB_)) * MB_; _Pragma("unroll") for (int mm = 0; mm < MB_; ++mm) _Pragma("unroll") for (int bj = 0; bj < 2; ++bj) { \
            const size_t row = (size_t)(row0 + ai_ * 128 + (m0_ + mm) * 16); gwv[(q) & 1][mm][bj] = *(const u32x4*)(G + row * 6144 + col0 + bj * 128); \
            if (!FIRST) owv[(q) & 1][mm][bj] = *(const u32x4*)(O + row * 2048 + col0 + bj * 128); } } while (0)
        EM_LOAD(0);
#pragma unroll
        for (int q = 0; q < NB; ++q) {
            if (q + 1 < NB) EM_LOAD(q + 1);
            const int ai = q / (4 / MB_), m0 = (q % (4 / MB_)) * MB_;
#pragma unroll
            for (int mm = 0; mm < MB_; ++mm)
#pragma unroll
                for (int bj = 0; bj < 2; ++bj) { const int m = m0 + mm; const size_t row = (size_t)(row0 + ai * 128 + m * 16);
                    const u32x4 gw = gwv[q & 1][mm][bj];
                    f32x4 v0 = acc[ai][bj][m][0], v1 = acc[ai][bj][m][1];
                    v0[0] *= bf_lo(gw.x); v0[1] *= bf_hi(gw.x); v0[2] *= bf_lo(gw.y); v0[3] *= bf_hi(gw.y);
                    v1[0] *= bf_lo(gw.z); v1[1] *= bf_hi(gw.z); v1[2] *= bf_lo(gw.w); v1[3] *= bf_hi(gw.w);
                    if (!FIRST) { const u32x4 ow = owv[q & 1][mm][bj];
                        v0[0] += bf_lo(ow.x); v0[1] += bf_hi(ow.x); v0[2] += bf_lo(ow.y); v0[3] += bf_hi(ow.y);
                        v1[0] += bf_lo(ow.z); v1[1] += bf_hi(ow.z); v1[2] += bf_lo(ow.w); v1[3] += bf_hi(ow.w); }
                    u32x4 w; w.x = cvt_pk_bf16(v0[0], v0[1]); w.y = cvt_pk_bf16(v0[2], v0[3]); w.z = cvt_pk_bf16(v1[0], v1[1]); w.w = cvt_pk_bf16(v1[2], v1[3]);
                    *(u32x4*)(O + row * 2048 + col0 + bj * 128) = w; }
        }
#undef EM_LOAD
    }
};
struct EpiResid {
    static constexpr bool PERM = false, FP8 = false;
    float* XR; float* XC; const float* modl;
    __device__ __forceinline__ void operator()(const AccT& acc, const pg8::Unit& u, int wr, int wc, int fr, int fq) const {
        const int row0 = u.pm * 256 + wr * 64 + fr, col0 = u.pn * 256 + wc * 32 + 4 * fq;
        const int mb = u.pm < 128 ? (u.pm >> 3) : 16;
        const float* gv = modl + (size_t)mb * NMOD + col0;
        float* basep = u.pm < 128 ? XR : (XC - (size_t)TL * D);
        f32x4 gvv[2][2];
#pragma unroll
        for (int bj = 0; bj < 2; ++bj)
#pragma unroll
            for (int n = 0; n < 2; ++n) gvv[bj][n] = *(const f32x4*)(gv + bj * 128 + n * 16);
        f32x4 xo[2][2][2][2];
#define ER_LOAD(q) do { const int ai_ = (q) >> 1, m0_ = ((q) & 1) * 2; _Pragma("unroll") for (int mm = 0; mm < 2; ++mm) _Pragma("unroll") for (int bj = 0; bj < 2; ++bj) _Pragma("unroll") for (int n = 0; n < 2; ++n) \
            xo[(q) & 1][mm][bj][n] = *(const f32x4*)(basep + (size_t)(row0 + ai_ * 128 + (m0_ + mm) * 16) * D + col0 + bj * 128 + n * 16); } while (0)
        ER_LOAD(0);
#pragma unroll
        for (int q = 0; q < 4; ++q) {
            if (q + 1 < 4) ER_LOAD(q + 1);
            const int ai = q >> 1, m0 = (q & 1) * 2;
#pragma unroll
            for (int mm = 0; mm < 2; ++mm)
#pragma unroll
                for (int bj = 0; bj < 2; ++bj)
#pragma unroll
                    for (int n = 0; n < 2; ++n) *(f32x4*)(basep + (size_t)(row0 + ai * 128 + (m0 + mm) * 16) * D + col0 + bj * 128 + n * 16) = xo[q & 1][mm][bj][n] + gvv[bj][n] * acc[ai][bj][m0 + mm][n];
        }
#undef ER_LOAD
    }
};
struct EpiF32 {
    static constexpr bool PERM = false, FP8 = false;
    float* C; int ldc;
    __device__ __forceinline__ void operator()(const AccT& acc, const pg8::Unit& u, int wr, int wc, int fr, int fq) const {
        const int row0 = u.pm * 256 + wr * 64 + fr, col0 = u.pn * 256 + wc * 32 + 4 * fq;
#pragma unroll
        for (int ai = 0; ai < 2; ++ai)
#pragma unroll
            for (int m = 0; m < 4; ++m) {
                float* rowp = C + (size_t)(row0 + ai * 128 + m * 16) * ldc + col0;
#pragma unroll
                for (int bj = 0; bj < 2; ++bj)
#pragma unroll
                    for (int n = 0; n < 2; ++n) *(f32x4*)(rowp + bj * 128 + n * 16) = acc[ai][bj][m][n];
            }
    }
};

template <class Epi>
__device__ __forceinline__ void run_gemm(LAS unsigned char* lds, const bf16_t* A, const bf16_t* Bt, int M, int N, int K, const Epi& E, int rot = 0) {
    pg8::Gemm g{A, Bt, M, N, K};
    const int G_ = (int)gridDim.x; int c_ = (int)blockIdx.x - rot; if (c_ < 0) c_ += G_;
    pg8::StaticOrder S; S.init(M, N, G_, c_);
    pg8::gemm_phase<Epi, pg8::StaticOrder>(lds, g, S, E);
}

__device__ __forceinline__ void phase_mod(const Params& p, LAS unsigned char* lds) {
    const int tid_ = otid();
    LAS float* cs = (LAS float*)lds;
    LAS float* red = (LAS float*)(lds + 2048 * 17 * 4);
    const int tid = tid_;
    float* modv = (float*)(p.ws + OFF_MODV);
    { f32x4 cv[17];
#pragma unroll
      for (int r = 0; r < 17; ++r) cv[r] = *(const f32x4*)((r < 16 ? p.c + r * 2048 : p.c_ctx) + tid * 4);
#pragma unroll
      for (int r = 0; r < 17; ++r)
#pragma unroll
          for (int e = 0; e < 4; ++e) { const float c = cv[r][e]; cs[(tid * 4 + e) * 17 + r] = c / (1.0f + __expf(-c)); } }
    __syncthreads();
    const int lane = tid & 63, wv = tid >> 6, cq = lane & 7, kg = wv * 8 + (lane >> 3);
    for (int u = blockIdx.x; u < 768; u += gridDim.x) {
        const int l = u / 384, c0 = (u % 384) * 32;
        const float* w = p.w_mod + (size_t)l * 2048 * NMOD + (size_t)kg * NMOD + c0 + cq * 4;
        f32x4 acc[17];
#pragma unroll
        for (int r = 0; r < 17; ++r) acc[r] = (f32x4){0.f, 0.f, 0.f, 0.f};
#pragma unroll 16
        for (int j = 0; j < 32; ++j) {
            const f32x4 w4 = *(const f32x4*)(w + (size_t)j * 64 * NMOD);
            const LAS float* cr = cs + (kg + 64 * j) * 17;
#pragma unroll
            for (int r = 0; r < 17; ++r) acc[r] += w4 * cr[r];
        }
#pragma unroll
        for (int r = 0; r < 17; ++r)
#pragma unroll
            for (int c = 0; c < 4; ++c) { float v = acc[r][c]; v += __shfl_xor(v, 8); v += __shfl_xor(v, 16); v += __shfl_xor(v, 32);
                if (lane < 8) red[(wv * 32 + cq * 4 + c) * 17 + r] = v; }
        __syncthreads();
        for (int o = tid; o < 32 * 17; o += NTHREADS) { const int col = o & 31, r = o >> 5;
            float sum = p.b_mod[l * NMOD + c0 + col];
#pragma unroll
            for (int q = 0; q < 8; ++q) sum += red[(q * 32 + col) * 17 + r];
            modv[(size_t)(l * 17 + r) * NMOD + c0 + col] = sum; }
        __syncthreads();
    }
}
__device__ __forceinline__ void phase_prep(const Params& p) {
    const int tid_ = otid();
    const int gt = blockIdx.x * NTHREADS + tid_, nt = gridDim.x * NTHREADS;
    float* lb = (float*)(p.ws + OFF_LB);
    for (int i = gt; i < 2 * 1024; i += nt) { const float x0 = p.lb_logits[i], x1 = p.lb_logits[2048 + i]; lb[i] = 0.f; lb[2048 + i] = 1.0f / (1.0f + expf(x0 - x1)); }
    float* s5lam = (float*)(p.ws + OFF_S5LAM); float* s5bb = (float*)(p.ws + OFF_S5BB);
    for (int i = gt; i < 2 * 2 * 48 * 64; i += nt) {
        const int ldg = i >> 6;
        const double lre = (double)p.lam_re[i], lim = (double)p.lam_im[i], dt = exp((double)p.log_step[ldg]);
        const double er = exp(lre * dt); double sn, cs; sincos(lim * dt, &sn, &cs);
        const double br = er * cs, bi = er * sn;
        s5lam[i * 2] = (float)br; s5lam[i * 2 + 1] = (float)bi;
        const double nr = br - 1.0, ni = bi, den = lre * lre + lim * lim;
        const double cr = (nr * lre + ni * lim) / den, ci = (ni * lre - nr * lim) / den;
        for (int d = 0; d < 16; ++d) { const double xr = (double)p.b_re[(size_t)i * 16 + d], xi = (double)p.b_im[(size_t)i * 16 + d];
            s5bb[(size_t)i * 32 + d] = (float)(cr * xr - ci * xi); s5bb[(size_t)i * 32 + 16 + d] = (float)(cr * xi + ci * xr); }
    }
    float* pe = (float*)(p.ws + OFF_PE);
    for (int i = gt; i < 96 * 1024; i += nt) {
        const int r = i >> 10, cc = i & 1023, j = cc & 511;
        const float pos = (float)(r < 32 ? r : r - 32);
        const float omega = 1.0f / powf(10000.0f, (float)j * (1.0f / 512.0f));
        const float ang = pos * omega;
        pe[i] = cc < 512 ? sinf(ang) : cosf(ang);
    }
}

template <int MAPMODE>
__device__ __forceinline__ void transpose_convert(const float* src, int K, int N, bf16_t* dst, LAS unsigned char* lds) {
    const int tid_ = otid();
    LAS float* tile = (LAS float*)lds;
    const int tid = tid_, nkb = K / 64, nnb = N / 64;
    for (int u = blockIdx.x; u < nkb * nnb; u += gridDim.x) {
        const int kb = u / nnb, nb = u % nnb, k0 = kb * 64, n0 = nb * 64;
        { const int nn = tid & 63, kk = tid >> 6;
#pragma unroll
          for (int i = 0; i < 8; ++i) tile[(kk + i * 8) * 65 + nn] = src[(size_t)(k0 + kk + i * 8) * N + n0 + nn]; }
        __syncthreads();
        { const int kk2 = (tid & 7) * 8, nn2 = tid >> 3; float v[8];
#pragma unroll
          for (int i = 0; i < 8; ++i) v[i] = tile[(kk2 + i) * 65 + nn2];
          int n = n0 + nn2, nr;
          if (MAPMODE == 1) { if (n < 768) nr = (n >> 7) * 256 + (n & 127); else { const int m = n - 768; nr = (m >> 7) * 256 + 128 + (m & 127); } } else nr = n;
          u32x4 w; w.x = cvt_pk_bf16(v[0], v[1]); w.y = cvt_pk_bf16(v[2], v[3]); w.z = cvt_pk_bf16(v[4], v[5]); w.w = cvt_pk_bf16(v[6], v[7]);
          *(u32x4*)(dst + (size_t)nr * K + k0 + kk2) = w; }
        __syncthreads();
    }
}
__device__ __forceinline__ void phase_wscore(const float* wq, const float* sk, bf16_t* dst, LAS unsigned char* lds) {
    const int tid_ = otid();
    LAS float* skt = (LAS float*)lds;
    LAS float* wqt = (LAS float*)(lds + 128 * 129 * 4);
    const int tid = tid_;
    for (int u = blockIdx.x; u < 16 * 32; u += gridDim.x) {
        const int hp = u >> 5, kb = u & 31;
        for (int i = tid; i < 128 * 128; i += NTHREADS) { const int key = i >> 7, e = i & 127; skt[key * 129 + e] = sk[(size_t)hp * 16384 + i]; }
        for (int i = tid; i < 64 * 128; i += NTHREADS) { const int k = i >> 7, e = i & 127; wqt[e * 68 + k] = wq[(size_t)(kb * 64 + k) * 2048 + hp * 128 + e]; }
        __syncthreads();
        const int key = tid & 127, kg = tid >> 7;
        float acc[16];
#pragma unroll
        for (int i = 0; i < 16; ++i) acc[i] = 0.f;
        for (int e = 0; e < 128; ++e) {
            const float s = skt[key * 129 + e];
#pragma unroll
            for (int q = 0; q < 4; ++q) { const f32x4 w4 = *(const LAS f32x4*)(wqt + e * 68 + kg * 16 + q * 4);
                acc[q * 4 + 0] += s * w4[0]; acc[q * 4 + 1] += s * w4[1]; acc[q * 4 + 2] += s * w4[2]; acc[q * 4 + 3] += s * w4[3]; }
        }
        bf16_t* o = dst + (size_t)(hp * 128 + key) * 2048 + kb * 64 + kg * 16;
        u32x4 w0, w1;
        w0.x = cvt_pk_bf16(acc[0], acc[1]); w0.y = cvt_pk_bf16(acc[2], acc[3]); w0.z = cvt_pk_bf16(acc[4], acc[5]); w0.w = cvt_pk_bf16(acc[6], acc[7]);
        w1.x = cvt_pk_bf16(acc[8], acc[9]); w1.y = cvt_pk_bf16(acc[10], acc[11]); w1.z = cvt_pk_bf16(acc[12], acc[13]); w1.w = cvt_pk_bf16(acc[14], acc[15]);
        *(u32x4*)o = w0; *(u32x4*)(o + 8) = w1;
        __syncthreads();
    }
}
__device__ __forceinline__ void phase_colmax(const Params& p) {
    const int tid_ = otid();
    unsigned* cm = (unsigned*)(p.ws + OFF_CMAX);
    const int total = 2 * (INC / 4) * 16;
    for (int i = blockIdx.x * NTHREADS + tid_; i < total; i += gridDim.x * NTHREADS) {
        const int kc = i / (2 * (INC / 4)), cidx = i % (2 * (INC / 4)), l = cidx / (INC / 4), nq = cidx % (INC / 4);
        const float* w = p.w_in + (size_t)l * D * INC + (size_t)(kc * 128) * INC + nq * 4;
        f32x4 am = (f32x4){0.f, 0.f, 0.f, 0.f};
#pragma unroll 32
        for (int k = 0; k < 128; ++k) { const f32x4 v = *(const f32x4*)(w + (size_t)k * INC);
            am[0] = fmaxf(am[0], fabsf(v[0])); am[1] = fmaxf(am[1], fabsf(v[1])); am[2] = fmaxf(am[2], fabsf(v[2])); am[3] = fmaxf(am[3], fabsf(v[3])); }
        unsigned* o = cm + l * INC + nq * 4;
        atomicMax(o, __float_as_uint(am[0])); atomicMax(o + 1, __float_as_uint(am[1])); atomicMax(o + 2, __float_as_uint(am[2])); atomicMax(o + 3, __float_as_uint(am[3]));
    }
}
__device__ __forceinline__ void transpose_convert_fp8(const float* src, int K, int N, unsigned char* dst, const unsigned* cmax, LAS unsigned char* lds) {
    const int tid_ = otid();
    LAS float* tile = (LAS float*)lds;
    const int tid = tid_, nkb = K / 64, nnb = N / 64;
    for (int u = blockIdx.x; u < nkb * nnb; u += gridDim.x) {
        const int kb = u / nnb, nb = u % nnb, k0 = kb * 64, n0 = nb * 64;
        { const int nn = tid & 63, kk = tid >> 6;
#pragma unroll
          for (int i = 0; i < 8; ++i) tile[(kk + i * 8) * 65 + nn] = src[(size_t)(k0 + kk + i * 8) * N + n0 + nn]; }
        __syncthreads();
        { const int kk2 = (tid & 7) * 8, nn2 = tid >> 3; float v[8];
          const float cmv = __uint_as_float(cmax[n0 + nn2]); const float sc = cmv > 0.f ? 240.0f / cmv : 1.0f;
#pragma unroll
          for (int i = 0; i < 8; ++i) v[i] = tile[(kk2 + i) * 65 + nn2] * sc;
          u32x2 w; w.x = pack_fp8x4(v[0], v[1], v[2], v[3]); w.y = pack_fp8x4(v[4], v[5], v[6], v[7]);
          *(u32x2*)(dst + (size_t)(n0 + nn2) * K + k0 + kk2) = w; }
        __syncthreads();
    }
}
__device__ __forceinline__ void phase_wconv(const Params& p, int l, LAS unsigned char* lds) {
    unsigned char* W = p.ws + OFF_W;
    transpose_convert_fp8(p.w_in + (size_t)l * D * INC, D, INC, W + W_IN, (const unsigned*)(p.ws + OFF_CMAX) + (size_t)l * INC, lds);
    transpose_convert<1>(p.w_glu + (size_t)l * 768 * 1536, 768, 1536, (bf16_t*)(W + W_GLU), lds);
    transpose_convert<0>(p.wa + (size_t)l * 1024 * D, 1024, D, (bf16_t*)(W + W_A), lds);
    transpose_convert<0>(p.wb + (size_t)l * 1024 * D, 1024, D, (bf16_t*)(W + W_B), lds);
    transpose_convert<0>(p.wc + (size_t)l * 768 * D, 768, D, (bf16_t*)(W + W_C), lds);
    transpose_convert<0>(p.wo + (size_t)l * D * D, D, D, (bf16_t*)(W + W_O), lds);
    phase_wscore(p.w_q + (size_t)l * D * D, p.sub_keys + (size_t)l * 16 * 16384, (bf16_t*)(W + W_S), lds);
}
__device__ __forceinline__ void phase_tabconv(const Params& p, int l) {
    const int tid_ = otid();
    const int lane = tid_ & 63, gw = blockIdx.x * 8 + __builtin_amdgcn_readfirstlane(tid_ >> 6), nw = gridDim.x * 8;
    unsigned char* U6 = p.ws + OFF_P + Q_UT; unsigned char* V6 = p.ws + OFF_P + Q_VT;
    float* USC = (float*)(p.ws + OFF_P + Q_USC); float* VSC = (float*)(p.ws + OFF_P + Q_VSC);
    for (int r = gw; r < 32768; r += nw) {
        const bool isv = r >= 16384; const int rr = r & 16383;
        const float* src = (isv ? p.peer_v : p.peer_u) + (size_t)l * 16384 * 2048 + (size_t)rr * 2048;
        f32x4 v[8];
#pragma unroll
        for (int j = 0; j < 8; ++j) v[j] = *(const f32x4*)(src + j * 256 + lane * 4);
        float am = 0.f;
#pragma unroll
        for (int j = 0; j < 8; ++j) am = fmaxf(am, fmaxf(fmaxf(fabsf(v[j][0]), fabsf(v[j][1])), fmaxf(fabsf(v[j][2]), fabsf(v[j][3]))));
#pragma unroll
        for (int o = 32; o >= 1; o >>= 1) am = fmaxf(am, __shfl_xor(am, o));
        {
            const float sc4 = am > 0.f ? 6.0f / am : 1.0f;
            unsigned wd[4] = {0u, 0u, 0u, 0u};
#pragma unroll
            for (int j = 0; j < 8; ++j) {
                if ((j & 1) == 0) { wd[j >> 1] = __builtin_amdgcn_cvt_scalef32_pk_fp4_f32(wd[j >> 1], v[j][0] * sc4, v[j][1] * sc4, 1.0f, 0); wd[j >> 1] = __builtin_amdgcn_cvt_scalef32_pk_fp4_f32(wd[j >> 1], v[j][2] * sc4, v[j][3] * sc4, 1.0f, 1); }
                else { wd[j >> 1] = __builtin_amdgcn_cvt_scalef32_pk_fp4_f32(wd[j >> 1], v[j][0] * sc4, v[j][1] * sc4, 1.0f, 2); wd[j >> 1] = __builtin_amdgcn_cvt_scalef32_pk_fp4_f32(wd[j >> 1], v[j][2] * sc4, v[j][3] * sc4, 1.0f, 3); } }
            u32x4 w4; w4.x = wd[0]; w4.y = wd[1]; w4.z = wd[2]; w4.w = wd[3];
            *(u32x4*)((isv ? V6 : U6) + (size_t)rr * 1024 + lane * 16) = w4;
            if (lane == 0) (isv ? VSC : USC)[rr] = am > 0.f ? am * (1.0f / 6.0f) : 1.0f;
        }
    }
}

template <int MODE, bool F8OUT = false>
__device__ __forceinline__ void phase_norm(const Params& p, int l, int M, int off_sh, int off_sc) {
    const int tid_ = otid();
    const int lane = tid_ & 63, gw = blockIdx.x * 8 + __builtin_amdgcn_readfirstlane(tid_ >> 6), nw = gridDim.x * 8;
    const float* modv = (const float*)(p.ws + OFF_MODV) + (size_t)l * 17 * NMOD;
    const float* pe = (const float*)(p.ws + OFF_PE);
    float* XC = (float*)(p.ws + OFF_XC);
    bf16_t* H = (bf16_t*)(p.ws + OFF_H);
    for (int r = gw; r < M; r += nw) {
        const bool lat = r < TL;
        const float* src = MODE == 0 ? (lat ? p.x + (size_t)r * D : p.ctx + (size_t)(r - TL) * D) : (lat ? p.out + (size_t)r * D : XC + (size_t)(r - TL) * D);
        f32x4 v[4][2];
#pragma unroll
        for (int j = 0; j < 4; ++j) { v[j][0] = *(const f32x4*)(src + j * 512 + lane * 8); v[j][1] = *(const f32x4*)(src + j * 512 + lane * 8 + 4); }
        if (MODE == 0) {
            if (lat) { const int n = r & 2047, gr = n >> 6, gc = n & 63;
#pragma unroll
                for (int j = 0; j < 4; ++j) { const float* pr = (j < 2) ? pe + (size_t)gr * 1024 + j * 512 + lane * 8 : pe + (size_t)(32 + gc) * 1024 + (j - 2) * 512 + lane * 8;
                    v[j][0] += *(const f32x4*)pr; v[j][1] += *(const f32x4*)(pr + 4); } }
            float* dst = lat ? p.out + (size_t)r * D : XC + (size_t)(r - TL) * D;
#pragma unroll
            for (int j = 0; j < 4; ++j) { *(f32x4*)(dst + j * 512 + lane * 8) = v[j][0]; *(f32x4*)(dst + j * 512 + lane * 8 + 4) = v[j][1]; }
        }
        float ss = 0.f;
#pragma unroll
        for (int j = 0; j < 4; ++j)
#pragma unroll
            for (int h = 0; h < 2; ++h) ss += v[j][h][0] * v[j][h][0] + v[j][h][1] * v[j][h][1] + v[j][h][2] * v[j][h][2] + v[j][h][3] * v[j][h][3];
        ss = wave_sum(ss);
        const float rs = rsqrtf(ss * (1.0f / 2048.0f) + 1e-6f);
        const int mb = lat ? (r >> 11) : 16;
        const float* sh = modv + (size_t)mb * NMOD + off_sh; const float* sc = modv + (size_t)mb * NMOD + off_sc;
        if (F8OUT) {
            float am = 0.f;
#pragma unroll
            for (int j = 0; j < 4; ++j) { const int e = j * 512 + lane * 8;
                const f32x4 s0 = *(const f32x4*)(sc + e), s1 = *(const f32x4*)(sc + e + 4), h0 = *(const f32x4*)(sh + e), h1 = *(const f32x4*)(sh + e + 4);
                v[j][0] = v[j][0] * rs * (s0 + 1.0f) + h0; v[j][1] = v[j][1] * rs * (s1 + 1.0f) + h1;
#pragma unroll
                for (int hh = 0; hh < 2; ++hh) am = fmaxf(am, fmaxf(fmaxf(fabsf(v[j][hh][0]), fabsf(v[j][hh][1])), fmaxf(fabsf(v[j][hh][2]), fabsf(v[j][hh][3])))); }
#pragma unroll
            for (int o = 32; o >= 1; o >>= 1) am = fmaxf(am, __shfl_xor(am, o));
            const float q = am > 0.f ? 240.0f / am : 1.0f;
            unsigned char* H8 = p.ws + OFF_H8 + (size_t)r * D;
#pragma unroll
            for (int j = 0; j < 4; ++j) { u32x2 w; w.x = pack_fp8x4(v[j][0][0] * q, v[j][0][1] * q, v[j][0][2] * q, v[j][0][3] * q); w.y = pack_fp8x4(v[j][1][0] * q, v[j][1][1] * q, v[j][1][2] * q, v[j][1][3] * q);
                *(u32x2*)(H8 + j * 512 + lane * 8) = w; }
            if (lane == 0) ((float*)(p.ws + OFF_HS))[r] = am > 0.f ? am * (1.0f / 240.0f) : 1.0f;
        } else {
#pragma unroll
        for (int j = 0; j < 4; ++j) {
            const int e = j * 512 + lane * 8;
            const f32x4 s0 = *(const f32x4*)(sc + e), s1 = *(const f32x4*)(sc + e + 4), h0 = *(const f32x4*)(sh + e), h1 = *(const f32x4*)(sh + e + 4);
            f32x4 a = v[j][0] * rs * (s0 + 1.0f) + h0, b = v[j][1] * rs * (s1 + 1.0f) + h1;
            u32x4 w; w.x = cvt_pk_bf16(a[0], a[1]); w.y = cvt_pk_bf16(a[2], a[3]); w.z = cvt_pk_bf16(b[0], b[1]); w.w = cvt_pk_bf16(b[2], b[3]);
            *(u32x4*)(H + (size_t)r * D + e) = w;
        }
        }
    }
}
__device__ __forceinline__ bf16x8 mk_bf16x8(unsigned a, unsigned b, unsigned c, unsigned d) { u32x4 q; q.x = a; q.y = b; q.z = c; q.w = d; return __builtin_bit_cast(bf16x8, q); }
__device__ __forceinline__ void phase_hgrn(const Params& p, int l, LAS unsigned char* lds, bool dry = false) {
    const int tid_ = otid();
    const int lane = tid_ & 63, w = __builtin_amdgcn_readfirstlane(tid_ >> 6), q = lane >> 4, m = lane & 15;
    constexpr int OQ = 0, OKH = 4352, OKT = 8704, OIT = 14848, OE = 20992, BUFSZ = 21504, RAWOFF = 2 * 21504, RAWSZ = 3 * 4352;
    unsigned char* P = p.ws + OFF_P;
    const float* lbp = (const float*)(p.ws + OFF_LB) + (size_t)l * 2048;
    const int kch = 16 * w + m;
    for (int u = blockIdx.x; u < 256; u += gridDim.x) {
        const int b = u >> 4, h = (u >> 1) & 7, dir = u & 1;
        const bf16_t* BQ = (const bf16_t*)(P + P_BQ); const bf16_t* BI = (const bf16_t*)(P + P_BI);
        bf16_t* BF = (bf16_t*)(P + (dir ? P_BFB : P_BFF));
        const float lbv = lbp[dir * 1024 + h * 128 + kch];
        f32x4 Sacc[8];
#pragma unroll
        for (int i = 0; i < 8; ++i) Sacc[i] = (f32x4){0.f, 0.f, 0.f, 0.f};
        for (int seg = 0; seg < 2; ++seg) {
            const int len = seg == 0 ? CTXL : SEQ, rbase = seg == 0 ? TL + b * CTXL : b * SEQ, nch = len / 16;
            u32x4 g0 = (u32x4){0u, 0u, 0u, 0u}, g1 = g0;
            const int gs = (tid_ & 255) >> 4, gc8 = (tid_ & 15) * 8;
#define HG_GLOAD(c) do { const int st = (c) * 16 + gs, n = dir ? (len - 1 - st) : st; const size_t o = (size_t)(rbase + n) * 1024 + h * 128 + gc8; \
                if (tid_ < 256) { g0 = *(const u32x4*)(BQ + o); g1 = *(const u32x4*)(BF + o); } else { g0 = *(const u32x4*)(BI + o); } } while (0)
#define HG_RAWW(c) do { LAS unsigned char* rw = lds + RAWOFF + ((c) & 1) * RAWSZ + gs * 272 + gc8 * 2; \
                if (tid_ < 256) { *(LAS u32x4*)(rw) = g0; *(LAS u32x4*)(rw + 4352) = g1; } else { *(LAS u32x4*)(rw + 8704) = g0; } } while (0)
#define HG_STAGE(c, bufp) do { float fv[4], cb[4]; float run = 0.f; unsigned short rq[4], rf[4], ri[4]; \
                { const LAS unsigned char* rr = lds + RAWOFF + ((c) & 1) * RAWSZ + kch * 2; _Pragma("unroll") for (int j = 0; j < 4; ++j) { rq[j] = *(const LAS bf16_t*)(rr + (4 * q + j) * 272); rf[j] = *(const LAS bf16_t*)(rr + 4352 + (4 * q + j) * 272); ri[j] = *(const LAS bf16_t*)(rr + 8704 + (4 * q + j) * 272); } } \
                _Pragma("unroll") for (int j = 0; j < 4; ++j) { const float xf = __uint_as_float(((unsigned)rf[j]) << 16); fv[j] = lbv + (1.0f - lbv) * fast_sigmoid(xf); run += flog(fv[j]); cb[j] = run; } \
                const float t0 = __shfl(run, m), t1 = __shfl(run, m + 16), t2 = __shfl(run, m + 32); \
                const float off = (q > 0 ? t0 : 0.f) + (q > 1 ? t1 : 0.f) + (q > 2 ? t2 : 0.f); \
                float qh[4], kh[4]; \
                _Pragma("unroll") for (int j = 0; j < 4; ++j) { const float bb = off + cb[j], bc = fmaxf(bb, -80.0f); qh[j] = __uint_as_float(((unsigned)rq[j]) << 16) * fexp(bc); kh[j] = (1.0f - fv[j]) * fexp(-bc);     \
                    if (j == 3 && q == 3) *(LAS float*)((bufp) + OE + kch * 4) = fexp(bb); } \
                const unsigned q01 = cvt_pk_bf16(qh[0], qh[1]), q23 = cvt_pk_bf16(qh[2], qh[3]), k01 = cvt_pk_bf16(kh[0], kh[1]), k23 = cvt_pk_bf16(kh[2], kh[3]); \
                *(LAS bf16_t*)((bufp) + OQ + (4 * q + 0) * 272 + kch * 2) = (bf16_t)(q01 & 0xffffu); *(LAS bf16_t*)((bufp) + OQ + (4 * q + 1) * 272 + kch * 2) = (bf16_t)(q01 >> 16); \
                *(LAS bf16_t*)((bufp) + OQ + (4 * q + 2) * 272 + kch * 2) = (bf16_t)(q23 & 0xffffu); *(LAS bf16_t*)((bufp) + OQ + (4 * q + 3) * 272 + kch * 2) = (bf16_t)(q23 >> 16); \
                *(LAS bf16_t*)((bufp) + OKH + (4 * q + 0) * 272 + kch * 2) = (bf16_t)(k01 & 0xffffu); *(LAS bf16_t*)((bufp) + OKH + (4 * q + 1) * 272 + kch * 2) = (bf16_t)(k01 >> 16); \
                *(LAS bf16_t*)((bufp) + OKH + (4 * q + 2) * 272 + kch * 2) = (bf16_t)(k23 & 0xffffu); *(LAS bf16_t*)((bufp) + OKH + (4 * q + 3) * 272 + kch * 2) = (bf16_t)(k23 >> 16); \
                u32x2 kt2; kt2.x = k01; kt2.y = k23; *(LAS u32x2*)((bufp) + OKT + kch * 48 + q * 8) = kt2; \
                u32x2 it2; it2.x = (unsigned)ri[0] | ((unsigned)ri[1] << 16); it2.y = (unsigned)ri[2] | ((unsigned)ri[3] << 16); *(LAS u32x2*)((bufp) + OIT + kch * 48 + q * 8) = it2; } while (0)
#define HG_COMPUTE(c) do { \
                LAS unsigned char* buf = lds + ((c) & 1) * BUFSZ; \
                f32x4 at = (f32x4){0.f, 0.f, 0.f, 0.f}; \
                _Pragma("unroll") \
                for (int kb = 0; kb < 4; ++kb) { const bf16x8 a = *(const LAS bf16x8*)(buf + OKH + m * 272 + kb * 64 + q * 16), bq = *(const LAS bf16x8*)(buf + OQ + m * 272 + kb * 64 + q * 16); \
                    at = __builtin_amdgcn_mfma_f32_16x16x32_bf16(a, bq, at, 0, 0, 0); } \
                asm volatile("s_nop 15\n s_nop 15" : "+v"(at)); \
                _Pragma("unroll") \
                for (int r = 0; r < 4; ++r) at[r] = (4 * q + r <= m) ? at[r] : 0.f; \
                const bf16x8 attB = mk_bf16x8(cvt_pk_bf16(at[0], at[1]), cvt_pk_bf16(at[2], at[3]), 0u, 0u); \
                f32x4 oacc = (f32x4){0.f, 0.f, 0.f, 0.f}; \
                _Pragma("unroll") \
                for (int kb = 0; kb < 4; ++kb) { \
                    const bf16x8 a = mk_bf16x8(cvt_pk_bf16(Sacc[2 * kb][0], Sacc[2 * kb][1]), cvt_pk_bf16(Sacc[2 * kb][2], Sacc[2 * kb][3]), cvt_pk_bf16(Sacc[2 * kb + 1][0], Sacc[2 * kb + 1][1]), cvt_pk_bf16(Sacc[2 * kb + 1][2], Sacc[2 * kb + 1][3])); \
                    const u32x2 b0 = *(const LAS u32x2*)(buf + OQ + m * 272 + (32 * kb + 4 * q) * 2), b1 = *(const LAS u32x2*)(buf + OQ + m * 272 + (32 * kb + 16 + 4 * q) * 2); \
                    oacc = __builtin_amdgcn_mfma_f32_16x16x32_bf16(a, mk_bf16x8(b0.x, b0.y, b1.x, b1.y), oacc, 0, 0, 0); } \
                { const u32x2 i0 = *(const LAS u32x2*)(buf + OIT + (16 * w + m) * 48 + q * 8); \
                  oacc = __builtin_amdgcn_mfma_f32_16x16x32_bf16(mk_bf16x8(i0.x, i0.y, 0u, 0u), attB, oacc, 0, 0, 0); } \
                asm volatile("s_nop 15\n s_nop 15" : "+v"(oacc)); \
                { const int st = (c) * 16 + m, n = dir ? (len - 1 - st) : st; \
                  u32x2 o2; o2.x = cvt_pk_bf16(oacc[0], oacc[1]); o2.y = cvt_pk_bf16(oacc[2], oacc[3]); \
                  if (!dry || p.ws == nullptr) *(u32x2*)(BF + (size_t)(rbase + n) * 1024 + h * 128 + 16 * w + 4 * q) = o2; } \
                u32x4 bsu = (u32x4){0u, 0u, 0u, 0u}; \
                if (q < 2) bsu = *(const LAS u32x4*)(buf + OIT + (16 * w + m) * 48 + q * 16); \
                const bf16x8 bs = __builtin_bit_cast(bf16x8, bsu); \
                _Pragma("unroll") \
                for (int kt = 0; kt < 8; ++kt) { u32x4 au = (u32x4){0u, 0u, 0u, 0u}; \
                    if (q < 2) au = *(const LAS u32x4*)(buf + OKT + (16 * kt + m) * 48 + q * 16); \
                    Sacc[kt] = __builtin_amdgcn_mfma_f32_16x16x32_bf16(__builtin_bit_cast(bf16x8, au), bs, Sacc[kt], 0, 0, 0); } \
                asm volatile("s_nop 15\n s_nop 15" : "+v"(Sacc[0]), "+v"(Sacc[1]), "+v"(Sacc[2]), "+v"(Sacc[3]), "+v"(Sacc[4]), "+v"(Sacc[5]), "+v"(Sacc[6]), "+v"(Sacc[7])); \
                _Pragma("unroll") \
                for (int kt = 0; kt < 8; ++kt) Sacc[kt] *= *(const LAS f32x4*)(buf + OE + (16 * kt + 4 * q) * 4); \
                } while (0)
            HG_GLOAD(0); HG_RAWW(0);
            if (nch > 1) { HG_GLOAD(1); HG_RAWW(1); }
            if (nch > 2) HG_GLOAD(2);
            __syncthreads();
            HG_STAGE(0, lds);
            __syncthreads();
            for (int c = 0; c < nch; ++c) {
                if (c + 2 < nch) { HG_RAWW(c + 2); if (c + 3 < nch) HG_GLOAD(c + 3); }
                if (c + 1 < nch) HG_STAGE(c + 1, lds + ((c + 1) & 1) * BUFSZ);
                HG_COMPUTE(c);
                __syncthreads();
            }
#undef HG_COMPUTE
#undef HG_GLOAD
#undef HG_RAWW
#undef HG_STAGE
        }
        __syncthreads();
    }
}
__device__ __forceinline__ void phase_hcomb(const Params& p, int l, int M, bool dry = false) {
    const int tid_ = otid();
    const int lane = tid_ & 63, gw = blockIdx.x * 8 + __builtin_amdgcn_readfirstlane(tid_ >> 6), nw = gridDim.x * 8;
    unsigned char* P = p.ws + OFF_P;
    bf16_t* OF = (bf16_t*)(P + P_BFF); const bf16_t* OB = (const bf16_t*)(P + P_BFB); const bf16_t* BG = (const bf16_t*)(P + P_BG);
    const float* hg = p.hn_g + (size_t)l * 1024 + lane * 16;
    for (int r = gw; r < M; r += nw) {
        const size_t o = (size_t)r * 1024 + lane * 16;
        float x[16]; float ss = 0.f;
#pragma unroll
        for (int hh = 0; hh < 2; ++hh) { const u32x4 a = *(const u32x4*)(OF + o + hh * 8), bq = *(const u32x4*)(OB + o + hh * 8);
            const unsigned aa[4] = {a.x, a.y, a.z, a.w}, bb[4] = {bq.x, bq.y, bq.z, bq.w};
#pragma unroll
            for (int j = 0; j < 4; ++j) { x[hh * 8 + 2 * j] = bf_lo(aa[j]) + bf_lo(bb[j]); x[hh * 8 + 2 * j + 1] = bf_hi(aa[j]) + bf_hi(bb[j]); } }
#pragma unroll
        for (int j = 0; j < 16; ++j) ss += x[j] * x[j];
        ss += __shfl_xor(ss, 1); ss += __shfl_xor(ss, 2); ss += __shfl_xor(ss, 4);
        const float rs = rsqrtf(ss * (1.0f / 128.0f) + 1e-6f);
#pragma unroll
        for (int hh = 0; hh < 2; ++hh) { const u32x4 gq = *(const u32x4*)(BG + o + hh * 8); const unsigned gg[4] = {gq.x, gq.y, gq.z, gq.w};
            float y[8];
#pragma unroll
            for (int j = 0; j < 4; ++j) { y[2 * j] = x[hh * 8 + 2 * j] * rs * hg[hh * 8 + 2 * j] * bf_lo(gg[j]); y[2 * j + 1] = x[hh * 8 + 2 * j + 1] * rs * hg[hh * 8 + 2 * j + 1] * bf_hi(gg[j]); }
            u32x4 w; w.x = cvt_pk_bf16(y[0], y[1]); w.y = cvt_pk_bf16(y[2], y[3]); w.z = cvt_pk_bf16(y[4], y[5]); w.w = cvt_pk_bf16(y[6], y[7]);
            if (!dry || p.ws == nullptr) *(u32x4*)(OF + o + hh * 8) = w; }
    }
}

__device__ __forceinline__ bf16x8 pack_bf16x8(const float (&v)[8]) {
    const unsigned a = cvt_pk_bf16(v[0], v[1]), b = cvt_pk_bf16(v[2], v[3]), c = cvt_pk_bf16(v[4], v[5]), d = cvt_pk_bf16(v[6], v[7]);
    u32x4 q; q.x = a; q.y = b; q.z = c; q.w = d;
    return __builtin_bit_cast(bf16x8, q);
}
__device__ __forceinline__ void phase_s5(const Params& p, int l, LAS unsigned char* lds) {
    const int tid_ = otid();
    const int lane = tid_ & 63, w = __builtin_amdgcn_readfirstlane(tid_ >> 6);
    if (w >= 6) return;
    LAS float* BU = (LAS float*)(lds + w * 12800);
    LAS unsigned char* XB = lds + w * 12800 + 8448;
    const int lq = lane >> 4, lr = lane & 15;
    const bf16_t* CU = (const bf16_t*)(p.ws + OFF_P + P_CU);
    const float* s5lam = (const float*)(p.ws + OFF_S5LAM); const float* s5bb = (const float*)(p.ws + OFF_S5BB);
    for (int s = w * (int)gridDim.x + (int)blockIdx.x; s < 1536; s += 6 * (int)gridDim.x) {
        const int dir = s & 1, g = (s >> 1) % 48, b = s / 96;
        const int ldg = (l * 2 + dir) * 48 + g;
        const float lre = s5lam[(size_t)(ldg * 64 + lane) * 2], lim = s5lam[(size_t)(ldg * 64 + lane) * 2 + 1];
        bf16x8 bbf[8], cf[4];
#pragma unroll
        for (int nt = 0; nt < 8; ++nt) { const int col = nt * 16 + lr, pp = col >> 1, c = col & 1; float v[8];
#pragma unroll
            for (int j = 0; j < 8; ++j) v[j] = (lq < 2) ? s5bb[(size_t)(ldg * 64 + pp) * 32 + c * 16 + lq * 8 + j] : 0.f;
            bbf[nt] = pack_bf16x8(v); }
#pragma unroll
        for (int kb = 0; kb < 4; ++kb) { float v[8];
#pragma unroll
            for (int j = 0; j < 8; ++j) { const int k = kb * 32 + lq * 8 + j, pp = k >> 1; const size_t ci = ((size_t)ldg * 16 + lr) * 64 + pp;
                v[j] = (k & 1) ? -p.c_im[ci] : p.c_re[ci]; }
            cf[kb] = pack_bf16x8(v); }
        bf16_t* YS = (bf16_t*)(p.ws + OFF_H + (dir ? H_YSB : H_YSF));
        float xr = 0.f, xi = 0.f;
        for (int seg = 0; seg < 2; ++seg) {
            const int len = seg == 0 ? CTXL : SEQ, rbase = seg == 0 ? TL + b * CTXL : b * SEQ, nblk = len / 64;
            u32x4 unext[4];
#pragma unroll
            for (int tt = 0; tt < 4; ++tt) { unext[tt] = (u32x4){0u, 0u, 0u, 0u};
                if (lq < 2) { const int st = tt * 16 + lr, n = dir ? (len - 1 - st) : st; unext[tt] = *(const u32x4*)(CU + (size_t)(rbase + n) * 768 + g * 16 + lq * 8); } }
            for (int blk = 0; blk < nblk; ++blk) {
                u32x4 ucur[4];
#pragma unroll
                for (int tt = 0; tt < 4; ++tt) ucur[tt] = unext[tt];
                if (blk + 1 < nblk && lq < 2) {
#pragma unroll
                    for (int tt = 0; tt < 4; ++tt) { const int st = (blk + 1) * 64 + tt * 16 + lr, n = dir ? (len - 1 - st) : st; unext[tt] = *(const u32x4*)(CU + (size_t)(rbase + n) * 768 + g * 16 + lq * 8); } }
#pragma unroll
                for (int tt = 0; tt < 4; ++tt) {
                    const bf16x8 uf = __builtin_bit_cast(bf16x8, ucur[tt]);
                    f32x4 dd[8];
#pragma unroll
                    for (int nt = 0; nt < 8; ++nt) dd[nt] = __builtin_amdgcn_mfma_f32_16x16x32_bf16(bbf[nt], uf, (f32x4){0.f, 0.f, 0.f, 0.f}, 0, 0, 0);
                    asm volatile("s_nop 15\n s_nop 15" : "+v"(dd[0]), "+v"(dd[1]), "+v"(dd[2]), "+v"(dd[3]), "+v"(dd[4]), "+v"(dd[5]), "+v"(dd[6]), "+v"(dd[7]));
#pragma unroll
                    for (int nt = 0; nt < 8; ++nt) *(LAS f32x4*)(BU + lr * 132 + nt * 16 + lq * 4) = dd[nt];
                    asm volatile("s_waitcnt lgkmcnt(0)" ::: "memory");
                    f32x2 bu[16];
#pragma unroll
                    for (int t = 0; t < 16; ++t) bu[t] = *(const LAS f32x2*)(BU + t * 132 + 2 * lane);
#pragma unroll
                    for (int t = 0; t < 16; ++t) { const float nr = lre * xr - lim * xi + bu[t].x, ni = lre * xi + lim * xr + bu[t].y; xr = nr; xi = ni;
                        *(LAS unsigned*)(XB + t * 272 + lane * 4) = cvt_pk_bf16(xr, xi); }
                    asm volatile("s_waitcnt lgkmcnt(0)" ::: "memory");
                    f32x4 acc = (f32x4){0.f, 0.f, 0.f, 0.f};
#pragma unroll
                    for (int kb = 0; kb < 4; ++kb) { const bf16x8 xf = *(const LAS bf16x8*)(XB + lr * 272 + kb * 64 + lq * 16); acc = __builtin_amdgcn_mfma_f32_16x16x32_bf16(cf[kb], xf, acc, 0, 0, 0); }
                    asm volatile("s_nop 15\n s_nop 15\n s_waitcnt lgkmcnt(0)" : "+v"(acc) :: "memory");
                    const int st = blk * 64 + tt * 16 + lr, n = dir ? (len - 1 - st) : st;
                    u32x2 o; o.x = cvt_pk_bf16(acc[0], acc[1]); o.y = cvt_pk_bf16(acc[2], acc[3]);
                    *(u32x2*)(YS + (size_t)(rbase + n) * 768 + g * 16 + lq * 4) = o;
                }
            }
        }
    }
}
__device__ __forceinline__ void phase_s5post(const Params& p, int l, int M, bool dry = false) {
    const int tid_ = otid();
    const size_t n8 = (size_t)M * 768 / 8;
    bf16_t* YF = (bf16_t*)(p.ws + OFF_H + H_YSF); const bf16_t* YB = (const bf16_t*)(p.ws + OFF_H + H_YSB); const bf16_t* CU = (const bf16_t*)(p.ws + OFF_P + P_CU);
    const float* dsk = p.s5_d + (size_t)l * 768;
    for (size_t i = (size_t)blockIdx.x * NTHREADS + tid_; i < n8; i += (size_t)gridDim.x * NTHREADS) {
        const int c = (int)((i * 8) % 768);
        const u32x4 a = *(const u32x4*)(YF + i * 8), bq = *(const u32x4*)(YB + i * 8), uq = *(const u32x4*)(CU + i * 8);
        const unsigned aa[4] = {a.x, a.y, a.z, a.w}, bb[4] = {bq.x, bq.y, bq.z, bq.w}, uu[4] = {uq.x, uq.y, uq.z, uq.w};
        float y[8];
#pragma unroll
        for (int j = 0; j < 4; ++j) { y[2 * j] = gelu_f(bf_lo(aa[j]) + bf_lo(bb[j]) + dsk[c + 2 * j] * bf_lo(uu[j])); y[2 * j + 1] = gelu_f(bf_hi(aa[j]) + bf_hi(bb[j]) + dsk[c + 2 * j + 1] * bf_hi(uu[j])); }
        u32x4 w; w.x = cvt_pk_bf16(y[0], y[1]); w.y = cvt_pk_bf16(y[2], y[3]); w.z = cvt_pk_bf16(y[4], y[5]); w.w = cvt_pk_bf16(y[6], y[7]);
        if (!dry || p.ws == nullptr) *(u32x4*)(YF + i * 8) = w;
    }
}

__device__ __forceinline__ void phase_gmlp(const Params& p, int l, int M, LAS unsigned char* lds, bool dry = false) {
    const int tid_ = otid();
    LAS unsigned char* Wb = lds;
    LAS unsigned char* Vt = lds + 34816;
    LAS float* st = (LAS float*)(lds + 69632);
    const int tid = tid_, lane = tid & 63, w = __builtin_amdgcn_readfirstlane(tid_ >> 6), q = lane >> 4, m = lane & 15;
    bf16_t* AU = (bf16_t*)(p.ws + OFF_P + P_AU); const bf16_t* AV = (const bf16_t*)(p.ws + OFF_P + P_AV);
    const float* lng = p.ln_g + (size_t)l * 1024; const float* lnb = p.ln_b + (size_t)l * 1024;
    const int nch = M / 128, G_ = (int)gridDim.x, nfull = (nch / G_) * G_, nitem = nfull + (nch - nfull) * 8;
    for (int it = blockIdx.x; it < nitem; it += G_) {
        const int u = it < nfull ? it : nfull + ((it - nfull) >> 3), g0 = it < nfull ? 0 : ((it - nfull) & 7), g1 = it < nfull ? 8 : g0 + 1;
        const size_t r0 = (size_t)u * 128;
        for (int i = 0; i < 16; ++i) {
            const int s = w * 16 + i; const bf16_t* rp = AV + (r0 + s) * 1024 + lane * 16;
            const u32x4 a = *(const u32x4*)rp, bq = *(const u32x4*)(rp + 8);
            const unsigned aa[8] = {a.x, a.y, a.z, a.w, bq.x, bq.y, bq.z, bq.w};
            float sm = 0.f, sq = 0.f;
#pragma unroll
            for (int j = 0; j < 8; ++j) { const float x0 = bf_lo(aa[j]), x1 = bf_hi(aa[j]); sm += x0 + x1; sq += x0 * x0 + x1 * x1; }
            sm = wave_sum(sm); sq = wave_sum(sq);
            const float mean = sm * (1.0f / 1024.0f), var = fmaxf(sq * (1.0f / 1024.0f) - mean * mean, 0.f);
            if (lane == 0) { st[s * 2] = mean; st[s * 2 + 1] = rsqrtf(var + 1e-6f); }
        }
        __syncthreads();
        for (int g = g0; g < g1; ++g) {
            { const int t = tid >> 2, s0 = (tid & 3) * 32; const float* ws = p.w_s + ((size_t)l * 8 + g) * 16384 + t * 128 + s0;
#pragma unroll
              for (int qq = 0; qq < 4; ++qq) { const f32x4 a = *(const f32x4*)(ws + qq * 8), b4 = *(const f32x4*)(ws + qq * 8 + 4);
                  u32x4 o; o.x = cvt_pk_bf16(a[0], a[1]); o.y = cvt_pk_bf16(a[2], a[3]); o.z = cvt_pk_bf16(b4[0], b4[1]); o.w = cvt_pk_bf16(b4[2], b4[3]);
                  *(LAS u32x4*)(Wb + t * 272 + (s0 + qq * 8) * 2) = o; } }
            { const int s = tid >> 2, c0 = (tid & 3) * 32; const bf16_t* rp = AV + (r0 + s) * 1024 + g * 128 + c0;
              const float mean = st[s * 2], rstd = st[s * 2 + 1];
#pragma unroll
              for (int qq = 0; qq < 4; ++qq) { const u32x4 a = *(const u32x4*)(rp + qq * 8); const unsigned aa[4] = {a.x, a.y, a.z, a.w};
#pragma unroll
                  for (int j = 0; j < 4; ++j) { const int cl = c0 + qq * 8 + 2 * j, c = g * 128 + cl;
                      const unsigned pk = cvt_pk_bf16((bf_lo(aa[j]) - mean) * rstd * lng[c] + lnb[c], (bf_hi(aa[j]) - mean) * rstd * lng[c + 1] + lnb[c + 1]);
                      *(LAS bf16_t*)(Vt + cl * 272 + s * 2) = (bf16_t)(pk & 0xffffu); *(LAS bf16_t*)(Vt + (cl + 1) * 272 + s * 2) = (bf16_t)(pk >> 16); } } }
            __syncthreads();
            bf16x8 af[4];
#pragma unroll
            for (int kb = 0; kb < 4; ++kb) af[kb] = *(const LAS bf16x8*)(Vt + (16 * w + m) * 272 + kb * 64 + q * 16);
            const float* bs = p.b_s + ((size_t)l * 8 + g) * 128;
#pragma unroll
            for (int tt = 0; tt < 8; ++tt) {
                f32x4 acc = (f32x4){0.f, 0.f, 0.f, 0.f};
#pragma unroll
                for (int kb = 0; kb < 4; ++kb) acc = __builtin_amdgcn_mfma_f32_16x16x32_bf16(af[kb], *(const LAS bf16x8*)(Wb + (16 * tt + m) * 272 + kb * 64 + q * 16), acc, 0, 0, 0);
                const float bb = bs[16 * tt + m];
                bf16_t* up = AU + (r0 + 16 * tt + m) * 1024 + g * 128 + 16 * w + 4 * q;
                const u32x2 uw = *(const u32x2*)up;
                const float y0 = (acc[0] + bb) * bf_lo(uw.x), y1 = (acc[1] + bb) * bf_hi(uw.x), y2 = (acc[2] + bb) * bf_lo(uw.y), y3 = (acc[3] + bb) * bf_hi(uw.y);
                u32x2 o; o.x = cvt_pk_bf16(y0, y1); o.y = cvt_pk_bf16(y2, y3);
                if (!dry || p.ws == nullptr) *(u32x2*)up = o;
            }
            __syncthreads();
        }
    }
}

__device__ __forceinline__ unsigned fkey(float x) { const unsigned b = __float_as_uint(x); return b ^ ((b >> 31) ? 0xFFFFFFFFu : 0x80000000u); }
__device__ __forceinline__ int mbcnt64(unsigned long long m) { return __builtin_amdgcn_mbcnt_hi((unsigned)(m >> 32), __builtin_amdgcn_mbcnt_lo((unsigned)m, 0u)); }
template <int NV>
__device__ __forceinline__ int count_ge(const unsigned (&k)[NV], unsigned cand) {
    int cnt = 0;
#pragma unroll
    for (int i = 0; i < NV; ++i) cnt += __popcll(__ballot(k[i] >= cand));
    return cnt;
}
template <int NV>
__device__ __forceinline__ unsigned radix_thr16(const unsigned (&k)[NV], unsigned e0bits) {
    unsigned prefix = 0u; int bit = 31;
    {
        const unsigned c0 = e0bits ^ 0x80000000u, c1 = c0 + 0x00800000u, c2 = c0 + 0x01000000u, c3 = c0 + 0x01800000u;
        const int n0 = count_ge<NV>(k, c0), n1 = count_ge<NV>(k, c1), n2 = count_ge<NV>(k, c2), n3 = count_ge<NV>(k, c3);
        if (n0 >= 16 && n3 < 16) { prefix = (n2 >= 16) ? c2 : ((n1 >= 16) ? c1 : c0); bit = 22;
            const int nn = (n2 >= 16) ? n2 : ((n1 >= 16) ? n1 : n0); if (nn == 16) bit = -1; }
    }
    for (; bit >= 0; --bit) {
        const unsigned cand = prefix | (1u << bit);
        const int cnt = count_ge<NV>(k, cand);
        if (cnt >= 16) prefix = cand;
        if (cnt == 16) break;
    }
    return prefix;
}
__device__ __forceinline__ unsigned umin_(unsigned a, unsigned b) { return a < b ? a : b; }
__device__ __forceinline__ unsigned umax_(unsigned a, unsigned b) { return a > b ? a : b; }
__device__ __forceinline__ unsigned med3u(unsigned x, unsigned y, unsigned z) { return umax_(umin_(x, y), umin_(umax_(x, y), z)); }
__device__ __forceinline__ float unkey(unsigned k) { return __uint_as_float((k & 0x80000000u) ? (k ^ 0x80000000u) : ~k); }
__device__ __forceinline__ void ins16(unsigned (&a)[16], unsigned x) {
#pragma unroll
    for (int s = 15; s >= 1; --s) a[s] = med3u(a[s - 1], x, a[s]);
    a[0] = umax_(a[0], x);
}
__device__ __forceinline__ unsigned sel16(const unsigned (&a)[16], int i) {
    unsigned r = a[0];
#pragma unroll
    for (int t = 1; t < 16; ++t) r = (i == t) ? a[t] : r;
    return r;
}
__device__ __forceinline__ void phase_topk(const Params& p, int M, LAS unsigned char* lds) {
    const int tid_ = otid();
    LAS unsigned* lk = (LAS unsigned*)lds + tid_;
    const int gl = blockIdx.x * NTHREADS + tid_, nl = gridDim.x * NTHREADS;
    const float* SC = (const float*)(p.ws + OFF_P + Q_SC);
    int* IDX = (int*)(p.ws + OFF_P + Q_IDX); float* GATE = (float*)(p.ws + OFF_P + Q_GATE);
    const int ntask = M * 8;
    for (int task = gl; task < ntask; task += nl) {
        const float* sc = SC + (size_t)task * 256;
        unsigned a[16], b[16];
#pragma unroll
        for (int i = 0; i < 16; ++i) { a[i] = 0u; b[i] = 0u; }
#pragma unroll 4
        for (int i4 = 0; i4 < 32; ++i4) {
            const f32x4 va = *(const f32x4*)(sc + i4 * 4), vb = *(const f32x4*)(sc + 128 + i4 * 4);
#pragma unroll
            for (int e = 0; e < 4; ++e) { const unsigned tag = 127u - (unsigned)(i4 * 4 + e);
                ins16(a, (fkey(va[e]) & ~127u) | tag); ins16(b, (fkey(vb[e]) & ~127u) | tag); }
        }
        float fa[16], fb[16];
#pragma unroll
        for (int i = 0; i < 16; ++i) { fa[i] = unkey(a[i] & ~127u); fb[i] = unkey(b[i] & ~127u); }
        unsigned c[16];
#pragma unroll
        for (int i = 0; i < 16; ++i) c[i] = 0u;
#pragma unroll
        for (int i = 0; i < 16; ++i)
#pragma unroll
            for (int j = 0; j < 16; ++j)
                if ((i + 1) * (j + 1) <= 16) ins16(c, (fkey(fa[i] + fb[j]) & ~255u) | (unsigned)(i * 16 + j));
#pragma unroll
        for (int i = 0; i < 16; ++i) { lk[i * 512] = a[i]; lk[(16 + i) * 512] = b[i]; }
        const float mx = unkey(c[0] & ~255u);
        float ev[16]; float sm = 0.f; int id[16];
#pragma unroll
        for (int s = 0; s < 16; ++s) { ev[s] = __expf(unkey(c[s] & ~255u) - mx); sm += ev[s];
            const int ij = (int)(c[s] & 255u);
            const unsigned ka = lk[(ij >> 4) * 512], kb = lk[(16 + (ij & 15)) * 512];
            id[s] = (int)(127u - (ka & 127u)) * 128 + (int)(127u - (kb & 127u)); }
        const float inv = 1.0f / sm;
#pragma unroll
        for (int q = 0; q < 4; ++q) {
            u32x4 iw; iw.x = (unsigned)id[4 * q]; iw.y = (unsigned)id[4 * q + 1]; iw.z = (unsigned)id[4 * q + 2]; iw.w = (unsigned)id[4 * q + 3];
            *(u32x4*)(IDX + (size_t)task * 16 + q * 4) = iw;
            *(f32x4*)(GATE + (size_t)task * 16 + q * 4) = (f32x4){ev[4 * q] * inv, ev[4 * q + 1] * inv, ev[4 * q + 2] * inv, ev[4 * q + 3] * inv};
        }
    }
}

__device__ __forceinline__ float dot2u(unsigned a, unsigned b, float acc) {
    return __builtin_amdgcn_fdot2_f32_bf16(__builtin_bit_cast(bf16x2_t, a), __builtin_bit_cast(bf16x2_t, b), acc, false);
}
__device__ __forceinline__ float dot8(const u32x4 a, const u32x4 b, float acc) {
    acc = dot2u(a.x, b.x, acc); acc = dot2u(a.y, b.y, acc); acc = dot2u(a.z, b.z, acc); acc = dot2u(a.w, b.w, acc);
    return acc;
}
__device__ __forceinline__ void phase_peer(const Params& p, int l, int M, LAS unsigned char* lds, bool dry = false) {
    const int tid_ = otid();
    const int lane = tid_ & 63, wv_ = __builtin_amdgcn_readfirstlane(tid_ >> 6), gw = blockIdx.x * 8 + wv_, nw = gridDim.x * 8;
    LAS float* wl = (LAS float*)(lds + wv_ * 512);
    const bf16_t* H = (const bf16_t*)(p.ws + OFF_H);
    const unsigned char* U6 = p.ws + OFF_P + Q_UT; const unsigned char* V6 = p.ws + OFF_P + Q_VT;
    const float* USC = (const float*)(p.ws + OFF_P + Q_USC); const float* VSC = (const float*)(p.ws + OFF_P + Q_VSC);
    const int* IDX = (const int*)(p.ws + OFF_P + Q_IDX); const float* GATE = (const float*)(p.ws + OFF_P + Q_GATE);
    const float* modl = (const float*)(p.ws + OFF_MODV) + (size_t)l * 17 * NMOD + 10240;
    float* XC = (float*)(p.ws + OFF_XC);
    const unsigned lane24 = (unsigned)lane * 24u, lane16 = (unsigned)lane * 16u;
#define PEER_LOAD(buf, TAB, g) do { const int _is = ((g) < 8) ? id0 : id1; _Pragma("unroll") for (int e = 0; e < 8; ++e) { \
        const int _id = __builtin_amdgcn_readlane(_is, (((g) * 8 + e) & 63)); const unsigned char* _rb = (TAB) + (size_t)(unsigned)_id * 1536u; \
        const u32x4 _a = *(const u32x4*)(_rb + lane24); const u32x2 _b = *(const u32x2*)(_rb + lane24 + 16); \
        buf[e][0] = _a.x; buf[e][1] = _a.y; buf[e][2] = _a.z; buf[e][3] = _a.w; buf[e][4] = _b.x; buf[e][5] = _b.y; } } while (0)
    for (int row = gw; row < M; row += nw) {
        unsigned xw[16];
#pragma unroll
        for (int j = 0; j < 8; ++j) { const u32x2 a = *(const u32x2*)(H + (size_t)row * D + j * 256 + lane * 4); xw[2 * j] = a.x; xw[2 * j + 1] = a.y; }
        const int id0 = IDX[(size_t)row * 128 + lane], id1 = IDX[(size_t)row * 128 + 64 + lane];
        const float g0 = GATE[(size_t)row * 128 + lane], g1 = GATE[(size_t)row * 128 + 64 + lane];
        const float us0 = USC[id0], us1 = USC[id1];
        const float gv0 = g0 * VSC[id0], gv1 = g1 * VSC[id1];
#pragma unroll 1
        for (int g = 0; g < 8; ++g) {
            u32x4 bU[16];
            { const int _is = (g < 4) ? id0 : id1;
#pragma unroll
              for (int e = 0; e < 16; ++e) { const int _id = __builtin_amdgcn_readlane(_is, ((g * 16 + e) & 63)); bU[e] = *(const u32x4*)(U6 + (size_t)(unsigned)_id * 1024u + lane16); } }
            float part[16];
            float chain = 0.f;
#pragma unroll
            for (int e = 0; e < 16; ++e) { asm volatile("" : "+v"(bU[e]), "+v"(chain));
                const unsigned wd[4] = {bU[e].x, bU[e].y, bU[e].z, bU[e].w};
                float a0 = 0.f, a1 = 0.f;
#pragma unroll
                for (int d = 0; d < 4; ++d) {
                    a0 = dot2u(__builtin_bit_cast(unsigned, __builtin_amdgcn_cvt_scalef32_pk_bf16_fp4(wd[d], 1.0f, 0)), xw[4 * d + 0], a0);
                    a1 = dot2u(__builtin_bit_cast(unsigned, __builtin_amdgcn_cvt_scalef32_pk_bf16_fp4(wd[d], 1.0f, 1)), xw[4 * d + 1], a1);
                    a0 = dot2u(__builtin_bit_cast(unsigned, __builtin_amdgcn_cvt_scalef32_pk_bf16_fp4(wd[d], 1.0f, 2)), xw[4 * d + 2], a0);
                    a1 = dot2u(__builtin_bit_cast(unsigned, __builtin_amdgcn_cvt_scalef32_pk_bf16_fp4(wd[d], 1.0f, 3)), xw[4 * d + 3], a1); }
                part[e] = a0 + a1; chain = part[e]; }
            float r8[8];
#pragma unroll
            for (int i = 0; i < 8; ++i) { const bool hi = (lane & 32) != 0; const float keep = hi ? part[i + 8] : part[i], send = hi ? part[i] : part[i + 8]; r8[i] = keep + __shfl_xor(send, 32); }
            float r4[4];
#pragma unroll
            for (int i = 0; i < 4; ++i) { const bool hi = (lane & 16) != 0; const float keep = hi ? r8[i + 4] : r8[i], send = hi ? r8[i] : r8[i + 4]; r4[i] = keep + __shfl_xor(send, 16); }
            float r2[2];
#pragma unroll
            for (int i = 0; i < 2; ++i) { const bool hi = (lane & 8) != 0; const float keep = hi ? r4[i + 2] : r4[i], send = hi ? r4[i] : r4[i + 2]; r2[i] = keep + __shfl_xor(send, 8); }
            float r1;
            { const bool hi = (lane & 4) != 0; const float keep = hi ? r2[1] : r2[0], send = hi ? r2[0] : r2[1]; r1 = keep + __shfl_xor(send, 4); }
            r1 += __shfl_xor(r1, 2); r1 += __shfl_xor(r1, 1);
            const int k = g * 16 + ((lane >> 2) & 15);
            const float usk = __shfl((g < 4) ? us0 : us1, k & 63), gvk = __shfl((g < 4) ? gv0 : gv1, k & 63);
            if ((lane & 3) == 0) wl[k] = gelu_f(r1 * usk) * gvk;
        }
        asm volatile("s_waitcnt lgkmcnt(0)" ::: "memory");
        h16x2 oh[16];
#pragma unroll
        for (int i = 0; i < 16; ++i) oh[i] = (h16x2){(_Float16)0.f, (_Float16)0.f};
#pragma unroll 1
        for (int g = 0; g < 8; ++g) {
            u32x4 bV[16];
            { const int _is = (g < 4) ? id0 : id1;
#pragma unroll
              for (int e = 0; e < 16; ++e) { const int _id = __builtin_amdgcn_readlane(_is, ((g * 16 + e) & 63)); bV[e] = *(const u32x4*)(V6 + (size_t)(unsigned)_id * 1024u + lane16); } }
#pragma unroll
            for (int e = 0; e < 16; ++e) { const float wkf = wl[g * 16 + e]; asm volatile("" : "+v"(bV[e]), "+v"(oh[0]), "+v"(oh[5]), "+v"(oh[10]), "+v"(oh[15]));
                const _Float16 wk1 = (_Float16)wkf; const h16x2 wk = (h16x2){wk1, wk1};
                const unsigned wd[4] = {bV[e].x, bV[e].y, bV[e].z, bV[e].w};
#pragma unroll
                for (int d = 0; d < 4; ++d) {
                    oh[4 * d + 0] = __builtin_elementwise_fma(__builtin_bit_cast(h16x2, __builtin_amdgcn_cvt_scalef32_pk_f16_fp4(wd[d], 1.0f, 0)), wk, oh[4 * d + 0]);
                    oh[4 * d + 1] = __builtin_elementwise_fma(__builtin_bit_cast(h16x2, __builtin_amdgcn_cvt_scalef32_pk_f16_fp4(wd[d], 1.0f, 1)), wk, oh[4 * d + 1]);
                    oh[4 * d + 2] = __builtin_elementwise_fma(__builtin_bit_cast(h16x2, __builtin_amdgcn_cvt_scalef32_pk_f16_fp4(wd[d], 1.0f, 2)), wk, oh[4 * d + 2]);
                    oh[4 * d + 3] = __builtin_elementwise_fma(__builtin_bit_cast(h16x2, __builtin_amdgcn_cvt_scalef32_pk_f16_fp4(wd[d], 1.0f, 3)), wk, oh[4 * d + 3]); } }
        }
        float out[32];
#pragma unroll
        for (int i = 0; i < 16; ++i) { out[2 * i] = (float)oh[i].x; out[2 * i + 1] = (float)oh[i].y; }
        asm volatile("s_waitcnt lgkmcnt(0)" ::: "memory");
        const bool lat = row < TL; const int mb = lat ? (row >> 11) : 16;
        float* xp = lat ? p.out + (size_t)row * D : XC + (size_t)(row - TL) * D;
        const float* gv = modl + (size_t)mb * NMOD;
        f32x4 xn[8]; float ss = 0.f;
#pragma unroll
        for (int j = 0; j < 8; ++j) { const int e = j * 256 + lane * 4;
            const f32x4 o4 = (f32x4){out[4 * j], out[4 * j + 1], out[4 * j + 2], out[4 * j + 3]};
            xn[j] = *(const f32x4*)(xp + e) + *(const f32x4*)(gv + e) * o4;
            ss += xn[j][0] * xn[j][0] + xn[j][1] * xn[j][1] + xn[j][2] * xn[j][2] + xn[j][3] * xn[j][3]; }
        ss = wave_sum(ss);
        const float rs = rsqrtf(ss * (1.0f / 2048.0f) + 1e-6f);
        if (!dry || p.ws == nullptr) {
            if (l == 0) {
                const float* m1 = (const float*)(p.ws + OFF_MODV) + (size_t)17 * NMOD + (size_t)mb * NMOD;
                float am = 0.f;
#pragma unroll
                for (int j = 0; j < 8; ++j) { const int e = j * 256 + lane * 4;
                    *(f32x4*)(xp + e) = xn[j];
                    xn[j] = xn[j] * rs * (*(const f32x4*)(m1 + 2048 + e) + 1.0f) + *(const f32x4*)(m1 + e);
                    am = fmaxf(am, fmaxf(fmaxf(fabsf(xn[j][0]), fabsf(xn[j][1])), fmaxf(fabsf(xn[j][2]), fabsf(xn[j][3])))); }
#pragma unroll
                for (int o = 32; o >= 1; o >>= 1) am = fmaxf(am, __shfl_xor(am, o));
                const float qs = am > 0.f ? 240.0f / am : 1.0f;
                unsigned char* H8 = p.ws + OFF_H8 + (size_t)row * D;
#pragma unroll
                for (int j = 0; j < 8; ++j) *(unsigned*)(H8 + j * 256 + lane * 4) = pack_fp8x4(xn[j][0] * qs, xn[j][1] * qs, xn[j][2] * qs, xn[j][3] * qs);
                if (lane == 0) ((float*)(p.ws + OFF_HS))[row] = am > 0.f ? am * (1.0f / 240.0f) : 1.0f;
            } else {
#pragma unroll
                for (int j = 0; j < 8; ++j) { const int e = j * 256 + lane * 4; *(f32x4*)(xp + e) = xn[j] * rs * *(const f32x4*)(p.final_g + e); }
            }
        }
    }
#undef PEER_LOAD
}

__device__ __forceinline__ Params load_params() {
    Params r;
#if defined(__HIP_DEVICE_COMPILE__)
    typedef const unsigned long long __attribute__((address_space(4)))* KP;
    KP k = (KP)__builtin_amdgcn_kernarg_segment_ptr();
    asm volatile("" : "+s"(k));
    void** d = (void**)&r;
#pragma unroll
    for (int i = 0; i < (int)(sizeof(Params) / 8); ++i) d[i] = (void*)(__attribute__((address_space(1))) void*)k[i];
#endif
    return r;
}
#define WSP(off) (p.ws + (off))
template <int l>
__device__ __forceinline__ void mega_layer(LAS unsigned char* lds, const XcdBarrier& bar) {
        const int Mrows = (l == 0) ? TT : TL;
        const int GLU_ROT = (((Mrows / 256) * 6) % (int)gridDim.x) & ~7;
        if (l == 0) {
            { const Params p = load_params(); phase_wconv(p, 0, lds); }
            { const Params p = load_params(); phase_norm<0, true>(p, 0, TT, 0, 2048); }
            xcd_barrier(bar);
        }
        { const Params p = load_params(); EpiInProj E{WSP(OFF_P), (const float*)WSP(OFF_HS), (const unsigned*)WSP(OFF_CMAX) + (size_t)l * INC};
          run_gemm(lds, (const bf16_t*)WSP(OFF_H8), (const bf16_t*)WSP(OFF_W + W_IN), TT, INC, D / 2, E); }
        xcd_barrier(bar);
        { const Params p = load_params(); phase_hgrn(p, l, lds); }
        __syncthreads();
        { const Params p = load_params(); phase_s5(p, l, lds); }
        xcd_barrier(bar);
        { const Params p = load_params(); phase_gmlp(p, l, Mrows, lds); }
        { const Params p = load_params(); phase_hcomb(p, l, Mrows); }
        { const Params p = load_params(); phase_s5post(p, l, Mrows); }
        xcd_barrier(bar);
        { const Params p = load_params(); EpiGlu E{(bf16_t*)WSP(OFF_P + P_CU)}; run_gemm(lds, (const bf16_t*)WSP(OFF_H + H_YSF), (const bf16_t*)WSP(OFF_W + W_GLU), Mrows, 1536, 768, E); }
        { const Params p = load_params(); EpiMerge<true> E{(bf16_t*)WSP(OFF_P + P_MERGED), (const bf16_t*)WSP(OFF_P + P_GATES)}; run_gemm(lds, (const bf16_t*)WSP(OFF_P + P_AU), (const bf16_t*)WSP(OFF_W + W_A), Mrows, D, 1024, E, GLU_ROT); }
        { const Params p = load_params(); EpiMerge<false> E{(bf16_t*)WSP(OFF_P + P_MERGED), (const bf16_t*)WSP(OFF_P + P_GATES) + 2048}; run_gemm(lds, (const bf16_t*)WSP(OFF_P + P_BFF), (const bf16_t*)WSP(OFF_W + W_B), Mrows, D, 1024, E, GLU_ROT); }
        xcd_barrier(bar);
        { const Params p = load_params(); EpiMerge<false> E{(bf16_t*)WSP(OFF_P + P_MERGED), (const bf16_t*)WSP(OFF_P + P_GATES) + 4096}; run_gemm(lds, (const bf16_t*)WSP(OFF_P + P_CU), (const bf16_t*)WSP(OFF_W + W_C), Mrows, D, 768, E); }
        xcd_barrier(bar);
        { const Params p = load_params(); EpiResid E{p.out, (float*)WSP(OFF_XC), (const float*)WSP(OFF_MODV) + (size_t)l * 17 * NMOD + 4096}; run_gemm(lds, (const bf16_t*)WSP(OFF_P + P_MERGED), (const bf16_t*)WSP(OFF_W + W_O), Mrows, D, D, E); }
        { const Params p = load_params(); phase_tabconv(p, l); }
        xcd_barrier(bar);
        { const Params p = load_params(); phase_norm<1>(p, l, Mrows, 6144, 8192); }
        xcd_barrier(bar);
        { const Params p = load_params(); EpiF32 E{(float*)WSP(OFF_P + Q_SC), 2048}; run_gemm(lds, (const bf16_t*)WSP(OFF_H), (const bf16_t*)WSP(OFF_W + W_S), Mrows, D, D, E); }
        xcd_barrier(bar);
        { const Params p = load_params(); phase_topk(p, Mrows, lds); }
        xcd_barrier(bar);
        { const Params p = load_params(); phase_peer(p, l, Mrows, lds); }
        if (l == 0) {
            __syncthreads();
            { const Params p = load_params(); phase_wconv(p, 1, lds); }
            xcd_barrier(bar);
        }
}
#undef WSP
__global__ void __launch_bounds__(NTHREADS, 2) k_mega(Params p_kernarg_only) {
    extern __shared__ __attribute__((aligned(16))) unsigned char smem[];
    LAS unsigned char* lds = (LAS unsigned char*)smem;
    volatile LAS unsigned* xbw = (volatile LAS unsigned*)(lds + LDS_BYTES - 16);
    if (threadIdx.x == 0) { xbw[0] = 0u; xbw[1] = 0u; xbw[2] = 0u; xbw[3] = 0u; }
    __syncthreads();
    XcdBarrier bar;
    { const Params p = load_params(); bar = xcd_barrier_post((unsigned*)(p.ws + OFF_BAR), xbw); }
#define WSP(off) (p.ws + (off))
    { const Params p = load_params(); phase_colmax(p); }
    { const Params p = load_params(); phase_prep(p); phase_mod(p, lds); }
    xcd_barrier(bar);
    mega_layer<0>(lds, bar);
    mega_layer<1>(lds, bar);
#undef WSP
}

extern "C" void kernel_launch(void* const* d_in, const int* in_sizes, int n_in, void* d_out, int out_size, void* d_ws, size_t ws_size, hipStream_t stream) {
    (void)in_sizes; (void)n_in; (void)out_size; (void)ws_size;
    Params p;
    const float** f = (const float**)&p;
    for (int i = 0; i < 31; ++i) f[i] = (const float*)d_in[i];
    p.out = (float*)d_out; p.ws = (unsigned char*)d_ws;
    static int grid = 0;
    if (!grid) {
        int dev = 0, cus = 0, per_cu = 0;
        (void)hipGetDevice(&dev);
        (void)hipDeviceGetAttribute(&cus, hipDeviceAttributeMultiprocessorCount, dev);
        (void)hipFuncSetAttribute((const void*)k_mega, hipFuncAttributeMaxDynamicSharedMemorySize, LDS_BYTES);
        (void)hipOccupancyMaxActiveBlocksPerMultiprocessor(&per_cu, (const void*)k_mega, NTHREADS, LDS_BYTES);
        grid = (per_cu >= 1 && cus > 0) ? (cus < 256 ? cus : 256) : 256;
    }
    (void)hipMemsetAsync(p.ws + OFF_BAR, 0, OFF_MODV, stream);
    hipLaunchKernelGGL(k_mega, dim3(grid), dim3(NTHREADS), LDS_BYTES, stream, p);
}
```
